# Optimizing an MI355X kernel written in HIP

```python
import jax, jax.numpy as jnp
from jax import lax
import numpy as np

D_MODEL = 2048
BATCH = 4
SEQ = 8192
DEPTH = 1

CHUNK = 64
D_FF = 5632
FFN_RES = 0.5
RMS_EPS = 1e-6

RWKV_WIDTH = D_MODEL // 2
RWKV_HEAD = 64
RWKV_HEADS = RWKV_WIDTH // RWKV_HEAD
DECAY_LORA = 64
AAA_LORA = 64
GATE_LORA = 160
GN_EPS = 64e-5

HGRN_WIDTH = D_MODEL - RWKV_WIDTH
HGRN_EXPAND = 128
HGRN_HEADS = HGRN_WIDTH // HGRN_EXPAND
HGRN_HEAD = HGRN_WIDTH // HGRN_HEADS

RWKV_COLS = 3 * RWKV_WIDTH + DECAY_LORA + AAA_LORA + GATE_LORA
HGRN_COLS = 4 * HGRN_WIDTH
IN_COLS = RWKV_COLS + HGRN_COLS

kernel_name = 'hybrid_rwkv7_hgrn2_macaron_layer'


def rms_norm(x, gain, eps=RMS_EPS):
    x32 = x.astype(jnp.float32)
    inv = lax.rsqrt(jnp.mean(x32 * x32, axis=-1, keepdims=True) + eps)
    return (x32 * inv).astype(x.dtype) * gain


def swiglu(h, w_gate, w_up, w_down):
    return (jax.nn.silu(h @ w_gate) * (h @ w_up)) @ w_down


def rwkv7_mix(p, mu, w0, w2, a0, a2, g2, k_k, k_a, r_k, ln_w, ln_b):
    B, T, _ = p.shape
    C, H, N = RWKV_WIDTH, RWKV_HEADS, RWKV_HEAD
    f32 = jnp.float32
    p_prev = jnp.pad(p, ((0, 0), (1, 0), (0, 0)))[:, :T]
    p = p + (p_prev - p) * mu
    r, k, v, xw, xa, xg = jnp.split(
        p, [C, 2 * C, 3 * C, 3 * C + DECAY_LORA, 3 * C + DECAY_LORA + AAA_LORA], axis=-1)
    w = -jax.nn.softplus(-(w0 + jnp.tanh(xw.astype(f32)) @ w2.astype(f32))) - 0.5
    decay = jnp.exp(-jnp.exp(w))
    a = jax.nn.sigmoid((a0 + xa @ a2).astype(f32))
    g = jax.nn.sigmoid(xg) @ g2
    heads = lambda t: t.astype(f32).reshape(B, T, H, N)
    r, k, v, a, decay = heads(r), heads(k), heads(v), heads(a), heads(decay)
    kk = k * k_k.astype(f32).reshape(H, N)
    kk = kk / jnp.maximum(jnp.sqrt(jnp.sum(kk * kk, axis=-1, keepdims=True)), 1e-12)
    k = k * (1.0 + (a - 1.0) * k_a.astype(f32).reshape(H, N))

    def step(S, inp):
        r_t, w_t, k_t, v_t, kk_t, a_t = inp
        sa = jnp.einsum('bhvk,bhk->bhv', S, -kk_t)
        S = (S * w_t[:, :, None, :] + sa[..., None] * (kk_t * a_t)[:, :, None, :]
             + v_t[..., None] * k_t[:, :, None, :])
        return S, jnp.einsum('bhvk,bhk->bhv', S, r_t)

    seq_first = lambda t: jnp.moveaxis(t, 1, 0)
    S0 = jnp.zeros((B, H, N, N), f32)
    _, y = lax.scan(step, S0, (seq_first(r), seq_first(decay), seq_first(k),
                               seq_first(v), seq_first(kk), seq_first(a)))
    y = jnp.moveaxis(y, 0, 1)
    mean = jnp.mean(y, axis=-1, keepdims=True)
    var = jnp.var(y, axis=-1, keepdims=True)
    y = ((y - mean) * lax.rsqrt(var + GN_EPS)).reshape(B, T, C) * ln_w + ln_b
    bonus = jnp.sum(r * k * r_k.astype(f32), axis=-1, keepdims=True) * v
    y = (y + bonus.reshape(B, T, C)) * g
    return y.astype(p.dtype)


def hgrn2_mix(p, lb, norm_w):
    B, T, _ = p.shape
    H, Dh = HGRN_HEADS, HGRN_HEAD
    f32 = jnp.float32
    q, f, i, gate = jnp.split(p, 4, axis=-1)
    q = jax.nn.silu(q.astype(f32))
    forget = lb + (1.0 - lb) * jax.nn.sigmoid(f.astype(f32))
    log_f = jnp.log(forget)
    k = 1.0 - forget
    n_chunks = T // CHUNK
    chunks = lambda t: t.astype(f32).reshape(B, n_chunks, CHUNK, H, Dh).transpose(1, 0, 3, 2, 4)
    causal = jnp.tril(jnp.ones((CHUNK, CHUNK), dtype=bool))

    def step(S, inp):
        q_c, k_c, v_c, lf_c = inp
        G = jnp.cumsum(lf_c, axis=2)
        o_inter = jnp.einsum('bhik,bhkv->bhiv', q_c * jnp.exp(G), S)
        diff = G[:, :, :, None, :] - G[:, :, None, :, :]
        dec = jnp.exp(jnp.where(causal[:, :, None], diff, -jnp.inf))
        A = jnp.einsum('bhik,bhijk->bhij', q_c, dec * k_c[:, :, None, :, :])
        o = o_inter + jnp.einsum('bhij,bhjv->bhiv', A, v_c)
        G_last = G[:, :, -1:, :]
        S = (S * jnp.exp(G_last)[:, :, 0, :, None]
             + jnp.einsum('bhjk,bhjv->bhkv', k_c * jnp.exp(G_last - G), v_c))
        return S, o

    S0 = jnp.zeros((B, H, Dh, Dh), f32)
    _, o = lax.scan(step, S0, (chunks(q), chunks(k), chunks(i), chunks(log_f)))
    o = o.transpose(1, 0, 3, 2, 4).reshape(B, T, H, Dh)
    o = o * lax.rsqrt(jnp.mean(o * o, axis=-1, keepdims=True) + RMS_EPS)
    o = o.reshape(B, T, HGRN_WIDTH) * norm_w * jax.nn.silu(gate.astype(f32))
    return o.astype(p.dtype)


def setup_inputs(seed: int = 0) -> dict:
    key = jax.random.key(seed)
    ks = jax.random.split(key, 32)
    f32 = jnp.float32
    L, D, F = DEPTH, D_MODEL, D_FF
    C, Ch = RWKV_WIDTH, HGRN_WIDTH
    nrm = lambda k, shape, scale: scale * jax.random.normal(k, shape, f32)
    gain = lambda k, shape: 1.0 + 0.02 * jax.random.normal(k, shape, f32)
    return {
        'x': nrm(ks[0], (BATCH, SEQ, D), 1.0),
        'ffn1_norm': gain(ks[1], (L, D)),
        'ffn1_w_gate': nrm(ks[2], (L, D, F), D ** -0.5),
        'ffn1_w_up': nrm(ks[3], (L, D, F), D ** -0.5),
        'ffn1_w_down': nrm(ks[4], (L, F, D), F ** -0.5),
        'mix_norm': gain(ks[5], (L, D)),
        'w_in': nrm(ks[6], (L, D, IN_COLS), D ** -0.5),
        'rwkv_mu': jax.random.uniform(ks[7], (L, RWKV_COLS), f32),
        'rwkv_w0': jax.random.uniform(ks[8], (L, C), f32, -6.0, -1.0),
        'rwkv_w2': nrm(ks[9], (L, DECAY_LORA, C), 0.1),
        'rwkv_a0': nrm(ks[10], (L, C), 0.1),
        'rwkv_a2': nrm(ks[11], (L, AAA_LORA, C), 0.1),
        'rwkv_g2': nrm(ks[12], (L, GATE_LORA, C), GATE_LORA ** -0.5),
        'rwkv_k_k': 0.85 + nrm(ks[13], (L, C), 0.05),
        'rwkv_k_a': 1.0 + nrm(ks[14], (L, C), 0.05),
        'rwkv_r_k': nrm(ks[15], (L, RWKV_HEADS, RWKV_HEAD), 0.1),
        'rwkv_ln_w': gain(ks[16], (L, C)),
        'rwkv_ln_b': nrm(ks[17], (L, C), 0.02),
        'hgrn_lb_logits': nrm(ks[18], (L + 1, Ch), 0.5),
        'hgrn_norm': gain(ks[19], (L, Ch)),
        'w_out': nrm(ks[20], (L, D, D), D ** -0.5),
        'ffn2_norm': gain(ks[21], (L, D)),
        'ffn2_w_gate': nrm(ks[22], (L, D, F), D ** -0.5),
        'ffn2_w_up': nrm(ks[23], (L, D, F), D ** -0.5),
        'ffn2_w_down': nrm(ks[24], (L, F, D), F ** -0.5),
        'final_norm': gain(ks[25], (D,)),
    }


def reference(x, ffn1_norm, ffn1_w_gate, ffn1_w_up, ffn1_w_down, mix_norm, w_in,
              rwkv_mu, rwkv_w0, rwkv_w2, rwkv_a0, rwkv_a2, rwkv_g2, rwkv_k_k, rwkv_k_a,
              rwkv_r_k, rwkv_ln_w, rwkv_ln_b, hgrn_lb_logits, hgrn_norm, w_out,
              ffn2_norm, ffn2_w_gate, ffn2_w_up, ffn2_w_down, final_norm):
    lb_all = jnp.cumsum(jax.nn.softmax(hgrn_lb_logits.astype(jnp.float32), axis=0), axis=0)
    for l in range(DEPTH):
        h = rms_norm(x, ffn1_norm[l])
        x = x + FFN_RES * swiglu(h, ffn1_w_gate[l], ffn1_w_up[l], ffn1_w_down[l])
        h = rms_norm(x, mix_norm[l])
        proj = h @ w_in[l]
        y_rwkv = rwkv7_mix(proj[..., :RWKV_COLS], rwkv_mu[l], rwkv_w0[l], rwkv_w2[l],
                           rwkv_a0[l], rwkv_a2[l], rwkv_g2[l], rwkv_k_k[l], rwkv_k_a[l],
                           rwkv_r_k[l], rwkv_ln_w[l], rwkv_ln_b[l])
        y_hgrn = hgrn2_mix(proj[..., RWKV_COLS:], lb_all[l], hgrn_norm[l])
        x = x + jnp.concatenate([y_rwkv, y_hgrn], axis=-1) @ w_out[l]
        h = rms_norm(x, ffn2_norm[l])
        x = x + FFN_RES * swiglu(h, ffn2_w_gate[l], ffn2_w_up[l], ffn2_w_down[l])
    return rms_norm(x, final_norm)
```

```cpp
#include <hip/hip_runtime.h>
#include <cstdio>
#include <cstdint>
namespace pg8 {
#define PG8_LAS __attribute__((address_space(3)))
typedef unsigned short bf16_t;
typedef short bf16x8 __attribute__((ext_vector_type(8)));
typedef float f32x4 __attribute__((ext_vector_type(4)));
typedef unsigned u32x4 __attribute__((ext_vector_type(4)));
constexpr int BM = 256, BK = 64, HALF = 128, HTB = HALF * BK * 2  , STAGE_BYTES = 8 * HTB, NXCD = 8, WGM = 8;

__host__ __device__ __forceinline__ int lds_byte(int r, int c) { const int st = (r >> 4) * 2 + (c >> 5), rr = r & 15, cc = c & 31, ob = rr * 64 + cc * 2; return st * 1024 + (ob ^ (((ob >> 9) & 1) << 5)); }
__host__ __device__ __forceinline__ void stage_rc(int b, int& R, int& C) { const int st = b / 1024, sb = b % 1024, swz = sb ^ (((sb >> 9) & 1) << 5); R = (st >> 1) * 16 + swz / 64; C = (st & 1) * 32 + (swz % 64) / 2; }
__host__ __device__ __forceinline__ int perm32(int rho) { const int n = rho >> 4, i = rho & 15; return 8 * (i >> 2) + 4 * n + (i & 3); }

struct Unit { int pm, pn; };
struct Gemm { const bf16_t* A; const bf16_t* Bt; int M, N, K; };

struct StaticOrder {
    int nM, nN, nwg, G, c;
    __host__ __device__ void init(int M, int N, int G_, int c_) { nM = M / BM; nN = N / BM; nwg = nM * nN; G = G_; c = c_; }
    __host__ __device__ bool next(int i, Unit& u) const {
        const long L = (long)i * G + c; if (L >= nwg) return false;
        int wgid = (int)L; { const int q = nwg / NXCD, r = nwg % NXCD, xcd = wgid % NXCD, off = wgid / NXCD; wgid = (xcd < r ? xcd * (q + 1) : r * (q + 1) + (xcd - r) * q) + off; }
        const int nig = WGM * nN, gid = wgid / nig, fm = gid * WGM, gsz = (nM - fm) < WGM ? (nM - fm) : WGM;
        u.pm = fm + ((wgid % nig) % gsz); u.pn = (wgid % nig) / gsz; return true;
    }
    __device__ __forceinline__ void a_ready(const Unit&) const {}
    __device__ __forceinline__ void done(const Unit&) const {}
};


__device__ __forceinline__ unsigned cvt_pk_bf16(float lo, float hi) { unsigned r; asm volatile("v_cvt_pk_bf16_f32 %0, %1, %2" : "=v"(r) : "v"(lo), "v"(hi)); return r; }
__device__ __forceinline__ float fast_sigmoid(float z) { return __builtin_amdgcn_rcpf(1.0f + __builtin_amdgcn_exp2f(-1.44269504f * z)); }
__device__ __forceinline__ float fast_silu(float z) { return z * fast_sigmoid(z); }
constexpr float SS_SCALE = 16777216.0f;
__device__ __forceinline__ float inv_rms_from_val(unsigned long long v) {
    const float tot = (float)v * (1.0f / SS_SCALE);
    return 1.0f / sqrtf(tot * (1.0f / 2048.0f) + 1e-6f);
}
__device__ __forceinline__ u32x4 pack8(const f32x4 v0, const f32x4 v1) { u32x4 w; w.x = cvt_pk_bf16(v0[0], v0[1]); w.y = cvt_pk_bf16(v0[2], v0[3]); w.z = cvt_pk_bf16(v1[0], v1[1]); w.w = cvt_pk_bf16(v1[2], v1[3]); return w; }

struct EpiSwiglu {
    static constexpr bool PERM = true, AFTER_DRAIN = false;
    bf16_t* O; int ldc; const unsigned long long* ss;
    __device__ __forceinline__ void operator()(const f32x4 (&acc)[2][2][4][2], const Unit& u, int wr, int wc, int fr, int fq) const {
        const int row0 = u.pm * BM + wr * 64 + fr, col0 = u.pn * HALF + wc * 32 + 8 * fq;
        unsigned long long sv[2][4];
#pragma unroll
        for (int ai = 0; ai < 2; ++ai)
#pragma unroll
            for (int m = 0; m < 4; ++m) sv[ai][m] = ss[row0 + ai * HALF + m * 16];
#pragma unroll
        for (int ai = 0; ai < 2; ++ai)
#pragma unroll
            for (int m = 0; m < 4; ++m) { const int row = row0 + ai * HALF + m * 16; const float inv = inv_rms_from_val(sv[ai][m]);
                f32x4 o[2];
#pragma unroll
                for (int n = 0; n < 2; ++n) { const f32x4 g = acc[ai][0][m][n] * inv, up = acc[ai][1][m][n] * inv;
#pragma unroll
                    for (int j = 0; j < 4; ++j) o[n][j] = fast_silu(g[j]) * up[j]; }
                *(u32x4*)(O + (size_t)row * ldc + col0) = pack8(o[0], o[1]); }
    }
};
struct EpiResid {
    static constexpr bool PERM = true, AFTER_DRAIN = false;
    const float* resid; float* out; bf16_t* ob; unsigned long long* ss; float alpha;
    __device__ __forceinline__ void operator()(const f32x4 (&acc)[2][2][4][2], const Unit& u, int wr, int wc, int fr, int fq) const {
        const int row0 = u.pm * BM + wr * 64 + fr, col0 = u.pn * BM + wc * 32 + 8 * fq;
#pragma unroll
        for (int ai = 0; ai < 2; ++ai)
#pragma unroll
            for (int m = 0; m < 4; ++m) { const int row = row0 + ai * HALF + m * 16; const size_t off = (size_t)row * 2048 + col0; float s = 0.f;
#pragma unroll
                for (int bj = 0; bj < 2; ++bj) {
                    const f32x4 r0 = *(const f32x4*)(resid + off + bj * HALF), r1 = *(const f32x4*)(resid + off + bj * HALF + 4);
                    const f32x4 o0 = r0 + acc[ai][bj][m][0] * alpha, o1 = r1 + acc[ai][bj][m][1] * alpha;
                    *(f32x4*)(out + off + bj * HALF) = o0; *(f32x4*)(out + off + bj * HALF + 4) = o1;
                    if (ob) *(u32x4*)(ob + off + bj * HALF) = pack8(o0, o1);
                    s += (o0[0] * o0[0] + o0[1] * o0[1]) + (o0[2] * o0[2] + o0[3] * o0[3]) + (o1[0] * o1[0] + o1[1] * o1[1]) + (o1[2] * o1[2] + o1[3] * o1[3]); }
                if (ss) { s += __shfl_xor(s, 16); s += __shfl_xor(s, 32);
                    if (fq == 0) atomicAdd(ss + row, (unsigned long long)(s * SS_SCALE + 0.5f)); } }
    }
};
struct EpiInProj {
    static constexpr bool PERM = true, AFTER_DRAIN = false;
    bf16_t* rkv; float* lin; bf16_t* hg; const unsigned long long* ss; const float* lbl;
    __device__ __forceinline__ void operator()(const f32x4 (&acc)[2][2][4][2], const Unit& u, int wr, int wc, int fr, int fq) const {
        const int row0 = u.pm * BM + wr * 64 + fr, cin = wc * 32 + 8 * fq;
        const int pn = u.pn;
        float invs[2][4];
        { unsigned long long sv[2][4];
#pragma unroll
          for (int ai = 0; ai < 2; ++ai)
#pragma unroll
              for (int m = 0; m < 4; ++m) sv[ai][m] = ss[row0 + ai * HALF + m * 16];
#pragma unroll
          for (int ai = 0; ai < 2; ++ai)
#pragma unroll
              for (int m = 0; m < 4; ++m) invs[ai][m] = inv_rms_from_val(sv[ai][m]); }
        int mode;
        if (pn < 12) mode = 0; else if (pn < 14) mode = 1; else { const int sg = (pn - 14) >> 2; mode = (sg == 0 || sg == 3) ? 2 : (sg == 1 ? 3 : 4); }
#pragma unroll
        for (int bj = 0; bj < 2; ++bj) {
            f32x4 om0 = (f32x4){0.f, 0.f, 0.f, 0.f}, om1 = om0;
            if (mode == 3) { const float* lp = lbl + (pn - 18) * BM + bj * HALF + cin; const f32x4 a0 = *(const f32x4*)lp, a1 = *(const f32x4*)(lp + 4), c0 = *(const f32x4*)(lp + 1024), c1 = *(const f32x4*)(lp + 1028);
#pragma unroll
                for (int j = 0; j < 4; ++j) { om0[j] = 1.0f - fast_sigmoid(a0[j] - c0[j]); om1[j] = 1.0f - fast_sigmoid(a1[j] - c1[j]); } }
#pragma unroll
            for (int ai = 0; ai < 2; ++ai)
#pragma unroll
                for (int m = 0; m < 4; ++m) { const int row = row0 + ai * HALF + m * 16; const float inv = invs[ai][m];
                    f32x4 v0 = acc[ai][bj][m][0] * inv, v1 = acc[ai][bj][m][1] * inv;
                    if (mode == 0) { *(u32x4*)(rkv + (size_t)row * 3072 + pn * BM + bj * HALF + cin) = pack8(v0, v1); }
                    else if (mode == 1) { const int cl = (pn - 12) * BM + bj * HALF + cin;
                        if (cl < 288) { *(f32x4*)(lin + (size_t)row * 288 + cl) = v0; *(f32x4*)(lin + (size_t)row * 288 + cl + 4) = v1; } }
                    else {
                        if (mode == 2) {
#pragma unroll
                            for (int j = 0; j < 4; ++j) { v0[j] = fast_silu(v0[j]); v1[j] = fast_silu(v1[j]); } }
                        else if (mode == 3) {
#pragma unroll
                            for (int j = 0; j < 4; ++j) { v0[j] = om0[j] * fast_sigmoid(-v0[j]); v1[j] = om1[j] * fast_sigmoid(-v1[j]); } }
                        *(u32x4*)(hg + (size_t)row * 4096 + (pn - 14) * BM + bj * HALF + cin) = pack8(v0, v1); } } }
    }
};
struct EpiLora {
    static constexpr bool PERM = true, AFTER_DRAIN = false;
    bf16_t* lout; const float* w0; const float* a0;
    __device__ __forceinline__ void operator()(const f32x4 (&acc)[2][2][4][2], const Unit& u, int wr, int wc, int fr, int fq) const {
        const int row0 = u.pm * BM + wr * 64 + fr, cin = wc * 32 + 8 * fq;
        const int pn = u.pn, mode = pn >> 2;
#pragma unroll
        for (int bj = 0; bj < 2; ++bj) {
            f32x4 b0 = (f32x4){0.f, 0.f, 0.f, 0.f}, b1 = b0;
            if (mode < 2) { const float* bp = (mode == 0 ? w0 : a0) + (pn & 3) * BM + bj * HALF + cin; b0 = *(const f32x4*)bp; b1 = *(const f32x4*)(bp + 4); }
#pragma unroll
            for (int ai = 0; ai < 2; ++ai)
#pragma unroll
                for (int m = 0; m < 4; ++m) { const int row = row0 + ai * HALF + m * 16;
                    f32x4 v0 = acc[ai][bj][m][0] + b0, v1 = acc[ai][bj][m][1] + b1;
#pragma unroll
                    for (int j = 0; j < 4; ++j) { const float s0 = fast_sigmoid(v0[j]), s1 = fast_sigmoid(v1[j]);
                        const float d0 = 1.0f - __builtin_amdgcn_exp2f(-0.87504572f * s0), d1 = 1.0f - __builtin_amdgcn_exp2f(-0.87504572f * s1);
                        v0[j] = mode == 0 ? d0 : (mode == 1 ? s0 : v0[j]); v1[j] = mode == 0 ? d1 : (mode == 1 ? s1 : v1[j]); }
                    *(u32x4*)(lout + (size_t)row * 3072 + pn * BM + bj * HALF + cin) = pack8(v0, v1); asm volatile("" ::: "memory"); } }
    }
};
template <class Epi, class Sched, bool ALIGN_EPI = false, bool SP2 = false>
__device__ __forceinline__ void gemm_phase(PG8_LAS unsigned char* lds, const Gemm g, const Sched& S, const Epi& E) {
    const int tid = threadIdx.x, wid = __builtin_amdgcn_readfirstlane(tid >> 6), lane = tid & 63, wr = wid >> 2, wc = wid & 3, fr = lane & 15, fq = lane >> 4;
    const int K = g.K, nt = K / BK;
    unsigned voffA[2], voffB[2];
#pragma unroll
    for (int i = 0; i < 2; ++i) { int R, C; stage_rc(tid * 16 + i * 8192, R, C); const int Rb = Epi::PERM ? ((R & ~31) + perm32(R & 31)) : R;
        voffA[i] = (unsigned)(R * K + C) * 2u; voffB[i] = (unsigned)(Rb * K + C) * 2u; }
    const size_t kstep = (size_t)(BK * 2);
    const size_t hstep = (size_t)HALF * K * 2;
    const size_t tstep = 2 * hstep;
    const unsigned ldsw = (unsigned)wid * 1024u;
    const int aoff = lds_byte(wr * 64 + fr, fq * 8), boff = lds_byte(wc * 32 + fr, fq * 8);
#define PG8_SA(b, h) (((b) * 2 + (h)) * HTB)
#define PG8_SB(b, h) ((4 + (b) * 2 + (h)) * HTB)
#define PG8_STAGE(bufoff, gbase, voff) do { _Pragma("unroll") for (int _i = 0; _i < 2; ++_i) \
        __builtin_amdgcn_global_load_lds((const unsigned*)((const char*)(gbase) + (voff)[_i]), (PG8_LAS unsigned*)(lds + (bufoff) + ldsw + _i * 8192), 16, 0, 0); } while (0)
#define PG8_LDA(dst, b, h) do { _Pragma("unroll") for (int m = 0; m < 4; ++m) _Pragma("unroll") for (int k = 0; k < 2; ++k) dst[m][k] = *(const PG8_LAS bf16x8*)(lds + PG8_SA(b, h) + aoff + m * 2048 + k * 1024); } while (0)
#define PG8_LDB(dst, b, h) do { _Pragma("unroll") for (int n = 0; n < 2; ++n) _Pragma("unroll") for (int k = 0; k < 2; ++k) dst[n][k] = *(const PG8_LAS bf16x8*)(lds + PG8_SB(b, h) + boff + n * 2048 + k * 1024); } while (0)
#define PG8_MMA(ai, bj, At, Bt) do { __builtin_amdgcn_s_setprio(1); _Pragma("unroll") for (int m = 0; m < 4; ++m) _Pragma("unroll") for (int n = 0; n < 2; ++n) _Pragma("unroll") for (int k = 0; k < 2; ++k) \
        acc[ai][bj][m][n] = __builtin_amdgcn_mfma_f32_16x16x32_bf16(Bt[n][k], At[m][k], acc[ai][bj][m][n], 0, 0, 0); __builtin_amdgcn_s_setprio(0); } while (0)
#define PG8_WAIT_V(n) asm volatile("s_waitcnt vmcnt(" #n ")" ::: "memory")
#define PG8_WAIT_L(n) asm volatile("s_waitcnt lgkmcnt(" #n ")" ::: "memory")
#define PG8_BAR __builtin_amdgcn_s_barrier()
#define PG8_SCHED __builtin_amdgcn_sched_barrier(0)
    Unit cur, nxt; int ui = 0;
    if (!S.next(0, cur)) return;
    f32x4 acc[2][2][4][2];
#pragma unroll
    for (int a = 0; a < 2; ++a)
#pragma unroll
        for (int b = 0; b < 2; ++b)
#pragma unroll
            for (int m = 0; m < 4; ++m)
#pragma unroll
                for (int n = 0; n < 2; ++n) acc[a][b][m][n] = (f32x4){0.f, 0.f, 0.f, 0.f};
    bf16x8 At[4][2], B0[2][2], B1[2][2];
    const char* cA = (const char*)g.A + (size_t)cur.pm * tstep; const char* cB = (const char*)g.Bt + (size_t)cur.pn * tstep;
    S.a_ready(cur);
    if constexpr (SP2) {
        PG8_STAGE(PG8_SB(0, 0), cB, voffB); PG8_STAGE(PG8_SB(0, 1), cB + hstep, voffB); PG8_STAGE(PG8_SA(0, 0), cA, voffA); PG8_STAGE(PG8_SA(0, 1), cA + hstep, voffA);
        if (wr == 1) PG8_BAR;
        PG8_WAIT_V(2); PG8_BAR;
        PG8_STAGE(PG8_SB(1, 0), cB + kstep, voffB); PG8_STAGE(PG8_SA(1, 0), cA + kstep, voffA); PG8_STAGE(PG8_SB(1, 1), cB + hstep + kstep, voffB);
        PG8_WAIT_V(6); PG8_BAR;
    } else {
        PG8_STAGE(PG8_SB(0, 0), cB, voffB); PG8_STAGE(PG8_SA(0, 0), cA, voffA); PG8_STAGE(PG8_SB(0, 1), cB + hstep, voffB); PG8_STAGE(PG8_SA(0, 1), cA + hstep, voffA);
        if (wr == 1) PG8_BAR;
        PG8_WAIT_V(4); PG8_BAR;
        PG8_STAGE(PG8_SB(1, 0), cB + kstep, voffB); PG8_STAGE(PG8_SA(1, 0), cA + kstep, voffA); PG8_STAGE(PG8_SB(1, 1), cB + hstep + kstep, voffB);
        PG8_WAIT_V(6); PG8_BAR;
    }
    for (;;) {
        const bool has_next = S.next(ui + 1, nxt);
        const char* nA = has_next ? (const char*)g.A + (size_t)nxt.pm * tstep : cA; const char* nB = has_next ? (const char*)g.Bt + (size_t)nxt.pn * tstep : cB;
        for (int t = 0; t < nt; t += 2) {
            const bool last = (t == nt - 2);
            const char* a1 = cA + (size_t)(t + 1) * kstep;
            const char* a2 = last ? nA : cA + (size_t)(t + 2) * kstep; const char* b2 = last ? nB : cB + (size_t)(t + 2) * kstep;
            const char* a3 = a2 + kstep; const char* b3 = b2 + kstep;
            if (last && has_next) S.a_ready(nxt);
            if constexpr (SP2) {
            PG8_LDB(B0, 0, 0); PG8_LDB(B1, 0, 1); PG8_SCHED; PG8_LDA(At, 0, 0); PG8_STAGE(PG8_SA(1, 1), a1 + hstep, voffA);
            PG8_WAIT_V(8); PG8_WAIT_L(0); PG8_BAR; PG8_MMA(0, 0, At, B0); PG8_MMA(0, 1, At, B1); PG8_BAR; PG8_SCHED;
            PG8_LDA(At, 0, 1); PG8_STAGE(PG8_SB(0, 0), b2, voffB); PG8_STAGE(PG8_SB(0, 1), b2 + hstep, voffB); PG8_STAGE(PG8_SA(0, 0), a2, voffA);
            PG8_WAIT_V(8); PG8_WAIT_L(0); PG8_BAR; PG8_MMA(1, 0, At, B0); PG8_MMA(1, 1, At, B1); PG8_BAR; PG8_SCHED;
            PG8_LDB(B0, 1, 0); PG8_LDB(B1, 1, 1); PG8_SCHED; PG8_LDA(At, 1, 0); PG8_STAGE(PG8_SA(0, 1), a2 + hstep, voffA);
            PG8_WAIT_V(8); PG8_WAIT_L(0); PG8_BAR; PG8_MMA(0, 0, At, B0); PG8_MMA(0, 1, At, B1); PG8_BAR; PG8_SCHED;
            PG8_LDA(At, 1, 1); PG8_STAGE(PG8_SB(1, 0), b3, voffB); PG8_STAGE(PG8_SB(1, 1), b3 + hstep, voffB); PG8_STAGE(PG8_SA(1, 0), a3, voffA);
            PG8_WAIT_V(8); PG8_WAIT_L(0); PG8_BAR; PG8_MMA(1, 0, At, B0); PG8_MMA(1, 1, At, B1); PG8_BAR; PG8_SCHED;
            } else {
            PG8_LDB(B0, 0, 0); PG8_SCHED; PG8_LDA(At, 0, 0); PG8_STAGE(PG8_SA(1, 1), a1 + hstep, voffA);
            PG8_WAIT_L(8); PG8_BAR; PG8_WAIT_L(0); PG8_MMA(0, 0, At, B0); PG8_BAR; PG8_SCHED;
            PG8_LDB(B1, 0, 1); PG8_STAGE(PG8_SB(0, 0), b2, voffB);
            PG8_BAR; PG8_WAIT_L(0); PG8_MMA(0, 1, At, B1); PG8_BAR;
            PG8_LDA(At, 0, 1); PG8_STAGE(PG8_SA(0, 0), a2, voffA);
            PG8_BAR; PG8_WAIT_L(0); PG8_MMA(1, 0, At, B0); PG8_BAR; PG8_SCHED;
            PG8_STAGE(PG8_SB(0, 1), b2 + hstep, voffB);
            PG8_WAIT_V(6); PG8_BAR; PG8_MMA(1, 1, At, B1); PG8_BAR;
            PG8_LDB(B0, 1, 0); PG8_SCHED; PG8_LDA(At, 1, 0); PG8_STAGE(PG8_SA(0, 1), a2 + hstep, voffA);
            PG8_WAIT_L(8); PG8_BAR; PG8_WAIT_L(0); PG8_MMA(0, 0, At, B0); PG8_BAR; PG8_SCHED;
            PG8_LDB(B1, 1, 1); PG8_STAGE(PG8_SB(1, 0), b3, voffB);
            PG8_BAR; PG8_WAIT_L(0); PG8_MMA(0, 1, At, B1); PG8_BAR;
            PG8_LDA(At, 1, 1); PG8_STAGE(PG8_SA(1, 0), a3, voffA);
            PG8_BAR; PG8_WAIT_L(0); PG8_MMA(1, 0, At, B0); PG8_BAR; PG8_SCHED;
            PG8_STAGE(PG8_SB(1, 1), b3 + hstep, voffB);
            PG8_WAIT_V(6); PG8_BAR; PG8_MMA(1, 1, At, B1); PG8_BAR;
            }
        }
        if constexpr (ALIGN_EPI) { if (wr == 0) PG8_BAR; }
        if constexpr (!Epi::AFTER_DRAIN) { E(acc, cur, wr, wc, fr, fq); S.done(cur); }
        if (!has_next) break;
#pragma unroll
        for (int a = 0; a < 2; ++a)
#pragma unroll
            for (int b = 0; b < 2; ++b)
#pragma unroll
                for (int m = 0; m < 4; ++m)
#pragma unroll
                    for (int n = 0; n < 2; ++n) acc[a][b][m][n] = (f32x4){0.f, 0.f, 0.f, 0.f};
        cur = nxt; cA = nA; cB = nB; ++ui;
        if constexpr (ALIGN_EPI) { if (wr == 1) PG8_BAR; }
    }
    PG8_WAIT_V(0);
    if constexpr (!ALIGN_EPI) { if (wr == 0) PG8_BAR; }
    PG8_BAR;
    if constexpr (Epi::AFTER_DRAIN) { E.fused(acc, cur, wr, wc, fr, fq, lds, wid, lane); S.done(cur); }
#undef PG8_SA
#undef PG8_SB
#undef PG8_STAGE
#undef PG8_LDA
#undef PG8_LDB
#undef PG8_MMA
#undef PG8_WAIT_V
#undef PG8_WAIT_L
#undef PG8_BAR
#undef PG8_SCHED
}
}

constexpr int NWAVES = 8;
constexpr int BATCH = 4, SEQ = 8192, D = 2048, M = BATCH * SEQ, FF = 5632;
constexpr int RC = 1024, RH = 16, RN = 64;
constexpr int HC = 1024, HH = 8, HD = 128;
constexpr int RWKV_COLS = 3360, IN_COLS = 7456, NIN = 7680;
constexpr int KL = 384, NL = 3072;
#ifndef MK_N_LAUNCHES
#define MK_N_LAUNCHES 12
#endif
constexpr int N_PHASES = 12;

constexpr size_t WS_CTL = 0, CTL_BYTES = 1u << 20;
constexpr size_t WS_W1GU = CTL_BYTES;
constexpr size_t WS_W1D = WS_W1GU + (size_t)2 * FF * D * 2;
constexpr size_t WS_WIN = WS_W1D + (size_t)D * FF * 2;
constexpr size_t WS_WLORA = WS_WIN + (size_t)NIN * D * 2;
constexpr size_t WS_WOUT = WS_WLORA + (size_t)NL * KL * 2;
constexpr size_t WS_W2GU = WS_WOUT + (size_t)D * D * 2;
constexpr size_t WS_W2D = WS_W2GU + (size_t)2 * FF * D * 2;
constexpr size_t WS_SS = WS_W2D + (size_t)D * FF * 2;
constexpr size_t WS_XB = WS_SS + (1u << 20);
constexpr size_t WS_R = WS_XB + (size_t)M * D * 2;
constexpr size_t R_ACT = 0;
constexpr size_t R_RKV = 0;
constexpr size_t R_HG = R_RKV + (size_t)M * 3072 * 2;
constexpr size_t R_LIN = R_HG + (size_t)M * 4096 * 2;
constexpr size_t R_X2B = (size_t)M * FF * 2;
constexpr size_t R_BYTES = R_LIN + (size_t)M * 288 * 4;
constexpr size_t WS_ALORA = WS_R + R_BYTES;
constexpr size_t WS_LOUT = WS_ALORA + (size_t)M * KL * 2;
constexpr size_t WS_END = WS_LOUT + (size_t)M * NL * 2;
static_assert(R_X2B + (size_t)M * D * 2 <= R_BYTES && WS_END <= ((size_t)1 << 30), "d_ws map");
constexpr int CW_BAR = 4096;

constexpr int RING_BYTES = 131072;
constexpr int LDSCTL_OFF = RING_BYTES, MISC_OFF = LDSCTL_OFF + 320;
constexpr int LDS_BYTES = 147456;
static_assert(MISC_OFF + 128 <= LDS_BYTES, "LDS map");

#define GAS __attribute__((address_space(1)))
#define LAS __attribute__((address_space(3)))
typedef unsigned short bf16;
typedef unsigned v4u __attribute__((ext_vector_type(4)));
typedef unsigned v2u __attribute__((ext_vector_type(2)));
typedef float f32x4 __attribute__((ext_vector_type(4)));
#define LDS_WAIT() asm volatile("s_waitcnt lgkmcnt(0)" ::: "memory")
#define VM_WAIT() asm volatile("s_waitcnt vmcnt(0)" ::: "memory")
__device__ __forceinline__ float bflo(unsigned u) { return __builtin_bit_cast(float, u << 16); }
__device__ __forceinline__ float bfhi(unsigned u) { return __builtin_bit_cast(float, u & 0xffff0000u); }
__device__ __forceinline__ f32x4 unpack4(v2u w) { return (f32x4){bflo(w.x), bfhi(w.x), bflo(w.y), bfhi(w.y)}; }
__device__ __forceinline__ unsigned pk2(float lo, float hi) { return pg8::cvt_pk_bf16(lo, hi); }
__device__ __forceinline__ v2u pack4(f32x4 v) { v2u w; w.x = pk2(v[0], v[1]); w.y = pk2(v[2], v[3]); return w; }
using pg8::fast_sigmoid;
using pg8::fast_silu;
template <int CTRL> __device__ __forceinline__ float dpp_mov(float x) { return __builtin_bit_cast(float, __builtin_amdgcn_update_dpp(0, __builtin_bit_cast(int, x), CTRL, 0xF, 0xF, true)); }
__device__ __forceinline__ float row16_sum(float x) { x += dpp_mov<0x128>(x); x += dpp_mov<0x124>(x); x += dpp_mov<0x122>(x); x += dpp_mov<0x121>(x); return x; }
__device__ __forceinline__ float wave_sum(float v) {
#pragma unroll
    for (int o = 1; o < 64; o <<= 1) v += __shfl_xor(v, o);
    return v;
}
#define XB_TMO      128
#define XB_XCNT(j)  (256  + 64 * (j))
#define XB_XSUB(j)  (1280 + 64 * (j))
#define XB_XGEN(j)  (2304 + 64 * (j))
#define XB_TOP      3328
#define XB_TOPGEN   3392
#define XCD_BAR_WORDS 3456
#define XB_SPIN_CAP (1u << 18)

__device__ __forceinline__ unsigned xb_ld(unsigned* p)              { return __hip_atomic_load(p, __ATOMIC_RELAXED, __HIP_MEMORY_SCOPE_AGENT); }
__device__ __forceinline__ unsigned xb_add(unsigned* p, unsigned v) { return __hip_atomic_fetch_add(p, v, __ATOMIC_RELAXED, __HIP_MEMORY_SCOPE_AGENT); }
__device__ __forceinline__ unsigned xb_xcc_id() { return (unsigned)__builtin_amdgcn_s_getreg((3 << 11) | 20) & 0xFu; }
#define XB_SPIN(cond, bar) do { unsigned _sp = 0; while (cond) { __builtin_amdgcn_s_sleep(1); \
    if ((++_sp & 255u) == 0u) { if (xb_ld(&(bar)[XB_TMO])) break; if (_sp > XB_SPIN_CAP) { atomicAdd(&(bar)[XB_TMO], 1u); break; } } } } while (0)

struct XcdBarrier {
    unsigned* bar; unsigned x;
    volatile LAS unsigned* st;
};

__device__ __forceinline__ XcdBarrier xcd_barrier_post(unsigned* bar, volatile LAS unsigned* st) {
    XcdBarrier b; b.bar = bar; b.x = xb_xcc_id(); b.st = st;
    if (threadIdx.x == 0) (void)xb_add(&bar[XB_XCNT(b.x)], 1u);
    return b;
}
__device__ __forceinline__ void xcd_barrier_complete(unsigned* bar, unsigned x, unsigned& nloc, unsigned& nx) {
    const unsigned G = gridDim.x * gridDim.y * gridDim.z;
    unsigned sum, cnt, mine, sp = 0u;
    for (;;) {
        sum = 0u; cnt = 0u; mine = 0u;
#pragma unroll
        for (unsigned j = 0; j < 16; ++j) { const unsigned c = xb_ld(&bar[XB_XCNT(j)]); sum += c; cnt += (c > 0u) ? 1u : 0u; mine = (j == x) ? c : mine; }
        if (sum == G) break;
        __builtin_amdgcn_s_sleep(1);
        if ((++sp & 255u) == 0u) { if (xb_ld(&bar[XB_TMO])) break; if (sp > XB_SPIN_CAP) { atomicAdd(&bar[XB_TMO], 1u); break; } }
    }
    nloc = mine > 0u ? mine : 1u; nx = cnt > 0u ? cnt : 1u;
}

__device__ __forceinline__ void xcd_barrier(const XcdBarrier& b) {
    asm volatile("s_waitcnt vmcnt(0)" ::: "memory");
    __syncthreads();
    if (threadIdx.x == 0) {
        unsigned* bar = b.bar;
        __builtin_amdgcn_s_waitcnt(0);
        unsigned nloc = b.st[0], nx = b.st[1];
        if (nloc == 0u) { xcd_barrier_complete(bar, b.x, nloc, nx); b.st[0] = nloc; b.st[1] = nx; }
        const unsigned old = xb_add(&bar[XB_XSUB(b.x)], 1u);
        const unsigned gen = old / nloc;
        if (old + 1u == (gen + 1u) * nloc) {
            __builtin_amdgcn_fence(__ATOMIC_RELEASE, "agent");
            asm volatile("s_waitcnt vmcnt(0)" ::: "memory");
            const unsigned og = xb_add(&bar[XB_TOP], 1u);
            const unsigned tg = og / nx;
            if (og + 1u == (tg + 1u) * nx) xb_add(&bar[XB_TOPGEN], 1u);
            else XB_SPIN(xb_ld(&bar[XB_TOPGEN]) == tg, bar);
            __builtin_amdgcn_fence(__ATOMIC_ACQUIRE, "agent");
            xb_add(&bar[XB_XGEN(b.x)], 1u);
            asm volatile("s_waitcnt vmcnt(0)" ::: "memory");
        } else {
            XB_SPIN(xb_ld(&bar[XB_XGEN(b.x)]) == gen, bar);
            __builtin_amdgcn_fence(__ATOMIC_ACQUIRE, "agent");
            asm volatile("s_waitcnt vmcnt(0)" ::: "memory");
        }
    }
    __syncthreads();
}

struct Frame {
    LAS unsigned char* lds;
    int tid, lane, wave, vcu, G;
    const float* in[26];
    float* out; unsigned char* ws;
};
#define WSP(T, off) ((T*)(F.ws + (off)))
struct Args { const float* in[26]; float* out; unsigned char* ws; int ph_lo, ph_hi; };

__device__ __forceinline__ void p0_transpose_item(const float* W, const float* gain, int K, int N, bf16* WT, int kb, int n0, int drow0, LAS float* scr, int lane) {
    const int k0 = 64 * kb;
#pragma unroll 8
    for (int i = 0; i < 32; ++i) { const int kk = 2 * i + (lane >> 5); const float gsc = gain ? gain[k0 + kk] : 1.0f; scr[kk * 33 + (lane & 31)] = W[(size_t)(k0 + kk) * N + n0 + (lane & 31)] * gsc; }
    LDS_WAIT(); asm volatile("" ::: "memory");
    const int c = lane & 7;
#pragma unroll
    for (int j = 0; j < 4; ++j) { const int n = (lane >> 3) + 8 * j; const LAS float* s = scr + (8 * c) * 33 + n;
        v4u o; o.x = pk2(s[0 * 33], s[1 * 33]); o.y = pk2(s[2 * 33], s[3 * 33]); o.z = pk2(s[4 * 33], s[5 * 33]); o.w = pk2(s[6 * 33], s[7 * 33]);
        *(GAS v4u*)(WT + (size_t)(drow0 + n) * K + k0 + 8 * c) = o; }
    LDS_WAIT(); asm volatile("" ::: "memory");
}
__device__ __forceinline__ int map_gu(int n0, int which) { return (n0 >> 7) * 256 + which * 128 + (n0 & 127); }
__device__ __forceinline__ void p0_prologue(Frame& F, const Args& A) {
    LAS float* scr = (LAS float*)(F.lds + F.wave * 16384);
    const int gw = F.vcu * NWAVES + F.wave, NGW = F.G * NWAVES;
    constexpr int I_GU = (D / 64) * (FF / 32);
    constexpr int I_DN = (FF / 64) * (D / 32);
    constexpr int I_IN = (D / 64) * (IN_COLS / 32);
    constexpr int I_OUT = (D / 64) * (D / 32);
    constexpr int NITEMS = 4 * I_GU + 2 * I_DN + I_IN + I_OUT;
    for (int it = gw; it < NITEMS; it += NGW) {
        int r = it;
        if (r < 4 * I_GU) { const int mat = r / I_GU; r -= mat * I_GU; const int nblk = FF / 32, kb = r / nblk, n0 = 32 * (r % nblk);
            const int ffn = mat >> 1, which = mat & 1;
            p0_transpose_item(A.in[2 + 20 * ffn + which], A.in[1 + 20 * ffn], D, FF, WSP(bf16, ffn ? WS_W2GU : WS_W1GU), kb, n0, map_gu(n0, which), scr, F.lane); continue; }
        r -= 4 * I_GU;
        if (r < 2 * I_DN) { const int ffn = r / I_DN; r -= ffn * I_DN; const int nblk = D / 32, kb = r / nblk, n0 = 32 * (r % nblk);
            p0_transpose_item(A.in[4 + 20 * ffn], nullptr, FF, D, WSP(bf16, ffn ? WS_W2D : WS_W1D), kb, n0, n0, scr, F.lane); continue; }
        r -= 2 * I_DN;
        if (r < I_IN) { const int nblk = IN_COLS / 32, kb = r / nblk, n0 = 32 * (r % nblk);
            p0_transpose_item(F.in[6], F.in[5], D, IN_COLS, WSP(bf16, WS_WIN), kb, n0, n0 < RWKV_COLS ? n0 : n0 + 224, scr, F.lane); continue; }
        r -= I_IN;
        { const int nblk = D / 32, kb = r / nblk, n0 = 32 * (r % nblk);
            p0_transpose_item(F.in[20], nullptr, D, D, WSP(bf16, WS_WOUT), kb, n0, n0, scr, F.lane); }
    }
    const size_t gt = (size_t)F.vcu * (NWAVES * 64) + F.tid, NT = (size_t)F.G * NWAVES * 64;
    { GAS v4u* z = (GAS v4u*)(WSP(bf16, WS_WIN) + (size_t)RWKV_COLS * D);
      for (size_t i = gt; i < (size_t)224 * D * 2 / 16; i += NT) z[i] = (v4u){0u, 0u, 0u, 0u}; }
    { bf16* wl = WSP(bf16, WS_WLORA); const float* w2 = F.in[9]; const float* a2 = F.in[11]; const float* g2 = F.in[12];
      for (size_t i = gt; i < (size_t)NL * KL / 2; i += NT) { const int n = (int)(i / (KL / 2)), k = 2 * (int)(i % (KL / 2)); const int seg = n >> 10, c = n & 1023;
          float v0 = 0.f, v1 = 0.f;
          if (seg == 0) { if (k < 64) { v0 = w2[(size_t)k * RC + c]; v1 = w2[(size_t)(k + 1) * RC + c]; } }
          else if (seg == 1) { if (k >= 64 && k < 128) { v0 = a2[(size_t)(k - 64) * RC + c]; v1 = a2[(size_t)(k - 63) * RC + c]; } }
          else { if (k >= 128 && k < 288) { v0 = g2[(size_t)(k - 128) * RC + c]; v1 = g2[(size_t)(k - 127) * RC + c]; } }
          ((GAS unsigned*)wl)[i] = pk2(v0, v1); } }
    { GAS unsigned long long* s = (GAS unsigned long long*)(F.ws + WS_SS) + M;
      for (size_t i = gt; i < (size_t)2 * M; i += NT) s[i] = 0ull; }
    { const float* x = F.in[0]; bf16* xb = WSP(bf16, WS_XB); unsigned long long* ss0 = WSP(unsigned long long, WS_SS);
      for (int m = gw; m < M; m += NGW) { const GAS f32x4* xr = (const GAS f32x4*)(x + (size_t)m * D) + 2 * F.lane; GAS v4u* o = (GAS v4u*)(xb + (size_t)m * D) + F.lane; float s = 0.f;
#pragma unroll
          for (int j = 0; j < 4; ++j) { const f32x4 a = xr[128 * j], b = xr[128 * j + 1];
              s += (a[0] * a[0] + a[1] * a[1]) + (a[2] * a[2] + a[3] * a[3]) + (b[0] * b[0] + b[1] * b[1]) + (b[2] * b[2] + b[3] * b[3]);
              o[64 * j] = pg8::pack8(a, b); }
          s = wave_sum(s);
          if (F.lane == 0) ss0[m] = (unsigned long long)(s * pg8::SS_SCALE + 0.5f); } }
}

__device__ __forceinline__ void p4_lora_in(Frame& F) {
    const float* lin = WSP(float, WS_R + R_LIN); bf16* al = WSP(bf16, WS_ALORA); const float* mu = F.in[7] + 3 * RC;
    const size_t gt = (size_t)F.vcu * (NWAVES * 64) + F.tid, NT = (size_t)F.G * NWAVES * 64;
    for (size_t i = gt; i < (size_t)M * 96; i += NT) { const int m = (int)(i / 96), q = (int)(i % 96); v2u o = (v2u){0u, 0u};
        if (q < 72) { const f32x4 p = *(const GAS f32x4*)(lin + (size_t)m * 288 + 4 * q); f32x4 pp = (f32x4){0.f, 0.f, 0.f, 0.f};
            if ((m & (SEQ - 1)) != 0) pp = *(const GAS f32x4*)(lin + (size_t)(m - 1) * 288 + 4 * q);
            const f32x4 mv = *(const GAS f32x4*)(mu + 4 * q); f32x4 s = p + (pp - p) * mv;
            if (q < 16) {
#pragma unroll
                for (int j = 0; j < 4; ++j) s[j] = 2.0f * fast_sigmoid(2.0f * s[j]) - 1.0f;
            } else if (q >= 32) {
#pragma unroll
                for (int j = 0; j < 4; ++j) s[j] = fast_sigmoid(s[j]); }
            o = pack4(s); }
        *(GAS v2u*)(al + (size_t)m * KL + 4 * q) = o; }
}

constexpr int TC = 16;
constexpr int RW_W = 0, RW_KK = 4096, RW_B = 8192, RW_KM = 12288, RW_R = 16384, RW_V = 20480, HG_F = 21504, HG_Q = 29696, HG_V = 37888, SCAN_BUF = 38912;
__device__ __forceinline__ void p6_scans(Frame& F) {
    const bf16* rkv = WSP(bf16, WS_R + R_RKV); const bf16* hg = WSP(bf16, WS_R + R_HG); const bf16* lout = WSP(bf16, WS_LOUT); bf16* yc = WSP(bf16, WS_XB);
    const int lane = F.lane, g = lane >> 4, j = lane & 15;
    for (int u = F.vcu; u < 256; u += F.G) {
        if (F.wave < 4) {
            const int bh = u >> 2, b = bh >> 4, h = bh & 15, rq = u & 3, w = F.wave;
            const int tt = F.tid >> 4, jq = F.tid & 15;
            const int ch = h * RN + 4 * jq;
            const f32x4 mu_r = *(const f32x4*)(F.in[7] + ch), mu_k = *(const f32x4*)(F.in[7] + RC + ch);
            const f32x4 kkc = *(const f32x4*)(F.in[13] + ch), kac = *(const f32x4*)(F.in[14] + ch);
            const int vch = h * RN + 16 * rq + 4 * (jq & 3);
            const f32x4 mu_v = *(const f32x4*)(F.in[7] + 2 * RC + vch);
            const size_t rowbase = (size_t)b * SEQ;
            float S0 = 0.f, S1 = 0.f, S2 = 0.f, S3 = 0.f;
            v2u Lr, Lrp, Lk, Lkp, Lw, La, Lv, Lvp;
#define RW_LOAD(t0) do { const int t_ = (t0) + tt; const bf16* p_ = rkv + (rowbase + t_) * 3072; const bf16* q_ = rkv + (rowbase + (t_ > 0 ? t_ - 1 : 0)) * 3072; const bf16* l_ = lout + (rowbase + t_) * 3072; \
                Lr = *(const GAS v2u*)(p_ + ch); Lk = *(const GAS v2u*)(p_ + RC + ch); Lv = *(const GAS v2u*)(p_ + 2 * RC + vch); \
                Lrp = *(const GAS v2u*)(q_ + ch); Lkp = *(const GAS v2u*)(q_ + RC + ch); Lvp = *(const GAS v2u*)(q_ + 2 * RC + vch); \
                Lw = *(const GAS v2u*)(l_ + ch); La = *(const GAS v2u*)(l_ + RC + ch); } while (0)
#define RW_STAGE(t0, bufp) do { const bool first_ = ((t0) + tt) == 0; \
                const f32x4 r_ = unpack4(Lr), k_ = unpack4(Lk), v_ = unpack4(Lv); \
                const f32x4 rp_ = first_ ? (f32x4){0.f, 0.f, 0.f, 0.f} : unpack4(Lrp), kp_ = first_ ? (f32x4){0.f, 0.f, 0.f, 0.f} : unpack4(Lkp), vp_ = first_ ? (f32x4){0.f, 0.f, 0.f, 0.f} : unpack4(Lvp); \
                const f32x4 rs_ = r_ + (rp_ - r_) * mu_r, ks_ = k_ + (kp_ - k_) * mu_k, vs_ = v_ + (vp_ - v_) * mu_v; \
                const f32x4 a_ = unpack4(La), om_ = unpack4(Lw); \
                f32x4 kk_ = ks_ * kkc; float n2_ = (kk_[0] * kk_[0] + kk_[1] * kk_[1]) + (kk_[2] * kk_[2] + kk_[3] * kk_[3]); n2_ = row16_sum(n2_); \
                const float in_ = 1.0f / fmaxf(sqrtf(n2_), 1e-12f); kk_ = kk_ * in_; \
                const f32x4 bb_ = kk_ * a_, km_ = ks_ * (1.0f + (a_ - 1.0f) * kac), dec_ = 1.0f - om_; \
                LAS unsigned char* d_ = (bufp) + tt * 256 + jq * 16; \
                *(LAS f32x4*)(d_ + RW_W) = dec_; *(LAS f32x4*)(d_ + RW_KK) = kk_; *(LAS f32x4*)(d_ + RW_B) = bb_; *(LAS f32x4*)(d_ + RW_KM) = km_; *(LAS f32x4*)(d_ + RW_R) = rs_; \
                if (jq < 4) *(LAS f32x4*)((bufp) + RW_V + tt * 64 + jq * 16) = vs_; } while (0)
            RW_LOAD(0); RW_STAGE(0, F.lds);
            LDS_WAIT(); __builtin_amdgcn_s_barrier(); asm volatile("" ::: "memory");
            for (int c = 0; c < SEQ / TC; ++c) {
                const int t0 = c * TC; LAS unsigned char* cur = F.lds + (c & 1) * SCAN_BUF; LAS unsigned char* nxt = F.lds + ((c + 1) & 1) * SCAN_BUF;
                const bool more = (c + 1) < SEQ / TC;
                if (more) RW_LOAD(t0 + TC);
                float yreg = 0.f;
#pragma unroll
                for (int s = 0; s < TC; ++s) {
                    const LAS unsigned char* p = cur + s * 256 + j * 16;
                    const f32x4 w4 = *(const LAS f32x4*)(p + RW_W), k4 = *(const LAS f32x4*)(p + RW_KK), b4 = *(const LAS f32x4*)(p + RW_B), m4 = *(const LAS f32x4*)(p + RW_KM), r4 = *(const LAS f32x4*)(p + RW_R);
                    const float vv = *(const LAS float*)(cur + RW_V + s * 64 + (4 * w + g) * 4);
                    float pd = (S0 * k4[0] + S1 * k4[1]) + (S2 * k4[2] + S3 * k4[3]);
                    pd = row16_sum(pd); const float sa = -pd;
                    S0 = S0 * w4[0] + (sa * b4[0] + vv * m4[0]); S1 = S1 * w4[1] + (sa * b4[1] + vv * m4[1]);
                    S2 = S2 * w4[2] + (sa * b4[2] + vv * m4[2]); S3 = S3 * w4[3] + (sa * b4[3] + vv * m4[3]);
                    float y = (S0 * r4[0] + S1 * r4[1]) + (S2 * r4[2] + S3 * r4[3]);
                    y = row16_sum(y);
                    yreg = (j == s) ? y : yreg;
                }
                yc[(rowbase + t0 + j) * 2048 + h * RN + 16 * rq + 4 * w + g] = (bf16)(pk2(yreg, 0.f) & 0xffffu);
                if (more) RW_STAGE(t0 + TC, nxt);
                LDS_WAIT(); __builtin_amdgcn_s_barrier(); asm volatile("" ::: "memory");
            }
#undef RW_LOAD
#undef RW_STAGE
        } else {
            const int bh = u >> 3, b = bh >> 3, h = bh & 7, cq = u & 7, w = F.wave - 4;
            const int t2 = F.tid - 256, tt = t2 >> 4, jq = t2 & 15;
            const int ch = h * HD + 8 * jq, vch = h * HD + 16 * cq + 8 * (jq & 1);
            const size_t rowbase = (size_t)b * SEQ;
            float S[8];
#pragma unroll
            for (int i = 0; i < 8; ++i) S[i] = 0.f;
            v4u Lq, Lf, Lv;
#define HG_LOAD(t0) do { const bf16* p_ = hg + (rowbase + (t0) + tt) * 4096; Lq = *(const GAS v4u*)(p_ + ch); Lf = *(const GAS v4u*)(p_ + HC + ch); Lv = *(const GAS v4u*)(p_ + 2 * HC + vch); } while (0)
#define HG_STAGE(bufp) do { LAS unsigned char* d_ = (bufp) + tt * 512 + jq * 32; \
                *(LAS f32x4*)(d_ + HG_Q) = (f32x4){bflo(Lq.x), bfhi(Lq.x), bflo(Lq.y), bfhi(Lq.y)}; *(LAS f32x4*)(d_ + HG_Q + 16) = (f32x4){bflo(Lq.z), bfhi(Lq.z), bflo(Lq.w), bfhi(Lq.w)}; \
                *(LAS f32x4*)(d_ + HG_F) = (f32x4){bflo(Lf.x), bfhi(Lf.x), bflo(Lf.y), bfhi(Lf.y)}; *(LAS f32x4*)(d_ + HG_F + 16) = (f32x4){bflo(Lf.z), bfhi(Lf.z), bflo(Lf.w), bfhi(Lf.w)}; \
                if (jq < 2) { LAS unsigned char* e_ = (bufp) + HG_V + tt * 64 + jq * 32; \
                    *(LAS f32x4*)(e_) = (f32x4){bflo(Lv.x), bfhi(Lv.x), bflo(Lv.y), bfhi(Lv.y)}; *(LAS f32x4*)(e_ + 16) = (f32x4){bflo(Lv.z), bfhi(Lv.z), bflo(Lv.w), bfhi(Lv.w)}; } } while (0)
            HG_LOAD(0); HG_STAGE(F.lds);
            LDS_WAIT(); __builtin_amdgcn_s_barrier(); asm volatile("" ::: "memory");
            for (int c = 0; c < SEQ / TC; ++c) {
                const int t0 = c * TC; LAS unsigned char* cur = F.lds + (c & 1) * SCAN_BUF; LAS unsigned char* nxt = F.lds + ((c + 1) & 1) * SCAN_BUF;
                const bool more = (c + 1) < SEQ / TC;
                if (more) HG_LOAD(t0 + TC);
                float oreg = 0.f;
#pragma unroll
                for (int s = 0; s < TC; ++s) {
                    const LAS unsigned char* p = cur + s * 512 + j * 16;
                    const f32x4 f0 = *(const LAS f32x4*)(p + HG_F), f1 = *(const LAS f32x4*)(p + HG_F + 256), q0 = *(const LAS f32x4*)(p + HG_Q), q1 = *(const LAS f32x4*)(p + HG_Q + 256);
                    const float vv = *(const LAS float*)(cur + HG_V + s * 64 + (4 * w + g) * 4);
                    float o = 0.f;
#pragma unroll
                    for (int i = 0; i < 4; ++i) { S[i] = S[i] - f0[i] * (S[i] - vv); S[4 + i] = S[4 + i] - f1[i] * (S[4 + i] - vv); }
                    o = ((S[0] * q0[0] + S[1] * q0[1]) + (S[2] * q0[2] + S[3] * q0[3])) + ((S[4] * q1[0] + S[5] * q1[1]) + (S[6] * q1[2] + S[7] * q1[3]));
                    o = row16_sum(o);
                    oreg = (j == s) ? o : oreg;
                }
                yc[(rowbase + t0 + j) * 2048 + RC + h * HD + 16 * cq + 4 * w + g] = (bf16)(pk2(oreg, 0.f) & 0xffffu);
                if (more) HG_STAGE(nxt);
                LDS_WAIT(); __builtin_amdgcn_s_barrier(); asm volatile("" ::: "memory");
            }
#undef HG_LOAD
#undef HG_STAGE
        }
    }
}

__device__ __forceinline__ void p7_post(Frame& F) {
    const bf16* rkv = WSP(bf16, WS_R + R_RKV); const bf16* hg = WSP(bf16, WS_R + R_HG); const bf16* lout = WSP(bf16, WS_LOUT); bf16* yc = WSP(bf16, WS_XB);
    { const int half = F.tid >> 8, ch = (F.tid & 255) * 4;
      const f32x4 mu_r = *(const f32x4*)(F.in[7] + ch), mu_k = *(const f32x4*)(F.in[7] + RC + ch), mu_v = *(const f32x4*)(F.in[7] + 2 * RC + ch);
      const f32x4 kac = *(const f32x4*)(F.in[14] + ch), rkc = *(const f32x4*)(F.in[15] + ch), lnw = *(const f32x4*)(F.in[16] + ch), lnb = *(const f32x4*)(F.in[17] + ch);
      for (int m = F.vcu * 2 + half; m < M; m += 2 * F.G) {
          const bool first = (m & (SEQ - 1)) == 0; const size_t mp = first ? m : m - 1;
          const bf16* p = rkv + (size_t)m * 3072 + ch; const bf16* q = rkv + mp * 3072 + ch; const bf16* l = lout + (size_t)m * 3072 + ch;
          const f32x4 y = unpack4(*(const GAS v2u*)(yc + (size_t)m * 2048 + ch));
          const f32x4 r = unpack4(*(const GAS v2u*)(p)), k = unpack4(*(const GAS v2u*)(p + RC)), v = unpack4(*(const GAS v2u*)(p + 2 * RC));
          f32x4 rp = unpack4(*(const GAS v2u*)(q)), kp = unpack4(*(const GAS v2u*)(q + RC)), vp = unpack4(*(const GAS v2u*)(q + 2 * RC));
          if (first) { rp = (f32x4){0.f, 0.f, 0.f, 0.f}; kp = rp; vp = rp; }
          const f32x4 a = unpack4(*(const GAS v2u*)(l + RC)), gg = unpack4(*(const GAS v2u*)(l + 2 * RC));
          const f32x4 rs = r + (rp - r) * mu_r, ks = k + (kp - k) * mu_k, vs = v + (vp - v) * mu_v;
          const f32x4 km = ks * (1.0f + (a - 1.0f) * kac);
          const f32x4 bt = rs * km * rkc; float bon = (bt[0] + bt[1]) + (bt[2] + bt[3]); bon = row16_sum(bon);
          float s1 = (y[0] + y[1]) + (y[2] + y[3]); s1 = row16_sum(s1); const float mean = s1 * (1.0f / 64.0f);
          const f32x4 d = y - mean; float s2 = (d[0] * d[0] + d[1] * d[1]) + (d[2] * d[2] + d[3] * d[3]); s2 = row16_sum(s2);
          const float rstd = 1.0f / sqrtf(s2 * (1.0f / 64.0f) + 64e-5f);
          const f32x4 o = ((d * rstd) * lnw + lnb + vs * bon) * gg;
          *(GAS v2u*)(yc + (size_t)m * 2048 + ch) = pack4(o); } }
    { const int quarter = F.tid >> 7, ch = (F.tid & 127) * 8;
      const f32x4 nw0 = *(const f32x4*)(F.in[19] + ch), nw1 = *(const f32x4*)(F.in[19] + ch + 4);
      for (int m = F.vcu * 4 + quarter; m < M; m += 4 * F.G) {
          const v4u ow = *(const GAS v4u*)(yc + (size_t)m * 2048 + RC + ch), gw4 = *(const GAS v4u*)(hg + (size_t)m * 4096 + 3 * HC + ch);
          const f32x4 o0 = (f32x4){bflo(ow.x), bfhi(ow.x), bflo(ow.y), bfhi(ow.y)}, o1 = (f32x4){bflo(ow.z), bfhi(ow.z), bflo(ow.w), bfhi(ow.w)};
          const f32x4 g0 = (f32x4){bflo(gw4.x), bfhi(gw4.x), bflo(gw4.y), bfhi(gw4.y)}, g1 = (f32x4){bflo(gw4.z), bfhi(gw4.z), bflo(gw4.w), bfhi(gw4.w)};
          float s2 = ((o0[0] * o0[0] + o0[1] * o0[1]) + (o0[2] * o0[2] + o0[3] * o0[3])) + ((o1[0] * o1[0] + o1[1] * o1[1]) + (o1[2] * o1[2] + o1[3] * o1[3])); s2 = row16_sum(s2);
          const float rstd = 1.0f / sqrtf(s2 * (1.0f / 128.0f) + 1e-6f);
          *(GAS v4u*)(yc + (size_t)m * 2048 + RC + ch) = pg8::pack8(o0 * rstd * nw0 * g0, o1 * rstd * nw1 * g1); } }
}

__device__ __forceinline__ void p11_final(Frame& F) {
    const int gw = F.vcu * NWAVES + F.wave, NGW = F.G * NWAVES; const float* fg = F.in[25];
    f32x4 gn[8];
#pragma unroll
    for (int i = 0; i < 8; ++i) gn[i] = *(const f32x4*)(fg + 4 * F.lane + 256 * i);
    for (int m = gw; m < M; m += NGW) { GAS f32x4* xr = (GAS f32x4*)(F.out + (size_t)m * D) + F.lane; f32x4 v[8]; float s = 0.f;
#pragma unroll
        for (int i = 0; i < 8; ++i) { v[i] = xr[64 * i]; s += (v[i][0] * v[i][0] + v[i][1] * v[i][1]) + (v[i][2] * v[i][2] + v[i][3] * v[i][3]); }
        s = wave_sum(s); const float inv = 1.0f / sqrtf(s * (1.0f / D) + 1e-6f);
#pragma unroll
        for (int i = 0; i < 8; ++i) xr[64 * i] = v[i] * inv * gn[i]; }
}

__global__ void __launch_bounds__(NWAVES * 64, 2) mk_fwd(Args args) {
    extern __shared__ __attribute__((aligned(16))) unsigned char lds[];
    Frame F;
    F.lds = (LAS unsigned char*)lds;
    F.tid = threadIdx.x; F.lane = F.tid & 63; F.wave = __builtin_amdgcn_readfirstlane(F.tid >> 6);
    F.G = gridDim.x; { const int bx = blockIdx.x; F.vcu = (F.G % 8 == 0) ? (bx % 8) * (F.G / 8) + bx / 8 : bx; }
#pragma unroll
    for (int i = 0; i < 26; ++i) F.in[i] = args.in[i];
    F.out = args.out; F.ws = args.ws;
    for (int u = F.tid; u < (LDS_BYTES - LDSCTL_OFF) / 4; u += NWAVES * 64) ((LAS unsigned*)(F.lds + LDSCTL_OFF))[u] = 0u;
    __syncthreads();
    const int lo = args.ph_lo, hi = args.ph_hi;
    XcdBarrier bar; bar.bar = (unsigned*)(args.ws + WS_CTL) + CW_BAR; bar.x = 0; bar.st = nullptr;
    if (hi - lo > 1) bar = xcd_barrier_post((unsigned*)(args.ws + WS_CTL) + CW_BAR, (volatile LAS unsigned*)(F.lds + MISC_OFF) + 8);
#ifndef PH_MASK
#define PH_MASK 0xFFF
#endif
#define IN(k) (((PH_MASK >> (k)) & 1) && lo <= (k) && (k) < hi)
#define SEAM(k) do { if (IN(k) && IN((k) + 1)) xcd_barrier(bar); } while (0)
    const bf16* xb = WSP(bf16, WS_XB); unsigned long long* ss = WSP(unsigned long long, WS_SS);
    const int cid = (int)blockIdx.x;

    if (IN(0)) { p0_prologue(F, args); } SEAM(0);
    if (IN(1)) {
        pg8::Gemm g{xb, WSP(bf16, WS_W1GU), M, 2 * FF, D}; pg8::StaticOrder S; S.init(M, 2 * FF, F.G, cid);
        pg8::EpiSwiglu E{WSP(bf16, WS_R + R_ACT), FF, ss};
        pg8::gemm_phase<pg8::EpiSwiglu, pg8::StaticOrder, true, true>(F.lds, g, S, E);
    } SEAM(1);
    if (IN(2)) {
        pg8::Gemm g{WSP(bf16, WS_R + R_ACT), WSP(bf16, WS_W1D), M, D, FF}; pg8::StaticOrder S; S.init(M, D, F.G, cid);
        pg8::EpiResid E{F.in[0], F.out, WSP(bf16, WS_XB), ss + M, 0.5f};
        pg8::gemm_phase<pg8::EpiResid, pg8::StaticOrder, true, true>(F.lds, g, S, E);
    } SEAM(2);
    if (IN(3)) {
        pg8::Gemm g{xb, WSP(bf16, WS_WIN), M, NIN, D}; pg8::StaticOrder S; S.init(M, NIN, F.G, cid);
        pg8::EpiInProj E{WSP(bf16, WS_R + R_RKV), WSP(float, WS_R + R_LIN), WSP(bf16, WS_R + R_HG), ss + M, F.in[18]};
        pg8::gemm_phase<pg8::EpiInProj, pg8::StaticOrder, true, true>(F.lds, g, S, E);
    } SEAM(3);
    if (IN(4)) { p4_lora_in(F); } SEAM(4);
    if (IN(5)) {
        int kl = KL; asm volatile("" : "+s"(kl));
        pg8::Gemm g{WSP(bf16, WS_ALORA), WSP(bf16, WS_WLORA), M, NL, kl}; pg8::StaticOrder S; S.init(M, NL, F.G, cid);
        pg8::EpiLora E{WSP(bf16, WS_LOUT), F.in[8], F.in[10]};
        pg8::gemm_phase<pg8::EpiLora, pg8::StaticOrder, true, true>(F.lds, g, S, E);
    } SEAM(5);
    if (IN(6)) { p6_scans(F); } SEAM(6);
    if (IN(7)) { p7_post(F); } SEAM(7);
    if (IN(8)) {
        pg8::Gemm g{xb, WSP(bf16, WS_WOUT), M, D, D}; pg8::StaticOrder S; S.init(M, D, F.G, cid);
        pg8::EpiResid E{F.out, F.out, WSP(bf16, WS_R + R_X2B), ss + 2 * M, 1.0f};
        pg8::gemm_phase<pg8::EpiResid, pg8::StaticOrder, true, true>(F.lds, g, S, E);
    } SEAM(8);
    if (IN(9)) {
        pg8::Gemm g{WSP(bf16, WS_R + R_X2B), WSP(bf16, WS_W2GU), M, 2 * FF, D}; pg8::StaticOrder S; S.init(M, 2 * FF, F.G, cid);
        pg8::EpiSwiglu E{WSP(bf16, WS_R + R_ACT), FF, ss + 2 * M};
        pg8::gemm_phase<pg8::EpiSwiglu, pg8::StaticOrder, true, true>(F.lds, g, S, E);
    } SEAM(9);
    if (IN(10)) {
        pg8::Gemm g{WSP(bf16, WS_R + R_ACT), WSP(bf16, WS_W2D), M, D, FF}; pg8::StaticOrder S; S.init(M, D, F.G, cid);
        pg8::EpiResid E{F.out, F.out, nullptr, nullptr, 0.5f};
        pg8::gemm_phase<pg8::EpiResid, pg8::StaticOrder, true, true>(F.lds, g, S, E);
    } SEAM(10);
    if (IN(11)) { p11_final(F); }
#undef IN
#undef SEAM
}

extern "C" void kernel_launch(void* const* d_in, const int* in_sizes, int n_in, void* d_out, int out_size, void* d_ws, size_t ws_size, hipStream_t stream) {
    static int grid = 0;
    if (grid == 0) {
        if (n_in != 26 || in_sizes[0] != M * D || out_size != M * D || ws_size < WS_END) { fprintf(stderr, "kernel_launch: unexpected problem (n_in %d, ws %zu < %zu)\n", n_in, ws_size, (size_t)WS_END); grid = -1; return; }
        int dev = 0, cus = 0, per_cu = 0;
        if (hipGetDevice(&dev) != hipSuccess || hipDeviceGetAttribute(&cus, hipDeviceAttributeMultiprocessorCount, dev) != hipSuccess) { grid = -1; return; }
        if (hipFuncSetAttribute((const void*)mk_fwd, hipFuncAttributeMaxDynamicSharedMemorySize, LDS_BYTES) != hipSuccess) { grid = -1; return; }
        if (hipOccupancyMaxActiveBlocksPerMultiprocessor(&per_cu, (const void*)mk_fwd, NWAVES * 64, LDS_BYTES) != hipSuccess || per_cu < 1) fprintf(stderr, "kernel_launch: occupancy query reports %d\n", per_cu);
        (void)hipGetLastError();
        grid = cus;
    }
    if (grid < 0) return;
    (void)hipMemsetAsync((char*)d_ws + WS_CTL, 0, CTL_BYTES, stream);
    Args a{};
    for (int i = 0; i < 26; ++i) a.in[i] = (const float*)d_in[i];
    a.out = (float*)d_out; a.ws = (unsigned char*)d_ws;
    constexpr int NL_ = MK_N_LAUNCHES;
    for (int li = 0; li < NL_; ++li) {
        a.ph_lo = (NL_ == 1) ? 0 : li; a.ph_hi = (NL_ == 1) ? N_PHASES : li + 1;
        hipLaunchKernelGGL(mk_fwd, dim3(grid), dim3(NWAVES * 64), LDS_BYTES, stream, a);
    }
}
```

```cpp
#include <hip/hip_runtime.h>
#include <cstdio>
#include <cstdint>
namespace pg8 {
#define PG8_LAS __attribute__((address_space(3)))
typedef unsigned short bf16_t;
typedef short bf16x8 __attribute__((ext_vector_type(8)));
typedef float f32x4 __attribute__((ext_vector_type(4)));
typedef unsigned u32x4 __attribute__((ext_vector_type(4)));
constexpr int BM = 256, BK = 64, HALF = 128, HTB = HALF * BK * 2  , STAGE_BYTES = 8 * HTB, NXCD = 8, WGM = 8;

__host__ __device__ __forceinline__ int lds_byte(int r, int c) { const int st = (r >> 4) * 2 + (c >> 5), rr = r & 15, cc = c & 31, ob = rr * 64 + cc * 2; return st * 1024 + (ob ^ (((ob >> 9) & 1) << 5)); }
__host__ __device__ __forceinline__ void stage_rc(int b, int& R, int& C) { const int st = b / 1024, sb = b % 1024, swz = sb ^ (((sb >> 9) & 1) << 5); R = (st >> 1) * 16 + swz / 64; C = (st & 1) * 32 + (swz % 64) / 2; }
__host__ __device__ __forceinline__ int perm32(int rho) { const int n = rho >> 4, i = rho & 15; return 8 * (i >> 2) + 4 * n + (i & 3); }

struct Unit { int pm, pn; };
struct Gemm { const bf16_t* A; const bf16_t* Bt; int M, N, K; };

struct StaticOrder {
    int nM, nN, nwg, G, c;
    __host__ __device__ void init(int M, int N, int G_, int c_) { nM = M / BM; nN = N / BM; nwg = nM * nN; G = G_; c = c_; }
    __host__ __device__ bool next(int i, Unit& u) const {
        const long L = (long)i * G + c; if (L >= nwg) return false;
        int wgid = (int)L; { const int q = nwg / NXCD, r = nwg % NXCD, xcd = wgid % NXCD, off = wgid / NXCD; wgid = (xcd < r ? xcd * (q + 1) : r * (q + 1) + (xcd - r) * q) + off; }
        const int nig = WGM * nN, gid = wgid / nig, fm = gid * WGM, gsz = (nM - fm) < WGM ? (nM - fm) : WGM;
        u.pm = fm + ((wgid % nig) % gsz); u.pn = (wgid % nig) / gsz; return true;
    }
    __device__ __forceinline__ void a_ready(const Unit&) const {}
    __device__ __forceinline__ void done(const Unit&) const {}
};


__device__ __forceinline__ unsigned cvt_pk_bf16(float lo, float hi) { unsigned r; asm volatile("v_cvt_pk_bf16_f32 %0, %1, %2" : "=v"(r) : "v"(lo), "v"(hi)); return r; }
__device__ __forceinline__ float fast_sigmoid(float z) { return __builtin_amdgcn_rcpf(1.0f + __builtin_amdgcn_exp2f(-1.44269504f * z)); }
__device__ __forceinline__ float fast_silu(float z) { return z * fast_sigmoid(z); }
constexpr float SS_SCALE = 16777216.0f;
__device__ __forceinline__ float inv_rms_from_val(unsigned long long v) {
    const float tot = (float)v * (1.0f / SS_SCALE);
    return 1.0f / sqrtf(tot * (1.0f / 2048.0f) + 1e-6f);
}
__device__ __forceinline__ u32x4 pack8(const f32x4 v0, const f32x4 v1) { u32x4 w; w.x = cvt_pk_bf16(v0[0], v0[1]); w.y = cvt_pk_bf16(v0[2], v0[3]); w.z = cvt_pk_bf16(v1[0], v1[1]); w.w = cvt_pk_bf16(v1[2], v1[3]); return w; }

struct EpiSwiglu {
    static constexpr bool PERM = true, AFTER_DRAIN = false;
    bf16_t* O; int ldc; const unsigned long long* ss;
    __device__ __forceinline__ void operator()(const f32x4 (&acc)[2][2][4][2], const Unit& u, int wr, int wc, int fr, int fq) const {
        const int row0 = u.pm * BM + wr * 64 + fr, col0 = u.pn * HALF + wc * 32 + 8 * fq;
        unsigned long long sv[2][4];
#pragma unroll
        for (int ai = 0; ai < 2; ++ai)
#pragma unroll
            for (int m = 0; m < 4; ++m) sv[ai][m] = ss[row0 + ai * HALF + m * 16];
#pragma unroll
        for (int ai = 0; ai < 2; ++ai)
#pragma unroll
            for (int m = 0; m < 4; ++m) { const int row = row0 + ai * HALF + m * 16; const float inv = inv_rms_from_val(sv[ai][m]);
                f32x4 o[2];
#pragma unroll
                for (int n = 0; n < 2; ++n) { const f32x4 g = acc[ai][0][m][n] * inv, up = acc[ai][1][m][n] * inv;
#pragma unroll
                    for (int j = 0; j < 4; ++j) o[n][j] = fast_silu(g[j]) * up[j]; }
                *(u32x4*)(O + (size_t)row * ldc + col0) = pack8(o[0], o[1]); }
    }
};
struct EpiResid {
    static constexpr bool PERM = true, AFTER_DRAIN = false;
    const float* resid; float* out; bf16_t* ob; unsigned long long* ss; float alpha;
    __device__ __forceinline__ void operator()(const f32x4 (&acc)[2][2][4][2], const Unit& u, int wr, int wc, int fr, int fq) const {
        const int row0 = u.pm * BM + wr * 64 + fr, col0 = u.pn * BM + wc * 32 + 8 * fq;
#pragma unroll
        for (int ai = 0; ai < 2; ++ai)
#pragma unroll
            for (int m = 0; m < 4; ++m) { const int row = row0 + ai * HALF + m * 16; const size_t off = (size_t)row * 2048 + col0; float s = 0.f;
#pragma unroll
                for (int bj = 0; bj < 2; ++bj) {
                    const f32x4 r0 = *(const f32x4*)(resid + off + bj * HALF), r1 = *(const f32x4*)(resid + off + bj * HALF + 4);
                    const f32x4 o0 = r0 + acc[ai][bj][m][0] * alpha, o1 = r1 + acc[ai][bj][m][1] * alpha;
                    *(f32x4*)(out + off + bj * HALF) = o0; *(f32x4*)(out + off + bj * HALF + 4) = o1;
                    if (ob) *(u32x4*)(ob + off + bj * HALF) = pack8(o0, o1);
                    s += (o0[0] * o0[0] + o0[1] * o0[1]) + (o0[2] * o0[2] + o0[3] * o0[3]) + (o1[0] * o1[0] + o1[1] * o1[1]) + (o1[2] * o1[2] + o1[3] * o1[3]); }
                if (ss) { s += __shfl_xor(s, 16); s += __shfl_xor(s, 32);
                    if (fq == 0) atomicAdd(ss + row, (unsigned long long)(s * SS_SCALE + 0.5f)); } }
    }
};
struct EpiInProj {
    static constexpr bool PERM = true, AFTER_DRAIN = false;
    bf16_t* rkv; float* lin; bf16_t* hg; const unsigned long long* ss; const float* lbl;
    __device__ __forceinline__ void operator()(const f32x4 (&acc)[2][2][4][2], const Unit& u, int wr, int wc, int fr, int fq) const {
        const int row0 = u.pm * BM + wr * 64 + fr, cin = wc * 32 + 8 * fq;
        const int pn = u.pn;
        float invs[2][4];
        { unsigned long long sv[2][4];
#pragma unroll
          for (int ai = 0; ai < 2; ++ai)
#pragma unroll
              for (int m = 0; m < 4; ++m) sv[ai][m] = ss[row0 + ai * HALF + m * 16];
#pragma unroll
          for (int ai = 0; ai < 2; ++ai)
#pragma unroll
              for (int m = 0; m < 4; ++m) invs[ai][m] = inv_rms_from_val(sv[ai][m]); }
        int mode;
        if (pn < 12) mode = 0; else if (pn < 14) mode = 1; else { const int sg = (pn - 14) >> 2; mode = (sg == 0 || sg == 3) ? 2 : (sg == 1 ? 3 : 4); }
#pragma unroll
        for (int bj = 0; bj < 2; ++bj) {
            f32x4 om0 = (f32x4){0.f, 0.f, 0.f, 0.f}, om1 = om0;
            if (mode == 3) { const float* lp = lbl + (pn - 18) * BM + bj * HALF + cin; const f32x4 a0 = *(const f32x4*)lp, a1 = *(const f32x4*)(lp + 4), c0 = *(const f32x4*)(lp + 1024), c1 = *(const f32x4*)(lp + 1028);
#pragma unroll
                for (int j = 0; j < 4; ++j) { om0[j] = 1.0f - fast_sigmoid(a0[j] - c0[j]); om1[j] = 1.0f - fast_sigmoid(a1[j] - c1[j]); } }
#pragma unroll
            for (int ai = 0; ai < 2; ++ai)
#pragma unroll
                for (int m = 0; m < 4; ++m) { const int row = row0 + ai * HALF + m * 16; const float inv = invs[ai][m];
                    f32x4 v0 = acc[ai][bj][m][0] * inv, v1 = acc[ai][bj][m][1] * inv;
                    if (mode == 0) { *(u32x4*)(rkv + (size_t)row * 3072 + pn * BM + bj * HALF + cin) = pack8(v0, v1); }
                    else if (mode == 1) { const int cl = (pn - 12) * BM + bj * HALF + cin;
                        if (cl < 288) { *(f32x4*)(lin + (size_t)row * 288 + cl) = v0; *(f32x4*)(lin + (size_t)row * 288 + cl + 4) = v1; } }
                    else {
                        if (mode == 2) {
#pragma unroll
                            for (int j = 0; j < 4; ++j) { v0[j] = fast_silu(v0[j]); v1[j] = fast_silu(v1[j]); } }
                        else if (mode == 3) {
#pragma unroll
                            for (int j = 0; j < 4; ++j) { v0[j] = om0[j] * fast_sigmoid(-v0[j]); v1[j] = om1[j] * fast_sigmoid(-v1[j]); } }
                        *(u32x4*)(hg + (size_t)row * 4096 + (pn - 14) * BM + bj * HALF + cin) = pack8(v0, v1); } } }
    }
};
struct EpiLora {
    static constexpr bool PERM = true, AFTER_DRAIN = false;
    bf16_t* lout; const float* w0; const float* a0;
    __device__ __forceinline__ void operator()(const f32x4 (&acc)[2][2][4][2], const Unit& u, int wr, int wc, int fr, int fq) const {
        const int row0 = u.pm * BM + wr * 64 + fr, cin = wc * 32 + 8 * fq;
        const int pn = u.pn, mode = pn >> 2;
#pragma unroll
        for (int bj = 0; bj < 2; ++bj) {
            f32x4 b0 = (f32x4){0.f, 0.f, 0.f, 0.f}, b1 = b0;
            if (mode < 2) { const float* bp = (mode == 0 ? w0 : a0) + (pn & 3) * BM + bj * HALF + cin; b0 = *(const f32x4*)bp; b1 = *(const f32x4*)(bp + 4); }
#pragma unroll
            for (int ai = 0; ai < 2; ++ai)
#pragma unroll
                for (int m = 0; m < 4; ++m) { const int row = row0 + ai * HALF + m * 16;
                    f32x4 v0 = acc[ai][bj][m][0] + b0, v1 = acc[ai][bj][m][1] + b1;
#pragma unroll
                    for (int j = 0; j < 4; ++j) { const float s0 = fast_sigmoid(v0[j]), s1 = fast_sigmoid(v1[j]);
                        const float d0 = 1.0f - __builtin_amdgcn_exp2f(-0.87504572f * s0), d1 = 1.0f - __builtin_amdgcn_exp2f(-0.87504572f * s1);
                        v0[j] = mode == 0 ? d0 : (mode == 1 ? s0 : v0[j]); v1[j] = mode == 0 ? d1 : (mode == 1 ? s1 : v1[j]); }
                    *(u32x4*)(lout + (size_t)row * 3072 + pn * BM + bj * HALF + cin) = pack8(v0, v1); asm volatile("" ::: "memory"); } }
    }
};
template <class Epi, class Sched, bool ALIGN_EPI = false, bool SP2 = false>
__device__ __forceinline__ void gemm_phase(PG8_LAS unsigned char* lds, const Gemm g, const Sched& S, const Epi& E) {
    const int tid = threadIdx.x, wid = __builtin_amdgcn_readfirstlane(tid >> 6), lane = tid & 63, wr = wid >> 2, wc = wid & 3, fr = lane & 15, fq = lane >> 4;
    const int K = g.K, nt = K / BK;
    unsigned voffA[2], voffB[2];
#pragma unroll
    for (int i = 0; i < 2; ++i) { int R, C; stage_rc(tid * 16 + i * 8192, R, C); const int Rb = Epi::PERM ? ((R & ~31) + perm32(R & 31)) : R;
        voffA[i] = (unsigned)(R * K + C) * 2u; voffB[i] = (unsigned)(Rb * K + C) * 2u; }
    const size_t kstep = (size_t)(BK * 2);
    const size_t hstep = (size_t)HALF * K * 2;
    const size_t tstep = 2 * hstep;
    const unsigned ldsw = (unsigned)wid * 1024u;
    const int aoff = lds_byte(wr * 64 + fr, fq * 8), boff = lds_byte(wc * 32 + fr, fq * 8);
#define PG8_SA(b, h) (((b) * 2 + (h)) * HTB)
#define PG8_SB(b, h) ((4 + (b) * 2 + (h)) * HTB)
#define PG8_STAGE(bufoff, gbase, voff) do { _Pragma("unroll") for (int _i = 0; _i < 2; ++_i) \
        __builtin_amdgcn_global_load_lds((const unsigned*)((const char*)(gbase) + (voff)[_i]), (PG8_LAS unsigned*)(lds + (bufoff) + ldsw + _i * 8192), 16, 0, 0); } while (0)
#define PG8_LDA(dst, b, h) do { _Pragma("unroll") for (int m = 0; m < 4; ++m) _Pragma("unroll") for (int k = 0; k < 2; ++k) dst[m][k] = *(const PG8_LAS bf16x8*)(lds + PG8_SA(b, h) + aoff + m * 2048 + k * 1024); } while (0)
#define PG8_LDB(dst, b, h) do { _Pragma("unroll") for (int n = 0; n < 2; ++n) _Pragma("unroll") for (int k = 0; k < 2; ++k) dst[n][k] = *(const PG8_LAS bf16x8*)(lds + PG8_SB(b, h) + boff + n * 2048 + k * 1024); } while (0)
#define PG8_MMA(ai, bj, At, Bt) do { __builtin_amdgcn_s_setprio(1); _Pragma("unroll") for (int m = 0; m < 4; ++m) _Pragma("unroll") for (int n = 0; n < 2; ++n) _Pragma("unroll") for (int k = 0; k < 2; ++k) \
        acc[ai][bj][m][n] = __builtin_amdgcn_mfma_f32_16x16x32_bf16(Bt[n][k], At[m][k], acc[ai][bj][m][n], 0, 0, 0); __builtin_amdgcn_s_setprio(0); } while (0)
#define PG8_WAIT_V(n) asm volatile("s_waitcnt vmcnt(" #n ")" ::: "memory")
#define PG8_WAIT_L(n) asm volatile("s_waitcnt lgkmcnt(" #n ")" ::: "memory")
#define PG8_BAR __builtin_amdgcn_s_barrier()
#define PG8_SCHED __builtin_amdgcn_sched_barrier(0)
    Unit cur, nxt; int ui = 0;
    if (!S.next(0, cur)) return;
    f32x4 acc[2][2][4][2];
#pragma unroll
    for (int a = 0; a < 2; ++a)
#pragma unroll
        for (int b = 0; b < 2; ++b)
#pragma unroll
            for (int m = 0; m < 4; ++m)
#pragma unroll
                for (int n = 0; n < 2; ++n) acc[a][b][m][n] = (f32x4){0.f, 0.f, 0.f, 0.f};
    bf16x8 At[4][2], B0[2][2], B1[2][2];
    const char* cA = (const char*)g.A + (size_t)cur.pm * tstep; const char* cB = (const char*)g.Bt + (size_t)cur.pn * tstep;
    S.a_ready(cur);
    if constexpr (SP2) {
        PG8_STAGE(PG8_SB(0, 0), cB, voffB); PG8_STAGE(PG8_SB(0, 1), cB + hstep, voffB); PG8_STAGE(PG8_SA(0, 0), cA, voffA); PG8_STAGE(PG8_SA(0, 1), cA + hstep, voffA);
        if (wr == 1) PG8_BAR;
        PG8_WAIT_V(2); PG8_BAR;
        PG8_STAGE(PG8_SB(1, 0), cB + kstep, voffB); PG8_STAGE(PG8_SA(1, 0), cA + kstep, voffA); PG8_STAGE(PG8_SB(1, 1), cB + hstep + kstep, voffB);
        PG8_WAIT_V(6); PG8_BAR;
    } else {
        PG8_STAGE(PG8_SB(0, 0), cB, voffB); PG8_STAGE(PG8_SA(0, 0), cA, voffA); PG8_STAGE(PG8_SB(0, 1), cB + hstep, voffB); PG8_STAGE(PG8_SA(0, 1), cA + hstep, voffA);
        if (wr == 1) PG8_BAR;
        PG8_WAIT_V(4); PG8_BAR;
        PG8_STAGE(PG8_SB(1, 0), cB + kstep, voffB); PG8_STAGE(PG8_SA(1, 0), cA + kstep, voffA); PG8_STAGE(PG8_SB(1, 1), cB + hstep + kstep, voffB);
        PG8_WAIT_V(6); PG8_BAR;
    }
    for (;;) {
        const bool has_next = S.next(ui + 1, nxt);
        const char* nA = has_next ? (const char*)g.A + (size_t)nxt.pm * tstep : cA; const char* nB = has_next ? (const char*)g.Bt + (size_t)nxt.pn * tstep : cB;
        for (int t = 0; t < nt; t += 2) {
            const bool last = (t == nt - 2);
            const char* a1 = cA + (size_t)(t + 1) * kstep;
            const char* a2 = last ? nA : cA + (size_t)(t + 2) * kstep; const char* b2 = last ? nB : cB + (size_t)(t + 2) * kstep;
            const char* a3 = a2 + kstep; const char* b3 = b2 + kstep;
            if (last && has_next) S.a_ready(nxt);
            if constexpr (SP2) {
            PG8_LDB(B0, 0, 0); PG8_LDB(B1, 0, 1); PG8_SCHED; PG8_LDA(At, 0, 0); PG8_STAGE(PG8_SA(1, 1), a1 + hstep, voffA);
            PG8_WAIT_V(8); PG8_WAIT_L(0); PG8_BAR; PG8_MMA(0, 0, At, B0); PG8_MMA(0, 1, At, B1); PG8_BAR; PG8_SCHED;
            PG8_LDA(At, 0, 1); PG8_STAGE(PG8_SB(0, 0), b2, voffB); PG8_STAGE(PG8_SB(0, 1), b2 + hstep, voffB); PG8_STAGE(PG8_SA(0, 0), a2, voffA);
            PG8_WAIT_V(8); PG8_WAIT_L(0); PG8_BAR; PG8_MMA(1, 0, At, B0); PG8_MMA(1, 1, At, B1); PG8_BAR; PG8_SCHED;
            PG8_LDB(B0, 1, 0); PG8_LDB(B1, 1, 1); PG8_SCHED; PG8_LDA(At, 1, 0); PG8_STAGE(PG8_SA(0, 1), a2 + hstep, voffA);
            PG8_WAIT_V(8); PG8_WAIT_L(0); PG8_BAR; PG8_MMA(0, 0, At, B0); PG8_MMA(0, 1, At, B1); PG8_BAR; PG8_SCHED;
            PG8_LDA(At, 1, 1); PG8_STAGE(PG8_SB(1, 0), b3, voffB); PG8_STAGE(PG8_SB(1, 1), b3 + hstep, voffB); PG8_STAGE(PG8_SA(1, 0), a3, voffA);
            PG8_WAIT_V(8); PG8_WAIT_L(0); PG8_BAR; PG8_MMA(1, 0, At, B0); PG8_MMA(1, 1, At, B1); PG8_BAR; PG8_SCHED;
            } else {
            PG8_LDB(B0, 0, 0); PG8_SCHED; PG8_LDA(At, 0, 0); PG8_STAGE(PG8_SA(1, 1), a1 + hstep, voffA);
            PG8_WAIT_L(8); PG8_BAR; PG8_WAIT_L(0); PG8_MMA(0, 0, At, B0); PG8_BAR; PG8_SCHED;
            PG8_LDB(B1, 0, 1); PG8_STAGE(PG8_SB(0, 0), b2, voffB);
            PG8_BAR; PG8_WAIT_L(0); PG8_MMA(0, 1, At, B1); PG8_BAR;
            PG8_LDA(At, 0, 1); PG8_STAGE(PG8_SA(0, 0), a2, voffA);
            PG8_BAR; PG8_WAIT_L(0); PG8_MMA(1, 0, At, B0); PG8_BAR; PG8_SCHED;
            PG8_STAGE(PG8_SB(0, 1), b2 + hstep, voffB);
            PG8_WAIT_V(6); PG8_BAR; PG8_MMA(1, 1, At, B1); PG8_BAR;
            PG8_LDB(B0, 1, 0); PG8_SCHED; PG8_LDA(At, 1, 0); PG8_STAGE(PG8_SA(0, 1), a2 + hstep, voffA);
            PG8_WAIT_L(8); PG8_BAR; PG8_WAIT_L(0); PG8_MMA(0, 0, At, B0); PG8_BAR; PG8_SCHED;
            PG8_LDB(B1, 1, 1); PG8_STAGE(PG8_SB(1, 0), b3, voffB);
            PG8_BAR; PG8_WAIT_L(0); PG8_MMA(0, 1, At, B1); PG8_BAR;
            PG8_LDA(At, 1, 1); PG8_STAGE(PG8_SA(1, 0), a3, voffA);
            PG8_BAR; PG8_WAIT_L(0); PG8_MMA(1, 0, At, B0); PG8_BAR; PG8_SCHED;
            PG8_STAGE(PG8_SB(1, 1), b3 + hstep, voffB);
            PG8_WAIT_V(6); PG8_BAR; PG8_MMA(1, 1, At, B1); PG8_BAR;
            }
        }
        if constexpr (ALIGN_EPI) { if (wr == 0) PG8_BAR; }
        if constexpr (!Epi::AFTER_DRAIN) { E(acc, cur, wr, wc, fr, fq); S.done(cur); }
        if (!has_next) break;
#pragma unroll
        for (int a = 0; a < 2; ++a)
#pragma unroll
            for (int b = 0; b < 2; ++b)
#pragma unroll
                for (int m = 0; m < 4; ++m)
#pragma unroll
                    for (int n = 0; n < 2; ++n) acc[a][b][m][n] = (f32x4){0.f, 0.f, 0.f, 0.f};
        cur = nxt; cA = nA; cB = nB; ++ui;
        if constexpr (ALIGN_EPI) { if (wr == 1) PG8_BAR; }
    }
    PG8_WAIT_V(0);
    if constexpr (!ALIGN_EPI) { if (wr == 0) PG8_BAR; }
    PG8_BAR;
    if constexpr (Epi::AFTER_DRAIN) { E.fused(acc, cur, wr, wc, fr, fq, lds, wid, lane); S.done(cur); }
#undef PG8_SA
#undef PG8_SB
#undef PG8_STAGE
#undef PG8_LDA
#undef PG8_LDB
#undef PG8_MMA
#undef PG8_WAIT_V
#undef PG8_WAIT_L
#undef PG8_BAR
#undef PG8_SCHED
}
}

constexpr int NWAVES = 8;
constexpr int BATCH = 4, SEQ = 8192, D = 2048, M = BATCH * SEQ, FF = 5632;
constexpr int RC = 1024, RH = 16, RN = 64;
constexpr int HC = 1024, HH = 8, HD = 128;
constexpr int RWKV_COLS = 3360, IN_COLS = 7456, NIN = 7680;
constexpr int KL = 384, NL = 3072;
#ifndef MK_N_LAUNCHES
#define MK_N_LAUNCHES 1
#endif
constexpr int N_PHASES = 12;

constexpr size_t WS_CTL = 0, CTL_BYTES = 1u << 20;
constexpr size_t WS_W1GU = CTL_BYTES;
constexpr size_t WS_W1D = WS_W1GU + (size_t)2 * FF * D * 2;
constexpr size_t WS_WIN = WS_W1D + (size_t)D * FF * 2;
constexpr size_t WS_WLORA = WS_WIN + (size_t)NIN * D * 2;
constexpr size_t WS_WOUT = WS_WLORA + (size_t)NL * KL * 2;
constexpr size_t WS_W2GU = WS_WOUT + (size_t)D * D * 2;
constexpr size_t WS_W2D = WS_W2GU + (size_t)2 * FF * D * 2;
constexpr size_t WS_SS = WS_W2D + (size_t)D * FF * 2;
constexpr size_t WS_XB = WS_SS + (1u << 20);
constexpr size_t WS_R = WS_XB + (size_t)M * D * 2;
constexpr size_t R_ACT = 0;
constexpr size_t R_RKV = 0;
constexpr size_t R_HG = R_RKV + (size_t)M * 3072 * 2;
constexpr size_t R_LIN = R_HG + (size_t)M * 4096 * 2;
constexpr size_t R_X2B = (size_t)M * FF * 2;
constexpr size_t R_BYTES = R_LIN + (size_t)M * 288 * 4;
constexpr size_t WS_ALORA = WS_R + R_BYTES;
constexpr size_t WS_LOUT = WS_ALORA + (size_t)M * KL * 2;
constexpr size_t WS_END = WS_LOUT + (size_t)M * NL * 2;
static_assert(R_X2B + (size_t)M * D * 2 <= R_BYTES && WS_END <= ((size_t)1 << 30), "d_ws map");
constexpr int CW_BAR = 4096;

constexpr int RING_BYTES = 131072;
constexpr int LDSCTL_OFF = RING_BYTES, MISC_OFF = LDSCTL_OFF + 320;
constexpr int LDS_BYTES = 147456;
static_assert(MISC_OFF + 128 <= LDS_BYTES, "LDS map");

#define GAS __attribute__((address_space(1)))
#define LAS __attribute__((address_space(3)))
typedef unsigned short bf16;
typedef unsigned v4u __attribute__((ext_vector_type(4)));
typedef unsigned v2u __attribute__((ext_vector_type(2)));
typedef float f32x4 __attribute__((ext_vector_type(4)));
#define LDS_WAIT() asm volatile("s_waitcnt lgkmcnt(0)" ::: "memory")
#define VM_WAIT() asm volatile("s_waitcnt vmcnt(0)" ::: "memory")
__device__ __forceinline__ float bflo(unsigned u) { return __builtin_bit_cast(float, u << 16); }
__device__ __forceinline__ float bfhi(unsigned u) { return __builtin_bit_cast(float, u & 0xffff0000u); }
__device__ __forceinline__ f32x4 unpack4(v2u w) { return (f32x4){bflo(w.x), bfhi(w.x), bflo(w.y), bfhi(w.y)}; }
__device__ __forceinline__ unsigned pk2(float lo, float hi) { return pg8::cvt_pk_bf16(lo, hi); }
__device__ __forceinline__ v2u pack4(f32x4 v) { v2u w; w.x = pk2(v[0], v[1]); w.y = pk2(v[2], v[3]); return w; }
using pg8::fast_sigmoid;
using pg8::fast_silu;
template <int CTRL> __device__ __forceinline__ float dpp_mov(float x) { return __builtin_bit_cast(float, __builtin_amdgcn_update_dpp(0, __builtin_bit_cast(int, x), CTRL, 0xF, 0xF, true)); }
__device__ __forceinline__ float row16_sum(float x) { x += dpp_mov<0x128>(x); x += dpp_mov<0x124>(x); x += dpp_mov<0x122>(x); x += dpp_mov<0x121>(x); return x; }
__device__ __forceinline__ float wave_sum(float v) {
#pragma unroll
    for (int o = 1; o < 64; o <<= 1) v += __shfl_xor(v, o);
    return v;
}
#define XB_TMO      128
#define XB_XCNT(j)  (256  + 64 * (j))
#define XB_XSUB(j)  (1280 + 64 * (j))
#define XB_XGEN(j)  (2304 + 64 * (j))
#define XB_TOP      3328
#define XB_TOPGEN   3392
#define XCD_BAR_WORDS 3456
#define XB_SPIN_CAP (1u << 18)

__device__ __forceinline__ unsigned xb_ld(unsigned* p)              { return __hip_atomic_load(p, __ATOMIC_RELAXED, __HIP_MEMORY_SCOPE_AGENT); }
__device__ __forceinline__ unsigned xb_add(unsigned* p, unsigned v) { return __hip_atomic_fetch_add(p, v, __ATOMIC_RELAXED, __HIP_MEMORY_SCOPE_AGENT); }
__device__ __forceinline__ unsigned xb_xcc_id() { return (unsigned)__builtin_amdgcn_s_getreg((3 << 11) | 20) & 0xFu; }
#define XB_SPIN(cond, bar) do { unsigned _sp = 0; while (cond) { __builtin_amdgcn_s_sleep(1); \
    if ((++_sp & 255u) == 0u) { if (xb_ld(&(bar)[XB_TMO])) break; if (_sp > XB_SPIN_CAP) { atomicAdd(&(bar)[XB_TMO], 1u); break; } } } } while (0)

struct XcdBarrier {
    unsigned* bar; unsigned x;
    volatile LAS unsigned* st;
};

__device__ __forceinline__ XcdBarrier xcd_barrier_post(unsigned* bar, volatile LAS unsigned* st) {
    XcdBarrier b; b.bar = bar; b.x = xb_xcc_id(); b.st = st;
    if (threadIdx.x == 0) (void)xb_add(&bar[XB_XCNT(b.x)], 1u);
    return b;
}
__device__ __forceinline__ void xcd_barrier_complete(unsigned* bar, unsigned x, unsigned& nloc, unsigned& nx) {
    const unsigned G = gridDim.x * gridDim.y * gridDim.z;
    unsigned sum, cnt, mine, sp = 0u;
    for (;;) {
        sum = 0u; cnt = 0u; mine = 0u;
#pragma unroll
        for (unsigned j = 0; j < 16; ++j) { const unsigned c = xb_ld(&bar[XB_XCNT(j)]); sum += c; cnt += (c > 0u) ? 1u : 0u; mine = (j == x) ? c : mine; }
        if (sum == G) break;
        __builtin_amdgcn_s_sleep(1);
        if ((++sp & 255u) == 0u) { if (xb_ld(&bar[XB_TMO])) break; if (sp > XB_SPIN_CAP) { atomicAdd(&bar[XB_TMO], 1u); break; } }
    }
    nloc = mine > 0u ? mine : 1u; nx = cnt > 0u ? cnt : 1u;
}

__device__ __forceinline__ void xcd_barrier(const XcdBarrier& b) {
    asm volatile("s_waitcnt vmcnt(0)" ::: "memory");
    __syncthreads();
    if (threadIdx.x == 0) {
        unsigned* bar = b.bar;
        __builtin_amdgcn_s_waitcnt(0);
        unsigned nloc = b.st[0], nx = b.st[1];
        if (nloc == 0u) { xcd_barrier_complete(bar, b.x, nloc, nx); b.st[0] = nloc; b.st[1] = nx; }
        const unsigned old = xb_add(&bar[XB_XSUB(b.x)], 1u);
        const unsigned gen = old / nloc;
        if (old + 1u == (gen + 1u) * nloc) {
            __builtin_amdgcn_fence(__ATOMIC_RELEASE, "agent");
            asm volatile("s_waitcnt vmcnt(0)" ::: "memory");
            const unsigned og = xb_add(&bar[XB_TOP], 1u);
            const unsigned tg = og / nx;
            if (og + 1u == (tg + 1u) * nx) xb_add(&bar[XB_TOPGEN], 1u);
            else XB_SPIN(xb_ld(&bar[XB_TOPGEN]) == tg, bar);
            __builtin_amdgcn_fence(__ATOMIC_ACQUIRE, "agent");
            xb_add(&bar[XB_XGEN(b.x)], 1u);
            asm volatile("s_waitcnt vmcnt(0)" ::: "memory");
        } else {
            XB_SPIN(xb_ld(&bar[XB_XGEN(b.x)]) == gen, bar);
            __builtin_amdgcn_fence(__ATOMIC_ACQUIRE, "agent");
            asm volatile("s_waitcnt vmcnt(0)" ::: "memory");
        }
    }
    __syncthreads();
}

struct Frame {
    LAS unsigned char* lds;
    int tid, lane, wave, vcu, G;
    const float* in[26];
    float* out; unsigned char* ws;
};
#define WSP(T, off) ((T*)(F.ws + (off)))
struct Args { const float* in[26]; float* out; unsigned char* ws; int ph_lo, ph_hi; };

__device__ __forceinline__ void p0_transpose_item(const float* W, const float* gain, int K, int N, bf16* WT, int kb, int n0, int drow0, LAS float* scr, int lane) {
    const int k0 = 64 * kb;
#pragma unroll 8
    for (int i = 0; i < 32; ++i) { const int kk = 2 * i + (lane >> 5); const float gsc = gain ? gain[k0 + kk] : 1.0f; scr[kk * 33 + (lane & 31)] = W[(size_t)(k0 + kk) * N + n0 + (lane & 31)] * gsc; }
    LDS_WAIT(); asm volatile("" ::: "memory");
    const int c = lane & 7;
#pragma unroll
    for (int j = 0; j < 4; ++j) { const int n = (lane >> 3) + 8 * j; const LAS float* s = scr + (8 * c) * 33 + n;
        v4u o; o.x = pk2(s[0 * 33], s[1 * 33]); o.y = pk2(s[2 * 33], s[3 * 33]); o.z = pk2(s[4 * 33], s[5 * 33]); o.w = pk2(s[6 * 33], s[7 * 33]);
        *(GAS v4u*)(WT + (size_t)(drow0 + n) * K + k0 + 8 * c) = o; }
    LDS_WAIT(); asm volatile("" ::: "memory");
}
__device__ __forceinline__ int map_gu(int n0, int which) { return (n0 >> 7) * 256 + which * 128 + (n0 & 127); }
__device__ __forceinline__ void p0_prologue(Frame& F, const Args& A) {
    LAS float* scr = (LAS float*)(F.lds + F.wave * 16384);
    const int gw = F.vcu * NWAVES + F.wave, NGW = F.G * NWAVES;
    constexpr int I_GU = (D / 64) * (FF / 32);
    constexpr int I_DN = (FF / 64) * (D / 32);
    constexpr int I_IN = (D / 64) * (IN_COLS / 32);
    constexpr int I_OUT = (D / 64) * (D / 32);
    constexpr int NITEMS = 4 * I_GU + 2 * I_DN + I_IN + I_OUT;
    for (int it = gw; it < NITEMS; it += NGW) {
        int r = it;
        if (r < 4 * I_GU) { const int mat = r / I_GU; r -= mat * I_GU; const int nblk = FF / 32, kb = r / nblk, n0 = 32 * (r % nblk);
            const int ffn = mat >> 1, which = mat & 1;
            p0_transpose_item(A.in[2 + 20 * ffn + which], A.in[1 + 20 * ffn], D, FF, WSP(bf16, ffn ? WS_W2GU : WS_W1GU), kb, n0, map_gu(n0, which), scr, F.lane); continue; }
        r -= 4 * I_GU;
        if (r < 2 * I_DN) { const int ffn = r / I_DN; r -= ffn * I_DN; const int nblk = D / 32, kb = r / nblk, n0 = 32 * (r % nblk);
            p0_transpose_item(A.in[4 + 20 * ffn], nullptr, FF, D, WSP(bf16, ffn ? WS_W2D : WS_W1D), kb, n0, n0, scr, F.lane); continue; }
        r -= 2 * I_DN;
        if (r < I_IN) { const int nblk = IN_COLS / 32, kb = r / nblk, n0 = 32 * (r % nblk);
            p0_transpose_item(F.in[6], F.in[5], D, IN_COLS, WSP(bf16, WS_WIN), kb, n0, n0 < RWKV_COLS ? n0 : n0 + 224, scr, F.lane); continue; }
        r -= I_IN;
        { const int nblk = D / 32, kb = r / nblk, n0 = 32 * (r % nblk);
            p0_transpose_item(F.in[20], nullptr, D, D, WSP(bf16, WS_WOUT), kb, n0, n0, scr, F.lane); }
    }
    const size_t gt = (size_t)F.vcu * (NWAVES * 64) + F.tid, NT = (size_t)F.G * NWAVES * 64;
    { GAS v4u* z = (GAS v4u*)(WSP(bf16, WS_WIN) + (size_t)RWKV_COLS * D);
      for (size_t i = gt; i < (size_t)224 * D * 2 / 16; i += NT) z[i] = (v4u){0u, 0u, 0u, 0u}; }
    { bf16* wl = WSP(bf16, WS_WLORA); const float* w2 = F.in[9]; const float* a2 = F.in[11]; const float* g2 = F.in[12];
      for (size_t i = gt; i < (size_t)NL * KL / 2; i += NT) { const int n = (int)(i / (KL / 2)), k = 2 * (int)(i % (KL / 2)); const int seg = n >> 10, c = n & 1023;
          float v0 = 0.f, v1 = 0.f;
          if (seg == 0) { if (k < 64) { v0 = w2[(size_t)k * RC + c]; v1 = w2[(size_t)(k + 1) * RC + c]; } }
          else if (seg == 1) { if (k >= 64 && k < 128) { v0 = a2[(size_t)(k - 64) * RC + c]; v1 = a2[(size_t)(k - 63) * RC + c]; } }
          else { if (k >= 128 && k < 288) { v0 = g2[(size_t)(k - 128) * RC + c]; v1 = g2[(size_t)(k - 127) * RC + c]; } }
          ((GAS unsigned*)wl)[i] = pk2(v0, v1); } }
    { GAS unsigned long long* s = (GAS unsigned long long*)(F.ws + WS_SS) + M;
      for (size_t i = gt; i < (size_t)2 * M; i += NT) s[i] = 0ull; }
    { const float* x = F.in[0]; bf16* xb = WSP(bf16, WS_XB); unsigned long long* ss0 = WSP(unsigned long long, WS_SS);
      for (int m = gw; m < M; m += NGW) { const GAS f32x4* xr = (const GAS f32x4*)(x + (size_t)m * D) + 2 * F.lane; GAS v4u* o = (GAS v4u*)(xb + (size_t)m * D) + F.lane; float s = 0.f;
#pragma unroll
          for (int j = 0; j < 4; ++j) { const f32x4 a = xr[128 * j], b = xr[128 * j + 1];
              s += (a[0] * a[0] + a[1] * a[1]) + (a[2] * a[2] + a[3] * a[3]) + (b[0] * b[0] + b[1] * b[1]) + (b[2] * b[2] + b[3] * b[3]);
              o[64 * j] = pg8::pack8(a, b); }
          s = wave_sum(s);
          if (F.lane == 0) ss0[m] = (unsigned long long)(s * pg8::SS_SCALE + 0.5f); } }
}

__device__ __forceinline__ void p4_lora_in(Frame& F) {
    const float* lin = WSP(float, WS_R + R_LIN); bf16* al = WSP(bf16, WS_ALORA); const float* mu = F.in[7] + 3 * RC;
    const size_t gt = (size_t)F.vcu * (NWAVES * 64) + F.tid, NT = (size_t)F.G * NWAVES * 64;
    for (size_t i = gt; i < (size_t)M * 96; i += NT) { const int m = (int)(i / 96), q = (int)(i % 96); v2u o = (v2u){0u, 0u};
        if (q < 72) { const f32x4 p = *(const GAS f32x4*)(lin + (size_t)m * 288 + 4 * q); f32x4 pp = (f32x4){0.f, 0.f, 0.f, 0.f};
            if ((m & (SEQ - 1)) != 0) pp = *(const GAS f32x4*)(lin + (size_t)(m - 1) * 288 + 4 * q);
            const f32x4 mv = *(const GAS f32x4*)(mu + 4 * q); f32x4 s = p + (pp - p) * mv;
            if (q < 16) {
#pragma unroll
                for (int j = 0; j < 4; ++j) s[j] = 2.0f * fast_sigmoid(2.0f * s[j]) - 1.0f;
            } else if (q >= 32) {
#pragma unroll
                for (int j = 0; j < 4; ++j) s[j] = fast_sigmoid(s[j]); }
            o = pack4(s); }
        *(GAS v2u*)(al + (size_t)m * KL + 4 * q) = o; }
}

constexpr int TC = 16;
constexpr int RW_W = 0, RW_KK = 4096, RW_B = 8192, RW_KM = 12288, RW_R = 16384, RW_V = 20480, HG_F = 21504, HG_Q = 29696, HG_V = 37888, SCAN_BUF = 38912;
__device__ __forceinline__ void p6_scans(Frame& F) {
    const bf16* rkv = WSP(bf16, WS_R + R_RKV); const bf16* hg = WSP(bf16, WS_R + R_HG); const bf16* lout = WSP(bf16, WS_LOUT); bf16* yc = WSP(bf16, WS_XB);
    const int lane = F.lane, g = lane >> 4, j = lane & 15;
    for (int u = F.vcu; u < 256; u += F.G) {
        if (F.wave < 4) {
            const int bh = u >> 2, b = bh >> 4, h = bh & 15, rq = u & 3, w = F.wave;
            const int tt = F.tid >> 4, jq = F.tid & 15;
            const int ch = h * RN + 4 * jq;
            const f32x4 mu_r = *(const f32x4*)(F.in[7] + ch), mu_k = *(const f32x4*)(F.in[7] + RC + ch);
            const f32x4 kkc = *(const f32x4*)(F.in[13] + ch), kac = *(const f32x4*)(F.in[14] + ch);
            const int vch = h * RN + 16 * rq + 4 * (jq & 3);
            const f32x4 mu_v = *(const f32x4*)(F.in[7] + 2 * RC + vch);
            const size_t rowbase = (size_t)b * SEQ;
            float S0 = 0.f, S1 = 0.f, S2 = 0.f, S3 = 0.f;
            v2u Lr, Lrp, Lk, Lkp, Lw, La, Lv, Lvp;
#define RW_LOAD(t0) do { const int t_ = (t0) + tt; const bf16* p_ = rkv + (rowbase + t_) * 3072; const bf16* q_ = rkv + (rowbase + (t_ > 0 ? t_ - 1 : 0)) * 3072; const bf16* l_ = lout + (rowbase + t_) * 3072; \
                Lr = *(const GAS v2u*)(p_ + ch); Lk = *(const GAS v2u*)(p_ + RC + ch); Lv = *(const GAS v2u*)(p_ + 2 * RC + vch); \
                Lrp = *(const GAS v2u*)(q_ + ch); Lkp = *(const GAS v2u*)(q_ + RC + ch); Lvp = *(const GAS v2u*)(q_ + 2 * RC + vch); \
                Lw = *(const GAS v2u*)(l_ + ch); La = *(const GAS v2u*)(l_ + RC + ch); } while (0)
#define RW_STAGE(t0, bufp) do { const bool first_ = ((t0) + tt) == 0; \
                const f32x4 r_ = unpack4(Lr), k_ = unpack4(Lk), v_ = unpack4(Lv); \
                const f32x4 rp_ = first_ ? (f32x4){0.f, 0.f, 0.f, 0.f} : unpack4(Lrp), kp_ = first_ ? (f32x4){0.f, 0.f, 0.f, 0.f} : unpack4(Lkp), vp_ = first_ ? (f32x4){0.f, 0.f, 0.f, 0.f} : unpack4(Lvp); \
                const f32x4 rs_ = r_ + (rp_ - r_) * mu_r, ks_ = k_ + (kp_ - k_) * mu_k, vs_ = v_ + (vp_ - v_) * mu_v; \
                const f32x4 a_ = unpack4(La), om_ = unpack4(Lw); \
                f32x4 kk_ = ks_ * kkc; float n2_ = (kk_[0] * kk_[0] + kk_[1] * kk_[1]) + (kk_[2] * kk_[2] + kk_[3] * kk_[3]); n2_ = row16_sum(n2_); \
                const float in_ = 1.0f / fmaxf(sqrtf(n2_), 1e-12f); kk_ = kk_ * in_; \
                const f32x4 bb_ = kk_ * a_, km_ = ks_ * (1.0f + (a_ - 1.0f) * kac), dec_ = 1.0f - om_; \
                LAS unsigned char* d_ = (bufp) + tt * 256 + jq * 16; \
                *(LAS f32x4*)(d_ + RW_W) = dec_; *(LAS f32x4*)(d_ + RW_KK) = kk_; *(LAS f32x4*)(d_ + RW_B) = bb_; *(LAS f32x4*)(d_ + RW_KM) = km_; *(LAS f32x4*)(d_ + RW_R) = rs_; \
                if (jq < 4) *(LAS f32x4*)((bufp) + RW_V + tt * 64 + jq * 16) = vs_; } while (0)
            RW_LOAD(0); RW_STAGE(0, F.lds);
            LDS_WAIT(); __builtin_amdgcn_s_barrier(); asm volatile("" ::: "memory");
            for (int c = 0; c < SEQ / TC; ++c) {
                const int t0 = c * TC; LAS unsigned char* cur = F.lds + (c & 1) * SCAN_BUF; LAS unsigned char* nxt = F.lds + ((c + 1) & 1) * SCAN_BUF;
                const bool more = (c + 1) < SEQ / TC;
                if (more) RW_LOAD(t0 + TC);
                float yreg = 0.f;
#pragma unroll
                for (int s = 0; s < TC; ++s) {
                    const LAS unsigned char* p = cur + s * 256 + j * 16;
                    const f32x4 w4 = *(const LAS f32x4*)(p + RW_W), k4 = *(const LAS f32x4*)(p + RW_KK), b4 = *(const LAS f32x4*)(p + RW_B), m4 = *(const LAS f32x4*)(p + RW_KM), r4 = *(const LAS f32x4*)(p + RW_R);
                    const float vv = *(const LAS float*)(cur + RW_V + s * 64 + (4 * w + g) * 4);
                    float pd = (S0 * k4[0] + S1 * k4[1]) + (S2 * k4[2] + S3 * k4[3]);
                    pd = row16_sum(pd); const float sa = -pd;
                    S0 = S0 * w4[0] + (sa * b4[0] + vv * m4[0]); S1 = S1 * w4[1] + (sa * b4[1] + vv * m4[1]);
                    S2 = S2 * w4[2] + (sa * b4[2] + vv * m4[2]); S3 = S3 * w4[3] + (sa * b4[3] + vv * m4[3]);
                    float y = (S0 * r4[0] + S1 * r4[1]) + (S2 * r4[2] + S3 * r4[3]);
                    y = row16_sum(y);
                    yreg = (j == s) ? y : yreg;
                }
                yc[(rowbase + t0 + j) * 2048 + h * RN + 16 * rq + 4 * w + g] = (bf16)(pk2(yreg, 0.f) & 0xffffu);
                if (more) RW_STAGE(t0 + TC, nxt);
                LDS_WAIT(); __builtin_amdgcn_s_barrier(); asm volatile("" ::: "memory");
            }
#undef RW_LOAD
#undef RW_STAGE
        } else {
            const int bh = u >> 3, b = bh >> 3, h = bh & 7, cq = u & 7, w = F.wave - 4;
            const int t2 = F.tid - 256, tt = t2 >> 4, jq = t2 & 15;
            const int ch = h * HD + 8 * jq, vch = h * HD + 16 * cq + 8 * (jq & 1);
            const size_t rowbase = (size_t)b * SEQ;
            float S[8];
#pragma unroll
            for (int i = 0; i < 8; ++i) S[i] = 0.f;
            v4u Lq, Lf, Lv;
#define HG_LOAD(t0) do { const bf16* p_ = hg + (rowbase + (t0) + tt) * 4096; Lq = *(const GAS v4u*)(p_ + ch); Lf = *(const GAS v4u*)(p_ + HC + ch); Lv = *(const GAS v4u*)(p_ + 2 * HC + vch); } while (0)
#define HG_STAGE(bufp) do { LAS unsigned char* d_ = (bufp) + tt * 512 + jq * 32; \
                *(LAS f32x4*)(d_ + HG_Q) = (f32x4){bflo(Lq.x), bfhi(Lq.x), bflo(Lq.y), bfhi(Lq.y)}; *(LAS f32x4*)(d_ + HG_Q + 16) = (f32x4){bflo(Lq.z), bfhi(Lq.z), bflo(Lq.w), bfhi(Lq.w)}; \
                *(LAS f32x4*)(d_ + HG_F) = (f32x4){bflo(Lf.x), bfhi(Lf.x), bflo(Lf.y), bfhi(Lf.y)}; *(LAS f32x4*)(d_ + HG_F + 16) = (f32x4){bflo(Lf.z), bfhi(Lf.z), bflo(Lf.w), bfhi(Lf.w)}; \
                if (jq < 2) { LAS unsigned char* e_ = (bufp) + HG_V + tt * 64 + jq * 32; \
                    *(LAS f32x4*)(e_) = (f32x4){bflo(Lv.x), bfhi(Lv.x), bflo(Lv.y), bfhi(Lv.y)}; *(LAS f32x4*)(e_ + 16) = (f32x4){bflo(Lv.z), bfhi(Lv.z), bflo(Lv.w), bfhi(Lv.w)}; } } while (0)
            HG_LOAD(0); HG_STAGE(F.lds);
            LDS_WAIT(); __builtin_amdgcn_s_barrier(); asm volatile("" ::: "memory");
            for (int c = 0; c < SEQ / TC; ++c) {
                const int t0 = c * TC; LAS unsigned char* cur = F.lds + (c & 1) * SCAN_BUF; LAS unsigned char* nxt = F.lds + ((c + 1) & 1) * SCAN_BUF;
                const bool more = (c + 1) < SEQ / TC;
                if (more) HG_LOAD(t0 + TC);
                float oreg = 0.f;
#pragma unroll
                for (int s = 0; s < TC; ++s) {
                    const LAS unsigned char* p = cur + s * 512 + j * 16;
                    const f32x4 f0 = *(const LAS f32x4*)(p + HG_F), f1 = *(const LAS f32x4*)(p + HG_F + 256), q0 = *(const LAS f32x4*)(p + HG_Q), q1 = *(const LAS f32x4*)(p + HG_Q + 256);
                    const float vv = *(const LAS float*)(cur + HG_V + s * 64 + (4 * w + g) * 4);
                    float o = 0.f;
#pragma unroll
                    for (int i = 0; i < 4; ++i) { S[i] = S[i] - f0[i] * (S[i] - vv); S[4 + i] = S[4 + i] - f1[i] * (S[4 + i] - vv); }
                    o = ((S[0] * q0[0] + S[1] * q0[1]) + (S[2] * q0[2] + S[3] * q0[3])) + ((S[4] * q1[0] + S[5] * q1[1]) + (S[6] * q1[2] + S[7] * q1[3]));
                    o = row16_sum(o);
                    oreg = (j == s) ? o : oreg;
                }
                yc[(rowbase + t0 + j) * 2048 + RC + h * HD + 16 * cq + 4 * w + g] = (bf16)(pk2(oreg, 0.f) & 0xffffu);
                if (more) HG_STAGE(nxt);
                LDS_WAIT(); __builtin_amdgcn_s_barrier(); asm volatile("" ::: "memory");
            }
#undef HG_LOAD
#undef HG_STAGE
        }
    }
}

__device__ __forceinline__ void p7_post(Frame& F) {
    const bf16* rkv = WSP(bf16, WS_R + R_RKV); const bf16* hg = WSP(bf16, WS_R + R_HG); const bf16* lout = WSP(bf16, WS_LOUT); bf16* yc = WSP(bf16, WS_XB);
    { const int half = F.tid >> 8, ch = (F.tid & 255) * 4;
      const f32x4 mu_r = *(const f32x4*)(F.in[7] + ch), mu_k = *(const f32x4*)(F.in[7] + RC + ch), mu_v = *(const f32x4*)(F.in[7] + 2 * RC + ch);
      const f32x4 kac = *(const f32x4*)(F.in[14] + ch), rkc = *(const f32x4*)(F.in[15] + ch), lnw = *(const f32x4*)(F.in[16] + ch), lnb = *(const f32x4*)(F.in[17] + ch);
      for (int m = F.vcu * 2 + half; m < M; m += 2 * F.G) {
          const bool first = (m & (SEQ - 1)) == 0; const size_t mp = first ? m : m - 1;
          const bf16* p = rkv + (size_t)m * 3072 + ch; const bf16* q = rkv + mp * 3072 + ch; const bf16* l = lout + (size_t)m * 3072 + ch;
          const f32x4 y = unpack4(*(const GAS v2u*)(yc + (size_t)m * 2048 + ch));
          const f32x4 r = unpack4(*(const GAS v2u*)(p)), k = unpack4(*(const GAS v2u*)(p + RC)), v = unpack4(*(const GAS v2u*)(p + 2 * RC));
          f32x4 rp = unpack4(*(const GAS v2u*)(q)), kp = unpack4(*(const GAS v2u*)(q + RC)), vp = unpack4(*(const GAS v2u*)(q + 2 * RC));
          if (first) { rp = (f32x4){0.f, 0.f, 0.f, 0.f}; kp = rp; vp = rp; }
          const f32x4 a = unpack4(*(const GAS v2u*)(l + RC)), gg = unpack4(*(const GAS v2u*)(l + 2 * RC));
          const f32x4 rs = r + (rp - r) * mu_r, ks = k + (kp - k) * mu_k, vs = v + (vp - v) * mu_v;
          const f32x4 km = ks * (1.0f + (a - 1.0f) * kac);
          const f32x4 bt = rs * km * rkc; float bon = (bt[0] + bt[1]) + (bt[2] + bt[3]); bon = row16_sum(bon);
          float s1 = (y[0] + y[1]) + (y[2] + y[3]); s1 = row16_sum(s1); const float mean = s1 * (1.0f / 64.0f);
          const f32x4 d = y - mean; float s2 = (d[0] * d[0] + d[1] * d[1]) + (d[2] * d[2] + d[3] * d[3]); s2 = row16_sum(s2);
          const float rstd = 1.0f / sqrtf(s2 * (1.0f / 64.0f) + 64e-5f);
          const f32x4 o = ((d * rstd) * lnw + lnb + vs * bon) * gg;
          *(GAS v2u*)(yc + (size_t)m * 2048 + ch) = pack4(o); } }
    { const int quarter = F.tid >> 7, ch = (F.tid & 127) * 8;
      const f32x4 nw0 = *(const f32x4*)(F.in[19] + ch), nw1 = *(const f32x4*)(F.in[19] + ch + 4);
      for (int m = F.vcu * 4 + quarter; m < M; m += 4 * F.G) {
          const v4u ow = *(const GAS v4u*)(yc + (size_t)m * 2048 + RC + ch), gw4 = *(const GAS v4u*)(hg + (size_t)m * 4096 + 3 * HC + ch);
          const f32x4 o0 = (f32x4){bflo(ow.x), bfhi(ow.x), bflo(ow.y), bfhi(ow.y)}, o1 = (f32x4){bflo(ow.z), bfhi(ow.z), bflo(ow.w), bfhi(ow.w)};
          const f32x4 g0 = (f32x4){bflo(gw4.x), bfhi(gw4.x), bflo(gw4.y), bfhi(gw4.y)}, g1 = (f32x4){bflo(gw4.z), bfhi(gw4.z), bflo(gw4.w), bfhi(gw4.w)};
          float s2 = ((o0[0] * o0[0] + o0[1] * o0[1]) + (o0[2] * o0[2] + o0[3] * o0[3])) + ((o1[0] * o1[0] + o1[1] * o1[1]) + (o1[2] * o1[2] + o1[3] * o1[3])); s2 = row16_sum(s2);
          const float rstd = 1.0f / sqrtf(s2 * (1.0f / 128.0f) + 1e-6f);
          *(GAS v4u*)(yc + (size_t)m * 2048 + RC + ch) = pg8::pack8(o0 * rstd * nw0 * g0, o1 * rstd * nw1 * g1); } }
}

__device__ __forceinline__ void p11_final(Frame& F) {
    const int gw = F.vcu * NWAVES + F.wave, NGW = F.G * NWAVES; const float* fg = F.in[25];
    f32x4 gn[8];
#pragma unroll
    for (int i = 0; i < 8; ++i) gn[i] = *(const f32x4*)(fg + 4 * F.lane + 256 * i);
    for (int m = gw; m < M; m += NGW) { GAS f32x4* xr = (GAS f32x4*)(F.out + (size_t)m * D) + F.lane; f32x4 v[8]; float s = 0.f;
#pragma unroll
        for (int i = 0; i < 8; ++i) { v[i] = xr[64 * i]; s += (v[i][0] * v[i][0] + v[i][1] * v[i][1]) + (v[i][2] * v[i][2] + v[i][3] * v[i][3]); }
        s = wave_sum(s); const float inv = 1.0f / sqrtf(s * (1.0f / D) + 1e-6f);
#pragma unroll
        for (int i = 0; i < 8; ++i) xr[64 * i] = v[i] * inv * gn[i]; }
}

__global__ void __launch_bounds__(NWAVES * 64, 2) mk_fwd(Args args) {
    extern __shared__ __attribute__((aligned(16))) unsigned char lds[];
    Frame F;
    F.lds = (LAS unsigned char*)lds;
    F.tid = threadIdx.x; F.lane = F.tid & 63; F.wave = __builtin_amdgcn_readfirstlane(F.tid >> 6);
    F.G = gridDim.x; { const int bx = blockIdx.x; F.vcu = (F.G % 8 == 0) ? (bx % 8) * (F.G / 8) + bx / 8 : bx; }
#pragma unroll
    for (int i = 0; i < 26; ++i) F.in[i] = args.in[i];
    F.out = args.out; F.ws = args.ws;
    for (int u = F.tid; u < (LDS_BYTES - LDSCTL_OFF) / 4; u += NWAVES * 64) ((LAS unsigned*)(F.lds + LDSCTL_OFF))[u] = 0u;
    __syncthreads();
    const int lo = args.ph_lo, hi = args.ph_hi;
    XcdBarrier bar; bar.bar = (unsigned*)(args.ws + WS_CTL) + CW_BAR; bar.x = 0; bar.st = nullptr;
    if (hi - lo > 1) bar = xcd_barrier_post((unsigned*)(args.ws + WS_CTL) + CW_BAR, (volatile LAS unsigned*)(F.lds + MISC_OFF) + 8);
#ifndef PH_MASK
#define PH_MASK 0xFFF
#endif
#define IN(k) (((PH_MASK >> (k)) & 1) && lo <= (k) && (k) < hi)
#define SEAM(k) do { if (IN(k) && IN((k) + 1)) xcd_barrier(bar); } while (0)
    const bf16* xb = WSP(bf16, WS_XB); unsigned long long* ss = WSP(unsigned long long, WS_SS);
    const int cid = (int)blockIdx.x;

    if (IN(0)) { p0_prologue(F, args); } SEAM(0);
    if (IN(1)) {
        pg8::Gemm g{xb, WSP(bf16, WS_W1GU), M, 2 * FF, D}; pg8::StaticOrder S; S.init(M, 2 * FF, F.G, cid);
        pg8::EpiSwiglu E{WSP(bf16, WS_R + R_ACT), FF, ss};
        pg8::gemm_phase<pg8::EpiSwiglu, pg8::StaticOrder, true, true>(F.lds, g, S, E);
    } SEAM(1);
    if (IN(2)) {
        pg8::Gemm g{WSP(bf16, WS_R + R_ACT), WSP(bf16, WS_W1D), M, D, FF}; pg8::StaticOrder S; S.init(M, D, F.G, cid);
        pg8::EpiResid E{F.in[0], F.out, WSP(bf16, WS_XB), ss + M, 0.5f};
        pg8::gemm_phase<pg8::EpiResid, pg8::StaticOrder, true, true>(F.lds, g, S, E);
    } SEAM(2);
    if (IN(3)) {
        pg8::Gemm g{xb, WSP(bf16, WS_WIN), M, NIN, D}; pg8::StaticOrder S; S.init(M, NIN, F.G, cid);
        pg8::EpiInProj E{WSP(bf16, WS_R + R_RKV), WSP(float, WS_R + R_LIN), WSP(bf16, WS_R + R_HG), ss + M, F.in[18]};
        pg8::gemm_phase<pg8::EpiInProj, pg8::StaticOrder, true, true>(F.lds, g, S, E);
    } SEAM(3);
    if (IN(4)) { p4_lora_in(F); } SEAM(4);
    if (IN(5)) {
        int kl = KL; asm volatile("" : "+s"(kl));
        pg8::Gemm g{WSP(bf16, WS_ALORA), WSP(bf16, WS_WLORA), M, NL, kl}; pg8::StaticOrder S; S.init(M, NL, F.G, cid);
        pg8::EpiLora E{WSP(bf16, WS_LOUT), F.in[8], F.in[10]};
        pg8::gemm_phase<pg8::EpiLora, pg8::StaticOrder, true, true>(F.lds, g, S, E);
    } SEAM(5);
    if (IN(6)) { p6_scans(F); } SEAM(6);
    if (IN(7)) { p7_post(F); } SEAM(7);
    if (IN(8)) {
        pg8::Gemm g{xb, WSP(bf16, WS_WOUT), M, D, D}; pg8::StaticOrder S; S.init(M, D, F.G, cid);
        pg8::EpiResid E{F.out, F.out, WSP(bf16, WS_R + R_X2B), ss + 2 * M, 1.0f};
        pg8::gemm_phase<pg8::EpiResid, pg8::StaticOrder, true, true>(F.lds, g, S, E);
    } SEAM(8);
    if (IN(9)) {
        pg8::Gemm g{WSP(bf16, WS_R + R_X2B), WSP(bf16, WS_W2GU), M, 2 * FF, D}; pg8::StaticOrder S; S.init(M, 2 * FF, F.G, cid);
        pg8::EpiSwiglu E{WSP(bf16, WS_R + R_ACT), FF, ss + 2 * M};
        pg8::gemm_phase<pg8::EpiSwiglu, pg8::StaticOrder, true, true>(F.lds, g, S, E);
    } SEAM(9);
    if (IN(10)) {
        pg8::Gemm g{WSP(bf16, WS_R + R_ACT), WSP(bf16, WS_W2D), M, D, FF}; pg8::StaticOrder S; S.init(M, D, F.G, cid);
        pg8::EpiResid E{F.out, F.out, nullptr, nullptr, 0.5f};
        pg8::gemm_phase<pg8::EpiResid, pg8::StaticOrder, true, true>(F.lds, g, S, E);
    } SEAM(10);
    if (IN(11)) { p11_final(F); }
#undef IN
#undef SEAM
}

extern "C" void kernel_launch(void* const* d_in, const int* in_sizes, int n_in, void* d_out, int out_size, void* d_ws, size_t ws_size, hipStream_t stream) {
    static int grid = 0;
    if (grid == 0) {
        if (n_in != 26 || in_sizes[0] != M * D || out_size != M * D || ws_size < WS_END) { fprintf(stderr, "kernel_launch: unexpected problem (n_in %d, ws %zu < %zu)\n", n_in, ws_size, (size_t)WS_END); grid = -1; return; }
        int dev = 0, cus = 0, per_cu = 0;
        if (hipGetDevice(&dev) != hipSuccess || hipDeviceGetAttribute(&cus, hipDeviceAttributeMultiprocessorCount, dev) != hipSuccess) { grid = -1; return; }
        if (hipFuncSetAttribute((const void*)mk_fwd, hipFuncAttributeMaxDynamicSharedMemorySize, LDS_BYTES) != hipSuccess) { grid = -1; return; }
        if (hipOccupancyMaxActiveBlocksPerMultiprocessor(&per_cu, (const void*)mk_fwd, NWAVES * 64, LDS_BYTES) != hipSuccess || per_cu < 1) fprintf(stderr, "kernel_launch: occupancy query reports %d\n", per_cu);
        (void)hipGetLastError();
        grid = cus;
    }
    if (grid < 0) return;
    (void)hipMemsetAsync((char*)d_ws + WS_CTL, 0, CTL_BYTES, stream);
    Args a{};
    for (int i = 0; i < 26; ++i) a.in[i] = (const float*)d_in[i];
    a.out = (float*)d_out; a.ws = (unsigned char*)d_ws;
    constexpr int NL_ = MK_N_LAUNCHES;
    for (int li = 0; li < NL_; ++li) {
        a.ph_lo = (NL_ == 1) ? 0 : li; a.ph_hi = (NL_ == 1) ? N_PHASES : li + 1;
        hipLaunchKernelGGL(mk_fwd, dim3(grid), dim3(NWAVES * 64), LDS_BYTES, stream, a);
    }
}
```

```cpp
#include <hip/hip_runtime.h>
#include <cstdio>
#include <cstdint>
namespace pg8 {
#define PG8_LAS __attribute__((address_space(3)))
typedef unsigned short bf16_t;
typedef short bf16x8 __attribute__((ext_vector_type(8)));
typedef float f32x4 __attribute__((ext_vector_type(4)));
typedef unsigned u32x4 __attribute__((ext_vector_type(4)));
constexpr int BM = 256, BK = 64, HALF = 128, HTB = HALF * BK * 2  , STAGE_BYTES = 8 * HTB, NXCD = 8, WGM = 8;

__host__ __device__ __forceinline__ int lds_byte(int r, int c) { const int st = (r >> 4) * 2 + (c >> 5), rr = r & 15, cc = c & 31, ob = rr * 64 + cc * 2; return st * 1024 + (ob ^ (((ob >> 9) & 1) << 5)); }
__host__ __device__ __forceinline__ void stage_rc(int b, int& R, int& C) { const int st = b / 1024, sb = b % 1024, swz = sb ^ (((sb >> 9) & 1) << 5); R = (st >> 1) * 16 + swz / 64; C = (st & 1) * 32 + (swz % 64) / 2; }
__host__ __device__ __forceinline__ int perm32(int rho) { const int n = rho >> 4, i = rho & 15; return 8 * (i >> 2) + 4 * n + (i & 3); }

struct Unit { int pm, pn; };
struct Gemm { const bf16_t* A; const bf16_t* Bt; int M, N, K; };

struct StaticOrder {
    int nM, nN, nwg, G, c;
    __host__ __device__ void init(int M, int N, int G_, int c_) { nM = M / BM; nN = N / BM; nwg = nM * nN; G = G_; c = c_; }
    __host__ __device__ bool next(int i, Unit& u) const {
        const long L = (long)i * G + c; if (L >= nwg) return false;
        int wgid = (int)L; { const int q = nwg / NXCD, r = nwg % NXCD, xcd = wgid % NXCD, off = wgid / NXCD; wgid = (xcd < r ? xcd * (q + 1) : r * (q + 1) + (xcd - r) * q) + off; }
        const int nig = WGM * nN, gid = wgid / nig, fm = gid * WGM, gsz = (nM - fm) < WGM ? (nM - fm) : WGM;
        u.pm = fm + ((wgid % nig) % gsz); u.pn = (wgid % nig) / gsz; return true;
    }
    __device__ __forceinline__ void a_ready(const Unit&) const {}
    __device__ __forceinline__ void done(const Unit&) const {}
};


typedef __bf16 bf16n2 __attribute__((ext_vector_type(2)));
__device__ __forceinline__ unsigned cvt_pk_bf16(float lo, float hi) { bf16n2 v; v.x = (__bf16)lo; v.y = (__bf16)hi; return __builtin_bit_cast(unsigned, v); }
__device__ __forceinline__ float fast_sigmoid(float z) { return __builtin_amdgcn_rcpf(1.0f + __builtin_amdgcn_exp2f(-1.44269504f * z)); }
__device__ __forceinline__ float fast_silu(float z) { return z * fast_sigmoid(z); }
constexpr float SS_SCALE = 16777216.0f;
__device__ __forceinline__ float inv_rms_from_val(unsigned long long v) {
    const float tot = (float)v * (1.0f / SS_SCALE);
    return 1.0f / sqrtf(tot * (1.0f / 2048.0f) + 1e-6f);
}
__device__ __forceinline__ u32x4 pack8(const f32x4 v0, const f32x4 v1) { u32x4 w; w.x = cvt_pk_bf16(v0[0], v0[1]); w.y = cvt_pk_bf16(v0[2], v0[3]); w.z = cvt_pk_bf16(v1[0], v1[1]); w.w = cvt_pk_bf16(v1[2], v1[3]); return w; }

struct EpiSwiglu {
    static constexpr bool PERM = true, AFTER_DRAIN = false;
    bf16_t* O; int ldc; const unsigned long long* ss;
    __device__ __forceinline__ void operator()(const f32x4 (&acc)[2][2][4][2], const Unit& u, int wr, int wc, int fr, int fq) const {
        const int row0 = u.pm * BM + wr * 64 + fr, col0 = u.pn * HALF + wc * 32 + 8 * fq;
        unsigned long long sv[2][4];
#pragma unroll
        for (int ai = 0; ai < 2; ++ai)
#pragma unroll
            for (int m = 0; m < 4; ++m) sv[ai][m] = ss[row0 + ai * HALF + m * 16];
#pragma unroll
        for (int ai = 0; ai < 2; ++ai)
#pragma unroll
            for (int m = 0; m < 4; ++m) { const int row = row0 + ai * HALF + m * 16; const float inv = inv_rms_from_val(sv[ai][m]);
                f32x4 o[2];
#pragma unroll
                for (int n = 0; n < 2; ++n) { const f32x4 g = acc[ai][0][m][n] * inv, up = acc[ai][1][m][n] * inv;
#pragma unroll
                    for (int j = 0; j < 4; ++j) o[n][j] = fast_silu(g[j]) * up[j]; }
                *(u32x4*)(O + (size_t)row * ldc + col0) = pack8(o[0], o[1]); }
    }
};
struct EpiResid {
    static constexpr bool PERM = true, AFTER_DRAIN = false;
    const float* resid; float* out; bf16_t* ob; unsigned long long* ss; float alpha;
    __device__ __forceinline__ void operator()(const f32x4 (&acc)[2][2][4][2], const Unit& u, int wr, int wc, int fr, int fq) const {
        const int row0 = u.pm * BM + wr * 64 + fr, col0 = u.pn * BM + wc * 32 + 8 * fq;
#pragma unroll
        for (int ai = 0; ai < 2; ++ai)
#pragma unroll
            for (int m = 0; m < 4; ++m) { const int row = row0 + ai * HALF + m * 16; const size_t off = (size_t)row * 2048 + col0; float s = 0.f;
#pragma unroll
                for (int bj = 0; bj < 2; ++bj) {
                    const f32x4 r0 = *(const f32x4*)(resid + off + bj * HALF), r1 = *(const f32x4*)(resid + off + bj * HALF + 4);
                    const f32x4 o0 = r0 + acc[ai][bj][m][0] * alpha, o1 = r1 + acc[ai][bj][m][1] * alpha;
                    *(f32x4*)(out + off + bj * HALF) = o0; *(f32x4*)(out + off + bj * HALF + 4) = o1;
                    if (ob) *(u32x4*)(ob + off + bj * HALF) = pack8(o0, o1);
                    s += (o0[0] * o0[0] + o0[1] * o0[1]) + (o0[2] * o0[2] + o0[3] * o0[3]) + (o1[0] * o1[0] + o1[1] * o1[1]) + (o1[2] * o1[2] + o1[3] * o1[3]); }
                if (ss) { s += __shfl_xor(s, 16); s += __shfl_xor(s, 32);
                    if (fq == 0) atomicAdd(ss + row, (unsigned long long)(s * SS_SCALE + 0.5f)); } }
    }
};
struct EpiInProj {
    static constexpr bool PERM = true, AFTER_DRAIN = false;
    bf16_t* rkv; float* lin; bf16_t* hg; const unsigned long long* ss; const float* lbl;
    __device__ __forceinline__ void operator()(const f32x4 (&acc)[2][2][4][2], const Unit& u, int wr, int wc, int fr, int fq) const {
        const int row0 = u.pm * BM + wr * 64 + fr, cin = wc * 32 + 8 * fq;
        const int pn = u.pn;
        float invs[2][4];
        { unsigned long long sv[2][4];
#pragma unroll
          for (int ai = 0; ai < 2; ++ai)
#pragma unroll
              for (int m = 0; m < 4; ++m) sv[ai][m] = ss[row0 + ai * HALF + m * 16];
#pragma unroll
          for (int ai = 0; ai < 2; ++ai)
#pragma unroll
              for (int m = 0; m < 4; ++m) invs[ai][m] = inv_rms_from_val(sv[ai][m]); }
        int mode;
        if (pn < 12) mode = 0; else if (pn < 14) mode = 1; else { const int sg = (pn - 14) >> 2; mode = (sg == 0 || sg == 3) ? 2 : (sg == 1 ? 3 : 4); }
#pragma unroll
        for (int bj = 0; bj < 2; ++bj) {
            f32x4 om0 = (f32x4){0.f, 0.f, 0.f, 0.f}, om1 = om0;
            if (mode == 3) { const float* lp = lbl + (pn - 18) * BM + bj * HALF + cin; const f32x4 a0 = *(const f32x4*)lp, a1 = *(const f32x4*)(lp + 4), c0 = *(const f32x4*)(lp + 1024), c1 = *(const f32x4*)(lp + 1028);
#pragma unroll
                for (int j = 0; j < 4; ++j) { om0[j] = 1.0f - fast_sigmoid(a0[j] - c0[j]); om1[j] = 1.0f - fast_sigmoid(a1[j] - c1[j]); } }
#pragma unroll
            for (int ai = 0; ai < 2; ++ai)
#pragma unroll
                for (int m = 0; m < 4; ++m) { const int row = row0 + ai * HALF + m * 16; const float inv = invs[ai][m];
                    f32x4 v0 = acc[ai][bj][m][0] * inv, v1 = acc[ai][bj][m][1] * inv;
                    if (mode == 0) { *(u32x4*)(rkv + (size_t)row * 3072 + pn * BM + bj * HALF + cin) = pack8(v0, v1); }
                    else if (mode == 1) { const int cl = (pn - 12) * BM + bj * HALF + cin;
                        if (cl < 288) { *(f32x4*)(lin + (size_t)row * 288 + cl) = v0; *(f32x4*)(lin + (size_t)row * 288 + cl + 4) = v1; } }
                    else {
                        if (mode == 2) {
#pragma unroll
                            for (int j = 0; j < 4; ++j) { v0[j] = fast_silu(v0[j]); v1[j] = fast_silu(v1[j]); } }
                        else if (mode == 3) {
#pragma unroll
                            for (int j = 0; j < 4; ++j) { v0[j] = __logf(1.0f - om0[j] * fast_sigmoid(-v0[j])); v1[j] = __logf(1.0f - om1[j] * fast_sigmoid(-v1[j])); } }
                        *(u32x4*)(hg + (size_t)row * 4096 + (pn - 14) * BM + bj * HALF + cin) = pack8(v0, v1); } } }
    }
};
struct EpiLora {
    static constexpr bool PERM = true, AFTER_DRAIN = false;
    bf16_t* lout; const float* w0; const float* a0;
    __device__ __forceinline__ void operator()(const f32x4 (&acc)[2][2][4][2], const Unit& u, int wr, int wc, int fr, int fq) const {
        const int row0 = u.pm * BM + wr * 64 + fr, cin = wc * 32 + 8 * fq;
        const int pn = u.pn, mode = pn >> 2;
#pragma unroll
        for (int bj = 0; bj < 2; ++bj) {
            f32x4 b0 = (f32x4){0.f, 0.f, 0.f, 0.f}, b1 = b0;
            if (mode < 2) { const float* bp = (mode == 0 ? w0 : a0) + (pn & 3) * BM + bj * HALF + cin; b0 = *(const f32x4*)bp; b1 = *(const f32x4*)(bp + 4); }
#pragma unroll
            for (int ai = 0; ai < 2; ++ai)
#pragma unroll
                for (int m = 0; m < 4; ++m) { const int row = row0 + ai * HALF + m * 16;
                    f32x4 v0 = acc[ai][bj][m][0] + b0, v1 = acc[ai][bj][m][1] + b1;
#pragma unroll
                    for (int j = 0; j < 4; ++j) { const float s0 = fast_sigmoid(v0[j]), s1 = fast_sigmoid(v1[j]);
                        const float d0 = -0.60653066f * s0, d1 = -0.60653066f * s1;
                        v0[j] = mode == 0 ? d0 : (mode == 1 ? s0 : v0[j]); v1[j] = mode == 0 ? d1 : (mode == 1 ? s1 : v1[j]); }
                    *(u32x4*)(lout + (size_t)row * 3072 + pn * BM + bj * HALF + cin) = pack8(v0, v1); asm volatile("" ::: "memory"); } }
    }
};
template <class Epi, class Sched, bool ALIGN_EPI = false, bool SP2 = false>
__device__ __forceinline__ void gemm_phase(PG8_LAS unsigned char* lds, const Gemm g, const Sched& S, const Epi& E) {
    const int tid = threadIdx.x, wid = __builtin_amdgcn_readfirstlane(tid >> 6), lane = tid & 63, wr = wid >> 2, wc = wid & 3, fr = lane & 15, fq = lane >> 4;
    const int K = g.K, nt = K / BK;
    unsigned voffA[2], voffB[2];
#pragma unroll
    for (int i = 0; i < 2; ++i) { int R, C; stage_rc(tid * 16 + i * 8192, R, C); const int Rb = Epi::PERM ? ((R & ~31) + perm32(R & 31)) : R;
        voffA[i] = (unsigned)(R * K + C) * 2u; voffB[i] = (unsigned)(Rb * K + C) * 2u; }
    const size_t kstep = (size_t)(BK * 2);
    const size_t hstep = (size_t)HALF * K * 2;
    const size_t tstep = 2 * hstep;
    const unsigned ldsw = (unsigned)wid * 1024u;
    const int aoff = lds_byte(wr * 64 + fr, fq * 8), boff = lds_byte(wc * 32 + fr, fq * 8);
#define PG8_SA(b, h) (((b) * 2 + (h)) * HTB)
#define PG8_SB(b, h) ((4 + (b) * 2 + (h)) * HTB)
#define PG8_STAGE(bufoff, gbase, voff) do { _Pragma("unroll") for (int _i = 0; _i < 2; ++_i) \
        __builtin_amdgcn_global_load_lds((const unsigned*)((const char*)(gbase) + (voff)[_i]), (PG8_LAS unsigned*)(lds + (bufoff) + ldsw + _i * 8192), 16, 0, 0); } while (0)
#define PG8_LDA(dst, b, h) do { _Pragma("unroll") for (int m = 0; m < 4; ++m) _Pragma("unroll") for (int k = 0; k < 2; ++k) dst[m][k] = *(const PG8_LAS bf16x8*)(lds + PG8_SA(b, h) + aoff + m * 2048 + k * 1024); } while (0)
#define PG8_LDB(dst, b, h) do { _Pragma("unroll") for (int n = 0; n < 2; ++n) _Pragma("unroll") for (int k = 0; k < 2; ++k) dst[n][k] = *(const PG8_LAS bf16x8*)(lds + PG8_SB(b, h) + boff + n * 2048 + k * 1024); } while (0)
#define PG8_MMA(ai, bj, At, Bt) do { __builtin_amdgcn_s_setprio(1); _Pragma("unroll") for (int m = 0; m < 4; ++m) _Pragma("unroll") for (int n = 0; n < 2; ++n) _Pragma("unroll") for (int k = 0; k < 2; ++k) \
        acc[ai][bj][m][n] = __builtin_amdgcn_mfma_f32_16x16x32_bf16(Bt[n][k], At[m][k], acc[ai][bj][m][n], 0, 0, 0); __builtin_amdgcn_s_setprio(0); } while (0)
#define PG8_WAIT_V(n) asm volatile("s_waitcnt vmcnt(" #n ")" ::: "memory")
#define PG8_WAIT_L(n) asm volatile("s_waitcnt lgkmcnt(" #n ")" ::: "memory")
#define PG8_BAR __builtin_amdgcn_s_barrier()
#define PG8_SCHED __builtin_amdgcn_sched_barrier(0)
    Unit cur, nxt; int ui = 0;
    if (!S.next(0, cur)) return;
    f32x4 acc[2][2][4][2];
#pragma unroll
    for (int a = 0; a < 2; ++a)
#pragma unroll
        for (int b = 0; b < 2; ++b)
#pragma unroll
            for (int m = 0; m < 4; ++m)
#pragma unroll
                for (int n = 0; n < 2; ++n) acc[a][b][m][n] = (f32x4){0.f, 0.f, 0.f, 0.f};
    bf16x8 At[4][2], B0[2][2], B1[2][2];
    const char* cA = (const char*)g.A + (size_t)cur.pm * tstep; const char* cB = (const char*)g.Bt + (size_t)cur.pn * tstep;
    S.a_ready(cur);
    if constexpr (SP2) {
        PG8_STAGE(PG8_SB(0, 0), cB, voffB); PG8_STAGE(PG8_SB(0, 1), cB + hstep, voffB); PG8_STAGE(PG8_SA(0, 0), cA, voffA); PG8_STAGE(PG8_SA(0, 1), cA + hstep, voffA);
        if (wr == 1) PG8_BAR;
        PG8_WAIT_V(2); PG8_BAR;
        PG8_STAGE(PG8_SB(1, 0), cB + kstep, voffB); PG8_STAGE(PG8_SA(1, 0), cA + kstep, voffA); PG8_STAGE(PG8_SB(1, 1), cB + hstep + kstep, voffB);
        PG8_WAIT_V(6); PG8_BAR;
    } else {
        PG8_STAGE(PG8_SB(0, 0), cB, voffB); PG8_STAGE(PG8_SA(0, 0), cA, voffA); PG8_STAGE(PG8_SB(0, 1), cB + hstep, voffB); PG8_STAGE(PG8_SA(0, 1), cA + hstep, voffA);
        if (wr == 1) PG8_BAR;
        PG8_WAIT_V(4); PG8_BAR;
        PG8_STAGE(PG8_SB(1, 0), cB + kstep, voffB); PG8_STAGE(PG8_SA(1, 0), cA + kstep, voffA); PG8_STAGE(PG8_SB(1, 1), cB + hstep + kstep, voffB);
        PG8_WAIT_V(6); PG8_BAR;
    }
    for (;;) {
        const bool has_next = S.next(ui + 1, nxt);
        const char* nA = has_next ? (const char*)g.A + (size_t)nxt.pm * tstep : cA; const char* nB = has_next ? (const char*)g.Bt + (size_t)nxt.pn * tstep : cB;
        for (int t = 0; t < nt; t += 2) {
            const bool last = (t == nt - 2);
            const char* a1 = cA + (size_t)(t + 1) * kstep;
            const char* a2 = last ? nA : cA + (size_t)(t + 2) * kstep; const char* b2 = last ? nB : cB + (size_t)(t + 2) * kstep;
            const char* a3 = a2 + kstep; const char* b3 = b2 + kstep;
            if (last && has_next) S.a_ready(nxt);
            if constexpr (SP2) {
            PG8_LDB(B0, 0, 0); PG8_LDB(B1, 0, 1); PG8_SCHED; PG8_LDA(At, 0, 0); PG8_STAGE(PG8_SA(1, 1), a1 + hstep, voffA);
            PG8_WAIT_V(8); PG8_WAIT_L(0); PG8_BAR; PG8_MMA(0, 0, At, B0); PG8_MMA(0, 1, At, B1); PG8_BAR; PG8_SCHED;
            PG8_LDA(At, 0, 1); PG8_STAGE(PG8_SB(0, 0), b2, voffB); PG8_STAGE(PG8_SB(0, 1), b2 + hstep, voffB); PG8_STAGE(PG8_SA(0, 0), a2, voffA);
            PG8_WAIT_V(8); PG8_WAIT_L(0); PG8_BAR; PG8_MMA(1, 0, At, B0); PG8_MMA(1, 1, At, B1); PG8_BAR; PG8_SCHED;
            PG8_LDB(B0, 1, 0); PG8_LDB(B1, 1, 1); PG8_SCHED; PG8_LDA(At, 1, 0); PG8_STAGE(PG8_SA(0, 1), a2 + hstep, voffA);
            PG8_WAIT_V(8); PG8_WAIT_L(0); PG8_BAR; PG8_MMA(0, 0, At, B0); PG8_MMA(0, 1, At, B1); PG8_BAR; PG8_SCHED;
            PG8_LDA(At, 1, 1); PG8_STAGE(PG8_SB(1, 0), b3, voffB); PG8_STAGE(PG8_SB(1, 1), b3 + hstep, voffB); PG8_STAGE(PG8_SA(1, 0), a3, voffA);
            PG8_WAIT_V(8); PG8_WAIT_L(0); PG8_BAR; PG8_MMA(1, 0, At, B0); PG8_MMA(1, 1, At, B1); PG8_BAR; PG8_SCHED;
            } else {
            PG8_LDB(B0, 0, 0); PG8_SCHED; PG8_LDA(At, 0, 0); PG8_STAGE(PG8_SA(1, 1), a1 + hstep, voffA);
            PG8_WAIT_L(8); PG8_BAR; PG8_WAIT_L(0); PG8_MMA(0, 0, At, B0); PG8_BAR; PG8_SCHED;
            PG8_LDB(B1, 0, 1); PG8_STAGE(PG8_SB(0, 0), b2, voffB);
            PG8_BAR; PG8_WAIT_L(0); PG8_MMA(0, 1, At, B1); PG8_BAR;
            PG8_LDA(At, 0, 1); PG8_STAGE(PG8_SA(0, 0), a2, voffA);
            PG8_BAR; PG8_WAIT_L(0); PG8_MMA(1, 0, At, B0); PG8_BAR; PG8_SCHED;
            PG8_STAGE(PG8_SB(0, 1), b2 + hstep, voffB);
            PG8_WAIT_V(6); PG8_BAR; PG8_MMA(1, 1, At, B1); PG8_BAR;
            PG8_LDB(B0, 1, 0); PG8_SCHED; PG8_LDA(At, 1, 0); PG8_STAGE(PG8_SA(0, 1), a2 + hstep, voffA);
            PG8_WAIT_L(8); PG8_BAR; PG8_WAIT_L(0); PG8_MMA(0, 0, At, B0); PG8_BAR; PG8_SCHED;
            PG8_LDB(B1, 1, 1); PG8_STAGE(PG8_SB(1, 0), b3, voffB);
            PG8_BAR; PG8_WAIT_L(0); PG8_MMA(0, 1, At, B1); PG8_BAR;
            PG8_LDA(At, 1, 1); PG8_STAGE(PG8_SA(1, 0), a3, voffA);
            PG8_BAR; PG8_WAIT_L(0); PG8_MMA(1, 0, At, B0); PG8_BAR; PG8_SCHED;
            PG8_STAGE(PG8_SB(1, 1), b3 + hstep, voffB);
            PG8_WAIT_V(6); PG8_BAR; PG8_MMA(1, 1, At, B1); PG8_BAR;
            }
        }
        if constexpr (ALIGN_EPI) { if (wr == 0) PG8_BAR; }
        if constexpr (!Epi::AFTER_DRAIN) { E(acc, cur, wr, wc, fr, fq); S.done(cur); }
        if (!has_next) break;
#pragma unroll
        for (int a = 0; a < 2; ++a)
#pragma unroll
            for (int b = 0; b < 2; ++b)
#pragma unroll
                for (int m = 0; m < 4; ++m)
#pragma unroll
                    for (int n = 0; n < 2; ++n) acc[a][b][m][n] = (f32x4){0.f, 0.f, 0.f, 0.f};
        cur = nxt; cA = nA; cB = nB; ++ui;
        if constexpr (ALIGN_EPI) { if (wr == 1) PG8_BAR; }
    }
    PG8_WAIT_V(0);
    if constexpr (!ALIGN_EPI) { if (wr == 0) PG8_BAR; }
    PG8_BAR;
    if constexpr (Epi::AFTER_DRAIN) { E.fused(acc, cur, wr, wc, fr, fq, lds, wid, lane); S.done(cur); }
#undef PG8_SA
#undef PG8_SB
#undef PG8_STAGE
#undef PG8_LDA
#undef PG8_LDB
#undef PG8_MMA
#undef PG8_WAIT_V
#undef PG8_WAIT_L
#undef PG8_BAR
#undef PG8_SCHED
}
}

constexpr int NWAVES = 8;
constexpr int BATCH = 4, SEQ = 8192, D = 2048, M = BATCH * SEQ, FF = 5632;
constexpr int RC = 1024, RH = 16, RN = 64;
constexpr int HC = 1024, HH = 8, HD = 128;
constexpr int RWKV_COLS = 3360, IN_COLS = 7456, NIN = 7680;
constexpr int KL = 384, NL = 3072;
#ifndef MK_N_LAUNCHES
#define MK_N_LAUNCHES 1
#endif
constexpr int N_PHASES = 12;

constexpr size_t WS_CTL = 0, CTL_BYTES = 1u << 20;
constexpr size_t WS_W1GU = CTL_BYTES;
constexpr size_t WS_W1D = WS_W1GU + (size_t)2 * FF * D * 2;
constexpr size_t WS_WIN = WS_W1D + (size_t)D * FF * 2;
constexpr size_t WS_WLORA = WS_WIN + (size_t)NIN * D * 2;
constexpr size_t WS_WOUT = WS_WLORA + (size_t)NL * KL * 2;
constexpr size_t WS_W2GU = WS_WOUT + (size_t)D * D * 2;
constexpr size_t WS_W2D = WS_W2GU + (size_t)2 * FF * D * 2;
constexpr size_t WS_SS = WS_W2D + (size_t)D * FF * 2;
constexpr size_t WS_XB = WS_SS + (1u << 20);
constexpr size_t WS_R = WS_XB + (size_t)M * D * 2;
constexpr size_t R_ACT = 0;
constexpr size_t R_RKV = 0;
constexpr size_t R_HG = R_RKV + (size_t)M * 3072 * 2;
constexpr size_t R_LIN = R_HG + (size_t)M * 4096 * 2;
constexpr size_t R_X2B = (size_t)M * FF * 2;
constexpr size_t R_BYTES = R_LIN + (size_t)M * 288 * 4;
constexpr size_t WS_ALORA = WS_R + R_BYTES;
constexpr size_t WS_LOUT = WS_ALORA + (size_t)M * KL * 2;
constexpr size_t WS_INVN = WS_LOUT + (size_t)M * NL * 2;
constexpr size_t WS_END = WS_INVN + (size_t)M * RH * 4;
static_assert(R_X2B + (size_t)M * D * 2 <= R_BYTES && WS_END <= ((size_t)1 << 30), "d_ws map");
constexpr int CW_BAR = 4096;

constexpr int RING_BYTES = 131072;
constexpr int LDSCTL_OFF = RING_BYTES, MISC_OFF = LDSCTL_OFF + 320;
constexpr int LDS_BYTES = 147456;
static_assert(MISC_OFF + 128 <= LDS_BYTES, "LDS map");

#define GAS __attribute__((address_space(1)))
#define LAS __attribute__((address_space(3)))
typedef unsigned short bf16;
typedef unsigned v4u __attribute__((ext_vector_type(4)));
typedef unsigned v2u __attribute__((ext_vector_type(2)));
typedef float f32x4 __attribute__((ext_vector_type(4)));
#define LDS_WAIT() asm volatile("s_waitcnt lgkmcnt(0)" ::: "memory")
#define VM_WAIT() asm volatile("s_waitcnt vmcnt(0)" ::: "memory")
__device__ __forceinline__ float bflo(unsigned u) { return __builtin_bit_cast(float, u << 16); }
__device__ __forceinline__ float bfhi(unsigned u) { return __builtin_bit_cast(float, u & 0xffff0000u); }
__device__ __forceinline__ f32x4 unpack4(v2u w) { return (f32x4){bflo(w.x), bfhi(w.x), bflo(w.y), bfhi(w.y)}; }
__device__ __forceinline__ unsigned pk2(float lo, float hi) { return pg8::cvt_pk_bf16(lo, hi); }
__device__ __forceinline__ v2u pack4(f32x4 v) { v2u w; w.x = pk2(v[0], v[1]); w.y = pk2(v[2], v[3]); return w; }
using pg8::fast_sigmoid;
using pg8::fast_silu;
template <int CTRL> __device__ __forceinline__ float dpp_mov(float x) { return __builtin_bit_cast(float, __builtin_amdgcn_update_dpp(0, __builtin_bit_cast(int, x), CTRL, 0xF, 0xF, true)); }
__device__ __forceinline__ float row16_sum(float x) { x += dpp_mov<0x128>(x); x += dpp_mov<0x124>(x); x += dpp_mov<0x122>(x); x += dpp_mov<0x121>(x); return x; }
template <int CTRL, int BANK> __device__ __forceinline__ float dpp_upd(float old, float x) { return __builtin_bit_cast(float, __builtin_amdgcn_update_dpp(__builtin_bit_cast(int, old), __builtin_bit_cast(int, x), CTRL, 0xF, BANK, false)); }
__device__ __forceinline__ float tr_reduce16(const float (&v)[16], int lane) {
    float u[8], w[4], x[2];
#pragma unroll
    for (int s = 0; s < 8; ++s) { const float t = v[s + 8] + dpp_mov<0x128>(v[s + 8]), a = v[s] + dpp_mov<0x128>(v[s]); u[s] = dpp_upd<0xE4, 0x3>(t, a); }
#pragma unroll
    for (int s = 0; s < 4; ++s) { const float t = u[s + 4] + dpp_mov<0x141>(u[s + 4]), a = u[s] + dpp_mov<0x141>(u[s]); w[s] = dpp_upd<0xE4, 0x5>(t, a); }
    const bool b1 = (lane & 2) != 0, b0 = (lane & 1) != 0;
#pragma unroll
    for (int s = 0; s < 2; ++s) { const float K = b1 ? w[s + 2] : w[s], T = b1 ? w[s] : w[s + 2]; x[s] = K + dpp_mov<0x1B>(T); }
    const float K = b0 ? x[1] : x[0], T = b0 ? x[0] : x[1];
    return K + dpp_mov<0xB1>(T);
}
typedef float f32x2 __attribute__((ext_vector_type(2)));
#define LO2(v) __builtin_shufflevector(v, v, 0, 1)
#define HI2(v) __builtin_shufflevector(v, v, 2, 3)
__device__ __forceinline__ float wave_sum(float v) {
#pragma unroll
    for (int o = 1; o < 64; o <<= 1) v += __shfl_xor(v, o);
    return v;
}
#define XB_TMO      128
#define XB_XCNT(j)  (256  + 64 * (j))
#define XB_XSUB(j)  (1280 + 64 * (j))
#define XB_XGEN(j)  (2304 + 64 * (j))
#define XB_TOP      3328
#define XB_TOPGEN   3392
#define XCD_BAR_WORDS 3456
#define XB_SPIN_CAP (1u << 18)

__device__ __forceinline__ unsigned xb_ld(unsigned* p)              { return __hip_atomic_load(p, __ATOMIC_RELAXED, __HIP_MEMORY_SCOPE_AGENT); }
__device__ __forceinline__ unsigned xb_add(unsigned* p, unsigned v) { return __hip_atomic_fetch_add(p, v, __ATOMIC_RELAXED, __HIP_MEMORY_SCOPE_AGENT); }
__device__ __forceinline__ unsigned xb_xcc_id() { return (unsigned)__builtin_amdgcn_s_getreg((3 << 11) | 20) & 0xFu; }
#define XB_SPIN(cond, bar) do { unsigned _sp = 0; while (cond) { __builtin_amdgcn_s_sleep(1); \
    if ((++_sp & 255u) == 0u) { if (xb_ld(&(bar)[XB_TMO])) break; if (_sp > XB_SPIN_CAP) { atomicAdd(&(bar)[XB_TMO], 1u); break; } } } } while (0)

struct XcdBarrier {
    unsigned* bar; unsigned x;
    volatile LAS unsigned* st;
};

__device__ __forceinline__ XcdBarrier xcd_barrier_post(unsigned* bar, volatile LAS unsigned* st) {
    XcdBarrier b; b.bar = bar; b.x = xb_xcc_id(); b.st = st;
    if (threadIdx.x == 0) (void)xb_add(&bar[XB_XCNT(b.x)], 1u);
    return b;
}
__device__ __forceinline__ void xcd_barrier_complete(unsigned* bar, unsigned x, unsigned& nloc, unsigned& nx) {
    const unsigned G = gridDim.x * gridDim.y * gridDim.z;
    unsigned sum, cnt, mine, sp = 0u;
    for (;;) {
        sum = 0u; cnt = 0u; mine = 0u;
#pragma unroll
        for (unsigned j = 0; j < 16; ++j) { const unsigned c = xb_ld(&bar[XB_XCNT(j)]); sum += c; cnt += (c > 0u) ? 1u : 0u; mine = (j == x) ? c : mine; }
        if (sum == G) break;
        __builtin_amdgcn_s_sleep(1);
        if ((++sp & 255u) == 0u) { if (xb_ld(&bar[XB_TMO])) break; if (sp > XB_SPIN_CAP) { atomicAdd(&bar[XB_TMO], 1u); break; } }
    }
    nloc = mine > 0u ? mine : 1u; nx = cnt > 0u ? cnt : 1u;
}

__device__ __forceinline__ void xcd_barrier(const XcdBarrier& b) {
    asm volatile("s_waitcnt vmcnt(0)" ::: "memory");
    __syncthreads();
    if (threadIdx.x == 0) {
        unsigned* bar = b.bar;
        __builtin_amdgcn_s_waitcnt(0);
        unsigned nloc = b.st[0], nx = b.st[1];
        if (nloc == 0u) { xcd_barrier_complete(bar, b.x, nloc, nx); b.st[0] = nloc; b.st[1] = nx; }
        const unsigned old = xb_add(&bar[XB_XSUB(b.x)], 1u);
        const unsigned gen = old / nloc;
        if (old + 1u == (gen + 1u) * nloc) {
            __builtin_amdgcn_fence(__ATOMIC_RELEASE, "agent");
            asm volatile("s_waitcnt vmcnt(0)" ::: "memory");
            const unsigned og = xb_add(&bar[XB_TOP], 1u);
            const unsigned tg = og / nx;
            if (og + 1u == (tg + 1u) * nx) xb_add(&bar[XB_TOPGEN], 1u);
            else XB_SPIN(xb_ld(&bar[XB_TOPGEN]) == tg, bar);
            __builtin_amdgcn_fence(__ATOMIC_ACQUIRE, "agent");
            xb_add(&bar[XB_XGEN(b.x)], 1u);
            asm volatile("s_waitcnt vmcnt(0)" ::: "memory");
        } else {
            XB_SPIN(xb_ld(&bar[XB_XGEN(b.x)]) == gen, bar);
            __builtin_amdgcn_fence(__ATOMIC_ACQUIRE, "agent");
            asm volatile("s_waitcnt vmcnt(0)" ::: "memory");
        }
    }
    __syncthreads();
}

struct Frame {
    LAS unsigned char* lds;
    int tid, lane, wave, vcu, G;
    const float* in[26];
    float* out; unsigned char* ws;
};
#define WSP(T, off) ((T*)(F.ws + (off)))
struct Args { const float* in[26]; float* out; unsigned char* ws; int ph_lo, ph_hi; };

__device__ __forceinline__ void p0_transpose_item(const float* W, const float* gain, int K, int N, bf16* WT, int kb, int n0, int drow0, LAS float* scr, int lane) {
    const int k0 = 64 * kb;
#pragma unroll 8
    for (int i = 0; i < 32; ++i) { const int kk = 2 * i + (lane >> 5); const float gsc = gain ? gain[k0 + kk] : 1.0f; scr[kk * 33 + (lane & 31)] = W[(size_t)(k0 + kk) * N + n0 + (lane & 31)] * gsc; }
    LDS_WAIT(); asm volatile("" ::: "memory");
    const int c = lane & 7;
#pragma unroll
    for (int j = 0; j < 4; ++j) { const int n = (lane >> 3) + 8 * j; const LAS float* s = scr + (8 * c) * 33 + n;
        v4u o; o.x = pk2(s[0 * 33], s[1 * 33]); o.y = pk2(s[2 * 33], s[3 * 33]); o.z = pk2(s[4 * 33], s[5 * 33]); o.w = pk2(s[6 * 33], s[7 * 33]);
        *(GAS v4u*)(WT + (size_t)(drow0 + n) * K + k0 + 8 * c) = o; }
    LDS_WAIT(); asm volatile("" ::: "memory");
}
__device__ __forceinline__ int map_gu(int n0, int which) { return (n0 >> 7) * 256 + which * 128 + (n0 & 127); }
__device__ __forceinline__ void p0_prologue(Frame& F, const Args& A) {
    LAS float* scr = (LAS float*)(F.lds + F.wave * 16384);
    const int gw = F.vcu * NWAVES + F.wave, NGW = F.G * NWAVES;
    constexpr int I_GU = (D / 64) * (FF / 32);
    constexpr int I_DN = (FF / 64) * (D / 32);
    constexpr int I_IN = (D / 64) * (IN_COLS / 32);
    constexpr int I_OUT = (D / 64) * (D / 32);
    constexpr int NITEMS = 4 * I_GU + 2 * I_DN + I_IN + I_OUT;
    for (int it = gw; it < NITEMS; it += NGW) {
        int r = it;
        if (r < 4 * I_GU) { const int mat = r / I_GU; r -= mat * I_GU; const int nblk = FF / 32, kb = r / nblk, n0 = 32 * (r % nblk);
            const int ffn = mat >> 1, which = mat & 1;
            p0_transpose_item(A.in[2 + 20 * ffn + which], A.in[1 + 20 * ffn], D, FF, WSP(bf16, ffn ? WS_W2GU : WS_W1GU), kb, n0, map_gu(n0, which), scr, F.lane); continue; }
        r -= 4 * I_GU;
        if (r < 2 * I_DN) { const int ffn = r / I_DN; r -= ffn * I_DN; const int nblk = D / 32, kb = r / nblk, n0 = 32 * (r % nblk);
            p0_transpose_item(A.in[4 + 20 * ffn], nullptr, FF, D, WSP(bf16, ffn ? WS_W2D : WS_W1D), kb, n0, n0, scr, F.lane); continue; }
        r -= 2 * I_DN;
        if (r < I_IN) { const int nblk = IN_COLS / 32, kb = r / nblk, n0 = 32 * (r % nblk);
            p0_transpose_item(F.in[6], F.in[5], D, IN_COLS, WSP(bf16, WS_WIN), kb, n0, n0 < RWKV_COLS ? n0 : n0 + 224, scr, F.lane); continue; }
        r -= I_IN;
        { const int nblk = D / 32, kb = r / nblk, n0 = 32 * (r % nblk);
            p0_transpose_item(F.in[20], nullptr, D, D, WSP(bf16, WS_WOUT), kb, n0, n0, scr, F.lane); }
    }
    const size_t gt = (size_t)F.vcu * (NWAVES * 64) + F.tid, NT = (size_t)F.G * NWAVES * 64;
    { GAS v4u* z = (GAS v4u*)(WSP(bf16, WS_WIN) + (size_t)RWKV_COLS * D);
      for (size_t i = gt; i < (size_t)224 * D * 2 / 16; i += NT) z[i] = (v4u){0u, 0u, 0u, 0u}; }
    { bf16* wl = WSP(bf16, WS_WLORA); const float* w2 = F.in[9]; const float* a2 = F.in[11]; const float* g2 = F.in[12];
      for (size_t i = gt; i < (size_t)NL * KL / 2; i += NT) { const int n = (int)(i / (KL / 2)), k = 2 * (int)(i % (KL / 2)); const int seg = n >> 10, c = n & 1023;
          float v0 = 0.f, v1 = 0.f;
          if (seg == 0) { if (k < 64) { v0 = w2[(size_t)k * RC + c]; v1 = w2[(size_t)(k + 1) * RC + c]; } }
          else if (seg == 1) { if (k >= 64 && k < 128) { v0 = a2[(size_t)(k - 64) * RC + c]; v1 = a2[(size_t)(k - 63) * RC + c]; } }
          else { if (k >= 128 && k < 288) { v0 = g2[(size_t)(k - 128) * RC + c]; v1 = g2[(size_t)(k - 127) * RC + c]; } }
          ((GAS unsigned*)wl)[i] = pk2(v0, v1); } }
    { GAS unsigned long long* s = (GAS unsigned long long*)(F.ws + WS_SS) + M;
      for (size_t i = gt; i < (size_t)2 * M; i += NT) s[i] = 0ull; }
    { const float* x = F.in[0]; bf16* xb = WSP(bf16, WS_XB); unsigned long long* ss0 = WSP(unsigned long long, WS_SS);
      for (int m = gw; m < M; m += NGW) { const GAS f32x4* xr = (const GAS f32x4*)(x + (size_t)m * D) + 2 * F.lane; GAS v4u* o = (GAS v4u*)(xb + (size_t)m * D) + F.lane; float s = 0.f;
#pragma unroll
          for (int j = 0; j < 4; ++j) { const f32x4 a = xr[128 * j], b = xr[128 * j + 1];
              s += (a[0] * a[0] + a[1] * a[1]) + (a[2] * a[2] + a[3] * a[3]) + (b[0] * b[0] + b[1] * b[1]) + (b[2] * b[2] + b[3] * b[3]);
              o[64 * j] = pg8::pack8(a, b); }
          s = wave_sum(s);
          if (F.lane == 0) ss0[m] = (unsigned long long)(s * pg8::SS_SCALE + 0.5f); } }
}

__device__ __forceinline__ void p4_lora_in(Frame& F) {
    const float* lin = WSP(float, WS_R + R_LIN); bf16* al = WSP(bf16, WS_ALORA); const float* mu = F.in[7] + 3 * RC;
    const size_t gt = (size_t)F.vcu * (NWAVES * 64) + F.tid, NT = (size_t)F.G * NWAVES * 64;
    for (size_t i = gt; i < (size_t)M * 96; i += NT) { const int m = (int)(i / 96), q = (int)(i % 96); v2u o = (v2u){0u, 0u};
        if (q < 72) { const f32x4 p = *(const GAS f32x4*)(lin + (size_t)m * 288 + 4 * q); f32x4 pp = (f32x4){0.f, 0.f, 0.f, 0.f};
            if ((m & (SEQ - 1)) != 0) pp = *(const GAS f32x4*)(lin + (size_t)(m - 1) * 288 + 4 * q);
            const f32x4 mv = *(const GAS f32x4*)(mu + 4 * q); f32x4 s = p + (pp - p) * mv;
            if (q < 16) {
#pragma unroll
                for (int j = 0; j < 4; ++j) s[j] = 2.0f * fast_sigmoid(2.0f * s[j]) - 1.0f;
            } else if (q >= 32) {
#pragma unroll
                for (int j = 0; j < 4; ++j) s[j] = fast_sigmoid(s[j]); }
            o = pack4(s); }
        *(GAS v2u*)(al + (size_t)m * KL + 4 * q) = o; }
    { const bf16* rkv = WSP(bf16, WS_R + R_RKV); float* invn = WSP(float, WS_INVN); const int j4 = (F.tid & 15) * 4;
      for (size_t it = gt >> 4; it < (size_t)M * RH; it += NT >> 4) { const int m = (int)(it >> 4), h = (int)(it & 15), ch = h * RN + j4;
          const f32x4 k = unpack4(*(const GAS v2u*)(rkv + (size_t)m * 3072 + RC + ch)); f32x4 kp = (f32x4){0.f, 0.f, 0.f, 0.f};
          if ((m & (SEQ - 1)) != 0) kp = unpack4(*(const GAS v2u*)(rkv + (size_t)(m - 1) * 3072 + RC + ch));
          const f32x4 muk = *(const f32x4*)(F.in[7] + RC + ch), kkc = *(const f32x4*)(F.in[13] + ch);
          const f32x4 kk = (k + (kp - k) * muk) * kkc; float s2 = (kk[0] * kk[0] + kk[1] * kk[1]) + (kk[2] * kk[2] + kk[3] * kk[3]); s2 = row16_sum(s2);
          if ((F.tid & 15) == 0) invn[it] = 1.0f / fmaxf(sqrtf(s2), 1e-12f); } }
}

typedef short bf16x4 __attribute__((ext_vector_type(4)));
typedef short bf16x8 __attribute__((ext_vector_type(8)));
#define MFMA32(a, b, c) __builtin_amdgcn_mfma_f32_16x16x32_bf16(a, b, c, 0, 0, 0)
#define MFMA16(a, b, c) __builtin_amdgcn_mfma_f32_16x16x16bf16_1k(a, b, c, 0, 0, 0)
__device__ __forceinline__ bf16x4 cv4(f32x4 v) { v2u w; w.x = pk2(v[0], v[1]); w.y = pk2(v[2], v[3]); return __builtin_bit_cast(bf16x4, w); }
__device__ __forceinline__ bf16x8 cv8(f32x4 a, f32x4 b) { v4u w; w.x = pk2(a[0], a[1]); w.y = pk2(a[2], a[3]); w.z = pk2(b[0], b[1]); w.w = pk2(b[2], b[3]); return __builtin_bit_cast(bf16x8, w); }
__device__ __forceinline__ bf16x8 cat8(bf16x4 a, bf16x4 b) { return __builtin_shufflevector(a, b, 0, 1, 2, 3, 4, 5, 6, 7); }
__device__ __forceinline__ bf16x8 join8(v2u a, v2u b) { v4u w; w.x = a.x; w.y = a.y; w.z = b.x; w.w = b.y; return __builtin_bit_cast(bf16x8, w); }
__device__ __forceinline__ float row16_scan(float x) { x += dpp_mov<0x111>(x); x += dpp_mov<0x112>(x); x += dpp_mov<0x114>(x); x += dpp_mov<0x118>(x); return x; }
__device__ __forceinline__ unsigned short bf1(float x) { return (unsigned short)(pk2(x, 0.f) & 0xffffu); }
constexpr int CH = 16;
constexpr int RWS = 144;
constexpr int HGS = 272;
constexpr int RWB_KG = 0, RWB_RG = 16 * RWS, RWB_KTI = 32 * RWS, RWB_BTI = 48 * RWS, RWB_KTIT = 64 * RWS, RWB_BTIT = RWB_KTIT + 2048, RWB_VT = RWB_BTIT + 2048, RWB_GL = RWB_VT + 2048, RWB_BYTES = RWB_GL + 256;
constexpr int HGB_QG = 0, HGB_KI = 16 * HGS, HGB_KIT = 32 * HGS, HGB_VT = HGB_KIT + 4096, HGB_GL = HGB_VT + 4096, HGB_BYTES = HGB_GL + 512;

__device__ __forceinline__ f32x4 padc(f32x4 r) { asm("s_nop 15" : "+v"(r)); return r; }
constexpr int NCHK = SEQ / CH;
constexpr int RWR_R = 0, RWR_K = 16 * RWS, RWR_V = 32 * RWS, RWR_LW = 48 * RWS, RWR_A = 64 * RWS, RWR_INV = 80 * RWS, RWR_BYTES = RWR_INV + 64;
constexpr int RW_OPND = 0, RW_RAW = 2 * RWB_BYTES;
constexpr int HGR_Q = 0, HGR_LF = 16 * HGS, HGR_V = 32 * HGS, HGR_BYTES = 48 * HGS;
constexpr int HG_OPND = 0, HG_RAW = 2 * HGB_BYTES;
struct RwSet { unsigned r, k, v, lw, a; float inv; };
struct HgSet { v2u q, lf, v; };

__device__ __forceinline__ void p6_rwkv_head(Frame& F, int bh) {
    const bf16* rkv = WSP(bf16, WS_R + R_RKV); const bf16* lout = WSP(bf16, WS_LOUT); const float* invn = WSP(float, WS_INVN); bf16* yc = WSP(bf16, WS_XB);
    const int lane = F.lane, c = lane & 15, g = lane >> 4, w = F.wave;
    const int b = bh >> 4, h = bh & 15;
    const size_t rowbase = (size_t)b * SEQ;
    const int tl = 2 * w + (lane >> 5), kl = lane & 31;
    const int st = lane & 15, k0 = 2 * (w * 4 + (lane >> 4)), chn = h * RN + k0;
    const float mur0 = F.in[7][chn], mur1 = F.in[7][chn + 1], muk0 = F.in[7][RC + chn], muk1 = F.in[7][RC + chn + 1], muv0 = F.in[7][2 * RC + chn], muv1 = F.in[7][2 * RC + chn + 1];
    const float kk0 = F.in[13][chn], kk1 = F.in[13][chn + 1], ka0 = F.in[14][chn], ka1 = F.in[14][chn + 1];
    LAS unsigned char* const opnd = F.lds + RW_OPND; LAS unsigned char* const raw = F.lds + RW_RAW;
#define RW3_LOAD(S, j) do { const size_t ro_ = (rowbase + (size_t)(j) * CH + tl) * 3072 + h * RN + 2 * kl; \
        (S).r = *(const GAS unsigned*)(rkv + ro_); (S).k = *(const GAS unsigned*)(rkv + ro_ + RC); (S).v = *(const GAS unsigned*)(rkv + ro_ + 2 * RC); \
        (S).lw = *(const GAS unsigned*)(lout + ro_); (S).a = *(const GAS unsigned*)(lout + ro_ + RC); (S).inv = invn[(rowbase + (size_t)(j) * CH + tl) * RH + h]; } while (0)
#define RW3_RAW(S, j) do { LAS unsigned char* d_ = raw + ((j) % 3) * RWR_BYTES + tl * RWS + kl * 4; \
        *(LAS unsigned*)(d_ + RWR_R) = (S).r; *(LAS unsigned*)(d_ + RWR_K) = (S).k; *(LAS unsigned*)(d_ + RWR_V) = (S).v; *(LAS unsigned*)(d_ + RWR_LW) = (S).lw; *(LAS unsigned*)(d_ + RWR_A) = (S).a; \
        if (kl == 0) *(LAS float*)(raw + ((j) % 3) * RWR_BYTES + RWR_INV + tl * 4) = (S).inv; } while (0)
#define RW3_PROC(j) do { const LAS unsigned char* s_ = raw + ((j) % 3) * RWR_BYTES; const LAS unsigned char* sp_ = (st > 0) ? s_ + (st - 1) * RWS : raw + (((j) + 2) % 3) * RWR_BYTES + 15 * RWS; \
        const bool first_ = ((j) == 0) && (st == 0); \
        const unsigned Lr = *(const LAS unsigned*)(s_ + RWR_R + st * RWS + k0 * 2), Lk = *(const LAS unsigned*)(s_ + RWR_K + st * RWS + k0 * 2), Lv = *(const LAS unsigned*)(s_ + RWR_V + st * RWS + k0 * 2); \
        const unsigned Lw = *(const LAS unsigned*)(s_ + RWR_LW + st * RWS + k0 * 2), La = *(const LAS unsigned*)(s_ + RWR_A + st * RWS + k0 * 2); \
        const unsigned Lrp = *(const LAS unsigned*)(sp_ + RWR_R + k0 * 2), Lkp = *(const LAS unsigned*)(sp_ + RWR_K + k0 * 2), Lvp = *(const LAS unsigned*)(sp_ + RWR_V + k0 * 2); \
        const float Linv = *(const LAS float*)(s_ + RWR_INV + st * 4); \
        const float r0_ = bflo(Lr), r1_ = bfhi(Lr), q0_ = bflo(Lk), q1_ = bfhi(Lk), v0_ = bflo(Lv), v1_ = bfhi(Lv); \
        const float rp0_ = first_ ? 0.f : bflo(Lrp), rp1_ = first_ ? 0.f : bfhi(Lrp), qp0_ = first_ ? 0.f : bflo(Lkp), qp1_ = first_ ? 0.f : bfhi(Lkp), vp0_ = first_ ? 0.f : bflo(Lvp), vp1_ = first_ ? 0.f : bfhi(Lvp); \
        const float rs0_ = r0_ + (rp0_ - r0_) * mur0, rs1_ = r1_ + (rp1_ - r1_) * mur1, ks0_ = q0_ + (qp0_ - q0_) * muk0, ks1_ = q1_ + (qp1_ - q1_) * muk1, vs0_ = v0_ + (vp0_ - v0_) * muv0, vs1_ = v1_ + (vp1_ - v1_) * muv1; \
        const float a0_ = bflo(La), a1_ = bfhi(La), lw0_ = bflo(Lw) * 1.44269504f, lw1_ = bfhi(Lw) * 1.44269504f; \
        const float kap0_ = ks0_ * kk0 * Linv, kap1_ = ks1_ * kk1 * Linv, bet0_ = kap0_ * a0_, bet1_ = kap1_ * a1_; \
        const float kt0_ = ks0_ * (1.0f + (a0_ - 1.0f) * ka0), kt1_ = ks1_ * (1.0f + (a1_ - 1.0f) * ka1); \
        const float G0_ = row16_scan(lw0_), G1_ = row16_scan(lw1_); \
        const float eg0_ = __builtin_amdgcn_exp2f(G0_), eg1_ = __builtin_amdgcn_exp2f(G1_), ep0_ = __builtin_amdgcn_exp2f(G0_ - lw0_), ep1_ = __builtin_amdgcn_exp2f(G1_ - lw1_), ei0_ = __builtin_amdgcn_exp2f(-G0_), ei1_ = __builtin_amdgcn_exp2f(-G1_); \
        LAS unsigned char* d_ = opnd + ((j) & 1) * RWB_BYTES; \
        *(LAS unsigned*)(d_ + RWB_KG + st * RWS + k0 * 2) = pk2(kap0_ * ep0_, kap1_ * ep1_); *(LAS unsigned*)(d_ + RWB_RG + st * RWS + k0 * 2) = pk2(rs0_ * eg0_, rs1_ * eg1_); \
        const unsigned kti_ = pk2(kt0_ * ei0_, kt1_ * ei1_), bti_ = pk2(bet0_ * ei0_, bet1_ * ei1_), vv_ = pk2(vs0_, vs1_); \
        *(LAS unsigned*)(d_ + RWB_KTI + st * RWS + k0 * 2) = kti_; *(LAS unsigned*)(d_ + RWB_BTI + st * RWS + k0 * 2) = bti_; \
        *(LAS unsigned short*)(d_ + RWB_KTIT + k0 * 32 + st * 2) = (unsigned short)(kti_ & 0xffffu); *(LAS unsigned short*)(d_ + RWB_KTIT + (k0 + 1) * 32 + st * 2) = (unsigned short)(kti_ >> 16); \
        *(LAS unsigned short*)(d_ + RWB_BTIT + k0 * 32 + st * 2) = (unsigned short)(bti_ & 0xffffu); *(LAS unsigned short*)(d_ + RWB_BTIT + (k0 + 1) * 32 + st * 2) = (unsigned short)(bti_ >> 16); \
        *(LAS unsigned short*)(d_ + RWB_VT + k0 * 32 + st * 2) = (unsigned short)(vv_ & 0xffffu); *(LAS unsigned short*)(d_ + RWB_VT + (k0 + 1) * 32 + st * 2) = (unsigned short)(vv_ >> 16); \
        if (st == 15) { *(LAS float*)(d_ + RWB_GL + k0 * 4) = eg0_; *(LAS float*)(d_ + RWB_GL + k0 * 4 + 4) = eg1_; } } while (0)
#define WG_BAR() do { LDS_WAIT(); __builtin_amdgcn_s_barrier(); asm volatile("" ::: "memory"); } while (0)
    f32x4 Z[4];
#pragma unroll
    for (int i = 0; i < 4; ++i) Z[i] = (f32x4){0.f, 0.f, 0.f, 0.f};
    const f32x4 zero4 = (f32x4){0.f, 0.f, 0.f, 0.f};
    RwSet S0, S1, S2;
    { RwSet Sa, Sb; RW3_LOAD(Sa, 0); RW3_LOAD(Sb, 1); RW3_LOAD(S0, 2); RW3_LOAD(S1, 3);
      RW3_RAW(Sa, 0); RW3_RAW(Sb, 1); WG_BAR(); RW3_PROC(0); WG_BAR(); }
    for (int ci = 0; ci < NCHK; ++ci) {
        const int t0 = ci * CH; const LAS unsigned char* cur = opnd + (ci & 1) * RWB_BYTES;
        if (ci + 4 < NCHK) RW3_LOAD(S2, ci + 4);
        if (ci + 1 < NCHK) RW3_PROC(ci + 1);
        if (w < 4) {
            const LAS unsigned char* rowp = cur + c * RWS;
            bf16x8 nKg[2], nRg[2], nKti[2], nBti[2], pKg[2], pRg[2];
#pragma unroll
            for (int s = 0; s < 2; ++s) {
                nKg[s] = *(const LAS bf16x8*)(rowp + RWB_KG + 64 * s + 16 * g); nRg[s] = *(const LAS bf16x8*)(rowp + RWB_RG + 64 * s + 16 * g);
                nKti[s] = *(const LAS bf16x8*)(rowp + RWB_KTI + 64 * s + 16 * g); nBti[s] = *(const LAS bf16x8*)(rowp + RWB_BTI + 64 * s + 16 * g);
                pKg[s] = join8(*(const LAS v2u*)(rowp + RWB_KG + 64 * s + 8 * g), *(const LAS v2u*)(rowp + RWB_KG + 64 * s + 32 + 8 * g));
                pRg[s] = join8(*(const LAS v2u*)(rowp + RWB_RG + 64 * s + 8 * g), *(const LAS v2u*)(rowp + RWB_RG + 64 * s + 32 + 8 * g)); }
            const bf16x4 bV = *(const LAS bf16x4*)(cur + RWB_VT + (16 * w + c) * 32 + 8 * g);
            f32x4 N1 = MFMA32(nBti[0], nKg[0], zero4); N1 = MFMA32(nBti[1], nKg[1], N1);
            f32x4 N1t = MFMA32(nKg[0], nBti[0], zero4); N1t = MFMA32(nKg[1], nBti[1], N1t);
            f32x4 N2 = MFMA32(nKti[0], nKg[0], zero4); N2 = MFMA32(nKti[1], nKg[1], N2);
            f32x4 N3 = MFMA32(nKti[0], nRg[0], zero4); N3 = MFMA32(nKti[1], nRg[1], N3);
            f32x4 N4 = MFMA32(nBti[0], nRg[0], zero4); N4 = MFMA32(nBti[1], nRg[1], N4);
            f32x4 X;
#pragma unroll
            for (int r = 0; r < 4; ++r) { const int rj = 4 * g + r;
                N1[r] = (c > rj) ? N1[r] : 0.f; N1t[r] = (rj > c) ? N1t[r] : 0.f; N2[r] = (c > rj) ? N2[r] : 0.f; N3[r] = (c >= rj) ? N3[r] : 0.f; N4[r] = (c >= rj) ? N4[r] : 0.f;
                X[r] = ((rj == c) ? 1.0f : 0.f) - N1[r]; }
            {
                bf16x4 an = cv4(N1), at = cv4(N1t);
                f32x4 P = MFMA16(at, an, zero4), Pt = MFMA16(an, at, zero4);
                X = MFMA16(cv4(Pt), cv4(X), padc(X));
                an = cv4(P); at = cv4(Pt);
                P = MFMA16(at, an, zero4); Pt = MFMA16(an, at, zero4);
                X = MFMA16(cv4(Pt), cv4(X), padc(X));
                an = cv4(P); at = cv4(Pt);
                Pt = MFMA16(an, at, zero4);
                X = MFMA16(cv4(Pt), cv4(X), padc(X));
            }
            const bf16x8 bZ0 = cv8(Z[0], Z[1]), bZ1 = cv8(Z[2], Z[3]);
            const bf16x4 z4 = (bf16x4){0, 0, 0, 0};
            f32x4 W = MFMA32(pKg[0], bZ0, zero4); W = MFMA32(pKg[1], bZ1, W); W = MFMA32(cat8(cv4(N2), z4), cat8(bV, z4), W);
            const f32x4 U = MFMA16(cv4(X), cv4(W), zero4);
            const bf16x4 nU = cv4(-U);
            const bf16x8 bVU = cat8(bV, nU);
            f32x4 Y = MFMA32(pRg[0], bZ0, zero4); Y = MFMA32(pRg[1], bZ1, Y); Y = MFMA32(cat8(cv4(N3), cv4(N4)), bVU, Y);
#pragma unroll
            for (int r = 0; r < 4; ++r) yc[(rowbase + t0 + 4 * g + r) * 2048 + h * RN + 16 * w + c] = bf1(Y[r]);
#pragma unroll
            for (int zt = 0; zt < 4; ++zt) {
                const bf16x4 aK = *(const LAS bf16x4*)(cur + RWB_KTIT + (16 * zt + c) * 32 + 8 * g), aB = *(const LAS bf16x4*)(cur + RWB_BTIT + (16 * zt + c) * 32 + 8 * g);
                const f32x4 gl = *(const LAS f32x4*)(cur + RWB_GL + (16 * zt + 4 * g) * 4);
                Z[zt] = MFMA32(cat8(aK, aB), bVU, Z[zt]) * gl; }
        }
        if (ci + 2 < NCHK) RW3_RAW(S0, ci + 2);
        S0 = S1; S1 = S2;
        WG_BAR();
    }
#undef RW3_LOAD
#undef RW3_RAW
#undef RW3_PROC
}

__device__ __forceinline__ void p6_hgrn_head(Frame& F, int bh) {
    const bf16* hg = WSP(bf16, WS_R + R_HG); bf16* yc = WSP(bf16, WS_XB);
    const int lane = F.lane, c = lane & 15, g = lane >> 4, w = F.wave;
    const int b = bh >> 3, h = bh & 7;
    const size_t rowbase = (size_t)b * SEQ;
    const int tl = 2 * w + (lane >> 5), kl = lane & 31;
    const int st = lane & 15, k0 = 4 * (w * 4 + (lane >> 4));
    LAS unsigned char* const opnd = F.lds + HG_OPND; LAS unsigned char* const raw = F.lds + HG_RAW;
#define HG3_LOAD(S, j) do { const bf16* p_ = hg + (rowbase + (size_t)(j) * CH + tl) * 4096 + h * HD + 4 * kl; (S).q = *(const GAS v2u*)(p_); (S).lf = *(const GAS v2u*)(p_ + HC); (S).v = *(const GAS v2u*)(p_ + 2 * HC); } while (0)
#define HG3_RAW(S, j) do { LAS unsigned char* d_ = raw + ((j) & 1) * HGR_BYTES + tl * HGS + kl * 8; *(LAS v2u*)(d_ + HGR_Q) = (S).q; *(LAS v2u*)(d_ + HGR_LF) = (S).lf; *(LAS v2u*)(d_ + HGR_V) = (S).v; } while (0)
#define HG3_PROC(j) do { const LAS unsigned char* s_ = raw + ((j) & 1) * HGR_BYTES + st * HGS + k0 * 2; LAS unsigned char* d_ = opnd + ((j) & 1) * HGB_BYTES; \
        const v2u Lq = *(const LAS v2u*)(s_ + HGR_Q), Lf = *(const LAS v2u*)(s_ + HGR_LF), Lv = *(const LAS v2u*)(s_ + HGR_V); \
        const f32x4 q_ = unpack4(Lq); f32x4 lf_ = unpack4(Lf) * 1.44269504f; f32x4 qg_, ki_, eg_; \
        _Pragma("unroll") for (int e = 0; e < 4; ++e) { const float G_ = row16_scan(lf_[e]); eg_[e] = __builtin_amdgcn_exp2f(G_); qg_[e] = q_[e] * eg_[e]; ki_[e] = (1.0f - __builtin_amdgcn_exp2f(lf_[e])) * __builtin_amdgcn_exp2f(-G_); } \
        const v2u kw_ = pack4(ki_); *(LAS v2u*)(d_ + HGB_QG + st * HGS + k0 * 2) = pack4(qg_); *(LAS v2u*)(d_ + HGB_KI + st * HGS + k0 * 2) = kw_; \
        *(LAS unsigned short*)(d_ + HGB_KIT + (k0 + 0) * 32 + st * 2) = (unsigned short)(kw_.x & 0xffffu); *(LAS unsigned short*)(d_ + HGB_KIT + (k0 + 1) * 32 + st * 2) = (unsigned short)(kw_.x >> 16); \
        *(LAS unsigned short*)(d_ + HGB_KIT + (k0 + 2) * 32 + st * 2) = (unsigned short)(kw_.y & 0xffffu); *(LAS unsigned short*)(d_ + HGB_KIT + (k0 + 3) * 32 + st * 2) = (unsigned short)(kw_.y >> 16); \
        *(LAS unsigned short*)(d_ + HGB_VT + (k0 + 0) * 32 + st * 2) = (unsigned short)(Lv.x & 0xffffu); *(LAS unsigned short*)(d_ + HGB_VT + (k0 + 1) * 32 + st * 2) = (unsigned short)(Lv.x >> 16); \
        *(LAS unsigned short*)(d_ + HGB_VT + (k0 + 2) * 32 + st * 2) = (unsigned short)(Lv.y & 0xffffu); *(LAS unsigned short*)(d_ + HGB_VT + (k0 + 3) * 32 + st * 2) = (unsigned short)(Lv.y >> 16); \
        if (st == 15) *(LAS f32x4*)(d_ + HGB_GL + k0 * 4) = eg_; } while (0)
    f32x4 Z[8];
#pragma unroll
    for (int i = 0; i < 8; ++i) Z[i] = (f32x4){0.f, 0.f, 0.f, 0.f};
    const f32x4 zero4 = (f32x4){0.f, 0.f, 0.f, 0.f};
    HgSet S0, S1, S2;
    { HgSet Sa, Sb; HG3_LOAD(Sa, 0); HG3_LOAD(Sb, 1); HG3_LOAD(S0, 2); HG3_LOAD(S1, 3);
      HG3_RAW(Sa, 0); HG3_RAW(Sb, 1); WG_BAR(); HG3_PROC(0); WG_BAR(); }
    for (int ci = 0; ci < NCHK; ++ci) {
        const int t0 = ci * CH; const LAS unsigned char* cur = opnd + (ci & 1) * HGB_BYTES;
        if (ci + 4 < NCHK) HG3_LOAD(S2, ci + 4);
        if (ci + 1 < NCHK) HG3_PROC(ci + 1);
        {
            const LAS unsigned char* rowp = cur + c * HGS;
            f32x4 N = zero4, Y = zero4;
#pragma unroll
            for (int s = 0; s < 4; ++s) {
                const bf16x8 nQ = *(const LAS bf16x8*)(rowp + HGB_QG + 64 * s + 16 * g), nK = *(const LAS bf16x8*)(rowp + HGB_KI + 64 * s + 16 * g);
                N = MFMA32(nK, nQ, N);
                const bf16x8 pQ = join8(*(const LAS v2u*)(rowp + HGB_QG + 64 * s + 8 * g), *(const LAS v2u*)(rowp + HGB_QG + 64 * s + 32 + 8 * g));
                Y = MFMA32(pQ, cv8(Z[2 * s], Z[2 * s + 1]), Y); }
#pragma unroll
            for (int r = 0; r < 4; ++r) N[r] = (c >= 4 * g + r) ? N[r] : 0.f;
            const bf16x4 bV = *(const LAS bf16x4*)(cur + HGB_VT + (16 * w + c) * 32 + 8 * g);
            const bf16x4 z4 = (bf16x4){0, 0, 0, 0};
            Y = MFMA32(cat8(cv4(N), z4), cat8(bV, z4), Y);
#pragma unroll
            for (int r = 0; r < 4; ++r) yc[(rowbase + t0 + 4 * g + r) * 2048 + RC + h * HD + 16 * w + c] = bf1(Y[r]);
#pragma unroll
            for (int zt = 0; zt < 8; ++zt) {
                const bf16x4 aK = *(const LAS bf16x4*)(cur + HGB_KIT + (16 * zt + c) * 32 + 8 * g);
                const f32x4 gl = *(const LAS f32x4*)(cur + HGB_GL + (16 * zt + 4 * g) * 4);
                Z[zt] = MFMA16(aK, bV, Z[zt]) * gl; }
        }
        if (ci + 2 < NCHK) HG3_RAW(S0, ci + 2);
        S0 = S1; S1 = S2;
        WG_BAR();
    }
#undef HG3_LOAD
#undef HG3_RAW
#undef HG3_PROC
#undef WG_BAR
}
__device__ __forceinline__ void p6_scans(Frame& F) {
    for (int u = (int)blockIdx.x; u < BATCH * RH + BATCH * HH; u += F.G) {
        if (u < BATCH * RH) p6_rwkv_head(F, u); else p6_hgrn_head(F, u - BATCH * RH);
    }
}

__device__ __forceinline__ void p7_post(Frame& F) {
    const bf16* rkv = WSP(bf16, WS_R + R_RKV); const bf16* hg = WSP(bf16, WS_R + R_HG); const bf16* lout = WSP(bf16, WS_LOUT); bf16* yc = WSP(bf16, WS_XB);
    { const int half = F.tid >> 8, ch = (F.tid & 255) * 4;
      const f32x4 mu_r = *(const f32x4*)(F.in[7] + ch), mu_k = *(const f32x4*)(F.in[7] + RC + ch), mu_v = *(const f32x4*)(F.in[7] + 2 * RC + ch);
      const f32x4 kac = *(const f32x4*)(F.in[14] + ch), rkc = *(const f32x4*)(F.in[15] + ch), lnw = *(const f32x4*)(F.in[16] + ch), lnb = *(const f32x4*)(F.in[17] + ch);
      for (int m = F.vcu * 2 + half; m < M; m += 2 * F.G) {
          const bool first = (m & (SEQ - 1)) == 0; const size_t mp = first ? m : m - 1;
          const bf16* p = rkv + (size_t)m * 3072 + ch; const bf16* q = rkv + mp * 3072 + ch; const bf16* l = lout + (size_t)m * 3072 + ch;
          const f32x4 y = unpack4(*(const GAS v2u*)(yc + (size_t)m * 2048 + ch));
          const f32x4 r = unpack4(*(const GAS v2u*)(p)), k = unpack4(*(const GAS v2u*)(p + RC)), v = unpack4(*(const GAS v2u*)(p + 2 * RC));
          f32x4 rp = unpack4(*(const GAS v2u*)(q)), kp = unpack4(*(const GAS v2u*)(q + RC)), vp = unpack4(*(const GAS v2u*)(q + 2 * RC));
          if (first) { rp = (f32x4){0.f, 0.f, 0.f, 0.f}; kp = rp; vp = rp; }
          const f32x4 a = unpack4(*(const GAS v2u*)(l + RC)), gg = unpack4(*(const GAS v2u*)(l + 2 * RC));
          const f32x4 rs = r + (rp - r) * mu_r, ks = k + (kp - k) * mu_k, vs = v + (vp - v) * mu_v;
          const f32x4 km = ks * (1.0f + (a - 1.0f) * kac);
          const f32x4 bt = rs * km * rkc; float bon = (bt[0] + bt[1]) + (bt[2] + bt[3]); bon = row16_sum(bon);
          float s1 = (y[0] + y[1]) + (y[2] + y[3]); s1 = row16_sum(s1); const float mean = s1 * (1.0f / 64.0f);
          const f32x4 d = y - mean; float s2 = (d[0] * d[0] + d[1] * d[1]) + (d[2] * d[2] + d[3] * d[3]); s2 = row16_sum(s2);
          const float rstd = 1.0f / sqrtf(s2 * (1.0f / 64.0f) + 64e-5f);
          const f32x4 o = ((d * rstd) * lnw + lnb + vs * bon) * gg;
          *(GAS v2u*)(yc + (size_t)m * 2048 + ch) = pack4(o); } }
    { const int quarter = F.tid >> 7, ch = (F.tid & 127) * 8;
      const f32x4 nw0 = *(const f32x4*)(F.in[19] + ch), nw1 = *(const f32x4*)(F.in[19] + ch + 4);
      for (int m = F.vcu * 4 + quarter; m < M; m += 4 * F.G) {
          const v4u ow = *(const GAS v4u*)(yc + (size_t)m * 2048 + RC + ch), gw4 = *(const GAS v4u*)(hg + (size_t)m * 4096 + 3 * HC + ch);
          const f32x4 o0 = (f32x4){bflo(ow.x), bfhi(ow.x), bflo(ow.y), bfhi(ow.y)}, o1 = (f32x4){bflo(ow.z), bfhi(ow.z), bflo(ow.w), bfhi(ow.w)};
          const f32x4 g0 = (f32x4){bflo(gw4.x), bfhi(gw4.x), bflo(gw4.y), bfhi(gw4.y)}, g1 = (f32x4){bflo(gw4.z), bfhi(gw4.z), bflo(gw4.w), bfhi(gw4.w)};
          float s2 = ((o0[0] * o0[0] + o0[1] * o0[1]) + (o0[2] * o0[2] + o0[3] * o0[3])) + ((o1[0] * o1[0] + o1[1] * o1[1]) + (o1[2] * o1[2] + o1[3] * o1[3])); s2 = row16_sum(s2);
          const float rstd = 1.0f / sqrtf(s2 * (1.0f / 128.0f) + 1e-6f);
          *(GAS v4u*)(yc + (size_t)m * 2048 + RC + ch) = pg8::pack8(o0 * rstd * nw0 * g0, o1 * rstd * nw1 * g1); } }
}

__device__ __forceinline__ void p11_final(Frame& F) {
    const int gw = F.vcu * NWAVES + F.wave, NGW = F.G * NWAVES; const float* fg = F.in[25];
    f32x4 gn[8];
#pragma unroll
    for (int i = 0; i < 8; ++i) gn[i] = *(const f32x4*)(fg + 4 * F.lane + 256 * i);
    for (int m = gw; m < M; m += NGW) { GAS f32x4* xr = (GAS f32x4*)(F.out + (size_t)m * D) + F.lane; f32x4 v[8]; float s = 0.f;
#pragma unroll
        for (int i = 0; i < 8; ++i) { v[i] = xr[64 * i]; s += (v[i][0] * v[i][0] + v[i][1] * v[i][1]) + (v[i][2] * v[i][2] + v[i][3] * v[i][3]); }
        s = wave_sum(s); const float inv = 1.0f / sqrtf(s * (1.0f / D) + 1e-6f);
#pragma unroll
        for (int i = 0; i < 8; ++i) xr[64 * i] = v[i] * inv * gn[i]; }
}

__global__ void __launch_bounds__(NWAVES * 64, 2) mk_fwd(Args args) {
    extern __shared__ __attribute__((aligned(16))) unsigned char lds[];
    Frame F;
    F.lds = (LAS unsigned char*)lds;
    F.tid = threadIdx.x; F.lane = F.tid & 63; F.wave = __builtin_amdgcn_readfirstlane(F.tid >> 6);
    F.G = gridDim.x; { const int bx = blockIdx.x; F.vcu = (F.G % 8 == 0) ? (bx % 8) * (F.G / 8) + bx / 8 : bx; }
#pragma unroll
    for (int i = 0; i < 26; ++i) F.in[i] = args.in[i];
    F.out = args.out; F.ws = args.ws;
    for (int u = F.tid; u < (LDS_BYTES - LDSCTL_OFF) / 4; u += NWAVES * 64) ((LAS unsigned*)(F.lds + LDSCTL_OFF))[u] = 0u;
    __syncthreads();
    const int lo = args.ph_lo, hi = args.ph_hi;
    XcdBarrier bar; bar.bar = (unsigned*)(args.ws + WS_CTL) + CW_BAR; bar.x = 0; bar.st = nullptr;
    if (hi - lo > 1) bar = xcd_barrier_post((unsigned*)(args.ws + WS_CTL) + CW_BAR, (volatile LAS unsigned*)(F.lds + MISC_OFF) + 8);
#ifndef PH_MASK
#define PH_MASK 0xFFF
#endif
#define IN(k) (((PH_MASK >> (k)) & 1) && lo <= (k) && (k) < hi)
#define SEAM(k) do { if (IN(k) && IN((k) + 1)) xcd_barrier(bar); } while (0)
    const bf16* xb = WSP(bf16, WS_XB); unsigned long long* ss = WSP(unsigned long long, WS_SS);
    const int cid = (int)blockIdx.x;

    if (IN(0)) { p0_prologue(F, args); } SEAM(0);
    if (IN(1)) {
        pg8::Gemm g{xb, WSP(bf16, WS_W1GU), M, 2 * FF, D}; pg8::StaticOrder S; S.init(M, 2 * FF, F.G, cid);
        pg8::EpiSwiglu E{WSP(bf16, WS_R + R_ACT), FF, ss};
        pg8::gemm_phase<pg8::EpiSwiglu, pg8::StaticOrder, true, true>(F.lds, g, S, E);
    } SEAM(1);
    if (IN(2)) {
        pg8::Gemm g{WSP(bf16, WS_R + R_ACT), WSP(bf16, WS_W1D), M, D, FF}; pg8::StaticOrder S; S.init(M, D, F.G, cid);
        pg8::EpiResid E{F.in[0], F.out, WSP(bf16, WS_XB), ss + M, 0.5f};
        pg8::gemm_phase<pg8::EpiResid, pg8::StaticOrder, true, true>(F.lds, g, S, E);
    } SEAM(2);
    if (IN(3)) {
        pg8::Gemm g{xb, WSP(bf16, WS_WIN), M, NIN, D}; pg8::StaticOrder S; S.init(M, NIN, F.G, cid);
        pg8::EpiInProj E{WSP(bf16, WS_R + R_RKV), WSP(float, WS_R + R_LIN), WSP(bf16, WS_R + R_HG), ss + M, F.in[18]};
        pg8::gemm_phase<pg8::EpiInProj, pg8::StaticOrder, true, true>(F.lds, g, S, E);
    } SEAM(3);
    if (IN(4)) { p4_lora_in(F); } SEAM(4);
    if (IN(5)) {
        int kl = KL; asm volatile("" : "+s"(kl));
        pg8::Gemm g{WSP(bf16, WS_ALORA), WSP(bf16, WS_WLORA), M, NL, kl}; pg8::StaticOrder S; S.init(M, NL, F.G, cid);
        pg8::EpiLora E{WSP(bf16, WS_LOUT), F.in[8], F.in[10]};
        pg8::gemm_phase<pg8::EpiLora, pg8::StaticOrder, true, true>(F.lds, g, S, E);
    } SEAM(5);
    if (IN(6)) { p6_scans(F); } SEAM(6);
    if (IN(7)) { p7_post(F); } SEAM(7);
    if (IN(8)) {
        pg8::Gemm g{xb, WSP(bf16, WS_WOUT), M, D, D}; pg8::StaticOrder S; S.init(M, D, F.G, cid);
        pg8::EpiResid E{F.out, F.out, WSP(bf16, WS_R + R_X2B), ss + 2 * M, 1.0f};
        pg8::gemm_phase<pg8::EpiResid, pg8::StaticOrder, true, true>(F.lds, g, S, E);
    } SEAM(8);
    if (IN(9)) {
        pg8::Gemm g{WSP(bf16, WS_R + R_X2B), WSP(bf16, WS_W2GU), M, 2 * FF, D}; pg8::StaticOrder S; S.init(M, 2 * FF, F.G, cid);
        pg8::EpiSwiglu E{WSP(bf16, WS_R + R_ACT), FF, ss + 2 * M};
        pg8::gemm_phase<pg8::EpiSwiglu, pg8::StaticOrder, true, true>(F.lds, g, S, E);
    } SEAM(9);
    if (IN(10)) {
        pg8::Gemm g{WSP(bf16, WS_R + R_ACT), WSP(bf16, WS_W2D), M, D, FF}; pg8::StaticOrder S; S.init(M, D, F.G, cid);
        pg8::EpiResid E{F.out, F.out, nullptr, nullptr, 0.5f};
        pg8::gemm_phase<pg8::EpiResid, pg8::StaticOrder, true, true>(F.lds, g, S, E);
    } SEAM(10);
    if (IN(11)) { p11_final(F); }
#undef IN
#undef SEAM
}

extern "C" void kernel_launch(void* const* d_in, const int* in_sizes, int n_in, void* d_out, int out_size, void* d_ws, size_t ws_size, hipStream_t stream) {
    static int grid = 0;
    if (grid == 0) {
        if (n_in != 26 || in_sizes[0] != M * D || out_size != M * D || ws_size < WS_END) { fprintf(stderr, "kernel_launch: unexpected problem (n_in %d, ws %zu < %zu)\n", n_in, ws_size, (size_t)WS_END); grid = -1; return; }
        int dev = 0, cus = 0, per_cu = 0;
        if (hipGetDevice(&dev) != hipSuccess || hipDeviceGetAttribute(&cus, hipDeviceAttributeMultiprocessorCount, dev) != hipSuccess) { grid = -1; return; }
        if (hipFuncSetAttribute((const void*)mk_fwd, hipFuncAttributeMaxDynamicSharedMemorySize, LDS_BYTES) != hipSuccess) { grid = -1; return; }
        if (hipOccupancyMaxActiveBlocksPerMultiprocessor(&per_cu, (const void*)mk_fwd, NWAVES * 64, LDS_BYTES) != hipSuccess || per_cu < 1) fprintf(stderr, "kernel_launch: occupancy query reports %d\n", per_cu);
        (void)hipGetLastError();
        grid = cus;
    }
    if (grid < 0) return;
    (void)hipMemsetAsync((char*)d_ws + WS_CTL, 0, CTL_BYTES, stream);
    Args a{};
    for (int i = 0; i < 26; ++i) a.in[i] = (const float*)d_in[i];
    a.out = (float*)d_out; a.ws = (unsigned char*)d_ws;
    constexpr int NL_ = MK_N_LAUNCHES;
    for (int li = 0; li < NL_; ++li) {
        a.ph_lo = (NL_ == 1) ? 0 : li; a.ph_hi = (NL_ == 1) ? N_PHASES : li + 1;
        hipLaunchKernelGGL(mk_fwd, dim3(grid), dim3(NWAVES * 64), LDS_BYTES, stream, a);
    }
}
```

```cpp
#include <hip/hip_runtime.h>
#include <cstdio>
#include <cstdint>
namespace pg8 {
#define PG8_LAS __attribute__((address_space(3)))
typedef unsigned short bf16_t;
typedef short bf16x8 __attribute__((ext_vector_type(8)));
typedef float f32x4 __attribute__((ext_vector_type(4)));
typedef unsigned u32x4 __attribute__((ext_vector_type(4)));
constexpr int BM = 256, BK = 64, HALF = 128, HTB = HALF * BK * 2  , STAGE_BYTES = 8 * HTB, NXCD = 8, WGM = 8;

__host__ __device__ __forceinline__ int lds_byte(int r, int c) { const int st = (r >> 4) * 2 + (c >> 5), rr = r & 15, cc = c & 31, ob = rr * 64 + cc * 2; return st * 1024 + (ob ^ (((ob >> 9) & 1) << 5)); }
__host__ __device__ __forceinline__ void stage_rc(int b, int& R, int& C) { const int st = b / 1024, sb = b % 1024, swz = sb ^ (((sb >> 9) & 1) << 5); R = (st >> 1) * 16 + swz / 64; C = (st & 1) * 32 + (swz % 64) / 2; }
__host__ __device__ __forceinline__ int perm32(int rho) { const int n = rho >> 4, i = rho & 15; return 8 * (i >> 2) + 4 * n + (i & 3); }

struct Unit { int pm, pn; };
struct Gemm { const bf16_t* A; const bf16_t* Bt; int M, N, K; };

struct StaticOrder {
    int nM, nN, nwg, G, c;
    __host__ __device__ void init(int M, int N, int G_, int c_) { nM = M / BM; nN = N / BM; nwg = nM * nN; G = G_; c = c_; }
    __host__ __device__ bool next(int i, Unit& u) const {
        const long L = (long)i * G + c; if (L >= nwg) return false;
        int wgid = (int)L; { const int q = nwg / NXCD, r = nwg % NXCD, xcd = wgid % NXCD, off = wgid / NXCD; wgid = (xcd < r ? xcd * (q + 1) : r * (q + 1) + (xcd - r) * q) + off; }
        const int nig = WGM * nN, gid = wgid / nig, fm = gid * WGM, gsz = (nM - fm) < WGM ? (nM - fm) : WGM;
        u.pm = fm + ((wgid % nig) % gsz); u.pn = (wgid % nig) / gsz; return true;
    }
    __device__ __forceinline__ void a_ready(const Unit&) const {}
    __device__ __forceinline__ void done(const Unit&) const {}
};


typedef __bf16 bf16n2 __attribute__((ext_vector_type(2)));
__device__ __forceinline__ unsigned cvt_pk_bf16(float lo, float hi) { bf16n2 v; v.x = (__bf16)lo; v.y = (__bf16)hi; return __builtin_bit_cast(unsigned, v); }
__device__ __forceinline__ float fast_sigmoid(float z) { return __builtin_amdgcn_rcpf(1.0f + __builtin_amdgcn_exp2f(-1.44269504f * z)); }
__device__ __forceinline__ float fast_silu(float z) { return z * fast_sigmoid(z); }
constexpr float SS_SCALE = 16777216.0f;
__device__ __forceinline__ float inv_rms_from_val(unsigned long long v) {
    const float tot = (float)v * (1.0f / SS_SCALE);
    return 1.0f / sqrtf(tot * (1.0f / 2048.0f) + 1e-6f);
}
__device__ __forceinline__ u32x4 pack8(const f32x4 v0, const f32x4 v1) { u32x4 w; w.x = cvt_pk_bf16(v0[0], v0[1]); w.y = cvt_pk_bf16(v0[2], v0[3]); w.z = cvt_pk_bf16(v1[0], v1[1]); w.w = cvt_pk_bf16(v1[2], v1[3]); return w; }

struct EpiSwiglu {
    static constexpr bool PERM = true, AFTER_DRAIN = false;
    bf16_t* O; int ldc; const unsigned long long* ss;
    __device__ __forceinline__ void operator()(const f32x4 (&acc)[2][2][4][2], const Unit& u, int wr, int wc, int fr, int fq) const {
        const int row0 = u.pm * BM + wr * 64 + fr, col0 = u.pn * HALF + wc * 32 + 8 * fq;
        unsigned long long sv[2][4];
#pragma unroll
        for (int ai = 0; ai < 2; ++ai)
#pragma unroll
            for (int m = 0; m < 4; ++m) sv[ai][m] = ss[row0 + ai * HALF + m * 16];
#pragma unroll
        for (int ai = 0; ai < 2; ++ai)
#pragma unroll
            for (int m = 0; m < 4; ++m) { const int row = row0 + ai * HALF + m * 16; const float inv = inv_rms_from_val(sv[ai][m]);
                f32x4 o[2];
#pragma unroll
                for (int n = 0; n < 2; ++n) { const f32x4 g = acc[ai][0][m][n] * inv, up = acc[ai][1][m][n] * inv;
#pragma unroll
                    for (int j = 0; j < 4; ++j) o[n][j] = fast_silu(g[j]) * up[j]; }
                *(u32x4*)(O + (size_t)row * ldc + col0) = pack8(o[0], o[1]); }
    }
};
struct EpiResid {
    static constexpr bool PERM = true, AFTER_DRAIN = false;
    const float* resid; float* out; bf16_t* ob; unsigned long long* ss; float alpha; const float* gain;
    __device__ __forceinline__ void operator()(const f32x4 (&acc)[2][2][4][2], const Unit& u, int wr, int wc, int fr, int fq) const {
        const int row0 = u.pm * BM + wr * 64 + fr, col0 = u.pn * BM + wc * 32 + 8 * fq;
#pragma unroll
        for (int ai = 0; ai < 2; ++ai)
#pragma unroll
            for (int m = 0; m < 4; ++m) { const int row = row0 + ai * HALF + m * 16; const size_t off = (size_t)row * 2048 + col0; float s = 0.f;
#pragma unroll
                for (int bj = 0; bj < 2; ++bj) {
                    const f32x4 r0 = *(const f32x4*)(resid + off + bj * HALF), r1 = *(const f32x4*)(resid + off + bj * HALF + 4);
                    const f32x4 o0 = r0 + acc[ai][bj][m][0] * alpha, o1 = r1 + acc[ai][bj][m][1] * alpha;
                    *(f32x4*)(out + off + bj * HALF) = o0; *(f32x4*)(out + off + bj * HALF + 4) = o1;
                    if (ob) { const f32x4 g0 = *(const f32x4*)(gain + col0 + bj * HALF), g1 = *(const f32x4*)(gain + col0 + bj * HALF + 4); *(u32x4*)(ob + off + bj * HALF) = pack8(o0 * g0, o1 * g1); }
                    s += (o0[0] * o0[0] + o0[1] * o0[1]) + (o0[2] * o0[2] + o0[3] * o0[3]) + (o1[0] * o1[0] + o1[1] * o1[1]) + (o1[2] * o1[2] + o1[3] * o1[3]); }
                if (ss) { s += __shfl_xor(s, 16); s += __shfl_xor(s, 32);
                    if (fq == 0) atomicAdd(ss + row, (unsigned long long)(s * SS_SCALE + 0.5f)); } }
    }
};
struct EpiInProj {
    static constexpr bool PERM = true, AFTER_DRAIN = false;
    bf16_t* rkv; float* lin; bf16_t* hg; const unsigned long long* ss; const float* lbl;
    __device__ __forceinline__ void operator()(const f32x4 (&acc)[2][2][4][2], const Unit& u, int wr, int wc, int fr, int fq) const {
        const int row0 = u.pm * BM + wr * 64 + fr, cin = wc * 32 + 8 * fq;
        const int pn = u.pn;
        float invs[2][4];
        { unsigned long long sv[2][4];
#pragma unroll
          for (int ai = 0; ai < 2; ++ai)
#pragma unroll
              for (int m = 0; m < 4; ++m) sv[ai][m] = ss[row0 + ai * HALF + m * 16];
#pragma unroll
          for (int ai = 0; ai < 2; ++ai)
#pragma unroll
              for (int m = 0; m < 4; ++m) invs[ai][m] = inv_rms_from_val(sv[ai][m]); }
        int mode;
        if (pn < 12) mode = 0; else if (pn < 14) mode = 1; else { const int sg = (pn - 14) >> 2; mode = (sg == 0 || sg == 3) ? 2 : (sg == 1 ? 3 : 4); }
#pragma unroll
        for (int bj = 0; bj < 2; ++bj) {
            f32x4 om0 = (f32x4){0.f, 0.f, 0.f, 0.f}, om1 = om0;
            if (mode == 3) { const float* lp = lbl + (pn - 18) * BM + bj * HALF + cin; const f32x4 a0 = *(const f32x4*)lp, a1 = *(const f32x4*)(lp + 4), c0 = *(const f32x4*)(lp + 1024), c1 = *(const f32x4*)(lp + 1028);
#pragma unroll
                for (int j = 0; j < 4; ++j) { om0[j] = 1.0f - fast_sigmoid(a0[j] - c0[j]); om1[j] = 1.0f - fast_sigmoid(a1[j] - c1[j]); } }
#pragma unroll
            for (int ai = 0; ai < 2; ++ai)
#pragma unroll
                for (int m = 0; m < 4; ++m) { const int row = row0 + ai * HALF + m * 16; const float inv = invs[ai][m];
                    f32x4 v0 = acc[ai][bj][m][0] * inv, v1 = acc[ai][bj][m][1] * inv;
                    if (mode == 0) { *(u32x4*)(rkv + (size_t)row * 3072 + pn * BM + bj * HALF + cin) = pack8(v0, v1); }
                    else if (mode == 1) { const int cl = (pn - 12) * BM + bj * HALF + cin;
                        if (cl < 288) { *(f32x4*)(lin + (size_t)row * 288 + cl) = v0; *(f32x4*)(lin + (size_t)row * 288 + cl + 4) = v1; } }
                    else {
                        if (mode == 2) {
#pragma unroll
                            for (int j = 0; j < 4; ++j) { v0[j] = fast_silu(v0[j]); v1[j] = fast_silu(v1[j]); } }
                        else if (mode == 3) {
#pragma unroll
                            for (int j = 0; j < 4; ++j) { v0[j] = __logf(1.0f - om0[j] * fast_sigmoid(-v0[j])); v1[j] = __logf(1.0f - om1[j] * fast_sigmoid(-v1[j])); } }
                        *(u32x4*)(hg + (size_t)row * 4096 + (pn - 14) * BM + bj * HALF + cin) = pack8(v0, v1); } } }
    }
};
struct EpiLora {
    static constexpr bool PERM = true, AFTER_DRAIN = false;
    bf16_t* lout; const float* w0; const float* a0;
    __device__ __forceinline__ void operator()(const f32x4 (&acc)[2][2][4][2], const Unit& u, int wr, int wc, int fr, int fq) const {
        const int row0 = u.pm * BM + wr * 64 + fr, cin = wc * 32 + 8 * fq;
        const int pn = u.pn, mode = pn >> 2;
#pragma unroll
        for (int bj = 0; bj < 2; ++bj) {
            f32x4 b0 = (f32x4){0.f, 0.f, 0.f, 0.f}, b1 = b0;
            if (mode < 2) { const float* bp = (mode == 0 ? w0 : a0) + (pn & 3) * BM + bj * HALF + cin; b0 = *(const f32x4*)bp; b1 = *(const f32x4*)(bp + 4); }
#pragma unroll
            for (int ai = 0; ai < 2; ++ai)
#pragma unroll
                for (int m = 0; m < 4; ++m) { const int row = row0 + ai * HALF + m * 16;
                    f32x4 v0 = acc[ai][bj][m][0] + b0, v1 = acc[ai][bj][m][1] + b1;
#pragma unroll
                    for (int j = 0; j < 4; ++j) { const float s0 = fast_sigmoid(v0[j]), s1 = fast_sigmoid(v1[j]);
                        const float d0 = -0.60653066f * s0, d1 = -0.60653066f * s1;
                        v0[j] = mode == 0 ? d0 : (mode == 1 ? s0 : v0[j]); v1[j] = mode == 0 ? d1 : (mode == 1 ? s1 : v1[j]); }
                    *(u32x4*)(lout + (size_t)row * 3072 + pn * BM + bj * HALF + cin) = pack8(v0, v1); asm volatile("" ::: "memory"); } }
    }
};
template <class Epi, class Sched, bool ALIGN_EPI = false, bool SP2 = false>
__device__ __forceinline__ void gemm_phase(PG8_LAS unsigned char* lds, const Gemm g, const Sched& S, const Epi& E) {
    const int tid = threadIdx.x, wid = __builtin_amdgcn_readfirstlane(tid >> 6), lane = tid & 63, wr = wid >> 2, wc = wid & 3, fr = lane & 15, fq = lane >> 4;
    const int K = g.K, nt = K / BK;
    unsigned voffA[2], voffB[2];
#pragma unroll
    for (int i = 0; i < 2; ++i) { int R, C; stage_rc(tid * 16 + i * 8192, R, C); const int Rb = Epi::PERM ? ((R & ~31) + perm32(R & 31)) : R;
        voffA[i] = (unsigned)(R * K + C) * 2u; voffB[i] = (unsigned)(Rb * K + C) * 2u; }
    const size_t kstep = (size_t)(BK * 2);
    const size_t hstep = (size_t)HALF * K * 2;
    const size_t tstep = 2 * hstep;
    const unsigned ldsw = (unsigned)wid * 1024u;
    const int aoff = lds_byte(wr * 64 + fr, fq * 8), boff = lds_byte(wc * 32 + fr, fq * 8);
#define PG8_SA(b, h) (((b) * 2 + (h)) * HTB)
#define PG8_SB(b, h) ((4 + (b) * 2 + (h)) * HTB)
#define PG8_STAGE(bufoff, gbase, voff) do { _Pragma("unroll") for (int _i = 0; _i < 2; ++_i) \
        __builtin_amdgcn_global_load_lds((const unsigned*)((const char*)(gbase) + (voff)[_i]), (PG8_LAS unsigned*)(lds + (bufoff) + ldsw + _i * 8192), 16, 0, 0); } while (0)
#define PG8_LDA(dst, b, h) do { _Pragma("unroll") for (int m = 0; m < 4; ++m) _Pragma("unroll") for (int k = 0; k < 2; ++k) dst[m][k] = *(const PG8_LAS bf16x8*)(lds + PG8_SA(b, h) + aoff + m * 2048 + k * 1024); } while (0)
#define PG8_LDB(dst, b, h) do { _Pragma("unroll") for (int n = 0; n < 2; ++n) _Pragma("unroll") for (int k = 0; k < 2; ++k) dst[n][k] = *(const PG8_LAS bf16x8*)(lds + PG8_SB(b, h) + boff + n * 2048 + k * 1024); } while (0)
#define PG8_MMA(ai, bj, At, Bt) do { __builtin_amdgcn_s_setprio(1); _Pragma("unroll") for (int m = 0; m < 4; ++m) _Pragma("unroll") for (int n = 0; n < 2; ++n) _Pragma("unroll") for (int k = 0; k < 2; ++k) \
        acc[ai][bj][m][n] = __builtin_amdgcn_mfma_f32_16x16x32_bf16(Bt[n][k], At[m][k], acc[ai][bj][m][n], 0, 0, 0); __builtin_amdgcn_s_setprio(0); } while (0)
#define PG8_WAIT_V(n) asm volatile("s_waitcnt vmcnt(" #n ")" ::: "memory")
#define PG8_WAIT_L(n) asm volatile("s_waitcnt lgkmcnt(" #n ")" ::: "memory")
#define PG8_BAR __builtin_amdgcn_s_barrier()
#define PG8_SCHED __builtin_amdgcn_sched_barrier(0)
    Unit cur, nxt; int ui = 0;
    if (!S.next(0, cur)) return;
    f32x4 acc[2][2][4][2];
#pragma unroll
    for (int a = 0; a < 2; ++a)
#pragma unroll
        for (int b = 0; b < 2; ++b)
#pragma unroll
            for (int m = 0; m < 4; ++m)
#pragma unroll
                for (int n = 0; n < 2; ++n) acc[a][b][m][n] = (f32x4){0.f, 0.f, 0.f, 0.f};
    bf16x8 At[4][2], B0[2][2], B1[2][2];
    const char* cA = (const char*)g.A + (size_t)cur.pm * tstep; const char* cB = (const char*)g.Bt + (size_t)cur.pn * tstep;
    S.a_ready(cur);
    if constexpr (SP2) {
        PG8_STAGE(PG8_SB(0, 0), cB, voffB); PG8_STAGE(PG8_SB(0, 1), cB + hstep, voffB); PG8_STAGE(PG8_SA(0, 0), cA, voffA); PG8_STAGE(PG8_SA(0, 1), cA + hstep, voffA);
        if (wr == 1) PG8_BAR;
        PG8_WAIT_V(2); PG8_BAR;
        PG8_STAGE(PG8_SB(1, 0), cB + kstep, voffB); PG8_STAGE(PG8_SA(1, 0), cA + kstep, voffA); PG8_STAGE(PG8_SB(1, 1), cB + hstep + kstep, voffB);
        PG8_WAIT_V(6); PG8_BAR;
    } else {
        PG8_STAGE(PG8_SB(0, 0), cB, voffB); PG8_STAGE(PG8_SA(0, 0), cA, voffA); PG8_STAGE(PG8_SB(0, 1), cB + hstep, voffB); PG8_STAGE(PG8_SA(0, 1), cA + hstep, voffA);
        if (wr == 1) PG8_BAR;
        PG8_WAIT_V(4); PG8_BAR;
        PG8_STAGE(PG8_SB(1, 0), cB + kstep, voffB); PG8_STAGE(PG8_SA(1, 0), cA + kstep, voffA); PG8_STAGE(PG8_SB(1, 1), cB + hstep + kstep, voffB);
        PG8_WAIT_V(6); PG8_BAR;
    }
    for (;;) {
        const bool has_next = S.next(ui + 1, nxt);
        const char* nA = has_next ? (const char*)g.A + (size_t)nxt.pm * tstep : cA; const char* nB = has_next ? (const char*)g.Bt + (size_t)nxt.pn * tstep : cB;
        for (int t = 0; t < nt; t += 2) {
            const bool last = (t == nt - 2);
            const char* a1 = cA + (size_t)(t + 1) * kstep;
            const char* a2 = last ? nA : cA + (size_t)(t + 2) * kstep; const char* b2 = last ? nB : cB + (size_t)(t + 2) * kstep;
            const char* a3 = a2 + kstep; const char* b3 = b2 + kstep;
            if (last && has_next) S.a_ready(nxt);
            if constexpr (SP2) {
            PG8_LDB(B0, 0, 0); PG8_LDB(B1, 0, 1); PG8_SCHED; PG8_LDA(At, 0, 0); PG8_STAGE(PG8_SA(1, 1), a1 + hstep, voffA);
            PG8_WAIT_V(8); PG8_WAIT_L(0); PG8_BAR; PG8_MMA(0, 0, At, B0); PG8_MMA(0, 1, At, B1); PG8_BAR; PG8_SCHED;
            PG8_LDA(At, 0, 1); PG8_STAGE(PG8_SB(0, 0), b2, voffB); PG8_STAGE(PG8_SB(0, 1), b2 + hstep, voffB); PG8_STAGE(PG8_SA(0, 0), a2, voffA);
            PG8_WAIT_V(8); PG8_WAIT_L(0); PG8_BAR; PG8_MMA(1, 0, At, B0); PG8_MMA(1, 1, At, B1); PG8_BAR; PG8_SCHED;
            PG8_LDB(B0, 1, 0); PG8_LDB(B1, 1, 1); PG8_SCHED; PG8_LDA(At, 1, 0); PG8_STAGE(PG8_SA(0, 1), a2 + hstep, voffA);
            PG8_WAIT_V(8); PG8_WAIT_L(0); PG8_BAR; PG8_MMA(0, 0, At, B0); PG8_MMA(0, 1, At, B1); PG8_BAR; PG8_SCHED;
            PG8_LDA(At, 1, 1); PG8_STAGE(PG8_SB(1, 0), b3, voffB); PG8_STAGE(PG8_SB(1, 1), b3 + hstep, voffB); PG8_STAGE(PG8_SA(1, 0), a3, voffA);
            PG8_WAIT_V(8); PG8_WAIT_L(0); PG8_BAR; PG8_MMA(1, 0, At, B0); PG8_MMA(1, 1, At, B1); PG8_BAR; PG8_SCHED;
            } else {
            PG8_LDB(B0, 0, 0); PG8_SCHED; PG8_LDA(At, 0, 0); PG8_STAGE(PG8_SA(1, 1), a1 + hstep, voffA);
            PG8_WAIT_L(8); PG8_BAR; PG8_WAIT_L(0); PG8_MMA(0, 0, At, B0); PG8_BAR; PG8_SCHED;
            PG8_LDB(B1, 0, 1); PG8_STAGE(PG8_SB(0, 0), b2, voffB);
            PG8_BAR; PG8_WAIT_L(0); PG8_MMA(0, 1, At, B1); PG8_BAR;
            PG8_LDA(At, 0, 1); PG8_STAGE(PG8_SA(0, 0), a2, voffA);
            PG8_BAR; PG8_WAIT_L(0); PG8_MMA(1, 0, At, B0); PG8_BAR; PG8_SCHED;
            PG8_STAGE(PG8_SB(0, 1), b2 + hstep, voffB);
            PG8_WAIT_V(6); PG8_BAR; PG8_MMA(1, 1, At, B1); PG8_BAR;
            PG8_LDB(B0, 1, 0); PG8_SCHED; PG8_LDA(At, 1, 0); PG8_STAGE(PG8_SA(0, 1), a2 + hstep, voffA);
            PG8_WAIT_L(8); PG8_BAR; PG8_WAIT_L(0); PG8_MMA(0, 0, At, B0); PG8_BAR; PG8_SCHED;
            PG8_LDB(B1, 1, 1); PG8_STAGE(PG8_SB(1, 0), b3, voffB);
            PG8_BAR; PG8_WAIT_L(0); PG8_MMA(0, 1, At, B1); PG8_BAR;
            PG8_LDA(At, 1, 1); PG8_STAGE(PG8_SA(1, 0), a3, voffA);
            PG8_BAR; PG8_WAIT_L(0); PG8_MMA(1, 0, At, B0); PG8_BAR; PG8_SCHED;
            PG8_STAGE(PG8_SB(1, 1), b3 + hstep, voffB);
            PG8_WAIT_V(6); PG8_BAR; PG8_MMA(1, 1, At, B1); PG8_BAR;
            }
        }
        if constexpr (ALIGN_EPI) { if (wr == 0) PG8_BAR; }
        if constexpr (!Epi::AFTER_DRAIN) { E(acc, cur, wr, wc, fr, fq); S.done(cur); }
        if (!has_next) break;
#pragma unroll
        for (int a = 0; a < 2; ++a)
#pragma unroll
            for (int b = 0; b < 2; ++b)
#pragma unroll
                for (int m = 0; m < 4; ++m)
#pragma unroll
                    for (int n = 0; n < 2; ++n) acc[a][b][m][n] = (f32x4){0.f, 0.f, 0.f, 0.f};
        cur = nxt; cA = nA; cB = nB; ++ui;
        if constexpr (ALIGN_EPI) { if (wr == 1) PG8_BAR; }
    }
    PG8_WAIT_V(0);
    if constexpr (!ALIGN_EPI) { if (wr == 0) PG8_BAR; }
    PG8_BAR;
    if constexpr (Epi::AFTER_DRAIN) { E.fused(acc, cur, wr, wc, fr, fq, lds, wid, lane); S.done(cur); }
#undef PG8_SA
#undef PG8_SB
#undef PG8_STAGE
#undef PG8_LDA
#undef PG8_LDB
#undef PG8_MMA
#undef PG8_WAIT_V
#undef PG8_WAIT_L
#undef PG8_BAR
#undef PG8_SCHED
}
}

constexpr int NWAVES = 8;
constexpr int BATCH = 4, SEQ = 8192, D = 2048, M = BATCH * SEQ, FF = 5632;
constexpr int RC = 1024, RH = 16, RN = 64;
constexpr int HC = 1024, HH = 8, HD = 128;
constexpr int RWKV_COLS = 3360, IN_COLS = 7456, NIN = 7680;
constexpr int KL = 384, NL = 3072;
#ifndef MK_N_LAUNCHES
#define MK_N_LAUNCHES 1
#endif
constexpr int N_PHASES = 12;

constexpr size_t WS_CTL = 0, CTL_BYTES = 1u << 20;
constexpr size_t WS_W1GU = CTL_BYTES;
constexpr size_t WS_W1D = WS_W1GU + (size_t)2 * FF * D * 2;
constexpr size_t WS_WIN = WS_W1D + (size_t)D * FF * 2;
constexpr size_t WS_WLORA = WS_WIN + (size_t)NIN * D * 2;
constexpr size_t WS_WOUT = WS_WLORA + (size_t)NL * KL * 2;
constexpr size_t WS_W2GU = WS_WOUT + (size_t)D * D * 2;
constexpr size_t WS_W2D = WS_W2GU + (size_t)2 * FF * D * 2;
constexpr size_t WS_SS = WS_W2D + (size_t)D * FF * 2;
constexpr size_t WS_XB = WS_SS + (1u << 20);
constexpr size_t WS_R = WS_XB + (size_t)M * D * 2;
constexpr size_t R_ACT = 0;
constexpr size_t R_RKV = 0;
constexpr size_t R_HG = R_RKV + (size_t)M * 3072 * 2;
constexpr size_t R_LIN = R_HG + (size_t)M * 4096 * 2;
constexpr size_t R_X2B = (size_t)M * FF * 2;
constexpr size_t R_BYTES = R_LIN + (size_t)M * 288 * 4;
constexpr size_t WS_ALORA = WS_R + R_BYTES;
constexpr size_t WS_LOUT = WS_ALORA + (size_t)M * KL * 2;
constexpr size_t WS_INVN = WS_LOUT + (size_t)M * NL * 2;
constexpr size_t WS_END = WS_INVN + (size_t)M * RH * 4;
static_assert(R_X2B + (size_t)M * D * 2 <= R_BYTES && WS_END <= ((size_t)1 << 30), "d_ws map");
constexpr int CW_BAR = 4096;

constexpr int RING_BYTES = 131072;
constexpr int LDSCTL_OFF = RING_BYTES, MISC_OFF = LDSCTL_OFF + 320;
constexpr int LDS_BYTES = 147456;
static_assert(MISC_OFF + 128 <= LDS_BYTES, "LDS map");

#define GAS __attribute__((address_space(1)))
#define LAS __attribute__((address_space(3)))
typedef unsigned short bf16;
typedef unsigned v4u __attribute__((ext_vector_type(4)));
typedef unsigned v2u __attribute__((ext_vector_type(2)));
typedef float f32x4 __attribute__((ext_vector_type(4)));
#define LDS_WAIT() asm volatile("s_waitcnt lgkmcnt(0)" ::: "memory")
#define VM_WAIT() asm volatile("s_waitcnt vmcnt(0)" ::: "memory")
__device__ __forceinline__ float bflo(unsigned u) { return __builtin_bit_cast(float, u << 16); }
__device__ __forceinline__ float bfhi(unsigned u) { return __builtin_bit_cast(float, u & 0xffff0000u); }
__device__ __forceinline__ f32x4 unpack4(v2u w) { return (f32x4){bflo(w.x), bfhi(w.x), bflo(w.y), bfhi(w.y)}; }
__device__ __forceinline__ unsigned pk2(float lo, float hi) { return pg8::cvt_pk_bf16(lo, hi); }
__device__ __forceinline__ v2u pack4(f32x4 v) { v2u w; w.x = pk2(v[0], v[1]); w.y = pk2(v[2], v[3]); return w; }
using pg8::fast_sigmoid;
using pg8::fast_silu;
template <int CTRL> __device__ __forceinline__ float dpp_mov(float x) { return __builtin_bit_cast(float, __builtin_amdgcn_update_dpp(0, __builtin_bit_cast(int, x), CTRL, 0xF, 0xF, true)); }
__device__ __forceinline__ float row16_sum(float x) { x += dpp_mov<0x128>(x); x += dpp_mov<0x124>(x); x += dpp_mov<0x122>(x); x += dpp_mov<0x121>(x); return x; }
template <int CTRL, int BANK> __device__ __forceinline__ float dpp_upd(float old, float x) { return __builtin_bit_cast(float, __builtin_amdgcn_update_dpp(__builtin_bit_cast(int, old), __builtin_bit_cast(int, x), CTRL, 0xF, BANK, false)); }
__device__ __forceinline__ float tr_reduce16(const float (&v)[16], int lane) {
    float u[8], w[4], x[2];
#pragma unroll
    for (int s = 0; s < 8; ++s) { const float t = v[s + 8] + dpp_mov<0x128>(v[s + 8]), a = v[s] + dpp_mov<0x128>(v[s]); u[s] = dpp_upd<0xE4, 0x3>(t, a); }
#pragma unroll
    for (int s = 0; s < 4; ++s) { const float t = u[s + 4] + dpp_mov<0x141>(u[s + 4]), a = u[s] + dpp_mov<0x141>(u[s]); w[s] = dpp_upd<0xE4, 0x5>(t, a); }
    const bool b1 = (lane & 2) != 0, b0 = (lane & 1) != 0;
#pragma unroll
    for (int s = 0; s < 2; ++s) { const float K = b1 ? w[s + 2] : w[s], T = b1 ? w[s] : w[s + 2]; x[s] = K + dpp_mov<0x1B>(T); }
    const float K = b0 ? x[1] : x[0], T = b0 ? x[0] : x[1];
    return K + dpp_mov<0xB1>(T);
}
typedef float f32x2 __attribute__((ext_vector_type(2)));
#define LO2(v) __builtin_shufflevector(v, v, 0, 1)
#define HI2(v) __builtin_shufflevector(v, v, 2, 3)
__device__ __forceinline__ float wave_sum(float v) {
#pragma unroll
    for (int o = 1; o < 64; o <<= 1) v += __shfl_xor(v, o);
    return v;
}
#define XB_TMO      128
#define XB_XCNT(j)  (256  + 64 * (j))
#define XB_XSUB(j)  (1280 + 64 * (j))
#define XB_XGEN(j)  (2304 + 64 * (j))
#define XB_TOP      3328
#define XB_TOPGEN   3392
#define XCD_BAR_WORDS 3456
#define XB_SPIN_CAP (1u << 18)

__device__ __forceinline__ unsigned xb_ld(unsigned* p)              { return __hip_atomic_load(p, __ATOMIC_RELAXED, __HIP_MEMORY_SCOPE_AGENT); }
__device__ __forceinline__ unsigned xb_add(unsigned* p, unsigned v) { return __hip_atomic_fetch_add(p, v, __ATOMIC_RELAXED, __HIP_MEMORY_SCOPE_AGENT); }
__device__ __forceinline__ unsigned xb_xcc_id() { return (unsigned)__builtin_amdgcn_s_getreg((3 << 11) | 20) & 0xFu; }
#define XB_SPIN(cond, bar) do { unsigned _sp = 0; while (cond) { __builtin_amdgcn_s_sleep(1); \
    if ((++_sp & 255u) == 0u) { if (xb_ld(&(bar)[XB_TMO])) break; if (_sp > XB_SPIN_CAP) { atomicAdd(&(bar)[XB_TMO], 1u); break; } } } } while (0)

struct XcdBarrier {
    unsigned* bar; unsigned x;
    volatile LAS unsigned* st;
};

__device__ __forceinline__ XcdBarrier xcd_barrier_post(unsigned* bar, volatile LAS unsigned* st) {
    XcdBarrier b; b.bar = bar; b.x = xb_xcc_id(); b.st = st;
    if (threadIdx.x == 0) (void)xb_add(&bar[XB_XCNT(b.x)], 1u);
    return b;
}
__device__ __forceinline__ void xcd_barrier_complete(unsigned* bar, unsigned x, unsigned& nloc, unsigned& nx) {
    const unsigned G = gridDim.x * gridDim.y * gridDim.z;
    unsigned sum, cnt, mine, sp = 0u;
    for (;;) {
        sum = 0u; cnt = 0u; mine = 0u;
#pragma unroll
        for (unsigned j = 0; j < 16; ++j) { const unsigned c = xb_ld(&bar[XB_XCNT(j)]); sum += c; cnt += (c > 0u) ? 1u : 0u; mine = (j == x) ? c : mine; }
        if (sum == G) break;
        __builtin_amdgcn_s_sleep(1);
        if ((++sp & 255u) == 0u) { if (xb_ld(&bar[XB_TMO])) break; if (sp > XB_SPIN_CAP) { atomicAdd(&bar[XB_TMO], 1u); break; } }
    }
    nloc = mine > 0u ? mine : 1u; nx = cnt > 0u ? cnt : 1u;
}

__device__ __forceinline__ void xcd_barrier(const XcdBarrier& b) {
    asm volatile("s_waitcnt vmcnt(0)" ::: "memory");
    __syncthreads();
    if (threadIdx.x == 0) {
        unsigned* bar = b.bar;
        __builtin_amdgcn_s_waitcnt(0);
        unsigned nloc = b.st[0], nx = b.st[1];
        if (nloc == 0u) { xcd_barrier_complete(bar, b.x, nloc, nx); b.st[0] = nloc; b.st[1] = nx; }
        const unsigned old = xb_add(&bar[XB_XSUB(b.x)], 1u);
        const unsigned gen = old / nloc;
        if (old + 1u == (gen + 1u) * nloc) {
            __builtin_amdgcn_fence(__ATOMIC_RELEASE, "agent");
            asm volatile("s_waitcnt vmcnt(0)" ::: "memory");
            const unsigned og = xb_add(&bar[XB_TOP], 1u);
            const unsigned tg = og / nx;
            if (og + 1u == (tg + 1u) * nx) xb_add(&bar[XB_TOPGEN], 1u);
            else XB_SPIN(xb_ld(&bar[XB_TOPGEN]) == tg, bar);
            __builtin_amdgcn_fence(__ATOMIC_ACQUIRE, "agent");
            xb_add(&bar[XB_XGEN(b.x)], 1u);
            asm volatile("s_waitcnt vmcnt(0)" ::: "memory");
        } else {
            XB_SPIN(xb_ld(&bar[XB_XGEN(b.x)]) == gen, bar);
            __builtin_amdgcn_fence(__ATOMIC_ACQUIRE, "agent");
            asm volatile("s_waitcnt vmcnt(0)" ::: "memory");
        }
    }
    __syncthreads();
}

struct Frame {
    LAS unsigned char* lds;
    int tid, lane, wave, vcu, G;
    const float* in[26];
    float* out; unsigned char* ws;
};
#define WSP(T, off) ((T*)(F.ws + (off)))
struct Args { const float* in[26]; float* out; unsigned char* ws; int ph_lo, ph_hi; };

struct P0Item { const float* W; bf16* WT; int K, N, kb, n0, drow0; };
__device__ __forceinline__ int map_gu(int n0, int which) { return (n0 >> 7) * 256 + which * 128 + (n0 & 127); }
__device__ __forceinline__ P0Item p0_decode(Frame& F, const Args& A, int it) {
    constexpr int I_GU = (D / 64) * (FF / 32);
    constexpr int I_DN = (FF / 64) * (D / 32);
    constexpr int I_IN = (D / 64) * (IN_COLS / 32);
    P0Item p; int r = it;
    if (r < 4 * I_GU) { const int mat = r / I_GU; r -= mat * I_GU; const int nblk = FF / 32, ffn = mat >> 1, which = mat & 1;
        p.W = A.in[2 + 20 * ffn + which]; p.WT = WSP(bf16, ffn ? WS_W2GU : WS_W1GU); p.K = D; p.N = FF; p.kb = r / nblk; p.n0 = 32 * (r % nblk); p.drow0 = map_gu(p.n0, which); return p; }
    r -= 4 * I_GU;
    if (r < 2 * I_DN) { const int ffn = r / I_DN; r -= ffn * I_DN; const int nblk = D / 32;
        p.W = A.in[4 + 20 * ffn]; p.WT = WSP(bf16, ffn ? WS_W2D : WS_W1D); p.K = FF; p.N = D; p.kb = r / nblk; p.n0 = 32 * (r % nblk); p.drow0 = p.n0; return p; }
    r -= 2 * I_DN;
    if (r < I_IN) { const int nblk = IN_COLS / 32;
        p.W = A.in[6]; p.WT = WSP(bf16, WS_WIN); p.K = D; p.N = IN_COLS; p.kb = r / nblk; p.n0 = 32 * (r % nblk); p.drow0 = p.n0 < RWKV_COLS ? p.n0 : p.n0 + 224; return p; }
    r -= I_IN;
    { const int nblk = D / 32; p.W = A.in[20]; p.WT = WSP(bf16, WS_WOUT); p.K = D; p.N = D; p.kb = r / nblk; p.n0 = 32 * (r % nblk); p.drow0 = p.n0; return p; }
}
__device__ __forceinline__ void p0_dma(const P0Item& p, LAS unsigned char* tile, int lane) {
    const int half = lane >> 5, sl = lane & 31;
#pragma unroll 8
    for (int i = 0; i < 32; ++i) { const int kk = 2 * i + half;
        __builtin_amdgcn_global_load_lds((const GAS unsigned*)(p.W + (size_t)(64 * p.kb + kk) * p.N + p.n0 + (sl ^ (4 * (kk >> 3)))), (LAS unsigned*)(tile + i * 256), 4, 0, 0); }
}
__device__ __forceinline__ void p0_emit(const P0Item& p, const LAS float* t, int lane) {
    const int c = lane & 7;
#pragma unroll
    for (int j = 0; j < 4; ++j) { const int n = (lane >> 3) + 8 * j; const LAS float* s = t + (8 * c) * 32 + (n ^ (4 * c));
        v4u o; o.x = pk2(s[0 * 32], s[1 * 32]); o.y = pk2(s[2 * 32], s[3 * 32]); o.z = pk2(s[4 * 32], s[5 * 32]); o.w = pk2(s[6 * 32], s[7 * 32]);
        *(GAS v4u*)(p.WT + (size_t)(p.drow0 + n) * p.K + 64 * p.kb + 8 * c) = o; }
}
__device__ __forceinline__ void p0_prologue(Frame& F, const Args& A) {
    LAS unsigned char* tiles = F.lds + F.wave * 16384;
    const int gw = F.vcu * NWAVES + F.wave, NGW = F.G * NWAVES;
    constexpr int NITEMS = 4 * ((D / 64) * (FF / 32)) + 2 * ((FF / 64) * (D / 32)) + (D / 64) * (IN_COLS / 32) + (D / 64) * (D / 32);
    if (gw < NITEMS) {
        P0Item cur = p0_decode(F, A, gw); int buf = 0;
        p0_dma(cur, tiles, F.lane);
        for (int it = gw; it < NITEMS; it += NGW) {
            const bool more = it + NGW < NITEMS; P0Item nxt = cur;
            if (more) { nxt = p0_decode(F, A, it + NGW); p0_dma(nxt, tiles + (buf ^ 1) * 8192, F.lane); asm volatile("s_waitcnt vmcnt(32)" ::: "memory"); }
            else asm volatile("s_waitcnt vmcnt(0)" ::: "memory");
            p0_emit(cur, (const LAS float*)(tiles + buf * 8192), F.lane);
            LDS_WAIT(); asm volatile("" ::: "memory");
            cur = nxt; buf ^= 1;
        }
        asm volatile("s_waitcnt vmcnt(0)" ::: "memory");
    }
    const size_t gt = (size_t)F.vcu * (NWAVES * 64) + F.tid, NT = (size_t)F.G * NWAVES * 64;
    { GAS v4u* z = (GAS v4u*)(WSP(bf16, WS_WIN) + (size_t)RWKV_COLS * D);
      for (size_t i = gt; i < (size_t)224 * D * 2 / 16; i += NT) z[i] = (v4u){0u, 0u, 0u, 0u}; }
    { bf16* wl = WSP(bf16, WS_WLORA); const float* w2 = F.in[9]; const float* a2 = F.in[11]; const float* g2 = F.in[12];
      for (size_t i = gt; i < (size_t)NL * KL / 2; i += NT) { const int n = (int)(i / (KL / 2)), k = 2 * (int)(i % (KL / 2)); const int seg = n >> 10, c = n & 1023;
          float v0 = 0.f, v1 = 0.f;
          if (seg == 0) { if (k < 64) { v0 = w2[(size_t)k * RC + c]; v1 = w2[(size_t)(k + 1) * RC + c]; } }
          else if (seg == 1) { if (k >= 64 && k < 128) { v0 = a2[(size_t)(k - 64) * RC + c]; v1 = a2[(size_t)(k - 63) * RC + c]; } }
          else { if (k >= 128 && k < 288) { v0 = g2[(size_t)(k - 128) * RC + c]; v1 = g2[(size_t)(k - 127) * RC + c]; } }
          ((GAS unsigned*)wl)[i] = pk2(v0, v1); } }
    { GAS unsigned long long* s = (GAS unsigned long long*)(F.ws + WS_SS) + M;
      for (size_t i = gt; i < (size_t)2 * M; i += NT) s[i] = 0ull; }
    { const float* x = F.in[0]; bf16* xb = WSP(bf16, WS_XB); unsigned long long* ss0 = WSP(unsigned long long, WS_SS);
      for (int m = gw; m < M; m += NGW) { const GAS f32x4* xr = (const GAS f32x4*)(x + (size_t)m * D) + 2 * F.lane; GAS v4u* o = (GAS v4u*)(xb + (size_t)m * D) + F.lane; float s = 0.f;
#pragma unroll
          for (int j = 0; j < 4; ++j) { const f32x4 a = xr[128 * j], b = xr[128 * j + 1];
              s += (a[0] * a[0] + a[1] * a[1]) + (a[2] * a[2] + a[3] * a[3]) + (b[0] * b[0] + b[1] * b[1]) + (b[2] * b[2] + b[3] * b[3]);
              const f32x4 ga = *(const f32x4*)(F.in[1] + 8 * F.lane + 512 * j), gb = *(const f32x4*)(F.in[1] + 8 * F.lane + 512 * j + 4);
              o[64 * j] = pg8::pack8(a * ga, b * gb); }
          s = wave_sum(s);
          if (F.lane == 0) ss0[m] = (unsigned long long)(s * pg8::SS_SCALE + 0.5f); } }
}

__device__ __forceinline__ void p4_lora_in(Frame& F) {
    const float* lin = WSP(float, WS_R + R_LIN); bf16* al = WSP(bf16, WS_ALORA); const float* mu = F.in[7] + 3 * RC;
    const size_t gt = (size_t)F.vcu * (NWAVES * 64) + F.tid, NT = (size_t)F.G * NWAVES * 64;
    for (size_t i = gt; i < (size_t)M * 96; i += NT) { const int m = (int)(i / 96), q = (int)(i % 96); v2u o = (v2u){0u, 0u};
        if (q < 72) { const f32x4 p = *(const GAS f32x4*)(lin + (size_t)m * 288 + 4 * q); f32x4 pp = (f32x4){0.f, 0.f, 0.f, 0.f};
            if ((m & (SEQ - 1)) != 0) pp = *(const GAS f32x4*)(lin + (size_t)(m - 1) * 288 + 4 * q);
            const f32x4 mv = *(const GAS f32x4*)(mu + 4 * q); f32x4 s = p + (pp - p) * mv;
            if (q < 16) {
#pragma unroll
                for (int j = 0; j < 4; ++j) s[j] = 2.0f * fast_sigmoid(2.0f * s[j]) - 1.0f;
            } else if (q >= 32) {
#pragma unroll
                for (int j = 0; j < 4; ++j) s[j] = fast_sigmoid(s[j]); }
            o = pack4(s); }
        *(GAS v2u*)(al + (size_t)m * KL + 4 * q) = o; }
    { const bf16* rkv = WSP(bf16, WS_R + R_RKV); float* invn = WSP(float, WS_INVN); const int j4 = (F.tid & 15) * 4;
      for (size_t it = gt >> 4; it < (size_t)M * RH; it += NT >> 4) { const int m = (int)(it >> 4), h = (int)(it & 15), ch = h * RN + j4;
          const f32x4 k = unpack4(*(const GAS v2u*)(rkv + (size_t)m * 3072 + RC + ch)); f32x4 kp = (f32x4){0.f, 0.f, 0.f, 0.f};
          if ((m & (SEQ - 1)) != 0) kp = unpack4(*(const GAS v2u*)(rkv + (size_t)(m - 1) * 3072 + RC + ch));
          const f32x4 muk = *(const f32x4*)(F.in[7] + RC + ch), kkc = *(const f32x4*)(F.in[13] + ch);
          const f32x4 kk = (k + (kp - k) * muk) * kkc; float s2 = (kk[0] * kk[0] + kk[1] * kk[1]) + (kk[2] * kk[2] + kk[3] * kk[3]); s2 = row16_sum(s2);
          if ((F.tid & 15) == 0) invn[it] = 1.0f / fmaxf(sqrtf(s2), 1e-12f); } }
}

typedef short bf16x4 __attribute__((ext_vector_type(4)));
typedef short bf16x8 __attribute__((ext_vector_type(8)));
#define MFMA32(a, b, c) __builtin_amdgcn_mfma_f32_16x16x32_bf16(a, b, c, 0, 0, 0)
#define MFMA16(a, b, c) __builtin_amdgcn_mfma_f32_16x16x16bf16_1k(a, b, c, 0, 0, 0)
__device__ __forceinline__ bf16x4 cv4(f32x4 v) { v2u w; w.x = pk2(v[0], v[1]); w.y = pk2(v[2], v[3]); return __builtin_bit_cast(bf16x4, w); }
__device__ __forceinline__ bf16x8 cv8(f32x4 a, f32x4 b) { v4u w; w.x = pk2(a[0], a[1]); w.y = pk2(a[2], a[3]); w.z = pk2(b[0], b[1]); w.w = pk2(b[2], b[3]); return __builtin_bit_cast(bf16x8, w); }
__device__ __forceinline__ bf16x8 cat8(bf16x4 a, bf16x4 b) { return __builtin_shufflevector(a, b, 0, 1, 2, 3, 4, 5, 6, 7); }
__device__ __forceinline__ bf16x8 join8(v2u a, v2u b) { v4u w; w.x = a.x; w.y = a.y; w.z = b.x; w.w = b.y; return __builtin_bit_cast(bf16x8, w); }
__device__ __forceinline__ float row16_scan(float x) { x += dpp_mov<0x111>(x); x += dpp_mov<0x112>(x); x += dpp_mov<0x114>(x); x += dpp_mov<0x118>(x); return x; }
__device__ __forceinline__ unsigned short bf1(float x) { return (unsigned short)(pk2(x, 0.f) & 0xffffu); }
constexpr int CH = 16;
constexpr int RWS = 144;
constexpr int HGS = 272;
constexpr int RWB_KG = 0, RWB_RG = 16 * RWS, RWB_KTI = 32 * RWS, RWB_BTI = 48 * RWS, RWB_KTIT = 64 * RWS, RWB_BTIT = RWB_KTIT + 2048, RWB_VT = RWB_BTIT + 2048, RWB_GL = RWB_VT + 2048, RWB_BYTES = RWB_GL + 256;
constexpr int HGB_QG = 0, HGB_KI = 16 * HGS, HGB_KIT = 32 * HGS, HGB_VT = HGB_KIT + 4096, HGB_GL = HGB_VT + 4096, HGB_BYTES = HGB_GL + 512;

__device__ __forceinline__ f32x4 padc(f32x4 r) { asm("s_nop 15" : "+v"(r)); return r; }
constexpr int NCHK = SEQ / CH;
constexpr int NRAW = 5;
constexpr int RWR_R = 0, RWR_K = 2048, RWR_V = 4096, RWR_LW = 6144, RWR_A = 8192, RWR_INV = 10240, RWR_BYTES = 10304;
constexpr int RW_OPND = 0, RW_RAW = 3 * RWB_BYTES, RW_AOP = RW_RAW + NRAW * RWR_BYTES, RW_LDS = RW_AOP + 2 * 2048;
constexpr int HGR_Q = 0, HGR_LF = 4096, HGR_V = 8192, HGR_BYTES = 12288;
constexpr int HG_OPND = 0, HG_RAW = 3 * HGB_BYTES, HG_AOP = HG_RAW + NRAW * HGR_BYTES, HG_LDS = HG_AOP + 2 * 512;
static_assert(RW_LDS <= RING_BYTES && HG_LDS <= RING_BYTES && RW_AOP % 16 == 0 && HG_AOP % 16 == 0, "scan LDS map");
#define GLDS4(gptr, lptr) __builtin_amdgcn_global_load_lds((const GAS unsigned*)(gptr), (LAS unsigned*)(lptr), 4, 0, 0)
#define WG_BAR() do { LDS_WAIT(); __builtin_amdgcn_s_barrier(); asm volatile("" ::: "memory"); } while (0)

__device__ __forceinline__ void p6_rwkv_head(Frame& F, int bh) {
    const bf16* rkv = WSP(bf16, WS_R + R_RKV); const bf16* lout = WSP(bf16, WS_LOUT); const float* invn = WSP(float, WS_INVN); bf16* yc = WSP(bf16, WS_XB);
    const int lane = F.lane, c = lane & 15, g = lane >> 4, w = F.wave;
    const int b = bh >> 4, h = bh & 15;
    const size_t rowbase = (size_t)b * SEQ;
    const int st = lane & 15, k0 = 2 * (w * 4 + (lane >> 4)), chn = h * RN + k0;
    const float mur0 = F.in[7][chn], mur1 = F.in[7][chn + 1], muk0 = F.in[7][RC + chn], muk1 = F.in[7][RC + chn + 1], muv0 = F.in[7][2 * RC + chn], muv1 = F.in[7][2 * RC + chn + 1];
    const float kk0 = F.in[13][chn], kk1 = F.in[13][chn + 1], ka0 = F.in[14][chn], ka1 = F.in[14][chn + 1];
    LAS unsigned char* const opnd = F.lds + RW_OPND; LAS unsigned char* const raw = F.lds + RW_RAW; LAS unsigned char* const aop = F.lds + RW_AOP;
#define RW3_DMA(j) do { const int r_ = 2 * w + (lane >> 5); const size_t ro_ = (rowbase + (size_t)(j) * CH + r_) * 3072 + h * RN + 2 * ((lane & 31) ^ r_); \
        LAS unsigned char* d_ = raw + ((j) % NRAW) * RWR_BYTES + w * 256; \
        GLDS4(rkv + ro_, d_ + RWR_R); GLDS4(rkv + ro_ + RC, d_ + RWR_K); GLDS4(rkv + ro_ + 2 * RC, d_ + RWR_V); GLDS4(lout + ro_, d_ + RWR_LW); GLDS4(lout + ro_ + RC, d_ + RWR_A); \
        if (lane < 2) GLDS4(invn + (rowbase + (size_t)(j) * CH + 2 * w + lane) * RH + h, raw + ((j) % NRAW) * RWR_BYTES + RWR_INV + w * 8); } while (0)
#define RW3_PROC(j) do { const LAS unsigned char* s_ = raw + ((j) % NRAW) * RWR_BYTES; const int pq_ = (k0 >> 1) ^ st, pp_ = (k0 >> 1) ^ ((st + 15) & 15); \
        const LAS unsigned char* sc_ = s_ + st * 128 + pq_ * 4; const LAS unsigned char* sp_ = ((st > 0) ? s_ + (st - 1) * 128 : raw + (((j) + NRAW - 1) % NRAW) * RWR_BYTES + 15 * 128) + pp_ * 4; \
        const bool first_ = ((j) == 0) && (st == 0); \
        const unsigned Lr = *(const LAS unsigned*)(sc_ + RWR_R), Lk = *(const LAS unsigned*)(sc_ + RWR_K), Lv = *(const LAS unsigned*)(sc_ + RWR_V); \
        const unsigned Lw = *(const LAS unsigned*)(sc_ + RWR_LW), La = *(const LAS unsigned*)(sc_ + RWR_A); \
        const unsigned Lrp = *(const LAS unsigned*)(sp_ + RWR_R), Lkp = *(const LAS unsigned*)(sp_ + RWR_K), Lvp = *(const LAS unsigned*)(sp_ + RWR_V); \
        const float Linv = *(const LAS float*)(s_ + RWR_INV + st * 4); \
        const float r0_ = bflo(Lr), r1_ = bfhi(Lr), q0_ = bflo(Lk), q1_ = bfhi(Lk), v0_ = bflo(Lv), v1_ = bfhi(Lv); \
        const float rp0_ = first_ ? 0.f : bflo(Lrp), rp1_ = first_ ? 0.f : bfhi(Lrp), qp0_ = first_ ? 0.f : bflo(Lkp), qp1_ = first_ ? 0.f : bfhi(Lkp), vp0_ = first_ ? 0.f : bflo(Lvp), vp1_ = first_ ? 0.f : bfhi(Lvp); \
        const float rs0_ = r0_ + (rp0_ - r0_) * mur0, rs1_ = r1_ + (rp1_ - r1_) * mur1, ks0_ = q0_ + (qp0_ - q0_) * muk0, ks1_ = q1_ + (qp1_ - q1_) * muk1, vs0_ = v0_ + (vp0_ - v0_) * muv0, vs1_ = v1_ + (vp1_ - v1_) * muv1; \
        const float a0_ = bflo(La), a1_ = bfhi(La), lw0_ = bflo(Lw) * 1.44269504f, lw1_ = bfhi(Lw) * 1.44269504f; \
        const float kap0_ = ks0_ * kk0 * Linv, kap1_ = ks1_ * kk1 * Linv, bet0_ = kap0_ * a0_, bet1_ = kap1_ * a1_; \
        const float kt0_ = ks0_ * (1.0f + (a0_ - 1.0f) * ka0), kt1_ = ks1_ * (1.0f + (a1_ - 1.0f) * ka1); \
        const float G0_ = row16_scan(lw0_), G1_ = row16_scan(lw1_); \
        const float eg0_ = __builtin_amdgcn_exp2f(G0_), eg1_ = __builtin_amdgcn_exp2f(G1_), ep0_ = __builtin_amdgcn_exp2f(G0_ - lw0_), ep1_ = __builtin_amdgcn_exp2f(G1_ - lw1_), ei0_ = __builtin_amdgcn_exp2f(-G0_), ei1_ = __builtin_amdgcn_exp2f(-G1_); \
        LAS unsigned char* d_ = opnd + ((j) % 3) * RWB_BYTES; \
        *(LAS unsigned*)(d_ + RWB_KG + st * RWS + k0 * 2) = pk2(kap0_ * ep0_, kap1_ * ep1_); *(LAS unsigned*)(d_ + RWB_RG + st * RWS + k0 * 2) = pk2(rs0_ * eg0_, rs1_ * eg1_); \
        const unsigned kti_ = pk2(kt0_ * ei0_, kt1_ * ei1_), bti_ = pk2(bet0_ * ei0_, bet1_ * ei1_), vv_ = pk2(vs0_, vs1_); \
        *(LAS unsigned*)(d_ + RWB_KTI + st * RWS + k0 * 2) = kti_; *(LAS unsigned*)(d_ + RWB_BTI + st * RWS + k0 * 2) = bti_; \
        *(LAS unsigned short*)(d_ + RWB_KTIT + k0 * 32 + st * 2) = (unsigned short)(kti_ & 0xffffu); *(LAS unsigned short*)(d_ + RWB_KTIT + (k0 + 1) * 32 + st * 2) = (unsigned short)(kti_ >> 16); \
        *(LAS unsigned short*)(d_ + RWB_BTIT + k0 * 32 + st * 2) = (unsigned short)(bti_ & 0xffffu); *(LAS unsigned short*)(d_ + RWB_BTIT + (k0 + 1) * 32 + st * 2) = (unsigned short)(bti_ >> 16); \
        *(LAS unsigned short*)(d_ + RWB_VT + k0 * 32 + st * 2) = (unsigned short)(vv_ & 0xffffu); *(LAS unsigned short*)(d_ + RWB_VT + (k0 + 1) * 32 + st * 2) = (unsigned short)(vv_ >> 16); \
        if (st == 15) { *(LAS float*)(d_ + RWB_GL + k0 * 4) = eg0_; *(LAS float*)(d_ + RWB_GL + k0 * 4 + 4) = eg1_; } } while (0)
    const f32x4 zero4 = (f32x4){0.f, 0.f, 0.f, 0.f};
    auto a_stage = [&](int j) {
        const LAS unsigned char* rowp = opnd + (j % 3) * RWB_BYTES + c * RWS;
        const int offA = (w == 4 || w == 7) ? RWB_BTI : RWB_KTI;
        const int offB = (w == 4 || w == 5) ? RWB_KG : RWB_RG;
        const bf16x8 a0 = *(const LAS bf16x8*)(rowp + offA + 16 * g), a1 = *(const LAS bf16x8*)(rowp + offA + 64 + 16 * g);
        const bf16x8 b0 = *(const LAS bf16x8*)(rowp + offB + 16 * g), b1 = *(const LAS bf16x8*)(rowp + offB + 64 + 16 * g);
        f32x4 N = MFMA32(a0, b0, zero4); N = MFMA32(a1, b1, N);
        const bool strict = (w == 4 || w == 5);
#pragma unroll
        for (int r = 0; r < 4; ++r) { const int rj = 4 * g + r; N[r] = (strict ? (c > rj) : (c >= rj)) ? N[r] : 0.f; }
        f32x4 res = N;
        if (w == 4) {
            f32x4 N1t = MFMA32(b0, a0, zero4); N1t = MFMA32(b1, a1, N1t);
            f32x4 X;
#pragma unroll
            for (int r = 0; r < 4; ++r) { const int rj = 4 * g + r; N1t[r] = (rj > c) ? N1t[r] : 0.f; X[r] = ((rj == c) ? 1.0f : 0.f) - N[r]; }
            bf16x4 an = cv4(N), at = cv4(N1t);
            f32x4 P = MFMA16(at, an, zero4), Pt = MFMA16(an, at, zero4);
            X = MFMA16(cv4(Pt), cv4(X), padc(X));
            an = cv4(P); at = cv4(Pt);
            P = MFMA16(at, an, zero4); Pt = MFMA16(an, at, zero4);
            X = MFMA16(cv4(Pt), cv4(X), padc(X));
            an = cv4(P); at = cv4(Pt);
            Pt = MFMA16(an, at, zero4);
            X = MFMA16(cv4(Pt), cv4(X), padc(X));
            res = X;
        }
        *(LAS bf16x4*)(aop + (j & 1) * 2048 + (w - 4) * 512 + lane * 8) = cv4(res);
    };
    f32x4 Z[4];
#pragma unroll
    for (int i = 0; i < 4; ++i) Z[i] = (f32x4){0.f, 0.f, 0.f, 0.f};
#define RW3_WAIT() do { if (w < 4) asm volatile("s_waitcnt vmcnt(20)" ::: "memory"); else asm volatile("s_waitcnt vmcnt(12)" ::: "memory"); } while (0)
    { RW3_DMA(0); RW3_DMA(1); RW3_DMA(2); RW3_DMA(3); RW3_DMA(4); asm volatile("s_waitcnt vmcnt(0)" ::: "memory"); WG_BAR(); RW3_PROC(0); RW3_PROC(1); WG_BAR(); if (w >= 4) a_stage(0); WG_BAR(); }
    for (int ci = 0; ci < NCHK; ++ci) {
        const int t0 = ci * CH;
        if (ci + 2 < NCHK) RW3_PROC(ci + 2);
        if (w >= 4) { if (ci + 1 < NCHK) a_stage(ci + 1); }
        else {
            const LAS unsigned char* cur = opnd + (ci % 3) * RWB_BYTES; const LAS unsigned char* rowp = cur + c * RWS; const LAS unsigned char* ap = aop + (ci & 1) * 2048 + lane * 8;
            bf16x8 pKg[2], pRg[2];
#pragma unroll
            for (int s = 0; s < 2; ++s) {
                pKg[s] = join8(*(const LAS v2u*)(rowp + RWB_KG + 64 * s + 8 * g), *(const LAS v2u*)(rowp + RWB_KG + 64 * s + 32 + 8 * g));
                pRg[s] = join8(*(const LAS v2u*)(rowp + RWB_RG + 64 * s + 8 * g), *(const LAS v2u*)(rowp + RWB_RG + 64 * s + 32 + 8 * g)); }
            const bf16x4 bV = *(const LAS bf16x4*)(cur + RWB_VT + (16 * w + c) * 32 + 8 * g);
            const bf16x4 xT = *(const LAS bf16x4*)(ap), n2 = *(const LAS bf16x4*)(ap + 512), n3 = *(const LAS bf16x4*)(ap + 1024), n4 = *(const LAS bf16x4*)(ap + 1536);
            const bf16x8 bZ0 = cv8(Z[0], Z[1]), bZ1 = cv8(Z[2], Z[3]);
            const bf16x4 z4 = (bf16x4){0, 0, 0, 0};
            f32x4 W = MFMA32(pKg[0], bZ0, zero4); W = MFMA32(pKg[1], bZ1, W); W = MFMA32(cat8(n2, z4), cat8(bV, z4), W);
            const f32x4 U = MFMA16(xT, cv4(W), zero4);
            const bf16x4 nU = cv4(-U);
            const bf16x8 bVU = cat8(bV, nU);
            f32x4 Y = MFMA32(pRg[0], bZ0, zero4); Y = MFMA32(pRg[1], bZ1, Y); Y = MFMA32(cat8(n3, n4), bVU, Y);
#pragma unroll
            for (int r = 0; r < 4; ++r) yc[(rowbase + t0 + 4 * g + r) * 2048 + h * RN + 16 * w + c] = bf1(Y[r]);
#pragma unroll
            for (int zt = 0; zt < 4; ++zt) {
                const bf16x4 aK = *(const LAS bf16x4*)(cur + RWB_KTIT + (16 * zt + c) * 32 + 8 * g), aB = *(const LAS bf16x4*)(cur + RWB_BTIT + (16 * zt + c) * 32 + 8 * g);
                const f32x4 gl = *(const LAS f32x4*)(cur + RWB_GL + (16 * zt + 4 * g) * 4);
                Z[zt] = MFMA32(cat8(aK, aB), bVU, Z[zt]) * gl; }
        }
        { const int jn = (ci + 5 < NCHK) ? ci + 5 : NCHK - 1; RW3_DMA(jn); }
        RW3_WAIT();
        WG_BAR();
    }
#undef RW3_WAIT
#undef RW3_DMA
#undef RW3_PROC
}

__device__ __forceinline__ void p6_hgrn_head(Frame& F, int hb) {
    const bf16* hg = WSP(bf16, WS_R + R_HG); bf16* yc = WSP(bf16, WS_XB);
    const int lane = F.lane, c = lane & 15, g = lane >> 4, w = F.wave;
    const int bh = hb >> 1, half = hb & 1, b = bh >> 3, h = bh & 7, vb = half * 4 + (w & 3);
    const size_t rowbase = (size_t)b * SEQ;
    const int st = lane & 15, k0 = 4 * (w * 4 + (lane >> 4));
    LAS unsigned char* const opnd = F.lds + HG_OPND; LAS unsigned char* const raw = F.lds + HG_RAW; LAS unsigned char* const aop = F.lds + HG_AOP;
#define HG3_DMA(j) do { _Pragma("unroll") for (int rr_ = 0; rr_ < 2; ++rr_) { const int r_ = 2 * w + rr_; const bf16* p_ = hg + (rowbase + (size_t)(j) * CH + r_) * 4096 + h * HD + 2 * (2 * ((lane >> 1) ^ r_) + (lane & 1)); \
        LAS unsigned char* d_ = raw + ((j) % NRAW) * HGR_BYTES + r_ * 256; GLDS4(p_, d_ + HGR_Q); GLDS4(p_ + HC, d_ + HGR_LF); GLDS4(p_ + 2 * HC, d_ + HGR_V); } } while (0)
#define HG3_PROC(j) do { const LAS unsigned char* s_ = raw + ((j) % NRAW) * HGR_BYTES + st * 256 + (((k0 >> 2) ^ st) * 8); LAS unsigned char* d_ = opnd + ((j) % 3) * HGB_BYTES; \
        const v2u Lq = *(const LAS v2u*)(s_ + HGR_Q), Lf = *(const LAS v2u*)(s_ + HGR_LF), Lv = *(const LAS v2u*)(s_ + HGR_V); \
        const f32x4 q_ = unpack4(Lq); f32x4 lf_ = unpack4(Lf) * 1.44269504f; f32x4 qg_, ki_, eg_; \
        _Pragma("unroll") for (int e = 0; e < 4; ++e) { const float G_ = row16_scan(lf_[e]); eg_[e] = __builtin_amdgcn_exp2f(G_); qg_[e] = q_[e] * eg_[e]; ki_[e] = (1.0f - __builtin_amdgcn_exp2f(lf_[e])) * __builtin_amdgcn_exp2f(-G_); } \
        const v2u kw_ = pack4(ki_); *(LAS v2u*)(d_ + HGB_QG + st * HGS + k0 * 2) = pack4(qg_); *(LAS v2u*)(d_ + HGB_KI + st * HGS + k0 * 2) = kw_; \
        *(LAS unsigned short*)(d_ + HGB_KIT + (k0 + 0) * 32 + st * 2) = (unsigned short)(kw_.x & 0xffffu); *(LAS unsigned short*)(d_ + HGB_KIT + (k0 + 1) * 32 + st * 2) = (unsigned short)(kw_.x >> 16); \
        *(LAS unsigned short*)(d_ + HGB_KIT + (k0 + 2) * 32 + st * 2) = (unsigned short)(kw_.y & 0xffffu); *(LAS unsigned short*)(d_ + HGB_KIT + (k0 + 3) * 32 + st * 2) = (unsigned short)(kw_.y >> 16); \
        *(LAS unsigned short*)(d_ + HGB_VT + (k0 + 0) * 32 + st * 2) = (unsigned short)(Lv.x & 0xffffu); *(LAS unsigned short*)(d_ + HGB_VT + (k0 + 1) * 32 + st * 2) = (unsigned short)(Lv.x >> 16); \
        *(LAS unsigned short*)(d_ + HGB_VT + (k0 + 2) * 32 + st * 2) = (unsigned short)(Lv.y & 0xffffu); *(LAS unsigned short*)(d_ + HGB_VT + (k0 + 3) * 32 + st * 2) = (unsigned short)(Lv.y >> 16); \
        if (st == 15) *(LAS f32x4*)(d_ + HGB_GL + k0 * 4) = eg_; } while (0)
    const f32x4 zero4 = (f32x4){0.f, 0.f, 0.f, 0.f};
    auto a_stage = [&](int j) {
        const LAS unsigned char* rowp = opnd + (j % 3) * HGB_BYTES + c * HGS;
        f32x4 N = zero4;
#pragma unroll
        for (int s = 0; s < 4; ++s) { const bf16x8 nQ = *(const LAS bf16x8*)(rowp + HGB_QG + 64 * s + 16 * g), nK = *(const LAS bf16x8*)(rowp + HGB_KI + 64 * s + 16 * g); N = MFMA32(nK, nQ, N); }
#pragma unroll
        for (int r = 0; r < 4; ++r) N[r] = (c >= 4 * g + r) ? N[r] : 0.f;
        *(LAS bf16x4*)(aop + (j & 1) * 512 + lane * 8) = cv4(N);
    };
    f32x4 Z[8];
#pragma unroll
    for (int i = 0; i < 8; ++i) Z[i] = (f32x4){0.f, 0.f, 0.f, 0.f};
#define HG3_WAIT() do { if (w < 4) asm volatile("s_waitcnt vmcnt(20)" ::: "memory"); else asm volatile("s_waitcnt vmcnt(12)" ::: "memory"); } while (0)
    { HG3_DMA(0); HG3_DMA(1); HG3_DMA(2); HG3_DMA(3); HG3_DMA(4); asm volatile("s_waitcnt vmcnt(0)" ::: "memory"); WG_BAR(); HG3_PROC(0); HG3_PROC(1); WG_BAR(); if (w == 4) a_stage(0); WG_BAR(); }
    for (int ci = 0; ci < NCHK; ++ci) {
        const int t0 = ci * CH;
        if (ci + 2 < NCHK) HG3_PROC(ci + 2);
        if (w == 4) { if (ci + 1 < NCHK) a_stage(ci + 1); }
        else if (w < 4) {
            const LAS unsigned char* cur = opnd + (ci % 3) * HGB_BYTES; const LAS unsigned char* rowp = cur + c * HGS;
            f32x4 Y = zero4;
#pragma unroll
            for (int s = 0; s < 4; ++s) {
                const bf16x8 pQ = join8(*(const LAS v2u*)(rowp + HGB_QG + 64 * s + 8 * g), *(const LAS v2u*)(rowp + HGB_QG + 64 * s + 32 + 8 * g));
                Y = MFMA32(pQ, cv8(Z[2 * s], Z[2 * s + 1]), Y); }
            const bf16x4 bV = *(const LAS bf16x4*)(cur + HGB_VT + (16 * vb + c) * 32 + 8 * g);
            const bf16x4 n = *(const LAS bf16x4*)(aop + (ci & 1) * 512 + lane * 8);
            const bf16x4 z4 = (bf16x4){0, 0, 0, 0};
            Y = MFMA32(cat8(n, z4), cat8(bV, z4), Y);
#pragma unroll
            for (int r = 0; r < 4; ++r) yc[(rowbase + t0 + 4 * g + r) * 2048 + RC + h * HD + 16 * vb + c] = bf1(Y[r]);
#pragma unroll
            for (int zt = 0; zt < 8; ++zt) {
                const bf16x4 aK = *(const LAS bf16x4*)(cur + HGB_KIT + (16 * zt + c) * 32 + 8 * g);
                const f32x4 gl = *(const LAS f32x4*)(cur + HGB_GL + (16 * zt + 4 * g) * 4);
                Z[zt] = MFMA16(aK, bV, Z[zt]) * gl; }
        }
        { const int jn = (ci + 5 < NCHK) ? ci + 5 : NCHK - 1; HG3_DMA(jn); }
        HG3_WAIT();
        WG_BAR();
    }
#undef HG3_WAIT
#undef HG3_DMA
#undef HG3_PROC
}
#undef WG_BAR
__device__ __forceinline__ void p6_scans(Frame& F) {
    for (int u = (int)blockIdx.x; u < BATCH * RH + 2 * BATCH * HH; u += F.G) {
        if (u < BATCH * RH) p6_rwkv_head(F, u); else p6_hgrn_head(F, u - BATCH * RH);
    }
}

__device__ __forceinline__ void p7_post(Frame& F) {
    const bf16* rkv = WSP(bf16, WS_R + R_RKV); const bf16* hg = WSP(bf16, WS_R + R_HG); const bf16* lout = WSP(bf16, WS_LOUT); bf16* yc = WSP(bf16, WS_XB);
    { const int half = F.tid >> 8, ch = (F.tid & 255) * 4;
      const f32x4 mu_r = *(const f32x4*)(F.in[7] + ch), mu_k = *(const f32x4*)(F.in[7] + RC + ch), mu_v = *(const f32x4*)(F.in[7] + 2 * RC + ch);
      const f32x4 kac = *(const f32x4*)(F.in[14] + ch), rkc = *(const f32x4*)(F.in[15] + ch), lnw = *(const f32x4*)(F.in[16] + ch), lnb = *(const f32x4*)(F.in[17] + ch);
      for (int m = F.vcu * 2 + half; m < M; m += 2 * F.G) {
          const bool first = (m & (SEQ - 1)) == 0; const size_t mp = first ? m : m - 1;
          const bf16* p = rkv + (size_t)m * 3072 + ch; const bf16* q = rkv + mp * 3072 + ch; const bf16* l = lout + (size_t)m * 3072 + ch;
          const f32x4 y = unpack4(*(const GAS v2u*)(yc + (size_t)m * 2048 + ch));
          const f32x4 r = unpack4(*(const GAS v2u*)(p)), k = unpack4(*(const GAS v2u*)(p + RC)), v = unpack4(*(const GAS v2u*)(p + 2 * RC));
          f32x4 rp = unpack4(*(const GAS v2u*)(q)), kp = unpack4(*(const GAS v2u*)(q + RC)), vp = unpack4(*(const GAS v2u*)(q + 2 * RC));
          if (first) { rp = (f32x4){0.f, 0.f, 0.f, 0.f}; kp = rp; vp = rp; }
          const f32x4 a = unpack4(*(const GAS v2u*)(l + RC)), gg = unpack4(*(const GAS v2u*)(l + 2 * RC));
          const f32x4 rs = r + (rp - r) * mu_r, ks = k + (kp - k) * mu_k, vs = v + (vp - v) * mu_v;
          const f32x4 km = ks * (1.0f + (a - 1.0f) * kac);
          const f32x4 bt = rs * km * rkc; float bon = (bt[0] + bt[1]) + (bt[2] + bt[3]); bon = row16_sum(bon);
          float s1 = (y[0] + y[1]) + (y[2] + y[3]); s1 = row16_sum(s1); const float mean = s1 * (1.0f / 64.0f);
          const f32x4 d = y - mean; float s2 = (d[0] * d[0] + d[1] * d[1]) + (d[2] * d[2] + d[3] * d[3]); s2 = row16_sum(s2);
          const float rstd = 1.0f / sqrtf(s2 * (1.0f / 64.0f) + 64e-5f);
          const f32x4 o = ((d * rstd) * lnw + lnb + vs * bon) * gg;
          *(GAS v2u*)(yc + (size_t)m * 2048 + ch) = pack4(o); } }
    { const int quarter = F.tid >> 7, ch = (F.tid & 127) * 8;
      const f32x4 nw0 = *(const f32x4*)(F.in[19] + ch), nw1 = *(const f32x4*)(F.in[19] + ch + 4);
      for (int m = F.vcu * 4 + quarter; m < M; m += 4 * F.G) {
          const v4u ow = *(const GAS v4u*)(yc + (size_t)m * 2048 + RC + ch), gw4 = *(const GAS v4u*)(hg + (size_t)m * 4096 + 3 * HC + ch);
          const f32x4 o0 = (f32x4){bflo(ow.x), bfhi(ow.x), bflo(ow.y), bfhi(ow.y)}, o1 = (f32x4){bflo(ow.z), bfhi(ow.z), bflo(ow.w), bfhi(ow.w)};
          const f32x4 g0 = (f32x4){bflo(gw4.x), bfhi(gw4.x), bflo(gw4.y), bfhi(gw4.y)}, g1 = (f32x4){bflo(gw4.z), bfhi(gw4.z), bflo(gw4.w), bfhi(gw4.w)};
          float s2 = ((o0[0] * o0[0] + o0[1] * o0[1]) + (o0[2] * o0[2] + o0[3] * o0[3])) + ((o1[0] * o1[0] + o1[1] * o1[1]) + (o1[2] * o1[2] + o1[3] * o1[3])); s2 = row16_sum(s2);
          const float rstd = 1.0f / sqrtf(s2 * (1.0f / 128.0f) + 1e-6f);
          *(GAS v4u*)(yc + (size_t)m * 2048 + RC + ch) = pg8::pack8(o0 * rstd * nw0 * g0, o1 * rstd * nw1 * g1); } }
}

__device__ __forceinline__ void p11_final(Frame& F) {
    const int gw = F.vcu * NWAVES + F.wave, NGW = F.G * NWAVES; const float* fg = F.in[25];
    f32x4 gn[8];
#pragma unroll
    for (int i = 0; i < 8; ++i) gn[i] = *(const f32x4*)(fg + 4 * F.lane + 256 * i);
    for (int m = gw; m < M; m += NGW) { GAS f32x4* xr = (GAS f32x4*)(F.out + (size_t)m * D) + F.lane; f32x4 v[8]; float s = 0.f;
#pragma unroll
        for (int i = 0; i < 8; ++i) { v[i] = xr[64 * i]; s += (v[i][0] * v[i][0] + v[i][1] * v[i][1]) + (v[i][2] * v[i][2] + v[i][3] * v[i][3]); }
        s = wave_sum(s); const float inv = 1.0f / sqrtf(s * (1.0f / D) + 1e-6f);
#pragma unroll
        for (int i = 0; i < 8; ++i) xr[64 * i] = v[i] * inv * gn[i]; }
}

__global__ void __launch_bounds__(NWAVES * 64, 2) mk_fwd(Args args) {
    extern __shared__ __attribute__((aligned(16))) unsigned char lds[];
    Frame F;
    F.lds = (LAS unsigned char*)lds;
    F.tid = threadIdx.x; F.lane = F.tid & 63; F.wave = __builtin_amdgcn_readfirstlane(F.tid >> 6);
    F.G = gridDim.x; { const int bx = blockIdx.x; F.vcu = (F.G % 8 == 0) ? (bx % 8) * (F.G / 8) + bx / 8 : bx; }
#pragma unroll
    for (int i = 0; i < 26; ++i) F.in[i] = args.in[i];
    F.out = args.out; F.ws = args.ws;
    for (int u = F.tid; u < (LDS_BYTES - LDSCTL_OFF) / 4; u += NWAVES * 64) ((LAS unsigned*)(F.lds + LDSCTL_OFF))[u] = 0u;
    __syncthreads();
    const int lo = args.ph_lo, hi = args.ph_hi;
    XcdBarrier bar; bar.bar = (unsigned*)(args.ws + WS_CTL) + CW_BAR; bar.x = 0; bar.st = nullptr;
    if (hi - lo > 1) bar = xcd_barrier_post((unsigned*)(args.ws + WS_CTL) + CW_BAR, (volatile LAS unsigned*)(F.lds + MISC_OFF) + 8);
#ifndef PH_MASK
#define PH_MASK 0xFFF
#endif
#define IN(k) (((PH_MASK >> (k)) & 1) && lo <= (k) && (k) < hi)
#define SEAM(k) do { if (IN(k) && IN((k) + 1)) xcd_barrier(bar); } while (0)
    const bf16* xb = WSP(bf16, WS_XB); unsigned long long* ss = WSP(unsigned long long, WS_SS);
    const int cid = (int)blockIdx.x;

    if (IN(0)) { p0_prologue(F, args); } SEAM(0);
    if (IN(1)) {
        pg8::Gemm g{xb, WSP(bf16, WS_W1GU), M, 2 * FF, D}; pg8::StaticOrder S; S.init(M, 2 * FF, F.G, cid);
        pg8::EpiSwiglu E{WSP(bf16, WS_R + R_ACT), FF, ss};
        pg8::gemm_phase<pg8::EpiSwiglu, pg8::StaticOrder, true, true>(F.lds, g, S, E);
    } SEAM(1);
    if (IN(2)) {
        pg8::Gemm g{WSP(bf16, WS_R + R_ACT), WSP(bf16, WS_W1D), M, D, FF}; pg8::StaticOrder S; S.init(M, D, F.G, cid);
        pg8::EpiResid E{F.in[0], F.out, WSP(bf16, WS_XB), ss + M, 0.5f, F.in[5]};
        pg8::gemm_phase<pg8::EpiResid, pg8::StaticOrder, true, true>(F.lds, g, S, E);
    } SEAM(2);
    if (IN(3)) {
        pg8::Gemm g{xb, WSP(bf16, WS_WIN), M, NIN, D}; pg8::StaticOrder S; S.init(M, NIN, F.G, cid);
        pg8::EpiInProj E{WSP(bf16, WS_R + R_RKV), WSP(float, WS_R + R_LIN), WSP(bf16, WS_R + R_HG), ss + M, F.in[18]};
        pg8::gemm_phase<pg8::EpiInProj, pg8::StaticOrder, true, true>(F.lds, g, S, E);
    } SEAM(3);
    if (IN(4)) { p4_lora_in(F); } SEAM(4);
    if (IN(5)) {
        int kl = KL; asm volatile("" : "+s"(kl));
        pg8::Gemm g{WSP(bf16, WS_ALORA), WSP(bf16, WS_WLORA), M, NL, kl}; pg8::StaticOrder S; S.init(M, NL, F.G, cid);
        pg8::EpiLora E{WSP(bf16, WS_LOUT), F.in[8], F.in[10]};
        pg8::gemm_phase<pg8::EpiLora, pg8::StaticOrder, true, true>(F.lds, g, S, E);
    } SEAM(5);
    if (IN(6)) { p6_scans(F); } SEAM(6);
    if (IN(7)) { p7_post(F); } SEAM(7);
    if (IN(8)) {
        pg8::Gemm g{xb, WSP(bf16, WS_WOUT), M, D, D}; pg8::StaticOrder S; S.init(M, D, F.G, cid);
        pg8::EpiResid E{F.out, F.out, WSP(bf16, WS_R + R_X2B), ss + 2 * M, 1.0f, F.in[21]};
        pg8::gemm_phase<pg8::EpiResid, pg8::StaticOrder, true, true>(F.lds, g, S, E);
    } SEAM(8);
    if (IN(9)) {
        pg8::Gemm g{WSP(bf16, WS_R + R_X2B), WSP(bf16, WS_W2GU), M, 2 * FF, D}; pg8::StaticOrder S; S.init(M, 2 * FF, F.G, cid);
        pg8::EpiSwiglu E{WSP(bf16, WS_R + R_ACT), FF, ss + 2 * M};
        pg8::gemm_phase<pg8::EpiSwiglu, pg8::StaticOrder, true, true>(F.lds, g, S, E);
    } SEAM(9);
    if (IN(10)) {
        pg8::Gemm g{WSP(bf16, WS_R + R_ACT), WSP(bf16, WS_W2D), M, D, FF}; pg8::StaticOrder S; S.init(M, D, F.G, cid);
        pg8::EpiResid E{F.out, F.out, nullptr, nullptr, 0.5f, nullptr};
        pg8::gemm_phase<pg8::EpiResid, pg8::StaticOrder, true, true>(F.lds, g, S, E);
    } SEAM(10);
    if (IN(11)) { p11_final(F); }
#undef IN
#undef SEAM
}

extern "C" void kernel_launch(void* const* d_in, const int* in_sizes, int n_in, void* d_out, int out_size, void* d_ws, size_t ws_size, hipStream_t stream) {
    static int grid = 0;
    if (grid == 0) {
        if (n_in != 26 || in_sizes[0] != M * D || out_size != M * D || ws_size < WS_END) { fprintf(stderr, "kernel_launch: unexpected problem (n_in %d, ws %zu < %zu)\n", n_in, ws_size, (size_t)WS_END); grid = -1; return; }
        int dev = 0, cus = 0, per_cu = 0;
        if (hipGetDevice(&dev) != hipSuccess || hipDeviceGetAttribute(&cus, hipDeviceAttributeMultiprocessorCount, dev) != hipSuccess) { grid = -1; return; }
        if (hipFuncSetAttribute((const void*)mk_fwd, hipFuncAttributeMaxDynamicSharedMemorySize, LDS_BYTES) != hipSuccess) { grid = -1; return; }
        if (hipOccupancyMaxActiveBlocksPerMultiprocessor(&per_cu, (const void*)mk_fwd, NWAVES * 64, LDS_BYTES) != hipSuccess || per_cu < 1) fprintf(stderr, "kernel_launch: occupancy query reports %d\n", per_cu);
        (void)hipGetLastError();
        grid = cus;
    }
    if (grid < 0) return;
    (void)hipMemsetAsync((char*)d_ws + WS_CTL, 0, CTL_BYTES, stream);
    Args a{};
    for (int i = 0; i < 26; ++i) a.in[i] = (const float*)d_in[i];
    a.out = (float*)d_out; a.ws = (unsigned char*)d_ws;
    constexpr int NL_ = MK_N_LAUNCHES;
    for (int li = 0; li < NL_; ++li) {
        a.ph_lo = (NL_ == 1) ? 0 : li; a.ph_hi = (NL_ == 1) ? N_PHASES : li + 1;
        hipLaunchKernelGGL(mk_fwd, dim3(grid), dim3(NWAVES * 64), LDS_BYTES, stream, a);
    }
}
```

```cpp
#include <hip/hip_runtime.h>
#include <cstdio>
#include <cstdint>
namespace pg8 {
#define PG8_LAS __attribute__((address_space(3)))
typedef unsigned short bf16_t;
typedef short bf16x8 __attribute__((ext_vector_type(8)));
typedef float f32x4 __attribute__((ext_vector_type(4)));
typedef unsigned u32x4 __attribute__((ext_vector_type(4)));
constexpr int BM = 256, BK = 64, HALF = 128, HTB = HALF * BK * 2  , STAGE_BYTES = 8 * HTB, NXCD = 8, WGM = 8;

__host__ __device__ __forceinline__ int lds_byte(int r, int c) { const int st = (r >> 4) * 2 + (c >> 5), rr = r & 15, cc = c & 31, ob = rr * 64 + cc * 2; return st * 1024 + (ob ^ (((ob >> 9) & 1) << 5)); }
__host__ __device__ __forceinline__ void stage_rc(int b, int& R, int& C) { const int st = b / 1024, sb = b % 1024, swz = sb ^ (((sb >> 9) & 1) << 5); R = (st >> 1) * 16 + swz / 64; C = (st & 1) * 32 + (swz % 64) / 2; }
__host__ __device__ __forceinline__ int perm32(int rho) { const int n = rho >> 4, i = rho & 15; return 8 * (i >> 2) + 4 * n + (i & 3); }

struct Unit { int pm, pn; };
struct Gemm { const bf16_t* A; const bf16_t* Bt; int M, N, K; };

struct StaticOrder {
    int nM, nN, nwg, G, c;
    __host__ __device__ void init(int M, int N, int G_, int c_) { nM = M / BM; nN = N / BM; nwg = nM * nN; G = G_; c = c_; }
    __host__ __device__ bool next(int i, Unit& u) const {
        const long L = (long)i * G + c; if (L >= nwg) return false;
        int wgid = (int)L; { const int q = nwg / NXCD, r = nwg % NXCD, xcd = wgid % NXCD, off = wgid / NXCD; wgid = (xcd < r ? xcd * (q + 1) : r * (q + 1) + (xcd - r) * q) + off; }
        const int nig = WGM * nN, gid = wgid / nig, fm = gid * WGM, gsz = (nM - fm) < WGM ? (nM - fm) : WGM;
        u.pm = fm + ((wgid % nig) % gsz); u.pn = (wgid % nig) / gsz; return true;
    }
    __device__ __forceinline__ void a_ready(const Unit&) const {}
    __device__ __forceinline__ void done(const Unit&) const {}
};


typedef __bf16 bf16n2 __attribute__((ext_vector_type(2)));
__device__ __forceinline__ unsigned cvt_pk_bf16(float lo, float hi) { bf16n2 v; v.x = (__bf16)lo; v.y = (__bf16)hi; return __builtin_bit_cast(unsigned, v); }
__device__ __forceinline__ float fast_sigmoid(float z) { return __builtin_amdgcn_rcpf(1.0f + __builtin_amdgcn_exp2f(-1.44269504f * z)); }
__device__ __forceinline__ float fast_silu(float z) { return z * fast_sigmoid(z); }
constexpr float SS_SCALE = 16777216.0f;
__device__ __forceinline__ float inv_rms_from_val(unsigned long long v) {
    const float tot = (float)v * (1.0f / SS_SCALE);
    return 1.0f / sqrtf(tot * (1.0f / 2048.0f) + 1e-6f);
}
__device__ __forceinline__ u32x4 pack8(const f32x4 v0, const f32x4 v1) { u32x4 w; w.x = cvt_pk_bf16(v0[0], v0[1]); w.y = cvt_pk_bf16(v0[2], v0[3]); w.z = cvt_pk_bf16(v1[0], v1[1]); w.w = cvt_pk_bf16(v1[2], v1[3]); return w; }

struct EpiSwiglu {
    static constexpr bool PERM = true, AFTER_DRAIN = false;
    bf16_t* O; int ldc; const unsigned long long* ss;
    __device__ __forceinline__ void operator()(const f32x4 (&acc)[2][2][4][2], const Unit& u, int wr, int wc, int fr, int fq) const {
        const int row0 = u.pm * BM + wr * 64 + fr, col0 = u.pn * HALF + wc * 32 + 8 * fq;
        unsigned long long sv[2][4];
#pragma unroll
        for (int ai = 0; ai < 2; ++ai)
#pragma unroll
            for (int m = 0; m < 4; ++m) sv[ai][m] = ss[row0 + ai * HALF + m * 16];
#pragma unroll
        for (int ai = 0; ai < 2; ++ai)
#pragma unroll
            for (int m = 0; m < 4; ++m) { const int row = row0 + ai * HALF + m * 16; const float inv = inv_rms_from_val(sv[ai][m]);
                f32x4 o[2];
#pragma unroll
                for (int n = 0; n < 2; ++n) { const f32x4 g = acc[ai][0][m][n] * inv, up = acc[ai][1][m][n] * inv;
#pragma unroll
                    for (int j = 0; j < 4; ++j) o[n][j] = fast_silu(g[j]) * up[j]; }
                *(u32x4*)(O + (size_t)row * ldc + col0) = pack8(o[0], o[1]); }
    }
};
struct EpiResid {
    static constexpr bool PERM = true, AFTER_DRAIN = false;
    const float* resid; float* out; bf16_t* ob; unsigned long long* ss; float alpha; const float* gain;
    __device__ __forceinline__ void operator()(const f32x4 (&acc)[2][2][4][2], const Unit& u, int wr, int wc, int fr, int fq) const {
        const int row0 = u.pm * BM + wr * 64 + fr, col0 = u.pn * BM + wc * 32 + 8 * fq;
#pragma unroll
        for (int ai = 0; ai < 2; ++ai)
#pragma unroll
            for (int m = 0; m < 4; ++m) { const int row = row0 + ai * HALF + m * 16; const size_t off = (size_t)row * 2048 + col0; float s = 0.f;
#pragma unroll
                for (int bj = 0; bj < 2; ++bj) {
                    const f32x4 r0 = *(const f32x4*)(resid + off + bj * HALF), r1 = *(const f32x4*)(resid + off + bj * HALF + 4);
                    const f32x4 o0 = r0 + acc[ai][bj][m][0] * alpha, o1 = r1 + acc[ai][bj][m][1] * alpha;
                    *(f32x4*)(out + off + bj * HALF) = o0; *(f32x4*)(out + off + bj * HALF + 4) = o1;
                    if (ob) { const f32x4 g0 = *(const f32x4*)(gain + col0 + bj * HALF), g1 = *(const f32x4*)(gain + col0 + bj * HALF + 4); *(u32x4*)(ob + off + bj * HALF) = pack8(o0 * g0, o1 * g1); }
                    s += (o0[0] * o0[0] + o0[1] * o0[1]) + (o0[2] * o0[2] + o0[3] * o0[3]) + (o1[0] * o1[0] + o1[1] * o1[1]) + (o1[2] * o1[2] + o1[3] * o1[3]); }
                if (ss) { s += __shfl_xor(s, 16); s += __shfl_xor(s, 32);
                    if (fq == 0) atomicAdd(ss + row, (unsigned long long)(s * SS_SCALE + 0.5f)); } }
    }
};
struct EpiInProj {
    static constexpr bool PERM = true, AFTER_DRAIN = false;
    bf16_t* rkv; float* lin; bf16_t* hg; const unsigned long long* ss; const float* lbl; int pn0;
    __device__ __forceinline__ void operator()(const f32x4 (&acc)[2][2][4][2], const Unit& u, int wr, int wc, int fr, int fq) const {
        const int row0 = u.pm * BM + wr * 64 + fr, cin = wc * 32 + 8 * fq;
        const int pn = u.pn + pn0;
        float invs[2][4];
        { unsigned long long sv[2][4];
#pragma unroll
          for (int ai = 0; ai < 2; ++ai)
#pragma unroll
              for (int m = 0; m < 4; ++m) sv[ai][m] = ss[row0 + ai * HALF + m * 16];
#pragma unroll
          for (int ai = 0; ai < 2; ++ai)
#pragma unroll
              for (int m = 0; m < 4; ++m) invs[ai][m] = inv_rms_from_val(sv[ai][m]); }
        int mode;
        if (pn < 12) mode = 0; else if (pn < 14) mode = 1; else { const int sg = (pn - 14) >> 2; mode = (sg == 0 || sg == 3) ? 2 : (sg == 1 ? 3 : 4); }
#pragma unroll
        for (int bj = 0; bj < 2; ++bj) {
            f32x4 om0 = (f32x4){0.f, 0.f, 0.f, 0.f}, om1 = om0;
            if (mode == 3) { const float* lp = lbl + (pn - 18) * BM + bj * HALF + cin; const f32x4 a0 = *(const f32x4*)lp, a1 = *(const f32x4*)(lp + 4), c0 = *(const f32x4*)(lp + 1024), c1 = *(const f32x4*)(lp + 1028);
#pragma unroll
                for (int j = 0; j < 4; ++j) { om0[j] = 1.0f - fast_sigmoid(a0[j] - c0[j]); om1[j] = 1.0f - fast_sigmoid(a1[j] - c1[j]); } }
#pragma unroll
            for (int ai = 0; ai < 2; ++ai)
#pragma unroll
                for (int m = 0; m < 4; ++m) { const int row = row0 + ai * HALF + m * 16; const float inv = invs[ai][m];
                    f32x4 v0 = acc[ai][bj][m][0] * inv, v1 = acc[ai][bj][m][1] * inv;
                    if (mode == 0) { *(u32x4*)(rkv + (size_t)row * 3072 + pn * BM + bj * HALF + cin) = pack8(v0, v1); }
                    else if (mode == 1) { const int cl = (pn - 12) * BM + bj * HALF + cin;
                        if (cl < 288) { *(f32x4*)(lin + (size_t)row * 288 + cl) = v0; *(f32x4*)(lin + (size_t)row * 288 + cl + 4) = v1; } }
                    else {
                        if (mode == 2) {
#pragma unroll
                            for (int j = 0; j < 4; ++j) { v0[j] = fast_silu(v0[j]); v1[j] = fast_silu(v1[j]); } }
                        else if (mode == 3) {
#pragma unroll
                            for (int j = 0; j < 4; ++j) { v0[j] = __logf(1.0f - om0[j] * fast_sigmoid(-v0[j])); v1[j] = __logf(1.0f - om1[j] * fast_sigmoid(-v1[j])); } }
                        *(u32x4*)(hg + (size_t)row * 4096 + (pn - 14) * BM + bj * HALF + cin) = pack8(v0, v1); } } }
    }
};
struct EpiLora {
    static constexpr bool PERM = true, AFTER_DRAIN = false;
    bf16_t* lout; const float* w0; const float* a0; int pn0;
    __device__ __forceinline__ void operator()(const f32x4 (&acc)[2][2][4][2], const Unit& u, int wr, int wc, int fr, int fq) const {
        const int row0 = u.pm * BM + wr * 64 + fr, cin = wc * 32 + 8 * fq;
        const int pn = u.pn + pn0, mode = pn >> 2;
#pragma unroll
        for (int bj = 0; bj < 2; ++bj) {
            f32x4 b0 = (f32x4){0.f, 0.f, 0.f, 0.f}, b1 = b0;
            if (mode < 2) { const float* bp = (mode == 0 ? w0 : a0) + (pn & 3) * BM + bj * HALF + cin; b0 = *(const f32x4*)bp; b1 = *(const f32x4*)(bp + 4); }
#pragma unroll
            for (int ai = 0; ai < 2; ++ai)
#pragma unroll
                for (int m = 0; m < 4; ++m) { const int row = row0 + ai * HALF + m * 16;
                    f32x4 v0 = acc[ai][bj][m][0] + b0, v1 = acc[ai][bj][m][1] + b1;
#pragma unroll
                    for (int j = 0; j < 4; ++j) { const float s0 = fast_sigmoid(v0[j]), s1 = fast_sigmoid(v1[j]);
                        const float d0 = -0.60653066f * s0, d1 = -0.60653066f * s1;
                        v0[j] = mode == 0 ? d0 : (mode == 1 ? s0 : v0[j]); v1[j] = mode == 0 ? d1 : (mode == 1 ? s1 : v1[j]); }
                    *(u32x4*)(lout + (size_t)row * 3072 + pn * BM + bj * HALF + cin) = pack8(v0, v1); asm volatile("" ::: "memory"); } }
    }
};
template <class Epi, class Sched, bool ALIGN_EPI = false, bool SP2 = false>
__device__ __forceinline__ void gemm_phase(PG8_LAS unsigned char* lds, const Gemm g, const Sched& S, const Epi& E) {
    const int tid = threadIdx.x, wid = __builtin_amdgcn_readfirstlane(tid >> 6), lane = tid & 63, wr = wid >> 2, wc = wid & 3, fr = lane & 15, fq = lane >> 4;
    const int K = g.K, nt = K / BK;
    unsigned voffA[2], voffB[2];
#pragma unroll
    for (int i = 0; i < 2; ++i) { int R, C; stage_rc(tid * 16 + i * 8192, R, C); const int Rb = Epi::PERM ? ((R & ~31) + perm32(R & 31)) : R;
        voffA[i] = (unsigned)(R * K + C) * 2u; voffB[i] = (unsigned)(Rb * K + C) * 2u; }
    const size_t kstep = (size_t)(BK * 2);
    const size_t hstep = (size_t)HALF * K * 2;
    const size_t tstep = 2 * hstep;
    const unsigned ldsw = (unsigned)wid * 1024u;
    const int aoff = lds_byte(wr * 64 + fr, fq * 8), boff = lds_byte(wc * 32 + fr, fq * 8);
#define PG8_SA(b, h) (((b) * 2 + (h)) * HTB)
#define PG8_SB(b, h) ((4 + (b) * 2 + (h)) * HTB)
#define PG8_STAGE(bufoff, gbase, voff) do { _Pragma("unroll") for (int _i = 0; _i < 2; ++_i) \
        __builtin_amdgcn_global_load_lds((const unsigned*)((const char*)(gbase) + (voff)[_i]), (PG8_LAS unsigned*)(lds + (bufoff) + ldsw + _i * 8192), 16, 0, 0); } while (0)
#define PG8_LDA(dst, b, h) do { _Pragma("unroll") for (int m = 0; m < 4; ++m) _Pragma("unroll") for (int k = 0; k < 2; ++k) dst[m][k] = *(const PG8_LAS bf16x8*)(lds + PG8_SA(b, h) + aoff + m * 2048 + k * 1024); } while (0)
#define PG8_LDB(dst, b, h) do { _Pragma("unroll") for (int n = 0; n < 2; ++n) _Pragma("unroll") for (int k = 0; k < 2; ++k) dst[n][k] = *(const PG8_LAS bf16x8*)(lds + PG8_SB(b, h) + boff + n * 2048 + k * 1024); } while (0)
#define PG8_MMA(ai, bj, At, Bt) do { __builtin_amdgcn_s_setprio(1); _Pragma("unroll") for (int m = 0; m < 4; ++m) _Pragma("unroll") for (int n = 0; n < 2; ++n) _Pragma("unroll") for (int k = 0; k < 2; ++k) \
        acc[ai][bj][m][n] = __builtin_amdgcn_mfma_f32_16x16x32_bf16(Bt[n][k], At[m][k], acc[ai][bj][m][n], 0, 0, 0); __builtin_amdgcn_s_setprio(0); } while (0)
#define PG8_WAIT_V(n) asm volatile("s_waitcnt vmcnt(" #n ")" ::: "memory")
#define PG8_WAIT_L(n) asm volatile("s_waitcnt lgkmcnt(" #n ")" ::: "memory")
#define PG8_BAR __builtin_amdgcn_s_barrier()
#define PG8_SCHED __builtin_amdgcn_sched_barrier(0)
    Unit cur, nxt; int ui = 0;
    if (!S.next(0, cur)) return;
    f32x4 acc[2][2][4][2];
#pragma unroll
    for (int a = 0; a < 2; ++a)
#pragma unroll
        for (int b = 0; b < 2; ++b)
#pragma unroll
            for (int m = 0; m < 4; ++m)
#pragma unroll
                for (int n = 0; n < 2; ++n) acc[a][b][m][n] = (f32x4){0.f, 0.f, 0.f, 0.f};
    bf16x8 At[4][2], B0[2][2], B1[2][2];
    const char* cA = (const char*)g.A + (size_t)cur.pm * tstep; const char* cB = (const char*)g.Bt + (size_t)cur.pn * tstep;
    S.a_ready(cur);
    if constexpr (SP2) {
        PG8_STAGE(PG8_SB(0, 0), cB, voffB); PG8_STAGE(PG8_SB(0, 1), cB + hstep, voffB); PG8_STAGE(PG8_SA(0, 0), cA, voffA); PG8_STAGE(PG8_SA(0, 1), cA + hstep, voffA);
        if (wr == 1) PG8_BAR;
        PG8_WAIT_V(2); PG8_BAR;
        PG8_STAGE(PG8_SB(1, 0), cB + kstep, voffB); PG8_STAGE(PG8_SA(1, 0), cA + kstep, voffA); PG8_STAGE(PG8_SB(1, 1), cB + hstep + kstep, voffB);
        PG8_WAIT_V(6); PG8_BAR;
    } else {
        PG8_STAGE(PG8_SB(0, 0), cB, voffB); PG8_STAGE(PG8_SA(0, 0), cA, voffA); PG8_STAGE(PG8_SB(0, 1), cB + hstep, voffB); PG8_STAGE(PG8_SA(0, 1), cA + hstep, voffA);
        if (wr == 1) PG8_BAR;
        PG8_WAIT_V(4); PG8_BAR;
        PG8_STAGE(PG8_SB(1, 0), cB + kstep, voffB); PG8_STAGE(PG8_SA(1, 0), cA + kstep, voffA); PG8_STAGE(PG8_SB(1, 1), cB + hstep + kstep, voffB);
        PG8_WAIT_V(6); PG8_BAR;
    }
    for (;;) {
        const bool has_next = S.next(ui + 1, nxt);
        const char* nA = has_next ? (const char*)g.A + (size_t)nxt.pm * tstep : cA; const char* nB = has_next ? (const char*)g.Bt + (size_t)nxt.pn * tstep : cB;
        for (int t = 0; t < nt; t += 2) {
            const bool last = (t == nt - 2);
            const char* a1 = cA + (size_t)(t + 1) * kstep;
            const char* a2 = last ? nA : cA + (size_t)(t + 2) * kstep; const char* b2 = last ? nB : cB + (size_t)(t + 2) * kstep;
            const char* a3 = a2 + kstep; const char* b3 = b2 + kstep;
            if (last && has_next) S.a_ready(nxt);
            if constexpr (SP2) {
            PG8_LDB(B0, 0, 0); PG8_LDB(B1, 0, 1); PG8_SCHED; PG8_LDA(At, 0, 0); PG8_STAGE(PG8_SA(1, 1), a1 + hstep, voffA);
            PG8_WAIT_V(8); PG8_WAIT_L(0); PG8_BAR; PG8_MMA(0, 0, At, B0); PG8_MMA(0, 1, At, B1); PG8_BAR; PG8_SCHED;
            PG8_LDA(At, 0, 1); PG8_STAGE(PG8_SB(0, 0), b2, voffB); PG8_STAGE(PG8_SB(0, 1), b2 + hstep, voffB); PG8_STAGE(PG8_SA(0, 0), a2, voffA);
            PG8_WAIT_V(8); PG8_WAIT_L(0); PG8_BAR; PG8_MMA(1, 0, At, B0); PG8_MMA(1, 1, At, B1); PG8_BAR; PG8_SCHED;
            PG8_LDB(B0, 1, 0); PG8_LDB(B1, 1, 1); PG8_SCHED; PG8_LDA(At, 1, 0); PG8_STAGE(PG8_SA(0, 1), a2 + hstep, voffA);
            PG8_WAIT_V(8); PG8_WAIT_L(0); PG8_BAR; PG8_MMA(0, 0, At, B0); PG8_MMA(0, 1, At, B1); PG8_BAR; PG8_SCHED;
            PG8_LDA(At, 1, 1); PG8_STAGE(PG8_SB(1, 0), b3, voffB); PG8_STAGE(PG8_SB(1, 1), b3 + hstep, voffB); PG8_STAGE(PG8_SA(1, 0), a3, voffA);
            PG8_WAIT_V(8); PG8_WAIT_L(0); PG8_BAR; PG8_MMA(1, 0, At, B0); PG8_MMA(1, 1, At, B1); PG8_BAR; PG8_SCHED;
            } else {
            PG8_LDB(B0, 0, 0); PG8_SCHED; PG8_LDA(At, 0, 0); PG8_STAGE(PG8_SA(1, 1), a1 + hstep, voffA);
            PG8_WAIT_L(8); PG8_BAR; PG8_WAIT_L(0); PG8_MMA(0, 0, At, B0); PG8_BAR; PG8_SCHED;
            PG8_LDB(B1, 0, 1); PG8_STAGE(PG8_SB(0, 0), b2, voffB);
            PG8_BAR; PG8_WAIT_L(0); PG8_MMA(0, 1, At, B1); PG8_BAR;
            PG8_LDA(At, 0, 1); PG8_STAGE(PG8_SA(0, 0), a2, voffA);
            PG8_BAR; PG8_WAIT_L(0); PG8_MMA(1, 0, At, B0); PG8_BAR; PG8_SCHED;
            PG8_STAGE(PG8_SB(0, 1), b2 + hstep, voffB);
            PG8_WAIT_V(6); PG8_BAR; PG8_MMA(1, 1, At, B1); PG8_BAR;
            PG8_LDB(B0, 1, 0); PG8_SCHED; PG8_LDA(At, 1, 0); PG8_STAGE(PG8_SA(0, 1), a2 + hstep, voffA);
            PG8_WAIT_L(8); PG8_BAR; PG8_WAIT_L(0); PG8_MMA(0, 0, At, B0); PG8_BAR; PG8_SCHED;
            PG8_LDB(B1, 1, 1); PG8_STAGE(PG8_SB(1, 0), b3, voffB);
            PG8_BAR; PG8_WAIT_L(0); PG8_MMA(0, 1, At, B1); PG8_BAR;
            PG8_LDA(At, 1, 1); PG8_STAGE(PG8_SA(1, 0), a3, voffA);
            PG8_BAR; PG8_WAIT_L(0); PG8_MMA(1, 0, At, B0); PG8_BAR; PG8_SCHED;
            PG8_STAGE(PG8_SB(1, 1), b3 + hstep, voffB);
            PG8_WAIT_V(6); PG8_BAR; PG8_MMA(1, 1, At, B1); PG8_BAR;
            }
        }
        if constexpr (ALIGN_EPI) { if (wr == 0) PG8_BAR; }
        if constexpr (!Epi::AFTER_DRAIN) { E(acc, cur, wr, wc, fr, fq); S.done(cur); }
        if (!has_next) break;
#pragma unroll
        for (int a = 0; a < 2; ++a)
#pragma unroll
            for (int b = 0; b < 2; ++b)
#pragma unroll
                for (int m = 0; m < 4; ++m)
#pragma unroll
                    for (int n = 0; n < 2; ++n) acc[a][b][m][n] = (f32x4){0.f, 0.f, 0.f, 0.f};
        cur = nxt; cA = nA; cB = nB; ++ui;
        if constexpr (ALIGN_EPI) { if (wr == 1) PG8_BAR; }
    }
    PG8_WAIT_V(0);
    if constexpr (!ALIGN_EPI) { if (wr == 0) PG8_BAR; }
    PG8_BAR;
    if constexpr (Epi::AFTER_DRAIN) { E.fused(acc, cur, wr, wc, fr, fq, lds, wid, lane); S.done(cur); }
#undef PG8_SA
#undef PG8_SB
#undef PG8_STAGE
#undef PG8_LDA
#undef PG8_LDB
#undef PG8_MMA
#undef PG8_WAIT_V
#undef PG8_WAIT_L
#undef PG8_BAR
#undef PG8_SCHED
}
}

constexpr int NWAVES = 8;
constexpr int BATCH = 4, SEQ = 8192, D = 2048, M = BATCH * SEQ, FF = 5632;
constexpr int RC = 1024, RH = 16, RN = 64;
constexpr int HC = 1024, HH = 8, HD = 128;
constexpr int RWKV_COLS = 3360, IN_COLS = 7456, NIN = 7680;
constexpr int KL = 384, NL = 3072;
#ifndef MK_N_LAUNCHES
#define MK_N_LAUNCHES 1
#endif
constexpr int N_PHASES = 12;

constexpr size_t WS_CTL = 0, CTL_BYTES = 1u << 20;
constexpr size_t WS_W1GU = CTL_BYTES;
constexpr size_t WS_W1D = WS_W1GU + (size_t)2 * FF * D * 2;
constexpr size_t WS_WIN = WS_W1D + (size_t)D * FF * 2;
constexpr size_t WS_WLORA = WS_WIN + (size_t)NIN * D * 2;
constexpr size_t WS_WOUT = WS_WLORA + (size_t)NL * KL * 2;
constexpr size_t WS_W2GU = WS_WOUT + (size_t)D * D * 2;
constexpr size_t WS_W2D = WS_W2GU + (size_t)2 * FF * D * 2;
constexpr size_t WS_SS = WS_W2D + (size_t)D * FF * 2;
constexpr size_t WS_XB = WS_SS + (1u << 20);
constexpr size_t WS_R = WS_XB + (size_t)M * D * 2;
constexpr size_t R_ACT = 0;
constexpr size_t R_RKV = 0;
constexpr size_t R_HG = R_RKV + (size_t)M * 3072 * 2;
constexpr size_t R_LIN = R_HG + (size_t)M * 4096 * 2;
constexpr size_t R_X2B = (size_t)M * FF * 2;
constexpr size_t R_BYTES = R_LIN + (size_t)M * 288 * 4;
constexpr size_t WS_ALORA = WS_R + R_BYTES;
constexpr size_t WS_LOUT = WS_ALORA + (size_t)M * KL * 2;
constexpr size_t WS_INVN = WS_LOUT + (size_t)M * NL * 2;
constexpr size_t WS_END = WS_INVN + (size_t)M * RH * 4;
static_assert(R_X2B + (size_t)M * D * 2 <= R_BYTES && WS_END <= ((size_t)1 << 30), "d_ws map");
constexpr int CW_BAR = 4096;

constexpr int RING_BYTES = 162816;
constexpr int LDSCTL_OFF = RING_BYTES, MISC_OFF = LDSCTL_OFF + 320;
constexpr int LDS_BYTES = 163840;
static_assert(MISC_OFF + 128 <= LDS_BYTES, "LDS map");

#define GAS __attribute__((address_space(1)))
#define LAS __attribute__((address_space(3)))
typedef unsigned short bf16;
typedef unsigned v4u __attribute__((ext_vector_type(4)));
typedef unsigned v2u __attribute__((ext_vector_type(2)));
typedef float f32x4 __attribute__((ext_vector_type(4)));
#define LDS_WAIT() asm volatile("s_waitcnt lgkmcnt(0)" ::: "memory")
#define VM_WAIT() asm volatile("s_waitcnt vmcnt(0)" ::: "memory")
__device__ __forceinline__ float bflo(unsigned u) { return __builtin_bit_cast(float, u << 16); }
__device__ __forceinline__ float bfhi(unsigned u) { return __builtin_bit_cast(float, u & 0xffff0000u); }
__device__ __forceinline__ f32x4 unpack4(v2u w) { return (f32x4){bflo(w.x), bfhi(w.x), bflo(w.y), bfhi(w.y)}; }
__device__ __forceinline__ unsigned pk2(float lo, float hi) { return pg8::cvt_pk_bf16(lo, hi); }
__device__ __forceinline__ v2u pack4(f32x4 v) { v2u w; w.x = pk2(v[0], v[1]); w.y = pk2(v[2], v[3]); return w; }
using pg8::fast_sigmoid;
using pg8::fast_silu;
template <int CTRL> __device__ __forceinline__ float dpp_mov(float x) { return __builtin_bit_cast(float, __builtin_amdgcn_update_dpp(0, __builtin_bit_cast(int, x), CTRL, 0xF, 0xF, true)); }
__device__ __forceinline__ float row16_sum(float x) { x += dpp_mov<0x128>(x); x += dpp_mov<0x124>(x); x += dpp_mov<0x122>(x); x += dpp_mov<0x121>(x); return x; }
template <int CTRL, int BANK> __device__ __forceinline__ float dpp_upd(float old, float x) { return __builtin_bit_cast(float, __builtin_amdgcn_update_dpp(__builtin_bit_cast(int, old), __builtin_bit_cast(int, x), CTRL, 0xF, BANK, false)); }
__device__ __forceinline__ float tr_reduce16(const float (&v)[16], int lane) {
    float u[8], w[4], x[2];
#pragma unroll
    for (int s = 0; s < 8; ++s) { const float t = v[s + 8] + dpp_mov<0x128>(v[s + 8]), a = v[s] + dpp_mov<0x128>(v[s]); u[s] = dpp_upd<0xE4, 0x3>(t, a); }
#pragma unroll
    for (int s = 0; s < 4; ++s) { const float t = u[s + 4] + dpp_mov<0x141>(u[s + 4]), a = u[s] + dpp_mov<0x141>(u[s]); w[s] = dpp_upd<0xE4, 0x5>(t, a); }
    const bool b1 = (lane & 2) != 0, b0 = (lane & 1) != 0;
#pragma unroll
    for (int s = 0; s < 2; ++s) { const float K = b1 ? w[s + 2] : w[s], T = b1 ? w[s] : w[s + 2]; x[s] = K + dpp_mov<0x1B>(T); }
    const float K = b0 ? x[1] : x[0], T = b0 ? x[0] : x[1];
    return K + dpp_mov<0xB1>(T);
}
typedef float f32x2 __attribute__((ext_vector_type(2)));
#define LO2(v) __builtin_shufflevector(v, v, 0, 1)
#define HI2(v) __builtin_shufflevector(v, v, 2, 3)
__device__ __forceinline__ float wave_sum(float v) {
#pragma unroll
    for (int o = 1; o < 64; o <<= 1) v += __shfl_xor(v, o);
    return v;
}
#define XB_TMO      128
#define XB_XCNT(j)  (256  + 64 * (j))
#define XB_XSUB(j)  (1280 + 64 * (j))
#define XB_XGEN(j)  (2304 + 64 * (j))
#define XB_TOP      3328
#define XB_TOPGEN   3392
#define XCD_BAR_WORDS 3456
#define XB_SPIN_CAP (1u << 18)

__device__ __forceinline__ unsigned xb_ld(unsigned* p)              { return __hip_atomic_load(p, __ATOMIC_RELAXED, __HIP_MEMORY_SCOPE_AGENT); }
__device__ __forceinline__ unsigned xb_add(unsigned* p, unsigned v) { return __hip_atomic_fetch_add(p, v, __ATOMIC_RELAXED, __HIP_MEMORY_SCOPE_AGENT); }
__device__ __forceinline__ unsigned xb_xcc_id() { return (unsigned)__builtin_amdgcn_s_getreg((3 << 11) | 20) & 0xFu; }
#define XB_SPIN(cond, bar) do { unsigned _sp = 0; while (cond) { __builtin_amdgcn_s_sleep(1); \
    if ((++_sp & 255u) == 0u) { if (xb_ld(&(bar)[XB_TMO])) break; if (_sp > XB_SPIN_CAP) { atomicAdd(&(bar)[XB_TMO], 1u); break; } } } } while (0)

struct XcdBarrier {
    unsigned* bar; unsigned x;
    volatile LAS unsigned* st;
};

__device__ __forceinline__ XcdBarrier xcd_barrier_post(unsigned* bar, volatile LAS unsigned* st) {
    XcdBarrier b; b.bar = bar; b.x = xb_xcc_id(); b.st = st;
    if (threadIdx.x == 0) (void)xb_add(&bar[XB_XCNT(b.x)], 1u);
    return b;
}
__device__ __forceinline__ void xcd_barrier_complete(unsigned* bar, unsigned x, unsigned& nloc, unsigned& nx) {
    const unsigned G = gridDim.x * gridDim.y * gridDim.z;
    unsigned sum, cnt, mine, sp = 0u;
    for (;;) {
        sum = 0u; cnt = 0u; mine = 0u;
#pragma unroll
        for (unsigned j = 0; j < 16; ++j) { const unsigned c = xb_ld(&bar[XB_XCNT(j)]); sum += c; cnt += (c > 0u) ? 1u : 0u; mine = (j == x) ? c : mine; }
        if (sum == G) break;
        __builtin_amdgcn_s_sleep(1);
        if ((++sp & 255u) == 0u) { if (xb_ld(&bar[XB_TMO])) break; if (sp > XB_SPIN_CAP) { atomicAdd(&bar[XB_TMO], 1u); break; } }
    }
    nloc = mine > 0u ? mine : 1u; nx = cnt > 0u ? cnt : 1u;
}

__device__ __forceinline__ void xcd_barrier(const XcdBarrier& b) {
    asm volatile("s_waitcnt vmcnt(0)" ::: "memory");
    __syncthreads();
    if (threadIdx.x == 0) {
        unsigned* bar = b.bar;
        __builtin_amdgcn_s_waitcnt(0);
        unsigned nloc = b.st[0], nx = b.st[1];
        if (nloc == 0u) { xcd_barrier_complete(bar, b.x, nloc, nx); b.st[0] = nloc; b.st[1] = nx; }
        const unsigned old = xb_add(&bar[XB_XSUB(b.x)], 1u);
        const unsigned gen = old / nloc;
        if (old + 1u == (gen + 1u) * nloc) {
            __builtin_amdgcn_fence(__ATOMIC_RELEASE, "agent");
            asm volatile("s_waitcnt vmcnt(0)" ::: "memory");
            const unsigned og = xb_add(&bar[XB_TOP], 1u);
            const unsigned tg = og / nx;
            if (og + 1u == (tg + 1u) * nx) xb_add(&bar[XB_TOPGEN], 1u);
            else XB_SPIN(xb_ld(&bar[XB_TOPGEN]) == tg, bar);
            __builtin_amdgcn_fence(__ATOMIC_ACQUIRE, "agent");
            xb_add(&bar[XB_XGEN(b.x)], 1u);
            asm volatile("s_waitcnt vmcnt(0)" ::: "memory");
        } else {
            XB_SPIN(xb_ld(&bar[XB_XGEN(b.x)]) == gen, bar);
            __builtin_amdgcn_fence(__ATOMIC_ACQUIRE, "agent");
            asm volatile("s_waitcnt vmcnt(0)" ::: "memory");
        }
    }
    __syncthreads();
}

struct Frame {
    LAS unsigned char* lds;
    int tid, lane, wave, vcu, G;
    const float* in[26];
    float* out; unsigned char* ws;
};
#define WSP(T, off) ((T*)(F.ws + (off)))
struct Args { const float* in[26]; float* out; unsigned char* ws; int ph_lo, ph_hi; };

struct P0Item { const float* W; bf16* WT; int K, N, kb, n0, drow0; };
__device__ __forceinline__ int map_gu(int n0, int which) { return (n0 >> 7) * 256 + which * 128 + (n0 & 127); }
constexpr int P0_I_GU = (D / 64) * (FF / 32), P0_I_DN = (FF / 64) * (D / 32), P0_I_IN = (D / 64) * (IN_COLS / 32), P0_I_OUT = (D / 64) * (D / 32);
constexpr int P0_N0 = 2 * P0_I_GU + P0_I_DN + P0_I_IN, P0_N1 = 2 * P0_I_GU + P0_I_DN + P0_I_OUT;
template <int SET> __device__ __forceinline__ P0Item p0_decode(Frame& F, const Args& A, int it) {
    constexpr int I_GU = P0_I_GU, I_DN = P0_I_DN, I_IN = P0_I_IN;
    P0Item p; int r = it;
    if (SET == 0) { if (r >= 2 * I_GU) r += 2 * I_GU; if (r >= 4 * I_GU + I_DN) r += I_DN; }
    else { r += 2 * I_GU; if (r >= 4 * I_GU) r += I_DN; if (r >= 4 * I_GU + 2 * I_DN) r += I_IN; }
    if (r < 4 * I_GU) { const int mat = r / I_GU; r -= mat * I_GU; const int nblk = FF / 32, ffn = mat >> 1, which = mat & 1;
        p.W = A.in[2 + 20 * ffn + which]; p.WT = WSP(bf16, ffn ? WS_W2GU : WS_W1GU); p.K = D; p.N = FF; p.kb = r / nblk; p.n0 = 32 * (r % nblk); p.drow0 = map_gu(p.n0, which); return p; }
    r -= 4 * I_GU;
    if (r < 2 * I_DN) { const int ffn = r / I_DN; r -= ffn * I_DN; const int nblk = D / 32;
        p.W = A.in[4 + 20 * ffn]; p.WT = WSP(bf16, ffn ? WS_W2D : WS_W1D); p.K = FF; p.N = D; p.kb = r / nblk; p.n0 = 32 * (r % nblk); p.drow0 = p.n0; return p; }
    r -= 2 * I_DN;
    if (r < I_IN) { const int nblk = IN_COLS / 32;
        p.W = A.in[6]; p.WT = WSP(bf16, WS_WIN); p.K = D; p.N = IN_COLS; p.kb = r / nblk; p.n0 = 32 * (r % nblk); p.drow0 = p.n0 < RWKV_COLS ? p.n0 : p.n0 + 224; return p; }
    r -= I_IN;
    { const int nblk = D / 32; p.W = A.in[20]; p.WT = WSP(bf16, WS_WOUT); p.K = D; p.N = D; p.kb = r / nblk; p.n0 = 32 * (r % nblk); p.drow0 = p.n0; return p; }
}
__device__ __forceinline__ void p0_dma(const P0Item& p, LAS unsigned char* tile, int lane) {
    const int half = lane >> 5, sl = lane & 31;
#pragma unroll 8
    for (int i = 0; i < 32; ++i) { const int kk = 2 * i + half;
        __builtin_amdgcn_global_load_lds((const GAS unsigned*)(p.W + (size_t)(64 * p.kb + kk) * p.N + p.n0 + (sl ^ (4 * (kk >> 3)))), (LAS unsigned*)(tile + i * 256), 4, 0, 0); }
}
__device__ __forceinline__ void p0_emit(const P0Item& p, const LAS float* t, int lane) {
    const int c = lane & 7;
#pragma unroll
    for (int j = 0; j < 4; ++j) { const int n = (lane >> 3) + 8 * j; const LAS float* s = t + (8 * c) * 32 + (n ^ (4 * c));
        v4u o; o.x = pk2(s[0 * 32], s[1 * 32]); o.y = pk2(s[2 * 32], s[3 * 32]); o.z = pk2(s[4 * 32], s[5 * 32]); o.w = pk2(s[6 * 32], s[7 * 32]);
        *(GAS v4u*)(p.WT + (size_t)(p.drow0 + n) * p.K + 64 * p.kb + 8 * c) = o; }
}
template <int SET> __device__ __forceinline__ void p0_transposes(Frame& F, const Args& A, int gw, int NGW) {
    LAS unsigned char* tiles = F.lds + F.wave * 16384;
    constexpr int NITEMS = SET == 0 ? P0_N0 : P0_N1;
    if (gw < NITEMS) {
        P0Item cur = p0_decode<SET>(F, A, gw); int buf = 0;
        p0_dma(cur, tiles, F.lane);
        for (int it = gw; it < NITEMS; it += NGW) {
            const bool more = it + NGW < NITEMS; P0Item nxt = cur;
            if (more) { nxt = p0_decode<SET>(F, A, it + NGW); p0_dma(nxt, tiles + (buf ^ 1) * 8192, F.lane); asm volatile("s_waitcnt vmcnt(32)" ::: "memory"); }
            else asm volatile("s_waitcnt vmcnt(0)" ::: "memory");
            p0_emit(cur, (const LAS float*)(tiles + buf * 8192), F.lane);
            LDS_WAIT(); asm volatile("" ::: "memory");
            cur = nxt; buf ^= 1;
        }
        asm volatile("s_waitcnt vmcnt(0)" ::: "memory");
    }
}
__device__ __forceinline__ void p0_prologue(Frame& F, const Args& A) {
    const int gw = F.vcu * NWAVES + F.wave, NGW = F.G * NWAVES;
    p0_transposes<0>(F, A, gw, NGW);
    const size_t gt = (size_t)F.vcu * (NWAVES * 64) + F.tid, NT = (size_t)F.G * NWAVES * 64;
    { GAS v4u* z = (GAS v4u*)(WSP(bf16, WS_WIN) + (size_t)RWKV_COLS * D);
      for (size_t i = gt; i < (size_t)224 * D * 2 / 16; i += NT) z[i] = (v4u){0u, 0u, 0u, 0u}; }
    { bf16* wl = WSP(bf16, WS_WLORA); const float* w2 = F.in[9]; const float* a2 = F.in[11]; const float* g2 = F.in[12];
      for (size_t i = gt; i < (size_t)NL * KL / 2; i += NT) { const int n = (int)(i / (KL / 2)), k = 2 * (int)(i % (KL / 2)); const int seg = n >> 10, c = n & 1023;
          float v0 = 0.f, v1 = 0.f;
          if (seg == 0) { if (k < 64) { v0 = w2[(size_t)k * RC + c]; v1 = w2[(size_t)(k + 1) * RC + c]; } }
          else if (seg == 1) { if (k >= 64 && k < 128) { v0 = a2[(size_t)(k - 64) * RC + c]; v1 = a2[(size_t)(k - 63) * RC + c]; } }
          else { if (k >= 128 && k < 288) { v0 = g2[(size_t)(k - 128) * RC + c]; v1 = g2[(size_t)(k - 127) * RC + c]; } }
          ((GAS unsigned*)wl)[i] = pk2(v0, v1); } }
    { GAS unsigned long long* s = (GAS unsigned long long*)(F.ws + WS_SS) + M;
      for (size_t i = gt; i < (size_t)2 * M; i += NT) s[i] = 0ull; }
    { const float* x = F.in[0]; bf16* xb = WSP(bf16, WS_XB); unsigned long long* ss0 = WSP(unsigned long long, WS_SS);
      for (int m = gw; m < M; m += NGW) { const GAS f32x4* xr = (const GAS f32x4*)(x + (size_t)m * D) + 2 * F.lane; GAS v4u* o = (GAS v4u*)(xb + (size_t)m * D) + F.lane; float s = 0.f;
#pragma unroll
          for (int j = 0; j < 4; ++j) { const f32x4 a = xr[128 * j], b = xr[128 * j + 1];
              s += (a[0] * a[0] + a[1] * a[1]) + (a[2] * a[2] + a[3] * a[3]) + (b[0] * b[0] + b[1] * b[1]) + (b[2] * b[2] + b[3] * b[3]);
              const f32x4 ga = *(const f32x4*)(F.in[1] + 8 * F.lane + 512 * j), gb = *(const f32x4*)(F.in[1] + 8 * F.lane + 512 * j + 4);
              o[64 * j] = pg8::pack8(a * ga, b * gb); }
          s = wave_sum(s);
          if (F.lane == 0) ss0[m] = (unsigned long long)(s * pg8::SS_SCALE + 0.5f); } }
}

__device__ __forceinline__ void p4_lora_in(Frame& F) {
    const float* lin = WSP(float, WS_R + R_LIN); bf16* al = WSP(bf16, WS_ALORA); const float* mu = F.in[7] + 3 * RC;
    const size_t gt = (size_t)F.vcu * (NWAVES * 64) + F.tid, NT = (size_t)F.G * NWAVES * 64;
    for (size_t i = gt; i < (size_t)M * 96; i += NT) { const int m = (int)(i / 96), q = (int)(i % 96); v2u o = (v2u){0u, 0u};
        if (q < 72) { const f32x4 p = *(const GAS f32x4*)(lin + (size_t)m * 288 + 4 * q); f32x4 pp = (f32x4){0.f, 0.f, 0.f, 0.f};
            if ((m & (SEQ - 1)) != 0) pp = *(const GAS f32x4*)(lin + (size_t)(m - 1) * 288 + 4 * q);
            const f32x4 mv = *(const GAS f32x4*)(mu + 4 * q); f32x4 s = p + (pp - p) * mv;
            if (q < 16) {
#pragma unroll
                for (int j = 0; j < 4; ++j) s[j] = 2.0f * fast_sigmoid(2.0f * s[j]) - 1.0f;
            } else if (q >= 32) {
#pragma unroll
                for (int j = 0; j < 4; ++j) s[j] = fast_sigmoid(s[j]); }
            o = pack4(s); }
        *(GAS v2u*)(al + (size_t)m * KL + 4 * q) = o; }
    { const bf16* rkv = WSP(bf16, WS_R + R_RKV); float* invn = WSP(float, WS_INVN); const int j4 = (F.tid & 15) * 4;
      for (size_t it = gt >> 4; it < (size_t)M * RH; it += NT >> 4) { const int m = (int)(it >> 4), h = (int)(it & 15), ch = h * RN + j4;
          const f32x4 k = unpack4(*(const GAS v2u*)(rkv + (size_t)m * 3072 + RC + ch)); f32x4 kp = (f32x4){0.f, 0.f, 0.f, 0.f};
          if ((m & (SEQ - 1)) != 0) kp = unpack4(*(const GAS v2u*)(rkv + (size_t)(m - 1) * 3072 + RC + ch));
          const f32x4 muk = *(const f32x4*)(F.in[7] + RC + ch), kkc = *(const f32x4*)(F.in[13] + ch);
          const f32x4 kk = (k + (kp - k) * muk) * kkc; float s2 = (kk[0] * kk[0] + kk[1] * kk[1]) + (kk[2] * kk[2] + kk[3] * kk[3]); s2 = row16_sum(s2);
          if ((F.tid & 15) == 0) invn[it] = 1.0f / fmaxf(sqrtf(s2), 1e-12f); } }
}

typedef short bf16x4 __attribute__((ext_vector_type(4)));
typedef short bf16x8 __attribute__((ext_vector_type(8)));
#define MFMA32(a, b, c) __builtin_amdgcn_mfma_f32_16x16x32_bf16(a, b, c, 0, 0, 0)
#define MFMA16(a, b, c) __builtin_amdgcn_mfma_f32_16x16x16bf16_1k(a, b, c, 0, 0, 0)
__device__ __forceinline__ bf16x4 cv4(f32x4 v) { v2u w; w.x = pk2(v[0], v[1]); w.y = pk2(v[2], v[3]); return __builtin_bit_cast(bf16x4, w); }
__device__ __forceinline__ bf16x8 cv8(f32x4 a, f32x4 b) { v4u w; w.x = pk2(a[0], a[1]); w.y = pk2(a[2], a[3]); w.z = pk2(b[0], b[1]); w.w = pk2(b[2], b[3]); return __builtin_bit_cast(bf16x8, w); }
__device__ __forceinline__ bf16x8 cat8(bf16x4 a, bf16x4 b) { return __builtin_shufflevector(a, b, 0, 1, 2, 3, 4, 5, 6, 7); }
__device__ __forceinline__ bf16x8 join8(v2u a, v2u b) { v4u w; w.x = a.x; w.y = a.y; w.z = b.x; w.w = b.y; return __builtin_bit_cast(bf16x8, w); }
__device__ __forceinline__ float row16_scan(float x) { x += dpp_mov<0x111>(x); x += dpp_mov<0x112>(x); x += dpp_mov<0x114>(x); x += dpp_mov<0x118>(x); return x; }
__device__ __forceinline__ unsigned short bf1(float x) { return (unsigned short)(pk2(x, 0.f) & 0xffffu); }
constexpr int CH = 16;
constexpr int RWS = 144;
constexpr int HGS = 272;
constexpr int RWB_KG = 0, RWB_RG = 16 * RWS, RWB_KTI = 32 * RWS, RWB_BTI = 48 * RWS, RWB_KTIT = 64 * RWS, RWB_BTIT = RWB_KTIT + 2048, RWB_VT = RWB_BTIT + 2048, RWB_GL = RWB_VT + 2048, RWB_BYTES = RWB_GL + 256;
constexpr int HGB_QG = 0, HGB_KI = 16 * HGS, HGB_KIT = 32 * HGS, HGB_VT = HGB_KIT + 4096, HGB_GL = HGB_VT + 4096, HGB_BYTES = HGB_GL + 512;

__device__ __forceinline__ f32x4 padc(f32x4 r) { asm("s_nop 15" : "+v"(r)); return r; }
constexpr int NCHK = SEQ / CH;
constexpr int NRAW = 8;
constexpr int RWR_R = 0, RWR_K = 2048, RWR_V = 4096, RWR_LW = 6144, RWR_A = 8192, RWR_INV = 10240, RWR_BYTES = 10304;
constexpr int RW_OPND = 0, RW_RAW = 3 * RWB_BYTES, RW_AOP = RW_RAW + NRAW * RWR_BYTES, RW_LDS = RW_AOP + 2 * 2048;
constexpr int HGR_Q = 0, HGR_LF = 4096, HGR_V = 8192, HGR_BYTES = 12288;
constexpr int HG_OPND = 0, HG_RAW = 3 * HGB_BYTES, HG_AOP = HG_RAW + NRAW * HGR_BYTES, HG_LDS = HG_AOP + 2 * 512;
static_assert(RW_LDS <= RING_BYTES && HG_LDS <= RING_BYTES && RW_AOP % 16 == 0 && HG_AOP % 16 == 0, "scan LDS map");
#define GLDS4(gptr, lptr) __builtin_amdgcn_global_load_lds((const GAS unsigned*)(gptr), (LAS unsigned*)(lptr), 4, 0, 0)
#define WG_BAR() do { LDS_WAIT(); __builtin_amdgcn_s_barrier(); asm volatile("" ::: "memory"); } while (0)

__device__ __forceinline__ void p6_rwkv_head(Frame& F, int bh) {
    const bf16* rkv = WSP(bf16, WS_R + R_RKV); const bf16* lout = WSP(bf16, WS_LOUT); const float* invn = WSP(float, WS_INVN); bf16* ydst = WSP(bf16, WS_LOUT);
    const int lane = F.lane, c = lane & 15, g = lane >> 4, w = F.wave;
    const int b = bh >> 4, h = bh & 15;
    const size_t rowbase = (size_t)b * SEQ;
    const int st = lane & 15, k0 = 2 * (w * 4 + (lane >> 4)), chn = h * RN + k0;
    const float mur0 = F.in[7][chn], mur1 = F.in[7][chn + 1], muk0 = F.in[7][RC + chn], muk1 = F.in[7][RC + chn + 1], muv0 = F.in[7][2 * RC + chn], muv1 = F.in[7][2 * RC + chn + 1];
    const float kk0 = F.in[13][chn], kk1 = F.in[13][chn + 1], ka0 = F.in[14][chn], ka1 = F.in[14][chn + 1];
    LAS unsigned char* const opnd = F.lds + RW_OPND; LAS unsigned char* const raw = F.lds + RW_RAW; LAS unsigned char* const aop = F.lds + RW_AOP;
#define RW3_DMA(j) do { const int r_ = 2 * w + (lane >> 5); const size_t ro_ = (rowbase + (size_t)(j) * CH + r_) * 3072 + h * RN + 2 * ((lane & 31) ^ r_); \
        LAS unsigned char* d_ = raw + ((j) % NRAW) * RWR_BYTES + w * 256; \
        GLDS4(rkv + ro_, d_ + RWR_R); GLDS4(rkv + ro_ + RC, d_ + RWR_K); GLDS4(rkv + ro_ + 2 * RC, d_ + RWR_V); GLDS4(lout + ro_, d_ + RWR_LW); GLDS4(lout + ro_ + RC, d_ + RWR_A); \
        if (lane < 2) GLDS4(invn + (rowbase + (size_t)(j) * CH + 2 * w + lane) * RH + h, raw + ((j) % NRAW) * RWR_BYTES + RWR_INV + w * 8); } while (0)
#define RW3_PROC(j) do { const LAS unsigned char* s_ = raw + ((j) % NRAW) * RWR_BYTES; const int pq_ = (k0 >> 1) ^ st, pp_ = (k0 >> 1) ^ ((st + 15) & 15); \
        const LAS unsigned char* sc_ = s_ + st * 128 + pq_ * 4; const LAS unsigned char* sp_ = ((st > 0) ? s_ + (st - 1) * 128 : raw + (((j) + NRAW - 1) % NRAW) * RWR_BYTES + 15 * 128) + pp_ * 4; \
        const bool first_ = ((j) == 0) && (st == 0); \
        const unsigned Lr = *(const LAS unsigned*)(sc_ + RWR_R), Lk = *(const LAS unsigned*)(sc_ + RWR_K), Lv = *(const LAS unsigned*)(sc_ + RWR_V); \
        const unsigned Lw = *(const LAS unsigned*)(sc_ + RWR_LW), La = *(const LAS unsigned*)(sc_ + RWR_A); \
        const unsigned Lrp = *(const LAS unsigned*)(sp_ + RWR_R), Lkp = *(const LAS unsigned*)(sp_ + RWR_K), Lvp = *(const LAS unsigned*)(sp_ + RWR_V); \
        const float Linv = *(const LAS float*)(s_ + RWR_INV + st * 4); \
        const float r0_ = bflo(Lr), r1_ = bfhi(Lr), q0_ = bflo(Lk), q1_ = bfhi(Lk), v0_ = bflo(Lv), v1_ = bfhi(Lv); \
        const float rp0_ = first_ ? 0.f : bflo(Lrp), rp1_ = first_ ? 0.f : bfhi(Lrp), qp0_ = first_ ? 0.f : bflo(Lkp), qp1_ = first_ ? 0.f : bfhi(Lkp), vp0_ = first_ ? 0.f : bflo(Lvp), vp1_ = first_ ? 0.f : bfhi(Lvp); \
        const float rs0_ = r0_ + (rp0_ - r0_) * mur0, rs1_ = r1_ + (rp1_ - r1_) * mur1, ks0_ = q0_ + (qp0_ - q0_) * muk0, ks1_ = q1_ + (qp1_ - q1_) * muk1, vs0_ = v0_ + (vp0_ - v0_) * muv0, vs1_ = v1_ + (vp1_ - v1_) * muv1; \
        const float a0_ = bflo(La), a1_ = bfhi(La), lw0_ = bflo(Lw) * 1.44269504f, lw1_ = bfhi(Lw) * 1.44269504f; \
        const float kap0_ = ks0_ * kk0 * Linv, kap1_ = ks1_ * kk1 * Linv, bet0_ = kap0_ * a0_, bet1_ = kap1_ * a1_; \
        const float kt0_ = ks0_ * (1.0f + (a0_ - 1.0f) * ka0), kt1_ = ks1_ * (1.0f + (a1_ - 1.0f) * ka1); \
        const float G0_ = row16_scan(lw0_), G1_ = row16_scan(lw1_); \
        const float eg0_ = __builtin_amdgcn_exp2f(G0_), eg1_ = __builtin_amdgcn_exp2f(G1_), ep0_ = __builtin_amdgcn_exp2f(G0_ - lw0_), ep1_ = __builtin_amdgcn_exp2f(G1_ - lw1_), ei0_ = __builtin_amdgcn_exp2f(-G0_), ei1_ = __builtin_amdgcn_exp2f(-G1_); \
        LAS unsigned char* d_ = opnd + ((j) % 3) * RWB_BYTES; \
        *(LAS unsigned*)(d_ + RWB_KG + st * RWS + k0 * 2) = pk2(kap0_ * ep0_, kap1_ * ep1_); *(LAS unsigned*)(d_ + RWB_RG + st * RWS + k0 * 2) = pk2(rs0_ * eg0_, rs1_ * eg1_); \
        const unsigned kti_ = pk2(kt0_ * ei0_, kt1_ * ei1_), bti_ = pk2(bet0_ * ei0_, bet1_ * ei1_), vv_ = pk2(vs0_, vs1_); \
        *(LAS unsigned*)(d_ + RWB_KTI + st * RWS + k0 * 2) = kti_; *(LAS unsigned*)(d_ + RWB_BTI + st * RWS + k0 * 2) = bti_; \
        *(LAS unsigned short*)(d_ + RWB_KTIT + k0 * 32 + st * 2) = (unsigned short)(kti_ & 0xffffu); *(LAS unsigned short*)(d_ + RWB_KTIT + (k0 + 1) * 32 + st * 2) = (unsigned short)(kti_ >> 16); \
        *(LAS unsigned short*)(d_ + RWB_BTIT + k0 * 32 + st * 2) = (unsigned short)(bti_ & 0xffffu); *(LAS unsigned short*)(d_ + RWB_BTIT + (k0 + 1) * 32 + st * 2) = (unsigned short)(bti_ >> 16); \
        *(LAS unsigned short*)(d_ + RWB_VT + k0 * 32 + st * 2) = (unsigned short)(vv_ & 0xffffu); *(LAS unsigned short*)(d_ + RWB_VT + (k0 + 1) * 32 + st * 2) = (unsigned short)(vv_ >> 16); \
        if (st == 15) { *(LAS float*)(d_ + RWB_GL + k0 * 4) = eg0_; *(LAS float*)(d_ + RWB_GL + k0 * 4 + 4) = eg1_; } } while (0)
    const f32x4 zero4 = (f32x4){0.f, 0.f, 0.f, 0.f};
    auto a_stage = [&](int j) {
        const LAS unsigned char* rowp = opnd + (j % 3) * RWB_BYTES + c * RWS;
        const int offA = (w == 4 || w == 7) ? RWB_BTI : RWB_KTI;
        const int offB = (w == 4 || w == 5) ? RWB_KG : RWB_RG;
        const bf16x8 a0 = *(const LAS bf16x8*)(rowp + offA + 16 * g), a1 = *(const LAS bf16x8*)(rowp + offA + 64 + 16 * g);
        const bf16x8 b0 = *(const LAS bf16x8*)(rowp + offB + 16 * g), b1 = *(const LAS bf16x8*)(rowp + offB + 64 + 16 * g);
        f32x4 N = MFMA32(a0, b0, zero4); N = MFMA32(a1, b1, N);
        const bool strict = (w == 4 || w == 5);
#pragma unroll
        for (int r = 0; r < 4; ++r) { const int rj = 4 * g + r; N[r] = (strict ? (c > rj) : (c >= rj)) ? N[r] : 0.f; }
        f32x4 res = N;
        if (w == 4) {
            f32x4 N1t = MFMA32(b0, a0, zero4); N1t = MFMA32(b1, a1, N1t);
            f32x4 X;
#pragma unroll
            for (int r = 0; r < 4; ++r) { const int rj = 4 * g + r; N1t[r] = (rj > c) ? N1t[r] : 0.f; X[r] = ((rj == c) ? 1.0f : 0.f) - N[r]; }
            bf16x4 an = cv4(N), at = cv4(N1t);
            f32x4 P = MFMA16(at, an, zero4), Pt = MFMA16(an, at, zero4);
            X = MFMA16(cv4(Pt), cv4(X), padc(X));
            an = cv4(P); at = cv4(Pt);
            P = MFMA16(at, an, zero4); Pt = MFMA16(an, at, zero4);
            X = MFMA16(cv4(Pt), cv4(X), padc(X));
            an = cv4(P); at = cv4(Pt);
            Pt = MFMA16(an, at, zero4);
            X = MFMA16(cv4(Pt), cv4(X), padc(X));
            res = X;
        }
        *(LAS bf16x4*)(aop + (j & 1) * 2048 + (w - 4) * 512 + lane * 8) = cv4(res);
    };
    f32x4 Z[4];
#pragma unroll
    for (int i = 0; i < 4; ++i) Z[i] = (f32x4){0.f, 0.f, 0.f, 0.f};
    { RW3_DMA(0); RW3_DMA(1); RW3_DMA(2); RW3_DMA(3); RW3_DMA(4); RW3_DMA(5); RW3_DMA(6); RW3_DMA(7); asm volatile("s_waitcnt vmcnt(0)" ::: "memory"); WG_BAR(); RW3_PROC(0); RW3_PROC(1); WG_BAR(); if (w >= 4) a_stage(0); WG_BAR(); }
    if (w < 4) {
        for (int ci = 0; ci < NCHK; ++ci) {
            const int t0 = ci * CH; const int jp = (ci + 2 < NCHK) ? ci + 2 : NCHK - 1;
            RW3_PROC(jp);
            const LAS unsigned char* cur = opnd + (ci % 3) * RWB_BYTES; const LAS unsigned char* rowp = cur + c * RWS; const LAS unsigned char* ap = aop + (ci & 1) * 2048 + lane * 8;
            bf16x8 pKg[2], pRg[2];
#pragma unroll
            for (int s = 0; s < 2; ++s) {
                pKg[s] = join8(*(const LAS v2u*)(rowp + RWB_KG + 64 * s + 8 * g), *(const LAS v2u*)(rowp + RWB_KG + 64 * s + 32 + 8 * g));
                pRg[s] = join8(*(const LAS v2u*)(rowp + RWB_RG + 64 * s + 8 * g), *(const LAS v2u*)(rowp + RWB_RG + 64 * s + 32 + 8 * g)); }
            const bf16x4 bV = *(const LAS bf16x4*)(cur + RWB_VT + (16 * w + c) * 32 + 8 * g);
            const bf16x4 xT = *(const LAS bf16x4*)(ap), n2 = *(const LAS bf16x4*)(ap + 512), n3 = *(const LAS bf16x4*)(ap + 1024), n4 = *(const LAS bf16x4*)(ap + 1536);
            const bf16x8 bZ0 = cv8(Z[0], Z[1]), bZ1 = cv8(Z[2], Z[3]);
            const bf16x4 z4 = (bf16x4){0, 0, 0, 0};
            f32x4 W = MFMA32(pKg[0], bZ0, zero4); W = MFMA32(pKg[1], bZ1, W); W = MFMA32(cat8(n2, z4), cat8(bV, z4), W);
            const f32x4 U = MFMA16(xT, cv4(W), zero4);
            const bf16x4 nU = cv4(-U);
            const bf16x8 bVU = cat8(bV, nU);
            f32x4 Y = MFMA32(pRg[0], bZ0, zero4); Y = MFMA32(pRg[1], bZ1, Y); Y = MFMA32(cat8(n3, n4), bVU, Y);
#pragma unroll
            for (int r = 0; r < 4; ++r) ydst[(rowbase + t0 + 4 * g + r) * 3072 + h * RN + 16 * w + c] = bf1(Y[r]);
#pragma unroll
            for (int zt = 0; zt < 4; ++zt) {
                const bf16x4 aK = *(const LAS bf16x4*)(cur + RWB_KTIT + (16 * zt + c) * 32 + 8 * g), aB = *(const LAS bf16x4*)(cur + RWB_BTIT + (16 * zt + c) * 32 + 8 * g);
                const f32x4 gl = *(const LAS f32x4*)(cur + RWB_GL + (16 * zt + 4 * g) * 4);
                Z[zt] = MFMA32(cat8(aK, aB), bVU, Z[zt]) * gl; }
            { const int jn = (ci + NRAW < NCHK) ? ci + NRAW : NCHK - 1; RW3_DMA(jn); }
            asm volatile("s_waitcnt vmcnt(50)" ::: "memory");
            WG_BAR();
        }
    } else {
        for (int ci = 0; ci < NCHK; ++ci) {
            const int jp = (ci + 2 < NCHK) ? ci + 2 : NCHK - 1, ja = (ci + 1 < NCHK) ? ci + 1 : NCHK - 1;
            RW3_PROC(jp);
            a_stage(ja);
            { const int jn = (ci + NRAW < NCHK) ? ci + NRAW : NCHK - 1; RW3_DMA(jn); }
            asm volatile("s_waitcnt vmcnt(30)" ::: "memory");
            WG_BAR();
        }
    }
#undef RW3_DMA
#undef RW3_PROC
}

__device__ __forceinline__ void p6_hgrn_head(Frame& F, int hb) {
    const bf16* hg = WSP(bf16, WS_R + R_HG); bf16* odst = WSP(bf16, WS_R + R_HG);
    const int lane = F.lane, c = lane & 15, g = lane >> 4, w = F.wave;
    const int bh = hb >> 1, half = hb & 1, b = bh >> 3, h = bh & 7, vb = half * 4 + (w & 3);
    const size_t rowbase = (size_t)b * SEQ;
    const int st = lane & 15, k0 = 4 * (w * 4 + (lane >> 4));
    LAS unsigned char* const opnd = F.lds + HG_OPND; LAS unsigned char* const raw = F.lds + HG_RAW; LAS unsigned char* const aop = F.lds + HG_AOP;
#define HG3_DMA(j) do { _Pragma("unroll") for (int rr_ = 0; rr_ < 2; ++rr_) { const int r_ = 2 * w + rr_; const bf16* p_ = hg + (rowbase + (size_t)(j) * CH + r_) * 4096 + h * HD + 2 * (2 * ((lane >> 1) ^ r_) + (lane & 1)); \
        LAS unsigned char* d_ = raw + ((j) % NRAW) * HGR_BYTES + r_ * 256; GLDS4(p_, d_ + HGR_Q); GLDS4(p_ + HC, d_ + HGR_LF); GLDS4(p_ + 2 * HC, d_ + HGR_V); } } while (0)
#define HG3_PROC(j) do { const LAS unsigned char* s_ = raw + ((j) % NRAW) * HGR_BYTES + st * 256 + (((k0 >> 2) ^ st) * 8); LAS unsigned char* d_ = opnd + ((j) % 3) * HGB_BYTES; \
        const v2u Lq = *(const LAS v2u*)(s_ + HGR_Q), Lf = *(const LAS v2u*)(s_ + HGR_LF), Lv = *(const LAS v2u*)(s_ + HGR_V); \
        const f32x4 q_ = unpack4(Lq); f32x4 lf_ = unpack4(Lf) * 1.44269504f; f32x4 qg_, ki_, eg_; \
        _Pragma("unroll") for (int e = 0; e < 4; ++e) { const float G_ = row16_scan(lf_[e]); eg_[e] = __builtin_amdgcn_exp2f(G_); qg_[e] = q_[e] * eg_[e]; ki_[e] = (1.0f - __builtin_amdgcn_exp2f(lf_[e])) * __builtin_amdgcn_exp2f(-G_); } \
        const v2u kw_ = pack4(ki_); *(LAS v2u*)(d_ + HGB_QG + st * HGS + k0 * 2) = pack4(qg_); *(LAS v2u*)(d_ + HGB_KI + st * HGS + k0 * 2) = kw_; \
        *(LAS unsigned short*)(d_ + HGB_KIT + (k0 + 0) * 32 + st * 2) = (unsigned short)(kw_.x & 0xffffu); *(LAS unsigned short*)(d_ + HGB_KIT + (k0 + 1) * 32 + st * 2) = (unsigned short)(kw_.x >> 16); \
        *(LAS unsigned short*)(d_ + HGB_KIT + (k0 + 2) * 32 + st * 2) = (unsigned short)(kw_.y & 0xffffu); *(LAS unsigned short*)(d_ + HGB_KIT + (k0 + 3) * 32 + st * 2) = (unsigned short)(kw_.y >> 16); \
        *(LAS unsigned short*)(d_ + HGB_VT + (k0 + 0) * 32 + st * 2) = (unsigned short)(Lv.x & 0xffffu); *(LAS unsigned short*)(d_ + HGB_VT + (k0 + 1) * 32 + st * 2) = (unsigned short)(Lv.x >> 16); \
        *(LAS unsigned short*)(d_ + HGB_VT + (k0 + 2) * 32 + st * 2) = (unsigned short)(Lv.y & 0xffffu); *(LAS unsigned short*)(d_ + HGB_VT + (k0 + 3) * 32 + st * 2) = (unsigned short)(Lv.y >> 16); \
        if (st == 15) *(LAS f32x4*)(d_ + HGB_GL + k0 * 4) = eg_; } while (0)
    const f32x4 zero4 = (f32x4){0.f, 0.f, 0.f, 0.f};
    auto a_stage = [&](int j) {
        const LAS unsigned char* rowp = opnd + (j % 3) * HGB_BYTES + c * HGS;
        f32x4 N = zero4;
#pragma unroll
        for (int s = 0; s < 4; ++s) { const bf16x8 nQ = *(const LAS bf16x8*)(rowp + HGB_QG + 64 * s + 16 * g), nK = *(const LAS bf16x8*)(rowp + HGB_KI + 64 * s + 16 * g); N = MFMA32(nK, nQ, N); }
#pragma unroll
        for (int r = 0; r < 4; ++r) N[r] = (c >= 4 * g + r) ? N[r] : 0.f;
        *(LAS bf16x4*)(aop + (j & 1) * 512 + lane * 8) = cv4(N);
    };
    f32x4 Z[8];
#pragma unroll
    for (int i = 0; i < 8; ++i) Z[i] = (f32x4){0.f, 0.f, 0.f, 0.f};
    { HG3_DMA(0); HG3_DMA(1); HG3_DMA(2); HG3_DMA(3); HG3_DMA(4); HG3_DMA(5); HG3_DMA(6); HG3_DMA(7); asm volatile("s_waitcnt vmcnt(0)" ::: "memory"); WG_BAR(); HG3_PROC(0); HG3_PROC(1); WG_BAR(); if (w == 4) a_stage(0); WG_BAR(); }
    if (w < 4) {
        for (int ci = 0; ci < NCHK; ++ci) {
            const int t0 = ci * CH; const int jp = (ci + 2 < NCHK) ? ci + 2 : NCHK - 1;
            HG3_PROC(jp);
            const LAS unsigned char* cur = opnd + (ci % 3) * HGB_BYTES; const LAS unsigned char* rowp = cur + c * HGS;
            f32x4 Y = zero4;
#pragma unroll
            for (int s = 0; s < 4; ++s) {
                const bf16x8 pQ = join8(*(const LAS v2u*)(rowp + HGB_QG + 64 * s + 8 * g), *(const LAS v2u*)(rowp + HGB_QG + 64 * s + 32 + 8 * g));
                Y = MFMA32(pQ, cv8(Z[2 * s], Z[2 * s + 1]), Y); }
            const bf16x4 bV = *(const LAS bf16x4*)(cur + HGB_VT + (16 * vb + c) * 32 + 8 * g);
            const bf16x4 n = *(const LAS bf16x4*)(aop + (ci & 1) * 512 + lane * 8);
            const bf16x4 z4 = (bf16x4){0, 0, 0, 0};
            Y = MFMA32(cat8(n, z4), cat8(bV, z4), Y);
#pragma unroll
            for (int r = 0; r < 4; ++r) odst[(rowbase + t0 + 4 * g + r) * 4096 + 2 * HC + h * HD + 16 * vb + c] = bf1(Y[r]);
#pragma unroll
            for (int zt = 0; zt < 8; ++zt) {
                const bf16x4 aK = *(const LAS bf16x4*)(cur + HGB_KIT + (16 * zt + c) * 32 + 8 * g);
                const f32x4 gl = *(const LAS f32x4*)(cur + HGB_GL + (16 * zt + 4 * g) * 4);
                Z[zt] = MFMA16(aK, bV, Z[zt]) * gl; }
            { const int jn = (ci + NRAW < NCHK) ? ci + NRAW : NCHK - 1; HG3_DMA(jn); }
            asm volatile("s_waitcnt vmcnt(50)" ::: "memory");
            WG_BAR();
        }
    } else {
        for (int ci = 0; ci < NCHK; ++ci) {
            const int jp = (ci + 2 < NCHK) ? ci + 2 : NCHK - 1, ja = (ci + 1 < NCHK) ? ci + 1 : NCHK - 1;
            HG3_PROC(jp);
            if (w == 4) a_stage(ja);
            { const int jn = (ci + NRAW < NCHK) ? ci + NRAW : NCHK - 1; HG3_DMA(jn); }
            asm volatile("s_waitcnt vmcnt(30)" ::: "memory");
            WG_BAR();
        }
    }
#undef HG3_DMA
#undef HG3_PROC
}
#undef WG_BAR
constexpr int NSCAN = BATCH * RH + 2 * BATCH * HH;
__device__ __forceinline__ void p6_shadow(Frame& F, const Args& A, int c, int G) {
    const unsigned long long* ss = WSP(unsigned long long, WS_SS);
    {   pg8::Gemm g{WSP(bf16, WS_XB), WSP(bf16, WS_WIN) + (size_t)26 * 256 * D, M, 4 * 256, D}; pg8::StaticOrder S; S.init(M, 4 * 256, G, c);
        pg8::EpiInProj E{WSP(bf16, WS_R + R_RKV), WSP(float, WS_R + R_LIN), WSP(bf16, WS_R + R_HG), ss + M, F.in[18], 26};
        pg8::gemm_phase<pg8::EpiInProj, pg8::StaticOrder, true, true>(F.lds, g, S, E); }
    {   int kl = KL; asm volatile("" : "+s"(kl));
        pg8::Gemm g{WSP(bf16, WS_ALORA), WSP(bf16, WS_WLORA) + (size_t)8 * 256 * KL, M, 4 * 256, kl}; pg8::StaticOrder S; S.init(M, 4 * 256, G, c);
        pg8::EpiLora E{WSP(bf16, WS_LOUT), F.in[8], F.in[10], 8};
        pg8::gemm_phase<pg8::EpiLora, pg8::StaticOrder, true, true>(F.lds, g, S, E); }
    p0_transposes<1>(F, A, c * NWAVES + F.wave, G * NWAVES);
}
__device__ __forceinline__ void p6_scans(Frame& F, const Args& A) {
    const int bx = (int)blockIdx.x;
    if (F.G > NSCAN) { if (bx < NSCAN) { if (bx < BATCH * RH) p6_rwkv_head(F, bx); else p6_hgrn_head(F, bx - BATCH * RH); } else p6_shadow(F, A, bx - NSCAN, F.G - NSCAN); }
    else {
        for (int u = bx; u < NSCAN; u += F.G) { if (u < BATCH * RH) p6_rwkv_head(F, u); else p6_hgrn_head(F, u - BATCH * RH); }
        __syncthreads(); p6_shadow(F, A, bx, F.G);
    }
}

__device__ __forceinline__ void p7_post(Frame& F) {
    const bf16* rkv = WSP(bf16, WS_R + R_RKV); const bf16* hg = WSP(bf16, WS_R + R_HG); const bf16* lout = WSP(bf16, WS_LOUT); bf16* yc = WSP(bf16, WS_XB);
    { const int half = F.tid >> 8, ch = (F.tid & 255) * 4;
      const f32x4 mu_r = *(const f32x4*)(F.in[7] + ch), mu_k = *(const f32x4*)(F.in[7] + RC + ch), mu_v = *(const f32x4*)(F.in[7] + 2 * RC + ch);
      const f32x4 kac = *(const f32x4*)(F.in[14] + ch), rkc = *(const f32x4*)(F.in[15] + ch), lnw = *(const f32x4*)(F.in[16] + ch), lnb = *(const f32x4*)(F.in[17] + ch);
      for (int m = F.vcu * 2 + half; m < M; m += 2 * F.G) {
          const bool first = (m & (SEQ - 1)) == 0; const size_t mp = first ? m : m - 1;
          const bf16* p = rkv + (size_t)m * 3072 + ch; const bf16* q = rkv + mp * 3072 + ch; const bf16* l = lout + (size_t)m * 3072 + ch;
          const f32x4 y = unpack4(*(const GAS v2u*)(l));
          const f32x4 r = unpack4(*(const GAS v2u*)(p)), k = unpack4(*(const GAS v2u*)(p + RC)), v = unpack4(*(const GAS v2u*)(p + 2 * RC));
          f32x4 rp = unpack4(*(const GAS v2u*)(q)), kp = unpack4(*(const GAS v2u*)(q + RC)), vp = unpack4(*(const GAS v2u*)(q + 2 * RC));
          if (first) { rp = (f32x4){0.f, 0.f, 0.f, 0.f}; kp = rp; vp = rp; }
          const f32x4 a = unpack4(*(const GAS v2u*)(l + RC)), gg = unpack4(*(const GAS v2u*)(l + 2 * RC));
          const f32x4 rs = r + (rp - r) * mu_r, ks = k + (kp - k) * mu_k, vs = v + (vp - v) * mu_v;
          const f32x4 km = ks * (1.0f + (a - 1.0f) * kac);
          const f32x4 bt = rs * km * rkc; float bon = (bt[0] + bt[1]) + (bt[2] + bt[3]); bon = row16_sum(bon);
          float s1 = (y[0] + y[1]) + (y[2] + y[3]); s1 = row16_sum(s1); const float mean = s1 * (1.0f / 64.0f);
          const f32x4 d = y - mean; float s2 = (d[0] * d[0] + d[1] * d[1]) + (d[2] * d[2] + d[3] * d[3]); s2 = row16_sum(s2);
          const float rstd = 1.0f / sqrtf(s2 * (1.0f / 64.0f) + 64e-5f);
          const f32x4 o = ((d * rstd) * lnw + lnb + vs * bon) * gg;
          *(GAS v2u*)(yc + (size_t)m * 2048 + ch) = pack4(o); } }
    { const int quarter = F.tid >> 7, ch = (F.tid & 127) * 8;
      const f32x4 nw0 = *(const f32x4*)(F.in[19] + ch), nw1 = *(const f32x4*)(F.in[19] + ch + 4);
      for (int m = F.vcu * 4 + quarter; m < M; m += 4 * F.G) {
          const v4u ow = *(const GAS v4u*)(hg + (size_t)m * 4096 + 2 * HC + ch), gw4 = *(const GAS v4u*)(hg + (size_t)m * 4096 + 3 * HC + ch);
          const f32x4 o0 = (f32x4){bflo(ow.x), bfhi(ow.x), bflo(ow.y), bfhi(ow.y)}, o1 = (f32x4){bflo(ow.z), bfhi(ow.z), bflo(ow.w), bfhi(ow.w)};
          const f32x4 g0 = (f32x4){bflo(gw4.x), bfhi(gw4.x), bflo(gw4.y), bfhi(gw4.y)}, g1 = (f32x4){bflo(gw4.z), bfhi(gw4.z), bflo(gw4.w), bfhi(gw4.w)};
          float s2 = ((o0[0] * o0[0] + o0[1] * o0[1]) + (o0[2] * o0[2] + o0[3] * o0[3])) + ((o1[0] * o1[0] + o1[1] * o1[1]) + (o1[2] * o1[2] + o1[3] * o1[3])); s2 = row16_sum(s2);
          const float rstd = 1.0f / sqrtf(s2 * (1.0f / 128.0f) + 1e-6f);
          *(GAS v4u*)(yc + (size_t)m * 2048 + RC + ch) = pg8::pack8(o0 * rstd * nw0 * g0, o1 * rstd * nw1 * g1); } }
}

__device__ __forceinline__ void p11_final(Frame& F) {
    const int gw = F.vcu * NWAVES + F.wave, NGW = F.G * NWAVES; const float* fg = F.in[25];
    f32x4 gn[8];
#pragma unroll
    for (int i = 0; i < 8; ++i) gn[i] = *(const f32x4*)(fg + 4 * F.lane + 256 * i);
    for (int m = gw; m < M; m += NGW) { GAS f32x4* xr = (GAS f32x4*)(F.out + (size_t)m * D) + F.lane; f32x4 v[8]; float s = 0.f;
#pragma unroll
        for (int i = 0; i < 8; ++i) { v[i] = xr[64 * i]; s += (v[i][0] * v[i][0] + v[i][1] * v[i][1]) + (v[i][2] * v[i][2] + v[i][3] * v[i][3]); }
        s = wave_sum(s); const float inv = 1.0f / sqrtf(s * (1.0f / D) + 1e-6f);
#pragma unroll
        for (int i = 0; i < 8; ++i) xr[64 * i] = v[i] * inv * gn[i]; }
}

__global__ void __launch_bounds__(NWAVES * 64, 2) mk_fwd(Args args) {
    extern __shared__ __attribute__((aligned(16))) unsigned char lds[];
    Frame F;
    F.lds = (LAS unsigned char*)lds;
    F.tid = threadIdx.x; F.lane = F.tid & 63; F.wave = __builtin_amdgcn_readfirstlane(F.tid >> 6);
    F.G = gridDim.x; { const int bx = blockIdx.x; F.vcu = (F.G % 8 == 0) ? (bx % 8) * (F.G / 8) + bx / 8 : bx; }
#pragma unroll
    for (int i = 0; i < 26; ++i) F.in[i] = args.in[i];
    F.out = args.out; F.ws = args.ws;
    for (int u = F.tid; u < (LDS_BYTES - LDSCTL_OFF) / 4; u += NWAVES * 64) ((LAS unsigned*)(F.lds + LDSCTL_OFF))[u] = 0u;
    __syncthreads();
    const int lo = args.ph_lo, hi = args.ph_hi;
    XcdBarrier bar; bar.bar = (unsigned*)(args.ws + WS_CTL) + CW_BAR; bar.x = 0; bar.st = nullptr;
    if (hi - lo > 1) bar = xcd_barrier_post((unsigned*)(args.ws + WS_CTL) + CW_BAR, (volatile LAS unsigned*)(F.lds + MISC_OFF) + 8);
#ifndef PH_MASK
#define PH_MASK 0xFFF
#endif
#define IN(k) (((PH_MASK >> (k)) & 1) && lo <= (k) && (k) < hi)
#define SEAM(k) do { if (IN(k) && IN((k) + 1)) xcd_barrier(bar); } while (0)
    const bf16* xb = WSP(bf16, WS_XB); unsigned long long* ss = WSP(unsigned long long, WS_SS);
    const int cid = (int)blockIdx.x;

    if (IN(0)) { p0_prologue(F, args); } SEAM(0);
    if (IN(1)) {
        pg8::Gemm g{xb, WSP(bf16, WS_W1GU), M, 2 * FF, D}; pg8::StaticOrder S; S.init(M, 2 * FF, F.G, cid);
        pg8::EpiSwiglu E{WSP(bf16, WS_R + R_ACT), FF, ss};
        pg8::gemm_phase<pg8::EpiSwiglu, pg8::StaticOrder, true, true>(F.lds, g, S, E);
    } SEAM(1);
    if (IN(2)) {
        pg8::Gemm g{WSP(bf16, WS_R + R_ACT), WSP(bf16, WS_W1D), M, D, FF}; pg8::StaticOrder S; S.init(M, D, F.G, cid);
        pg8::EpiResid E{F.in[0], F.out, WSP(bf16, WS_XB), ss + M, 0.5f, F.in[5]};
        pg8::gemm_phase<pg8::EpiResid, pg8::StaticOrder, true, true>(F.lds, g, S, E);
    } SEAM(2);
    if (IN(3)) {
        pg8::Gemm g{xb, WSP(bf16, WS_WIN), M, 26 * 256, D}; pg8::StaticOrder S; S.init(M, 26 * 256, F.G, cid);
        pg8::EpiInProj E{WSP(bf16, WS_R + R_RKV), WSP(float, WS_R + R_LIN), WSP(bf16, WS_R + R_HG), ss + M, F.in[18], 0};
        pg8::gemm_phase<pg8::EpiInProj, pg8::StaticOrder, true, true>(F.lds, g, S, E);
    } SEAM(3);
    if (IN(4)) { p4_lora_in(F); } SEAM(4);
    if (IN(5)) {
        int kl = KL; asm volatile("" : "+s"(kl));
        pg8::Gemm g{WSP(bf16, WS_ALORA), WSP(bf16, WS_WLORA), M, 8 * 256, kl}; pg8::StaticOrder S; S.init(M, 8 * 256, F.G, cid);
        pg8::EpiLora E{WSP(bf16, WS_LOUT), F.in[8], F.in[10], 0};
        pg8::gemm_phase<pg8::EpiLora, pg8::StaticOrder, true, true>(F.lds, g, S, E);
    } SEAM(5);
    if (IN(6)) { p6_scans(F, args); } SEAM(6);
    if (IN(7)) { p7_post(F); } SEAM(7);
    if (IN(8)) {
        pg8::Gemm g{xb, WSP(bf16, WS_WOUT), M, D, D}; pg8::StaticOrder S; S.init(M, D, F.G, cid);
        pg8::EpiResid E{F.out, F.out, WSP(bf16, WS_R + R_X2B), ss + 2 * M, 1.0f, F.in[21]};
        pg8::gemm_phase<pg8::EpiResid, pg8::StaticOrder, true, true>(F.lds, g, S, E);
    } SEAM(8);
    if (IN(9)) {
        pg8::Gemm g{WSP(bf16, WS_R + R_X2B), WSP(bf16, WS_W2GU), M, 2 * FF, D}; pg8::StaticOrder S; S.init(M, 2 * FF, F.G, cid);
        pg8::EpiSwiglu E{WSP(bf16, WS_R + R_ACT), FF, ss + 2 * M};
        pg8::gemm_phase<pg8::EpiSwiglu, pg8::StaticOrder, true, true>(F.lds, g, S, E);
    } SEAM(9);
    if (IN(10)) {
        pg8::Gemm g{WSP(bf16, WS_R + R_ACT), WSP(bf16, WS_W2D), M, D, FF}; pg8::StaticOrder S; S.init(M, D, F.G, cid);
        pg8::EpiResid E{F.out, F.out, nullptr, nullptr, 0.5f, nullptr};
        pg8::gemm_phase<pg8::EpiResid, pg8::StaticOrder, true, true>(F.lds, g, S, E);
    } SEAM(10);
    if (IN(11)) { p11_final(F); }
#undef IN
#undef SEAM
}

extern "C" void kernel_launch(void* const* d_in, const int* in_sizes, int n_in, void* d_out, int out_size, void* d_ws, size_t ws_size, hipStream_t stream) {
    static int grid = 0;
    if (grid == 0) {
        if (n_in != 26 || in_sizes[0] != M * D || out_size != M * D || ws_size < WS_END) { fprintf(stderr, "kernel_launch: unexpected problem (n_in %d, ws %zu < %zu)\n", n_in, ws_size, (size_t)WS_END); grid = -1; return; }
        int dev = 0, cus = 0, per_cu = 0;
        if (hipGetDevice(&dev) != hipSuccess || hipDeviceGetAttribute(&cus, hipDeviceAttributeMultiprocessorCount, dev) != hipSuccess) { grid = -1; return; }
        if (hipFuncSetAttribute((const void*)mk_fwd, hipFuncAttributeMaxDynamicSharedMemorySize, LDS_BYTES) != hipSuccess) { grid = -1; return; }
        if (hipOccupancyMaxActiveBlocksPerMultiprocessor(&per_cu, (const void*)mk_fwd, NWAVES * 64, LDS_BYTES) != hipSuccess || per_cu < 1) fprintf(stderr, "kernel_launch: occupancy query reports %d\n", per_cu);
        (void)hipGetLastError();
        grid = cus;
    }
    if (grid < 0) return;
    (void)hipMemsetAsync((char*)d_ws + WS_CTL, 0, CTL_BYTES, stream);
    Args a{};
    for (int i = 0; i < 26; ++i) a.in[i] = (const float*)d_in[i];
    a.out = (float*)d_out; a.ws = (unsigned char*)d_ws;
    constexpr int NL_ = MK_N_LAUNCHES;
    for (int li = 0; li < NL_; ++li) {
        a.ph_lo = (NL_ == 1) ? 0 : li; a.ph_hi = (NL_ == 1) ? N_PHASES : li + 1;
        hipLaunchKernelGGL(mk_fwd, dim3(grid), dim3(NWAVES * 64), LDS_BYTES, stream, a);
    }
}
```

```cpp
#include <hip/hip_runtime.h>
#include <cstdio>
#include <cstdint>
namespace pg8 {
#define PG8_LAS __attribute__((address_space(3)))
typedef unsigned short bf16_t;
typedef short bf16x8 __attribute__((ext_vector_type(8)));
typedef float f32x4 __attribute__((ext_vector_type(4)));
typedef unsigned u32x4 __attribute__((ext_vector_type(4)));
constexpr int BM = 256, BK = 64, HALF = 128, HTB = HALF * BK * 2  , STAGE_BYTES = 8 * HTB, NXCD = 8, WGM = 8;

__host__ __device__ __forceinline__ int lds_byte(int r, int c) { const int st = (r >> 4) * 2 + (c >> 5), rr = r & 15, cc = c & 31, ob = rr * 64 + cc * 2; return st * 1024 + (ob ^ (((ob >> 9) & 1) << 5)); }
__host__ __device__ __forceinline__ void stage_rc(int b, int& R, int& C) { const int st = b / 1024, sb = b % 1024, swz = sb ^ (((sb >> 9) & 1) << 5); R = (st >> 1) * 16 + swz / 64; C = (st & 1) * 32 + (swz % 64) / 2; }
__host__ __device__ __forceinline__ int perm32(int rho) { const int n = rho >> 4, i = rho & 15; return 8 * (i >> 2) + 4 * n + (i & 3); }

struct Unit { int pm, pn; };
struct Gemm { const bf16_t* A; const bf16_t* Bt; int M, N, K; };

struct StaticOrder {
    int nM, nN, nwg, G, c, wgm;
    __host__ __device__ void init(int M, int N, int G_, int c_, int wgm_ = WGM) { nM = M / BM; nN = N / BM; nwg = nM * nN; G = G_; c = c_; wgm = wgm_; }
    __host__ __device__ bool next(int i, Unit& u) const {
        const long L = (long)i * G + c; if (L >= nwg) return false;
        int wgid = (int)L; { const int q = nwg / NXCD, r = nwg % NXCD, xcd = wgid % NXCD, off = wgid / NXCD; wgid = (xcd < r ? xcd * (q + 1) : r * (q + 1) + (xcd - r) * q) + off; }
        const int nig = wgm * nN, gid = wgid / nig, fm = gid * wgm, gsz = (nM - fm) < wgm ? (nM - fm) : wgm;
        u.pm = fm + ((wgid % nig) % gsz); u.pn = (wgid % nig) / gsz; return true;
    }
    __device__ __forceinline__ void a_ready(const Unit&) const {}
    __device__ __forceinline__ void done(const Unit&) const {}
};


typedef __bf16 bf16n2 __attribute__((ext_vector_type(2)));
__device__ __forceinline__ unsigned cvt_pk_bf16(float lo, float hi) { bf16n2 v; v.x = (__bf16)lo; v.y = (__bf16)hi; return __builtin_bit_cast(unsigned, v); }
__device__ __forceinline__ float fast_sigmoid(float z) { return __builtin_amdgcn_rcpf(1.0f + __builtin_amdgcn_exp2f(-1.44269504f * z)); }
__device__ __forceinline__ float fast_silu(float z) { return z * fast_sigmoid(z); }
constexpr float SS_SCALE = 16777216.0f;
__device__ __forceinline__ float inv_rms_from_val(unsigned long long v) {
    const float tot = (float)v * (1.0f / SS_SCALE);
    return 1.0f / sqrtf(tot * (1.0f / 2048.0f) + 1e-6f);
}
__device__ __forceinline__ u32x4 pack8(const f32x4 v0, const f32x4 v1) { u32x4 w; w.x = cvt_pk_bf16(v0[0], v0[1]); w.y = cvt_pk_bf16(v0[2], v0[3]); w.z = cvt_pk_bf16(v1[0], v1[1]); w.w = cvt_pk_bf16(v1[2], v1[3]); return w; }

struct InvTab {
    const PG8_LAS float* tab; int t0, t1, t2, t3; const unsigned long long* ss;
    __device__ __forceinline__ int slot(int pm) const { return pm == t0 ? 0 : (pm == t1 ? 1 : (pm == t2 ? 2 : (pm == t3 ? 3 : -1))); }
    __device__ __forceinline__ void get(float (&inv)[2][4], int pm, int r0) const {
        const int sl = slot(pm);
        if (sl >= 0) {
#pragma unroll
            for (int ai = 0; ai < 2; ++ai)
#pragma unroll
                for (int m = 0; m < 4; ++m) inv[ai][m] = tab[sl * BM + r0 + ai * HALF + m * 16];
        } else { unsigned long long sv[2][4];
#pragma unroll
            for (int ai = 0; ai < 2; ++ai)
#pragma unroll
                for (int m = 0; m < 4; ++m) sv[ai][m] = ss[pm * BM + r0 + ai * HALF + m * 16];
#pragma unroll
            for (int ai = 0; ai < 2; ++ai)
#pragma unroll
                for (int m = 0; m < 4; ++m) inv[ai][m] = inv_rms_from_val(sv[ai][m]); }
    }
};
template <class Sched> __device__ __forceinline__ InvTab inv_preload(PG8_LAS float* tab, const Sched& S, const unsigned long long* ss) {
    InvTab T; T.tab = tab; T.t0 = -1; T.t1 = -1; T.t2 = -1; T.t3 = -1; T.ss = ss; int n = 0; Unit u;
    for (int i = 0; S.next(i, u); ++i) {
        if (T.slot(u.pm) < 0 && n < 4) {
            if (threadIdx.x < BM) tab[n * BM + threadIdx.x] = inv_rms_from_val(ss[u.pm * BM + threadIdx.x]);
            if (n == 0) T.t0 = u.pm; else if (n == 1) T.t1 = u.pm; else if (n == 2) T.t2 = u.pm; else T.t3 = u.pm;
            ++n; } }
    __syncthreads();
    return T;
}
struct EpiSwiglu {
    static constexpr bool PERM = true, AFTER_DRAIN = false;
    bf16_t* O; int ldc; InvTab it;
    __device__ __forceinline__ void operator()(const f32x4 (&acc)[2][2][4][2], const Unit& u, int wr, int wc, int fr, int fq) const {
        const int row0 = u.pm * BM + wr * 64 + fr, col0 = u.pn * HALF + wc * 32 + 8 * fq;
        float invs[2][4]; it.get(invs, u.pm, wr * 64 + fr);
#pragma unroll
        for (int ai = 0; ai < 2; ++ai)
#pragma unroll
            for (int m = 0; m < 4; ++m) { const int row = row0 + ai * HALF + m * 16; const float inv = invs[ai][m];
                f32x4 o[2];
#pragma unroll
                for (int n = 0; n < 2; ++n) { const f32x4 g = acc[ai][0][m][n] * inv, up = acc[ai][1][m][n] * inv;
#pragma unroll
                    for (int j = 0; j < 4; ++j) o[n][j] = fast_silu(g[j]) * up[j]; }
                *(u32x4*)(O + (size_t)row * ldc + col0) = pack8(o[0], o[1]); }
    }
};
struct EpiResid {
    static constexpr bool PERM = true, AFTER_DRAIN = false;
    const float* resid; float* out; bf16_t* ob; unsigned long long* ss; float alpha; const float* gain;
    __device__ __forceinline__ void operator()(const f32x4 (&acc)[2][2][4][2], const Unit& u, int wr, int wc, int fr, int fq) const {
        const int row0 = u.pm * BM + wr * 64 + fr, col0 = u.pn * BM + wc * 32 + 8 * fq;
#pragma unroll
        for (int ai = 0; ai < 2; ++ai)
#pragma unroll
            for (int m = 0; m < 4; ++m) { const int row = row0 + ai * HALF + m * 16; const size_t off = (size_t)row * 2048 + col0; float s = 0.f;
#pragma unroll
                for (int bj = 0; bj < 2; ++bj) {
                    const f32x4 r0 = *(const f32x4*)(resid + off + bj * HALF), r1 = *(const f32x4*)(resid + off + bj * HALF + 4);
                    const f32x4 o0 = r0 + acc[ai][bj][m][0] * alpha, o1 = r1 + acc[ai][bj][m][1] * alpha;
                    *(f32x4*)(out + off + bj * HALF) = o0; *(f32x4*)(out + off + bj * HALF + 4) = o1;
                    if (ob) { const f32x4 g0 = *(const f32x4*)(gain + col0 + bj * HALF), g1 = *(const f32x4*)(gain + col0 + bj * HALF + 4); *(u32x4*)(ob + off + bj * HALF) = pack8(o0 * g0, o1 * g1); }
                    s += (o0[0] * o0[0] + o0[1] * o0[1]) + (o0[2] * o0[2] + o0[3] * o0[3]) + (o1[0] * o1[0] + o1[1] * o1[1]) + (o1[2] * o1[2] + o1[3] * o1[3]); }
                if (ss) { s += __shfl_xor(s, 16); s += __shfl_xor(s, 32);
                    if (fq == 0) atomicAdd(ss + row, (unsigned long long)(s * SS_SCALE + 0.5f)); } }
    }
};
struct EpiInProj {
    static constexpr bool PERM = true, AFTER_DRAIN = false;
    bf16_t* rkv; float* lin; bf16_t* hg; InvTab it; const PG8_LAS float* oml; int pn0;
    __device__ __forceinline__ void operator()(const f32x4 (&acc)[2][2][4][2], const Unit& u, int wr, int wc, int fr, int fq) const {
        const int row0 = u.pm * BM + wr * 64 + fr, cin = wc * 32 + 8 * fq;
        const int pn = u.pn + pn0;
        float invs[2][4]; it.get(invs, u.pm, wr * 64 + fr);
        int mode;
        if (pn < 12) mode = 0; else if (pn < 14) mode = 1; else { const int sg = (pn - 14) >> 2; mode = (sg == 0 || sg == 3) ? 2 : (sg == 1 ? 3 : 4); }
#pragma unroll
        for (int bj = 0; bj < 2; ++bj) {
            f32x4 om0 = (f32x4){0.f, 0.f, 0.f, 0.f}, om1 = om0;
            if (mode == 3) { const PG8_LAS float* lp = oml + (pn - 18) * BM + bj * HALF + cin; om0 = *(const PG8_LAS f32x4*)lp; om1 = *(const PG8_LAS f32x4*)(lp + 4); }
#pragma unroll
            for (int ai = 0; ai < 2; ++ai)
#pragma unroll
                for (int m = 0; m < 4; ++m) { const int row = row0 + ai * HALF + m * 16; const float inv = invs[ai][m];
                    f32x4 v0 = acc[ai][bj][m][0] * inv, v1 = acc[ai][bj][m][1] * inv;
                    if (mode == 0) { *(u32x4*)(rkv + (size_t)row * 3072 + pn * BM + bj * HALF + cin) = pack8(v0, v1); }
                    else if (mode == 1) { const int cl = (pn - 12) * BM + bj * HALF + cin;
                        if (cl < 288) { *(f32x4*)(lin + (size_t)row * 288 + cl) = v0; *(f32x4*)(lin + (size_t)row * 288 + cl + 4) = v1; } }
                    else {
                        if (mode == 2) {
#pragma unroll
                            for (int j = 0; j < 4; ++j) { v0[j] = fast_silu(v0[j]); v1[j] = fast_silu(v1[j]); } }
                        else if (mode == 3) {
#pragma unroll
                            for (int j = 0; j < 4; ++j) { v0[j] = __logf(1.0f - om0[j] * fast_sigmoid(-v0[j])); v1[j] = __logf(1.0f - om1[j] * fast_sigmoid(-v1[j])); } }
                        *(u32x4*)(hg + (size_t)row * 4096 + (pn - 14) * BM + bj * HALF + cin) = pack8(v0, v1); } } }
    }
};
struct EpiLora {
    static constexpr bool PERM = true, AFTER_DRAIN = false;
    bf16_t* lout; const PG8_LAS float* bias; int pn0;
    __device__ __forceinline__ void operator()(const f32x4 (&acc)[2][2][4][2], const Unit& u, int wr, int wc, int fr, int fq) const {
        const int row0 = u.pm * BM + wr * 64 + fr, cin = wc * 32 + 8 * fq;
        const int pn = u.pn + pn0, mode = pn >> 2;
#pragma unroll
        for (int bj = 0; bj < 2; ++bj) {
            f32x4 b0 = (f32x4){0.f, 0.f, 0.f, 0.f}, b1 = b0;
            if (mode < 2) { const PG8_LAS float* bp = bias + pn * BM + bj * HALF + cin; b0 = *(const PG8_LAS f32x4*)bp; b1 = *(const PG8_LAS f32x4*)(bp + 4); }
#pragma unroll
            for (int ai = 0; ai < 2; ++ai)
#pragma unroll
                for (int m = 0; m < 4; ++m) { const int row = row0 + ai * HALF + m * 16;
                    f32x4 v0 = acc[ai][bj][m][0] + b0, v1 = acc[ai][bj][m][1] + b1;
#pragma unroll
                    for (int j = 0; j < 4; ++j) { const float s0 = fast_sigmoid(v0[j]), s1 = fast_sigmoid(v1[j]);
                        const float d0 = -0.60653066f * s0, d1 = -0.60653066f * s1;
                        v0[j] = mode == 0 ? d0 : (mode == 1 ? s0 : v0[j]); v1[j] = mode == 0 ? d1 : (mode == 1 ? s1 : v1[j]); }
                    *(u32x4*)(lout + (size_t)row * 3072 + pn * BM + bj * HALF + cin) = pack8(v0, v1); asm volatile("" ::: "memory"); } }
    }
};
template <class Epi, class Sched, bool ALIGN_EPI = false, bool SP2 = false>
__device__ __forceinline__ void gemm_phase(PG8_LAS unsigned char* lds, const Gemm g, const Sched& S, const Epi& E) {
    const int tid = threadIdx.x, wid = __builtin_amdgcn_readfirstlane(tid >> 6), lane = tid & 63, wr = wid >> 2, wc = wid & 3, fr = lane & 15, fq = lane >> 4;
    const int K = g.K, nt = K / BK;
    unsigned voffA[2], voffB[2];
#pragma unroll
    for (int i = 0; i < 2; ++i) { int R, C; stage_rc(tid * 16 + i * 8192, R, C); const int Rb = Epi::PERM ? ((R & ~31) + perm32(R & 31)) : R;
        voffA[i] = (unsigned)(R * K + C) * 2u; voffB[i] = (unsigned)(Rb * K + C) * 2u; }
    const size_t kstep = (size_t)(BK * 2);
    const size_t hstep = (size_t)HALF * K * 2;
    const size_t tstep = 2 * hstep;
    const unsigned ldsw = (unsigned)wid * 1024u;
    const int aoff = lds_byte(wr * 64 + fr, fq * 8), boff = lds_byte(wc * 32 + fr, fq * 8);
#define PG8_SA(b, h) (((b) * 2 + (h)) * HTB)
#define PG8_SB(b, h) ((4 + (b) * 2 + (h)) * HTB)
#define PG8_STAGE(bufoff, gbase, voff) do { _Pragma("unroll") for (int _i = 0; _i < 2; ++_i) \
        __builtin_amdgcn_global_load_lds((const unsigned*)((const char*)(gbase) + (voff)[_i]), (PG8_LAS unsigned*)(lds + (bufoff) + ldsw + _i * 8192), 16, 0, 0); } while (0)
#define PG8_LDA(dst, b, h) do { _Pragma("unroll") for (int m = 0; m < 4; ++m) _Pragma("unroll") for (int k = 0; k < 2; ++k) dst[m][k] = *(const PG8_LAS bf16x8*)(lds + PG8_SA(b, h) + aoff + m * 2048 + k * 1024); } while (0)
#define PG8_LDB(dst, b, h) do { _Pragma("unroll") for (int n = 0; n < 2; ++n) _Pragma("unroll") for (int k = 0; k < 2; ++k) dst[n][k] = *(const PG8_LAS bf16x8*)(lds + PG8_SB(b, h) + boff + n * 2048 + k * 1024); } while (0)
#define PG8_MMA(ai, bj, At, Bt) do { __builtin_amdgcn_s_setprio(1); _Pragma("unroll") for (int m = 0; m < 4; ++m) _Pragma("unroll") for (int n = 0; n < 2; ++n) _Pragma("unroll") for (int k = 0; k < 2; ++k) \
        acc[ai][bj][m][n] = __builtin_amdgcn_mfma_f32_16x16x32_bf16(Bt[n][k], At[m][k], acc[ai][bj][m][n], 0, 0, 0); __builtin_amdgcn_s_setprio(0); } while (0)
#define PG8_WAIT_V(n) asm volatile("s_waitcnt vmcnt(" #n ")" ::: "memory")
#define PG8_WAIT_L(n) asm volatile("s_waitcnt lgkmcnt(" #n ")" ::: "memory")
#define PG8_BAR __builtin_amdgcn_s_barrier()
#define PG8_SCHED __builtin_amdgcn_sched_barrier(0)
    Unit cur, nxt; int ui = 0;
    if (!S.next(0, cur)) return;
    f32x4 acc[2][2][4][2];
#pragma unroll
    for (int a = 0; a < 2; ++a)
#pragma unroll
        for (int b = 0; b < 2; ++b)
#pragma unroll
            for (int m = 0; m < 4; ++m)
#pragma unroll
                for (int n = 0; n < 2; ++n) acc[a][b][m][n] = (f32x4){0.f, 0.f, 0.f, 0.f};
    bf16x8 At[4][2], B0[2][2], B1[2][2];
    const char* cA = (const char*)g.A + (size_t)cur.pm * tstep; const char* cB = (const char*)g.Bt + (size_t)cur.pn * tstep;
    S.a_ready(cur);
    if constexpr (SP2) {
        PG8_STAGE(PG8_SB(0, 0), cB, voffB); PG8_STAGE(PG8_SB(0, 1), cB + hstep, voffB); PG8_STAGE(PG8_SA(0, 0), cA, voffA); PG8_STAGE(PG8_SA(0, 1), cA + hstep, voffA);
        if (wr == 1) PG8_BAR;
        PG8_WAIT_V(2); PG8_BAR;
        PG8_STAGE(PG8_SB(1, 0), cB + kstep, voffB); PG8_STAGE(PG8_SA(1, 0), cA + kstep, voffA); PG8_STAGE(PG8_SB(1, 1), cB + hstep + kstep, voffB);
        PG8_WAIT_V(6); PG8_BAR;
    } else {
        PG8_STAGE(PG8_SB(0, 0), cB, voffB); PG8_STAGE(PG8_SA(0, 0), cA, voffA); PG8_STAGE(PG8_SB(0, 1), cB + hstep, voffB); PG8_STAGE(PG8_SA(0, 1), cA + hstep, voffA);
        if (wr == 1) PG8_BAR;
        PG8_WAIT_V(4); PG8_BAR;
        PG8_STAGE(PG8_SB(1, 0), cB + kstep, voffB); PG8_STAGE(PG8_SA(1, 0), cA + kstep, voffA); PG8_STAGE(PG8_SB(1, 1), cB + hstep + kstep, voffB);
        PG8_WAIT_V(6); PG8_BAR;
    }
    for (;;) {
        const bool has_next = S.next(ui + 1, nxt);
        const char* nA = has_next ? (const char*)g.A + (size_t)nxt.pm * tstep : cA; const char* nB = has_next ? (const char*)g.Bt + (size_t)nxt.pn * tstep : cB;
        for (int t = 0; t < nt; t += 2) {
            const bool last = (t == nt - 2);
            const char* a1 = cA + (size_t)(t + 1) * kstep;
            const char* a2 = last ? nA : cA + (size_t)(t + 2) * kstep; const char* b2 = last ? nB : cB + (size_t)(t + 2) * kstep;
            const char* a3 = a2 + kstep; const char* b3 = b2 + kstep;
            if (last && has_next) S.a_ready(nxt);
            if constexpr (SP2) {
            PG8_LDB(B0, 0, 0); PG8_LDB(B1, 0, 1); PG8_SCHED; PG8_LDA(At, 0, 0); PG8_STAGE(PG8_SA(1, 1), a1 + hstep, voffA);
            PG8_WAIT_V(8); PG8_WAIT_L(0); PG8_BAR; PG8_MMA(0, 0, At, B0); PG8_MMA(0, 1, At, B1); PG8_BAR; PG8_SCHED;
            PG8_LDA(At, 0, 1); PG8_STAGE(PG8_SB(0, 0), b2, voffB); PG8_STAGE(PG8_SB(0, 1), b2 + hstep, voffB); PG8_STAGE(PG8_SA(0, 0), a2, voffA);
            PG8_WAIT_V(8); PG8_WAIT_L(0); PG8_BAR; PG8_MMA(1, 0, At, B0); PG8_MMA(1, 1, At, B1); PG8_BAR; PG8_SCHED;
            PG8_LDB(B0, 1, 0); PG8_LDB(B1, 1, 1); PG8_SCHED; PG8_LDA(At, 1, 0); PG8_STAGE(PG8_SA(0, 1), a2 + hstep, voffA);
            PG8_WAIT_V(8); PG8_WAIT_L(0); PG8_BAR; PG8_MMA(0, 0, At, B0); PG8_MMA(0, 1, At, B1); PG8_BAR; PG8_SCHED;
            PG8_LDA(At, 1, 1); PG8_STAGE(PG8_SB(1, 0), b3, voffB); PG8_STAGE(PG8_SB(1, 1), b3 + hstep, voffB); PG8_STAGE(PG8_SA(1, 0), a3, voffA);
            PG8_WAIT_V(8); PG8_WAIT_L(0); PG8_BAR; PG8_MMA(1, 0, At, B0); PG8_MMA(1, 1, At, B1); PG8_BAR; PG8_SCHED;
            } else {
            PG8_LDB(B0, 0, 0); PG8_SCHED; PG8_LDA(At, 0, 0); PG8_STAGE(PG8_SA(1, 1), a1 + hstep, voffA);
            PG8_WAIT_L(8); PG8_BAR; PG8_WAIT_L(0); PG8_MMA(0, 0, At, B0); PG8_BAR; PG8_SCHED;
            PG8_LDB(B1, 0, 1); PG8_STAGE(PG8_SB(0, 0), b2, voffB);
            PG8_BAR; PG8_WAIT_L(0); PG8_MMA(0, 1, At, B1); PG8_BAR;
            PG8_LDA(At, 0, 1); PG8_STAGE(PG8_SA(0, 0), a2, voffA);
            PG8_BAR; PG8_WAIT_L(0); PG8_MMA(1, 0, At, B0); PG8_BAR; PG8_SCHED;
            PG8_STAGE(PG8_SB(0, 1), b2 + hstep, voffB);
            PG8_WAIT_V(6); PG8_BAR; PG8_MMA(1, 1, At, B1); PG8_BAR;
            PG8_LDB(B0, 1, 0); PG8_SCHED; PG8_LDA(At, 1, 0); PG8_STAGE(PG8_SA(0, 1), a2 + hstep, voffA);
            PG8_WAIT_L(8); PG8_BAR; PG8_WAIT_L(0); PG8_MMA(0, 0, At, B0); PG8_BAR; PG8_SCHED;
            PG8_LDB(B1, 1, 1); PG8_STAGE(PG8_SB(1, 0), b3, voffB);
            PG8_BAR; PG8_WAIT_L(0); PG8_MMA(0, 1, At, B1); PG8_BAR;
            PG8_LDA(At, 1, 1); PG8_STAGE(PG8_SA(1, 0), a3, voffA);
            PG8_BAR; PG8_WAIT_L(0); PG8_MMA(1, 0, At, B0); PG8_BAR; PG8_SCHED;
            PG8_STAGE(PG8_SB(1, 1), b3 + hstep, voffB);
            PG8_WAIT_V(6); PG8_BAR; PG8_MMA(1, 1, At, B1); PG8_BAR;
            }
        }
        if constexpr (ALIGN_EPI) { if (wr == 0) PG8_BAR; }
        if constexpr (!Epi::AFTER_DRAIN) { E(acc, cur, wr, wc, fr, fq); S.done(cur); }
        if (!has_next) break;
#pragma unroll
        for (int a = 0; a < 2; ++a)
#pragma unroll
            for (int b = 0; b < 2; ++b)
#pragma unroll
                for (int m = 0; m < 4; ++m)
#pragma unroll
                    for (int n = 0; n < 2; ++n) acc[a][b][m][n] = (f32x4){0.f, 0.f, 0.f, 0.f};
        cur = nxt; cA = nA; cB = nB; ++ui;
        if constexpr (ALIGN_EPI) { if (wr == 1) PG8_BAR; }
    }
    PG8_WAIT_V(0);
    if constexpr (!ALIGN_EPI) { if (wr == 0) PG8_BAR; }
    PG8_BAR;
    if constexpr (Epi::AFTER_DRAIN) { E.fused(acc, cur, wr, wc, fr, fq, lds, wid, lane); S.done(cur); }
#undef PG8_SA
#undef PG8_SB
#undef PG8_STAGE
#undef PG8_LDA
#undef PG8_LDB
#undef PG8_MMA
#undef PG8_WAIT_V
#undef PG8_WAIT_L
#undef PG8_BAR
#undef PG8_SCHED
}
}

constexpr int NWAVES = 8;
constexpr int BATCH = 4, SEQ = 8192, D = 2048, M = BATCH * SEQ, FF = 5632;
constexpr int RC = 1024, RH = 16, RN = 64;
constexpr int HC = 1024, HH = 8, HD = 128;
constexpr int RWKV_COLS = 3360, IN_COLS = 7456, NIN = 7680;
constexpr int KL = 384, NL = 3072;
#ifndef MK_N_LAUNCHES
#define MK_N_LAUNCHES 1
#endif
constexpr int N_PHASES = 12;

constexpr size_t WS_CTL = 0, CTL_BYTES = 1u << 20;
constexpr size_t WS_W1GU = CTL_BYTES;
constexpr size_t WS_W1D = WS_W1GU + (size_t)2 * FF * D * 2;
constexpr size_t WS_WIN = WS_W1D + (size_t)D * FF * 2;
constexpr size_t WS_WLORA = WS_WIN + (size_t)NIN * D * 2;
constexpr size_t WS_WOUT = WS_WLORA + (size_t)NL * KL * 2;
constexpr size_t WS_W2GU = WS_WOUT + (size_t)D * D * 2;
constexpr size_t WS_W2D = WS_W2GU + (size_t)2 * FF * D * 2;
constexpr size_t WS_SS = WS_W2D + (size_t)D * FF * 2;
constexpr size_t WS_XB = WS_SS + (1u << 20);
constexpr size_t WS_R = WS_XB + (size_t)M * D * 2;
constexpr size_t R_ACT = 0;
constexpr size_t R_RKV = 0;
constexpr size_t R_HG = R_RKV + (size_t)M * 3072 * 2;
constexpr size_t R_LIN = R_HG + (size_t)M * 4096 * 2;
constexpr size_t R_X2B = (size_t)M * FF * 2;
constexpr size_t R_BYTES = R_LIN + (size_t)M * 288 * 4;
constexpr size_t WS_ALORA = WS_R + R_BYTES;
constexpr size_t WS_LOUT = WS_ALORA + (size_t)M * KL * 2;
constexpr size_t WS_INVN = WS_LOUT + (size_t)M * NL * 2;
constexpr size_t WS_END = WS_INVN + (size_t)M * RH * 4;
static_assert(R_X2B + (size_t)M * D * 2 <= R_BYTES && WS_END <= ((size_t)1 << 30), "d_ws map");
constexpr int CW_BAR = 4096;

constexpr int RING_BYTES = 162816;
constexpr int LDSCTL_OFF = RING_BYTES, MISC_OFF = LDSCTL_OFF + 320;
constexpr int LDS_BYTES = 163840;
static_assert(MISC_OFF + 128 <= LDS_BYTES, "LDS map");

#define GAS __attribute__((address_space(1)))
#define LAS __attribute__((address_space(3)))
typedef unsigned short bf16;
typedef unsigned v4u __attribute__((ext_vector_type(4)));
typedef unsigned v2u __attribute__((ext_vector_type(2)));
typedef float f32x4 __attribute__((ext_vector_type(4)));
#define LDS_WAIT() asm volatile("s_waitcnt lgkmcnt(0)" ::: "memory")
#define VM_WAIT() asm volatile("s_waitcnt vmcnt(0)" ::: "memory")
__device__ __forceinline__ float bflo(unsigned u) { return __builtin_bit_cast(float, u << 16); }
__device__ __forceinline__ float bfhi(unsigned u) { return __builtin_bit_cast(float, u & 0xffff0000u); }
__device__ __forceinline__ f32x4 unpack4(v2u w) { return (f32x4){bflo(w.x), bfhi(w.x), bflo(w.y), bfhi(w.y)}; }
__device__ __forceinline__ unsigned pk2(float lo, float hi) { return pg8::cvt_pk_bf16(lo, hi); }
__device__ __forceinline__ v2u pack4(f32x4 v) { v2u w; w.x = pk2(v[0], v[1]); w.y = pk2(v[2], v[3]); return w; }
using pg8::fast_sigmoid;
using pg8::fast_silu;
template <int CTRL> __device__ __forceinline__ float dpp_mov(float x) { return __builtin_bit_cast(float, __builtin_amdgcn_update_dpp(0, __builtin_bit_cast(int, x), CTRL, 0xF, 0xF, true)); }
__device__ __forceinline__ float row16_sum(float x) { x += dpp_mov<0x128>(x); x += dpp_mov<0x124>(x); x += dpp_mov<0x122>(x); x += dpp_mov<0x121>(x); return x; }
template <int CTRL, int BANK> __device__ __forceinline__ float dpp_upd(float old, float x) { return __builtin_bit_cast(float, __builtin_amdgcn_update_dpp(__builtin_bit_cast(int, old), __builtin_bit_cast(int, x), CTRL, 0xF, BANK, false)); }
__device__ __forceinline__ float tr_reduce16(const float (&v)[16], int lane) {
    float u[8], w[4], x[2];
#pragma unroll
    for (int s = 0; s < 8; ++s) { const float t = v[s + 8] + dpp_mov<0x128>(v[s + 8]), a = v[s] + dpp_mov<0x128>(v[s]); u[s] = dpp_upd<0xE4, 0x3>(t, a); }
#pragma unroll
    for (int s = 0; s < 4; ++s) { const float t = u[s + 4] + dpp_mov<0x141>(u[s + 4]), a = u[s] + dpp_mov<0x141>(u[s]); w[s] = dpp_upd<0xE4, 0x5>(t, a); }
    const bool b1 = (lane & 2) != 0, b0 = (lane & 1) != 0;
#pragma unroll
    for (int s = 0; s < 2; ++s) { const float K = b1 ? w[s + 2] : w[s], T = b1 ? w[s] : w[s + 2]; x[s] = K + dpp_mov<0x1B>(T); }
    const float K = b0 ? x[1] : x[0], T = b0 ? x[0] : x[1];
    return K + dpp_mov<0xB1>(T);
}
typedef float f32x2 __attribute__((ext_vector_type(2)));
#define LO2(v) __builtin_shufflevector(v, v, 0, 1)
#define HI2(v) __builtin_shufflevector(v, v, 2, 3)
__device__ __forceinline__ float wave_sum(float v) {
#pragma unroll
    for (int o = 1; o < 64; o <<= 1) v += __shfl_xor(v, o);
    return v;
}
#define XB_TMO      128
#define XB_XCNT(j)  (256  + 64 * (j))
#define XB_XSUB(j)  (1280 + 64 * (j))
#define XB_XGEN(j)  (2304 + 64 * (j))
#define XB_TOP      3328
#define XB_TOPGEN   3392
#define XCD_BAR_WORDS 3456
#define XB_SPIN_CAP (1u << 18)

__device__ __forceinline__ unsigned xb_ld(unsigned* p)              { return __hip_atomic_load(p, __ATOMIC_RELAXED, __HIP_MEMORY_SCOPE_AGENT); }
__device__ __forceinline__ unsigned xb_add(unsigned* p, unsigned v) { return __hip_atomic_fetch_add(p, v, __ATOMIC_RELAXED, __HIP_MEMORY_SCOPE_AGENT); }
__device__ __forceinline__ unsigned xb_xcc_id() { return (unsigned)__builtin_amdgcn_s_getreg((3 << 11) | 20) & 0xFu; }
#define XB_SPIN(cond, bar) do { unsigned _sp = 0; while (cond) { __builtin_amdgcn_s_sleep(1); \
    if ((++_sp & 255u) == 0u) { if (xb_ld(&(bar)[XB_TMO])) break; if (_sp > XB_SPIN_CAP) { atomicAdd(&(bar)[XB_TMO], 1u); break; } } } } while (0)

struct XcdBarrier {
    unsigned* bar; unsigned x;
    volatile LAS unsigned* st;
};

__device__ __forceinline__ XcdBarrier xcd_barrier_post(unsigned* bar, volatile LAS unsigned* st) {
    XcdBarrier b; b.bar = bar; b.x = xb_xcc_id(); b.st = st;
    if (threadIdx.x == 0) (void)xb_add(&bar[XB_XCNT(b.x)], 1u);
    return b;
}
__device__ __forceinline__ void xcd_barrier_complete(unsigned* bar, unsigned x, unsigned& nloc, unsigned& nx) {
    const unsigned G = gridDim.x * gridDim.y * gridDim.z;
    unsigned sum, cnt, mine, sp = 0u;
    for (;;) {
        sum = 0u; cnt = 0u; mine = 0u;
#pragma unroll
        for (unsigned j = 0; j < 16; ++j) { const unsigned c = xb_ld(&bar[XB_XCNT(j)]); sum += c; cnt += (c > 0u) ? 1u : 0u; mine = (j == x) ? c : mine; }
        if (sum == G) break;
        __builtin_amdgcn_s_sleep(1);
        if ((++sp & 255u) == 0u) { if (xb_ld(&bar[XB_TMO])) break; if (sp > XB_SPIN_CAP) { atomicAdd(&bar[XB_TMO], 1u); break; } }
    }
    nloc = mine > 0u ? mine : 1u; nx = cnt > 0u ? cnt : 1u;
}

__device__ __forceinline__ void xcd_barrier(const XcdBarrier& b) {
    asm volatile("s_waitcnt vmcnt(0)" ::: "memory");
    __syncthreads();
    if (threadIdx.x == 0) {
        unsigned* bar = b.bar;
        __builtin_amdgcn_s_waitcnt(0);
        unsigned nloc = b.st[0], nx = b.st[1];
        if (nloc == 0u) { xcd_barrier_complete(bar, b.x, nloc, nx); b.st[0] = nloc; b.st[1] = nx; }
        const unsigned old = xb_add(&bar[XB_XSUB(b.x)], 1u);
        const unsigned gen = old / nloc;
        if (old + 1u == (gen + 1u) * nloc) {
            __builtin_amdgcn_fence(__ATOMIC_RELEASE, "agent");
            asm volatile("s_waitcnt vmcnt(0)" ::: "memory");
            const unsigned og = xb_add(&bar[XB_TOP], 1u);
            const unsigned tg = og / nx;
            if (og + 1u == (tg + 1u) * nx) xb_add(&bar[XB_TOPGEN], 1u);
            else XB_SPIN(xb_ld(&bar[XB_TOPGEN]) == tg, bar);
            __builtin_amdgcn_fence(__ATOMIC_ACQUIRE, "agent");
            xb_add(&bar[XB_XGEN(b.x)], 1u);
            asm volatile("s_waitcnt vmcnt(0)" ::: "memory");
        } else {
            XB_SPIN(xb_ld(&bar[XB_XGEN(b.x)]) == gen, bar);
            __builtin_amdgcn_fence(__ATOMIC_ACQUIRE, "agent");
            asm volatile("s_waitcnt vmcnt(0)" ::: "memory");
        }
    }
    __syncthreads();
}

struct Frame {
    LAS unsigned char* lds;
    int tid, lane, wave, vcu, G;
    const float* in[26];
    float* out; unsigned char* ws;
};
#define WSP(T, off) ((T*)(F.ws + (off)))
struct Args { const float* in[26]; float* out; unsigned char* ws; int ph_lo, ph_hi; };

struct P0Item { const float* W; bf16* WT; int K, N, kb, n0, drow0; };
__device__ __forceinline__ int map_gu(int n0, int which) { return (n0 >> 7) * 256 + which * 128 + (n0 & 127); }
constexpr int P0_I_GU = (D / 64) * (FF / 32), P0_I_DN = (FF / 64) * (D / 32), P0_I_IN = (D / 64) * (IN_COLS / 32), P0_I_OUT = (D / 64) * (D / 32);
constexpr int P0_N0 = 2 * P0_I_GU + P0_I_DN + P0_I_IN, P0_N1 = 2 * P0_I_GU + P0_I_DN + P0_I_OUT;
template <int SET> __device__ __forceinline__ P0Item p0_decode(Frame& F, const Args& A, int it) {
    constexpr int I_GU = P0_I_GU, I_DN = P0_I_DN, I_IN = P0_I_IN;
    P0Item p; int r = it;
    if (SET == 0) { if (r >= 2 * I_GU) r += 2 * I_GU; if (r >= 4 * I_GU + I_DN) r += I_DN; }
    else { r += 2 * I_GU; if (r >= 4 * I_GU) r += I_DN; if (r >= 4 * I_GU + 2 * I_DN) r += I_IN; }
    if (r < 4 * I_GU) { const int mat = r / I_GU; r -= mat * I_GU; const int nblk = FF / 32, ffn = mat >> 1, which = mat & 1;
        p.W = A.in[2 + 20 * ffn + which]; p.WT = WSP(bf16, ffn ? WS_W2GU : WS_W1GU); p.K = D; p.N = FF; p.kb = r / nblk; p.n0 = 32 * (r % nblk); p.drow0 = map_gu(p.n0, which); return p; }
    r -= 4 * I_GU;
    if (r < 2 * I_DN) { const int ffn = r / I_DN; r -= ffn * I_DN; const int nblk = D / 32;
        p.W = A.in[4 + 20 * ffn]; p.WT = WSP(bf16, ffn ? WS_W2D : WS_W1D); p.K = FF; p.N = D; p.kb = r / nblk; p.n0 = 32 * (r % nblk); p.drow0 = p.n0; return p; }
    r -= 2 * I_DN;
    if (r < I_IN) { const int nblk = IN_COLS / 32;
        p.W = A.in[6]; p.WT = WSP(bf16, WS_WIN); p.K = D; p.N = IN_COLS; p.kb = r / nblk; p.n0 = 32 * (r % nblk); p.drow0 = p.n0 < RWKV_COLS ? p.n0 : p.n0 + 224; return p; }
    r -= I_IN;
    { const int nblk = D / 32; p.W = A.in[20]; p.WT = WSP(bf16, WS_WOUT); p.K = D; p.N = D; p.kb = r / nblk; p.n0 = 32 * (r % nblk); p.drow0 = p.n0; return p; }
}
__device__ __forceinline__ void p0_dma(const P0Item& p, LAS unsigned char* tile, int lane) {
    const int half = lane >> 5, sl = lane & 31;
#pragma unroll 8
    for (int i = 0; i < 32; ++i) { const int kk = 2 * i + half;
        __builtin_amdgcn_global_load_lds((const GAS unsigned*)(p.W + (size_t)(64 * p.kb + kk) * p.N + p.n0 + (sl ^ (4 * (kk >> 3)))), (LAS unsigned*)(tile + i * 256), 4, 0, 0); }
}
__device__ __forceinline__ void p0_emit(const P0Item& p, const LAS float* t, int lane) {
    const int c = lane & 7;
#pragma unroll
    for (int j = 0; j < 4; ++j) { const int n = (lane >> 3) + 8 * j; const LAS float* s = t + (8 * c) * 32 + (n ^ (4 * c));
        v4u o; o.x = pk2(s[0 * 32], s[1 * 32]); o.y = pk2(s[2 * 32], s[3 * 32]); o.z = pk2(s[4 * 32], s[5 * 32]); o.w = pk2(s[6 * 32], s[7 * 32]);
        *(GAS v4u*)(p.WT + (size_t)(p.drow0 + n) * p.K + 64 * p.kb + 8 * c) = o; }
}
template <int SET> __device__ __forceinline__ void p0_transposes(Frame& F, const Args& A, int gw, int NGW) {
    LAS unsigned char* tiles = F.lds + F.wave * 16384;
    constexpr int NITEMS = SET == 0 ? P0_N0 : P0_N1;
    if (gw < NITEMS) {
        P0Item cur = p0_decode<SET>(F, A, gw); int buf = 0;
        p0_dma(cur, tiles, F.lane);
        for (int it = gw; it < NITEMS; it += NGW) {
            const bool more = it + NGW < NITEMS; P0Item nxt = cur;
            if (more) { nxt = p0_decode<SET>(F, A, it + NGW); p0_dma(nxt, tiles + (buf ^ 1) * 8192, F.lane); asm volatile("s_waitcnt vmcnt(32)" ::: "memory"); }
            else asm volatile("s_waitcnt vmcnt(0)" ::: "memory");
            p0_emit(cur, (const LAS float*)(tiles + buf * 8192), F.lane);
            LDS_WAIT(); asm volatile("" ::: "memory");
            cur = nxt; buf ^= 1;
        }
        asm volatile("s_waitcnt vmcnt(0)" ::: "memory");
    }
}
__device__ __forceinline__ void p0_prologue(Frame& F, const Args& A) {
    const int gw = F.vcu * NWAVES + F.wave, NGW = F.G * NWAVES;
    p0_transposes<0>(F, A, gw, NGW);
    const size_t gt = (size_t)F.vcu * (NWAVES * 64) + F.tid, NT = (size_t)F.G * NWAVES * 64;
    { GAS v4u* z = (GAS v4u*)(WSP(bf16, WS_WIN) + (size_t)RWKV_COLS * D);
      for (size_t i = gt; i < (size_t)224 * D * 2 / 16; i += NT) z[i] = (v4u){0u, 0u, 0u, 0u}; }
    { bf16* wl = WSP(bf16, WS_WLORA); const float* w2 = F.in[9]; const float* a2 = F.in[11]; const float* g2 = F.in[12];
      for (size_t i = gt; i < (size_t)NL * KL / 2; i += NT) { const int n = (int)(i / (KL / 2)), k = 2 * (int)(i % (KL / 2)); const int seg = n >> 10, c = n & 1023;
          float v0 = 0.f, v1 = 0.f;
          if (seg == 0) { if (k < 64) { v0 = w2[(size_t)k * RC + c]; v1 = w2[(size_t)(k + 1) * RC + c]; } }
          else if (seg == 1) { if (k >= 64 && k < 128) { v0 = a2[(size_t)(k - 64) * RC + c]; v1 = a2[(size_t)(k - 63) * RC + c]; } }
          else { if (k >= 128 && k < 288) { v0 = g2[(size_t)(k - 128) * RC + c]; v1 = g2[(size_t)(k - 127) * RC + c]; } }
          ((GAS unsigned*)wl)[i] = pk2(v0, v1); } }
    { GAS unsigned long long* s = (GAS unsigned long long*)(F.ws + WS_SS) + M;
      for (size_t i = gt; i < (size_t)2 * M; i += NT) s[i] = 0ull; }
    { const float* x = F.in[0]; bf16* xb = WSP(bf16, WS_XB); unsigned long long* ss0 = WSP(unsigned long long, WS_SS);
      for (int m = gw; m < M; m += NGW) { const GAS f32x4* xr = (const GAS f32x4*)(x + (size_t)m * D) + 2 * F.lane; GAS v4u* o = (GAS v4u*)(xb + (size_t)m * D) + F.lane; float s = 0.f;
#pragma unroll
          for (int j = 0; j < 4; ++j) { const f32x4 a = xr[128 * j], b = xr[128 * j + 1];
              s += (a[0] * a[0] + a[1] * a[1]) + (a[2] * a[2] + a[3] * a[3]) + (b[0] * b[0] + b[1] * b[1]) + (b[2] * b[2] + b[3] * b[3]);
              const f32x4 ga = *(const f32x4*)(F.in[1] + 8 * F.lane + 512 * j), gb = *(const f32x4*)(F.in[1] + 8 * F.lane + 512 * j + 4);
              o[64 * j] = pg8::pack8(a * ga, b * gb); }
          s = wave_sum(s);
          if (F.lane == 0) ss0[m] = (unsigned long long)(s * pg8::SS_SCALE + 0.5f); } }
}

__device__ __forceinline__ void p4_lora_in(Frame& F) {
    const float* lin = WSP(float, WS_R + R_LIN); bf16* al = WSP(bf16, WS_ALORA); const float* mu = F.in[7] + 3 * RC;
    const size_t gt = (size_t)F.vcu * (NWAVES * 64) + F.tid, NT = (size_t)F.G * NWAVES * 64;
#pragma unroll 4
    for (size_t i = gt; i < (size_t)M * 96; i += NT) { const int m = (int)(i / 96), q = (int)(i % 96), qc = q < 72 ? q : 0; const bool first = (m & (SEQ - 1)) == 0;
        const f32x4 p = *(const GAS f32x4*)(lin + (size_t)m * 288 + 4 * qc), pr = *(const GAS f32x4*)(lin + (size_t)(first ? m : m - 1) * 288 + 4 * qc), mv = *(const GAS f32x4*)(mu + 4 * qc);
        const f32x4 pp = first ? (f32x4){0.f, 0.f, 0.f, 0.f} : pr; f32x4 s = p + (pp - p) * mv;
#pragma unroll
        for (int j = 0; j < 4; ++j) { const float sg = fast_sigmoid(q < 16 ? 2.0f * s[j] : s[j]); s[j] = q < 16 ? 2.0f * sg - 1.0f : (q >= 32 ? sg : s[j]); }
        v2u o = pack4(s); if (q >= 72) o = (v2u){0u, 0u};
        *(GAS v2u*)(al + (size_t)m * KL + 4 * q) = o; }
    { const bf16* rkv = WSP(bf16, WS_R + R_RKV); float* invn = WSP(float, WS_INVN); const int j4 = (F.tid & 15) * 4;
      const size_t it0 = gt >> 4, step = NT >> 4; const int h = (int)(it0 & 15), ch = h * RN + j4;
      const f32x4 muk = *(const f32x4*)(F.in[7] + RC + ch), kkc = *(const f32x4*)(F.in[13] + ch);
      if ((step & 15) == 0) {
#pragma unroll 4
          for (size_t it = it0; it < (size_t)M * RH; it += step) { const int m = (int)(it >> 4); const bool first = (m & (SEQ - 1)) == 0;
              const f32x4 k = unpack4(*(const GAS v2u*)(rkv + (size_t)m * 3072 + RC + ch)), kr = unpack4(*(const GAS v2u*)(rkv + (size_t)(first ? m : m - 1) * 3072 + RC + ch));
              const f32x4 kp = first ? (f32x4){0.f, 0.f, 0.f, 0.f} : kr;
              const f32x4 kk = (k + (kp - k) * muk) * kkc; float s2 = (kk[0] * kk[0] + kk[1] * kk[1]) + (kk[2] * kk[2] + kk[3] * kk[3]); s2 = row16_sum(s2);
              if ((F.tid & 15) == 0) invn[it] = 1.0f / fmaxf(sqrtf(s2), 1e-12f); }
      } else {
          for (size_t it = it0; it < (size_t)M * RH; it += step) { const int m = (int)(it >> 4), h2 = (int)(it & 15), c2 = h2 * RN + j4; const bool first = (m & (SEQ - 1)) == 0;
              const f32x4 k = unpack4(*(const GAS v2u*)(rkv + (size_t)m * 3072 + RC + c2)), kr = unpack4(*(const GAS v2u*)(rkv + (size_t)(first ? m : m - 1) * 3072 + RC + c2));
              const f32x4 kp = first ? (f32x4){0.f, 0.f, 0.f, 0.f} : kr; const f32x4 mk2 = *(const f32x4*)(F.in[7] + RC + c2), kc2 = *(const f32x4*)(F.in[13] + c2);
              const f32x4 kk = (k + (kp - k) * mk2) * kc2; float s2 = (kk[0] * kk[0] + kk[1] * kk[1]) + (kk[2] * kk[2] + kk[3] * kk[3]); s2 = row16_sum(s2);
              if ((F.tid & 15) == 0) invn[it] = 1.0f / fmaxf(sqrtf(s2), 1e-12f); } } }
}

typedef short bf16x4 __attribute__((ext_vector_type(4)));
typedef short bf16x8 __attribute__((ext_vector_type(8)));
#define MFMA32(a, b, c) __builtin_amdgcn_mfma_f32_16x16x32_bf16(a, b, c, 0, 0, 0)
#define MFMA16(a, b, c) __builtin_amdgcn_mfma_f32_16x16x16bf16_1k(a, b, c, 0, 0, 0)
__device__ __forceinline__ bf16x4 cv4(f32x4 v) { v2u w; w.x = pk2(v[0], v[1]); w.y = pk2(v[2], v[3]); return __builtin_bit_cast(bf16x4, w); }
__device__ __forceinline__ bf16x8 cv8(f32x4 a, f32x4 b) { v4u w; w.x = pk2(a[0], a[1]); w.y = pk2(a[2], a[3]); w.z = pk2(b[0], b[1]); w.w = pk2(b[2], b[3]); return __builtin_bit_cast(bf16x8, w); }
__device__ __forceinline__ bf16x8 cat8(bf16x4 a, bf16x4 b) { return __builtin_shufflevector(a, b, 0, 1, 2, 3, 4, 5, 6, 7); }
__device__ __forceinline__ bf16x8 join8(v2u a, v2u b) { v4u w; w.x = a.x; w.y = a.y; w.z = b.x; w.w = b.y; return __builtin_bit_cast(bf16x8, w); }
__device__ __forceinline__ float row16_scan(float x) { x += dpp_mov<0x111>(x); x += dpp_mov<0x112>(x); x += dpp_mov<0x114>(x); x += dpp_mov<0x118>(x); return x; }
__device__ __forceinline__ unsigned short bf1(float x) { return (unsigned short)(pk2(x, 0.f) & 0xffffu); }
constexpr int CH = 16;
constexpr int RWS = 144;
constexpr int HGS = 272;
constexpr int RWB_KG = 0, RWB_RG = 16 * RWS, RWB_KTI = 32 * RWS, RWB_BTI = 48 * RWS, RWB_KTIT = 64 * RWS, RWB_BTIT = RWB_KTIT + 2048, RWB_VT = RWB_BTIT + 2048, RWB_GL = RWB_VT + 2048, RWB_BYTES = RWB_GL + 256;
constexpr int HGB_QG = 0, HGB_KI = 16 * HGS, HGB_KIT = 32 * HGS, HGB_VT = HGB_KIT + 4096, HGB_GL = HGB_VT + 4096, HGB_BYTES = HGB_GL + 512;

__device__ __forceinline__ f32x4 padc(f32x4 r) { asm("s_nop 15" : "+v"(r)); return r; }
constexpr int NCHK = SEQ / CH;
constexpr int NRAW = 8;
constexpr int RWR_R = 0, RWR_K = 2048, RWR_V = 4096, RWR_LW = 6144, RWR_A = 8192, RWR_INV = 10240, RWR_BYTES = 10304;
constexpr int RW_OPND = 0, RW_RAW = 3 * RWB_BYTES, RW_AOP = RW_RAW + NRAW * RWR_BYTES, RW_LDS = RW_AOP + 2 * 2048;
constexpr int HGR_Q = 0, HGR_LF = 4096, HGR_V = 8192, HGR_BYTES = 12288;
constexpr int HG_OPND = 0, HG_RAW = 3 * HGB_BYTES, HG_AOP = HG_RAW + NRAW * HGR_BYTES, HG_LDS = HG_AOP + 2 * 512;
static_assert(RW_LDS <= RING_BYTES && HG_LDS <= RING_BYTES && RW_AOP % 16 == 0 && HG_AOP % 16 == 0, "scan LDS map");
#define GLDS4(gptr, lptr) __builtin_amdgcn_global_load_lds((const GAS unsigned*)(gptr), (LAS unsigned*)(lptr), 4, 0, 0)
#define WG_BAR() do { LDS_WAIT(); __builtin_amdgcn_s_barrier(); asm volatile("" ::: "memory"); } while (0)

__device__ __forceinline__ void p6_rwkv_head(Frame& F, int bh) {
    const bf16* rkv = WSP(bf16, WS_R + R_RKV); const bf16* lout = WSP(bf16, WS_LOUT); const float* invn = WSP(float, WS_INVN); bf16* ydst = WSP(bf16, WS_LOUT);
    const int lane = F.lane, c = lane & 15, g = lane >> 4, w = F.wave;
    const int b = bh >> 4, h = bh & 15;
    const size_t rowbase = (size_t)b * SEQ;
    const int st = lane & 15, k0 = 2 * (w * 4 + (lane >> 4)), chn = h * RN + k0;
    const float mur0 = F.in[7][chn], mur1 = F.in[7][chn + 1], muk0 = F.in[7][RC + chn], muk1 = F.in[7][RC + chn + 1], muv0 = F.in[7][2 * RC + chn], muv1 = F.in[7][2 * RC + chn + 1];
    const float kk0 = F.in[13][chn], kk1 = F.in[13][chn + 1], ka0 = F.in[14][chn], ka1 = F.in[14][chn + 1];
    LAS unsigned char* const opnd = F.lds + RW_OPND; LAS unsigned char* const raw = F.lds + RW_RAW; LAS unsigned char* const aop = F.lds + RW_AOP;
#define RW3_DMA(j) do { const int r_ = 2 * w + (lane >> 5); const size_t ro_ = (rowbase + (size_t)(j) * CH + r_) * 3072 + h * RN + 2 * ((lane & 31) ^ r_); \
        LAS unsigned char* d_ = raw + ((j) % NRAW) * RWR_BYTES + w * 256; \
        GLDS4(rkv + ro_, d_ + RWR_R); GLDS4(rkv + ro_ + RC, d_ + RWR_K); GLDS4(rkv + ro_ + 2 * RC, d_ + RWR_V); GLDS4(lout + ro_, d_ + RWR_LW); GLDS4(lout + ro_ + RC, d_ + RWR_A); \
        if (lane < 2) GLDS4(invn + (rowbase + (size_t)(j) * CH + 2 * w + lane) * RH + h, raw + ((j) % NRAW) * RWR_BYTES + RWR_INV + w * 8); } while (0)
#define RW3_PROC(j) do { const LAS unsigned char* s_ = raw + ((j) % NRAW) * RWR_BYTES; const int pq_ = (k0 >> 1) ^ st, pp_ = (k0 >> 1) ^ ((st + 15) & 15); \
        const LAS unsigned char* sc_ = s_ + st * 128 + pq_ * 4; const LAS unsigned char* sp_ = ((st > 0) ? s_ + (st - 1) * 128 : raw + (((j) + NRAW - 1) % NRAW) * RWR_BYTES + 15 * 128) + pp_ * 4; \
        const bool first_ = ((j) == 0) && (st == 0); \
        const unsigned Lr = *(const LAS unsigned*)(sc_ + RWR_R), Lk = *(const LAS unsigned*)(sc_ + RWR_K), Lv = *(const LAS unsigned*)(sc_ + RWR_V); \
        const unsigned Lw = *(const LAS unsigned*)(sc_ + RWR_LW), La = *(const LAS unsigned*)(sc_ + RWR_A); \
        const unsigned Lrp = *(const LAS unsigned*)(sp_ + RWR_R), Lkp = *(const LAS unsigned*)(sp_ + RWR_K), Lvp = *(const LAS unsigned*)(sp_ + RWR_V); \
        const float Linv = *(const LAS float*)(s_ + RWR_INV + st * 4); \
        const float r0_ = bflo(Lr), r1_ = bfhi(Lr), q0_ = bflo(Lk), q1_ = bfhi(Lk), v0_ = bflo(Lv), v1_ = bfhi(Lv); \
        const float rp0_ = first_ ? 0.f : bflo(Lrp), rp1_ = first_ ? 0.f : bfhi(Lrp), qp0_ = first_ ? 0.f : bflo(Lkp), qp1_ = first_ ? 0.f : bfhi(Lkp), vp0_ = first_ ? 0.f : bflo(Lvp), vp1_ = first_ ? 0.f : bfhi(Lvp); \
        const float rs0_ = r0_ + (rp0_ - r0_) * mur0, rs1_ = r1_ + (rp1_ - r1_) * mur1, ks0_ = q0_ + (qp0_ - q0_) * muk0, ks1_ = q1_ + (qp1_ - q1_) * muk1, vs0_ = v0_ + (vp0_ - v0_) * muv0, vs1_ = v1_ + (vp1_ - v1_) * muv1; \
        const float a0_ = bflo(La), a1_ = bfhi(La), lw0_ = bflo(Lw) * 1.44269504f, lw1_ = bfhi(Lw) * 1.44269504f; \
        const float kap0_ = ks0_ * kk0 * Linv, kap1_ = ks1_ * kk1 * Linv, bet0_ = kap0_ * a0_, bet1_ = kap1_ * a1_; \
        const float kt0_ = ks0_ * (1.0f + (a0_ - 1.0f) * ka0), kt1_ = ks1_ * (1.0f + (a1_ - 1.0f) * ka1); \
        const float G0_ = row16_scan(lw0_), G1_ = row16_scan(lw1_); \
        const float eg0_ = __builtin_amdgcn_exp2f(G0_), eg1_ = __builtin_amdgcn_exp2f(G1_), ep0_ = __builtin_amdgcn_exp2f(G0_ - lw0_), ep1_ = __builtin_amdgcn_exp2f(G1_ - lw1_), ei0_ = __builtin_amdgcn_exp2f(-G0_), ei1_ = __builtin_amdgcn_exp2f(-G1_); \
        LAS unsigned char* d_ = opnd + ((j) % 3) * RWB_BYTES; \
        *(LAS unsigned*)(d_ + RWB_KG + st * RWS + k0 * 2) = pk2(kap0_ * ep0_, kap1_ * ep1_); *(LAS unsigned*)(d_ + RWB_RG + st * RWS + k0 * 2) = pk2(rs0_ * eg0_, rs1_ * eg1_); \
        const unsigned kti_ = pk2(kt0_ * ei0_, kt1_ * ei1_), bti_ = pk2(bet0_ * ei0_, bet1_ * ei1_), vv_ = pk2(vs0_, vs1_); \
        *(LAS unsigned*)(d_ + RWB_KTI + st * RWS + k0 * 2) = kti_; *(LAS unsigned*)(d_ + RWB_BTI + st * RWS + k0 * 2) = bti_; \
        *(LAS unsigned short*)(d_ + RWB_KTIT + k0 * 32 + st * 2) = (unsigned short)(kti_ & 0xffffu); *(LAS unsigned short*)(d_ + RWB_KTIT + (k0 + 1) * 32 + st * 2) = (unsigned short)(kti_ >> 16); \
        *(LAS unsigned short*)(d_ + RWB_BTIT + k0 * 32 + st * 2) = (unsigned short)(bti_ & 0xffffu); *(LAS unsigned short*)(d_ + RWB_BTIT + (k0 + 1) * 32 + st * 2) = (unsigned short)(bti_ >> 16); \
        *(LAS unsigned short*)(d_ + RWB_VT + k0 * 32 + st * 2) = (unsigned short)(vv_ & 0xffffu); *(LAS unsigned short*)(d_ + RWB_VT + (k0 + 1) * 32 + st * 2) = (unsigned short)(vv_ >> 16); \
        if (st == 15) { *(LAS float*)(d_ + RWB_GL + k0 * 4) = eg0_; *(LAS float*)(d_ + RWB_GL + k0 * 4 + 4) = eg1_; } } while (0)
    const f32x4 zero4 = (f32x4){0.f, 0.f, 0.f, 0.f};
    auto a_stage = [&](int j) {
        const LAS unsigned char* rowp = opnd + (j % 3) * RWB_BYTES + c * RWS;
        const int offA = (w == 4 || w == 7) ? RWB_BTI : RWB_KTI;
        const int offB = (w == 4 || w == 5) ? RWB_KG : RWB_RG;
        const bf16x8 a0 = *(const LAS bf16x8*)(rowp + offA + 16 * g), a1 = *(const LAS bf16x8*)(rowp + offA + 64 + 16 * g);
        const bf16x8 b0 = *(const LAS bf16x8*)(rowp + offB + 16 * g), b1 = *(const LAS bf16x8*)(rowp + offB + 64 + 16 * g);
        f32x4 N = MFMA32(a0, b0, zero4); N = MFMA32(a1, b1, N);
        const bool strict = (w == 4 || w == 5);
#pragma unroll
        for (int r = 0; r < 4; ++r) { const int rj = 4 * g + r; N[r] = (strict ? (c > rj) : (c >= rj)) ? N[r] : 0.f; }
        f32x4 res = N;
        if (w == 4) {
            f32x4 N1t = MFMA32(b0, a0, zero4); N1t = MFMA32(b1, a1, N1t);
            f32x4 X;
#pragma unroll
            for (int r = 0; r < 4; ++r) { const int rj = 4 * g + r; N1t[r] = (rj > c) ? N1t[r] : 0.f; X[r] = ((rj == c) ? 1.0f : 0.f) - N[r]; }
            bf16x4 an = cv4(N), at = cv4(N1t);
            f32x4 P = MFMA16(at, an, zero4), Pt = MFMA16(an, at, zero4);
            X = MFMA16(cv4(Pt), cv4(X), padc(X));
            an = cv4(P); at = cv4(Pt);
            P = MFMA16(at, an, zero4); Pt = MFMA16(an, at, zero4);
            X = MFMA16(cv4(Pt), cv4(X), padc(X));
            an = cv4(P); at = cv4(Pt);
            Pt = MFMA16(an, at, zero4);
            X = MFMA16(cv4(Pt), cv4(X), padc(X));
            res = X;
        }
        *(LAS bf16x4*)(aop + (j & 1) * 2048 + (w - 4) * 512 + lane * 8) = cv4(res);
    };
    f32x4 Z[4];
#pragma unroll
    for (int i = 0; i < 4; ++i) Z[i] = (f32x4){0.f, 0.f, 0.f, 0.f};
    { RW3_DMA(0); RW3_DMA(1); RW3_DMA(2); RW3_DMA(3); RW3_DMA(4); RW3_DMA(5); RW3_DMA(6); RW3_DMA(7); asm volatile("s_waitcnt vmcnt(0)" ::: "memory"); WG_BAR(); RW3_PROC(0); RW3_PROC(1); WG_BAR(); if (w >= 4) a_stage(0); WG_BAR(); }
    if (w < 4) {
        for (int ci = 0; ci < NCHK; ++ci) {
            const int t0 = ci * CH; const int jp = (ci + 2 < NCHK) ? ci + 2 : NCHK - 1;
            RW3_PROC(jp);
            const LAS unsigned char* cur = opnd + (ci % 3) * RWB_BYTES; const LAS unsigned char* rowp = cur + c * RWS; const LAS unsigned char* ap = aop + (ci & 1) * 2048 + lane * 8;
            bf16x8 pKg[2], pRg[2];
#pragma unroll
            for (int s = 0; s < 2; ++s) {
                pKg[s] = join8(*(const LAS v2u*)(rowp + RWB_KG + 64 * s + 8 * g), *(const LAS v2u*)(rowp + RWB_KG + 64 * s + 32 + 8 * g));
                pRg[s] = join8(*(const LAS v2u*)(rowp + RWB_RG + 64 * s + 8 * g), *(const LAS v2u*)(rowp + RWB_RG + 64 * s + 32 + 8 * g)); }
            const bf16x4 bV = *(const LAS bf16x4*)(cur + RWB_VT + (16 * w + c) * 32 + 8 * g);
            const bf16x4 xT = *(const LAS bf16x4*)(ap), n2 = *(const LAS bf16x4*)(ap + 512), n3 = *(const LAS bf16x4*)(ap + 1024), n4 = *(const LAS bf16x4*)(ap + 1536);
            const bf16x8 bZ0 = cv8(Z[0], Z[1]), bZ1 = cv8(Z[2], Z[3]);
            const bf16x4 z4 = (bf16x4){0, 0, 0, 0};
            f32x4 W = MFMA32(pKg[0], bZ0, zero4); W = MFMA32(pKg[1], bZ1, W); W = MFMA32(cat8(n2, z4), cat8(bV, z4), W);
            const f32x4 U = MFMA16(xT, cv4(W), zero4);
            const bf16x4 nU = cv4(-U);
            const bf16x8 bVU = cat8(bV, nU);
            f32x4 Y = MFMA32(pRg[0], bZ0, zero4); Y = MFMA32(pRg[1], bZ1, Y); Y = MFMA32(cat8(n3, n4), bVU, Y);
#pragma unroll
            for (int r = 0; r < 4; ++r) ydst[(rowbase + t0 + 4 * g + r) * 3072 + h * RN + 16 * w + c] = bf1(Y[r]);
#pragma unroll
            for (int zt = 0; zt < 4; ++zt) {
                const bf16x4 aK = *(const LAS bf16x4*)(cur + RWB_KTIT + (16 * zt + c) * 32 + 8 * g), aB = *(const LAS bf16x4*)(cur + RWB_BTIT + (16 * zt + c) * 32 + 8 * g);
                const f32x4 gl = *(const LAS f32x4*)(cur + RWB_GL + (16 * zt + 4 * g) * 4);
                Z[zt] = MFMA32(cat8(aK, aB), bVU, Z[zt]) * gl; }
            { const int jn = (ci + NRAW < NCHK) ? ci + NRAW : NCHK - 1; RW3_DMA(jn); }
            asm volatile("s_waitcnt vmcnt(50)" ::: "memory");
            WG_BAR();
        }
    } else {
        for (int ci = 0; ci < NCHK; ++ci) {
            const int jp = (ci + 2 < NCHK) ? ci + 2 : NCHK - 1, ja = (ci + 1 < NCHK) ? ci + 1 : NCHK - 1;
            RW3_PROC(jp);
            a_stage(ja);
            { const int jn = (ci + NRAW < NCHK) ? ci + NRAW : NCHK - 1; RW3_DMA(jn); }
            asm volatile("s_waitcnt vmcnt(30)" ::: "memory");
            WG_BAR();
        }
    }
#undef RW3_DMA
#undef RW3_PROC
}

__device__ __forceinline__ void p6_hgrn_head(Frame& F, int hb) {
    const bf16* hg = WSP(bf16, WS_R + R_HG); bf16* odst = WSP(bf16, WS_R + R_HG);
    const int lane = F.lane, c = lane & 15, g = lane >> 4, w = F.wave;
    const int bh = hb >> 1, half = hb & 1, b = bh >> 3, h = bh & 7, vb = half * 4 + (w & 3);
    const size_t rowbase = (size_t)b * SEQ;
    const int st = lane & 15, k0 = 4 * (w * 4 + (lane >> 4));
    LAS unsigned char* const opnd = F.lds + HG_OPND; LAS unsigned char* const raw = F.lds + HG_RAW; LAS unsigned char* const aop = F.lds + HG_AOP;
#define HG3_DMA(j) do { _Pragma("unroll") for (int rr_ = 0; rr_ < 2; ++rr_) { const int r_ = 2 * w + rr_; const bf16* p_ = hg + (rowbase + (size_t)(j) * CH + r_) * 4096 + h * HD + 2 * (2 * ((lane >> 1) ^ r_) + (lane & 1)); \
        LAS unsigned char* d_ = raw + ((j) % NRAW) * HGR_BYTES + r_ * 256; GLDS4(p_, d_ + HGR_Q); GLDS4(p_ + HC, d_ + HGR_LF); GLDS4(p_ + 2 * HC, d_ + HGR_V); } } while (0)
#define HG3_PROC(j) do { const LAS unsigned char* s_ = raw + ((j) % NRAW) * HGR_BYTES + st * 256 + (((k0 >> 2) ^ st) * 8); LAS unsigned char* d_ = opnd + ((j) % 3) * HGB_BYTES; \
        const v2u Lq = *(const LAS v2u*)(s_ + HGR_Q), Lf = *(const LAS v2u*)(s_ + HGR_LF), Lv = *(const LAS v2u*)(s_ + HGR_V); \
        const f32x4 q_ = unpack4(Lq); f32x4 lf_ = unpack4(Lf) * 1.44269504f; f32x4 qg_, ki_, eg_; \
        _Pragma("unroll") for (int e = 0; e < 4; ++e) { const float G_ = row16_scan(lf_[e]); eg_[e] = __builtin_amdgcn_exp2f(G_); qg_[e] = q_[e] * eg_[e]; ki_[e] = (1.0f - __builtin_amdgcn_exp2f(lf_[e])) * __builtin_amdgcn_exp2f(-G_); } \
        const v2u kw_ = pack4(ki_); *(LAS v2u*)(d_ + HGB_QG + st * HGS + k0 * 2) = pack4(qg_); *(LAS v2u*)(d_ + HGB_KI + st * HGS + k0 * 2) = kw_; \
        *(LAS unsigned short*)(d_ + HGB_KIT + (k0 + 0) * 32 + st * 2) = (unsigned short)(kw_.x & 0xffffu); *(LAS unsigned short*)(d_ + HGB_KIT + (k0 + 1) * 32 + st * 2) = (unsigned short)(kw_.x >> 16); \
        *(LAS unsigned short*)(d_ + HGB_KIT + (k0 + 2) * 32 + st * 2) = (unsigned short)(kw_.y & 0xffffu); *(LAS unsigned short*)(d_ + HGB_KIT + (k0 + 3) * 32 + st * 2) = (unsigned short)(kw_.y >> 16); \
        *(LAS unsigned short*)(d_ + HGB_VT + (k0 + 0) * 32 + st * 2) = (unsigned short)(Lv.x & 0xffffu); *(LAS unsigned short*)(d_ + HGB_VT + (k0 + 1) * 32 + st * 2) = (unsigned short)(Lv.x >> 16); \
        *(LAS unsigned short*)(d_ + HGB_VT + (k0 + 2) * 32 + st * 2) = (unsigned short)(Lv.y & 0xffffu); *(LAS unsigned short*)(d_ + HGB_VT + (k0 + 3) * 32 + st * 2) = (unsigned short)(Lv.y >> 16); \
        if (st == 15) *(LAS f32x4*)(d_ + HGB_GL + k0 * 4) = eg_; } while (0)
    const f32x4 zero4 = (f32x4){0.f, 0.f, 0.f, 0.f};
    auto a_stage = [&](int j) {
        const LAS unsigned char* rowp = opnd + (j % 3) * HGB_BYTES + c * HGS;
        f32x4 N = zero4;
#pragma unroll
        for (int s = 0; s < 4; ++s) { const bf16x8 nQ = *(const LAS bf16x8*)(rowp + HGB_QG + 64 * s + 16 * g), nK = *(const LAS bf16x8*)(rowp + HGB_KI + 64 * s + 16 * g); N = MFMA32(nK, nQ, N); }
#pragma unroll
        for (int r = 0; r < 4; ++r) N[r] = (c >= 4 * g + r) ? N[r] : 0.f;
        *(LAS bf16x4*)(aop + (j & 1) * 512 + lane * 8) = cv4(N);
    };
    f32x4 Z[8];
#pragma unroll
    for (int i = 0; i < 8; ++i) Z[i] = (f32x4){0.f, 0.f, 0.f, 0.f};
    { HG3_DMA(0); HG3_DMA(1); HG3_DMA(2); HG3_DMA(3); HG3_DMA(4); HG3_DMA(5); HG3_DMA(6); HG3_DMA(7); asm volatile("s_waitcnt vmcnt(0)" ::: "memory"); WG_BAR(); HG3_PROC(0); HG3_PROC(1); WG_BAR(); if (w == 4) a_stage(0); WG_BAR(); }
    if (w < 4) {
        for (int ci = 0; ci < NCHK; ++ci) {
            const int t0 = ci * CH; const int jp = (ci + 2 < NCHK) ? ci + 2 : NCHK - 1;
            HG3_PROC(jp);
            const LAS unsigned char* cur = opnd + (ci % 3) * HGB_BYTES; const LAS unsigned char* rowp = cur + c * HGS;
            f32x4 Y = zero4;
#pragma unroll
            for (int s = 0; s < 4; ++s) {
                const bf16x8 pQ = join8(*(const LAS v2u*)(rowp + HGB_QG + 64 * s + 8 * g), *(const LAS v2u*)(rowp + HGB_QG + 64 * s + 32 + 8 * g));
                Y = MFMA32(pQ, cv8(Z[2 * s], Z[2 * s + 1]), Y); }
            const bf16x4 bV = *(const LAS bf16x4*)(cur + HGB_VT + (16 * vb + c) * 32 + 8 * g);
            const bf16x4 n = *(const LAS bf16x4*)(aop + (ci & 1) * 512 + lane * 8);
            const bf16x4 z4 = (bf16x4){0, 0, 0, 0};
            Y = MFMA32(cat8(n, z4), cat8(bV, z4), Y);
#pragma unroll
            for (int r = 0; r < 4; ++r) odst[(rowbase + t0 + 4 * g + r) * 4096 + 2 * HC + h * HD + 16 * vb + c] = bf1(Y[r]);
#pragma unroll
            for (int zt = 0; zt < 8; ++zt) {
                const bf16x4 aK = *(const LAS bf16x4*)(cur + HGB_KIT + (16 * zt + c) * 32 + 8 * g);
                const f32x4 gl = *(const LAS f32x4*)(cur + HGB_GL + (16 * zt + 4 * g) * 4);
                Z[zt] = MFMA16(aK, bV, Z[zt]) * gl; }
            { const int jn = (ci + NRAW < NCHK) ? ci + NRAW : NCHK - 1; HG3_DMA(jn); }
            asm volatile("s_waitcnt vmcnt(50)" ::: "memory");
            WG_BAR();
        }
    } else {
        for (int ci = 0; ci < NCHK; ++ci) {
            const int jp = (ci + 2 < NCHK) ? ci + 2 : NCHK - 1, ja = (ci + 1 < NCHK) ? ci + 1 : NCHK - 1;
            HG3_PROC(jp);
            if (w == 4) a_stage(ja);
            { const int jn = (ci + NRAW < NCHK) ? ci + NRAW : NCHK - 1; HG3_DMA(jn); }
            asm volatile("s_waitcnt vmcnt(30)" ::: "memory");
            WG_BAR();
        }
    }
#undef HG3_DMA
#undef HG3_PROC
}
#undef WG_BAR
constexpr int NSCAN = BATCH * RH + 2 * BATCH * HH;
__device__ __forceinline__ void p6_shadow(Frame& F, const Args& A, int c, int G) {
    const unsigned long long* ss = WSP(unsigned long long, WS_SS);
    {   pg8::Gemm g{WSP(bf16, WS_XB), WSP(bf16, WS_WIN) + (size_t)26 * 256 * D, M, 4 * 256, D}; pg8::StaticOrder S; S.init(M, 4 * 256, G, c);
        pg8::EpiInProj E{WSP(bf16, WS_R + R_RKV), WSP(float, WS_R + R_LIN), WSP(bf16, WS_R + R_HG), pg8::inv_preload((PG8_LAS float*)(F.lds + pg8::STAGE_BYTES), S, ss + M), (PG8_LAS float*)(F.lds + pg8::STAGE_BYTES + 4096), 26};
        pg8::gemm_phase<pg8::EpiInProj, pg8::StaticOrder, true, true>(F.lds, g, S, E); }
    {   int kl = KL; asm volatile("" : "+s"(kl));
        pg8::Gemm g{WSP(bf16, WS_ALORA), WSP(bf16, WS_WLORA) + (size_t)8 * 256 * KL, M, 4 * 256, kl}; pg8::StaticOrder S; S.init(M, 4 * 256, G, c);
        pg8::EpiLora E{WSP(bf16, WS_LOUT), (PG8_LAS float*)(F.lds + pg8::STAGE_BYTES), 8};
        pg8::gemm_phase<pg8::EpiLora, pg8::StaticOrder, true, true>(F.lds, g, S, E); }
    p0_transposes<1>(F, A, c * NWAVES + F.wave, G * NWAVES);
}
__device__ __forceinline__ void p6_scans(Frame& F, const Args& A) {
    const int bx = (int)blockIdx.x;
    if (F.G > NSCAN) { if (bx < NSCAN) { if (bx < BATCH * RH) p6_rwkv_head(F, bx); else p6_hgrn_head(F, bx - BATCH * RH); } else p6_shadow(F, A, bx - NSCAN, F.G - NSCAN); }
    else {
        for (int u = bx; u < NSCAN; u += F.G) { if (u < BATCH * RH) p6_rwkv_head(F, u); else p6_hgrn_head(F, u - BATCH * RH); }
        __syncthreads(); p6_shadow(F, A, bx, F.G);
    }
}

__device__ __forceinline__ void p7_post(Frame& F) {
    const bf16* rkv = WSP(bf16, WS_R + R_RKV); const bf16* hg = WSP(bf16, WS_R + R_HG); const bf16* lout = WSP(bf16, WS_LOUT); bf16* yc = WSP(bf16, WS_XB);
    { const int half = F.tid >> 8, ch = (F.tid & 255) * 4;
      const f32x4 mu_r = *(const f32x4*)(F.in[7] + ch), mu_k = *(const f32x4*)(F.in[7] + RC + ch), mu_v = *(const f32x4*)(F.in[7] + 2 * RC + ch);
      const f32x4 kac = *(const f32x4*)(F.in[14] + ch), rkc = *(const f32x4*)(F.in[15] + ch), lnw = *(const f32x4*)(F.in[16] + ch), lnb = *(const f32x4*)(F.in[17] + ch);
#pragma unroll 2
      for (int m = F.vcu * 2 + half; m < M; m += 2 * F.G) {
          const bool first = (m & (SEQ - 1)) == 0; const size_t mp = first ? m : m - 1;
          const bf16* p = rkv + (size_t)m * 3072 + ch; const bf16* q = rkv + mp * 3072 + ch; const bf16* l = lout + (size_t)m * 3072 + ch;
          const f32x4 y = unpack4(*(const GAS v2u*)(l));
          const f32x4 r = unpack4(*(const GAS v2u*)(p)), k = unpack4(*(const GAS v2u*)(p + RC)), v = unpack4(*(const GAS v2u*)(p + 2 * RC));
          f32x4 rp = unpack4(*(const GAS v2u*)(q)), kp = unpack4(*(const GAS v2u*)(q + RC)), vp = unpack4(*(const GAS v2u*)(q + 2 * RC));
          if (first) { rp = (f32x4){0.f, 0.f, 0.f, 0.f}; kp = rp; vp = rp; }
          const f32x4 a = unpack4(*(const GAS v2u*)(l + RC)), gg = unpack4(*(const GAS v2u*)(l + 2 * RC));
          const f32x4 rs = r + (rp - r) * mu_r, ks = k + (kp - k) * mu_k, vs = v + (vp - v) * mu_v;
          const f32x4 km = ks * (1.0f + (a - 1.0f) * kac);
          const f32x4 bt = rs * km * rkc; float bon = (bt[0] + bt[1]) + (bt[2] + bt[3]); bon = row16_sum(bon);
          float s1 = (y[0] + y[1]) + (y[2] + y[3]); s1 = row16_sum(s1); const float mean = s1 * (1.0f / 64.0f);
          const f32x4 d = y - mean; float s2 = (d[0] * d[0] + d[1] * d[1]) + (d[2] * d[2] + d[3] * d[3]); s2 = row16_sum(s2);
          const float rstd = 1.0f / sqrtf(s2 * (1.0f / 64.0f) + 64e-5f);
          const f32x4 o = ((d * rstd) * lnw + lnb + vs * bon) * gg;
          *(GAS v2u*)(yc + (size_t)m * 2048 + ch) = pack4(o); } }
    { const int quarter = F.tid >> 7, ch = (F.tid & 127) * 8;
      const f32x4 nw0 = *(const f32x4*)(F.in[19] + ch), nw1 = *(const f32x4*)(F.in[19] + ch + 4);
#pragma unroll 4
      for (int m = F.vcu * 4 + quarter; m < M; m += 4 * F.G) {
          const v4u ow = *(const GAS v4u*)(hg + (size_t)m * 4096 + 2 * HC + ch), gw4 = *(const GAS v4u*)(hg + (size_t)m * 4096 + 3 * HC + ch);
          const f32x4 o0 = (f32x4){bflo(ow.x), bfhi(ow.x), bflo(ow.y), bfhi(ow.y)}, o1 = (f32x4){bflo(ow.z), bfhi(ow.z), bflo(ow.w), bfhi(ow.w)};
          const f32x4 g0 = (f32x4){bflo(gw4.x), bfhi(gw4.x), bflo(gw4.y), bfhi(gw4.y)}, g1 = (f32x4){bflo(gw4.z), bfhi(gw4.z), bflo(gw4.w), bfhi(gw4.w)};
          float s2 = ((o0[0] * o0[0] + o0[1] * o0[1]) + (o0[2] * o0[2] + o0[3] * o0[3])) + ((o1[0] * o1[0] + o1[1] * o1[1]) + (o1[2] * o1[2] + o1[3] * o1[3])); s2 = row16_sum(s2);
          const float rstd = 1.0f / sqrtf(s2 * (1.0f / 128.0f) + 1e-6f);
          *(GAS v4u*)(yc + (size_t)m * 2048 + RC + ch) = pg8::pack8(o0 * rstd * nw0 * g0, o1 * rstd * nw1 * g1); } }
}

__device__ __forceinline__ void p11_final(Frame& F) {
    const int gw = F.vcu * NWAVES + F.wave, NGW = F.G * NWAVES; const float* fg = F.in[25];
    f32x4 gn[8];
#pragma unroll
    for (int i = 0; i < 8; ++i) gn[i] = *(const f32x4*)(fg + 4 * F.lane + 256 * i);
    for (int m = gw; m < M; m += NGW) { GAS f32x4* xr = (GAS f32x4*)(F.out + (size_t)m * D) + F.lane; f32x4 v[8]; float s = 0.f;
#pragma unroll
        for (int i = 0; i < 8; ++i) { v[i] = xr[64 * i]; s += (v[i][0] * v[i][0] + v[i][1] * v[i][1]) + (v[i][2] * v[i][2] + v[i][3] * v[i][3]); }
        s = wave_sum(s); const float inv = 1.0f / sqrtf(s * (1.0f / D) + 1e-6f);
#pragma unroll
        for (int i = 0; i < 8; ++i) xr[64 * i] = v[i] * inv * gn[i]; }
}

__global__ void __launch_bounds__(NWAVES * 64, 2) mk_fwd(Args args) {
    extern __shared__ __attribute__((aligned(16))) unsigned char lds[];
    Frame F;
    F.lds = (LAS unsigned char*)lds;
    F.tid = threadIdx.x; F.lane = F.tid & 63; F.wave = __builtin_amdgcn_readfirstlane(F.tid >> 6);
    F.G = gridDim.x; { const int bx = blockIdx.x; F.vcu = (F.G % 8 == 0) ? (bx % 8) * (F.G / 8) + bx / 8 : bx; }
#pragma unroll
    for (int i = 0; i < 26; ++i) F.in[i] = args.in[i];
    F.out = args.out; F.ws = args.ws;
    for (int u = F.tid; u < (LDS_BYTES - LDSCTL_OFF) / 4; u += NWAVES * 64) ((LAS unsigned*)(F.lds + LDSCTL_OFF))[u] = 0u;
    __syncthreads();
    const int lo = args.ph_lo, hi = args.ph_hi;
    XcdBarrier bar; bar.bar = (unsigned*)(args.ws + WS_CTL) + CW_BAR; bar.x = 0; bar.st = nullptr;
    if (hi - lo > 1) bar = xcd_barrier_post((unsigned*)(args.ws + WS_CTL) + CW_BAR, (volatile LAS unsigned*)(F.lds + MISC_OFF) + 8);
#ifndef PH_MASK
#define PH_MASK 0xFFF
#endif
#define IN(k) (((PH_MASK >> (k)) & 1) && lo <= (k) && (k) < hi)
#define SEAM(k) do { if (IN(k) && IN((k) + 1)) xcd_barrier(bar); } while (0)
    const bf16* xb = WSP(bf16, WS_XB); unsigned long long* ss = WSP(unsigned long long, WS_SS);
    const int cid = (int)blockIdx.x;

    if (IN(0)) { p0_prologue(F, args); } SEAM(0);
    if (IN(1)) {
        pg8::Gemm g{xb, WSP(bf16, WS_W1GU), M, 2 * FF, D}; pg8::StaticOrder S; S.init(M, 2 * FF, F.G, cid);
        pg8::EpiSwiglu E{WSP(bf16, WS_R + R_ACT), FF, pg8::inv_preload((PG8_LAS float*)(F.lds + pg8::STAGE_BYTES), S, ss)};
        pg8::gemm_phase<pg8::EpiSwiglu, pg8::StaticOrder, true, true>(F.lds, g, S, E);
    } SEAM(1);
    if (IN(2)) {
        pg8::Gemm g{WSP(bf16, WS_R + R_ACT), WSP(bf16, WS_W1D), M, D, FF}; pg8::StaticOrder S; S.init(M, D, F.G, cid, 4);
        pg8::EpiResid E{F.in[0], F.out, WSP(bf16, WS_XB), ss + M, 0.5f, F.in[5]};
        pg8::gemm_phase<pg8::EpiResid, pg8::StaticOrder, true, true>(F.lds, g, S, E);
    } SEAM(2);
    if (IN(3)) {
        pg8::Gemm g{xb, WSP(bf16, WS_WIN), M, 26 * 256, D}; pg8::StaticOrder S; S.init(M, 26 * 256, F.G, cid);
        PG8_LAS float* omt = (PG8_LAS float*)(F.lds + pg8::STAGE_BYTES + 4096);
        for (int cix = F.tid; cix < HC; cix += NWAVES * 64) omt[cix] = 1.0f - fast_sigmoid(F.in[18][cix] - F.in[18][HC + cix]);
        pg8::EpiInProj E{WSP(bf16, WS_R + R_RKV), WSP(float, WS_R + R_LIN), WSP(bf16, WS_R + R_HG), pg8::inv_preload((PG8_LAS float*)(F.lds + pg8::STAGE_BYTES), S, ss + M), omt, 0};
        pg8::gemm_phase<pg8::EpiInProj, pg8::StaticOrder, true, true>(F.lds, g, S, E);
    } SEAM(3);
    if (IN(4)) { p4_lora_in(F); } SEAM(4);
    if (IN(5)) {
        int kl = KL; asm volatile("" : "+s"(kl));
        pg8::Gemm g{WSP(bf16, WS_ALORA), WSP(bf16, WS_WLORA), M, 8 * 256, kl}; pg8::StaticOrder S; S.init(M, 8 * 256, F.G, cid);
        PG8_LAS float* bt = (PG8_LAS float*)(F.lds + pg8::STAGE_BYTES);
        for (int cix = F.tid; cix < 2 * RC; cix += NWAVES * 64) bt[cix] = cix < RC ? F.in[8][cix] : F.in[10][cix - RC];
        __syncthreads();
        pg8::EpiLora E{WSP(bf16, WS_LOUT), bt, 0};
        pg8::gemm_phase<pg8::EpiLora, pg8::StaticOrder, true, true>(F.lds, g, S, E);
    } SEAM(5);
    if (IN(6)) { p6_scans(F, args); } SEAM(6);
    if (IN(7)) { p7_post(F); } SEAM(7);
    if (IN(8)) {
        pg8::Gemm g{xb, WSP(bf16, WS_WOUT), M, D, D}; pg8::StaticOrder S; S.init(M, D, F.G, cid, 4);
        pg8::EpiResid E{F.out, F.out, WSP(bf16, WS_R + R_X2B), ss + 2 * M, 1.0f, F.in[21]};
        pg8::gemm_phase<pg8::EpiResid, pg8::StaticOrder, true, true>(F.lds, g, S, E);
    } SEAM(8);
    if (IN(9)) {
        pg8::Gemm g{WSP(bf16, WS_R + R_X2B), WSP(bf16, WS_W2GU), M, 2 * FF, D}; pg8::StaticOrder S; S.init(M, 2 * FF, F.G, cid);
        pg8::EpiSwiglu E{WSP(bf16, WS_R + R_ACT), FF, pg8::inv_preload((PG8_LAS float*)(F.lds + pg8::STAGE_BYTES), S, ss + 2 * M)};
        pg8::gemm_phase<pg8::EpiSwiglu, pg8::StaticOrder, true, true>(F.lds, g, S, E);
    } SEAM(9);
    if (IN(10)) {
        pg8::Gemm g{WSP(bf16, WS_R + R_ACT), WSP(bf16, WS_W2D), M, D, FF}; pg8::StaticOrder S; S.init(M, D, F.G, cid, 4);
        pg8::EpiResid E{F.out, F.out, nullptr, nullptr, 0.5f, nullptr};
        pg8::gemm_phase<pg8::EpiResid, pg8::StaticOrder, true, true>(F.lds, g, S, E);
    } SEAM(10);
    if (IN(11)) { p11_final(F); }
#undef IN
#undef SEAM
}

extern "C" void kernel_launch(void* const* d_in, const int* in_sizes, int n_in, void* d_out, int out_size, void* d_ws, size_t ws_size, hipStream_t stream) {
    static int grid = 0;
    if (grid == 0) {
        if (n_in != 26 || in_sizes[0] != M * D || out_size != M * D || ws_size < WS_END) { fprintf(stderr, "kernel_launch: unexpected problem (n_in %d, ws %zu < %zu)\n", n_in, ws_size, (size_t)WS_END); grid = -1; return; }
        int dev = 0, cus = 0, per_cu = 0;
        if (hipGetDevice(&dev) != hipSuccess || hipDeviceGetAttribute(&cus, hipDeviceAttributeMultiprocessorCount, dev) != hipSuccess) { grid = -1; return; }
        if (hipFuncSetAttribute((const void*)mk_fwd, hipFuncAttributeMaxDynamicSharedMemorySize, LDS_BYTES) != hipSuccess) { grid = -1; return; }
        if (hipOccupancyMaxActiveBlocksPerMultiprocessor(&per_cu, (const void*)mk_fwd, NWAVES * 64, LDS_BYTES) != hipSuccess || per_cu < 1) fprintf(stderr, "kernel_launch: occupancy query reports %d\n", per_cu);
        (void)hipGetLastError();
        grid = cus;
    }
    if (grid < 0) return;
    (void)hipMemsetAsync((char*)d_ws + WS_CTL, 0, CTL_BYTES, stream);
    Args a{};
    for (int i = 0; i < 26; ++i) a.in[i] = (const float*)d_in[i];
    a.out = (float*)d_out; a.ws = (unsigned char*)d_ws;
    constexpr int NL_ = MK_N_LAUNCHES;
    for (int li = 0; li < NL_; ++li) {
        a.ph_lo = (NL_ == 1) ? 0 : li; a.ph_hi = (NL_ == 1) ? N_PHASES : li + 1;
        hipLaunchKernelGGL(mk_fwd, dim3(grid), dim3(NWAVES * 64), LDS_BYTES, stream, a);
    }
}
```

```cpp
#include <hip/hip_runtime.h>
#include <cstdio>
#include <cstdint>
namespace pg8 {
#define PG8_LAS __attribute__((address_space(3)))
typedef unsigned short bf16_t;
typedef short bf16x8 __attribute__((ext_vector_type(8)));
typedef float f32x4 __attribute__((ext_vector_type(4)));
typedef unsigned u32x4 __attribute__((ext_vector_type(4)));
constexpr int BM = 256, BK = 64, HALF = 128, HTB = HALF * BK * 2  , STAGE_BYTES = 8 * HTB, NXCD = 8, WGM = 8;

__host__ __device__ __forceinline__ int lds_byte(int r, int c) { const int st = (r >> 4) * 2 + (c >> 5), rr = r & 15, cc = c & 31, ob = rr * 64 + cc * 2; return st * 1024 + (ob ^ (((ob >> 9) & 1) << 5)); }
__host__ __device__ __forceinline__ void stage_rc(int b, int& R, int& C) { const int st = b / 1024, sb = b % 1024, swz = sb ^ (((sb >> 9) & 1) << 5); R = (st >> 1) * 16 + swz / 64; C = (st & 1) * 32 + (swz % 64) / 2; }
__host__ __device__ __forceinline__ int perm32(int rho) { const int n = rho >> 4, i = rho & 15; return 8 * (i >> 2) + 4 * n + (i & 3); }

struct Unit { int pm, pn; };
struct Gemm { const bf16_t* A; const bf16_t* Bt; int M, N, K; };

struct StaticOrder {
    int nM, nN, nwg, G, c, wgm;
    __host__ __device__ void init(int M, int N, int G_, int c_, int wgm_ = WGM) { nM = M / BM; nN = N / BM; nwg = nM * nN; G = G_; c = c_; wgm = wgm_; }
    __host__ __device__ bool next(int i, Unit& u) const {
        const long L = (long)i * G + c; if (L >= nwg) return false;
        int wgid = (int)L; { const int q = nwg / NXCD, r = nwg % NXCD, xcd = wgid % NXCD, off = wgid / NXCD; wgid = (xcd < r ? xcd * (q + 1) : r * (q + 1) + (xcd - r) * q) + off; }
        const int nig = wgm * nN, gid = wgid / nig, fm = gid * wgm, gsz = (nM - fm) < wgm ? (nM - fm) : wgm;
        u.pm = fm + ((wgid % nig) % gsz); u.pn = (wgid % nig) / gsz; return true;
    }
    __device__ __forceinline__ void a_ready(const Unit&) const {}
    __device__ __forceinline__ void done(const Unit&) const {}
};


typedef __bf16 bf16n2 __attribute__((ext_vector_type(2)));
__device__ __forceinline__ unsigned cvt_pk_bf16(float lo, float hi) { bf16n2 v; v.x = (__bf16)lo; v.y = (__bf16)hi; return __builtin_bit_cast(unsigned, v); }
__device__ __forceinline__ float fast_sigmoid(float z) { return __builtin_amdgcn_rcpf(1.0f + __builtin_amdgcn_exp2f(-1.44269504f * z)); }
__device__ __forceinline__ float fast_silu(float z) { return z * fast_sigmoid(z); }
constexpr float SS_SCALE = 16777216.0f;
__device__ __forceinline__ float inv_rms_from_val(unsigned long long v) {
    const float tot = (float)v * (1.0f / SS_SCALE);
    return 1.0f / sqrtf(tot * (1.0f / 2048.0f) + 1e-6f);
}
__device__ __forceinline__ u32x4 pack8(const f32x4 v0, const f32x4 v1) { u32x4 w; w.x = cvt_pk_bf16(v0[0], v0[1]); w.y = cvt_pk_bf16(v0[2], v0[3]); w.z = cvt_pk_bf16(v1[0], v1[1]); w.w = cvt_pk_bf16(v1[2], v1[3]); return w; }

struct InvTab {
    const PG8_LAS float* tab; int t0, t1, t2, t3; const unsigned long long* ss;
    __device__ __forceinline__ int slot(int pm) const { return pm == t0 ? 0 : (pm == t1 ? 1 : (pm == t2 ? 2 : (pm == t3 ? 3 : -1))); }
    __device__ __forceinline__ void get(float (&inv)[2][4], int pm, int r0) const {
        const int sl = slot(pm);
        if (sl >= 0) {
#pragma unroll
            for (int ai = 0; ai < 2; ++ai)
#pragma unroll
                for (int m = 0; m < 4; ++m) inv[ai][m] = tab[sl * BM + r0 + ai * HALF + m * 16];
        } else { unsigned long long sv[2][4];
#pragma unroll
            for (int ai = 0; ai < 2; ++ai)
#pragma unroll
                for (int m = 0; m < 4; ++m) sv[ai][m] = ss[pm * BM + r0 + ai * HALF + m * 16];
#pragma unroll
            for (int ai = 0; ai < 2; ++ai)
#pragma unroll
                for (int m = 0; m < 4; ++m) inv[ai][m] = inv_rms_from_val(sv[ai][m]); }
    }
};
template <class Sched> __device__ __forceinline__ InvTab inv_preload(PG8_LAS float* tab, const Sched& S, const unsigned long long* ss) {
    InvTab T; T.tab = tab; T.t0 = -1; T.t1 = -1; T.t2 = -1; T.t3 = -1; T.ss = ss; int n = 0; Unit u;
    for (int i = 0; S.next(i, u); ++i) {
        if (T.slot(u.pm) < 0 && n < 4) {
            if (threadIdx.x < BM) tab[n * BM + threadIdx.x] = inv_rms_from_val(ss[u.pm * BM + threadIdx.x]);
            if (n == 0) T.t0 = u.pm; else if (n == 1) T.t1 = u.pm; else if (n == 2) T.t2 = u.pm; else T.t3 = u.pm;
            ++n; } }
    __syncthreads();
    return T;
}
struct EpiSwiglu {
    static constexpr bool PERM = true, AFTER_DRAIN = false;
    bf16_t* O; int ldc; InvTab it;
    __device__ __forceinline__ void operator()(const f32x4 (&acc)[2][2][4][2], const Unit& u, int wr, int wc, int fr, int fq) const {
        const int row0 = u.pm * BM + wr * 64 + fr, col0 = u.pn * HALF + wc * 32 + 8 * fq;
        float invs[2][4]; it.get(invs, u.pm, wr * 64 + fr);
#pragma unroll
        for (int ai = 0; ai < 2; ++ai)
#pragma unroll
            for (int m = 0; m < 4; ++m) { const int row = row0 + ai * HALF + m * 16; const float inv = invs[ai][m];
                f32x4 o[2];
#pragma unroll
                for (int n = 0; n < 2; ++n) { const f32x4 g = acc[ai][0][m][n] * inv, up = acc[ai][1][m][n] * inv;
#pragma unroll
                    for (int j = 0; j < 4; ++j) o[n][j] = fast_silu(g[j]) * up[j]; }
                *(u32x4*)(O + (size_t)row * ldc + col0) = pack8(o[0], o[1]); }
    }
};
struct EpiResid {
    static constexpr bool PERM = true, AFTER_DRAIN = false;
    const float* rf; const bf16_t* rb; const float* rbg; float* out; bf16_t* ob; const float* gain; bf16_t* ob2; unsigned long long* ss; float alpha;
    __device__ __forceinline__ void operator()(const f32x4 (&acc)[2][2][4][2], const Unit& u, int wr, int wc, int fr, int fq) const {
        const int row0 = u.pm * BM + wr * 64 + fr, col0 = u.pn * BM + wc * 32 + 8 * fq;
        f32x4 gi[2][2], go[2][2];
#pragma unroll
        for (int bj = 0; bj < 2; ++bj)
#pragma unroll
            for (int n = 0; n < 2; ++n) { gi[bj][n] = (f32x4){1.f, 1.f, 1.f, 1.f}; go[bj][n] = gi[bj][n];
                if (rbg) { const f32x4 t = *(const f32x4*)(rbg + col0 + bj * HALF + 4 * n); gi[bj][n] = (f32x4){1.0f / t[0], 1.0f / t[1], 1.0f / t[2], 1.0f / t[3]}; }
                if (ob) go[bj][n] = *(const f32x4*)(gain + col0 + bj * HALF + 4 * n); }
#pragma unroll
        for (int ai = 0; ai < 2; ++ai)
#pragma unroll
            for (int m = 0; m < 4; ++m) { const int row = row0 + ai * HALF + m * 16; const size_t off = (size_t)row * 2048 + col0; float s = 0.f;
#pragma unroll
                for (int bj = 0; bj < 2; ++bj) {
                    f32x4 r0, r1;
                    if (rf) { r0 = *(const f32x4*)(rf + off + bj * HALF); r1 = *(const f32x4*)(rf + off + bj * HALF + 4); }
                    else { const u32x4 w = *(const u32x4*)(rb + off + bj * HALF);
                        r0 = (f32x4){__builtin_bit_cast(float, w.x << 16), __builtin_bit_cast(float, w.x & 0xffff0000u), __builtin_bit_cast(float, w.y << 16), __builtin_bit_cast(float, w.y & 0xffff0000u)} * gi[bj][0];
                        r1 = (f32x4){__builtin_bit_cast(float, w.z << 16), __builtin_bit_cast(float, w.z & 0xffff0000u), __builtin_bit_cast(float, w.w << 16), __builtin_bit_cast(float, w.w & 0xffff0000u)} * gi[bj][1]; }
                    const f32x4 o0 = r0 + acc[ai][bj][m][0] * alpha, o1 = r1 + acc[ai][bj][m][1] * alpha;
                    if (out) { *(f32x4*)(out + off + bj * HALF) = o0; *(f32x4*)(out + off + bj * HALF + 4) = o1; }
                    if (ob) *(u32x4*)(ob + off + bj * HALF) = pack8(o0 * go[bj][0], o1 * go[bj][1]);
                    if (ob2) *(u32x4*)(ob2 + off + bj * HALF) = pack8(o0, o1);
                    s += (o0[0] * o0[0] + o0[1] * o0[1]) + (o0[2] * o0[2] + o0[3] * o0[3]) + (o1[0] * o1[0] + o1[1] * o1[1]) + (o1[2] * o1[2] + o1[3] * o1[3]); }
                if (ss) { s += __shfl_xor(s, 16); s += __shfl_xor(s, 32);
                    if (fq == 0) atomicAdd(ss + row, (unsigned long long)(s * SS_SCALE + 0.5f)); } }
    }
};
struct EpiInProj {
    static constexpr bool PERM = true, AFTER_DRAIN = false;
    bf16_t* rkv; float* lin; bf16_t* hg; InvTab it; const PG8_LAS float* oml; int pn0;
    __device__ __forceinline__ void operator()(const f32x4 (&acc)[2][2][4][2], const Unit& u, int wr, int wc, int fr, int fq) const {
        const int row0 = u.pm * BM + wr * 64 + fr, cin = wc * 32 + 8 * fq;
        const int pn = u.pn + pn0;
        float invs[2][4]; it.get(invs, u.pm, wr * 64 + fr);
        int mode;
        if (pn < 12) mode = 0; else if (pn < 14) mode = 1; else { const int sg = (pn - 14) >> 2; mode = (sg == 0 || sg == 3) ? 2 : (sg == 1 ? 3 : 4); }
#pragma unroll
        for (int bj = 0; bj < 2; ++bj) {
            f32x4 om0 = (f32x4){0.f, 0.f, 0.f, 0.f}, om1 = om0;
            if (mode == 3) { const PG8_LAS float* lp = oml + (pn - 18) * BM + bj * HALF + cin; om0 = *(const PG8_LAS f32x4*)lp; om1 = *(const PG8_LAS f32x4*)(lp + 4); }
#pragma unroll
            for (int ai = 0; ai < 2; ++ai)
#pragma unroll
                for (int m = 0; m < 4; ++m) { const int row = row0 + ai * HALF + m * 16; const float inv = invs[ai][m];
                    f32x4 v0 = acc[ai][bj][m][0] * inv, v1 = acc[ai][bj][m][1] * inv;
                    if (mode == 0) { *(u32x4*)(rkv + (size_t)row * 3072 + pn * BM + bj * HALF + cin) = pack8(v0, v1); }
                    else if (mode == 1) { const int cl = (pn - 12) * BM + bj * HALF + cin;
                        if (cl < 288) { *(f32x4*)(lin + (size_t)row * 288 + cl) = v0; *(f32x4*)(lin + (size_t)row * 288 + cl + 4) = v1; } }
                    else {
                        if (mode == 2) {
#pragma unroll
                            for (int j = 0; j < 4; ++j) { v0[j] = fast_silu(v0[j]); v1[j] = fast_silu(v1[j]); } }
                        else if (mode == 3) {
#pragma unroll
                            for (int j = 0; j < 4; ++j) { v0[j] = __logf(1.0f - om0[j] * fast_sigmoid(-v0[j])); v1[j] = __logf(1.0f - om1[j] * fast_sigmoid(-v1[j])); } }
                        *(u32x4*)(hg + (size_t)row * 4096 + (pn - 14) * BM + bj * HALF + cin) = pack8(v0, v1); } } }
    }
};
struct EpiLora {
    static constexpr bool PERM = true, AFTER_DRAIN = false;
    bf16_t* lout; const PG8_LAS float* bias; int pn0;
    __device__ __forceinline__ void operator()(const f32x4 (&acc)[2][2][4][2], const Unit& u, int wr, int wc, int fr, int fq) const {
        const int row0 = u.pm * BM + wr * 64 + fr, cin = wc * 32 + 8 * fq;
        const int pn = u.pn + pn0, mode = pn >> 2;
#pragma unroll
        for (int bj = 0; bj < 2; ++bj) {
            f32x4 b0 = (f32x4){0.f, 0.f, 0.f, 0.f}, b1 = b0;
            if (mode < 2) { const PG8_LAS float* bp = bias + pn * BM + bj * HALF + cin; b0 = *(const PG8_LAS f32x4*)bp; b1 = *(const PG8_LAS f32x4*)(bp + 4); }
#pragma unroll
            for (int ai = 0; ai < 2; ++ai)
#pragma unroll
                for (int m = 0; m < 4; ++m) { const int row = row0 + ai * HALF + m * 16;
                    f32x4 v0 = acc[ai][bj][m][0] + b0, v1 = acc[ai][bj][m][1] + b1;
#pragma unroll
                    for (int j = 0; j < 4; ++j) { const float s0 = fast_sigmoid(v0[j]), s1 = fast_sigmoid(v1[j]);
                        const float d0 = -0.60653066f * s0, d1 = -0.60653066f * s1;
                        v0[j] = mode == 0 ? d0 : (mode == 1 ? s0 : v0[j]); v1[j] = mode == 0 ? d1 : (mode == 1 ? s1 : v1[j]); }
                    *(u32x4*)(lout + (size_t)row * 3072 + pn * BM + bj * HALF + cin) = pack8(v0, v1); asm volatile("" ::: "memory"); } }
    }
};
template <class Epi, class Sched, bool ALIGN_EPI = false, bool SP2 = false>
__device__ __forceinline__ void gemm_phase(PG8_LAS unsigned char* lds, const Gemm g, const Sched& S, const Epi& E) {
    const int tid = threadIdx.x, wid = __builtin_amdgcn_readfirstlane(tid >> 6), lane = tid & 63, wr = wid >> 2, wc = wid & 3, fr = lane & 15, fq = lane >> 4;
    const int K = g.K, nt = K / BK;
    unsigned voffA[2], voffB[2];
#pragma unroll
    for (int i = 0; i < 2; ++i) { int R, C; stage_rc(tid * 16 + i * 8192, R, C); const int Rb = Epi::PERM ? ((R & ~31) + perm32(R & 31)) : R;
        voffA[i] = (unsigned)(R * K + C) * 2u; voffB[i] = (unsigned)(Rb * K + C) * 2u; }
    const size_t kstep = (size_t)(BK * 2);
    const size_t hstep = (size_t)HALF * K * 2;
    const size_t tstep = 2 * hstep;
    const unsigned ldsw = (unsigned)wid * 1024u;
    const int aoff = lds_byte(wr * 64 + fr, fq * 8), boff = lds_byte(wc * 32 + fr, fq * 8);
#define PG8_SA(b, h) (((b) * 2 + (h)) * HTB)
#define PG8_SB(b, h) ((4 + (b) * 2 + (h)) * HTB)
#define PG8_STAGE(bufoff, gbase, voff) do { _Pragma("unroll") for (int _i = 0; _i < 2; ++_i) \
        __builtin_amdgcn_global_load_lds((const unsigned*)((const char*)(gbase) + (voff)[_i]), (PG8_LAS unsigned*)(lds + (bufoff) + ldsw + _i * 8192), 16, 0, 0); } while (0)
#define PG8_LDA(dst, b, h) do { _Pragma("unroll") for (int m = 0; m < 4; ++m) _Pragma("unroll") for (int k = 0; k < 2; ++k) dst[m][k] = *(const PG8_LAS bf16x8*)(lds + PG8_SA(b, h) + aoff + m * 2048 + k * 1024); } while (0)
#define PG8_LDB(dst, b, h) do { _Pragma("unroll") for (int n = 0; n < 2; ++n) _Pragma("unroll") for (int k = 0; k < 2; ++k) dst[n][k] = *(const PG8_LAS bf16x8*)(lds + PG8_SB(b, h) + boff + n * 2048 + k * 1024); } while (0)
#define PG8_MMA(ai, bj, At, Bt) do { __builtin_amdgcn_s_setprio(1); _Pragma("unroll") for (int m = 0; m < 4; ++m) _Pragma("unroll") for (int n = 0; n < 2; ++n) _Pragma("unroll") for (int k = 0; k < 2; ++k) \
        acc[ai][bj][m][n] = __builtin_amdgcn_mfma_f32_16x16x32_bf16(Bt[n][k], At[m][k], acc[ai][bj][m][n], 0, 0, 0); __builtin_amdgcn_s_setprio(0); } while (0)
#define PG8_WAIT_V(n) asm volatile("s_waitcnt vmcnt(" #n ")" ::: "memory")
#define PG8_WAIT_L(n) asm volatile("s_waitcnt lgkmcnt(" #n ")" ::: "memory")
#define PG8_BAR __builtin_amdgcn_s_barrier()
#define PG8_SCHED __builtin_amdgcn_sched_barrier(0)
    Unit cur, nxt; int ui = 0;
    if (!S.next(0, cur)) return;
    f32x4 acc[2][2][4][2];
#pragma unroll
    for (int a = 0; a < 2; ++a)
#pragma unroll
        for (int b = 0; b < 2; ++b)
#pragma unroll
            for (int m = 0; m < 4; ++m)
#pragma unroll
                for (int n = 0; n < 2; ++n) acc[a][b][m][n] = (f32x4){0.f, 0.f, 0.f, 0.f};
    bf16x8 At[4][2], B0[2][2], B1[2][2];
    const char* cA = (const char*)g.A + (size_t)cur.pm * tstep; const char* cB = (const char*)g.Bt + (size_t)cur.pn * tstep;
    S.a_ready(cur);
    if constexpr (SP2) {
        PG8_STAGE(PG8_SB(0, 0), cB, voffB); PG8_STAGE(PG8_SB(0, 1), cB + hstep, voffB); PG8_STAGE(PG8_SA(0, 0), cA, voffA); PG8_STAGE(PG8_SA(0, 1), cA + hstep, voffA);
        if (wr == 1) PG8_BAR;
        PG8_WAIT_V(2); PG8_BAR;
        PG8_STAGE(PG8_SB(1, 0), cB + kstep, voffB); PG8_STAGE(PG8_SA(1, 0), cA + kstep, voffA); PG8_STAGE(PG8_SB(1, 1), cB + hstep + kstep, voffB);
        PG8_WAIT_V(6); PG8_BAR;
    } else {
        PG8_STAGE(PG8_SB(0, 0), cB, voffB); PG8_STAGE(PG8_SA(0, 0), cA, voffA); PG8_STAGE(PG8_SB(0, 1), cB + hstep, voffB); PG8_STAGE(PG8_SA(0, 1), cA + hstep, voffA);
        if (wr == 1) PG8_BAR;
        PG8_WAIT_V(4); PG8_BAR;
        PG8_STAGE(PG8_SB(1, 0), cB + kstep, voffB); PG8_STAGE(PG8_SA(1, 0), cA + kstep, voffA); PG8_STAGE(PG8_SB(1, 1), cB + hstep + kstep, voffB);
        PG8_WAIT_V(6); PG8_BAR;
    }
    for (;;) {
        const bool has_next = S.next(ui + 1, nxt);
        const char* nA = has_next ? (const char*)g.A + (size_t)nxt.pm * tstep : cA; const char* nB = has_next ? (const char*)g.Bt + (size_t)nxt.pn * tstep : cB;
        for (int t = 0; t < nt; t += 2) {
            const bool last = (t == nt - 2);
            const char* a1 = cA + (size_t)(t + 1) * kstep;
            const char* a2 = last ? nA : cA + (size_t)(t + 2) * kstep; const char* b2 = last ? nB : cB + (size_t)(t + 2) * kstep;
            const char* a3 = a2 + kstep; const char* b3 = b2 + kstep;
            if (last && has_next) S.a_ready(nxt);
            if constexpr (SP2) {
            PG8_LDB(B0, 0, 0); PG8_LDB(B1, 0, 1); PG8_SCHED; PG8_LDA(At, 0, 0); PG8_STAGE(PG8_SA(1, 1), a1 + hstep, voffA);
            PG8_WAIT_V(8); PG8_WAIT_L(0); PG8_BAR; PG8_MMA(0, 0, At, B0); PG8_MMA(0, 1, At, B1); PG8_BAR; PG8_SCHED;
            PG8_LDA(At, 0, 1); PG8_STAGE(PG8_SB(0, 0), b2, voffB); PG8_STAGE(PG8_SB(0, 1), b2 + hstep, voffB); PG8_STAGE(PG8_SA(0, 0), a2, voffA);
            PG8_WAIT_V(8); PG8_WAIT_L(0); PG8_BAR; PG8_MMA(1, 0, At, B0); PG8_MMA(1, 1, At, B1); PG8_BAR; PG8_SCHED;
            PG8_LDB(B0, 1, 0); PG8_LDB(B1, 1, 1); PG8_SCHED; PG8_LDA(At, 1, 0); PG8_STAGE(PG8_SA(0, 1), a2 + hstep, voffA);
            PG8_WAIT_V(8); PG8_WAIT_L(0); PG8_BAR; PG8_MMA(0, 0, At, B0); PG8_MMA(0, 1, At, B1); PG8_BAR; PG8_SCHED;
            PG8_LDA(At, 1, 1); PG8_STAGE(PG8_SB(1, 0), b3, voffB); PG8_STAGE(PG8_SB(1, 1), b3 + hstep, voffB); PG8_STAGE(PG8_SA(1, 0), a3, voffA);
            PG8_WAIT_V(8); PG8_WAIT_L(0); PG8_BAR; PG8_MMA(1, 0, At, B0); PG8_MMA(1, 1, At, B1); PG8_BAR; PG8_SCHED;
            } else {
            PG8_LDB(B0, 0, 0); PG8_SCHED; PG8_LDA(At, 0, 0); PG8_STAGE(PG8_SA(1, 1), a1 + hstep, voffA);
            PG8_WAIT_L(8); PG8_BAR; PG8_WAIT_L(0); PG8_MMA(0, 0, At, B0); PG8_BAR; PG8_SCHED;
            PG8_LDB(B1, 0, 1); PG8_STAGE(PG8_SB(0, 0), b2, voffB);
            PG8_BAR; PG8_WAIT_L(0); PG8_MMA(0, 1, At, B1); PG8_BAR;
            PG8_LDA(At, 0, 1); PG8_STAGE(PG8_SA(0, 0), a2, voffA);
            PG8_BAR; PG8_WAIT_L(0); PG8_MMA(1, 0, At, B0); PG8_BAR; PG8_SCHED;
            PG8_STAGE(PG8_SB(0, 1), b2 + hstep, voffB);
            PG8_WAIT_V(6); PG8_BAR; PG8_MMA(1, 1, At, B1); PG8_BAR;
            PG8_LDB(B0, 1, 0); PG8_SCHED; PG8_LDA(At, 1, 0); PG8_STAGE(PG8_SA(0, 1), a2 + hstep, voffA);
            PG8_WAIT_L(8); PG8_BAR; PG8_WAIT_L(0); PG8_MMA(0, 0, At, B0); PG8_BAR; PG8_SCHED;
            PG8_LDB(B1, 1, 1); PG8_STAGE(PG8_SB(1, 0), b3, voffB);
            PG8_BAR; PG8_WAIT_L(0); PG8_MMA(0, 1, At, B1); PG8_BAR;
            PG8_LDA(At, 1, 1); PG8_STAGE(PG8_SA(1, 0), a3, voffA);
            PG8_BAR; PG8_WAIT_L(0); PG8_MMA(1, 0, At, B0); PG8_BAR; PG8_SCHED;
            PG8_STAGE(PG8_SB(1, 1), b3 + hstep, voffB);
            PG8_WAIT_V(6); PG8_BAR; PG8_MMA(1, 1, At, B1); PG8_BAR;
            }
        }
        if constexpr (ALIGN_EPI) { if (wr == 0) PG8_BAR; }
        if constexpr (!Epi::AFTER_DRAIN) { E(acc, cur, wr, wc, fr, fq); S.done(cur); }
        if (!has_next) break;
#pragma unroll
        for (int a = 0; a < 2; ++a)
#pragma unroll
            for (int b = 0; b < 2; ++b)
#pragma unroll
                for (int m = 0; m < 4; ++m)
#pragma unroll
                    for (int n = 0; n < 2; ++n) acc[a][b][m][n] = (f32x4){0.f, 0.f, 0.f, 0.f};
        cur = nxt; cA = nA; cB = nB; ++ui;
        if constexpr (ALIGN_EPI) { if (wr == 1) PG8_BAR; }
    }
    PG8_WAIT_V(0);
    if constexpr (!ALIGN_EPI) { if (wr == 0) PG8_BAR; }
    PG8_BAR;
    if constexpr (Epi::AFTER_DRAIN) { E.fused(acc, cur, wr, wc, fr, fq, lds, wid, lane); S.done(cur); }
#undef PG8_SA
#undef PG8_SB
#undef PG8_STAGE
#undef PG8_LDA
#undef PG8_LDB
#undef PG8_MMA
#undef PG8_WAIT_V
#undef PG8_WAIT_L
#undef PG8_BAR
#undef PG8_SCHED
}
}

constexpr int NWAVES = 8;
constexpr int BATCH = 4, SEQ = 8192, D = 2048, M = BATCH * SEQ, FF = 5632;
constexpr int RC = 1024, RH = 16, RN = 64;
constexpr int HC = 1024, HH = 8, HD = 128;
constexpr int RWKV_COLS = 3360, IN_COLS = 7456, NIN = 7680;
constexpr int KL = 384, NL = 3072;
#ifndef MK_N_LAUNCHES
#define MK_N_LAUNCHES 1
#endif
constexpr int N_PHASES = 12;

constexpr size_t WS_CTL = 0, CTL_BYTES = 1u << 20;
constexpr size_t WS_W1GU = CTL_BYTES;
constexpr size_t WS_W1D = WS_W1GU + (size_t)2 * FF * D * 2;
constexpr size_t WS_WIN = WS_W1D + (size_t)D * FF * 2;
constexpr size_t WS_WLORA = WS_WIN + (size_t)NIN * D * 2;
constexpr size_t WS_WOUT = WS_WLORA + (size_t)NL * KL * 2;
constexpr size_t WS_W2GU = WS_WOUT + (size_t)D * D * 2;
constexpr size_t WS_W2D = WS_W2GU + (size_t)2 * FF * D * 2;
constexpr size_t WS_SS = WS_W2D + (size_t)D * FF * 2;
constexpr size_t WS_XB = WS_SS + (1u << 20);
constexpr size_t WS_R = WS_XB + (size_t)M * D * 2;
constexpr size_t R_ACT = 0;
constexpr size_t R_RKV = 0;
constexpr size_t R_HG = R_RKV + (size_t)M * 3072 * 2;
constexpr size_t R_LIN = R_HG + (size_t)M * 4096 * 2;
constexpr size_t R_X2B = (size_t)M * FF * 2;
constexpr size_t R_BYTES = R_LIN + (size_t)M * 288 * 4;
constexpr size_t WS_ALORA = WS_R + R_BYTES;
constexpr size_t WS_LOUT = WS_ALORA + (size_t)M * KL * 2;
constexpr size_t WS_INVN = WS_LOUT + (size_t)M * NL * 2;
constexpr size_t WS_END = WS_INVN + (size_t)M * RH * 4;
static_assert(R_X2B + (size_t)M * D * 2 <= R_BYTES && WS_END <= ((size_t)1 << 30), "d_ws map");
constexpr int CW_BAR = 4096;

constexpr int RING_BYTES = 162816;
constexpr int LDSCTL_OFF = RING_BYTES, MISC_OFF = LDSCTL_OFF + 320;
constexpr int LDS_BYTES = 163840;
static_assert(MISC_OFF + 128 <= LDS_BYTES, "LDS map");

#define GAS __attribute__((address_space(1)))
#define LAS __attribute__((address_space(3)))
typedef unsigned short bf16;
typedef unsigned v4u __attribute__((ext_vector_type(4)));
typedef unsigned v2u __attribute__((ext_vector_type(2)));
typedef float f32x4 __attribute__((ext_vector_type(4)));
#define LDS_WAIT() asm volatile("s_waitcnt lgkmcnt(0)" ::: "memory")
#define VM_WAIT() asm volatile("s_waitcnt vmcnt(0)" ::: "memory")
__device__ __forceinline__ float bflo(unsigned u) { return __builtin_bit_cast(float, u << 16); }
__device__ __forceinline__ float bfhi(unsigned u) { return __builtin_bit_cast(float, u & 0xffff0000u); }
__device__ __forceinline__ f32x4 unpack4(v2u w) { return (f32x4){bflo(w.x), bfhi(w.x), bflo(w.y), bfhi(w.y)}; }
__device__ __forceinline__ unsigned pk2(float lo, float hi) { return pg8::cvt_pk_bf16(lo, hi); }
__device__ __forceinline__ v2u pack4(f32x4 v) { v2u w; w.x = pk2(v[0], v[1]); w.y = pk2(v[2], v[3]); return w; }
using pg8::fast_sigmoid;
using pg8::fast_silu;
template <int CTRL> __device__ __forceinline__ float dpp_mov(float x) { return __builtin_bit_cast(float, __builtin_amdgcn_update_dpp(0, __builtin_bit_cast(int, x), CTRL, 0xF, 0xF, true)); }
__device__ __forceinline__ float row16_sum(float x) { x += dpp_mov<0x128>(x); x += dpp_mov<0x124>(x); x += dpp_mov<0x122>(x); x += dpp_mov<0x121>(x); return x; }
template <int CTRL, int BANK> __device__ __forceinline__ float dpp_upd(float old, float x) { return __builtin_bit_cast(float, __builtin_amdgcn_update_dpp(__builtin_bit_cast(int, old), __builtin_bit_cast(int, x), CTRL, 0xF, BANK, false)); }
__device__ __forceinline__ float tr_reduce16(const float (&v)[16], int lane) {
    float u[8], w[4], x[2];
#pragma unroll
    for (int s = 0; s < 8; ++s) { const float t = v[s + 8] + dpp_mov<0x128>(v[s + 8]), a = v[s] + dpp_mov<0x128>(v[s]); u[s] = dpp_upd<0xE4, 0x3>(t, a); }
#pragma unroll
    for (int s = 0; s < 4; ++s) { const float t = u[s + 4] + dpp_mov<0x141>(u[s + 4]), a = u[s] + dpp_mov<0x141>(u[s]); w[s] = dpp_upd<0xE4, 0x5>(t, a); }
    const bool b1 = (lane & 2) != 0, b0 = (lane & 1) != 0;
#pragma unroll
    for (int s = 0; s < 2; ++s) { const float K = b1 ? w[s + 2] : w[s], T = b1 ? w[s] : w[s + 2]; x[s] = K + dpp_mov<0x1B>(T); }
    const float K = b0 ? x[1] : x[0], T = b0 ? x[0] : x[1];
    return K + dpp_mov<0xB1>(T);
}
typedef float f32x2 __attribute__((ext_vector_type(2)));
#define LO2(v) __builtin_shufflevector(v, v, 0, 1)
#define HI2(v) __builtin_shufflevector(v, v, 2, 3)
__device__ __forceinline__ float wave_sum(float v) {
#pragma unroll
    for (int o = 1; o < 64; o <<= 1) v += __shfl_xor(v, o);
    return v;
}
#define XB_TMO      128
#define XB_XCNT(j)  (256  + 64 * (j))
#define XB_XSUB(j)  (1280 + 64 * (j))
#define XB_XGEN(j)  (2304 + 64 * (j))
#define XB_TOP      3328
#define XB_TOPGEN   3392
#define XCD_BAR_WORDS 3456
#define XB_SPIN_CAP (1u << 18)

__device__ __forceinline__ unsigned xb_ld(unsigned* p)              { return __hip_atomic_load(p, __ATOMIC_RELAXED, __HIP_MEMORY_SCOPE_AGENT); }
__device__ __forceinline__ unsigned xb_add(unsigned* p, unsigned v) { return __hip_atomic_fetch_add(p, v, __ATOMIC_RELAXED, __HIP_MEMORY_SCOPE_AGENT); }
__device__ __forceinline__ unsigned xb_xcc_id() { return (unsigned)__builtin_amdgcn_s_getreg((3 << 11) | 20) & 0xFu; }
#define XB_SPIN(cond, bar) do { unsigned _sp = 0; while (cond) { __builtin_amdgcn_s_sleep(1); \
    if ((++_sp & 255u) == 0u) { if (xb_ld(&(bar)[XB_TMO])) break; if (_sp > XB_SPIN_CAP) { atomicAdd(&(bar)[XB_TMO], 1u); break; } } } } while (0)

struct XcdBarrier {
    unsigned* bar; unsigned x;
    volatile LAS unsigned* st;
};

__device__ __forceinline__ XcdBarrier xcd_barrier_post(unsigned* bar, volatile LAS unsigned* st) {
    XcdBarrier b; b.bar = bar; b.x = xb_xcc_id(); b.st = st;
    if (threadIdx.x == 0) (void)xb_add(&bar[XB_XCNT(b.x)], 1u);
    return b;
}
__device__ __forceinline__ void xcd_barrier_complete(unsigned* bar, unsigned x, unsigned& nloc, unsigned& nx) {
    const unsigned G = gridDim.x * gridDim.y * gridDim.z;
    unsigned sum, cnt, mine, sp = 0u;
    for (;;) {
        sum = 0u; cnt = 0u; mine = 0u;
#pragma unroll
        for (unsigned j = 0; j < 16; ++j) { const unsigned c = xb_ld(&bar[XB_XCNT(j)]); sum += c; cnt += (c > 0u) ? 1u : 0u; mine = (j == x) ? c : mine; }
        if (sum == G) break;
        __builtin_amdgcn_s_sleep(1);
        if ((++sp & 255u) == 0u) { if (xb_ld(&bar[XB_TMO])) break; if (sp > XB_SPIN_CAP) { atomicAdd(&bar[XB_TMO], 1u); break; } }
    }
    nloc = mine > 0u ? mine : 1u; nx = cnt > 0u ? cnt : 1u;
}

__device__ __forceinline__ void xcd_barrier(const XcdBarrier& b) {
    asm volatile("s_waitcnt vmcnt(0)" ::: "memory");
    __syncthreads();
    if (threadIdx.x == 0) {
        unsigned* bar = b.bar;
        __builtin_amdgcn_s_waitcnt(0);
        unsigned nloc = b.st[0], nx = b.st[1];
        if (nloc == 0u) { xcd_barrier_complete(bar, b.x, nloc, nx); b.st[0] = nloc; b.st[1] = nx; }
        const unsigned old = xb_add(&bar[XB_XSUB(b.x)], 1u);
        const unsigned gen = old / nloc;
        if (old + 1u == (gen + 1u) * nloc) {
            __builtin_amdgcn_fence(__ATOMIC_RELEASE, "agent");
            asm volatile("s_waitcnt vmcnt(0)" ::: "memory");
            const unsigned og = xb_add(&bar[XB_TOP], 1u);
            const unsigned tg = og / nx;
            if (og + 1u == (tg + 1u) * nx) xb_add(&bar[XB_TOPGEN], 1u);
            else XB_SPIN(xb_ld(&bar[XB_TOPGEN]) == tg, bar);
            __builtin_amdgcn_fence(__ATOMIC_ACQUIRE, "agent");
            xb_add(&bar[XB_XGEN(b.x)], 1u);
            asm volatile("s_waitcnt vmcnt(0)" ::: "memory");
        } else {
            XB_SPIN(xb_ld(&bar[XB_XGEN(b.x)]) == gen, bar);
            __builtin_amdgcn_fence(__ATOMIC_ACQUIRE, "agent");
            asm volatile("s_waitcnt vmcnt(0)" ::: "memory");
        }
    }
    __syncthreads();
}

struct Frame {
    LAS unsigned char* lds;
    int tid, lane, wave, vcu, G;
    const float* in[26];
    float* out; unsigned char* ws;
};
#define WSP(T, off) ((T*)(F.ws + (off)))
struct Args { const float* in[26]; float* out; unsigned char* ws; int ph_lo, ph_hi; };

struct P0Item { const float* W; bf16* WT; int K, N, kb, n0, drow0; };
__device__ __forceinline__ int map_gu(int n0, int which) { return (n0 >> 7) * 256 + which * 128 + (n0 & 127); }
constexpr int P0_I_GU = (D / 64) * (FF / 32), P0_I_DN = (FF / 64) * (D / 32), P0_I_IN = (D / 64) * (IN_COLS / 32), P0_I_OUT = (D / 64) * (D / 32);
constexpr int P0_N0 = 2 * P0_I_GU + P0_I_DN + P0_I_IN, P0_N1 = 2 * P0_I_GU + P0_I_DN + P0_I_OUT;
template <int SET> __device__ __forceinline__ P0Item p0_decode(Frame& F, const Args& A, int it) {
    constexpr int I_GU = P0_I_GU, I_DN = P0_I_DN, I_IN = P0_I_IN;
    P0Item p; int r = it;
    if (SET == 0) { if (r >= 2 * I_GU) r += 2 * I_GU; if (r >= 4 * I_GU + I_DN) r += I_DN; }
    else { r += 2 * I_GU; if (r >= 4 * I_GU) r += I_DN; if (r >= 4 * I_GU + 2 * I_DN) r += I_IN; }
    if (r < 4 * I_GU) { const int mat = r / I_GU; r -= mat * I_GU; const int nblk = FF / 32, ffn = mat >> 1, which = mat & 1;
        p.W = A.in[2 + 20 * ffn + which]; p.WT = WSP(bf16, ffn ? WS_W2GU : WS_W1GU); p.K = D; p.N = FF; p.kb = r / nblk; p.n0 = 32 * (r % nblk); p.drow0 = map_gu(p.n0, which); return p; }
    r -= 4 * I_GU;
    if (r < 2 * I_DN) { const int ffn = r / I_DN; r -= ffn * I_DN; const int nblk = D / 32;
        p.W = A.in[4 + 20 * ffn]; p.WT = WSP(bf16, ffn ? WS_W2D : WS_W1D); p.K = FF; p.N = D; p.kb = r / nblk; p.n0 = 32 * (r % nblk); p.drow0 = p.n0; return p; }
    r -= 2 * I_DN;
    if (r < I_IN) { const int nblk = IN_COLS / 32;
        p.W = A.in[6]; p.WT = WSP(bf16, WS_WIN); p.K = D; p.N = IN_COLS; p.kb = r / nblk; p.n0 = 32 * (r % nblk); p.drow0 = p.n0 < RWKV_COLS ? p.n0 : p.n0 + 224; return p; }
    r -= I_IN;
    { const int nblk = D / 32; p.W = A.in[20]; p.WT = WSP(bf16, WS_WOUT); p.K = D; p.N = D; p.kb = r / nblk; p.n0 = 32 * (r % nblk); p.drow0 = p.n0; return p; }
}
__device__ __forceinline__ void p0_dma(const P0Item& p, LAS unsigned char* tile, int lane) {
    const int half = lane >> 5, sl = lane & 31;
#pragma unroll 8
    for (int i = 0; i < 32; ++i) { const int kk = 2 * i + half;
        __builtin_amdgcn_global_load_lds((const GAS unsigned*)(p.W + (size_t)(64 * p.kb + kk) * p.N + p.n0 + (sl ^ (4 * (kk >> 3)))), (LAS unsigned*)(tile + i * 256), 4, 0, 0); }
}
__device__ __forceinline__ void p0_emit(const P0Item& p, const LAS float* t, int lane) {
    const int c = lane & 7;
#pragma unroll
    for (int j = 0; j < 4; ++j) { const int n = (lane >> 3) + 8 * j; const LAS float* s = t + (8 * c) * 32 + (n ^ (4 * c));
        v4u o; o.x = pk2(s[0 * 32], s[1 * 32]); o.y = pk2(s[2 * 32], s[3 * 32]); o.z = pk2(s[4 * 32], s[5 * 32]); o.w = pk2(s[6 * 32], s[7 * 32]);
        *(GAS v4u*)(p.WT + (size_t)(p.drow0 + n) * p.K + 64 * p.kb + 8 * c) = o; }
}
template <int SET> __device__ __forceinline__ void p0_transposes(Frame& F, const Args& A, int gw, int NGW) {
    LAS unsigned char* tiles = F.lds + F.wave * 16384;
    constexpr int NITEMS = SET == 0 ? P0_N0 : P0_N1;
    if (gw < NITEMS) {
        P0Item cur = p0_decode<SET>(F, A, gw); int buf = 0;
        p0_dma(cur, tiles, F.lane);
        for (int it = gw; it < NITEMS; it += NGW) {
            const bool more = it + NGW < NITEMS; P0Item nxt = cur;
            if (more) { nxt = p0_decode<SET>(F, A, it + NGW); p0_dma(nxt, tiles + (buf ^ 1) * 8192, F.lane); asm volatile("s_waitcnt vmcnt(32)" ::: "memory"); }
            else asm volatile("s_waitcnt vmcnt(0)" ::: "memory");
            p0_emit(cur, (const LAS float*)(tiles + buf * 8192), F.lane);
            LDS_WAIT(); asm volatile("" ::: "memory");
            cur = nxt; buf ^= 1;
        }
        asm volatile("s_waitcnt vmcnt(0)" ::: "memory");
    }
}
__device__ __forceinline__ void p0_prologue(Frame& F, const Args& A) {
    const int gw = F.vcu * NWAVES + F.wave, NGW = F.G * NWAVES;
    p0_transposes<0>(F, A, gw, NGW);
    const size_t gt = (size_t)F.vcu * (NWAVES * 64) + F.tid, NT = (size_t)F.G * NWAVES * 64;
    { GAS v4u* z = (GAS v4u*)(WSP(bf16, WS_WIN) + (size_t)RWKV_COLS * D);
      for (size_t i = gt; i < (size_t)224 * D * 2 / 16; i += NT) z[i] = (v4u){0u, 0u, 0u, 0u}; }
    { bf16* wl = WSP(bf16, WS_WLORA); const float* w2 = F.in[9]; const float* a2 = F.in[11]; const float* g2 = F.in[12];
      for (size_t i = gt; i < (size_t)NL * KL / 2; i += NT) { const int n = (int)(i / (KL / 2)), k = 2 * (int)(i % (KL / 2)); const int seg = n >> 10, c = n & 1023;
          float v0 = 0.f, v1 = 0.f;
          if (seg == 0) { if (k < 64) { v0 = w2[(size_t)k * RC + c]; v1 = w2[(size_t)(k + 1) * RC + c]; } }
          else if (seg == 1) { if (k >= 64 && k < 128) { v0 = a2[(size_t)(k - 64) * RC + c]; v1 = a2[(size_t)(k - 63) * RC + c]; } }
          else { if (k >= 128 && k < 288) { v0 = g2[(size_t)(k - 128) * RC + c]; v1 = g2[(size_t)(k - 127) * RC + c]; } }
          ((GAS unsigned*)wl)[i] = pk2(v0, v1); } }
    { GAS unsigned long long* s = (GAS unsigned long long*)(F.ws + WS_SS) + M;
      for (size_t i = gt; i < (size_t)2 * M; i += NT) s[i] = 0ull; }
    { const float* x = F.in[0]; bf16* xb = WSP(bf16, WS_XB); unsigned long long* ss0 = WSP(unsigned long long, WS_SS);
      for (int m = gw; m < M; m += NGW) { const GAS f32x4* xr = (const GAS f32x4*)(x + (size_t)m * D) + 2 * F.lane; GAS v4u* o = (GAS v4u*)(xb + (size_t)m * D) + F.lane; float s = 0.f;
#pragma unroll
          for (int j = 0; j < 4; ++j) { const f32x4 a = xr[128 * j], b = xr[128 * j + 1];
              s += (a[0] * a[0] + a[1] * a[1]) + (a[2] * a[2] + a[3] * a[3]) + (b[0] * b[0] + b[1] * b[1]) + (b[2] * b[2] + b[3] * b[3]);
              const f32x4 ga = *(const f32x4*)(F.in[1] + 8 * F.lane + 512 * j), gb = *(const f32x4*)(F.in[1] + 8 * F.lane + 512 * j + 4);
              o[64 * j] = pg8::pack8(a * ga, b * gb); }
          s = wave_sum(s);
          if (F.lane == 0) ss0[m] = (unsigned long long)(s * pg8::SS_SCALE + 0.5f); } }
}

__device__ __forceinline__ void p4_lora_in(Frame& F) {
    const float* lin = WSP(float, WS_R + R_LIN); bf16* al = WSP(bf16, WS_ALORA); const float* mu = F.in[7] + 3 * RC;
    const size_t gt = (size_t)F.vcu * (NWAVES * 64) + F.tid, NT = (size_t)F.G * NWAVES * 64;
#pragma unroll 4
    for (size_t i = gt; i < (size_t)M * 96; i += NT) { const int m = (int)(i / 96), q = (int)(i % 96), qc = q < 72 ? q : 0; const bool first = (m & (SEQ - 1)) == 0;
        const f32x4 p = *(const GAS f32x4*)(lin + (size_t)m * 288 + 4 * qc), pr = *(const GAS f32x4*)(lin + (size_t)(first ? m : m - 1) * 288 + 4 * qc), mv = *(const GAS f32x4*)(mu + 4 * qc);
        const f32x4 pp = first ? (f32x4){0.f, 0.f, 0.f, 0.f} : pr; f32x4 s = p + (pp - p) * mv;
#pragma unroll
        for (int j = 0; j < 4; ++j) { const float sg = fast_sigmoid(q < 16 ? 2.0f * s[j] : s[j]); s[j] = q < 16 ? 2.0f * sg - 1.0f : (q >= 32 ? sg : s[j]); }
        v2u o = pack4(s); if (q >= 72) o = (v2u){0u, 0u};
        *(GAS v2u*)(al + (size_t)m * KL + 4 * q) = o; }
    { const bf16* rkv = WSP(bf16, WS_R + R_RKV); float* invn = WSP(float, WS_INVN); const int j4 = (F.tid & 15) * 4;
      const size_t it0 = gt >> 4, step = NT >> 4; const int h = (int)(it0 & 15), ch = h * RN + j4;
      const f32x4 muk = *(const f32x4*)(F.in[7] + RC + ch), kkc = *(const f32x4*)(F.in[13] + ch);
      if ((step & 15) == 0) {
#pragma unroll 4
          for (size_t it = it0; it < (size_t)M * RH; it += step) { const int m = (int)(it >> 4); const bool first = (m & (SEQ - 1)) == 0;
              const f32x4 k = unpack4(*(const GAS v2u*)(rkv + (size_t)m * 3072 + RC + ch)), kr = unpack4(*(const GAS v2u*)(rkv + (size_t)(first ? m : m - 1) * 3072 + RC + ch));
              const f32x4 kp = first ? (f32x4){0.f, 0.f, 0.f, 0.f} : kr;
              const f32x4 kk = (k + (kp - k) * muk) * kkc; float s2 = (kk[0] * kk[0] + kk[1] * kk[1]) + (kk[2] * kk[2] + kk[3] * kk[3]); s2 = row16_sum(s2);
              if ((F.tid & 15) == 0) invn[it] = 1.0f / fmaxf(sqrtf(s2), 1e-12f); }
      } else {
          for (size_t it = it0; it < (size_t)M * RH; it += step) { const int m = (int)(it >> 4), h2 = (int)(it & 15), c2 = h2 * RN + j4; const bool first = (m & (SEQ - 1)) == 0;
              const f32x4 k = unpack4(*(const GAS v2u*)(rkv + (size_t)m * 3072 + RC + c2)), kr = unpack4(*(const GAS v2u*)(rkv + (size_t)(first ? m : m - 1) * 3072 + RC + c2));
              const f32x4 kp = first ? (f32x4){0.f, 0.f, 0.f, 0.f} : kr; const f32x4 mk2 = *(const f32x4*)(F.in[7] + RC + c2), kc2 = *(const f32x4*)(F.in[13] + c2);
              const f32x4 kk = (k + (kp - k) * mk2) * kc2; float s2 = (kk[0] * kk[0] + kk[1] * kk[1]) + (kk[2] * kk[2] + kk[3] * kk[3]); s2 = row16_sum(s2);
              if ((F.tid & 15) == 0) invn[it] = 1.0f / fmaxf(sqrtf(s2), 1e-12f); } } }
}

typedef short bf16x4 __attribute__((ext_vector_type(4)));
typedef short bf16x8 __attribute__((ext_vector_type(8)));
#define MFMA32(a, b, c) __builtin_amdgcn_mfma_f32_16x16x32_bf16(a, b, c, 0, 0, 0)
#define MFMA16(a, b, c) __builtin_amdgcn_mfma_f32_16x16x16bf16_1k(a, b, c, 0, 0, 0)
__device__ __forceinline__ bf16x4 cv4(f32x4 v) { v2u w; w.x = pk2(v[0], v[1]); w.y = pk2(v[2], v[3]); return __builtin_bit_cast(bf16x4, w); }
__device__ __forceinline__ bf16x8 cv8(f32x4 a, f32x4 b) { v4u w; w.x = pk2(a[0], a[1]); w.y = pk2(a[2], a[3]); w.z = pk2(b[0], b[1]); w.w = pk2(b[2], b[3]); return __builtin_bit_cast(bf16x8, w); }
__device__ __forceinline__ bf16x8 cat8(bf16x4 a, bf16x4 b) { return __builtin_shufflevector(a, b, 0, 1, 2, 3, 4, 5, 6, 7); }
__device__ __forceinline__ bf16x8 join8(v2u a, v2u b) { v4u w; w.x = a.x; w.y = a.y; w.z = b.x; w.w = b.y; return __builtin_bit_cast(bf16x8, w); }
__device__ __forceinline__ float row16_scan(float x) { x += dpp_mov<0x111>(x); x += dpp_mov<0x112>(x); x += dpp_mov<0x114>(x); x += dpp_mov<0x118>(x); return x; }
__device__ __forceinline__ unsigned short bf1(float x) { return (unsigned short)(pk2(x, 0.f) & 0xffffu); }
constexpr int CH = 16;
constexpr int RWS = 144;
constexpr int HGS = 272;
constexpr int RWB_KG = 0, RWB_RG = 16 * RWS, RWB_KTI = 32 * RWS, RWB_BTI = 48 * RWS, RWB_KTIT = 64 * RWS, RWB_BTIT = RWB_KTIT + 2048, RWB_VT = RWB_BTIT + 2048, RWB_GL = RWB_VT + 2048, RWB_BYTES = RWB_GL + 256;
constexpr int HGB_QG = 0, HGB_KI = 16 * HGS, HGB_KIT = 32 * HGS, HGB_VT = HGB_KIT + 4096, HGB_GL = HGB_VT + 4096, HGB_BYTES = HGB_GL + 512;

__device__ __forceinline__ f32x4 padc(f32x4 r) { asm("s_nop 15" : "+v"(r)); return r; }
constexpr int NCHK = SEQ / CH;
constexpr int NRAW = 8;
constexpr int RWR_R = 0, RWR_K = 2048, RWR_V = 4096, RWR_LW = 6144, RWR_A = 8192, RWR_INV = 10240, RWR_BYTES = 10304;
constexpr int RW_OPND = 0, RW_RAW = 3 * RWB_BYTES, RW_AOP = RW_RAW + NRAW * RWR_BYTES, RW_LDS = RW_AOP + 2 * 2048;
constexpr int HGR_Q = 0, HGR_LF = 4096, HGR_V = 8192, HGR_BYTES = 12288;
constexpr int HG_OPND = 0, HG_RAW = 3 * HGB_BYTES, HG_AOP = HG_RAW + NRAW * HGR_BYTES, HG_LDS = HG_AOP + 2 * 512;
static_assert(RW_LDS <= RING_BYTES && HG_LDS <= RING_BYTES && RW_AOP % 16 == 0 && HG_AOP % 16 == 0, "scan LDS map");
#define GLDS4(gptr, lptr) __builtin_amdgcn_global_load_lds((const GAS unsigned*)(gptr), (LAS unsigned*)(lptr), 4, 0, 0)
#define WG_BAR() do { LDS_WAIT(); __builtin_amdgcn_s_barrier(); asm volatile("" ::: "memory"); } while (0)

__device__ __forceinline__ void p6_rwkv_head(Frame& F, int bh) {
    const bf16* rkv = WSP(bf16, WS_R + R_RKV); const bf16* lout = WSP(bf16, WS_LOUT); const float* invn = WSP(float, WS_INVN); bf16* ydst = WSP(bf16, WS_LOUT);
    const int lane = F.lane, c = lane & 15, g = lane >> 4, w = F.wave;
    const int b = bh >> 4, h = bh & 15;
    const size_t rowbase = (size_t)b * SEQ;
    const int st = lane & 15, k0 = 2 * (w * 4 + (lane >> 4)), chn = h * RN + k0;
    const float mur0 = F.in[7][chn], mur1 = F.in[7][chn + 1], muk0 = F.in[7][RC + chn], muk1 = F.in[7][RC + chn + 1], muv0 = F.in[7][2 * RC + chn], muv1 = F.in[7][2 * RC + chn + 1];
    const float kk0 = F.in[13][chn], kk1 = F.in[13][chn + 1], ka0 = F.in[14][chn], ka1 = F.in[14][chn + 1];
    LAS unsigned char* const opnd = F.lds + RW_OPND; LAS unsigned char* const raw = F.lds + RW_RAW; LAS unsigned char* const aop = F.lds + RW_AOP;
#define RW3_DMA(j) do { const int r_ = 2 * w + (lane >> 5); const size_t ro_ = (rowbase + (size_t)(j) * CH + r_) * 3072 + h * RN + 2 * ((lane & 31) ^ r_); \
        LAS unsigned char* d_ = raw + ((j) % NRAW) * RWR_BYTES + w * 256; \
        GLDS4(rkv + ro_, d_ + RWR_R); GLDS4(rkv + ro_ + RC, d_ + RWR_K); GLDS4(rkv + ro_ + 2 * RC, d_ + RWR_V); GLDS4(lout + ro_, d_ + RWR_LW); GLDS4(lout + ro_ + RC, d_ + RWR_A); \
        if (lane < 2) GLDS4(invn + (rowbase + (size_t)(j) * CH + 2 * w + lane) * RH + h, raw + ((j) % NRAW) * RWR_BYTES + RWR_INV + w * 8); } while (0)
#define RW3_PROC(j) do { const LAS unsigned char* s_ = raw + ((j) % NRAW) * RWR_BYTES; const int pq_ = (k0 >> 1) ^ st, pp_ = (k0 >> 1) ^ ((st + 15) & 15); \
        const LAS unsigned char* sc_ = s_ + st * 128 + pq_ * 4; const LAS unsigned char* sp_ = ((st > 0) ? s_ + (st - 1) * 128 : raw + (((j) + NRAW - 1) % NRAW) * RWR_BYTES + 15 * 128) + pp_ * 4; \
        const bool first_ = ((j) == 0) && (st == 0); \
        const unsigned Lr = *(const LAS unsigned*)(sc_ + RWR_R), Lk = *(const LAS unsigned*)(sc_ + RWR_K), Lv = *(const LAS unsigned*)(sc_ + RWR_V); \
        const unsigned Lw = *(const LAS unsigned*)(sc_ + RWR_LW), La = *(const LAS unsigned*)(sc_ + RWR_A); \
        const unsigned Lrp = *(const LAS unsigned*)(sp_ + RWR_R), Lkp = *(const LAS unsigned*)(sp_ + RWR_K), Lvp = *(const LAS unsigned*)(sp_ + RWR_V); \
        const float Linv = *(const LAS float*)(s_ + RWR_INV + st * 4); \
        const float r0_ = bflo(Lr), r1_ = bfhi(Lr), q0_ = bflo(Lk), q1_ = bfhi(Lk), v0_ = bflo(Lv), v1_ = bfhi(Lv); \
        const float rp0_ = first_ ? 0.f : bflo(Lrp), rp1_ = first_ ? 0.f : bfhi(Lrp), qp0_ = first_ ? 0.f : bflo(Lkp), qp1_ = first_ ? 0.f : bfhi(Lkp), vp0_ = first_ ? 0.f : bflo(Lvp), vp1_ = first_ ? 0.f : bfhi(Lvp); \
        const float rs0_ = r0_ + (rp0_ - r0_) * mur0, rs1_ = r1_ + (rp1_ - r1_) * mur1, ks0_ = q0_ + (qp0_ - q0_) * muk0, ks1_ = q1_ + (qp1_ - q1_) * muk1, vs0_ = v0_ + (vp0_ - v0_) * muv0, vs1_ = v1_ + (vp1_ - v1_) * muv1; \
        const float a0_ = bflo(La), a1_ = bfhi(La), lw0_ = bflo(Lw) * 1.44269504f, lw1_ = bfhi(Lw) * 1.44269504f; \
        const float kap0_ = ks0_ * kk0 * Linv, kap1_ = ks1_ * kk1 * Linv, bet0_ = kap0_ * a0_, bet1_ = kap1_ * a1_; \
        const float kt0_ = ks0_ * (1.0f + (a0_ - 1.0f) * ka0), kt1_ = ks1_ * (1.0f + (a1_ - 1.0f) * ka1); \
        const float G0_ = row16_scan(lw0_), G1_ = row16_scan(lw1_); \
        const float eg0_ = __builtin_amdgcn_exp2f(G0_), eg1_ = __builtin_amdgcn_exp2f(G1_), ep0_ = __builtin_amdgcn_exp2f(G0_ - lw0_), ep1_ = __builtin_amdgcn_exp2f(G1_ - lw1_), ei0_ = __builtin_amdgcn_exp2f(-G0_), ei1_ = __builtin_amdgcn_exp2f(-G1_); \
        LAS unsigned char* d_ = opnd + ((j) % 3) * RWB_BYTES; \
        *(LAS unsigned*)(d_ + RWB_KG + st * RWS + k0 * 2) = pk2(kap0_ * ep0_, kap1_ * ep1_); *(LAS unsigned*)(d_ + RWB_RG + st * RWS + k0 * 2) = pk2(rs0_ * eg0_, rs1_ * eg1_); \
        const unsigned kti_ = pk2(kt0_ * ei0_, kt1_ * ei1_), bti_ = pk2(bet0_ * ei0_, bet1_ * ei1_), vv_ = pk2(vs0_, vs1_); \
        *(LAS unsigned*)(d_ + RWB_KTI + st * RWS + k0 * 2) = kti_; *(LAS unsigned*)(d_ + RWB_BTI + st * RWS + k0 * 2) = bti_; \
        *(LAS unsigned short*)(d_ + RWB_KTIT + k0 * 32 + st * 2) = (unsigned short)(kti_ & 0xffffu); *(LAS unsigned short*)(d_ + RWB_KTIT + (k0 + 1) * 32 + st * 2) = (unsigned short)(kti_ >> 16); \
        *(LAS unsigned short*)(d_ + RWB_BTIT + k0 * 32 + st * 2) = (unsigned short)(bti_ & 0xffffu); *(LAS unsigned short*)(d_ + RWB_BTIT + (k0 + 1) * 32 + st * 2) = (unsigned short)(bti_ >> 16); \
        *(LAS unsigned short*)(d_ + RWB_VT + k0 * 32 + st * 2) = (unsigned short)(vv_ & 0xffffu); *(LAS unsigned short*)(d_ + RWB_VT + (k0 + 1) * 32 + st * 2) = (unsigned short)(vv_ >> 16); \
        if (st == 15) { *(LAS float*)(d_ + RWB_GL + k0 * 4) = eg0_; *(LAS float*)(d_ + RWB_GL + k0 * 4 + 4) = eg1_; } } while (0)
    const f32x4 zero4 = (f32x4){0.f, 0.f, 0.f, 0.f};
    auto a_stage = [&](int j) {
        const LAS unsigned char* rowp = opnd + (j % 3) * RWB_BYTES + c * RWS;
        const int offA = (w == 4 || w == 7) ? RWB_BTI : RWB_KTI;
        const int offB = (w == 4 || w == 5) ? RWB_KG : RWB_RG;
        const bf16x8 a0 = *(const LAS bf16x8*)(rowp + offA + 16 * g), a1 = *(const LAS bf16x8*)(rowp + offA + 64 + 16 * g);
        const bf16x8 b0 = *(const LAS bf16x8*)(rowp + offB + 16 * g), b1 = *(const LAS bf16x8*)(rowp + offB + 64 + 16 * g);
        f32x4 N = MFMA32(a0, b0, zero4); N = MFMA32(a1, b1, N);
        const bool strict = (w == 4 || w == 5);
#pragma unroll
        for (int r = 0; r < 4; ++r) { const int rj = 4 * g + r; N[r] = (strict ? (c > rj) : (c >= rj)) ? N[r] : 0.f; }
        f32x4 res = N;
        if (w == 4) {
            f32x4 N1t = MFMA32(b0, a0, zero4); N1t = MFMA32(b1, a1, N1t);
            f32x4 X;
#pragma unroll
            for (int r = 0; r < 4; ++r) { const int rj = 4 * g + r; N1t[r] = (rj > c) ? N1t[r] : 0.f; X[r] = ((rj == c) ? 1.0f : 0.f) - N[r]; }
            bf16x4 an = cv4(N), at = cv4(N1t);
            f32x4 P = MFMA16(at, an, zero4), Pt = MFMA16(an, at, zero4);
            X = MFMA16(cv4(Pt), cv4(X), padc(X));
            an = cv4(P); at = cv4(Pt);
            P = MFMA16(at, an, zero4); Pt = MFMA16(an, at, zero4);
            X = MFMA16(cv4(Pt), cv4(X), padc(X));
            an = cv4(P); at = cv4(Pt);
            Pt = MFMA16(an, at, zero4);
            X = MFMA16(cv4(Pt), cv4(X), padc(X));
            res = X;
        }
        *(LAS bf16x4*)(aop + (j & 1) * 2048 + (w - 4) * 512 + lane * 8) = cv4(res);
    };
    f32x4 Z[4];
#pragma unroll
    for (int i = 0; i < 4; ++i) Z[i] = (f32x4){0.f, 0.f, 0.f, 0.f};
    { RW3_DMA(0); RW3_DMA(1); RW3_DMA(2); RW3_DMA(3); RW3_DMA(4); RW3_DMA(5); RW3_DMA(6); RW3_DMA(7); asm volatile("s_waitcnt vmcnt(0)" ::: "memory"); WG_BAR(); RW3_PROC(0); RW3_PROC(1); WG_BAR(); if (w >= 4) a_stage(0); WG_BAR(); }
    if (w < 4) {
        for (int ci = 0; ci < NCHK; ++ci) {
            const int t0 = ci * CH; const int jp = (ci + 2 < NCHK) ? ci + 2 : NCHK - 1;
            RW3_PROC(jp);
            const LAS unsigned char* cur = opnd + (ci % 3) * RWB_BYTES; const LAS unsigned char* rowp = cur + c * RWS; const LAS unsigned char* ap = aop + (ci & 1) * 2048 + lane * 8;
            bf16x8 pKg[2], pRg[2];
#pragma unroll
            for (int s = 0; s < 2; ++s) {
                pKg[s] = join8(*(const LAS v2u*)(rowp + RWB_KG + 64 * s + 8 * g), *(const LAS v2u*)(rowp + RWB_KG + 64 * s + 32 + 8 * g));
                pRg[s] = join8(*(const LAS v2u*)(rowp + RWB_RG + 64 * s + 8 * g), *(const LAS v2u*)(rowp + RWB_RG + 64 * s + 32 + 8 * g)); }
            const bf16x4 bV = *(const LAS bf16x4*)(cur + RWB_VT + (16 * w + c) * 32 + 8 * g);
            const bf16x4 xT = *(const LAS bf16x4*)(ap), n2 = *(const LAS bf16x4*)(ap + 512), n3 = *(const LAS bf16x4*)(ap + 1024), n4 = *(const LAS bf16x4*)(ap + 1536);
            const bf16x8 bZ0 = cv8(Z[0], Z[1]), bZ1 = cv8(Z[2], Z[3]);
            const bf16x4 z4 = (bf16x4){0, 0, 0, 0};
            f32x4 W = MFMA32(pKg[0], bZ0, zero4); W = MFMA32(pKg[1], bZ1, W); W = MFMA32(cat8(n2, z4), cat8(bV, z4), W);
            const f32x4 U = MFMA16(xT, cv4(W), zero4);
            const bf16x4 nU = cv4(-U);
            const bf16x8 bVU = cat8(bV, nU);
            f32x4 Y = MFMA32(pRg[0], bZ0, zero4); Y = MFMA32(pRg[1], bZ1, Y); Y = MFMA32(cat8(n3, n4), bVU, Y);
#pragma unroll
            for (int r = 0; r < 4; ++r) ydst[(rowbase + t0 + 4 * g + r) * 3072 + h * RN + 16 * w + c] = bf1(Y[r]);
#pragma unroll
            for (int zt = 0; zt < 4; ++zt) {
                const bf16x4 aK = *(const LAS bf16x4*)(cur + RWB_KTIT + (16 * zt + c) * 32 + 8 * g), aB = *(const LAS bf16x4*)(cur + RWB_BTIT + (16 * zt + c) * 32 + 8 * g);
                const f32x4 gl = *(const LAS f32x4*)(cur + RWB_GL + (16 * zt + 4 * g) * 4);
                Z[zt] = MFMA32(cat8(aK, aB), bVU, Z[zt]) * gl; }
            { const int jn = (ci + NRAW < NCHK) ? ci + NRAW : NCHK - 1; RW3_DMA(jn); }
            asm volatile("s_waitcnt vmcnt(50)" ::: "memory");
            WG_BAR();
        }
    } else {
        for (int ci = 0; ci < NCHK; ++ci) {
            const int jp = (ci + 2 < NCHK) ? ci + 2 : NCHK - 1, ja = (ci + 1 < NCHK) ? ci + 1 : NCHK - 1;
            RW3_PROC(jp);
            a_stage(ja);
            { const int jn = (ci + NRAW < NCHK) ? ci + NRAW : NCHK - 1; RW3_DMA(jn); }
            asm volatile("s_waitcnt vmcnt(30)" ::: "memory");
            WG_BAR();
        }
    }
#undef RW3_DMA
#undef RW3_PROC
}

__device__ __forceinline__ void p6_hgrn_head(Frame& F, int hb) {
    const bf16* hg = WSP(bf16, WS_R + R_HG); bf16* odst = WSP(bf16, WS_R + R_HG);
    const int lane = F.lane, c = lane & 15, g = lane >> 4, w = F.wave;
    const int bh = hb >> 1, half = hb & 1, b = bh >> 3, h = bh & 7, vb = half * 4 + (w & 3);
    const size_t rowbase = (size_t)b * SEQ;
    const int st = lane & 15, k0 = 4 * (w * 4 + (lane >> 4));
    LAS unsigned char* const opnd = F.lds + HG_OPND; LAS unsigned char* const raw = F.lds + HG_RAW; LAS unsigned char* const aop = F.lds + HG_AOP;
#define HG3_DMA(j) do { _Pragma("unroll") for (int rr_ = 0; rr_ < 2; ++rr_) { const int r_ = 2 * w + rr_; const bf16* p_ = hg + (rowbase + (size_t)(j) * CH + r_) * 4096 + h * HD + 2 * (2 * ((lane >> 1) ^ r_) + (lane & 1)); \
        LAS unsigned char* d_ = raw + ((j) % NRAW) * HGR_BYTES + r_ * 256; GLDS4(p_, d_ + HGR_Q); GLDS4(p_ + HC, d_ + HGR_LF); GLDS4(p_ + 2 * HC, d_ + HGR_V); } } while (0)
#define HG3_PROC(j) do { const LAS unsigned char* s_ = raw + ((j) % NRAW) * HGR_BYTES + st * 256 + (((k0 >> 2) ^ st) * 8); LAS unsigned char* d_ = opnd + ((j) % 3) * HGB_BYTES; \
        const v2u Lq = *(const LAS v2u*)(s_ + HGR_Q), Lf = *(const LAS v2u*)(s_ + HGR_LF), Lv = *(const LAS v2u*)(s_ + HGR_V); \
        const f32x4 q_ = unpack4(Lq); f32x4 lf_ = unpack4(Lf) * 1.44269504f; f32x4 qg_, ki_, eg_; \
        _Pragma("unroll") for (int e = 0; e < 4; ++e) { const float G_ = row16_scan(lf_[e]); eg_[e] = __builtin_amdgcn_exp2f(G_); qg_[e] = q_[e] * eg_[e]; ki_[e] = (1.0f - __builtin_amdgcn_exp2f(lf_[e])) * __builtin_amdgcn_exp2f(-G_); } \
        const v2u kw_ = pack4(ki_); *(LAS v2u*)(d_ + HGB_QG + st * HGS + k0 * 2) = pack4(qg_); *(LAS v2u*)(d_ + HGB_KI + st * HGS + k0 * 2) = kw_; \
        *(LAS unsigned short*)(d_ + HGB_KIT + (k0 + 0) * 32 + st * 2) = (unsigned short)(kw_.x & 0xffffu); *(LAS unsigned short*)(d_ + HGB_KIT + (k0 + 1) * 32 + st * 2) = (unsigned short)(kw_.x >> 16); \
        *(LAS unsigned short*)(d_ + HGB_KIT + (k0 + 2) * 32 + st * 2) = (unsigned short)(kw_.y & 0xffffu); *(LAS unsigned short*)(d_ + HGB_KIT + (k0 + 3) * 32 + st * 2) = (unsigned short)(kw_.y >> 16); \
        *(LAS unsigned short*)(d_ + HGB_VT + (k0 + 0) * 32 + st * 2) = (unsigned short)(Lv.x & 0xffffu); *(LAS unsigned short*)(d_ + HGB_VT + (k0 + 1) * 32 + st * 2) = (unsigned short)(Lv.x >> 16); \
        *(LAS unsigned short*)(d_ + HGB_VT + (k0 + 2) * 32 + st * 2) = (unsigned short)(Lv.y & 0xffffu); *(LAS unsigned short*)(d_ + HGB_VT + (k0 + 3) * 32 + st * 2) = (unsigned short)(Lv.y >> 16); \
        if (st == 15) *(LAS f32x4*)(d_ + HGB_GL + k0 * 4) = eg_; } while (0)
    const f32x4 zero4 = (f32x4){0.f, 0.f, 0.f, 0.f};
    auto a_stage = [&](int j) {
        const LAS unsigned char* rowp = opnd + (j % 3) * HGB_BYTES + c * HGS;
        f32x4 N = zero4;
#pragma unroll
        for (int s = 0; s < 4; ++s) { const bf16x8 nQ = *(const LAS bf16x8*)(rowp + HGB_QG + 64 * s + 16 * g), nK = *(const LAS bf16x8*)(rowp + HGB_KI + 64 * s + 16 * g); N = MFMA32(nK, nQ, N); }
#pragma unroll
        for (int r = 0; r < 4; ++r) N[r] = (c >= 4 * g + r) ? N[r] : 0.f;
        *(LAS bf16x4*)(aop + (j & 1) * 512 + lane * 8) = cv4(N);
    };
    f32x4 Z[8];
#pragma unroll
    for (int i = 0; i < 8; ++i) Z[i] = (f32x4){0.f, 0.f, 0.f, 0.f};
    { HG3_DMA(0); HG3_DMA(1); HG3_DMA(2); HG3_DMA(3); HG3_DMA(4); HG3_DMA(5); HG3_DMA(6); HG3_DMA(7); asm volatile("s_waitcnt vmcnt(0)" ::: "memory"); WG_BAR(); HG3_PROC(0); HG3_PROC(1); WG_BAR(); if (w == 4) a_stage(0); WG_BAR(); }
    if (w < 4) {
        for (int ci = 0; ci < NCHK; ++ci) {
            const int t0 = ci * CH; const int jp = (ci + 2 < NCHK) ? ci + 2 : NCHK - 1;
            HG3_PROC(jp);
            const LAS unsigned char* cur = opnd + (ci % 3) * HGB_BYTES; const LAS unsigned char* rowp = cur + c * HGS;
            f32x4 Y = zero4;
#pragma unroll
            for (int s = 0; s < 4; ++s) {
                const bf16x8 pQ = join8(*(const LAS v2u*)(rowp + HGB_QG + 64 * s + 8 * g), *(const LAS v2u*)(rowp + HGB_QG + 64 * s + 32 + 8 * g));
                Y = MFMA32(pQ, cv8(Z[2 * s], Z[2 * s + 1]), Y); }
            const bf16x4 bV = *(const LAS bf16x4*)(cur + HGB_VT + (16 * vb + c) * 32 + 8 * g);
            const bf16x4 n = *(const LAS bf16x4*)(aop + (ci & 1) * 512 + lane * 8);
            const bf16x4 z4 = (bf16x4){0, 0, 0, 0};
            Y = MFMA32(cat8(n, z4), cat8(bV, z4), Y);
#pragma unroll
            for (int r = 0; r < 4; ++r) odst[(rowbase + t0 + 4 * g + r) * 4096 + 2 * HC + h * HD + 16 * vb + c] = bf1(Y[r]);
#pragma unroll
            for (int zt = 0; zt < 8; ++zt) {
                const bf16x4 aK = *(const LAS bf16x4*)(cur + HGB_KIT + (16 * zt + c) * 32 + 8 * g);
                const f32x4 gl = *(const LAS f32x4*)(cur + HGB_GL + (16 * zt + 4 * g) * 4);
                Z[zt] = MFMA16(aK, bV, Z[zt]) * gl; }
            { const int jn = (ci + NRAW < NCHK) ? ci + NRAW : NCHK - 1; HG3_DMA(jn); }
            asm volatile("s_waitcnt vmcnt(50)" ::: "memory");
            WG_BAR();
        }
    } else {
        for (int ci = 0; ci < NCHK; ++ci) {
            const int jp = (ci + 2 < NCHK) ? ci + 2 : NCHK - 1, ja = (ci + 1 < NCHK) ? ci + 1 : NCHK - 1;
            HG3_PROC(jp);
            if (w == 4) a_stage(ja);
            { const int jn = (ci + NRAW < NCHK) ? ci + NRAW : NCHK - 1; HG3_DMA(jn); }
            asm volatile("s_waitcnt vmcnt(30)" ::: "memory");
            WG_BAR();
        }
    }
#undef HG3_DMA
#undef HG3_PROC
}
#undef WG_BAR
constexpr int NSCAN = BATCH * RH + 2 * BATCH * HH;
__device__ __forceinline__ void p6_shadow(Frame& F, const Args& A, int c, int G) {
    const unsigned long long* ss = WSP(unsigned long long, WS_SS);
    {   pg8::Gemm g{WSP(bf16, WS_XB), WSP(bf16, WS_WIN) + (size_t)26 * 256 * D, M, 4 * 256, D}; pg8::StaticOrder S; S.init(M, 4 * 256, G, c);
        pg8::EpiInProj E{WSP(bf16, WS_R + R_RKV), WSP(float, WS_R + R_LIN), WSP(bf16, WS_R + R_HG), pg8::inv_preload((PG8_LAS float*)(F.lds + pg8::STAGE_BYTES), S, ss + M), (PG8_LAS float*)(F.lds + pg8::STAGE_BYTES + 4096), 26};
        pg8::gemm_phase<pg8::EpiInProj, pg8::StaticOrder, true, true>(F.lds, g, S, E); }
    {   int kl = KL; asm volatile("" : "+s"(kl));
        pg8::Gemm g{WSP(bf16, WS_ALORA), WSP(bf16, WS_WLORA) + (size_t)8 * 256 * KL, M, 4 * 256, kl}; pg8::StaticOrder S; S.init(M, 4 * 256, G, c);
        pg8::EpiLora E{WSP(bf16, WS_LOUT), (PG8_LAS float*)(F.lds + pg8::STAGE_BYTES), 8};
        pg8::gemm_phase<pg8::EpiLora, pg8::StaticOrder, true, true>(F.lds, g, S, E); }
    p0_transposes<1>(F, A, c * NWAVES + F.wave, G * NWAVES);
}
__device__ __forceinline__ void p6_scans(Frame& F, const Args& A) {
    const int bx = (int)blockIdx.x;
    if (F.G > NSCAN) { if (bx < NSCAN) { if (bx < BATCH * RH) p6_rwkv_head(F, bx); else p6_hgrn_head(F, bx - BATCH * RH); } else p6_shadow(F, A, bx - NSCAN, F.G - NSCAN); }
    else {
        for (int u = bx; u < NSCAN; u += F.G) { if (u < BATCH * RH) p6_rwkv_head(F, u); else p6_hgrn_head(F, u - BATCH * RH); }
        __syncthreads(); p6_shadow(F, A, bx, F.G);
    }
}

__device__ __forceinline__ void p7_post(Frame& F) {
    const bf16* rkv = WSP(bf16, WS_R + R_RKV); const bf16* hg = WSP(bf16, WS_R + R_HG); const bf16* lout = WSP(bf16, WS_LOUT); bf16* yc = WSP(bf16, WS_XB);
    { const int half = F.tid >> 8, ch = (F.tid & 255) * 4;
      const f32x4 mu_r = *(const f32x4*)(F.in[7] + ch), mu_k = *(const f32x4*)(F.in[7] + RC + ch), mu_v = *(const f32x4*)(F.in[7] + 2 * RC + ch);
      const f32x4 kac = *(const f32x4*)(F.in[14] + ch), rkc = *(const f32x4*)(F.in[15] + ch), lnw = *(const f32x4*)(F.in[16] + ch), lnb = *(const f32x4*)(F.in[17] + ch);
#pragma unroll 2
      for (int m = F.vcu * 2 + half; m < M; m += 2 * F.G) {
          const bool first = (m & (SEQ - 1)) == 0; const size_t mp = first ? m : m - 1;
          const bf16* p = rkv + (size_t)m * 3072 + ch; const bf16* q = rkv + mp * 3072 + ch; const bf16* l = lout + (size_t)m * 3072 + ch;
          const f32x4 y = unpack4(*(const GAS v2u*)(l));
          const f32x4 r = unpack4(*(const GAS v2u*)(p)), k = unpack4(*(const GAS v2u*)(p + RC)), v = unpack4(*(const GAS v2u*)(p + 2 * RC));
          f32x4 rp = unpack4(*(const GAS v2u*)(q)), kp = unpack4(*(const GAS v2u*)(q + RC)), vp = unpack4(*(const GAS v2u*)(q + 2 * RC));
          if (first) { rp = (f32x4){0.f, 0.f, 0.f, 0.f}; kp = rp; vp = rp; }
          const f32x4 a = unpack4(*(const GAS v2u*)(l + RC)), gg = unpack4(*(const GAS v2u*)(l + 2 * RC));
          const f32x4 rs = r + (rp - r) * mu_r, ks = k + (kp - k) * mu_k, vs = v + (vp - v) * mu_v;
          const f32x4 km = ks * (1.0f + (a - 1.0f) * kac);
          const f32x4 bt = rs * km * rkc; float bon = (bt[0] + bt[1]) + (bt[2] + bt[3]); bon = row16_sum(bon);
          float s1 = (y[0] + y[1]) + (y[2] + y[3]); s1 = row16_sum(s1); const float mean = s1 * (1.0f / 64.0f);
          const f32x4 d = y - mean; float s2 = (d[0] * d[0] + d[1] * d[1]) + (d[2] * d[2] + d[3] * d[3]); s2 = row16_sum(s2);
          const float rstd = 1.0f / sqrtf(s2 * (1.0f / 64.0f) + 64e-5f);
          const f32x4 o = ((d * rstd) * lnw + lnb + vs * bon) * gg;
          *(GAS v2u*)(yc + (size_t)m * 2048 + ch) = pack4(o); } }
    { const int quarter = F.tid >> 7, ch = (F.tid & 127) * 8;
      const f32x4 nw0 = *(const f32x4*)(F.in[19] + ch), nw1 = *(const f32x4*)(F.in[19] + ch + 4);
#pragma unroll 4
      for (int m = F.vcu * 4 + quarter; m < M; m += 4 * F.G) {
          const v4u ow = *(const GAS v4u*)(hg + (size_t)m * 4096 + 2 * HC + ch), gw4 = *(const GAS v4u*)(hg + (size_t)m * 4096 + 3 * HC + ch);
          const f32x4 o0 = (f32x4){bflo(ow.x), bfhi(ow.x), bflo(ow.y), bfhi(ow.y)}, o1 = (f32x4){bflo(ow.z), bfhi(ow.z), bflo(ow.w), bfhi(ow.w)};
          const f32x4 g0 = (f32x4){bflo(gw4.x), bfhi(gw4.x), bflo(gw4.y), bfhi(gw4.y)}, g1 = (f32x4){bflo(gw4.z), bfhi(gw4.z), bflo(gw4.w), bfhi(gw4.w)};
          float s2 = ((o0[0] * o0[0] + o0[1] * o0[1]) + (o0[2] * o0[2] + o0[3] * o0[3])) + ((o1[0] * o1[0] + o1[1] * o1[1]) + (o1[2] * o1[2] + o1[3] * o1[3])); s2 = row16_sum(s2);
          const float rstd = 1.0f / sqrtf(s2 * (1.0f / 128.0f) + 1e-6f);
          *(GAS v4u*)(yc + (size_t)m * 2048 + RC + ch) = pg8::pack8(o0 * rstd * nw0 * g0, o1 * rstd * nw1 * g1); } }
}

__device__ __forceinline__ void p11_final(Frame& F) {
    const int gw = F.vcu * NWAVES + F.wave, NGW = F.G * NWAVES; const float* fg = F.in[25];
    f32x4 gn[8];
#pragma unroll
    for (int i = 0; i < 8; ++i) gn[i] = *(const f32x4*)(fg + 4 * F.lane + 256 * i);
    for (int m = gw; m < M; m += NGW) { GAS f32x4* xr = (GAS f32x4*)(F.out + (size_t)m * D) + F.lane; f32x4 v[8]; float s = 0.f;
#pragma unroll
        for (int i = 0; i < 8; ++i) { v[i] = xr[64 * i]; s += (v[i][0] * v[i][0] + v[i][1] * v[i][1]) + (v[i][2] * v[i][2] + v[i][3] * v[i][3]); }
        s = wave_sum(s); const float inv = 1.0f / sqrtf(s * (1.0f / D) + 1e-6f);
#pragma unroll
        for (int i = 0; i < 8; ++i) xr[64 * i] = v[i] * inv * gn[i]; }
}

__global__ void __launch_bounds__(NWAVES * 64, 2) mk_fwd(Args args) {
    extern __shared__ __attribute__((aligned(16))) unsigned char lds[];
    Frame F;
    F.lds = (LAS unsigned char*)lds;
    F.tid = threadIdx.x; F.lane = F.tid & 63; F.wave = __builtin_amdgcn_readfirstlane(F.tid >> 6);
    F.G = gridDim.x; { const int bx = blockIdx.x; F.vcu = (F.G % 8 == 0) ? (bx % 8) * (F.G / 8) + bx / 8 : bx; }
#pragma unroll
    for (int i = 0; i < 26; ++i) F.in[i] = args.in[i];
    F.out = args.out; F.ws = args.ws;
    for (int u = F.tid; u < (LDS_BYTES - LDSCTL_OFF) / 4; u += NWAVES * 64) ((LAS unsigned*)(F.lds + LDSCTL_OFF))[u] = 0u;
    __syncthreads();
    const int lo = args.ph_lo, hi = args.ph_hi;
    XcdBarrier bar; bar.bar = (unsigned*)(args.ws + WS_CTL) + CW_BAR; bar.x = 0; bar.st = nullptr;
    if (hi - lo > 1) bar = xcd_barrier_post((unsigned*)(args.ws + WS_CTL) + CW_BAR, (volatile LAS unsigned*)(F.lds + MISC_OFF) + 8);
#ifndef PH_MASK
#define PH_MASK 0xFFF
#endif
#define IN(k) (((PH_MASK >> (k)) & 1) && lo <= (k) && (k) < hi)
#define SEAM(k) do { if (IN(k) && IN((k) + 1)) xcd_barrier(bar); } while (0)
    const bf16* xb = WSP(bf16, WS_XB); unsigned long long* ss = WSP(unsigned long long, WS_SS);
    const int cid = (int)blockIdx.x;

    if (IN(0)) { p0_prologue(F, args); } SEAM(0);
    if (IN(1)) {
        pg8::Gemm g{xb, WSP(bf16, WS_W1GU), M, 2 * FF, D}; pg8::StaticOrder S; S.init(M, 2 * FF, F.G, cid);
        pg8::EpiSwiglu E{WSP(bf16, WS_R + R_ACT), FF, pg8::inv_preload((PG8_LAS float*)(F.lds + pg8::STAGE_BYTES), S, ss)};
        pg8::gemm_phase<pg8::EpiSwiglu, pg8::StaticOrder, true, true>(F.lds, g, S, E);
    } SEAM(1);
    if (IN(2)) {
        pg8::Gemm g{WSP(bf16, WS_R + R_ACT), WSP(bf16, WS_W1D), M, D, FF}; pg8::StaticOrder S; S.init(M, D, F.G, cid, 4);
        pg8::EpiResid E{F.in[0], nullptr, nullptr, nullptr, WSP(bf16, WS_XB), F.in[5], (bf16*)F.out, ss + M, 0.5f};
        pg8::gemm_phase<pg8::EpiResid, pg8::StaticOrder, true, true>(F.lds, g, S, E);
    } SEAM(2);
    if (IN(3)) {
        pg8::Gemm g{xb, WSP(bf16, WS_WIN), M, 26 * 256, D}; pg8::StaticOrder S; S.init(M, 26 * 256, F.G, cid);
        PG8_LAS float* omt = (PG8_LAS float*)(F.lds + pg8::STAGE_BYTES + 4096);
        for (int cix = F.tid; cix < HC; cix += NWAVES * 64) omt[cix] = 1.0f - fast_sigmoid(F.in[18][cix] - F.in[18][HC + cix]);
        pg8::EpiInProj E{WSP(bf16, WS_R + R_RKV), WSP(float, WS_R + R_LIN), WSP(bf16, WS_R + R_HG), pg8::inv_preload((PG8_LAS float*)(F.lds + pg8::STAGE_BYTES), S, ss + M), omt, 0};
        pg8::gemm_phase<pg8::EpiInProj, pg8::StaticOrder, true, true>(F.lds, g, S, E);
    } SEAM(3);
    if (IN(4)) { p4_lora_in(F); } SEAM(4);
    if (IN(5)) {
        int kl = KL; asm volatile("" : "+s"(kl));
        pg8::Gemm g{WSP(bf16, WS_ALORA), WSP(bf16, WS_WLORA), M, 8 * 256, kl}; pg8::StaticOrder S; S.init(M, 8 * 256, F.G, cid);
        PG8_LAS float* bt = (PG8_LAS float*)(F.lds + pg8::STAGE_BYTES);
        for (int cix = F.tid; cix < 2 * RC; cix += NWAVES * 64) bt[cix] = cix < RC ? F.in[8][cix] : F.in[10][cix - RC];
        __syncthreads();
        pg8::EpiLora E{WSP(bf16, WS_LOUT), bt, 0};
        pg8::gemm_phase<pg8::EpiLora, pg8::StaticOrder, true, true>(F.lds, g, S, E);
    } SEAM(5);
    if (IN(6)) { p6_scans(F, args); } SEAM(6);
    if (IN(7)) { p7_post(F); } SEAM(7);
    if (IN(8)) {
        pg8::Gemm g{xb, WSP(bf16, WS_WOUT), M, D, D}; pg8::StaticOrder S; S.init(M, D, F.G, cid, 4);
        pg8::EpiResid E{nullptr, (const bf16*)F.out, nullptr, nullptr, WSP(bf16, WS_R + R_X2B), F.in[21], nullptr, ss + 2 * M, 1.0f};
        pg8::gemm_phase<pg8::EpiResid, pg8::StaticOrder, true, true>(F.lds, g, S, E);
    } SEAM(8);
    if (IN(9)) {
        pg8::Gemm g{WSP(bf16, WS_R + R_X2B), WSP(bf16, WS_W2GU), M, 2 * FF, D}; pg8::StaticOrder S; S.init(M, 2 * FF, F.G, cid);
        pg8::EpiSwiglu E{WSP(bf16, WS_R + R_ACT), FF, pg8::inv_preload((PG8_LAS float*)(F.lds + pg8::STAGE_BYTES), S, ss + 2 * M)};
        pg8::gemm_phase<pg8::EpiSwiglu, pg8::StaticOrder, true, true>(F.lds, g, S, E);
    } SEAM(9);
    if (IN(10)) {
        pg8::Gemm g{WSP(bf16, WS_R + R_ACT), WSP(bf16, WS_W2D), M, D, FF}; pg8::StaticOrder S; S.init(M, D, F.G, cid, 4);
        pg8::EpiResid E{nullptr, WSP(bf16, WS_R + R_X2B), F.in[21], F.out, nullptr, nullptr, nullptr, nullptr, 0.5f};
        pg8::gemm_phase<pg8::EpiResid, pg8::StaticOrder, true, true>(F.lds, g, S, E);
    } SEAM(10);
    if (IN(11)) { p11_final(F); }
#undef IN
#undef SEAM
}

extern "C" void kernel_launch(void* const* d_in, const int* in_sizes, int n_in, void* d_out, int out_size, void* d_ws, size_t ws_size, hipStream_t stream) {
    static int grid = 0;
    if (grid == 0) {
        if (n_in != 26 || in_sizes[0] != M * D || out_size != M * D || ws_size < WS_END) { fprintf(stderr, "kernel_launch: unexpected problem (n_in %d, ws %zu < %zu)\n", n_in, ws_size, (size_t)WS_END); grid = -1; return; }
        int dev = 0, cus = 0, per_cu = 0;
        if (hipGetDevice(&dev) != hipSuccess || hipDeviceGetAttribute(&cus, hipDeviceAttributeMultiprocessorCount, dev) != hipSuccess) { grid = -1; return; }
        if (hipFuncSetAttribute((const void*)mk_fwd, hipFuncAttributeMaxDynamicSharedMemorySize, LDS_BYTES) != hipSuccess) { grid = -1; return; }
        if (hipOccupancyMaxActiveBlocksPerMultiprocessor(&per_cu, (const void*)mk_fwd, NWAVES * 64, LDS_BYTES) != hipSuccess || per_cu < 1) fprintf(stderr, "kernel_launch: occupancy query reports %d\n", per_cu);
        (void)hipGetLastError();
        grid = cus;
    }
    if (grid < 0) return;
    (void)hipMemsetAsync((char*)d_ws + WS_CTL, 0, CTL_BYTES, stream);
    Args a{};
    for (int i = 0; i < 26; ++i) a.in[i] = (const float*)d_in[i];
    a.out = (float*)d_out; a.ws = (unsigned char*)d_ws;
    constexpr int NL_ = MK_N_LAUNCHES;
    for (int li = 0; li < NL_; ++li) {
        a.ph_lo = (NL_ == 1) ? 0 : li; a.ph_hi = (NL_ == 1) ? N_PHASES : li + 1;
        hipLaunchKernelGGL(mk_fwd, dim3(grid), dim3(NWAVES * 64), LDS_BYTES, stream, a);
    }
}
```

```cpp
#include <hip/hip_runtime.h>
#include <cstdio>
#include <cstdint>
namespace pg8 {
#define PG8_LAS __attribute__((address_space(3)))
typedef unsigned short bf16_t;
typedef short bf16x8 __attribute__((ext_vector_type(8)));
typedef float f32x4 __attribute__((ext_vector_type(4)));
typedef unsigned u32x4 __attribute__((ext_vector_type(4)));
constexpr int BM = 256, BK = 64, HALF = 128, HTB = HALF * BK * 2  , STAGE_BYTES = 8 * HTB, NXCD = 8, WGM = 8;

__host__ __device__ __forceinline__ int lds_byte(int r, int c) { const int st = (r >> 4) * 2 + (c >> 5), rr = r & 15, cc = c & 31, ob = rr * 64 + cc * 2; return st * 1024 + (ob ^ (((ob >> 9) & 1) << 5)); }
__host__ __device__ __forceinline__ void stage_rc(int b, int& R, int& C) { const int st = b / 1024, sb = b % 1024, swz = sb ^ (((sb >> 9) & 1) << 5); R = (st >> 1) * 16 + swz / 64; C = (st & 1) * 32 + (swz % 64) / 2; }
__host__ __device__ __forceinline__ int perm32(int rho) { const int n = rho >> 4, i = rho & 15; return 8 * (i >> 2) + 4 * n + (i & 3); }

struct Unit { int pm, pn; };
struct Gemm { const bf16_t* A; const bf16_t* Bt; int M, N, K, lda; };

struct StaticOrder {
    int nM, nN, nwg, G, c, wgm, hsel;
    __host__ __device__ void init(int M, int N, int G_, int c_, int wgm_ = WGM) { nM = M / BM; nN = N / BM; nwg = nM * nN; G = G_; c = c_; wgm = wgm_; hsel = -1; }
    __host__ __device__ bool next(int i, Unit& u) const {
        const long L = (long)i * G + c; if (L >= nwg) return false;
        int wgid = (int)L; { const int q = nwg / NXCD, r = nwg % NXCD, xcd = wgid % NXCD, off = wgid / NXCD; wgid = (xcd < r ? xcd * (q + 1) : r * (q + 1) + (xcd - r) * q) + off; }
        const int nig = wgm * nN, gid = wgid / nig, fm = gid * wgm, gsz = (nM - fm) < wgm ? (nM - fm) : wgm;
        u.pm = fm + ((wgid % nig) % gsz); u.pn = (wgid % nig) / gsz; if (hsel >= 0) u.pm = (u.pm >> 4) * 32 + (u.pm & 15) + 16 * hsel; return true;
    }
    __device__ __forceinline__ void a_ready(const Unit&) const {}
    __device__ __forceinline__ void done(const Unit&) const {}
};


typedef __bf16 bf16n2 __attribute__((ext_vector_type(2)));
__device__ __forceinline__ unsigned cvt_pk_bf16(float lo, float hi) { bf16n2 v; v.x = (__bf16)lo; v.y = (__bf16)hi; return __builtin_bit_cast(unsigned, v); }
__device__ __forceinline__ float fast_sigmoid(float z) { return __builtin_amdgcn_rcpf(1.0f + __builtin_amdgcn_exp2f(-1.44269504f * z)); }
__device__ __forceinline__ float fast_silu(float z) { return z * fast_sigmoid(z); }
constexpr float SS_SCALE = 16777216.0f;
__device__ __forceinline__ float inv_rms_from_val(unsigned long long v) {
    const float tot = (float)v * (1.0f / SS_SCALE);
    return 1.0f / sqrtf(tot * (1.0f / 2048.0f) + 1e-6f);
}
__device__ __forceinline__ u32x4 pack8(const f32x4 v0, const f32x4 v1) { u32x4 w; w.x = cvt_pk_bf16(v0[0], v0[1]); w.y = cvt_pk_bf16(v0[2], v0[3]); w.z = cvt_pk_bf16(v1[0], v1[1]); w.w = cvt_pk_bf16(v1[2], v1[3]); return w; }

struct InvTab {
    const PG8_LAS float* tab; int t0, t1, t2, t3; const unsigned long long* ss;
    __device__ __forceinline__ int slot(int pm) const { return pm == t0 ? 0 : (pm == t1 ? 1 : (pm == t2 ? 2 : (pm == t3 ? 3 : -1))); }
    __device__ __forceinline__ void get(float (&inv)[2][4], int pm, int r0) const {
        const int sl = slot(pm);
        if (sl >= 0) {
#pragma unroll
            for (int ai = 0; ai < 2; ++ai)
#pragma unroll
                for (int m = 0; m < 4; ++m) inv[ai][m] = tab[sl * BM + r0 + ai * HALF + m * 16];
        } else { unsigned long long sv[2][4];
#pragma unroll
            for (int ai = 0; ai < 2; ++ai)
#pragma unroll
                for (int m = 0; m < 4; ++m) sv[ai][m] = ss[pm * BM + r0 + ai * HALF + m * 16];
#pragma unroll
            for (int ai = 0; ai < 2; ++ai)
#pragma unroll
                for (int m = 0; m < 4; ++m) inv[ai][m] = inv_rms_from_val(sv[ai][m]); }
    }
};
template <class Sched> __device__ __forceinline__ InvTab inv_preload(PG8_LAS float* tab, const Sched& S, const unsigned long long* ss) {
    InvTab T; T.tab = tab; T.t0 = -1; T.t1 = -1; T.t2 = -1; T.t3 = -1; T.ss = ss; int n = 0; Unit u;
    for (int i = 0; S.next(i, u); ++i) {
        if (T.slot(u.pm) < 0 && n < 4) {
            if (threadIdx.x < BM) tab[n * BM + threadIdx.x] = inv_rms_from_val(ss[u.pm * BM + threadIdx.x]);
            if (n == 0) T.t0 = u.pm; else if (n == 1) T.t1 = u.pm; else if (n == 2) T.t2 = u.pm; else T.t3 = u.pm;
            ++n; } }
    __syncthreads();
    return T;
}
struct EpiSwiglu {
    static constexpr bool PERM = true, AFTER_DRAIN = false;
    bf16_t* O; int ldc; InvTab it;
    __device__ __forceinline__ void operator()(const f32x4 (&acc)[2][2][4][2], const Unit& u, int wr, int wc, int fr, int fq) const {
        const int row0 = u.pm * BM + wr * 64 + fr, col0 = u.pn * HALF + wc * 32 + 8 * fq;
        float invs[2][4]; it.get(invs, u.pm, wr * 64 + fr);
#pragma unroll
        for (int ai = 0; ai < 2; ++ai)
#pragma unroll
            for (int m = 0; m < 4; ++m) { const int row = row0 + ai * HALF + m * 16; const float inv = invs[ai][m];
                f32x4 o[2];
#pragma unroll
                for (int n = 0; n < 2; ++n) { const f32x4 g = acc[ai][0][m][n] * inv, up = acc[ai][1][m][n] * inv;
#pragma unroll
                    for (int j = 0; j < 4; ++j) o[n][j] = fast_silu(g[j]) * up[j]; }
                *(u32x4*)(O + (size_t)row * ldc + col0) = pack8(o[0], o[1]); }
    }
};
struct EpiResid {
    static constexpr bool PERM = true, AFTER_DRAIN = false;
    const float* rf; const bf16_t* rb; const float* rbg; float* out; bf16_t* ob; const float* gain; bf16_t* ob2; unsigned long long* ss; float alpha; int prb, pob, pob2;
    __device__ __forceinline__ void operator()(const f32x4 (&acc)[2][2][4][2], const Unit& u, int wr, int wc, int fr, int fq) const {
        const int row0 = u.pm * BM + wr * 64 + fr, col0 = u.pn * BM + wc * 32 + 8 * fq;
        f32x4 gi[2][2], go[2][2];
#pragma unroll
        for (int bj = 0; bj < 2; ++bj)
#pragma unroll
            for (int n = 0; n < 2; ++n) { gi[bj][n] = (f32x4){1.f, 1.f, 1.f, 1.f}; go[bj][n] = gi[bj][n];
                if (rbg) { const f32x4 t = *(const f32x4*)(rbg + col0 + bj * HALF + 4 * n); gi[bj][n] = (f32x4){1.0f / t[0], 1.0f / t[1], 1.0f / t[2], 1.0f / t[3]}; }
                if (ob) go[bj][n] = *(const f32x4*)(gain + col0 + bj * HALF + 4 * n); }
#pragma unroll
        for (int ai = 0; ai < 2; ++ai)
#pragma unroll
            for (int m = 0; m < 4; ++m) { const int row = row0 + ai * HALF + m * 16; const size_t off = (size_t)row * 2048 + col0, offr = (size_t)row * prb + col0, offo = (size_t)row * pob + col0, offo2 = (size_t)row * pob2 + col0; float s = 0.f;
#pragma unroll
                for (int bj = 0; bj < 2; ++bj) {
                    f32x4 r0, r1;
                    if (rf) { r0 = *(const f32x4*)(rf + off + bj * HALF); r1 = *(const f32x4*)(rf + off + bj * HALF + 4); }
                    else { const u32x4 w = *(const u32x4*)(rb + offr + bj * HALF);
                        r0 = (f32x4){__builtin_bit_cast(float, w.x << 16), __builtin_bit_cast(float, w.x & 0xffff0000u), __builtin_bit_cast(float, w.y << 16), __builtin_bit_cast(float, w.y & 0xffff0000u)} * gi[bj][0];
                        r1 = (f32x4){__builtin_bit_cast(float, w.z << 16), __builtin_bit_cast(float, w.z & 0xffff0000u), __builtin_bit_cast(float, w.w << 16), __builtin_bit_cast(float, w.w & 0xffff0000u)} * gi[bj][1]; }
                    const f32x4 o0 = r0 + acc[ai][bj][m][0] * alpha, o1 = r1 + acc[ai][bj][m][1] * alpha;
                    if (out) { *(f32x4*)(out + off + bj * HALF) = o0; *(f32x4*)(out + off + bj * HALF + 4) = o1; }
                    if (ob) *(u32x4*)(ob + offo + bj * HALF) = pack8(o0 * go[bj][0], o1 * go[bj][1]);
                    if (ob2) *(u32x4*)(ob2 + offo2 + bj * HALF) = pack8(o0, o1);
                    s += (o0[0] * o0[0] + o0[1] * o0[1]) + (o0[2] * o0[2] + o0[3] * o0[3]) + (o1[0] * o1[0] + o1[1] * o1[1]) + (o1[2] * o1[2] + o1[3] * o1[3]); }
                if (ss) { s += __shfl_xor(s, 16); s += __shfl_xor(s, 32);
                    if (fq == 0) atomicAdd(ss + row, (unsigned long long)(s * SS_SCALE + 0.5f)); } }
    }
};
struct EpiFinal {
    static constexpr bool PERM = true, AFTER_DRAIN = false;
    const bf16_t* rb; int prb; const float* rbg; const float* fgain; float* out; unsigned long long* ss; unsigned* cnt; unsigned* tmo; float alpha; unsigned npn;
    __device__ __forceinline__ void operator()(f32x4 (&acc)[2][2][4][2], const Unit& u, int wr, int wc, int fr, int fq) const {
        const int row0 = u.pm * BM + wr * 64 + fr, col0 = u.pn * BM + wc * 32 + 8 * fq;
        { f32x4 gi[2][2];
#pragma unroll
          for (int bj = 0; bj < 2; ++bj)
#pragma unroll
            for (int n = 0; n < 2; ++n) { const f32x4 t = *(const f32x4*)(rbg + col0 + bj * HALF + 4 * n); gi[bj][n] = (f32x4){1.0f / t[0], 1.0f / t[1], 1.0f / t[2], 1.0f / t[3]}; }
#pragma unroll
          for (int ai = 0; ai < 2; ++ai)
#pragma unroll
            for (int m = 0; m < 4; ++m) { const int row = row0 + ai * HALF + m * 16; const size_t offr = (size_t)row * prb + col0; float s = 0.f;
#pragma unroll
                for (int bj = 0; bj < 2; ++bj) { const u32x4 w = *(const u32x4*)(rb + offr + bj * HALF);
                    const f32x4 r0 = (f32x4){__builtin_bit_cast(float, w.x << 16), __builtin_bit_cast(float, w.x & 0xffff0000u), __builtin_bit_cast(float, w.y << 16), __builtin_bit_cast(float, w.y & 0xffff0000u)} * gi[bj][0];
                    const f32x4 r1 = (f32x4){__builtin_bit_cast(float, w.z << 16), __builtin_bit_cast(float, w.z & 0xffff0000u), __builtin_bit_cast(float, w.w << 16), __builtin_bit_cast(float, w.w & 0xffff0000u)} * gi[bj][1];
                    const f32x4 o0 = r0 + acc[ai][bj][m][0] * alpha, o1 = r1 + acc[ai][bj][m][1] * alpha; acc[ai][bj][m][0] = o0; acc[ai][bj][m][1] = o1;
                    s += (o0[0] * o0[0] + o0[1] * o0[1]) + (o0[2] * o0[2] + o0[3] * o0[3]) + (o1[0] * o1[0] + o1[1] * o1[1]) + (o1[2] * o1[2] + o1[3] * o1[3]); }
                s += __shfl_xor(s, 16); s += __shfl_xor(s, 32);
                if (fq == 0) atomicAdd(ss + row, (unsigned long long)(s * SS_SCALE + 0.5f)); } }
        asm volatile("s_waitcnt vmcnt(0)" ::: "memory"); __syncthreads();
        if (threadIdx.x == 0) { unsigned* c = cnt + u.pm;
            (void)__hip_atomic_fetch_add(c, 1u, __ATOMIC_RELAXED, __HIP_MEMORY_SCOPE_AGENT);
            unsigned sp = 0;
            while (__hip_atomic_load(c, __ATOMIC_RELAXED, __HIP_MEMORY_SCOPE_AGENT) < npn) { __builtin_amdgcn_s_sleep(1);
                if ((++sp & 255u) == 0u) { if (__hip_atomic_load(tmo, __ATOMIC_RELAXED, __HIP_MEMORY_SCOPE_AGENT)) break; if (sp > (1u << 18)) { atomicAdd(tmo, 1u); break; } } }
        }
        __syncthreads();
        f32x4 fg[2][2];
#pragma unroll
        for (int bj = 0; bj < 2; ++bj)
#pragma unroll
            for (int n = 0; n < 2; ++n) fg[bj][n] = *(const f32x4*)(fgain + col0 + bj * HALF + 4 * n);
#pragma unroll
        for (int ai = 0; ai < 2; ++ai)
#pragma unroll
            for (int m = 0; m < 4; ++m) { const int row = row0 + ai * HALF + m * 16; const size_t off = (size_t)row * 2048 + col0;
                const float inv = inv_rms_from_val(__hip_atomic_load(ss + row, __ATOMIC_RELAXED, __HIP_MEMORY_SCOPE_AGENT));
#pragma unroll
                for (int bj = 0; bj < 2; ++bj) { *(f32x4*)(out + off + bj * HALF) = acc[ai][bj][m][0] * inv * fg[bj][0]; *(f32x4*)(out + off + bj * HALF + 4) = acc[ai][bj][m][1] * inv * fg[bj][1]; } }
    }
};
struct EpiInProj {
    static constexpr bool PERM = true, AFTER_DRAIN = false;
    bf16_t* rkv; float* lin; bf16_t* hg; InvTab it; const PG8_LAS float* oml; int pn0;
    __device__ __forceinline__ void operator()(const f32x4 (&acc)[2][2][4][2], const Unit& u, int wr, int wc, int fr, int fq) const {
        const int row0 = u.pm * BM + wr * 64 + fr, cin = wc * 32 + 8 * fq;
        const int pn = u.pn + pn0;
        float invs[2][4]; it.get(invs, u.pm, wr * 64 + fr);
        int mode;
        if (pn < 12) mode = 0; else if (pn < 14) mode = 1; else { const int sg = (pn - 14) >> 2; mode = (sg == 0 || sg == 3) ? 2 : (sg == 1 ? 3 : 4); }
#pragma unroll
        for (int bj = 0; bj < 2; ++bj) {
            f32x4 om0 = (f32x4){0.f, 0.f, 0.f, 0.f}, om1 = om0;
            if (mode == 3) { const PG8_LAS float* lp = oml + (pn - 18) * BM + bj * HALF + cin; om0 = *(const PG8_LAS f32x4*)lp; om1 = *(const PG8_LAS f32x4*)(lp + 4); }
#pragma unroll
            for (int ai = 0; ai < 2; ++ai)
#pragma unroll
                for (int m = 0; m < 4; ++m) { const int row = row0 + ai * HALF + m * 16; const float inv = invs[ai][m];
                    f32x4 v0 = acc[ai][bj][m][0] * inv, v1 = acc[ai][bj][m][1] * inv;
                    if (mode == 0) { *(u32x4*)(rkv + (size_t)row * 3072 + pn * BM + bj * HALF + cin) = pack8(v0, v1); }
                    else if (mode == 1) { const int cl = (pn - 12) * BM + bj * HALF + cin;
                        if (cl < 288) { *(f32x4*)(lin + (size_t)row * 288 + cl) = v0; *(f32x4*)(lin + (size_t)row * 288 + cl + 4) = v1; } }
                    else {
                        if (mode == 2) {
#pragma unroll
                            for (int j = 0; j < 4; ++j) { v0[j] = fast_silu(v0[j]); v1[j] = fast_silu(v1[j]); } }
                        else if (mode == 3) {
#pragma unroll
                            for (int j = 0; j < 4; ++j) { v0[j] = __logf(1.0f - om0[j] * fast_sigmoid(-v0[j])); v1[j] = __logf(1.0f - om1[j] * fast_sigmoid(-v1[j])); } }
                        *(u32x4*)(hg + (size_t)row * 4096 + (pn - 14) * BM + bj * HALF + cin) = pack8(v0, v1); } } }
    }
};
struct EpiLora {
    static constexpr bool PERM = true, AFTER_DRAIN = false;
    bf16_t* lout; const PG8_LAS float* bias; int pn0;
    __device__ __forceinline__ void operator()(const f32x4 (&acc)[2][2][4][2], const Unit& u, int wr, int wc, int fr, int fq) const {
        const int row0 = u.pm * BM + wr * 64 + fr, cin = wc * 32 + 8 * fq;
        const int pn = u.pn + pn0, mode = pn >> 2;
#pragma unroll
        for (int bj = 0; bj < 2; ++bj) {
            f32x4 b0 = (f32x4){0.f, 0.f, 0.f, 0.f}, b1 = b0;
            if (mode < 2) { const PG8_LAS float* bp = bias + pn * BM + bj * HALF + cin; b0 = *(const PG8_LAS f32x4*)bp; b1 = *(const PG8_LAS f32x4*)(bp + 4); }
#pragma unroll
            for (int ai = 0; ai < 2; ++ai)
#pragma unroll
                for (int m = 0; m < 4; ++m) { const int row = row0 + ai * HALF + m * 16;
                    f32x4 v0 = acc[ai][bj][m][0] + b0, v1 = acc[ai][bj][m][1] + b1;
#pragma unroll
                    for (int j = 0; j < 4; ++j) { const float s0 = fast_sigmoid(v0[j]), s1 = fast_sigmoid(v1[j]);
                        const float d0 = -0.60653066f * s0, d1 = -0.60653066f * s1;
                        v0[j] = mode == 0 ? d0 : (mode == 1 ? s0 : v0[j]); v1[j] = mode == 0 ? d1 : (mode == 1 ? s1 : v1[j]); }
                    *(u32x4*)(lout + (size_t)row * 3072 + pn * BM + bj * HALF + cin) = pack8(v0, v1); asm volatile("" ::: "memory"); } }
    }
};
template <class Epi, class Sched, bool ALIGN_EPI = false, bool SP2 = false>
__device__ __forceinline__ void gemm_phase(PG8_LAS unsigned char* lds, const Gemm g, const Sched& S, const Epi& E) {
    const int tid = threadIdx.x, wid = __builtin_amdgcn_readfirstlane(tid >> 6), lane = tid & 63, wr = wid >> 2, wc = wid & 3, fr = lane & 15, fq = lane >> 4;
    const int K = g.K, nt = K / BK, lda = g.lda ? g.lda : g.K;
    unsigned voffA[2], voffB[2];
#pragma unroll
    for (int i = 0; i < 2; ++i) { int R, C; stage_rc(tid * 16 + i * 8192, R, C); const int Rb = Epi::PERM ? ((R & ~31) + perm32(R & 31)) : R;
        voffA[i] = (unsigned)(R * lda + C) * 2u; voffB[i] = (unsigned)(Rb * K + C) * 2u; }
    const size_t kstep = (size_t)(BK * 2);
    const size_t hstep = (size_t)HALF * K * 2, hstepA = (size_t)HALF * lda * 2;
    const size_t tstep = 2 * hstep, tstepA = 2 * hstepA;
    const unsigned ldsw = (unsigned)wid * 1024u;
    const int aoff = lds_byte(wr * 64 + fr, fq * 8), boff = lds_byte(wc * 32 + fr, fq * 8);
#define PG8_SA(b, h) (((b) * 2 + (h)) * HTB)
#define PG8_SB(b, h) ((4 + (b) * 2 + (h)) * HTB)
#define PG8_STAGE(bufoff, gbase, voff) do { _Pragma("unroll") for (int _i = 0; _i < 2; ++_i) \
        __builtin_amdgcn_global_load_lds((const unsigned*)((const char*)(gbase) + (voff)[_i]), (PG8_LAS unsigned*)(lds + (bufoff) + ldsw + _i * 8192), 16, 0, 0); } while (0)
#define PG8_LDA(dst, b, h) do { _Pragma("unroll") for (int m = 0; m < 4; ++m) _Pragma("unroll") for (int k = 0; k < 2; ++k) dst[m][k] = *(const PG8_LAS bf16x8*)(lds + PG8_SA(b, h) + aoff + m * 2048 + k * 1024); } while (0)
#define PG8_LDB(dst, b, h) do { _Pragma("unroll") for (int n = 0; n < 2; ++n) _Pragma("unroll") for (int k = 0; k < 2; ++k) dst[n][k] = *(const PG8_LAS bf16x8*)(lds + PG8_SB(b, h) + boff + n * 2048 + k * 1024); } while (0)
#define PG8_MMA(ai, bj, At, Bt) do { __builtin_amdgcn_s_setprio(1); _Pragma("unroll") for (int m = 0; m < 4; ++m) _Pragma("unroll") for (int n = 0; n < 2; ++n) _Pragma("unroll") for (int k = 0; k < 2; ++k) \
        acc[ai][bj][m][n] = __builtin_amdgcn_mfma_f32_16x16x32_bf16(Bt[n][k], At[m][k], acc[ai][bj][m][n], 0, 0, 0); __builtin_amdgcn_s_setprio(0); } while (0)
#define PG8_WAIT_V(n) asm volatile("s_waitcnt vmcnt(" #n ")" ::: "memory")
#define PG8_WAIT_L(n) asm volatile("s_waitcnt lgkmcnt(" #n ")" ::: "memory")
#define PG8_BAR __builtin_amdgcn_s_barrier()
#define PG8_SCHED __builtin_amdgcn_sched_barrier(0)
    Unit cur, nxt; int ui = 0;
    if (!S.next(0, cur)) return;
    f32x4 acc[2][2][4][2];
#pragma unroll
    for (int a = 0; a < 2; ++a)
#pragma unroll
        for (int b = 0; b < 2; ++b)
#pragma unroll
            for (int m = 0; m < 4; ++m)
#pragma unroll
                for (int n = 0; n < 2; ++n) acc[a][b][m][n] = (f32x4){0.f, 0.f, 0.f, 0.f};
    bf16x8 At[4][2], B0[2][2], B1[2][2];
    const char* cA = (const char*)g.A + (size_t)cur.pm * tstepA; const char* cB = (const char*)g.Bt + (size_t)cur.pn * tstep;
    S.a_ready(cur);
    if constexpr (SP2) {
        PG8_STAGE(PG8_SB(0, 0), cB, voffB); PG8_STAGE(PG8_SB(0, 1), cB + hstep, voffB); PG8_STAGE(PG8_SA(0, 0), cA, voffA); PG8_STAGE(PG8_SA(0, 1), cA + hstepA, voffA);
        if (wr == 1) PG8_BAR;
        PG8_WAIT_V(2); PG8_BAR;
        PG8_STAGE(PG8_SB(1, 0), cB + kstep, voffB); PG8_STAGE(PG8_SA(1, 0), cA + kstep, voffA); PG8_STAGE(PG8_SB(1, 1), cB + hstep + kstep, voffB);
        PG8_WAIT_V(6); PG8_BAR;
    } else {
        PG8_STAGE(PG8_SB(0, 0), cB, voffB); PG8_STAGE(PG8_SA(0, 0), cA, voffA); PG8_STAGE(PG8_SB(0, 1), cB + hstep, voffB); PG8_STAGE(PG8_SA(0, 1), cA + hstepA, voffA);
        if (wr == 1) PG8_BAR;
        PG8_WAIT_V(4); PG8_BAR;
        PG8_STAGE(PG8_SB(1, 0), cB + kstep, voffB); PG8_STAGE(PG8_SA(1, 0), cA + kstep, voffA); PG8_STAGE(PG8_SB(1, 1), cB + hstep + kstep, voffB);
        PG8_WAIT_V(6); PG8_BAR;
    }
    for (;;) {
        const bool has_next = S.next(ui + 1, nxt);
        const char* nA = has_next ? (const char*)g.A + (size_t)nxt.pm * tstepA : cA; const char* nB = has_next ? (const char*)g.Bt + (size_t)nxt.pn * tstep : cB;
        for (int t = 0; t < nt; t += 2) {
            const bool last = (t == nt - 2);
            const char* a1 = cA + (size_t)(t + 1) * kstep;
            const char* a2 = last ? nA : cA + (size_t)(t + 2) * kstep; const char* b2 = last ? nB : cB + (size_t)(t + 2) * kstep;
            const char* a3 = a2 + kstep; const char* b3 = b2 + kstep;
            if (last && has_next) S.a_ready(nxt);
            if constexpr (SP2) {
            PG8_LDB(B0, 0, 0); PG8_LDB(B1, 0, 1); PG8_SCHED; PG8_LDA(At, 0, 0); PG8_STAGE(PG8_SA(1, 1), a1 + hstepA, voffA);
            PG8_WAIT_V(8); PG8_WAIT_L(0); PG8_BAR; PG8_MMA(0, 0, At, B0); PG8_MMA(0, 1, At, B1); PG8_BAR; PG8_SCHED;
            PG8_LDA(At, 0, 1); PG8_STAGE(PG8_SB(0, 0), b2, voffB); PG8_STAGE(PG8_SB(0, 1), b2 + hstep, voffB); PG8_STAGE(PG8_SA(0, 0), a2, voffA);
            PG8_WAIT_V(8); PG8_WAIT_L(0); PG8_BAR; PG8_MMA(1, 0, At, B0); PG8_MMA(1, 1, At, B1); PG8_BAR; PG8_SCHED;
            PG8_LDB(B0, 1, 0); PG8_LDB(B1, 1, 1); PG8_SCHED; PG8_LDA(At, 1, 0); PG8_STAGE(PG8_SA(0, 1), a2 + hstepA, voffA);
            PG8_WAIT_V(8); PG8_WAIT_L(0); PG8_BAR; PG8_MMA(0, 0, At, B0); PG8_MMA(0, 1, At, B1); PG8_BAR; PG8_SCHED;
            PG8_LDA(At, 1, 1); PG8_STAGE(PG8_SB(1, 0), b3, voffB); PG8_STAGE(PG8_SB(1, 1), b3 + hstep, voffB); PG8_STAGE(PG8_SA(1, 0), a3, voffA);
            PG8_WAIT_V(8); PG8_WAIT_L(0); PG8_BAR; PG8_MMA(1, 0, At, B0); PG8_MMA(1, 1, At, B1); PG8_BAR; PG8_SCHED;
            } else {
            PG8_LDB(B0, 0, 0); PG8_SCHED; PG8_LDA(At, 0, 0); PG8_STAGE(PG8_SA(1, 1), a1 + hstepA, voffA);
            PG8_WAIT_L(8); PG8_BAR; PG8_WAIT_L(0); PG8_MMA(0, 0, At, B0); PG8_BAR; PG8_SCHED;
            PG8_LDB(B1, 0, 1); PG8_STAGE(PG8_SB(0, 0), b2, voffB);
            PG8_BAR; PG8_WAIT_L(0); PG8_MMA(0, 1, At, B1); PG8_BAR;
            PG8_LDA(At, 0, 1); PG8_STAGE(PG8_SA(0, 0), a2, voffA);
            PG8_BAR; PG8_WAIT_L(0); PG8_MMA(1, 0, At, B0); PG8_BAR; PG8_SCHED;
            PG8_STAGE(PG8_SB(0, 1), b2 + hstep, voffB);
            PG8_WAIT_V(6); PG8_BAR; PG8_MMA(1, 1, At, B1); PG8_BAR;
            PG8_LDB(B0, 1, 0); PG8_SCHED; PG8_LDA(At, 1, 0); PG8_STAGE(PG8_SA(0, 1), a2 + hstepA, voffA);
            PG8_WAIT_L(8); PG8_BAR; PG8_WAIT_L(0); PG8_MMA(0, 0, At, B0); PG8_BAR; PG8_SCHED;
            PG8_LDB(B1, 1, 1); PG8_STAGE(PG8_SB(1, 0), b3, voffB);
            PG8_BAR; PG8_WAIT_L(0); PG8_MMA(0, 1, At, B1); PG8_BAR;
            PG8_LDA(At, 1, 1); PG8_STAGE(PG8_SA(1, 0), a3, voffA);
            PG8_BAR; PG8_WAIT_L(0); PG8_MMA(1, 0, At, B0); PG8_BAR; PG8_SCHED;
            PG8_STAGE(PG8_SB(1, 1), b3 + hstep, voffB);
            PG8_WAIT_V(6); PG8_BAR; PG8_MMA(1, 1, At, B1); PG8_BAR;
            }
        }
        if constexpr (ALIGN_EPI) { if (wr == 0) PG8_BAR; }
        if constexpr (!Epi::AFTER_DRAIN) { E(acc, cur, wr, wc, fr, fq); S.done(cur); }
        if (!has_next) break;
#pragma unroll
        for (int a = 0; a < 2; ++a)
#pragma unroll
            for (int b = 0; b < 2; ++b)
#pragma unroll
                for (int m = 0; m < 4; ++m)
#pragma unroll
                    for (int n = 0; n < 2; ++n) acc[a][b][m][n] = (f32x4){0.f, 0.f, 0.f, 0.f};
        cur = nxt; cA = nA; cB = nB; ++ui;
        if constexpr (ALIGN_EPI) { if (wr == 1) PG8_BAR; }
    }
    PG8_WAIT_V(0);
    if constexpr (!ALIGN_EPI) { if (wr == 0) PG8_BAR; }
    PG8_BAR;
    if constexpr (Epi::AFTER_DRAIN) { E.fused(acc, cur, wr, wc, fr, fq, lds, wid, lane); S.done(cur); }
#undef PG8_SA
#undef PG8_SB
#undef PG8_STAGE
#undef PG8_LDA
#undef PG8_LDB
#undef PG8_MMA
#undef PG8_WAIT_V
#undef PG8_WAIT_L
#undef PG8_BAR
#undef PG8_SCHED
}
}

constexpr int NWAVES = 8;
constexpr int BATCH = 4, SEQ = 8192, D = 2048, M = BATCH * SEQ, FF = 5632;
constexpr int RC = 1024, RH = 16, RN = 64;
constexpr int HC = 1024, HH = 8, HD = 128;
constexpr int RWKV_COLS = 3360, IN_COLS = 7456, NIN = 7680;
constexpr int KL = 384, NL = 3072;
#ifndef MK_N_LAUNCHES
#define MK_N_LAUNCHES 1
#endif
constexpr int N_PHASES = 12;

constexpr size_t WS_CTL = 0, CTL_BYTES = 1u << 20;
constexpr size_t WS_W1GU = CTL_BYTES;
constexpr size_t WS_W1D = WS_W1GU + (size_t)2 * FF * D * 2;
constexpr size_t WS_WIN = WS_W1D + (size_t)D * FF * 2;
constexpr size_t WS_WLORA = WS_WIN + (size_t)NIN * D * 2;
constexpr size_t WS_WOUT = WS_WLORA + (size_t)NL * KL * 2;
constexpr size_t WS_W2GU = WS_WOUT + (size_t)D * D * 2;
constexpr size_t WS_W2D = WS_W2GU + (size_t)2 * FF * D * 2;
constexpr size_t WS_SS = WS_W2D + (size_t)D * FF * 2;
constexpr size_t WS_XB = WS_SS + (1u << 20);
constexpr size_t WS_R = WS_XB + (size_t)M * D * 2;
constexpr size_t R_ACT = 0;
constexpr size_t R_RKV = 0;
constexpr size_t R_HG = R_RKV + (size_t)M * 3072 * 2;
constexpr size_t R_LIN = R_HG + (size_t)M * 4096 * 2;
constexpr size_t R_BYTES = R_LIN + (size_t)M * 288 * 4;
constexpr size_t WS_ALORA = WS_R + R_BYTES;
constexpr size_t WS_LOUT = WS_ALORA + (size_t)M * KL * 2;
constexpr size_t WS_INVN = WS_LOUT + (size_t)M * NL * 2;
constexpr size_t WS_END = WS_INVN + (size_t)M * RH * 4;
static_assert(WS_END <= ((size_t)1 << 30), "d_ws map");
constexpr int CW_PCNT = 8704;
constexpr int CW_SIG_HALF = 8192, CW_SIG_SHA = 8256, CW_SIG_SHB = 8320;
constexpr int CW_BAR = 4096;

constexpr int RING_BYTES = 162816;
constexpr int LDSCTL_OFF = RING_BYTES, MISC_OFF = LDSCTL_OFF + 320;
constexpr int LDS_BYTES = 163840;
static_assert(MISC_OFF + 128 <= LDS_BYTES, "LDS map");

#define GAS __attribute__((address_space(1)))
#define LAS __attribute__((address_space(3)))
typedef unsigned short bf16;
typedef unsigned v4u __attribute__((ext_vector_type(4)));
typedef unsigned v2u __attribute__((ext_vector_type(2)));
typedef float f32x4 __attribute__((ext_vector_type(4)));
#define LDS_WAIT() asm volatile("s_waitcnt lgkmcnt(0)" ::: "memory")
#define VM_WAIT() asm volatile("s_waitcnt vmcnt(0)" ::: "memory")
__device__ __forceinline__ float bflo(unsigned u) { return __builtin_bit_cast(float, u << 16); }
__device__ __forceinline__ float bfhi(unsigned u) { return __builtin_bit_cast(float, u & 0xffff0000u); }
__device__ __forceinline__ f32x4 unpack4(v2u w) { return (f32x4){bflo(w.x), bfhi(w.x), bflo(w.y), bfhi(w.y)}; }
__device__ __forceinline__ unsigned pk2(float lo, float hi) { return pg8::cvt_pk_bf16(lo, hi); }
__device__ __forceinline__ v2u pack4(f32x4 v) { v2u w; w.x = pk2(v[0], v[1]); w.y = pk2(v[2], v[3]); return w; }
using pg8::fast_sigmoid;
using pg8::fast_silu;
template <int CTRL> __device__ __forceinline__ float dpp_mov(float x) { return __builtin_bit_cast(float, __builtin_amdgcn_update_dpp(0, __builtin_bit_cast(int, x), CTRL, 0xF, 0xF, true)); }
__device__ __forceinline__ float row16_sum(float x) { x += dpp_mov<0x128>(x); x += dpp_mov<0x124>(x); x += dpp_mov<0x122>(x); x += dpp_mov<0x121>(x); return x; }
template <int CTRL, int BANK> __device__ __forceinline__ float dpp_upd(float old, float x) { return __builtin_bit_cast(float, __builtin_amdgcn_update_dpp(__builtin_bit_cast(int, old), __builtin_bit_cast(int, x), CTRL, 0xF, BANK, false)); }
__device__ __forceinline__ float tr_reduce16(const float (&v)[16], int lane) {
    float u[8], w[4], x[2];
#pragma unroll
    for (int s = 0; s < 8; ++s) { const float t = v[s + 8] + dpp_mov<0x128>(v[s + 8]), a = v[s] + dpp_mov<0x128>(v[s]); u[s] = dpp_upd<0xE4, 0x3>(t, a); }
#pragma unroll
    for (int s = 0; s < 4; ++s) { const float t = u[s + 4] + dpp_mov<0x141>(u[s + 4]), a = u[s] + dpp_mov<0x141>(u[s]); w[s] = dpp_upd<0xE4, 0x5>(t, a); }
    const bool b1 = (lane & 2) != 0, b0 = (lane & 1) != 0;
#pragma unroll
    for (int s = 0; s < 2; ++s) { const float K = b1 ? w[s + 2] : w[s], T = b1 ? w[s] : w[s + 2]; x[s] = K + dpp_mov<0x1B>(T); }
    const float K = b0 ? x[1] : x[0], T = b0 ? x[0] : x[1];
    return K + dpp_mov<0xB1>(T);
}
typedef float f32x2 __attribute__((ext_vector_type(2)));
#define LO2(v) __builtin_shufflevector(v, v, 0, 1)
#define HI2(v) __builtin_shufflevector(v, v, 2, 3)
__device__ __forceinline__ float wave_sum(float v) {
#pragma unroll
    for (int o = 1; o < 64; o <<= 1) v += __shfl_xor(v, o);
    return v;
}
#define XB_TMO      128
#define XB_XCNT(j)  (256  + 64 * (j))
#define XB_XSUB(j)  (1280 + 64 * (j))
#define XB_XGEN(j)  (2304 + 64 * (j))
#define XB_TOP      3328
#define XB_TOPGEN   3392
#define XCD_BAR_WORDS 3456
#define XB_SPIN_CAP (1u << 18)

__device__ __forceinline__ unsigned xb_ld(unsigned* p)              { return __hip_atomic_load(p, __ATOMIC_RELAXED, __HIP_MEMORY_SCOPE_AGENT); }
__device__ __forceinline__ unsigned xb_add(unsigned* p, unsigned v) { return __hip_atomic_fetch_add(p, v, __ATOMIC_RELAXED, __HIP_MEMORY_SCOPE_AGENT); }
__device__ __forceinline__ unsigned xb_xcc_id() { return (unsigned)__builtin_amdgcn_s_getreg((3 << 11) | 20) & 0xFu; }
#define XB_SPIN(cond, bar) do { unsigned _sp = 0; while (cond) { __builtin_amdgcn_s_sleep(1); \
    if ((++_sp & 255u) == 0u) { if (xb_ld(&(bar)[XB_TMO])) break; if (_sp > XB_SPIN_CAP) { atomicAdd(&(bar)[XB_TMO], 1u); break; } } } } while (0)

struct XcdBarrier {
    unsigned* bar; unsigned x;
    volatile LAS unsigned* st;
};

__device__ __forceinline__ XcdBarrier xcd_barrier_post(unsigned* bar, volatile LAS unsigned* st) {
    XcdBarrier b; b.bar = bar; b.x = xb_xcc_id(); b.st = st;
    if (threadIdx.x == 0) (void)xb_add(&bar[XB_XCNT(b.x)], 1u);
    return b;
}
__device__ __forceinline__ void xcd_barrier_complete(unsigned* bar, unsigned x, unsigned& nloc, unsigned& nx) {
    const unsigned G = gridDim.x * gridDim.y * gridDim.z;
    unsigned sum, cnt, mine, sp = 0u;
    for (;;) {
        sum = 0u; cnt = 0u; mine = 0u;
#pragma unroll
        for (unsigned j = 0; j < 16; ++j) { const unsigned c = xb_ld(&bar[XB_XCNT(j)]); sum += c; cnt += (c > 0u) ? 1u : 0u; mine = (j == x) ? c : mine; }
        if (sum == G) break;
        __builtin_amdgcn_s_sleep(1);
        if ((++sp & 255u) == 0u) { if (xb_ld(&bar[XB_TMO])) break; if (sp > XB_SPIN_CAP) { atomicAdd(&bar[XB_TMO], 1u); break; } }
    }
    nloc = mine > 0u ? mine : 1u; nx = cnt > 0u ? cnt : 1u;
}

__device__ __forceinline__ void xcd_barrier(const XcdBarrier& b) {
    asm volatile("s_waitcnt vmcnt(0)" ::: "memory");
    __syncthreads();
    if (threadIdx.x == 0) {
        unsigned* bar = b.bar;
        __builtin_amdgcn_s_waitcnt(0);
        unsigned nloc = b.st[0], nx = b.st[1];
        if (nloc == 0u) { xcd_barrier_complete(bar, b.x, nloc, nx); b.st[0] = nloc; b.st[1] = nx; }
        const unsigned old = xb_add(&bar[XB_XSUB(b.x)], 1u);
        const unsigned gen = old / nloc;
        if (old + 1u == (gen + 1u) * nloc) {
            __builtin_amdgcn_fence(__ATOMIC_RELEASE, "agent");
            asm volatile("s_waitcnt vmcnt(0)" ::: "memory");
            const unsigned og = xb_add(&bar[XB_TOP], 1u);
            const unsigned tg = og / nx;
            if (og + 1u == (tg + 1u) * nx) xb_add(&bar[XB_TOPGEN], 1u);
            else XB_SPIN(xb_ld(&bar[XB_TOPGEN]) == tg, bar);
            __builtin_amdgcn_fence(__ATOMIC_ACQUIRE, "agent");
            xb_add(&bar[XB_XGEN(b.x)], 1u);
            asm volatile("s_waitcnt vmcnt(0)" ::: "memory");
        } else {
            XB_SPIN(xb_ld(&bar[XB_XGEN(b.x)]) == gen, bar);
            __builtin_amdgcn_fence(__ATOMIC_ACQUIRE, "agent");
            asm volatile("s_waitcnt vmcnt(0)" ::: "memory");
        }
    }
    __syncthreads();
}

__device__ __forceinline__ void sig_post(unsigned* ctr) {
    __builtin_amdgcn_fence(__ATOMIC_RELEASE, "agent"); asm volatile("s_waitcnt vmcnt(0)" ::: "memory"); (void)xb_add(ctr, 1u);
}
__device__ __forceinline__ void wg_signal(unsigned* ctr) {
    asm volatile("s_waitcnt vmcnt(0)" ::: "memory"); __syncthreads();
    if (threadIdx.x == 0) sig_post(ctr);
}
__device__ __forceinline__ void wg_wait(unsigned* ctr, unsigned target, unsigned* bar) {
    if (threadIdx.x == 0) { XB_SPIN(xb_ld(ctr) < target, bar); __builtin_amdgcn_fence(__ATOMIC_ACQUIRE, "agent"); asm volatile("s_waitcnt vmcnt(0)" ::: "memory"); }
    __syncthreads();
}

struct Frame {
    LAS unsigned char* lds;
    int tid, lane, wave, vcu, G;
    const float* in[26];
    float* out; unsigned char* ws;
};
#define WSP(T, off) ((T*)(F.ws + (off)))
struct Args { const float* in[26]; float* out; unsigned char* ws; int ph_lo, ph_hi; };

struct P0Item { const float* W; bf16* WT; int K, N, kb, n0, drow0; };
__device__ __forceinline__ int map_gu(int n0, int which) { return (n0 >> 7) * 256 + which * 128 + (n0 & 127); }
constexpr int P0_I_GU = (D / 64) * (FF / 32), P0_I_DN = (FF / 64) * (D / 32), P0_I_IN = (D / 64) * (IN_COLS / 32), P0_I_OUT = (D / 64) * (D / 32);
constexpr int P0_N0 = 2 * P0_I_GU + P0_I_DN + P0_I_IN, P0_N1 = 2 * P0_I_GU + P0_I_DN + P0_I_OUT;
template <int SET> __device__ __forceinline__ P0Item p0_decode(Frame& F, const Args& A, int it) {
    constexpr int I_GU = P0_I_GU, I_DN = P0_I_DN, I_IN = P0_I_IN;
    P0Item p; int r = it;
    if (SET == 0) { if (r >= 2 * I_GU) r += 2 * I_GU; if (r >= 4 * I_GU + I_DN) r += I_DN; }
    else { r += 2 * I_GU; if (r >= 4 * I_GU) r += I_DN; if (r >= 4 * I_GU + 2 * I_DN) r += I_IN; }
    if (r < 4 * I_GU) { const int mat = r / I_GU; r -= mat * I_GU; const int nblk = FF / 32, ffn = mat >> 1, which = mat & 1;
        p.W = A.in[2 + 20 * ffn + which]; p.WT = WSP(bf16, ffn ? WS_W2GU : WS_W1GU); p.K = D; p.N = FF; p.kb = r / nblk; p.n0 = 32 * (r % nblk); p.drow0 = map_gu(p.n0, which); return p; }
    r -= 4 * I_GU;
    if (r < 2 * I_DN) { const int ffn = r / I_DN; r -= ffn * I_DN; const int nblk = D / 32;
        p.W = A.in[4 + 20 * ffn]; p.WT = WSP(bf16, ffn ? WS_W2D : WS_W1D); p.K = FF; p.N = D; p.kb = r / nblk; p.n0 = 32 * (r % nblk); p.drow0 = p.n0; return p; }
    r -= 2 * I_DN;
    if (r < I_IN) { const int nblk = IN_COLS / 32;
        p.W = A.in[6]; p.WT = WSP(bf16, WS_WIN); p.K = D; p.N = IN_COLS; p.kb = r / nblk; p.n0 = 32 * (r % nblk); p.drow0 = p.n0 < RWKV_COLS ? p.n0 : p.n0 + 224; return p; }
    r -= I_IN;
    { const int nblk = D / 32; p.W = A.in[20]; p.WT = WSP(bf16, WS_WOUT); p.K = D; p.N = D; p.kb = r / nblk; p.n0 = 32 * (r % nblk); p.drow0 = p.n0; return p; }
}
__device__ __forceinline__ void p0_dma(const P0Item& p, LAS unsigned char* tile, int lane) {
    const int half = lane >> 5, sl = lane & 31;
#pragma unroll 8
    for (int i = 0; i < 32; ++i) { const int kk = 2 * i + half;
        __builtin_amdgcn_global_load_lds((const GAS unsigned*)(p.W + (size_t)(64 * p.kb + kk) * p.N + p.n0 + (sl ^ (4 * (kk >> 3)))), (LAS unsigned*)(tile + i * 256), 4, 0, 0); }
}
__device__ __forceinline__ void p0_emit(const P0Item& p, const LAS float* t, int lane) {
    const int c = lane & 7;
#pragma unroll
    for (int j = 0; j < 4; ++j) { const int n = (lane >> 3) + 8 * j; const LAS float* s = t + (8 * c) * 32 + (n ^ (4 * c));
        v4u o; o.x = pk2(s[0 * 32], s[1 * 32]); o.y = pk2(s[2 * 32], s[3 * 32]); o.z = pk2(s[4 * 32], s[5 * 32]); o.w = pk2(s[6 * 32], s[7 * 32]);
        *(GAS v4u*)(p.WT + (size_t)(p.drow0 + n) * p.K + 64 * p.kb + 8 * c) = o; }
}
template <int SET> __device__ __forceinline__ void p0_transposes(Frame& F, const Args& A, int gw, int NGW) {
    LAS unsigned char* tiles = F.lds + F.wave * 16384;
    constexpr int NITEMS = SET == 0 ? P0_N0 : P0_N1;
    if (gw < NITEMS) {
        P0Item cur = p0_decode<SET>(F, A, gw); int buf = 0;
        p0_dma(cur, tiles, F.lane);
        for (int it = gw; it < NITEMS; it += NGW) {
            const bool more = it + NGW < NITEMS; P0Item nxt = cur;
            if (more) { nxt = p0_decode<SET>(F, A, it + NGW); p0_dma(nxt, tiles + (buf ^ 1) * 8192, F.lane); asm volatile("s_waitcnt vmcnt(32)" ::: "memory"); }
            else asm volatile("s_waitcnt vmcnt(0)" ::: "memory");
            p0_emit(cur, (const LAS float*)(tiles + buf * 8192), F.lane);
            LDS_WAIT(); asm volatile("" ::: "memory");
            cur = nxt; buf ^= 1;
        }
        asm volatile("s_waitcnt vmcnt(0)" ::: "memory");
    }
}
__device__ __forceinline__ void p0_prologue(Frame& F, const Args& A) {
    const int gw = F.vcu * NWAVES + F.wave, NGW = F.G * NWAVES;
    p0_transposes<0>(F, A, gw, NGW);
    const size_t gt = (size_t)F.vcu * (NWAVES * 64) + F.tid, NT = (size_t)F.G * NWAVES * 64;
    { GAS v4u* z = (GAS v4u*)(WSP(bf16, WS_WIN) + (size_t)RWKV_COLS * D);
      for (size_t i = gt; i < (size_t)224 * D * 2 / 16; i += NT) z[i] = (v4u){0u, 0u, 0u, 0u}; }
    { bf16* wl = WSP(bf16, WS_WLORA); const float* w2 = F.in[9]; const float* a2 = F.in[11]; const float* g2 = F.in[12];
      for (size_t i = gt; i < (size_t)NL * KL / 2; i += NT) { const int n = (int)(i / (KL / 2)), k = 2 * (int)(i % (KL / 2)); const int seg = n >> 10, c = n & 1023;
          float v0 = 0.f, v1 = 0.f;
          if (seg == 0) { if (k < 64) { v0 = w2[(size_t)k * RC + c]; v1 = w2[(size_t)(k + 1) * RC + c]; } }
          else if (seg == 1) { if (k >= 64 && k < 128) { v0 = a2[(size_t)(k - 64) * RC + c]; v1 = a2[(size_t)(k - 63) * RC + c]; } }
          else { if (k >= 128 && k < 288) { v0 = g2[(size_t)(k - 128) * RC + c]; v1 = g2[(size_t)(k - 127) * RC + c]; } }
          ((GAS unsigned*)wl)[i] = pk2(v0, v1); } }
    { GAS unsigned long long* s = (GAS unsigned long long*)(F.ws + WS_SS) + M;
      for (size_t i = gt; i < (size_t)3 * M; i += NT) s[i] = 0ull; }
    { const float* x = F.in[0]; bf16* xb = WSP(bf16, WS_XB); unsigned long long* ss0 = WSP(unsigned long long, WS_SS);
      for (int m = gw; m < M; m += NGW) { const GAS f32x4* xr = (const GAS f32x4*)(x + (size_t)m * D) + 2 * F.lane; GAS v4u* o = (GAS v4u*)(xb + (size_t)m * D) + F.lane; float s = 0.f;
#pragma unroll
          for (int j = 0; j < 4; ++j) { const f32x4 a = xr[128 * j], b = xr[128 * j + 1];
              s += (a[0] * a[0] + a[1] * a[1]) + (a[2] * a[2] + a[3] * a[3]) + (b[0] * b[0] + b[1] * b[1]) + (b[2] * b[2] + b[3] * b[3]);
              const f32x4 ga = *(const f32x4*)(F.in[1] + 8 * F.lane + 512 * j), gb = *(const f32x4*)(F.in[1] + 8 * F.lane + 512 * j + 4);
              o[64 * j] = pg8::pack8(a * ga, b * gb); }
          s = wave_sum(s);
          if (F.lane == 0) ss0[m] = (unsigned long long)(s * pg8::SS_SCALE + 0.5f); } }
}

__device__ __forceinline__ void p4_lora_in(Frame& F) {
    const float* lin = WSP(float, WS_R + R_LIN); bf16* al = WSP(bf16, WS_ALORA); const float* mu = F.in[7] + 3 * RC;
    const size_t gt = (size_t)F.vcu * (NWAVES * 64) + F.tid, NT = (size_t)F.G * NWAVES * 64;
#pragma unroll 4
    for (size_t i = gt; i < (size_t)M * 96; i += NT) { const int m = (int)(i / 96), q = (int)(i % 96), qc = q < 72 ? q : 0; const bool first = (m & (SEQ - 1)) == 0;
        const f32x4 p = *(const GAS f32x4*)(lin + (size_t)m * 288 + 4 * qc), pr = *(const GAS f32x4*)(lin + (size_t)(first ? m : m - 1) * 288 + 4 * qc), mv = *(const GAS f32x4*)(mu + 4 * qc);
        const f32x4 pp = first ? (f32x4){0.f, 0.f, 0.f, 0.f} : pr; f32x4 s = p + (pp - p) * mv;
#pragma unroll
        for (int j = 0; j < 4; ++j) { const float sg = fast_sigmoid(q < 16 ? 2.0f * s[j] : s[j]); s[j] = q < 16 ? 2.0f * sg - 1.0f : (q >= 32 ? sg : s[j]); }
        v2u o = pack4(s); if (q >= 72) o = (v2u){0u, 0u};
        *(GAS v2u*)(al + (size_t)m * KL + 4 * q) = o; }
    { const bf16* rkv = WSP(bf16, WS_R + R_RKV); float* invn = WSP(float, WS_INVN); const int j4 = (F.tid & 15) * 4;
      const size_t it0 = gt >> 4, step = NT >> 4; const int h = (int)(it0 & 15), ch = h * RN + j4;
      const f32x4 muk = *(const f32x4*)(F.in[7] + RC + ch), kkc = *(const f32x4*)(F.in[13] + ch);
      if ((step & 15) == 0) {
#pragma unroll 4
          for (size_t it = it0; it < (size_t)M * RH; it += step) { const int m = (int)(it >> 4); const bool first = (m & (SEQ - 1)) == 0;
              const f32x4 k = unpack4(*(const GAS v2u*)(rkv + (size_t)m * 3072 + RC + ch)), kr = unpack4(*(const GAS v2u*)(rkv + (size_t)(first ? m : m - 1) * 3072 + RC + ch));
              const f32x4 kp = first ? (f32x4){0.f, 0.f, 0.f, 0.f} : kr;
              const f32x4 kk = (k + (kp - k) * muk) * kkc; float s2 = (kk[0] * kk[0] + kk[1] * kk[1]) + (kk[2] * kk[2] + kk[3] * kk[3]); s2 = row16_sum(s2);
              if ((F.tid & 15) == 0) invn[it] = 1.0f / fmaxf(sqrtf(s2), 1e-12f); }
      } else {
          for (size_t it = it0; it < (size_t)M * RH; it += step) { const int m = (int)(it >> 4), h2 = (int)(it & 15), c2 = h2 * RN + j4; const bool first = (m & (SEQ - 1)) == 0;
              const f32x4 k = unpack4(*(const GAS v2u*)(rkv + (size_t)m * 3072 + RC + c2)), kr = unpack4(*(const GAS v2u*)(rkv + (size_t)(first ? m : m - 1) * 3072 + RC + c2));
              const f32x4 kp = first ? (f32x4){0.f, 0.f, 0.f, 0.f} : kr; const f32x4 mk2 = *(const f32x4*)(F.in[7] + RC + c2), kc2 = *(const f32x4*)(F.in[13] + c2);
              const f32x4 kk = (k + (kp - k) * mk2) * kc2; float s2 = (kk[0] * kk[0] + kk[1] * kk[1]) + (kk[2] * kk[2] + kk[3] * kk[3]); s2 = row16_sum(s2);
              if ((F.tid & 15) == 0) invn[it] = 1.0f / fmaxf(sqrtf(s2), 1e-12f); } } }
}

typedef short bf16x4 __attribute__((ext_vector_type(4)));
typedef short bf16x8 __attribute__((ext_vector_type(8)));
#define MFMA32(a, b, c) __builtin_amdgcn_mfma_f32_16x16x32_bf16(a, b, c, 0, 0, 0)
#define MFMA16(a, b, c) __builtin_amdgcn_mfma_f32_16x16x16bf16_1k(a, b, c, 0, 0, 0)
__device__ __forceinline__ bf16x4 cv4(f32x4 v) { v2u w; w.x = pk2(v[0], v[1]); w.y = pk2(v[2], v[3]); return __builtin_bit_cast(bf16x4, w); }
__device__ __forceinline__ bf16x8 cv8(f32x4 a, f32x4 b) { v4u w; w.x = pk2(a[0], a[1]); w.y = pk2(a[2], a[3]); w.z = pk2(b[0], b[1]); w.w = pk2(b[2], b[3]); return __builtin_bit_cast(bf16x8, w); }
__device__ __forceinline__ bf16x8 cat8(bf16x4 a, bf16x4 b) { return __builtin_shufflevector(a, b, 0, 1, 2, 3, 4, 5, 6, 7); }
__device__ __forceinline__ bf16x8 join8(v2u a, v2u b) { v4u w; w.x = a.x; w.y = a.y; w.z = b.x; w.w = b.y; return __builtin_bit_cast(bf16x8, w); }
__device__ __forceinline__ float row16_scan(float x) { x += dpp_mov<0x111>(x); x += dpp_mov<0x112>(x); x += dpp_mov<0x114>(x); x += dpp_mov<0x118>(x); return x; }
__device__ __forceinline__ unsigned short bf1(float x) { return (unsigned short)(pk2(x, 0.f) & 0xffffu); }
constexpr int CH = 16;
constexpr int RWS = 144;
constexpr int HGS = 272;
constexpr int RWB_KG = 0, RWB_RG = 16 * RWS, RWB_KTI = 32 * RWS, RWB_BTI = 48 * RWS, RWB_KTIT = 64 * RWS, RWB_BTIT = RWB_KTIT + 2048, RWB_VT = RWB_BTIT + 2048, RWB_GL = RWB_VT + 2048, RWB_BYTES = RWB_GL + 256;
constexpr int HGB_QG = 0, HGB_KI = 16 * HGS, HGB_KIT = 32 * HGS, HGB_VT = HGB_KIT + 4096, HGB_GL = HGB_VT + 4096, HGB_BYTES = HGB_GL + 512;

__device__ __forceinline__ f32x4 padc(f32x4 r) { asm("s_nop 15" : "+v"(r)); return r; }
constexpr int NCHK = SEQ / CH;
constexpr int NRAW = 8;
constexpr int RWR_R = 0, RWR_K = 2048, RWR_V = 4096, RWR_LW = 6144, RWR_A = 8192, RWR_INV = 10240, RWR_BYTES = 10304;
constexpr int RW_OPND = 0, RW_RAW = 3 * RWB_BYTES, RW_AOP = RW_RAW + NRAW * RWR_BYTES, RW_LDS = RW_AOP + 2 * 2048;
constexpr int HGR_Q = 0, HGR_LF = 4096, HGR_V = 8192, HGR_BYTES = 12288;
constexpr int HG_OPND = 0, HG_RAW = 3 * HGB_BYTES, HG_AOP = HG_RAW + NRAW * HGR_BYTES, HG_LDS = HG_AOP + 2 * 512;
static_assert(RW_LDS <= RING_BYTES && HG_LDS <= RING_BYTES && RW_AOP % 16 == 0 && HG_AOP % 16 == 0, "scan LDS map");
#define GLDS4(gptr, lptr) __builtin_amdgcn_global_load_lds((const GAS unsigned*)(gptr), (LAS unsigned*)(lptr), 4, 0, 0)
#define WG_BAR() do { LDS_WAIT(); __builtin_amdgcn_s_barrier(); asm volatile("" ::: "memory"); } while (0)

__device__ __forceinline__ void p6_rwkv_head(Frame& F, int bh) {
    const bf16* rkv = WSP(bf16, WS_R + R_RKV); const bf16* lout = WSP(bf16, WS_LOUT); const float* invn = WSP(float, WS_INVN); bf16* ydst = WSP(bf16, WS_LOUT);
    const int lane = F.lane, c = lane & 15, g = lane >> 4, w = F.wave;
    const int b = bh >> 4, h = bh & 15;
    const size_t rowbase = (size_t)b * SEQ;
    const int st = lane & 15, k0 = 2 * (w * 4 + (lane >> 4)), chn = h * RN + k0;
    const float mur0 = F.in[7][chn], mur1 = F.in[7][chn + 1], muk0 = F.in[7][RC + chn], muk1 = F.in[7][RC + chn + 1], muv0 = F.in[7][2 * RC + chn], muv1 = F.in[7][2 * RC + chn + 1];
    const float kk0 = F.in[13][chn], kk1 = F.in[13][chn + 1], ka0 = F.in[14][chn], ka1 = F.in[14][chn + 1];
    LAS unsigned char* const opnd = F.lds + RW_OPND; LAS unsigned char* const raw = F.lds + RW_RAW; LAS unsigned char* const aop = F.lds + RW_AOP;
#define RW3_DMA(j) do { const int r_ = 2 * w + (lane >> 5); const size_t ro_ = (rowbase + (size_t)(j) * CH + r_) * 3072 + h * RN + 2 * ((lane & 31) ^ r_); \
        LAS unsigned char* d_ = raw + ((j) % NRAW) * RWR_BYTES + w * 256; \
        GLDS4(rkv + ro_, d_ + RWR_R); GLDS4(rkv + ro_ + RC, d_ + RWR_K); GLDS4(rkv + ro_ + 2 * RC, d_ + RWR_V); GLDS4(lout + ro_, d_ + RWR_LW); GLDS4(lout + ro_ + RC, d_ + RWR_A); \
        if (lane < 2) GLDS4(invn + (rowbase + (size_t)(j) * CH + 2 * w + lane) * RH + h, raw + ((j) % NRAW) * RWR_BYTES + RWR_INV + w * 8); } while (0)
#define RW3_PROC(j) do { const LAS unsigned char* s_ = raw + ((j) % NRAW) * RWR_BYTES; const int pq_ = (k0 >> 1) ^ st, pp_ = (k0 >> 1) ^ ((st + 15) & 15); \
        const LAS unsigned char* sc_ = s_ + st * 128 + pq_ * 4; const LAS unsigned char* sp_ = ((st > 0) ? s_ + (st - 1) * 128 : raw + (((j) + NRAW - 1) % NRAW) * RWR_BYTES + 15 * 128) + pp_ * 4; \
        const bool first_ = ((j) == 0) && (st == 0); \
        const unsigned Lr = *(const LAS unsigned*)(sc_ + RWR_R), Lk = *(const LAS unsigned*)(sc_ + RWR_K), Lv = *(const LAS unsigned*)(sc_ + RWR_V); \
        const unsigned Lw = *(const LAS unsigned*)(sc_ + RWR_LW), La = *(const LAS unsigned*)(sc_ + RWR_A); \
        const unsigned Lrp = *(const LAS unsigned*)(sp_ + RWR_R), Lkp = *(const LAS unsigned*)(sp_ + RWR_K), Lvp = *(const LAS unsigned*)(sp_ + RWR_V); \
        const float Linv = *(const LAS float*)(s_ + RWR_INV + st * 4); \
        const float r0_ = bflo(Lr), r1_ = bfhi(Lr), q0_ = bflo(Lk), q1_ = bfhi(Lk), v0_ = bflo(Lv), v1_ = bfhi(Lv); \
        const float rp0_ = first_ ? 0.f : bflo(Lrp), rp1_ = first_ ? 0.f : bfhi(Lrp), qp0_ = first_ ? 0.f : bflo(Lkp), qp1_ = first_ ? 0.f : bfhi(Lkp), vp0_ = first_ ? 0.f : bflo(Lvp), vp1_ = first_ ? 0.f : bfhi(Lvp); \
        const float rs0_ = r0_ + (rp0_ - r0_) * mur0, rs1_ = r1_ + (rp1_ - r1_) * mur1, ks0_ = q0_ + (qp0_ - q0_) * muk0, ks1_ = q1_ + (qp1_ - q1_) * muk1, vs0_ = v0_ + (vp0_ - v0_) * muv0, vs1_ = v1_ + (vp1_ - v1_) * muv1; \
        const float a0_ = bflo(La), a1_ = bfhi(La), lw0_ = bflo(Lw) * 1.44269504f, lw1_ = bfhi(Lw) * 1.44269504f; \
        const float kap0_ = ks0_ * kk0 * Linv, kap1_ = ks1_ * kk1 * Linv, bet0_ = kap0_ * a0_, bet1_ = kap1_ * a1_; \
        const float kt0_ = ks0_ * (1.0f + (a0_ - 1.0f) * ka0), kt1_ = ks1_ * (1.0f + (a1_ - 1.0f) * ka1); \
        const float G0_ = row16_scan(lw0_), G1_ = row16_scan(lw1_); \
        const float eg0_ = __builtin_amdgcn_exp2f(G0_), eg1_ = __builtin_amdgcn_exp2f(G1_), ep0_ = __builtin_amdgcn_exp2f(G0_ - lw0_), ep1_ = __builtin_amdgcn_exp2f(G1_ - lw1_), ei0_ = __builtin_amdgcn_exp2f(-G0_), ei1_ = __builtin_amdgcn_exp2f(-G1_); \
        LAS unsigned char* d_ = opnd + ((j) % 3) * RWB_BYTES; \
        *(LAS unsigned*)(d_ + RWB_KG + st * RWS + k0 * 2) = pk2(kap0_ * ep0_, kap1_ * ep1_); *(LAS unsigned*)(d_ + RWB_RG + st * RWS + k0 * 2) = pk2(rs0_ * eg0_, rs1_ * eg1_); \
        const unsigned kti_ = pk2(kt0_ * ei0_, kt1_ * ei1_), bti_ = pk2(bet0_ * ei0_, bet1_ * ei1_), vv_ = pk2(vs0_, vs1_); \
        *(LAS unsigned*)(d_ + RWB_KTI + st * RWS + k0 * 2) = kti_; *(LAS unsigned*)(d_ + RWB_BTI + st * RWS + k0 * 2) = bti_; \
        *(LAS unsigned short*)(d_ + RWB_KTIT + k0 * 32 + st * 2) = (unsigned short)(kti_ & 0xffffu); *(LAS unsigned short*)(d_ + RWB_KTIT + (k0 + 1) * 32 + st * 2) = (unsigned short)(kti_ >> 16); \
        *(LAS unsigned short*)(d_ + RWB_BTIT + k0 * 32 + st * 2) = (unsigned short)(bti_ & 0xffffu); *(LAS unsigned short*)(d_ + RWB_BTIT + (k0 + 1) * 32 + st * 2) = (unsigned short)(bti_ >> 16); \
        *(LAS unsigned short*)(d_ + RWB_VT + k0 * 32 + st * 2) = (unsigned short)(vv_ & 0xffffu); *(LAS unsigned short*)(d_ + RWB_VT + (k0 + 1) * 32 + st * 2) = (unsigned short)(vv_ >> 16); \
        if (st == 15) { *(LAS float*)(d_ + RWB_GL + k0 * 4) = eg0_; *(LAS float*)(d_ + RWB_GL + k0 * 4 + 4) = eg1_; } } while (0)
    const f32x4 zero4 = (f32x4){0.f, 0.f, 0.f, 0.f};
    auto a_stage = [&](int j) {
        const LAS unsigned char* rowp = opnd + (j % 3) * RWB_BYTES + c * RWS;
        const int offA = (w == 4 || w == 7) ? RWB_BTI : RWB_KTI;
        const int offB = (w == 4 || w == 5) ? RWB_KG : RWB_RG;
        const bf16x8 a0 = *(const LAS bf16x8*)(rowp + offA + 16 * g), a1 = *(const LAS bf16x8*)(rowp + offA + 64 + 16 * g);
        const bf16x8 b0 = *(const LAS bf16x8*)(rowp + offB + 16 * g), b1 = *(const LAS bf16x8*)(rowp + offB + 64 + 16 * g);
        f32x4 N = MFMA32(a0, b0, zero4); N = MFMA32(a1, b1, N);
        const bool strict = (w == 4 || w == 5);
#pragma unroll
        for (int r = 0; r < 4; ++r) { const int rj = 4 * g + r; N[r] = (strict ? (c > rj) : (c >= rj)) ? N[r] : 0.f; }
        f32x4 res = N;
        if (w == 4) {
            f32x4 N1t = MFMA32(b0, a0, zero4); N1t = MFMA32(b1, a1, N1t);
            f32x4 X;
#pragma unroll
            for (int r = 0; r < 4; ++r) { const int rj = 4 * g + r; N1t[r] = (rj > c) ? N1t[r] : 0.f; X[r] = ((rj == c) ? 1.0f : 0.f) - N[r]; }
            bf16x4 an = cv4(N), at = cv4(N1t);
            f32x4 P = MFMA16(at, an, zero4), Pt = MFMA16(an, at, zero4);
            X = MFMA16(cv4(Pt), cv4(X), padc(X));
            an = cv4(P); at = cv4(Pt);
            P = MFMA16(at, an, zero4); Pt = MFMA16(an, at, zero4);
            X = MFMA16(cv4(Pt), cv4(X), padc(X));
            an = cv4(P); at = cv4(Pt);
            Pt = MFMA16(an, at, zero4);
            X = MFMA16(cv4(Pt), cv4(X), padc(X));
            res = X;
        }
        *(LAS bf16x4*)(aop + (j & 1) * 2048 + (w - 4) * 512 + lane * 8) = cv4(res);
    };
    f32x4 Z[4];
#pragma unroll
    for (int i = 0; i < 4; ++i) Z[i] = (f32x4){0.f, 0.f, 0.f, 0.f};
    { RW3_DMA(0); RW3_DMA(1); RW3_DMA(2); RW3_DMA(3); RW3_DMA(4); RW3_DMA(5); RW3_DMA(6); RW3_DMA(7); asm volatile("s_waitcnt vmcnt(0)" ::: "memory"); WG_BAR(); RW3_PROC(0); RW3_PROC(1); WG_BAR(); if (w >= 4) a_stage(0); WG_BAR(); }
    if (w < 4) {
        for (int ci = 0; ci < NCHK; ++ci) {
            const int t0 = ci * CH; const int jp = (ci + 2 < NCHK) ? ci + 2 : NCHK - 1;
            RW3_PROC(jp);
            const LAS unsigned char* cur = opnd + (ci % 3) * RWB_BYTES; const LAS unsigned char* rowp = cur + c * RWS; const LAS unsigned char* ap = aop + (ci & 1) * 2048 + lane * 8;
            bf16x8 pKg[2], pRg[2];
#pragma unroll
            for (int s = 0; s < 2; ++s) {
                pKg[s] = join8(*(const LAS v2u*)(rowp + RWB_KG + 64 * s + 8 * g), *(const LAS v2u*)(rowp + RWB_KG + 64 * s + 32 + 8 * g));
                pRg[s] = join8(*(const LAS v2u*)(rowp + RWB_RG + 64 * s + 8 * g), *(const LAS v2u*)(rowp + RWB_RG + 64 * s + 32 + 8 * g)); }
            const bf16x4 bV = *(const LAS bf16x4*)(cur + RWB_VT + (16 * w + c) * 32 + 8 * g);
            const bf16x4 xT = *(const LAS bf16x4*)(ap), n2 = *(const LAS bf16x4*)(ap + 512), n3 = *(const LAS bf16x4*)(ap + 1024), n4 = *(const LAS bf16x4*)(ap + 1536);
            const bf16x8 bZ0 = cv8(Z[0], Z[1]), bZ1 = cv8(Z[2], Z[3]);
            const bf16x4 z4 = (bf16x4){0, 0, 0, 0};
            f32x4 W = MFMA32(pKg[0], bZ0, zero4); W = MFMA32(pKg[1], bZ1, W); W = MFMA32(cat8(n2, z4), cat8(bV, z4), W);
            const f32x4 U = MFMA16(xT, cv4(W), zero4);
            const bf16x4 nU = cv4(-U);
            const bf16x8 bVU = cat8(bV, nU);
            f32x4 Y = MFMA32(pRg[0], bZ0, zero4); Y = MFMA32(pRg[1], bZ1, Y); Y = MFMA32(cat8(n3, n4), bVU, Y);
#pragma unroll
            for (int r = 0; r < 4; ++r) ydst[(rowbase + t0 + 4 * g + r) * 3072 + h * RN + 16 * w + c] = bf1(Y[r]);
#pragma unroll
            for (int zt = 0; zt < 4; ++zt) {
                const bf16x4 aK = *(const LAS bf16x4*)(cur + RWB_KTIT + (16 * zt + c) * 32 + 8 * g), aB = *(const LAS bf16x4*)(cur + RWB_BTIT + (16 * zt + c) * 32 + 8 * g);
                const f32x4 gl = *(const LAS f32x4*)(cur + RWB_GL + (16 * zt + 4 * g) * 4);
                Z[zt] = MFMA32(cat8(aK, aB), bVU, Z[zt]) * gl; }
            { const int jn = (ci + NRAW < NCHK) ? ci + NRAW : NCHK - 1; RW3_DMA(jn); }
            if (ci == NCHK / 2 - 1) asm volatile("s_waitcnt vmcnt(0)" ::: "memory");
            asm volatile("s_waitcnt vmcnt(50)" ::: "memory");
            WG_BAR();
            if (ci == NCHK / 2 - 1 && w == 0 && lane == 0) sig_post(WSP(unsigned, WS_CTL) + CW_SIG_HALF);
        }
    } else {
        for (int ci = 0; ci < NCHK; ++ci) {
            const int jp = (ci + 2 < NCHK) ? ci + 2 : NCHK - 1, ja = (ci + 1 < NCHK) ? ci + 1 : NCHK - 1;
            RW3_PROC(jp);
            a_stage(ja);
            { const int jn = (ci + NRAW < NCHK) ? ci + NRAW : NCHK - 1; RW3_DMA(jn); }
            asm volatile("s_waitcnt vmcnt(30)" ::: "memory");
            WG_BAR();
        }
    }
#undef RW3_DMA
#undef RW3_PROC
}

__device__ __forceinline__ void p6_hgrn_head(Frame& F, int hb) {
    const bf16* hg = WSP(bf16, WS_R + R_HG); bf16* odst = WSP(bf16, WS_R + R_HG);
    const int lane = F.lane, c = lane & 15, g = lane >> 4, w = F.wave;
    const int bh = hb >> 1, half = hb & 1, b = bh >> 3, h = bh & 7, vb = half * 4 + (w & 3);
    const size_t rowbase = (size_t)b * SEQ;
    const int st = lane & 15, k0 = 4 * (w * 4 + (lane >> 4));
    LAS unsigned char* const opnd = F.lds + HG_OPND; LAS unsigned char* const raw = F.lds + HG_RAW; LAS unsigned char* const aop = F.lds + HG_AOP;
#define HG3_DMA(j) do { _Pragma("unroll") for (int rr_ = 0; rr_ < 2; ++rr_) { const int r_ = 2 * w + rr_; const bf16* p_ = hg + (rowbase + (size_t)(j) * CH + r_) * 4096 + h * HD + 2 * (2 * ((lane >> 1) ^ r_) + (lane & 1)); \
        LAS unsigned char* d_ = raw + ((j) % NRAW) * HGR_BYTES + r_ * 256; GLDS4(p_, d_ + HGR_Q); GLDS4(p_ + HC, d_ + HGR_LF); GLDS4(p_ + 2 * HC, d_ + HGR_V); } } while (0)
#define HG3_PROC(j) do { const LAS unsigned char* s_ = raw + ((j) % NRAW) * HGR_BYTES + st * 256 + (((k0 >> 2) ^ st) * 8); LAS unsigned char* d_ = opnd + ((j) % 3) * HGB_BYTES; \
        const v2u Lq = *(const LAS v2u*)(s_ + HGR_Q), Lf = *(const LAS v2u*)(s_ + HGR_LF), Lv = *(const LAS v2u*)(s_ + HGR_V); \
        const f32x4 q_ = unpack4(Lq); f32x4 lf_ = unpack4(Lf) * 1.44269504f; f32x4 qg_, ki_, eg_; \
        _Pragma("unroll") for (int e = 0; e < 4; ++e) { const float G_ = row16_scan(lf_[e]); eg_[e] = __builtin_amdgcn_exp2f(G_); qg_[e] = q_[e] * eg_[e]; ki_[e] = (1.0f - __builtin_amdgcn_exp2f(lf_[e])) * __builtin_amdgcn_exp2f(-G_); } \
        const v2u kw_ = pack4(ki_); *(LAS v2u*)(d_ + HGB_QG + st * HGS + k0 * 2) = pack4(qg_); *(LAS v2u*)(d_ + HGB_KI + st * HGS + k0 * 2) = kw_; \
        *(LAS unsigned short*)(d_ + HGB_KIT + (k0 + 0) * 32 + st * 2) = (unsigned short)(kw_.x & 0xffffu); *(LAS unsigned short*)(d_ + HGB_KIT + (k0 + 1) * 32 + st * 2) = (unsigned short)(kw_.x >> 16); \
        *(LAS unsigned short*)(d_ + HGB_KIT + (k0 + 2) * 32 + st * 2) = (unsigned short)(kw_.y & 0xffffu); *(LAS unsigned short*)(d_ + HGB_KIT + (k0 + 3) * 32 + st * 2) = (unsigned short)(kw_.y >> 16); \
        *(LAS unsigned short*)(d_ + HGB_VT + (k0 + 0) * 32 + st * 2) = (unsigned short)(Lv.x & 0xffffu); *(LAS unsigned short*)(d_ + HGB_VT + (k0 + 1) * 32 + st * 2) = (unsigned short)(Lv.x >> 16); \
        *(LAS unsigned short*)(d_ + HGB_VT + (k0 + 2) * 32 + st * 2) = (unsigned short)(Lv.y & 0xffffu); *(LAS unsigned short*)(d_ + HGB_VT + (k0 + 3) * 32 + st * 2) = (unsigned short)(Lv.y >> 16); \
        if (st == 15) *(LAS f32x4*)(d_ + HGB_GL + k0 * 4) = eg_; } while (0)
    const f32x4 zero4 = (f32x4){0.f, 0.f, 0.f, 0.f};
    auto a_stage = [&](int j) {
        const LAS unsigned char* rowp = opnd + (j % 3) * HGB_BYTES + c * HGS;
        f32x4 N = zero4;
#pragma unroll
        for (int s = 0; s < 4; ++s) { const bf16x8 nQ = *(const LAS bf16x8*)(rowp + HGB_QG + 64 * s + 16 * g), nK = *(const LAS bf16x8*)(rowp + HGB_KI + 64 * s + 16 * g); N = MFMA32(nK, nQ, N); }
#pragma unroll
        for (int r = 0; r < 4; ++r) N[r] = (c >= 4 * g + r) ? N[r] : 0.f;
        *(LAS bf16x4*)(aop + (j & 1) * 512 + lane * 8) = cv4(N);
    };
    f32x4 Z[8];
#pragma unroll
    for (int i = 0; i < 8; ++i) Z[i] = (f32x4){0.f, 0.f, 0.f, 0.f};
    { HG3_DMA(0); HG3_DMA(1); HG3_DMA(2); HG3_DMA(3); HG3_DMA(4); HG3_DMA(5); HG3_DMA(6); HG3_DMA(7); asm volatile("s_waitcnt vmcnt(0)" ::: "memory"); WG_BAR(); HG3_PROC(0); HG3_PROC(1); WG_BAR(); if (w == 4) a_stage(0); WG_BAR(); }
    if (w < 4) {
        for (int ci = 0; ci < NCHK; ++ci) {
            const int t0 = ci * CH; const int jp = (ci + 2 < NCHK) ? ci + 2 : NCHK - 1;
            HG3_PROC(jp);
            const LAS unsigned char* cur = opnd + (ci % 3) * HGB_BYTES; const LAS unsigned char* rowp = cur + c * HGS;
            f32x4 Y = zero4;
#pragma unroll
            for (int s = 0; s < 4; ++s) {
                const bf16x8 pQ = join8(*(const LAS v2u*)(rowp + HGB_QG + 64 * s + 8 * g), *(const LAS v2u*)(rowp + HGB_QG + 64 * s + 32 + 8 * g));
                Y = MFMA32(pQ, cv8(Z[2 * s], Z[2 * s + 1]), Y); }
            const bf16x4 bV = *(const LAS bf16x4*)(cur + HGB_VT + (16 * vb + c) * 32 + 8 * g);
            const bf16x4 n = *(const LAS bf16x4*)(aop + (ci & 1) * 512 + lane * 8);
            const bf16x4 z4 = (bf16x4){0, 0, 0, 0};
            Y = MFMA32(cat8(n, z4), cat8(bV, z4), Y);
#pragma unroll
            for (int r = 0; r < 4; ++r) odst[(rowbase + t0 + 4 * g + r) * 4096 + 2 * HC + h * HD + 16 * vb + c] = bf1(Y[r]);
#pragma unroll
            for (int zt = 0; zt < 8; ++zt) {
                const bf16x4 aK = *(const LAS bf16x4*)(cur + HGB_KIT + (16 * zt + c) * 32 + 8 * g);
                const f32x4 gl = *(const LAS f32x4*)(cur + HGB_GL + (16 * zt + 4 * g) * 4);
                Z[zt] = MFMA16(aK, bV, Z[zt]) * gl; }
            { const int jn = (ci + NRAW < NCHK) ? ci + NRAW : NCHK - 1; HG3_DMA(jn); }
            if (ci == NCHK / 2 - 1) asm volatile("s_waitcnt vmcnt(0)" ::: "memory");
            asm volatile("s_waitcnt vmcnt(50)" ::: "memory");
            WG_BAR();
            if (ci == NCHK / 2 - 1 && w == 0 && lane == 0) sig_post(WSP(unsigned, WS_CTL) + CW_SIG_HALF);
        }
    } else {
        for (int ci = 0; ci < NCHK; ++ci) {
            const int jp = (ci + 2 < NCHK) ? ci + 2 : NCHK - 1, ja = (ci + 1 < NCHK) ? ci + 1 : NCHK - 1;
            HG3_PROC(jp);
            if (w == 4) a_stage(ja);
            { const int jn = (ci + NRAW < NCHK) ? ci + NRAW : NCHK - 1; HG3_DMA(jn); }
            asm volatile("s_waitcnt vmcnt(30)" ::: "memory");
            WG_BAR();
        }
    }
#undef HG3_DMA
#undef HG3_PROC
}
#undef WG_BAR
__device__ __forceinline__ void p7_post(Frame& F, int hsel, int c, int G);
constexpr int NSCAN = BATCH * RH + 2 * BATCH * HH;
__device__ __forceinline__ void p6_shadow(Frame& F, const Args& A, int c, int G) {
    const unsigned long long* ss = WSP(unsigned long long, WS_SS);
    {   pg8::Gemm g{WSP(bf16, WS_XB), WSP(bf16, WS_WIN) + (size_t)26 * 256 * D, M, 4 * 256, D, 0}; pg8::StaticOrder S; S.init(M, 4 * 256, G, c);
        pg8::EpiInProj E{WSP(bf16, WS_R + R_RKV), WSP(float, WS_R + R_LIN), WSP(bf16, WS_R + R_HG), pg8::inv_preload((PG8_LAS float*)(F.lds + pg8::STAGE_BYTES), S, ss + M), (PG8_LAS float*)(F.lds + pg8::STAGE_BYTES + 4096), 26};
        pg8::gemm_phase<pg8::EpiInProj, pg8::StaticOrder, true, true>(F.lds, g, S, E); }
    {   int kl = KL; asm volatile("" : "+s"(kl));
        pg8::Gemm g{WSP(bf16, WS_ALORA), WSP(bf16, WS_WLORA) + (size_t)8 * 256 * KL, M, 4 * 256, kl, 0}; pg8::StaticOrder S; S.init(M, 4 * 256, G, c);
        pg8::EpiLora E{WSP(bf16, WS_LOUT), (PG8_LAS float*)(F.lds + pg8::STAGE_BYTES), 8};
        pg8::gemm_phase<pg8::EpiLora, pg8::StaticOrder, true, true>(F.lds, g, S, E); }
    p0_transposes<1>(F, A, c * NWAVES + F.wave, G * NWAVES);
}
__device__ __forceinline__ void p6_shadow_b(Frame& F, int c, int G) {
    unsigned* ctl = WSP(unsigned, WS_CTL);
    wg_signal(ctl + CW_SIG_SHA); wg_wait(ctl + CW_SIG_SHA, (unsigned)G, ctl + CW_BAR);
    wg_wait(ctl + CW_SIG_HALF, (unsigned)NSCAN, ctl + CW_BAR);
    p7_post(F, 0, c, G);
    wg_signal(ctl + CW_SIG_SHB); wg_wait(ctl + CW_SIG_SHB, (unsigned)G, ctl + CW_BAR);
    {   pg8::Gemm g{WSP(bf16, WS_XB), WSP(bf16, WS_WOUT), M, D, D, 0}; pg8::StaticOrder S; S.init(M / 2, D, G, c, 4); S.hsel = 0;
        pg8::EpiResid E{nullptr, (const bf16*)F.out, nullptr, nullptr, (bf16*)F.out + D, F.in[21], nullptr, WSP(unsigned long long, WS_SS) + 2 * M, 1.0f, 2 * D, 2 * D, 2048};
        pg8::gemm_phase<pg8::EpiResid, pg8::StaticOrder, true, true>(F.lds, g, S, E); }
}
__device__ __forceinline__ void p6_scans(Frame& F, const Args& A) {
    const int bx = (int)blockIdx.x;
    if (F.G == 2 * NSCAN) {
        const int x = bx & 7, idx = (bx >> 3) * 4 + (x & 3);
        if (x < 4) { if (idx < BATCH * RH) p6_rwkv_head(F, idx); else p6_hgrn_head(F, idx - BATCH * RH); } else { p6_shadow(F, A, idx, NSCAN); p6_shadow_b(F, idx, NSCAN); } }
    else if (F.G > NSCAN) { if (bx < NSCAN) { if (bx < BATCH * RH) p6_rwkv_head(F, bx); else p6_hgrn_head(F, bx - BATCH * RH); } else { p6_shadow(F, A, bx - NSCAN, F.G - NSCAN); p6_shadow_b(F, bx - NSCAN, F.G - NSCAN); } }
    else {
        for (int u = bx; u < NSCAN; u += F.G) { if (u < BATCH * RH) p6_rwkv_head(F, u); else p6_hgrn_head(F, u - BATCH * RH); }
        __syncthreads(); p6_shadow(F, A, bx, F.G);
    }
}

__device__ __forceinline__ void p7_post(Frame& F, int hsel, int c, int G) {
    const int NR = hsel < 0 ? M : M / 2;
    const bf16* rkv = WSP(bf16, WS_R + R_RKV); const bf16* hg = WSP(bf16, WS_R + R_HG); const bf16* lout = WSP(bf16, WS_LOUT); bf16* yc = WSP(bf16, WS_XB);
    { const int half = F.tid >> 8, ch = (F.tid & 255) * 4;
      const f32x4 mu_r = *(const f32x4*)(F.in[7] + ch), mu_k = *(const f32x4*)(F.in[7] + RC + ch), mu_v = *(const f32x4*)(F.in[7] + 2 * RC + ch);
      const f32x4 kac = *(const f32x4*)(F.in[14] + ch), rkc = *(const f32x4*)(F.in[15] + ch), lnw = *(const f32x4*)(F.in[16] + ch), lnb = *(const f32x4*)(F.in[17] + ch);
#pragma unroll 2
      for (int i = c * 2 + half; i < NR; i += 2 * G) { const int m = hsel < 0 ? i : (i / (SEQ / 2)) * SEQ + (i % (SEQ / 2)) + hsel * (SEQ / 2);
          const bool first = (m & (SEQ - 1)) == 0; const size_t mp = first ? m : m - 1;
          const bf16* p = rkv + (size_t)m * 3072 + ch; const bf16* q = rkv + mp * 3072 + ch; const bf16* l = lout + (size_t)m * 3072 + ch;
          const f32x4 y = unpack4(*(const GAS v2u*)(l));
          const f32x4 r = unpack4(*(const GAS v2u*)(p)), k = unpack4(*(const GAS v2u*)(p + RC)), v = unpack4(*(const GAS v2u*)(p + 2 * RC));
          f32x4 rp = unpack4(*(const GAS v2u*)(q)), kp = unpack4(*(const GAS v2u*)(q + RC)), vp = unpack4(*(const GAS v2u*)(q + 2 * RC));
          if (first) { rp = (f32x4){0.f, 0.f, 0.f, 0.f}; kp = rp; vp = rp; }
          const f32x4 a = unpack4(*(const GAS v2u*)(l + RC)), gg = unpack4(*(const GAS v2u*)(l + 2 * RC));
          const f32x4 rs = r + (rp - r) * mu_r, ks = k + (kp - k) * mu_k, vs = v + (vp - v) * mu_v;
          const f32x4 km = ks * (1.0f + (a - 1.0f) * kac);
          const f32x4 bt = rs * km * rkc; float bon = (bt[0] + bt[1]) + (bt[2] + bt[3]); bon = row16_sum(bon);
          float s1 = (y[0] + y[1]) + (y[2] + y[3]); s1 = row16_sum(s1); const float mean = s1 * (1.0f / 64.0f);
          const f32x4 d = y - mean; float s2 = (d[0] * d[0] + d[1] * d[1]) + (d[2] * d[2] + d[3] * d[3]); s2 = row16_sum(s2);
          const float rstd = 1.0f / sqrtf(s2 * (1.0f / 64.0f) + 64e-5f);
          const f32x4 o = ((d * rstd) * lnw + lnb + vs * bon) * gg;
          *(GAS v2u*)(yc + (size_t)m * 2048 + ch) = pack4(o); } }
    { const int quarter = F.tid >> 7, ch = (F.tid & 127) * 8;
      const f32x4 nw0 = *(const f32x4*)(F.in[19] + ch), nw1 = *(const f32x4*)(F.in[19] + ch + 4);
#pragma unroll 4
      for (int i = c * 4 + quarter; i < NR; i += 4 * G) { const int m = hsel < 0 ? i : (i / (SEQ / 2)) * SEQ + (i % (SEQ / 2)) + hsel * (SEQ / 2);
          const v4u ow = *(const GAS v4u*)(hg + (size_t)m * 4096 + 2 * HC + ch), gw4 = *(const GAS v4u*)(hg + (size_t)m * 4096 + 3 * HC + ch);
          const f32x4 o0 = (f32x4){bflo(ow.x), bfhi(ow.x), bflo(ow.y), bfhi(ow.y)}, o1 = (f32x4){bflo(ow.z), bfhi(ow.z), bflo(ow.w), bfhi(ow.w)};
          const f32x4 g0 = (f32x4){bflo(gw4.x), bfhi(gw4.x), bflo(gw4.y), bfhi(gw4.y)}, g1 = (f32x4){bflo(gw4.z), bfhi(gw4.z), bflo(gw4.w), bfhi(gw4.w)};
          float s2 = ((o0[0] * o0[0] + o0[1] * o0[1]) + (o0[2] * o0[2] + o0[3] * o0[3])) + ((o1[0] * o1[0] + o1[1] * o1[1]) + (o1[2] * o1[2] + o1[3] * o1[3])); s2 = row16_sum(s2);
          const float rstd = 1.0f / sqrtf(s2 * (1.0f / 128.0f) + 1e-6f);
          *(GAS v4u*)(yc + (size_t)m * 2048 + RC + ch) = pg8::pack8(o0 * rstd * nw0 * g0, o1 * rstd * nw1 * g1); } }
}

__device__ __forceinline__ void p11_final(Frame& F) {
    const int gw = F.vcu * NWAVES + F.wave, NGW = F.G * NWAVES; const float* fg = F.in[25];
    const bf16* x3 = WSP(bf16, WS_XB); const unsigned long long* ss3 = WSP(unsigned long long, WS_SS) + 3 * M;
    f32x4 gn[8];
#pragma unroll
    for (int j = 0; j < 4; ++j) { gn[2 * j] = *(const f32x4*)(fg + 8 * F.lane + 512 * j); gn[2 * j + 1] = *(const f32x4*)(fg + 8 * F.lane + 512 * j + 4); }
#pragma unroll 2
    for (int m = gw; m < M; m += NGW) { const GAS v4u* xr = (const GAS v4u*)(x3 + (size_t)m * D) + F.lane; GAS f32x4* o = (GAS f32x4*)(F.out + (size_t)m * D) + 2 * F.lane;
        const float inv = pg8::inv_rms_from_val(ss3[m]);
#pragma unroll
        for (int j = 0; j < 4; ++j) { const v4u w = xr[64 * j];
            o[128 * j] = (f32x4){bflo(w.x), bfhi(w.x), bflo(w.y), bfhi(w.y)} * inv * gn[2 * j]; o[128 * j + 1] = (f32x4){bflo(w.z), bfhi(w.z), bflo(w.w), bfhi(w.w)} * inv * gn[2 * j + 1]; } }
}

__global__ void __launch_bounds__(NWAVES * 64, 2) mk_fwd(Args args) {
    extern __shared__ __attribute__((aligned(16))) unsigned char lds[];
    Frame F;
    F.lds = (LAS unsigned char*)lds;
    F.tid = threadIdx.x; F.lane = F.tid & 63; F.wave = __builtin_amdgcn_readfirstlane(F.tid >> 6);
    F.G = gridDim.x; { const int bx = blockIdx.x; F.vcu = (F.G % 8 == 0) ? (bx % 8) * (F.G / 8) + bx / 8 : bx; }
#pragma unroll
    for (int i = 0; i < 26; ++i) F.in[i] = args.in[i];
    F.out = args.out; F.ws = args.ws;
    for (int u = F.tid; u < (LDS_BYTES - LDSCTL_OFF) / 4; u += NWAVES * 64) ((LAS unsigned*)(F.lds + LDSCTL_OFF))[u] = 0u;
    __syncthreads();
    const int lo = args.ph_lo, hi = args.ph_hi;
    XcdBarrier bar; bar.bar = (unsigned*)(args.ws + WS_CTL) + CW_BAR; bar.x = 0; bar.st = nullptr;
    if (hi - lo > 1) bar = xcd_barrier_post((unsigned*)(args.ws + WS_CTL) + CW_BAR, (volatile LAS unsigned*)(F.lds + MISC_OFF) + 8);
#ifndef PH_MASK
#define PH_MASK 0xFFF
#endif
#define IN(k) (((PH_MASK >> (k)) & 1) && lo <= (k) && (k) < hi)
#define SEAM(k) do { if (IN(k) && IN((k) + 1)) xcd_barrier(bar); } while (0)
    const bf16* xb = WSP(bf16, WS_XB); unsigned long long* ss = WSP(unsigned long long, WS_SS);
    const int cid = (int)blockIdx.x;
    bf16* const x2b = (bf16*)F.out + D;
    const bool fuse = (F.G % 256) == 0;

    if (IN(0)) { p0_prologue(F, args); } SEAM(0);
    if (IN(1)) {
        pg8::Gemm g{xb, WSP(bf16, WS_W1GU), M, 2 * FF, D, 0}; pg8::StaticOrder S; S.init(M, 2 * FF, F.G, cid);
        pg8::EpiSwiglu E{WSP(bf16, WS_R + R_ACT), FF, pg8::inv_preload((PG8_LAS float*)(F.lds + pg8::STAGE_BYTES), S, ss)};
        pg8::gemm_phase<pg8::EpiSwiglu, pg8::StaticOrder, true, true>(F.lds, g, S, E);
    } SEAM(1);
    if (IN(2)) {
        pg8::Gemm g{WSP(bf16, WS_R + R_ACT), WSP(bf16, WS_W1D), M, D, FF, 0}; pg8::StaticOrder S; S.init(M, D, F.G, cid, 4);
        pg8::EpiResid E{F.in[0], nullptr, nullptr, nullptr, WSP(bf16, WS_XB), F.in[5], (bf16*)F.out, ss + M, 0.5f, 2048, 2048, 2 * D};
        pg8::gemm_phase<pg8::EpiResid, pg8::StaticOrder, true, true>(F.lds, g, S, E);
    } SEAM(2);
    if (IN(3)) {
        pg8::Gemm g{xb, WSP(bf16, WS_WIN), M, 26 * 256, D, 0}; pg8::StaticOrder S; S.init(M, 26 * 256, F.G, cid);
        PG8_LAS float* omt = (PG8_LAS float*)(F.lds + pg8::STAGE_BYTES + 4096);
        for (int cix = F.tid; cix < HC; cix += NWAVES * 64) omt[cix] = 1.0f - fast_sigmoid(F.in[18][cix] - F.in[18][HC + cix]);
        pg8::EpiInProj E{WSP(bf16, WS_R + R_RKV), WSP(float, WS_R + R_LIN), WSP(bf16, WS_R + R_HG), pg8::inv_preload((PG8_LAS float*)(F.lds + pg8::STAGE_BYTES), S, ss + M), omt, 0};
        pg8::gemm_phase<pg8::EpiInProj, pg8::StaticOrder, true, true>(F.lds, g, S, E);
    } SEAM(3);
    if (IN(4)) { p4_lora_in(F); } SEAM(4);
    if (IN(5)) {
        int kl = KL; asm volatile("" : "+s"(kl));
        pg8::Gemm g{WSP(bf16, WS_ALORA), WSP(bf16, WS_WLORA), M, 8 * 256, kl, 0}; pg8::StaticOrder S; S.init(M, 8 * 256, F.G, cid);
        PG8_LAS float* bt = (PG8_LAS float*)(F.lds + pg8::STAGE_BYTES);
        for (int cix = F.tid; cix < 2 * RC; cix += NWAVES * 64) bt[cix] = cix < RC ? F.in[8][cix] : F.in[10][cix - RC];
        __syncthreads();
        pg8::EpiLora E{WSP(bf16, WS_LOUT), bt, 0};
        pg8::gemm_phase<pg8::EpiLora, pg8::StaticOrder, true, true>(F.lds, g, S, E);
    } SEAM(5);
    if (IN(6)) { p6_scans(F, args); } SEAM(6);
    const bool split = F.G > NSCAN;
    if (IN(7)) { p7_post(F, split ? 1 : -1, F.vcu, F.G); } SEAM(7);
    if (IN(8)) {
        pg8::Gemm g{xb, WSP(bf16, WS_WOUT), M, D, D, 0}; pg8::StaticOrder S; S.init(split ? M / 2 : M, D, F.G, cid, 4); S.hsel = split ? 1 : -1;
        pg8::EpiResid E{nullptr, (const bf16*)F.out, nullptr, nullptr, x2b, F.in[21], nullptr, ss + 2 * M, 1.0f, 2 * D, 2 * D, 2048};
        pg8::gemm_phase<pg8::EpiResid, pg8::StaticOrder, true, true>(F.lds, g, S, E);
    } SEAM(8);
    if (IN(9)) {
        pg8::Gemm g{x2b, WSP(bf16, WS_W2GU), M, 2 * FF, D, 2 * D}; pg8::StaticOrder S; S.init(M, 2 * FF, F.G, cid);
        pg8::EpiSwiglu E{WSP(bf16, WS_R + R_ACT), FF, pg8::inv_preload((PG8_LAS float*)(F.lds + pg8::STAGE_BYTES), S, ss + 2 * M)};
        pg8::gemm_phase<pg8::EpiSwiglu, pg8::StaticOrder, true, true>(F.lds, g, S, E);
    } SEAM(9);
    if (IN(10)) {
        pg8::Gemm g{WSP(bf16, WS_R + R_ACT), WSP(bf16, WS_W2D), M, D, FF, 0}; pg8::StaticOrder S; S.init(M, D, F.G, cid, 4);
        if (fuse) { pg8::EpiFinal E{x2b, 2 * D, F.in[21], F.in[25], F.out, ss + 3 * M, WSP(unsigned, WS_CTL) + CW_PCNT, WSP(unsigned, WS_CTL) + CW_BAR + XB_TMO, 0.5f, (unsigned)(D / 256)};
            pg8::gemm_phase<pg8::EpiFinal, pg8::StaticOrder, true, true>(F.lds, g, S, E); }
        else { pg8::EpiResid E{nullptr, x2b, F.in[21], nullptr, nullptr, nullptr, WSP(bf16, WS_XB), ss + 3 * M, 0.5f, 2 * D, 2048, 2048};
            pg8::gemm_phase<pg8::EpiResid, pg8::StaticOrder, true, true>(F.lds, g, S, E); }
    }
    if (!fuse) { SEAM(10); if (IN(11)) { p11_final(F); } }
#undef IN
#undef SEAM
}

extern "C" void kernel_launch(void* const* d_in, const int* in_sizes, int n_in, void* d_out, int out_size, void* d_ws, size_t ws_size, hipStream_t stream) {
    static int grid = 0;
    if (grid == 0) {
        if (n_in != 26 || in_sizes[0] != M * D || out_size != M * D || ws_size < WS_END) { fprintf(stderr, "kernel_launch: unexpected problem (n_in %d, ws %zu < %zu)\n", n_in, ws_size, (size_t)WS_END); grid = -1; return; }
        int dev = 0, cus = 0, per_cu = 0;
        if (hipGetDevice(&dev) != hipSuccess || hipDeviceGetAttribute(&cus, hipDeviceAttributeMultiprocessorCount, dev) != hipSuccess) { grid = -1; return; }
        if (hipFuncSetAttribute((const void*)mk_fwd, hipFuncAttributeMaxDynamicSharedMemorySize, LDS_BYTES) != hipSuccess) { grid = -1; return; }
        if (hipOccupancyMaxActiveBlocksPerMultiprocessor(&per_cu, (const void*)mk_fwd, NWAVES * 64, LDS_BYTES) != hipSuccess || per_cu < 1) fprintf(stderr, "kernel_launch: occupancy query reports %d\n", per_cu);
        (void)hipGetLastError();
        grid = cus;
    }
    if (grid < 0) return;
    (void)hipMemsetAsync((char*)d_ws + WS_CTL, 0, CTL_BYTES, stream);
    Args a{};
    for (int i = 0; i < 26; ++i) a.in[i] = (const float*)d_in[i];
    a.out = (float*)d_out; a.ws = (unsigned char*)d_ws;
    constexpr int NL_ = MK_N_LAUNCHES;
    for (int li = 0; li < NL_; ++li) {
        a.ph_lo = (NL_ == 1) ? 0 : li; a.ph_hi = (NL_ == 1) ? N_PHASES : li + 1;
        hipLaunchKernelGGL(mk_fwd, dim3(grid), dim3(NWAVES * 64), LDS_BYTES, stream, a);
    }
}
```

```cpp
#include <hip/hip_runtime.h>
#include <cstdio>
#include <cstdint>
namespace pg8 {
#define PG8_LAS __attribute__((address_space(3)))
typedef unsigned short bf16_t;
typedef short bf16x8 __attribute__((ext_vector_type(8)));
typedef float f32x4 __attribute__((ext_vector_type(4)));
typedef unsigned u32x4 __attribute__((ext_vector_type(4)));
constexpr int BM = 256, BK = 64, HALF = 128, HTB = HALF * BK * 2  , STAGE_BYTES = 8 * HTB, NXCD = 8, WGM = 8;

__host__ __device__ __forceinline__ int lds_byte(int r, int c) { const int st = (r >> 4) * 2 + (c >> 5), rr = r & 15, cc = c & 31, ob = rr * 64 + cc * 2; return st * 1024 + (ob ^ (((ob >> 9) & 1) << 5)); }
__host__ __device__ __forceinline__ void stage_rc(int b, int& R, int& C) { const int st = b / 1024, sb = b % 1024, swz = sb ^ (((sb >> 9) & 1) << 5); R = (st >> 1) * 16 + swz / 64; C = (st & 1) * 32 + (swz % 64) / 2; }
__host__ __device__ __forceinline__ int perm32(int rho) { const int n = rho >> 4, i = rho & 15; return 8 * (i >> 2) + 4 * n + (i & 3); }

struct Unit { int pm, pn; };
struct Gemm { const bf16_t* A; const bf16_t* Bt; int M, N, K, lda; };

struct StaticOrder {
    int nM, nN, nwg, G, c, wgm, hsel;
    __host__ __device__ void init(int M, int N, int G_, int c_, int wgm_ = WGM) { nM = M / BM; nN = N / BM; nwg = nM * nN; G = G_; c = c_; wgm = wgm_; hsel = -1; }
    __host__ __device__ bool next(int i, Unit& u) const {
        const long L = (long)i * G + c; if (L >= nwg) return false;
        int wgid = (int)L; { const int q = nwg / NXCD, r = nwg % NXCD, xcd = wgid % NXCD, off = wgid / NXCD; wgid = (xcd < r ? xcd * (q + 1) : r * (q + 1) + (xcd - r) * q) + off; }
        const int nig = wgm * nN, gid = wgid / nig, fm = gid * wgm, gsz = (nM - fm) < wgm ? (nM - fm) : wgm;
        u.pm = fm + ((wgid % nig) % gsz); u.pn = (wgid % nig) / gsz; if (hsel >= 0) u.pm = (u.pm >> 4) * 32 + (u.pm & 15) + 16 * hsel; return true;
    }
    __device__ __forceinline__ void a_ready(const Unit&) const {}
    __device__ __forceinline__ void done(const Unit&) const {}
};


typedef __bf16 bf16n2 __attribute__((ext_vector_type(2)));
__device__ __forceinline__ unsigned cvt_pk_bf16(float lo, float hi) { bf16n2 v; v.x = (__bf16)lo; v.y = (__bf16)hi; return __builtin_bit_cast(unsigned, v); }
__device__ __forceinline__ float fast_sigmoid(float z) { return __builtin_amdgcn_rcpf(1.0f + __builtin_amdgcn_exp2f(-1.44269504f * z)); }
__device__ __forceinline__ float fast_silu(float z) { return z * fast_sigmoid(z); }
constexpr float SS_SCALE = 16777216.0f;
__device__ __forceinline__ float inv_rms_from_val(unsigned long long v) {
    const float tot = (float)v * (1.0f / SS_SCALE);
    return 1.0f / sqrtf(tot * (1.0f / 2048.0f) + 1e-6f);
}
__device__ __forceinline__ u32x4 pack8(const f32x4 v0, const f32x4 v1) { u32x4 w; w.x = cvt_pk_bf16(v0[0], v0[1]); w.y = cvt_pk_bf16(v0[2], v0[3]); w.z = cvt_pk_bf16(v1[0], v1[1]); w.w = cvt_pk_bf16(v1[2], v1[3]); return w; }

struct InvTab {
    const PG8_LAS float* tab; int t0, t1, t2, t3; const unsigned long long* ss;
    __device__ __forceinline__ int slot(int pm) const { return pm == t0 ? 0 : (pm == t1 ? 1 : (pm == t2 ? 2 : (pm == t3 ? 3 : -1))); }
    __device__ __forceinline__ void get(float (&inv)[2][4], int pm, int r0) const {
        const int sl = slot(pm);
        if (sl >= 0) {
#pragma unroll
            for (int ai = 0; ai < 2; ++ai)
#pragma unroll
                for (int m = 0; m < 4; ++m) inv[ai][m] = tab[sl * BM + r0 + ai * HALF + m * 16];
        } else { unsigned long long sv[2][4];
#pragma unroll
            for (int ai = 0; ai < 2; ++ai)
#pragma unroll
                for (int m = 0; m < 4; ++m) sv[ai][m] = ss[pm * BM + r0 + ai * HALF + m * 16];
#pragma unroll
            for (int ai = 0; ai < 2; ++ai)
#pragma unroll
                for (int m = 0; m < 4; ++m) inv[ai][m] = inv_rms_from_val(sv[ai][m]); }
    }
};
template <class Sched> __device__ __forceinline__ InvTab inv_preload(PG8_LAS float* tab, const Sched& S, const unsigned long long* ss) {
    InvTab T; T.tab = tab; T.t0 = -1; T.t1 = -1; T.t2 = -1; T.t3 = -1; T.ss = ss; int n = 0; Unit u;
    for (int i = 0; S.next(i, u); ++i) {
        if (T.slot(u.pm) < 0 && n < 4) {
            if (threadIdx.x < BM) tab[n * BM + threadIdx.x] = inv_rms_from_val(ss[u.pm * BM + threadIdx.x]);
            if (n == 0) T.t0 = u.pm; else if (n == 1) T.t1 = u.pm; else if (n == 2) T.t2 = u.pm; else T.t3 = u.pm;
            ++n; } }
    __syncthreads();
    return T;
}
struct EpiSwiglu {
    static constexpr bool PERM = true, AFTER_DRAIN = false;
    bf16_t* O; int ldc; InvTab it;
    __device__ __forceinline__ void operator()(const f32x4 (&acc)[2][2][4][2], const Unit& u, int wr, int wc, int fr, int fq) const {
        const int row0 = u.pm * BM + wr * 64 + fr, col0 = u.pn * HALF + wc * 32 + 8 * fq;
        float invs[2][4]; it.get(invs, u.pm, wr * 64 + fr);
#pragma unroll
        for (int ai = 0; ai < 2; ++ai)
#pragma unroll
            for (int m = 0; m < 4; ++m) { const int row = row0 + ai * HALF + m * 16; const float inv = invs[ai][m];
                f32x4 o[2];
#pragma unroll
                for (int n = 0; n < 2; ++n) { const f32x4 g = acc[ai][0][m][n] * inv, up = acc[ai][1][m][n] * inv;
#pragma unroll
                    for (int j = 0; j < 4; ++j) o[n][j] = fast_silu(g[j]) * up[j]; }
                *(u32x4*)(O + (size_t)row * ldc + col0) = pack8(o[0], o[1]); }
    }
};
struct EpiResid {
    static constexpr bool PERM = true, AFTER_DRAIN = false;
    const float* rf; const bf16_t* rb; const float* rbg; float* out; bf16_t* ob; const float* gain; bf16_t* ob2; unsigned long long* ss; float alpha; int prb, pob, pob2;
    __device__ __forceinline__ void operator()(const f32x4 (&acc)[2][2][4][2], const Unit& u, int wr, int wc, int fr, int fq) const {
        const int row0 = u.pm * BM + wr * 64 + fr, col0 = u.pn * BM + wc * 32 + 8 * fq;
        f32x4 gi[2][2], go[2][2];
#pragma unroll
        for (int bj = 0; bj < 2; ++bj)
#pragma unroll
            for (int n = 0; n < 2; ++n) { gi[bj][n] = (f32x4){1.f, 1.f, 1.f, 1.f}; go[bj][n] = gi[bj][n];
                if (rbg) { const f32x4 t = *(const f32x4*)(rbg + col0 + bj * HALF + 4 * n); gi[bj][n] = (f32x4){1.0f / t[0], 1.0f / t[1], 1.0f / t[2], 1.0f / t[3]}; }
                if (ob) go[bj][n] = *(const f32x4*)(gain + col0 + bj * HALF + 4 * n); }
#pragma unroll
        for (int ai = 0; ai < 2; ++ai)
#pragma unroll
            for (int m = 0; m < 4; ++m) { const int row = row0 + ai * HALF + m * 16; const size_t off = (size_t)row * 2048 + col0, offr = (size_t)row * prb + col0, offo = (size_t)row * pob + col0, offo2 = (size_t)row * pob2 + col0; float s = 0.f;
#pragma unroll
                for (int bj = 0; bj < 2; ++bj) {
                    f32x4 r0, r1;
                    if (rf) { r0 = *(const f32x4*)(rf + off + bj * HALF); r1 = *(const f32x4*)(rf + off + bj * HALF + 4); }
                    else { const u32x4 w = *(const u32x4*)(rb + offr + bj * HALF);
                        r0 = (f32x4){__builtin_bit_cast(float, w.x << 16), __builtin_bit_cast(float, w.x & 0xffff0000u), __builtin_bit_cast(float, w.y << 16), __builtin_bit_cast(float, w.y & 0xffff0000u)} * gi[bj][0];
                        r1 = (f32x4){__builtin_bit_cast(float, w.z << 16), __builtin_bit_cast(float, w.z & 0xffff0000u), __builtin_bit_cast(float, w.w << 16), __builtin_bit_cast(float, w.w & 0xffff0000u)} * gi[bj][1]; }
                    const f32x4 o0 = r0 + acc[ai][bj][m][0] * alpha, o1 = r1 + acc[ai][bj][m][1] * alpha;
                    if (out) { *(f32x4*)(out + off + bj * HALF) = o0; *(f32x4*)(out + off + bj * HALF + 4) = o1; }
                    if (ob) *(u32x4*)(ob + offo + bj * HALF) = pack8(o0 * go[bj][0], o1 * go[bj][1]);
                    if (ob2) *(u32x4*)(ob2 + offo2 + bj * HALF) = pack8(o0, o1);
                    s += (o0[0] * o0[0] + o0[1] * o0[1]) + (o0[2] * o0[2] + o0[3] * o0[3]) + (o1[0] * o1[0] + o1[1] * o1[1]) + (o1[2] * o1[2] + o1[3] * o1[3]); }
                if (ss) { s += __shfl_xor(s, 16); s += __shfl_xor(s, 32);
                    if (fq == 0) atomicAdd(ss + row, (unsigned long long)(s * SS_SCALE + 0.5f)); } }
    }
};
struct EpiFinal {
    static constexpr bool PERM = true, AFTER_DRAIN = false;
    const bf16_t* rb; int prb; const float* rbg; const float* fgain; float* out; unsigned long long* ss; unsigned* cnt; unsigned* tmo; float alpha; unsigned npn;
    __device__ __forceinline__ void operator()(f32x4 (&acc)[2][2][4][2], const Unit& u, int wr, int wc, int fr, int fq) const {
        const int row0 = u.pm * BM + wr * 64 + fr, col0 = u.pn * BM + wc * 32 + 8 * fq;
        { f32x4 gi[2][2];
#pragma unroll
          for (int bj = 0; bj < 2; ++bj)
#pragma unroll
            for (int n = 0; n < 2; ++n) { const f32x4 t = *(const f32x4*)(rbg + col0 + bj * HALF + 4 * n); gi[bj][n] = (f32x4){1.0f / t[0], 1.0f / t[1], 1.0f / t[2], 1.0f / t[3]}; }
#pragma unroll
          for (int ai = 0; ai < 2; ++ai)
#pragma unroll
            for (int m = 0; m < 4; ++m) { const int row = row0 + ai * HALF + m * 16; const size_t offr = (size_t)row * prb + col0; float s = 0.f;
#pragma unroll
                for (int bj = 0; bj < 2; ++bj) { const u32x4 w = *(const u32x4*)(rb + offr + bj * HALF);
                    const f32x4 r0 = (f32x4){__builtin_bit_cast(float, w.x << 16), __builtin_bit_cast(float, w.x & 0xffff0000u), __builtin_bit_cast(float, w.y << 16), __builtin_bit_cast(float, w.y & 0xffff0000u)} * gi[bj][0];
                    const f32x4 r1 = (f32x4){__builtin_bit_cast(float, w.z << 16), __builtin_bit_cast(float, w.z & 0xffff0000u), __builtin_bit_cast(float, w.w << 16), __builtin_bit_cast(float, w.w & 0xffff0000u)} * gi[bj][1];
                    const f32x4 o0 = r0 + acc[ai][bj][m][0] * alpha, o1 = r1 + acc[ai][bj][m][1] * alpha; acc[ai][bj][m][0] = o0; acc[ai][bj][m][1] = o1;
                    s += (o0[0] * o0[0] + o0[1] * o0[1]) + (o0[2] * o0[2] + o0[3] * o0[3]) + (o1[0] * o1[0] + o1[1] * o1[1]) + (o1[2] * o1[2] + o1[3] * o1[3]); }
                s += __shfl_xor(s, 16); s += __shfl_xor(s, 32);
                if (fq == 0) atomicAdd(ss + row, (unsigned long long)(s * SS_SCALE + 0.5f)); } }
        asm volatile("s_waitcnt vmcnt(0)" ::: "memory"); __syncthreads();
        if (threadIdx.x == 0) { unsigned* c = cnt + u.pm;
            (void)__hip_atomic_fetch_add(c, 1u, __ATOMIC_RELAXED, __HIP_MEMORY_SCOPE_AGENT);
            unsigned sp = 0;
            while (__hip_atomic_load(c, __ATOMIC_RELAXED, __HIP_MEMORY_SCOPE_AGENT) < npn) { __builtin_amdgcn_s_sleep(1);
                if ((++sp & 255u) == 0u) { if (__hip_atomic_load(tmo, __ATOMIC_RELAXED, __HIP_MEMORY_SCOPE_AGENT)) break; if (sp > (1u << 18)) { atomicAdd(tmo, 1u); break; } } }
        }
        __syncthreads();
        f32x4 fg[2][2];
#pragma unroll
        for (int bj = 0; bj < 2; ++bj)
#pragma unroll
            for (int n = 0; n < 2; ++n) fg[bj][n] = *(const f32x4*)(fgain + col0 + bj * HALF + 4 * n);
#pragma unroll
        for (int ai = 0; ai < 2; ++ai)
#pragma unroll
            for (int m = 0; m < 4; ++m) { const int row = row0 + ai * HALF + m * 16; const size_t off = (size_t)row * 2048 + col0;
                const float inv = inv_rms_from_val(__hip_atomic_load(ss + row, __ATOMIC_RELAXED, __HIP_MEMORY_SCOPE_AGENT));
#pragma unroll
                for (int bj = 0; bj < 2; ++bj) { *(f32x4*)(out + off + bj * HALF) = acc[ai][bj][m][0] * inv * fg[bj][0]; *(f32x4*)(out + off + bj * HALF + 4) = acc[ai][bj][m][1] * inv * fg[bj][1]; } }
    }
};
struct EpiInProj {
    static constexpr bool PERM = true, AFTER_DRAIN = false;
    bf16_t* rkv; float* lin; bf16_t* hg; InvTab it; const PG8_LAS float* oml; int pn0;
    __device__ __forceinline__ void operator()(const f32x4 (&acc)[2][2][4][2], const Unit& u, int wr, int wc, int fr, int fq) const {
        const int row0 = u.pm * BM + wr * 64 + fr, cin = wc * 32 + 8 * fq;
        const int pn = u.pn + pn0;
        float invs[2][4]; it.get(invs, u.pm, wr * 64 + fr);
        int mode;
        if (pn < 12) mode = 0; else if (pn < 14) mode = 1; else { const int sg = (pn - 14) >> 2; mode = (sg == 0 || sg == 3) ? 2 : (sg == 1 ? 3 : 4); }
#pragma unroll
        for (int bj = 0; bj < 2; ++bj) {
            f32x4 om0 = (f32x4){0.f, 0.f, 0.f, 0.f}, om1 = om0;
            if (mode == 3) { const PG8_LAS float* lp = oml + (pn - 18) * BM + bj * HALF + cin; om0 = *(const PG8_LAS f32x4*)lp; om1 = *(const PG8_LAS f32x4*)(lp + 4); }
#pragma unroll
            for (int ai = 0; ai < 2; ++ai)
#pragma unroll
                for (int m = 0; m < 4; ++m) { const int row = row0 + ai * HALF + m * 16; const float inv = invs[ai][m];
                    f32x4 v0 = acc[ai][bj][m][0] * inv, v1 = acc[ai][bj][m][1] * inv;
                    if (mode == 0) { *(u32x4*)(rkv + (size_t)row * 3072 + pn * BM + bj * HALF + cin) = pack8(v0, v1); }
                    else if (mode == 1) { const int cl = (pn - 12) * BM + bj * HALF + cin;
                        if (cl < 288) { *(f32x4*)(lin + (size_t)row * 288 + cl) = v0; *(f32x4*)(lin + (size_t)row * 288 + cl + 4) = v1; } }
                    else {
                        if (mode == 2) {
#pragma unroll
                            for (int j = 0; j < 4; ++j) { v0[j] = fast_silu(v0[j]); v1[j] = fast_silu(v1[j]); } }
                        else if (mode == 3) {
#pragma unroll
                            for (int j = 0; j < 4; ++j) { v0[j] = __logf(1.0f - om0[j] * fast_sigmoid(-v0[j])); v1[j] = __logf(1.0f - om1[j] * fast_sigmoid(-v1[j])); } }
                        *(u32x4*)(hg + (size_t)row * 4096 + (pn - 14) * BM + bj * HALF + cin) = pack8(v0, v1); } } }
    }
};
struct EpiLora {
    static constexpr bool PERM = true, AFTER_DRAIN = false;
    bf16_t* lout; const PG8_LAS float* bias; int pn0;
    __device__ __forceinline__ void operator()(const f32x4 (&acc)[2][2][4][2], const Unit& u, int wr, int wc, int fr, int fq) const {
        const int row0 = u.pm * BM + wr * 64 + fr, cin = wc * 32 + 8 * fq;
        const int pn = u.pn + pn0, mode = pn >> 2;
#pragma unroll
        for (int bj = 0; bj < 2; ++bj) {
            f32x4 b0 = (f32x4){0.f, 0.f, 0.f, 0.f}, b1 = b0;
            if (mode < 2) { const PG8_LAS float* bp = bias + pn * BM + bj * HALF + cin; b0 = *(const PG8_LAS f32x4*)bp; b1 = *(const PG8_LAS f32x4*)(bp + 4); }
#pragma unroll
            for (int ai = 0; ai < 2; ++ai)
#pragma unroll
                for (int m = 0; m < 4; ++m) { const int row = row0 + ai * HALF + m * 16;
                    f32x4 v0 = acc[ai][bj][m][0] + b0, v1 = acc[ai][bj][m][1] + b1;
#pragma unroll
                    for (int j = 0; j < 4; ++j) { const float s0 = fast_sigmoid(v0[j]), s1 = fast_sigmoid(v1[j]);
                        const float d0 = -0.60653066f * s0, d1 = -0.60653066f * s1;
                        v0[j] = mode == 0 ? d0 : (mode == 1 ? s0 : v0[j]); v1[j] = mode == 0 ? d1 : (mode == 1 ? s1 : v1[j]); }
                    *(u32x4*)(lout + (size_t)row * 3072 + pn * BM + bj * HALF + cin) = pack8(v0, v1); asm volatile("" ::: "memory"); } }
    }
};
template <class Epi, class Sched, bool ALIGN_EPI = false, bool SP2 = false>
__device__ __forceinline__ void gemm_phase(PG8_LAS unsigned char* lds, const Gemm g, const Sched& S, const Epi& E) {
    const int tid = threadIdx.x, wid = __builtin_amdgcn_readfirstlane(tid >> 6), lane = tid & 63, wr = wid >> 2, wc = wid & 3, fr = lane & 15, fq = lane >> 4;
    const int K = g.K, nt = K / BK, lda = g.lda ? g.lda : g.K;
    unsigned voffA[2], voffB[2];
#pragma unroll
    for (int i = 0; i < 2; ++i) { int R, C; stage_rc(tid * 16 + i * 8192, R, C); const int Rb = Epi::PERM ? ((R & ~31) + perm32(R & 31)) : R;
        voffA[i] = (unsigned)(R * lda + C) * 2u; voffB[i] = (unsigned)(Rb * K + C) * 2u; }
    const size_t kstep = (size_t)(BK * 2);
    const size_t hstep = (size_t)HALF * K * 2, hstepA = (size_t)HALF * lda * 2;
    const size_t tstep = 2 * hstep, tstepA = 2 * hstepA;
    const unsigned ldsw = (unsigned)wid * 1024u;
    const int aoff = lds_byte(wr * 64 + fr, fq * 8), boff = lds_byte(wc * 32 + fr, fq * 8);
#define PG8_SA(b, h) (((b) * 2 + (h)) * HTB)
#define PG8_SB(b, h) ((4 + (b) * 2 + (h)) * HTB)
#define PG8_STAGE(bufoff, gbase, voff) do { _Pragma("unroll") for (int _i = 0; _i < 2; ++_i) \
        __builtin_amdgcn_global_load_lds((const unsigned*)((const char*)(gbase) + (voff)[_i]), (PG8_LAS unsigned*)(lds + (bufoff) + ldsw + _i * 8192), 16, 0, 0); } while (0)
#define PG8_LDA(dst, b, h) do { _Pragma("unroll") for (int m = 0; m < 4; ++m) _Pragma("unroll") for (int k = 0; k < 2; ++k) dst[m][k] = *(const PG8_LAS bf16x8*)(lds + PG8_SA(b, h) + aoff + m * 2048 + k * 1024); } while (0)
#define PG8_LDB(dst, b, h) do { _Pragma("unroll") for (int n = 0; n < 2; ++n) _Pragma("unroll") for (int k = 0; k < 2; ++k) dst[n][k] = *(const PG8_LAS bf16x8*)(lds + PG8_SB(b, h) + boff + n * 2048 + k * 1024); } while (0)
#define PG8_MMA(ai, bj, At, Bt) do { __builtin_amdgcn_s_setprio(1); _Pragma("unroll") for (int m = 0; m < 4; ++m) _Pragma("unroll") for (int n = 0; n < 2; ++n) _Pragma("unroll") for (int k = 0; k < 2; ++k) \
        acc[ai][bj][m][n] = __builtin_amdgcn_mfma_f32_16x16x32_bf16(Bt[n][k], At[m][k], acc[ai][bj][m][n], 0, 0, 0); __builtin_amdgcn_s_setprio(0); } while (0)
#define PG8_WAIT_V(n) asm volatile("s_waitcnt vmcnt(" #n ")" ::: "memory")
#define PG8_WAIT_L(n) asm volatile("s_waitcnt lgkmcnt(" #n ")" ::: "memory")
#define PG8_BAR __builtin_amdgcn_s_barrier()
#define PG8_SCHED __builtin_amdgcn_sched_barrier(0)
    Unit cur, nxt; int ui = 0;
    if (!S.next(0, cur)) return;
    f32x4 acc[2][2][4][2];
#pragma unroll
    for (int a = 0; a < 2; ++a)
#pragma unroll
        for (int b = 0; b < 2; ++b)
#pragma unroll
            for (int m = 0; m < 4; ++m)
#pragma unroll
                for (int n = 0; n < 2; ++n) acc[a][b][m][n] = (f32x4){0.f, 0.f, 0.f, 0.f};
    bf16x8 At[4][2], B0[2][2], B1[2][2];
    const char* cA = (const char*)g.A + (size_t)cur.pm * tstepA; const char* cB = (const char*)g.Bt + (size_t)cur.pn * tstep;
    S.a_ready(cur);
    if constexpr (SP2) {
        PG8_STAGE(PG8_SB(0, 0), cB, voffB); PG8_STAGE(PG8_SB(0, 1), cB + hstep, voffB); PG8_STAGE(PG8_SA(0, 0), cA, voffA); PG8_STAGE(PG8_SA(0, 1), cA + hstepA, voffA);
        if (wr == 1) PG8_BAR;
        PG8_WAIT_V(2); PG8_BAR;
        PG8_STAGE(PG8_SB(1, 0), cB + kstep, voffB); PG8_STAGE(PG8_SA(1, 0), cA + kstep, voffA); PG8_STAGE(PG8_SB(1, 1), cB + hstep + kstep, voffB);
        PG8_WAIT_V(6); PG8_BAR;
    } else {
        PG8_STAGE(PG8_SB(0, 0), cB, voffB); PG8_STAGE(PG8_SA(0, 0), cA, voffA); PG8_STAGE(PG8_SB(0, 1), cB + hstep, voffB); PG8_STAGE(PG8_SA(0, 1), cA + hstepA, voffA);
        if (wr == 1) PG8_BAR;
        PG8_WAIT_V(4); PG8_BAR;
        PG8_STAGE(PG8_SB(1, 0), cB + kstep, voffB); PG8_STAGE(PG8_SA(1, 0), cA + kstep, voffA); PG8_STAGE(PG8_SB(1, 1), cB + hstep + kstep, voffB);
        PG8_WAIT_V(6); PG8_BAR;
    }
    for (;;) {
        const bool has_next = S.next(ui + 1, nxt);
        const char* nA = has_next ? (const char*)g.A + (size_t)nxt.pm * tstepA : cA; const char* nB = has_next ? (const char*)g.Bt + (size_t)nxt.pn * tstep : cB;
        for (int t = 0; t < nt; t += 2) {
            const bool last = (t == nt - 2);
            const char* a1 = cA + (size_t)(t + 1) * kstep;
            const char* a2 = last ? nA : cA + (size_t)(t + 2) * kstep; const char* b2 = last ? nB : cB + (size_t)(t + 2) * kstep;
            const char* a3 = a2 + kstep; const char* b3 = b2 + kstep;
            if (last && has_next) S.a_ready(nxt);
            if constexpr (SP2) {
            PG8_LDB(B0, 0, 0); PG8_LDB(B1, 0, 1); PG8_SCHED; PG8_LDA(At, 0, 0); PG8_STAGE(PG8_SA(1, 1), a1 + hstepA, voffA);
            PG8_WAIT_V(8); PG8_WAIT_L(0); PG8_BAR; PG8_MMA(0, 0, At, B0); PG8_MMA(0, 1, At, B1); PG8_BAR; PG8_SCHED;
            PG8_LDA(At, 0, 1); PG8_STAGE(PG8_SB(0, 0), b2, voffB); PG8_STAGE(PG8_SB(0, 1), b2 + hstep, voffB); PG8_STAGE(PG8_SA(0, 0), a2, voffA);
            PG8_WAIT_V(8); PG8_WAIT_L(0); PG8_BAR; PG8_MMA(1, 0, At, B0); PG8_MMA(1, 1, At, B1); PG8_BAR; PG8_SCHED;
            PG8_LDB(B0, 1, 0); PG8_LDB(B1, 1, 1); PG8_SCHED; PG8_LDA(At, 1, 0); PG8_STAGE(PG8_SA(0, 1), a2 + hstepA, voffA);
            PG8_WAIT_V(8); PG8_WAIT_L(0); PG8_BAR; PG8_MMA(0, 0, At, B0); PG8_MMA(0, 1, At, B1); PG8_BAR; PG8_SCHED;
            PG8_LDA(At, 1, 1); PG8_STAGE(PG8_SB(1, 0), b3, voffB); PG8_STAGE(PG8_SB(1, 1), b3 + hstep, voffB); PG8_STAGE(PG8_SA(1, 0), a3, voffA);
            PG8_WAIT_V(8); PG8_WAIT_L(0); PG8_BAR; PG8_MMA(1, 0, At, B0); PG8_MMA(1, 1, At, B1); PG8_BAR; PG8_SCHED;
            } else {
            PG8_LDB(B0, 0, 0); PG8_SCHED; PG8_LDA(At, 0, 0); PG8_STAGE(PG8_SA(1, 1), a1 + hstepA, voffA);
            PG8_WAIT_L(8); PG8_BAR; PG8_WAIT_L(0); PG8_MMA(0, 0, At, B0); PG8_BAR; PG8_SCHED;
            PG8_LDB(B1, 0, 1); PG8_STAGE(PG8_SB(0, 0), b2, voffB);
            PG8_BAR; PG8_WAIT_L(0); PG8_MMA(0, 1, At, B1); PG8_BAR;
            PG8_LDA(At, 0, 1); PG8_STAGE(PG8_SA(0, 0), a2, voffA);
            PG8_BAR; PG8_WAIT_L(0); PG8_MMA(1, 0, At, B0); PG8_BAR; PG8_SCHED;
            PG8_STAGE(PG8_SB(0, 1), b2 + hstep, voffB);
            PG8_WAIT_V(6); PG8_BAR; PG8_MMA(1, 1, At, B1); PG8_BAR;
            PG8_LDB(B0, 1, 0); PG8_SCHED; PG8_LDA(At, 1, 0); PG8_STAGE(PG8_SA(0, 1), a2 + hstepA, voffA);
            PG8_WAIT_L(8); PG8_BAR; PG8_WAIT_L(0); PG8_MMA(0, 0, At, B0); PG8_BAR; PG8_SCHED;
            PG8_LDB(B1, 1, 1); PG8_STAGE(PG8_SB(1, 0), b3, voffB);
            PG8_BAR; PG8_WAIT_L(0); PG8_MMA(0, 1, At, B1); PG8_BAR;
            PG8_LDA(At, 1, 1); PG8_STAGE(PG8_SA(1, 0), a3, voffA);
            PG8_BAR; PG8_WAIT_L(0); PG8_MMA(1, 0, At, B0); PG8_BAR; PG8_SCHED;
            PG8_STAGE(PG8_SB(1, 1), b3 + hstep, voffB);
            PG8_WAIT_V(6); PG8_BAR; PG8_MMA(1, 1, At, B1); PG8_BAR;
            }
        }
        if constexpr (ALIGN_EPI) { if (wr == 0) PG8_BAR; }
        if constexpr (!Epi::AFTER_DRAIN) { E(acc, cur, wr, wc, fr, fq); S.done(cur); }
        if (!has_next) break;
#pragma unroll
        for (int a = 0; a < 2; ++a)
#pragma unroll
            for (int b = 0; b < 2; ++b)
#pragma unroll
                for (int m = 0; m < 4; ++m)
#pragma unroll
                    for (int n = 0; n < 2; ++n) acc[a][b][m][n] = (f32x4){0.f, 0.f, 0.f, 0.f};
        cur = nxt; cA = nA; cB = nB; ++ui;
        if constexpr (ALIGN_EPI) { if (wr == 1) PG8_BAR; }
    }
    PG8_WAIT_V(0);
    if constexpr (!ALIGN_EPI) { if (wr == 0) PG8_BAR; }
    PG8_BAR;
    if constexpr (Epi::AFTER_DRAIN) { E.fused(acc, cur, wr, wc, fr, fq, lds, wid, lane); S.done(cur); }
#undef PG8_SA
#undef PG8_SB
#undef PG8_STAGE
#undef PG8_LDA
#undef PG8_LDB
#undef PG8_MMA
#undef PG8_WAIT_V
#undef PG8_WAIT_L
#undef PG8_BAR
#undef PG8_SCHED
}
}

constexpr int NWAVES = 8;
constexpr int BATCH = 4, SEQ = 8192, D = 2048, M = BATCH * SEQ, FF = 5632;
constexpr int RC = 1024, RH = 16, RN = 64;
constexpr int HC = 1024, HH = 8, HD = 128;
constexpr int RWKV_COLS = 3360, IN_COLS = 7456, NIN = 7680;
constexpr int KL = 384, NL = 3072;
#ifndef MK_N_LAUNCHES
#define MK_N_LAUNCHES 1
#endif
constexpr int N_PHASES = 12;

constexpr size_t WS_CTL = 0, CTL_BYTES = 1u << 20;
constexpr size_t WS_W1GU = CTL_BYTES;
constexpr size_t WS_W1D = WS_W1GU + (size_t)2 * FF * D * 2;
constexpr size_t WS_WIN = WS_W1D + (size_t)D * FF * 2;
constexpr size_t WS_WLORA = WS_WIN + (size_t)NIN * D * 2;
constexpr size_t WS_WOUT = WS_WLORA + (size_t)NL * KL * 2;
constexpr size_t WS_W2GU = WS_WOUT + (size_t)D * D * 2;
constexpr size_t WS_W2D = WS_W2GU + (size_t)2 * FF * D * 2;
constexpr size_t WS_SS = WS_W2D + (size_t)D * FF * 2;
constexpr size_t WS_XB = WS_SS + (1u << 20);
constexpr size_t WS_R = WS_XB + (size_t)M * D * 2;
constexpr size_t R_ACT = 0;
constexpr size_t R_RKV = 0;
constexpr size_t R_HG = R_RKV + (size_t)M * 3072 * 2;
constexpr size_t R_LIN = R_HG + (size_t)M * 4096 * 2;
constexpr size_t R_BYTES = R_LIN + (size_t)M * 288 * 4;
constexpr size_t WS_ALORA = WS_R + R_BYTES;
constexpr size_t WS_LOUT = WS_ALORA + (size_t)M * KL * 2;
constexpr size_t WS_INVN = WS_LOUT + (size_t)M * NL * 2;
constexpr size_t WS_END = WS_INVN + (size_t)M * RH * 4;
static_assert(WS_END <= ((size_t)1 << 30), "d_ws map");
constexpr int CW_PCNT = 8704;
constexpr int CW_SIG_HALF = 8192, CW_SIG_SHA = 8256, CW_SIG_SHB = 8320, CW_SIG_P4 = 8384, CW_SIG_H2 = 8448;
constexpr int CW_BAR = 4096;

constexpr int RING_BYTES = 162816;
constexpr int LDSCTL_OFF = RING_BYTES, MISC_OFF = LDSCTL_OFF + 320;
constexpr int LDS_BYTES = 163840;
static_assert(MISC_OFF + 128 <= LDS_BYTES, "LDS map");

#define GAS __attribute__((address_space(1)))
#define LAS __attribute__((address_space(3)))
typedef unsigned short bf16;
typedef unsigned v4u __attribute__((ext_vector_type(4)));
typedef unsigned v2u __attribute__((ext_vector_type(2)));
typedef float f32x4 __attribute__((ext_vector_type(4)));
#define LDS_WAIT() asm volatile("s_waitcnt lgkmcnt(0)" ::: "memory")
#define VM_WAIT() asm volatile("s_waitcnt vmcnt(0)" ::: "memory")
__device__ __forceinline__ float bflo(unsigned u) { return __builtin_bit_cast(float, u << 16); }
__device__ __forceinline__ float bfhi(unsigned u) { return __builtin_bit_cast(float, u & 0xffff0000u); }
__device__ __forceinline__ f32x4 unpack4(v2u w) { return (f32x4){bflo(w.x), bfhi(w.x), bflo(w.y), bfhi(w.y)}; }
__device__ __forceinline__ unsigned pk2(float lo, float hi) { return pg8::cvt_pk_bf16(lo, hi); }
__device__ __forceinline__ v2u pack4(f32x4 v) { v2u w; w.x = pk2(v[0], v[1]); w.y = pk2(v[2], v[3]); return w; }
using pg8::fast_sigmoid;
using pg8::fast_silu;
template <int CTRL> __device__ __forceinline__ float dpp_mov(float x) { return __builtin_bit_cast(float, __builtin_amdgcn_update_dpp(0, __builtin_bit_cast(int, x), CTRL, 0xF, 0xF, true)); }
__device__ __forceinline__ float row16_sum(float x) { x += dpp_mov<0x128>(x); x += dpp_mov<0x124>(x); x += dpp_mov<0x122>(x); x += dpp_mov<0x121>(x); return x; }
template <int CTRL, int BANK> __device__ __forceinline__ float dpp_upd(float old, float x) { return __builtin_bit_cast(float, __builtin_amdgcn_update_dpp(__builtin_bit_cast(int, old), __builtin_bit_cast(int, x), CTRL, 0xF, BANK, false)); }
__device__ __forceinline__ float tr_reduce16(const float (&v)[16], int lane) {
    float u[8], w[4], x[2];
#pragma unroll
    for (int s = 0; s < 8; ++s) { const float t = v[s + 8] + dpp_mov<0x128>(v[s + 8]), a = v[s] + dpp_mov<0x128>(v[s]); u[s] = dpp_upd<0xE4, 0x3>(t, a); }
#pragma unroll
    for (int s = 0; s < 4; ++s) { const float t = u[s + 4] + dpp_mov<0x141>(u[s + 4]), a = u[s] + dpp_mov<0x141>(u[s]); w[s] = dpp_upd<0xE4, 0x5>(t, a); }
    const bool b1 = (lane & 2) != 0, b0 = (lane & 1) != 0;
#pragma unroll
    for (int s = 0; s < 2; ++s) { const float K = b1 ? w[s + 2] : w[s], T = b1 ? w[s] : w[s + 2]; x[s] = K + dpp_mov<0x1B>(T); }
    const float K = b0 ? x[1] : x[0], T = b0 ? x[0] : x[1];
    return K + dpp_mov<0xB1>(T);
}
typedef float f32x2 __attribute__((ext_vector_type(2)));
#define LO2(v) __builtin_shufflevector(v, v, 0, 1)
#define HI2(v) __builtin_shufflevector(v, v, 2, 3)
__device__ __forceinline__ float wave_sum(float v) {
#pragma unroll
    for (int o = 1; o < 64; o <<= 1) v += __shfl_xor(v, o);
    return v;
}
#define XB_TMO      128
#define XB_XCNT(j)  (256  + 64 * (j))
#define XB_XSUB(j)  (1280 + 64 * (j))
#define XB_XGEN(j)  (2304 + 64 * (j))
#define XB_TOP      3328
#define XB_TOPGEN   3392
#define XCD_BAR_WORDS 3456
#define XB_SPIN_CAP (1u << 18)

__device__ __forceinline__ unsigned xb_ld(unsigned* p)              { return __hip_atomic_load(p, __ATOMIC_RELAXED, __HIP_MEMORY_SCOPE_AGENT); }
__device__ __forceinline__ unsigned xb_add(unsigned* p, unsigned v) { return __hip_atomic_fetch_add(p, v, __ATOMIC_RELAXED, __HIP_MEMORY_SCOPE_AGENT); }
__device__ __forceinline__ unsigned xb_xcc_id() { return (unsigned)__builtin_amdgcn_s_getreg((3 << 11) | 20) & 0xFu; }
#define XB_SPIN(cond, bar) do { unsigned _sp = 0; while (cond) { __builtin_amdgcn_s_sleep(1); \
    if ((++_sp & 255u) == 0u) { if (xb_ld(&(bar)[XB_TMO])) break; if (_sp > XB_SPIN_CAP) { atomicAdd(&(bar)[XB_TMO], 1u); break; } } } } while (0)

struct XcdBarrier {
    unsigned* bar; unsigned x;
    volatile LAS unsigned* st;
};

__device__ __forceinline__ XcdBarrier xcd_barrier_post(unsigned* bar, volatile LAS unsigned* st) {
    XcdBarrier b; b.bar = bar; b.x = xb_xcc_id(); b.st = st;
    if (threadIdx.x == 0) (void)xb_add(&bar[XB_XCNT(b.x)], 1u);
    return b;
}
__device__ __forceinline__ void xcd_barrier_complete(unsigned* bar, unsigned x, unsigned& nloc, unsigned& nx) {
    const unsigned G = gridDim.x * gridDim.y * gridDim.z;
    unsigned sum, cnt, mine, sp = 0u;
    for (;;) {
        sum = 0u; cnt = 0u; mine = 0u;
#pragma unroll
        for (unsigned j = 0; j < 16; ++j) { const unsigned c = xb_ld(&bar[XB_XCNT(j)]); sum += c; cnt += (c > 0u) ? 1u : 0u; mine = (j == x) ? c : mine; }
        if (sum == G) break;
        __builtin_amdgcn_s_sleep(1);
        if ((++sp & 255u) == 0u) { if (xb_ld(&bar[XB_TMO])) break; if (sp > XB_SPIN_CAP) { atomicAdd(&bar[XB_TMO], 1u); break; } }
    }
    nloc = mine > 0u ? mine : 1u; nx = cnt > 0u ? cnt : 1u;
}

__device__ __forceinline__ void xcd_barrier(const XcdBarrier& b) {
    asm volatile("s_waitcnt vmcnt(0)" ::: "memory");
    __syncthreads();
    if (threadIdx.x == 0) {
        unsigned* bar = b.bar;
        __builtin_amdgcn_s_waitcnt(0);
        unsigned nloc = b.st[0], nx = b.st[1];
        if (nloc == 0u) { xcd_barrier_complete(bar, b.x, nloc, nx); b.st[0] = nloc; b.st[1] = nx; }
        const unsigned old = xb_add(&bar[XB_XSUB(b.x)], 1u);
        const unsigned gen = old / nloc;
        if (old + 1u == (gen + 1u) * nloc) {
            __builtin_amdgcn_fence(__ATOMIC_RELEASE, "agent");
            asm volatile("s_waitcnt vmcnt(0)" ::: "memory");
            const unsigned og = xb_add(&bar[XB_TOP], 1u);
            const unsigned tg = og / nx;
            if (og + 1u == (tg + 1u) * nx) xb_add(&bar[XB_TOPGEN], 1u);
            else XB_SPIN(xb_ld(&bar[XB_TOPGEN]) == tg, bar);
            __builtin_amdgcn_fence(__ATOMIC_ACQUIRE, "agent");
            xb_add(&bar[XB_XGEN(b.x)], 1u);
            asm volatile("s_waitcnt vmcnt(0)" ::: "memory");
        } else {
            XB_SPIN(xb_ld(&bar[XB_XGEN(b.x)]) == gen, bar);
            __builtin_amdgcn_fence(__ATOMIC_ACQUIRE, "agent");
            asm volatile("s_waitcnt vmcnt(0)" ::: "memory");
        }
    }
    __syncthreads();
}

__device__ __forceinline__ void sig_post(unsigned* ctr) {
    __builtin_amdgcn_fence(__ATOMIC_RELEASE, "agent"); asm volatile("s_waitcnt vmcnt(0)" ::: "memory"); (void)xb_add(ctr, 1u);
}
__device__ __forceinline__ void wg_signal(unsigned* ctr) {
    asm volatile("s_waitcnt vmcnt(0)" ::: "memory"); __syncthreads();
    if (threadIdx.x == 0) sig_post(ctr);
}
__device__ __forceinline__ void wg_wait(unsigned* ctr, unsigned target, unsigned* bar) {
    if (threadIdx.x == 0) { XB_SPIN(xb_ld(ctr) < target, bar); __builtin_amdgcn_fence(__ATOMIC_ACQUIRE, "agent"); asm volatile("s_waitcnt vmcnt(0)" ::: "memory"); }
    __syncthreads();
}

struct Frame {
    LAS unsigned char* lds;
    int tid, lane, wave, vcu, G;
    const float* in[26];
    float* out; unsigned char* ws;
};
#define WSP(T, off) ((T*)(F.ws + (off)))
struct Args { const float* in[26]; float* out; unsigned char* ws; int ph_lo, ph_hi; };

struct P0Item { const float* W; bf16* WT; int K, N, kb, n0, drow0; };
__device__ __forceinline__ int map_gu(int n0, int which) { return (n0 >> 7) * 256 + which * 128 + (n0 & 127); }
constexpr int P0_I_GU = (D / 64) * (FF / 32), P0_I_DN = (FF / 64) * (D / 32), P0_I_IN = (D / 64) * (IN_COLS / 32), P0_I_OUT = (D / 64) * (D / 32);
constexpr int P0_N0 = 2 * P0_I_GU + P0_I_DN + P0_I_IN, P0_N1 = 2 * P0_I_GU + P0_I_DN + P0_I_OUT;
template <int SET> __device__ __forceinline__ P0Item p0_decode(Frame& F, const Args& A, int it) {
    constexpr int I_GU = P0_I_GU, I_DN = P0_I_DN, I_IN = P0_I_IN;
    P0Item p; int r = it;
    if (SET == 0) { if (r >= 2 * I_GU) r += 2 * I_GU; if (r >= 4 * I_GU + I_DN) r += I_DN; }
    else { r += 2 * I_GU; if (r >= 4 * I_GU) r += I_DN; if (r >= 4 * I_GU + 2 * I_DN) r += I_IN; }
    if (r < 4 * I_GU) { const int mat = r / I_GU; r -= mat * I_GU; const int nblk = FF / 32, ffn = mat >> 1, which = mat & 1;
        p.W = A.in[2 + 20 * ffn + which]; p.WT = WSP(bf16, ffn ? WS_W2GU : WS_W1GU); p.K = D; p.N = FF; p.kb = r / nblk; p.n0 = 32 * (r % nblk); p.drow0 = map_gu(p.n0, which); return p; }
    r -= 4 * I_GU;
    if (r < 2 * I_DN) { const int ffn = r / I_DN; r -= ffn * I_DN; const int nblk = D / 32;
        p.W = A.in[4 + 20 * ffn]; p.WT = WSP(bf16, ffn ? WS_W2D : WS_W1D); p.K = FF; p.N = D; p.kb = r / nblk; p.n0 = 32 * (r % nblk); p.drow0 = p.n0; return p; }
    r -= 2 * I_DN;
    if (r < I_IN) { const int nblk = IN_COLS / 32;
        p.W = A.in[6]; p.WT = WSP(bf16, WS_WIN); p.K = D; p.N = IN_COLS; p.kb = r / nblk; p.n0 = 32 * (r % nblk); p.drow0 = p.n0 < RWKV_COLS ? p.n0 : p.n0 + 224; return p; }
    r -= I_IN;
    { const int nblk = D / 32; p.W = A.in[20]; p.WT = WSP(bf16, WS_WOUT); p.K = D; p.N = D; p.kb = r / nblk; p.n0 = 32 * (r % nblk); p.drow0 = p.n0; return p; }
}
__device__ __forceinline__ void p0_dma(const P0Item& p, LAS unsigned char* tile, int lane) {
    const int half = lane >> 5, sl = lane & 31;
#pragma unroll 8
    for (int i = 0; i < 32; ++i) { const int kk = 2 * i + half;
        __builtin_amdgcn_global_load_lds((const GAS unsigned*)(p.W + (size_t)(64 * p.kb + kk) * p.N + p.n0 + (sl ^ (4 * (kk >> 3)))), (LAS unsigned*)(tile + i * 256), 4, 0, 0); }
}
__device__ __forceinline__ void p0_emit(const P0Item& p, const LAS float* t, int lane) {
    const int c = lane & 7;
#pragma unroll
    for (int j = 0; j < 4; ++j) { const int n = (lane >> 3) + 8 * j; const LAS float* s = t + (8 * c) * 32 + (n ^ (4 * c));
        v4u o; o.x = pk2(s[0 * 32], s[1 * 32]); o.y = pk2(s[2 * 32], s[3 * 32]); o.z = pk2(s[4 * 32], s[5 * 32]); o.w = pk2(s[6 * 32], s[7 * 32]);
        *(GAS v4u*)(p.WT + (size_t)(p.drow0 + n) * p.K + 64 * p.kb + 8 * c) = o; }
}
template <int SET> __device__ __forceinline__ void p0_transposes(Frame& F, const Args& A, int gw, int NGW) {
    LAS unsigned char* tiles = F.lds + F.wave * 16384;
    constexpr int NITEMS = SET == 0 ? P0_N0 : P0_N1;
    if (gw < NITEMS) {
        P0Item cur = p0_decode<SET>(F, A, gw); int buf = 0;
        p0_dma(cur, tiles, F.lane);
        for (int it = gw; it < NITEMS; it += NGW) {
            const bool more = it + NGW < NITEMS; P0Item nxt = cur;
            if (more) { nxt = p0_decode<SET>(F, A, it + NGW); p0_dma(nxt, tiles + (buf ^ 1) * 8192, F.lane); asm volatile("s_waitcnt vmcnt(32)" ::: "memory"); }
            else asm volatile("s_waitcnt vmcnt(0)" ::: "memory");
            p0_emit(cur, (const LAS float*)(tiles + buf * 8192), F.lane);
            LDS_WAIT(); asm volatile("" ::: "memory");
            cur = nxt; buf ^= 1;
        }
        asm volatile("s_waitcnt vmcnt(0)" ::: "memory");
    }
}
__device__ __forceinline__ void p0_prologue(Frame& F, const Args& A) {
    const int gw = F.vcu * NWAVES + F.wave, NGW = F.G * NWAVES;
    p0_transposes<0>(F, A, gw, NGW);
    const size_t gt = (size_t)F.vcu * (NWAVES * 64) + F.tid, NT = (size_t)F.G * NWAVES * 64;
    { GAS v4u* z = (GAS v4u*)(WSP(bf16, WS_WIN) + (size_t)RWKV_COLS * D);
      for (size_t i = gt; i < (size_t)224 * D * 2 / 16; i += NT) z[i] = (v4u){0u, 0u, 0u, 0u}; }
    { bf16* wl = WSP(bf16, WS_WLORA); const float* w2 = F.in[9]; const float* a2 = F.in[11]; const float* g2 = F.in[12];
      for (size_t i = gt; i < (size_t)NL * KL / 2; i += NT) { const int n = (int)(i / (KL / 2)), k = 2 * (int)(i % (KL / 2)); const int seg = n >> 10, c = n & 1023;
          float v0 = 0.f, v1 = 0.f;
          if (seg == 0) { if (k < 64) { v0 = w2[(size_t)k * RC + c]; v1 = w2[(size_t)(k + 1) * RC + c]; } }
          else if (seg == 1) { if (k >= 64 && k < 128) { v0 = a2[(size_t)(k - 64) * RC + c]; v1 = a2[(size_t)(k - 63) * RC + c]; } }
          else { if (k >= 128 && k < 288) { v0 = g2[(size_t)(k - 128) * RC + c]; v1 = g2[(size_t)(k - 127) * RC + c]; } }
          ((GAS unsigned*)wl)[i] = pk2(v0, v1); } }
    { GAS unsigned long long* s = (GAS unsigned long long*)(F.ws + WS_SS) + M;
      for (size_t i = gt; i < (size_t)3 * M; i += NT) s[i] = 0ull; }
    { const float* x = F.in[0]; bf16* xb = WSP(bf16, WS_XB); unsigned long long* ss0 = WSP(unsigned long long, WS_SS);
      for (int m = gw; m < M; m += NGW) { const GAS f32x4* xr = (const GAS f32x4*)(x + (size_t)m * D) + 2 * F.lane; GAS v4u* o = (GAS v4u*)(xb + (size_t)m * D) + F.lane; float s = 0.f;
#pragma unroll
          for (int j = 0; j < 4; ++j) { const f32x4 a = xr[128 * j], b = xr[128 * j + 1];
              s += (a[0] * a[0] + a[1] * a[1]) + (a[2] * a[2] + a[3] * a[3]) + (b[0] * b[0] + b[1] * b[1]) + (b[2] * b[2] + b[3] * b[3]);
              const f32x4 ga = *(const f32x4*)(F.in[1] + 8 * F.lane + 512 * j), gb = *(const f32x4*)(F.in[1] + 8 * F.lane + 512 * j + 4);
              o[64 * j] = pg8::pack8(a * ga, b * gb); }
          s = wave_sum(s);
          if (F.lane == 0) ss0[m] = (unsigned long long)(s * pg8::SS_SCALE + 0.5f); } }
}

__device__ __forceinline__ void p4_lora_in(Frame& F, int hsel, int c, int G) {
    const int NR = hsel < 0 ? M : M / 2;
#define P4_ROW(i_) (hsel < 0 ? (i_) : ((i_) / (SEQ / 2)) * SEQ + ((i_) % (SEQ / 2)) + hsel * (SEQ / 2))
    const float* lin = WSP(float, WS_R + R_LIN); bf16* al = WSP(bf16, WS_ALORA); const float* mu = F.in[7] + 3 * RC;
    const size_t gt = (size_t)c * (NWAVES * 64) + F.tid, NT = (size_t)G * NWAVES * 64;
#pragma unroll 4
    for (size_t i = gt; i < (size_t)NR * 96; i += NT) { const int mi = (int)(i / 96), m = P4_ROW(mi), q = (int)(i % 96), qc = q < 72 ? q : 0; const bool first = (m & (SEQ - 1)) == 0;
        const f32x4 p = *(const GAS f32x4*)(lin + (size_t)m * 288 + 4 * qc), pr = *(const GAS f32x4*)(lin + (size_t)(first ? m : m - 1) * 288 + 4 * qc), mv = *(const GAS f32x4*)(mu + 4 * qc);
        const f32x4 pp = first ? (f32x4){0.f, 0.f, 0.f, 0.f} : pr; f32x4 s = p + (pp - p) * mv;
#pragma unroll
        for (int j = 0; j < 4; ++j) { const float sg = fast_sigmoid(q < 16 ? 2.0f * s[j] : s[j]); s[j] = q < 16 ? 2.0f * sg - 1.0f : (q >= 32 ? sg : s[j]); }
        v2u o = pack4(s); if (q >= 72) o = (v2u){0u, 0u};
        *(GAS v2u*)(al + (size_t)m * KL + 4 * q) = o; }
    { const bf16* rkv = WSP(bf16, WS_R + R_RKV); float* invn = WSP(float, WS_INVN); const int j4 = (F.tid & 15) * 4;
      const size_t it0 = gt >> 4, step = NT >> 4; const int h = (int)(it0 & 15), ch = h * RN + j4;
      const f32x4 muk = *(const f32x4*)(F.in[7] + RC + ch), kkc = *(const f32x4*)(F.in[13] + ch);
      if ((step & 15) == 0) {
#pragma unroll 4
          for (size_t it = it0; it < (size_t)NR * RH; it += step) { const int mi = (int)(it >> 4), m = P4_ROW(mi); const bool first = (m & (SEQ - 1)) == 0;
              const f32x4 k = unpack4(*(const GAS v2u*)(rkv + (size_t)m * 3072 + RC + ch)), kr = unpack4(*(const GAS v2u*)(rkv + (size_t)(first ? m : m - 1) * 3072 + RC + ch));
              const f32x4 kp = first ? (f32x4){0.f, 0.f, 0.f, 0.f} : kr;
              const f32x4 kk = (k + (kp - k) * muk) * kkc; float s2 = (kk[0] * kk[0] + kk[1] * kk[1]) + (kk[2] * kk[2] + kk[3] * kk[3]); s2 = row16_sum(s2);
              if ((F.tid & 15) == 0) invn[(size_t)m * RH + h] = 1.0f / fmaxf(sqrtf(s2), 1e-12f); }
      } else {
          for (size_t it = it0; it < (size_t)NR * RH; it += step) { const int mi = (int)(it >> 4), m = P4_ROW(mi), h2 = (int)(it & 15), c2 = h2 * RN + j4; const bool first = (m & (SEQ - 1)) == 0;
              const f32x4 k = unpack4(*(const GAS v2u*)(rkv + (size_t)m * 3072 + RC + c2)), kr = unpack4(*(const GAS v2u*)(rkv + (size_t)(first ? m : m - 1) * 3072 + RC + c2));
              const f32x4 kp = first ? (f32x4){0.f, 0.f, 0.f, 0.f} : kr; const f32x4 mk2 = *(const f32x4*)(F.in[7] + RC + c2), kc2 = *(const f32x4*)(F.in[13] + c2);
              const f32x4 kk = (k + (kp - k) * mk2) * kc2; float s2 = (kk[0] * kk[0] + kk[1] * kk[1]) + (kk[2] * kk[2] + kk[3] * kk[3]); s2 = row16_sum(s2);
              if ((F.tid & 15) == 0) invn[(size_t)m * RH + h2] = 1.0f / fmaxf(sqrtf(s2), 1e-12f); } } }
#undef P4_ROW
}

typedef short bf16x4 __attribute__((ext_vector_type(4)));
typedef short bf16x8 __attribute__((ext_vector_type(8)));
#define MFMA32(a, b, c) __builtin_amdgcn_mfma_f32_16x16x32_bf16(a, b, c, 0, 0, 0)
#define MFMA16(a, b, c) __builtin_amdgcn_mfma_f32_16x16x16bf16_1k(a, b, c, 0, 0, 0)
__device__ __forceinline__ bf16x4 cv4(f32x4 v) { v2u w; w.x = pk2(v[0], v[1]); w.y = pk2(v[2], v[3]); return __builtin_bit_cast(bf16x4, w); }
__device__ __forceinline__ bf16x8 cv8(f32x4 a, f32x4 b) { v4u w; w.x = pk2(a[0], a[1]); w.y = pk2(a[2], a[3]); w.z = pk2(b[0], b[1]); w.w = pk2(b[2], b[3]); return __builtin_bit_cast(bf16x8, w); }
__device__ __forceinline__ bf16x8 cat8(bf16x4 a, bf16x4 b) { return __builtin_shufflevector(a, b, 0, 1, 2, 3, 4, 5, 6, 7); }
__device__ __forceinline__ bf16x8 join8(v2u a, v2u b) { v4u w; w.x = a.x; w.y = a.y; w.z = b.x; w.w = b.y; return __builtin_bit_cast(bf16x8, w); }
__device__ __forceinline__ float row16_scan(float x) { x += dpp_mov<0x111>(x); x += dpp_mov<0x112>(x); x += dpp_mov<0x114>(x); x += dpp_mov<0x118>(x); return x; }
__device__ __forceinline__ unsigned short bf1(float x) { return (unsigned short)(pk2(x, 0.f) & 0xffffu); }
constexpr int CH = 16;
constexpr int RWS = 144;
constexpr int HGS = 272;
constexpr int RWB_KG = 0, RWB_RG = 16 * RWS, RWB_KTI = 32 * RWS, RWB_BTI = 48 * RWS, RWB_KTIT = 64 * RWS, RWB_BTIT = RWB_KTIT + 2048, RWB_VT = RWB_BTIT + 2048, RWB_GL = RWB_VT + 2048, RWB_BYTES = RWB_GL + 256;
constexpr int HGB_QG = 0, HGB_KI = 16 * HGS, HGB_KIT = 32 * HGS, HGB_VT = HGB_KIT + 4096, HGB_GL = HGB_VT + 4096, HGB_BYTES = HGB_GL + 512;

__device__ __forceinline__ f32x4 padc(f32x4 r) { asm("s_nop 15" : "+v"(r)); return r; }
constexpr int NCHK = SEQ / CH;
constexpr int NRAW = 8;
constexpr int RWR_R = 0, RWR_K = 2048, RWR_V = 4096, RWR_LW = 6144, RWR_A = 8192, RWR_INV = 10240, RWR_BYTES = 10304;
constexpr int RW_OPND = 0, RW_RAW = 3 * RWB_BYTES, RW_AOP = RW_RAW + NRAW * RWR_BYTES, RW_LDS = RW_AOP + 2 * 2048;
constexpr int HGR_Q = 0, HGR_LF = 4096, HGR_V = 8192, HGR_BYTES = 12288;
constexpr int HG_OPND = 0, HG_RAW = 3 * HGB_BYTES, HG_AOP = HG_RAW + NRAW * HGR_BYTES, HG_LDS = HG_AOP + 2 * 512;
static_assert(RW_LDS <= RING_BYTES && HG_LDS <= RING_BYTES && RW_AOP % 16 == 0 && HG_AOP % 16 == 0, "scan LDS map");
#define GLDS4(gptr, lptr) __builtin_amdgcn_global_load_lds((const GAS unsigned*)(gptr), (LAS unsigned*)(lptr), 4, 0, 0)
#define WG_BAR() do { LDS_WAIT(); __builtin_amdgcn_s_barrier(); asm volatile("" ::: "memory"); } while (0)

__device__ __forceinline__ void p6_rwkv_head(Frame& F, int bh, int nsh) {
    const bf16* rkv = WSP(bf16, WS_R + R_RKV); const bf16* lout = WSP(bf16, WS_LOUT); const float* invn = WSP(float, WS_INVN); bf16* ydst = WSP(bf16, WS_LOUT);
    const int lane = F.lane, c = lane & 15, g = lane >> 4, w = F.wave;
    const int b = bh >> 4, h = bh & 15;
    const size_t rowbase = (size_t)b * SEQ;
    const int st = lane & 15, k0 = 2 * (w * 4 + (lane >> 4)), chn = h * RN + k0;
    const float mur0 = F.in[7][chn], mur1 = F.in[7][chn + 1], muk0 = F.in[7][RC + chn], muk1 = F.in[7][RC + chn + 1], muv0 = F.in[7][2 * RC + chn], muv1 = F.in[7][2 * RC + chn + 1];
    const float kk0 = F.in[13][chn], kk1 = F.in[13][chn + 1], ka0 = F.in[14][chn], ka1 = F.in[14][chn + 1];
    LAS unsigned char* const opnd = F.lds + RW_OPND; LAS unsigned char* const raw = F.lds + RW_RAW; LAS unsigned char* const aop = F.lds + RW_AOP;
#define RW3_DMA(j) do { const int r_ = 2 * w + (lane >> 5); const size_t ro_ = (rowbase + (size_t)(j) * CH + r_) * 3072 + h * RN + 2 * ((lane & 31) ^ r_); \
        LAS unsigned char* d_ = raw + ((j) % NRAW) * RWR_BYTES + w * 256; \
        GLDS4(rkv + ro_, d_ + RWR_R); GLDS4(rkv + ro_ + RC, d_ + RWR_K); GLDS4(rkv + ro_ + 2 * RC, d_ + RWR_V); GLDS4(lout + ro_, d_ + RWR_LW); GLDS4(lout + ro_ + RC, d_ + RWR_A); \
        if (lane < 2) GLDS4(invn + (rowbase + (size_t)(j) * CH + 2 * w + lane) * RH + h, raw + ((j) % NRAW) * RWR_BYTES + RWR_INV + w * 8); } while (0)
#define RW3_PROC(j) do { const LAS unsigned char* s_ = raw + ((j) % NRAW) * RWR_BYTES; const int pq_ = (k0 >> 1) ^ st, pp_ = (k0 >> 1) ^ ((st + 15) & 15); \
        const LAS unsigned char* sc_ = s_ + st * 128 + pq_ * 4; const LAS unsigned char* sp_ = ((st > 0) ? s_ + (st - 1) * 128 : raw + (((j) + NRAW - 1) % NRAW) * RWR_BYTES + 15 * 128) + pp_ * 4; \
        const bool first_ = ((j) == 0) && (st == 0); \
        const unsigned Lr = *(const LAS unsigned*)(sc_ + RWR_R), Lk = *(const LAS unsigned*)(sc_ + RWR_K), Lv = *(const LAS unsigned*)(sc_ + RWR_V); \
        const unsigned Lw = *(const LAS unsigned*)(sc_ + RWR_LW), La = *(const LAS unsigned*)(sc_ + RWR_A); \
        const unsigned Lrp = *(const LAS unsigned*)(sp_ + RWR_R), Lkp = *(const LAS unsigned*)(sp_ + RWR_K), Lvp = *(const LAS unsigned*)(sp_ + RWR_V); \
        const float Linv = *(const LAS float*)(s_ + RWR_INV + st * 4); \
        const float r0_ = bflo(Lr), r1_ = bfhi(Lr), q0_ = bflo(Lk), q1_ = bfhi(Lk), v0_ = bflo(Lv), v1_ = bfhi(Lv); \
        const float rp0_ = first_ ? 0.f : bflo(Lrp), rp1_ = first_ ? 0.f : bfhi(Lrp), qp0_ = first_ ? 0.f : bflo(Lkp), qp1_ = first_ ? 0.f : bfhi(Lkp), vp0_ = first_ ? 0.f : bflo(Lvp), vp1_ = first_ ? 0.f : bfhi(Lvp); \
        const float rs0_ = r0_ + (rp0_ - r0_) * mur0, rs1_ = r1_ + (rp1_ - r1_) * mur1, ks0_ = q0_ + (qp0_ - q0_) * muk0, ks1_ = q1_ + (qp1_ - q1_) * muk1, vs0_ = v0_ + (vp0_ - v0_) * muv0, vs1_ = v1_ + (vp1_ - v1_) * muv1; \
        const float a0_ = bflo(La), a1_ = bfhi(La), lw0_ = bflo(Lw) * 1.44269504f, lw1_ = bfhi(Lw) * 1.44269504f; \
        const float kap0_ = ks0_ * kk0 * Linv, kap1_ = ks1_ * kk1 * Linv, bet0_ = kap0_ * a0_, bet1_ = kap1_ * a1_; \
        const float kt0_ = ks0_ * (1.0f + (a0_ - 1.0f) * ka0), kt1_ = ks1_ * (1.0f + (a1_ - 1.0f) * ka1); \
        const float G0_ = row16_scan(lw0_), G1_ = row16_scan(lw1_); \
        const float eg0_ = __builtin_amdgcn_exp2f(G0_), eg1_ = __builtin_amdgcn_exp2f(G1_), ep0_ = __builtin_amdgcn_exp2f(G0_ - lw0_), ep1_ = __builtin_amdgcn_exp2f(G1_ - lw1_), ei0_ = __builtin_amdgcn_exp2f(-G0_), ei1_ = __builtin_amdgcn_exp2f(-G1_); \
        LAS unsigned char* d_ = opnd + ((j) % 3) * RWB_BYTES; \
        *(LAS unsigned*)(d_ + RWB_KG + st * RWS + k0 * 2) = pk2(kap0_ * ep0_, kap1_ * ep1_); *(LAS unsigned*)(d_ + RWB_RG + st * RWS + k0 * 2) = pk2(rs0_ * eg0_, rs1_ * eg1_); \
        const unsigned kti_ = pk2(kt0_ * ei0_, kt1_ * ei1_), bti_ = pk2(bet0_ * ei0_, bet1_ * ei1_), vv_ = pk2(vs0_, vs1_); \
        *(LAS unsigned*)(d_ + RWB_KTI + st * RWS + k0 * 2) = kti_; *(LAS unsigned*)(d_ + RWB_BTI + st * RWS + k0 * 2) = bti_; \
        *(LAS unsigned short*)(d_ + RWB_KTIT + k0 * 32 + st * 2) = (unsigned short)(kti_ & 0xffffu); *(LAS unsigned short*)(d_ + RWB_KTIT + (k0 + 1) * 32 + st * 2) = (unsigned short)(kti_ >> 16); \
        *(LAS unsigned short*)(d_ + RWB_BTIT + k0 * 32 + st * 2) = (unsigned short)(bti_ & 0xffffu); *(LAS unsigned short*)(d_ + RWB_BTIT + (k0 + 1) * 32 + st * 2) = (unsigned short)(bti_ >> 16); \
        *(LAS unsigned short*)(d_ + RWB_VT + k0 * 32 + st * 2) = (unsigned short)(vv_ & 0xffffu); *(LAS unsigned short*)(d_ + RWB_VT + (k0 + 1) * 32 + st * 2) = (unsigned short)(vv_ >> 16); \
        if (st == 15) { *(LAS float*)(d_ + RWB_GL + k0 * 4) = eg0_; *(LAS float*)(d_ + RWB_GL + k0 * 4 + 4) = eg1_; } } while (0)
    const f32x4 zero4 = (f32x4){0.f, 0.f, 0.f, 0.f};
    auto a_stage = [&](int j) {
        const LAS unsigned char* rowp = opnd + (j % 3) * RWB_BYTES + c * RWS;
        const int offA = (w == 4 || w == 7) ? RWB_BTI : RWB_KTI;
        const int offB = (w == 4 || w == 5) ? RWB_KG : RWB_RG;
        const bf16x8 a0 = *(const LAS bf16x8*)(rowp + offA + 16 * g), a1 = *(const LAS bf16x8*)(rowp + offA + 64 + 16 * g);
        const bf16x8 b0 = *(const LAS bf16x8*)(rowp + offB + 16 * g), b1 = *(const LAS bf16x8*)(rowp + offB + 64 + 16 * g);
        f32x4 N = MFMA32(a0, b0, zero4); N = MFMA32(a1, b1, N);
        const bool strict = (w == 4 || w == 5);
#pragma unroll
        for (int r = 0; r < 4; ++r) { const int rj = 4 * g + r; N[r] = (strict ? (c > rj) : (c >= rj)) ? N[r] : 0.f; }
        f32x4 res = N;
        if (w == 4) {
            f32x4 N1t = MFMA32(b0, a0, zero4); N1t = MFMA32(b1, a1, N1t);
            f32x4 X;
#pragma unroll
            for (int r = 0; r < 4; ++r) { const int rj = 4 * g + r; N1t[r] = (rj > c) ? N1t[r] : 0.f; X[r] = ((rj == c) ? 1.0f : 0.f) - N[r]; }
            bf16x4 an = cv4(N), at = cv4(N1t);
            f32x4 P = MFMA16(at, an, zero4), Pt = MFMA16(an, at, zero4);
            X = MFMA16(cv4(Pt), cv4(X), padc(X));
            an = cv4(P); at = cv4(Pt);
            P = MFMA16(at, an, zero4); Pt = MFMA16(an, at, zero4);
            X = MFMA16(cv4(Pt), cv4(X), padc(X));
            an = cv4(P); at = cv4(Pt);
            Pt = MFMA16(an, at, zero4);
            X = MFMA16(cv4(Pt), cv4(X), padc(X));
            res = X;
        }
        *(LAS bf16x4*)(aop + (j & 1) * 2048 + (w - 4) * 512 + lane * 8) = cv4(res);
    };
    f32x4 Z[4];
#pragma unroll
    for (int i = 0; i < 4; ++i) Z[i] = (f32x4){0.f, 0.f, 0.f, 0.f};
    { RW3_DMA(0); RW3_DMA(1); RW3_DMA(2); RW3_DMA(3); RW3_DMA(4); RW3_DMA(5); RW3_DMA(6); RW3_DMA(7); asm volatile("s_waitcnt vmcnt(0)" ::: "memory"); WG_BAR(); RW3_PROC(0); RW3_PROC(1); WG_BAR(); if (w >= 4) a_stage(0); WG_BAR(); }
    if (w < 4) {
        for (int ci = 0; ci < NCHK; ++ci) {
            const int t0 = ci * CH; const int jp = (ci + 2 < NCHK) ? ci + 2 : NCHK - 1;
            if (nsh > 0 && ci == NCHK / 2 - NRAW) { if (w == 0 && lane == 0) { unsigned* ctl_ = WSP(unsigned, WS_CTL); XB_SPIN(xb_ld(ctl_ + CW_SIG_H2) < (unsigned)nsh, ctl_ + CW_BAR); __builtin_amdgcn_fence(__ATOMIC_ACQUIRE, "agent"); asm volatile("s_waitcnt vmcnt(0)" ::: "memory"); } WG_BAR(); }
            RW3_PROC(jp);
            const LAS unsigned char* cur = opnd + (ci % 3) * RWB_BYTES; const LAS unsigned char* rowp = cur + c * RWS; const LAS unsigned char* ap = aop + (ci & 1) * 2048 + lane * 8;
            bf16x8 pKg[2], pRg[2];
#pragma unroll
            for (int s = 0; s < 2; ++s) {
                pKg[s] = join8(*(const LAS v2u*)(rowp + RWB_KG + 64 * s + 8 * g), *(const LAS v2u*)(rowp + RWB_KG + 64 * s + 32 + 8 * g));
                pRg[s] = join8(*(const LAS v2u*)(rowp + RWB_RG + 64 * s + 8 * g), *(const LAS v2u*)(rowp + RWB_RG + 64 * s + 32 + 8 * g)); }
            const bf16x4 bV = *(const LAS bf16x4*)(cur + RWB_VT + (16 * w + c) * 32 + 8 * g);
            const bf16x4 xT = *(const LAS bf16x4*)(ap), n2 = *(const LAS bf16x4*)(ap + 512), n3 = *(const LAS bf16x4*)(ap + 1024), n4 = *(const LAS bf16x4*)(ap + 1536);
            const bf16x8 bZ0 = cv8(Z[0], Z[1]), bZ1 = cv8(Z[2], Z[3]);
            const bf16x4 z4 = (bf16x4){0, 0, 0, 0};
            f32x4 W = MFMA32(pKg[0], bZ0, zero4); W = MFMA32(pKg[1], bZ1, W); W = MFMA32(cat8(n2, z4), cat8(bV, z4), W);
            const f32x4 U = MFMA16(xT, cv4(W), zero4);
            const bf16x4 nU = cv4(-U);
            const bf16x8 bVU = cat8(bV, nU);
            f32x4 Y = MFMA32(pRg[0], bZ0, zero4); Y = MFMA32(pRg[1], bZ1, Y); Y = MFMA32(cat8(n3, n4), bVU, Y);
#pragma unroll
            for (int r = 0; r < 4; ++r) ydst[(rowbase + t0 + 4 * g + r) * 3072 + h * RN + 16 * w + c] = bf1(Y[r]);
#pragma unroll
            for (int zt = 0; zt < 4; ++zt) {
                const bf16x4 aK = *(const LAS bf16x4*)(cur + RWB_KTIT + (16 * zt + c) * 32 + 8 * g), aB = *(const LAS bf16x4*)(cur + RWB_BTIT + (16 * zt + c) * 32 + 8 * g);
                const f32x4 gl = *(const LAS f32x4*)(cur + RWB_GL + (16 * zt + 4 * g) * 4);
                Z[zt] = MFMA32(cat8(aK, aB), bVU, Z[zt]) * gl; }
            { const int jn = (ci + NRAW < NCHK) ? ci + NRAW : NCHK - 1; RW3_DMA(jn); }
            if (ci == NCHK / 2 - 1) asm volatile("s_waitcnt vmcnt(0)" ::: "memory");
            asm volatile("s_waitcnt vmcnt(50)" ::: "memory");
            WG_BAR();
            if (ci == NCHK / 2 - 1 && w == 0 && lane == 0) sig_post(WSP(unsigned, WS_CTL) + CW_SIG_HALF);
        }
    } else {
        for (int ci = 0; ci < NCHK; ++ci) {
            const int jp = (ci + 2 < NCHK) ? ci + 2 : NCHK - 1, ja = (ci + 1 < NCHK) ? ci + 1 : NCHK - 1;
            if (nsh > 0 && ci == NCHK / 2 - NRAW) WG_BAR();
            RW3_PROC(jp);
            a_stage(ja);
            { const int jn = (ci + NRAW < NCHK) ? ci + NRAW : NCHK - 1; RW3_DMA(jn); }
            asm volatile("s_waitcnt vmcnt(30)" ::: "memory");
            WG_BAR();
        }
    }
#undef RW3_DMA
#undef RW3_PROC
}

__device__ __forceinline__ void p6_hgrn_head(Frame& F, int hb) {
    const bf16* hg = WSP(bf16, WS_R + R_HG); bf16* odst = WSP(bf16, WS_R + R_HG);
    const int lane = F.lane, c = lane & 15, g = lane >> 4, w = F.wave;
    const int bh = hb >> 1, half = hb & 1, b = bh >> 3, h = bh & 7, vb = half * 4 + (w & 3);
    const size_t rowbase = (size_t)b * SEQ;
    const int st = lane & 15, k0 = 4 * (w * 4 + (lane >> 4));
    LAS unsigned char* const opnd = F.lds + HG_OPND; LAS unsigned char* const raw = F.lds + HG_RAW; LAS unsigned char* const aop = F.lds + HG_AOP;
#define HG3_DMA(j) do { _Pragma("unroll") for (int rr_ = 0; rr_ < 2; ++rr_) { const int r_ = 2 * w + rr_; const bf16* p_ = hg + (rowbase + (size_t)(j) * CH + r_) * 4096 + h * HD + 2 * (2 * ((lane >> 1) ^ r_) + (lane & 1)); \
        LAS unsigned char* d_ = raw + ((j) % NRAW) * HGR_BYTES + r_ * 256; GLDS4(p_, d_ + HGR_Q); GLDS4(p_ + HC, d_ + HGR_LF); GLDS4(p_ + 2 * HC, d_ + HGR_V); } } while (0)
#define HG3_PROC(j) do { const LAS unsigned char* s_ = raw + ((j) % NRAW) * HGR_BYTES + st * 256 + (((k0 >> 2) ^ st) * 8); LAS unsigned char* d_ = opnd + ((j) % 3) * HGB_BYTES; \
        const v2u Lq = *(const LAS v2u*)(s_ + HGR_Q), Lf = *(const LAS v2u*)(s_ + HGR_LF), Lv = *(const LAS v2u*)(s_ + HGR_V); \
        const f32x4 q_ = unpack4(Lq); f32x4 lf_ = unpack4(Lf) * 1.44269504f; f32x4 qg_, ki_, eg_; \
        _Pragma("unroll") for (int e = 0; e < 4; ++e) { const float G_ = row16_scan(lf_[e]); eg_[e] = __builtin_amdgcn_exp2f(G_); qg_[e] = q_[e] * eg_[e]; ki_[e] = (1.0f - __builtin_amdgcn_exp2f(lf_[e])) * __builtin_amdgcn_exp2f(-G_); } \
        const v2u kw_ = pack4(ki_); *(LAS v2u*)(d_ + HGB_QG + st * HGS + k0 * 2) = pack4(qg_); *(LAS v2u*)(d_ + HGB_KI + st * HGS + k0 * 2) = kw_; \
        *(LAS unsigned short*)(d_ + HGB_KIT + (k0 + 0) * 32 + st * 2) = (unsigned short)(kw_.x & 0xffffu); *(LAS unsigned short*)(d_ + HGB_KIT + (k0 + 1) * 32 + st * 2) = (unsigned short)(kw_.x >> 16); \
        *(LAS unsigned short*)(d_ + HGB_KIT + (k0 + 2) * 32 + st * 2) = (unsigned short)(kw_.y & 0xffffu); *(LAS unsigned short*)(d_ + HGB_KIT + (k0 + 3) * 32 + st * 2) = (unsigned short)(kw_.y >> 16); \
        *(LAS unsigned short*)(d_ + HGB_VT + (k0 + 0) * 32 + st * 2) = (unsigned short)(Lv.x & 0xffffu); *(LAS unsigned short*)(d_ + HGB_VT + (k0 + 1) * 32 + st * 2) = (unsigned short)(Lv.x >> 16); \
        *(LAS unsigned short*)(d_ + HGB_VT + (k0 + 2) * 32 + st * 2) = (unsigned short)(Lv.y & 0xffffu); *(LAS unsigned short*)(d_ + HGB_VT + (k0 + 3) * 32 + st * 2) = (unsigned short)(Lv.y >> 16); \
        if (st == 15) *(LAS f32x4*)(d_ + HGB_GL + k0 * 4) = eg_; } while (0)
    const f32x4 zero4 = (f32x4){0.f, 0.f, 0.f, 0.f};
    auto a_stage = [&](int j) {
        const LAS unsigned char* rowp = opnd + (j % 3) * HGB_BYTES + c * HGS;
        f32x4 N = zero4;
#pragma unroll
        for (int s = 0; s < 4; ++s) { const bf16x8 nQ = *(const LAS bf16x8*)(rowp + HGB_QG + 64 * s + 16 * g), nK = *(const LAS bf16x8*)(rowp + HGB_KI + 64 * s + 16 * g); N = MFMA32(nK, nQ, N); }
#pragma unroll
        for (int r = 0; r < 4; ++r) N[r] = (c >= 4 * g + r) ? N[r] : 0.f;
        *(LAS bf16x4*)(aop + (j & 1) * 512 + lane * 8) = cv4(N);
    };
    f32x4 Z[8];
#pragma unroll
    for (int i = 0; i < 8; ++i) Z[i] = (f32x4){0.f, 0.f, 0.f, 0.f};
    { HG3_DMA(0); HG3_DMA(1); HG3_DMA(2); HG3_DMA(3); HG3_DMA(4); HG3_DMA(5); HG3_DMA(6); HG3_DMA(7); asm volatile("s_waitcnt vmcnt(0)" ::: "memory"); WG_BAR(); HG3_PROC(0); HG3_PROC(1); WG_BAR(); if (w == 4) a_stage(0); WG_BAR(); }
    if (w < 4) {
        for (int ci = 0; ci < NCHK; ++ci) {
            const int t0 = ci * CH; const int jp = (ci + 2 < NCHK) ? ci + 2 : NCHK - 1;
            HG3_PROC(jp);
            const LAS unsigned char* cur = opnd + (ci % 3) * HGB_BYTES; const LAS unsigned char* rowp = cur + c * HGS;
            f32x4 Y = zero4;
#pragma unroll
            for (int s = 0; s < 4; ++s) {
                const bf16x8 pQ = join8(*(const LAS v2u*)(rowp + HGB_QG + 64 * s + 8 * g), *(const LAS v2u*)(rowp + HGB_QG + 64 * s + 32 + 8 * g));
                Y = MFMA32(pQ, cv8(Z[2 * s], Z[2 * s + 1]), Y); }
            const bf16x4 bV = *(const LAS bf16x4*)(cur + HGB_VT + (16 * vb + c) * 32 + 8 * g);
            const bf16x4 n = *(const LAS bf16x4*)(aop + (ci & 1) * 512 + lane * 8);
            const bf16x4 z4 = (bf16x4){0, 0, 0, 0};
            Y = MFMA32(cat8(n, z4), cat8(bV, z4), Y);
#pragma unroll
            for (int r = 0; r < 4; ++r) odst[(rowbase + t0 + 4 * g + r) * 4096 + 2 * HC + h * HD + 16 * vb + c] = bf1(Y[r]);
#pragma unroll
            for (int zt = 0; zt < 8; ++zt) {
                const bf16x4 aK = *(const LAS bf16x4*)(cur + HGB_KIT + (16 * zt + c) * 32 + 8 * g);
                const f32x4 gl = *(const LAS f32x4*)(cur + HGB_GL + (16 * zt + 4 * g) * 4);
                Z[zt] = MFMA16(aK, bV, Z[zt]) * gl; }
            { const int jn = (ci + NRAW < NCHK) ? ci + NRAW : NCHK - 1; HG3_DMA(jn); }
            if (ci == NCHK / 2 - 1) asm volatile("s_waitcnt vmcnt(0)" ::: "memory");
            asm volatile("s_waitcnt vmcnt(50)" ::: "memory");
            WG_BAR();
            if (ci == NCHK / 2 - 1 && w == 0 && lane == 0) sig_post(WSP(unsigned, WS_CTL) + CW_SIG_HALF);
        }
    } else {
        for (int ci = 0; ci < NCHK; ++ci) {
            const int jp = (ci + 2 < NCHK) ? ci + 2 : NCHK - 1, ja = (ci + 1 < NCHK) ? ci + 1 : NCHK - 1;
            HG3_PROC(jp);
            if (w == 4) a_stage(ja);
            { const int jn = (ci + NRAW < NCHK) ? ci + NRAW : NCHK - 1; HG3_DMA(jn); }
            asm volatile("s_waitcnt vmcnt(30)" ::: "memory");
            WG_BAR();
        }
    }
#undef HG3_DMA
#undef HG3_PROC
}
#undef WG_BAR
__device__ __forceinline__ void p7_post(Frame& F, int hsel, int c, int G);
constexpr int NSCAN = BATCH * RH + 2 * BATCH * HH;
__device__ __forceinline__ void p6_shadow(Frame& F, const Args& A, int c, int G) {
    const unsigned long long* ss = WSP(unsigned long long, WS_SS);
    {   pg8::Gemm g{WSP(bf16, WS_XB), WSP(bf16, WS_WIN) + (size_t)26 * 256 * D, M, 4 * 256, D, 0}; pg8::StaticOrder S; S.init(M, 4 * 256, G, c);
        pg8::EpiInProj E{WSP(bf16, WS_R + R_RKV), WSP(float, WS_R + R_LIN), WSP(bf16, WS_R + R_HG), pg8::inv_preload((PG8_LAS float*)(F.lds + pg8::STAGE_BYTES), S, ss + M), (PG8_LAS float*)(F.lds + pg8::STAGE_BYTES + 4096), 26};
        pg8::gemm_phase<pg8::EpiInProj, pg8::StaticOrder, true, true>(F.lds, g, S, E); }
    {   int kl = KL; asm volatile("" : "+s"(kl));
        pg8::Gemm g{WSP(bf16, WS_ALORA), WSP(bf16, WS_WLORA) + (size_t)8 * 256 * KL, M, 4 * 256, kl, 0}; pg8::StaticOrder S; S.init(M, 4 * 256, G, c);
        pg8::EpiLora E{WSP(bf16, WS_LOUT), (PG8_LAS float*)(F.lds + pg8::STAGE_BYTES), 8};
        pg8::gemm_phase<pg8::EpiLora, pg8::StaticOrder, true, true>(F.lds, g, S, E); }
    p0_transposes<1>(F, A, c * NWAVES + F.wave, G * NWAVES);
}
__device__ __forceinline__ void p6_shadow_pre(Frame& F, int c, int G) {
    unsigned* ctl = WSP(unsigned, WS_CTL);
    p4_lora_in(F, 1, c, G);
    wg_signal(ctl + CW_SIG_P4); wg_wait(ctl + CW_SIG_P4, (unsigned)G, ctl + CW_BAR);
    {   int kl = KL; asm volatile("" : "+s"(kl));
        pg8::Gemm g{WSP(bf16, WS_ALORA), WSP(bf16, WS_WLORA), M, 8 * 256, kl, 0}; pg8::StaticOrder S; S.init(M / 2, 8 * 256, G, c); S.hsel = 1;
        PG8_LAS float* bt = (PG8_LAS float*)(F.lds + pg8::STAGE_BYTES);
        for (int cix = F.tid; cix < 2 * RC; cix += NWAVES * 64) bt[cix] = cix < RC ? F.in[8][cix] : F.in[10][cix - RC];
        __syncthreads();
        pg8::EpiLora E{WSP(bf16, WS_LOUT), bt, 0};
        pg8::gemm_phase<pg8::EpiLora, pg8::StaticOrder, true, true>(F.lds, g, S, E); }
    wg_signal(ctl + CW_SIG_H2);
}
__device__ __forceinline__ void p6_shadow_b(Frame& F, int c, int G) {
    unsigned* ctl = WSP(unsigned, WS_CTL);
    wg_signal(ctl + CW_SIG_SHA); wg_wait(ctl + CW_SIG_SHA, (unsigned)G, ctl + CW_BAR);
    wg_wait(ctl + CW_SIG_HALF, (unsigned)NSCAN, ctl + CW_BAR);
    p7_post(F, 0, c, G);
    wg_signal(ctl + CW_SIG_SHB); wg_wait(ctl + CW_SIG_SHB, (unsigned)G, ctl + CW_BAR);
    {   pg8::Gemm g{WSP(bf16, WS_XB), WSP(bf16, WS_WOUT), M, D, D, 0}; pg8::StaticOrder S; S.init(M / 2, D, G, c, 4); S.hsel = 0;
        pg8::EpiResid E{nullptr, (const bf16*)F.out, nullptr, nullptr, (bf16*)F.out + D, F.in[21], nullptr, WSP(unsigned long long, WS_SS) + 2 * M, 1.0f, 2 * D, 2 * D, 2048};
        pg8::gemm_phase<pg8::EpiResid, pg8::StaticOrder, true, true>(F.lds, g, S, E); }
}
__device__ __forceinline__ void p6_scans(Frame& F, const Args& A) {
    const int bx = (int)blockIdx.x;
    if (F.G == 2 * NSCAN) {
        const int x = bx & 7, idx = (bx >> 3) * 4 + (x & 3);
        if (x < 4) { if (idx < BATCH * RH) p6_rwkv_head(F, idx, NSCAN); else p6_hgrn_head(F, idx - BATCH * RH); } else { p6_shadow_pre(F, idx, NSCAN); p6_shadow(F, A, idx, NSCAN); p6_shadow_b(F, idx, NSCAN); } }
    else if (F.G > NSCAN) { if (bx < NSCAN) { if (bx < BATCH * RH) p6_rwkv_head(F, bx, F.G - NSCAN); else p6_hgrn_head(F, bx - BATCH * RH); } else { p6_shadow_pre(F, bx - NSCAN, F.G - NSCAN); p6_shadow(F, A, bx - NSCAN, F.G - NSCAN); p6_shadow_b(F, bx - NSCAN, F.G - NSCAN); } }
    else {
        for (int u = bx; u < NSCAN; u += F.G) { if (u < BATCH * RH) p6_rwkv_head(F, u, 0); else p6_hgrn_head(F, u - BATCH * RH); }
        __syncthreads(); p6_shadow(F, A, bx, F.G);
    }
}

__device__ __forceinline__ void p7_post(Frame& F, int hsel, int c, int G) {
    const int NR = hsel < 0 ? M : M / 2;
    const bf16* rkv = WSP(bf16, WS_R + R_RKV); const bf16* hg = WSP(bf16, WS_R + R_HG); const bf16* lout = WSP(bf16, WS_LOUT); bf16* yc = WSP(bf16, WS_XB);
    { const int half = F.tid >> 8, ch = (F.tid & 255) * 4;
      const f32x4 mu_r = *(const f32x4*)(F.in[7] + ch), mu_k = *(const f32x4*)(F.in[7] + RC + ch), mu_v = *(const f32x4*)(F.in[7] + 2 * RC + ch);
      const f32x4 kac = *(const f32x4*)(F.in[14] + ch), rkc = *(const f32x4*)(F.in[15] + ch), lnw = *(const f32x4*)(F.in[16] + ch), lnb = *(const f32x4*)(F.in[17] + ch);
#pragma unroll 2
      for (int i = c * 2 + half; i < NR; i += 2 * G) { const int m = hsel < 0 ? i : (i / (SEQ / 2)) * SEQ + (i % (SEQ / 2)) + hsel * (SEQ / 2);
          const bool first = (m & (SEQ - 1)) == 0; const size_t mp = first ? m : m - 1;
          const bf16* p = rkv + (size_t)m * 3072 + ch; const bf16* q = rkv + mp * 3072 + ch; const bf16* l = lout + (size_t)m * 3072 + ch;
          const f32x4 y = unpack4(*(const GAS v2u*)(l));
          const f32x4 r = unpack4(*(const GAS v2u*)(p)), k = unpack4(*(const GAS v2u*)(p + RC)), v = unpack4(*(const GAS v2u*)(p + 2 * RC));
          f32x4 rp = unpack4(*(const GAS v2u*)(q)), kp = unpack4(*(const GAS v2u*)(q + RC)), vp = unpack4(*(const GAS v2u*)(q + 2 * RC));
          if (first) { rp = (f32x4){0.f, 0.f, 0.f, 0.f}; kp = rp; vp = rp; }
          const f32x4 a = unpack4(*(const GAS v2u*)(l + RC)), gg = unpack4(*(const GAS v2u*)(l + 2 * RC));
          const f32x4 rs = r + (rp - r) * mu_r, ks = k + (kp - k) * mu_k, vs = v + (vp - v) * mu_v;
          const f32x4 km = ks * (1.0f + (a - 1.0f) * kac);
          const f32x4 bt = rs * km * rkc; float bon = (bt[0] + bt[1]) + (bt[2] + bt[3]); bon = row16_sum(bon);
          float s1 = (y[0] + y[1]) + (y[2] + y[3]); s1 = row16_sum(s1); const float mean = s1 * (1.0f / 64.0f);
          const f32x4 d = y - mean; float s2 = (d[0] * d[0] + d[1] * d[1]) + (d[2] * d[2] + d[3] * d[3]); s2 = row16_sum(s2);
          const float rstd = 1.0f / sqrtf(s2 * (1.0f / 64.0f) + 64e-5f);
          const f32x4 o = ((d * rstd) * lnw + lnb + vs * bon) * gg;
          *(GAS v2u*)(yc + (size_t)m * 2048 + ch) = pack4(o); } }
    { const int quarter = F.tid >> 7, ch = (F.tid & 127) * 8;
      const f32x4 nw0 = *(const f32x4*)(F.in[19] + ch), nw1 = *(const f32x4*)(F.in[19] + ch + 4);
#pragma unroll 4
      for (int i = c * 4 + quarter; i < NR; i += 4 * G) { const int m = hsel < 0 ? i : (i / (SEQ / 2)) * SEQ + (i % (SEQ / 2)) + hsel * (SEQ / 2);
          const v4u ow = *(const GAS v4u*)(hg + (size_t)m * 4096 + 2 * HC + ch), gw4 = *(const GAS v4u*)(hg + (size_t)m * 4096 + 3 * HC + ch);
          const f32x4 o0 = (f32x4){bflo(ow.x), bfhi(ow.x), bflo(ow.y), bfhi(ow.y)}, o1 = (f32x4){bflo(ow.z), bfhi(ow.z), bflo(ow.w), bfhi(ow.w)};
          const f32x4 g0 = (f32x4){bflo(gw4.x), bfhi(gw4.x), bflo(gw4.y), bfhi(gw4.y)}, g1 = (f32x4){bflo(gw4.z), bfhi(gw4.z), bflo(gw4.w), bfhi(gw4.w)};
          float s2 = ((o0[0] * o0[0] + o0[1] * o0[1]) + (o0[2] * o0[2] + o0[3] * o0[3])) + ((o1[0] * o1[0] + o1[1] * o1[1]) + (o1[2] * o1[2] + o1[3] * o1[3])); s2 = row16_sum(s2);
          const float rstd = 1.0f / sqrtf(s2 * (1.0f / 128.0f) + 1e-6f);
          *(GAS v4u*)(yc + (size_t)m * 2048 + RC + ch) = pg8::pack8(o0 * rstd * nw0 * g0, o1 * rstd * nw1 * g1); } }
}

__device__ __forceinline__ void p11_final(Frame& F) {
    const int gw = F.vcu * NWAVES + F.wave, NGW = F.G * NWAVES; const float* fg = F.in[25];
    const bf16* x3 = WSP(bf16, WS_XB); const unsigned long long* ss3 = WSP(unsigned long long, WS_SS) + 3 * M;
    f32x4 gn[8];
#pragma unroll
    for (int j = 0; j < 4; ++j) { gn[2 * j] = *(const f32x4*)(fg + 8 * F.lane + 512 * j); gn[2 * j + 1] = *(const f32x4*)(fg + 8 * F.lane + 512 * j + 4); }
#pragma unroll 2
    for (int m = gw; m < M; m += NGW) { const GAS v4u* xr = (const GAS v4u*)(x3 + (size_t)m * D) + F.lane; GAS f32x4* o = (GAS f32x4*)(F.out + (size_t)m * D) + 2 * F.lane;
        const float inv = pg8::inv_rms_from_val(ss3[m]);
#pragma unroll
        for (int j = 0; j < 4; ++j) { const v4u w = xr[64 * j];
            o[128 * j] = (f32x4){bflo(w.x), bfhi(w.x), bflo(w.y), bfhi(w.y)} * inv * gn[2 * j]; o[128 * j + 1] = (f32x4){bflo(w.z), bfhi(w.z), bflo(w.w), bfhi(w.w)} * inv * gn[2 * j + 1]; } }
}

__global__ void __launch_bounds__(NWAVES * 64, 2) mk_fwd(Args args) {
    extern __shared__ __attribute__((aligned(16))) unsigned char lds[];
    Frame F;
    F.lds = (LAS unsigned char*)lds;
    F.tid = threadIdx.x; F.lane = F.tid & 63; F.wave = __builtin_amdgcn_readfirstlane(F.tid >> 6);
    F.G = gridDim.x; { const int bx = blockIdx.x; F.vcu = (F.G % 8 == 0) ? (bx % 8) * (F.G / 8) + bx / 8 : bx; }
#pragma unroll
    for (int i = 0; i < 26; ++i) F.in[i] = args.in[i];
    F.out = args.out; F.ws = args.ws;
    for (int u = F.tid; u < (LDS_BYTES - LDSCTL_OFF) / 4; u += NWAVES * 64) ((LAS unsigned*)(F.lds + LDSCTL_OFF))[u] = 0u;
    __syncthreads();
    const int lo = args.ph_lo, hi = args.ph_hi;
    XcdBarrier bar; bar.bar = (unsigned*)(args.ws + WS_CTL) + CW_BAR; bar.x = 0; bar.st = nullptr;
    if (hi - lo > 1) bar = xcd_barrier_post((unsigned*)(args.ws + WS_CTL) + CW_BAR, (volatile LAS unsigned*)(F.lds + MISC_OFF) + 8);
#ifndef PH_MASK
#define PH_MASK 0xFFF
#endif
#define IN(k) (((PH_MASK >> (k)) & 1) && lo <= (k) && (k) < hi)
#define SEAM(k) do { if (IN(k) && IN((k) + 1)) xcd_barrier(bar); } while (0)
    const bf16* xb = WSP(bf16, WS_XB); unsigned long long* ss = WSP(unsigned long long, WS_SS);
    const int cid = (int)blockIdx.x;
    bf16* const x2b = (bf16*)F.out + D;
    const bool fuse = (F.G % 256) == 0;

    if (IN(0)) { p0_prologue(F, args); } SEAM(0);
    if (IN(1)) {
        pg8::Gemm g{xb, WSP(bf16, WS_W1GU), M, 2 * FF, D, 0}; pg8::StaticOrder S; S.init(M, 2 * FF, F.G, cid);
        pg8::EpiSwiglu E{WSP(bf16, WS_R + R_ACT), FF, pg8::inv_preload((PG8_LAS float*)(F.lds + pg8::STAGE_BYTES), S, ss)};
        pg8::gemm_phase<pg8::EpiSwiglu, pg8::StaticOrder, true, true>(F.lds, g, S, E);
    } SEAM(1);
    if (IN(2)) {
        pg8::Gemm g{WSP(bf16, WS_R + R_ACT), WSP(bf16, WS_W1D), M, D, FF, 0}; pg8::StaticOrder S; S.init(M, D, F.G, cid, 4);
        pg8::EpiResid E{F.in[0], nullptr, nullptr, nullptr, WSP(bf16, WS_XB), F.in[5], (bf16*)F.out, ss + M, 0.5f, 2048, 2048, 2 * D};
        pg8::gemm_phase<pg8::EpiResid, pg8::StaticOrder, true, true>(F.lds, g, S, E);
    } SEAM(2);
    if (IN(3)) {
        pg8::Gemm g{xb, WSP(bf16, WS_WIN), M, 26 * 256, D, 0}; pg8::StaticOrder S; S.init(M, 26 * 256, F.G, cid);
        PG8_LAS float* omt = (PG8_LAS float*)(F.lds + pg8::STAGE_BYTES + 4096);
        for (int cix = F.tid; cix < HC; cix += NWAVES * 64) omt[cix] = 1.0f - fast_sigmoid(F.in[18][cix] - F.in[18][HC + cix]);
        pg8::EpiInProj E{WSP(bf16, WS_R + R_RKV), WSP(float, WS_R + R_LIN), WSP(bf16, WS_R + R_HG), pg8::inv_preload((PG8_LAS float*)(F.lds + pg8::STAGE_BYTES), S, ss + M), omt, 0};
        pg8::gemm_phase<pg8::EpiInProj, pg8::StaticOrder, true, true>(F.lds, g, S, E);
    } SEAM(3);
    const bool split = F.G > NSCAN;
    if (IN(4)) { p4_lora_in(F, split ? 0 : -1, F.vcu, F.G); } SEAM(4);
    if (IN(5)) {
        int kl = KL; asm volatile("" : "+s"(kl));
        pg8::Gemm g{WSP(bf16, WS_ALORA), WSP(bf16, WS_WLORA), M, 8 * 256, kl, 0}; pg8::StaticOrder S; S.init(split ? M / 2 : M, 8 * 256, F.G, cid); S.hsel = split ? 0 : -1;
        PG8_LAS float* bt = (PG8_LAS float*)(F.lds + pg8::STAGE_BYTES);
        for (int cix = F.tid; cix < 2 * RC; cix += NWAVES * 64) bt[cix] = cix < RC ? F.in[8][cix] : F.in[10][cix - RC];
        __syncthreads();
        pg8::EpiLora E{WSP(bf16, WS_LOUT), bt, 0};
        pg8::gemm_phase<pg8::EpiLora, pg8::StaticOrder, true, true>(F.lds, g, S, E);
    } SEAM(5);
    if (IN(6)) { p6_scans(F, args); } SEAM(6);
    if (IN(7)) { p7_post(F, split ? 1 : -1, F.vcu, F.G); } SEAM(7);
    if (IN(8)) {
        pg8::Gemm g{xb, WSP(bf16, WS_WOUT), M, D, D, 0}; pg8::StaticOrder S; S.init(split ? M / 2 : M, D, F.G, cid, 4); S.hsel = split ? 1 : -1;
        pg8::EpiResid E{nullptr, (const bf16*)F.out, nullptr, nullptr, x2b, F.in[21], nullptr, ss + 2 * M, 1.0f, 2 * D, 2 * D, 2048};
        pg8::gemm_phase<pg8::EpiResid, pg8::StaticOrder, true, true>(F.lds, g, S, E);
    } SEAM(8);
    if (IN(9)) {
        pg8::Gemm g{x2b, WSP(bf16, WS_W2GU), M, 2 * FF, D, 2 * D}; pg8::StaticOrder S; S.init(M, 2 * FF, F.G, cid);
        pg8::EpiSwiglu E{WSP(bf16, WS_R + R_ACT), FF, pg8::inv_preload((PG8_LAS float*)(F.lds + pg8::STAGE_BYTES), S, ss + 2 * M)};
        pg8::gemm_phase<pg8::EpiSwiglu, pg8::StaticOrder, true, true>(F.lds, g, S, E);
    } SEAM(9);
    if (IN(10)) {
        pg8::Gemm g{WSP(bf16, WS_R + R_ACT), WSP(bf16, WS_W2D), M, D, FF, 0}; pg8::StaticOrder S; S.init(M, D, F.G, cid, 4);
        if (fuse) { pg8::EpiFinal E{x2b, 2 * D, F.in[21], F.in[25], F.out, ss + 3 * M, WSP(unsigned, WS_CTL) + CW_PCNT, WSP(unsigned, WS_CTL) + CW_BAR + XB_TMO, 0.5f, (unsigned)(D / 256)};
            pg8::gemm_phase<pg8::EpiFinal, pg8::StaticOrder, true, true>(F.lds, g, S, E); }
        else { pg8::EpiResid E{nullptr, x2b, F.in[21], nullptr, nullptr, nullptr, WSP(bf16, WS_XB), ss + 3 * M, 0.5f, 2 * D, 2048, 2048};
            pg8::gemm_phase<pg8::EpiResid, pg8::StaticOrder, true, true>(F.lds, g, S, E); }
    }
    if (!fuse) { SEAM(10); if (IN(11)) { p11_final(F); } }
#undef IN
#undef SEAM
}

extern "C" void kernel_launch(void* const* d_in, const int* in_sizes, int n_in, void* d_out, int out_size, void* d_ws, size_t ws_size, hipStream_t stream) {
    static int grid = 0;
    if (grid == 0) {
        if (n_in != 26 || in_sizes[0] != M * D || out_size != M * D || ws_size < WS_END) { fprintf(stderr, "kernel_launch: unexpected problem (n_in %d, ws %zu < %zu)\n", n_in, ws_size, (size_t)WS_END); grid = -1; return; }
        int dev = 0, cus = 0, per_cu = 0;
        if (hipGetDevice(&dev) != hipSuccess || hipDeviceGetAttribute(&cus, hipDeviceAttributeMultiprocessorCount, dev) != hipSuccess) { grid = -1; return; }
        if (hipFuncSetAttribute((const void*)mk_fwd, hipFuncAttributeMaxDynamicSharedMemorySize, LDS_BYTES) != hipSuccess) { grid = -1; return; }
        if (hipOccupancyMaxActiveBlocksPerMultiprocessor(&per_cu, (const void*)mk_fwd, NWAVES * 64, LDS_BYTES) != hipSuccess || per_cu < 1) fprintf(stderr, "kernel_launch: occupancy query reports %d\n", per_cu);
        (void)hipGetLastError();
        grid = cus;
    }
    if (grid < 0) return;
    (void)hipMemsetAsync((char*)d_ws + WS_CTL, 0, CTL_BYTES, stream);
    Args a{};
    for (int i = 0; i < 26; ++i) a.in[i] = (const float*)d_in[i];
    a.out = (float*)d_out; a.ws = (unsigned char*)d_ws;
    constexpr int NL_ = MK_N_LAUNCHES;
    for (int li = 0; li < NL_; ++li) {
        a.ph_lo = (NL_ == 1) ? 0 : li; a.ph_hi = (NL_ == 1) ? N_PHASES : li + 1;
        hipLaunchKernelGGL(mk_fwd, dim3(grid), dim3(NWAVES * 64), LDS_BYTES, stream, a);
    }
}
```

```cpp
#include <hip/hip_runtime.h>
#include <cstdio>
#include <cstdint>
namespace pg8 {
#define PG8_LAS __attribute__((address_space(3)))
typedef unsigned short bf16_t;
typedef short bf16x8 __attribute__((ext_vector_type(8)));
typedef float f32x4 __attribute__((ext_vector_type(4)));
typedef unsigned u32x4 __attribute__((ext_vector_type(4)));
constexpr int BM = 256, BK = 64, HALF = 128, HTB = HALF * BK * 2  , STAGE_BYTES = 8 * HTB, NXCD = 8, WGM = 8;

__host__ __device__ __forceinline__ int lds_byte(int r, int c) { const int st = (r >> 4) * 2 + (c >> 5), rr = r & 15, cc = c & 31, ob = rr * 64 + cc * 2; return st * 1024 + (ob ^ (((ob >> 9) & 1) << 5)); }
__host__ __device__ __forceinline__ void stage_rc(int b, int& R, int& C) { const int st = b / 1024, sb = b % 1024, swz = sb ^ (((sb >> 9) & 1) << 5); R = (st >> 1) * 16 + swz / 64; C = (st & 1) * 32 + (swz % 64) / 2; }
__host__ __device__ __forceinline__ int perm32(int rho) { const int n = rho >> 4, i = rho & 15; return 8 * (i >> 2) + 4 * n + (i & 3); }

struct Unit { int pm, pn; };
struct Gemm { const bf16_t* A; const bf16_t* Bt; int M, N, K, lda; };

struct StaticOrder {
    int nM, nN, nwg, G, c, wgm, hsel;
    __host__ __device__ void init(int M, int N, int G_, int c_, int wgm_ = WGM) { nM = M / BM; nN = N / BM; nwg = nM * nN; G = G_; c = c_; wgm = wgm_; hsel = -1; }
    __host__ __device__ bool next(int i, Unit& u) const {
        const long L = (long)i * G + c; if (L >= nwg) return false;
        int wgid = (int)L; { const int q = nwg / NXCD, r = nwg % NXCD, xcd = wgid % NXCD, off = wgid / NXCD; wgid = (xcd < r ? xcd * (q + 1) : r * (q + 1) + (xcd - r) * q) + off; }
        const int nig = wgm * nN, gid = wgid / nig, fm = gid * wgm, gsz = (nM - fm) < wgm ? (nM - fm) : wgm;
        u.pm = fm + ((wgid % nig) % gsz); u.pn = (wgid % nig) / gsz; if (hsel >= 0) u.pm = (u.pm >> 4) * 32 + (u.pm & 15) + 16 * hsel; return true;
    }
    __device__ __forceinline__ void a_ready(const Unit&) const {}
    __device__ __forceinline__ void done(const Unit&) const {}
};


typedef __bf16 bf16n2 __attribute__((ext_vector_type(2)));
__device__ __forceinline__ unsigned cvt_pk_bf16(float lo, float hi) { bf16n2 v; v.x = (__bf16)lo; v.y = (__bf16)hi; return __builtin_bit_cast(unsigned, v); }
__device__ __forceinline__ float fast_sigmoid(float z) { return __builtin_amdgcn_rcpf(1.0f + __builtin_amdgcn_exp2f(-1.44269504f * z)); }
__device__ __forceinline__ float fast_silu(float z) { return z * fast_sigmoid(z); }
constexpr float SS_SCALE = 16777216.0f;
__device__ __forceinline__ float inv_rms_from_val(unsigned long long v) {
    const float tot = (float)v * (1.0f / SS_SCALE);
    return 1.0f / sqrtf(tot * (1.0f / 2048.0f) + 1e-6f);
}
__device__ __forceinline__ u32x4 pack8(const f32x4 v0, const f32x4 v1) { u32x4 w; w.x = cvt_pk_bf16(v0[0], v0[1]); w.y = cvt_pk_bf16(v0[2], v0[3]); w.z = cvt_pk_bf16(v1[0], v1[1]); w.w = cvt_pk_bf16(v1[2], v1[3]); return w; }

struct InvTab {
    const PG8_LAS float* tab; int t0, t1, t2, t3; const unsigned long long* ss;
    __device__ __forceinline__ int slot(int pm) const { return pm == t0 ? 0 : (pm == t1 ? 1 : (pm == t2 ? 2 : (pm == t3 ? 3 : -1))); }
    __device__ __forceinline__ void get(float (&inv)[2][4], int pm, int r0) const {
        const int sl = slot(pm);
        if (sl >= 0) {
#pragma unroll
            for (int ai = 0; ai < 2; ++ai)
#pragma unroll
                for (int m = 0; m < 4; ++m) inv[ai][m] = tab[sl * BM + r0 + ai * HALF + m * 16];
        } else { unsigned long long sv[2][4];
#pragma unroll
            for (int ai = 0; ai < 2; ++ai)
#pragma unroll
                for (int m = 0; m < 4; ++m) sv[ai][m] = ss[pm * BM + r0 + ai * HALF + m * 16];
#pragma unroll
            for (int ai = 0; ai < 2; ++ai)
#pragma unroll
                for (int m = 0; m < 4; ++m) inv[ai][m] = inv_rms_from_val(sv[ai][m]); }
    }
};
template <class Sched> __device__ __forceinline__ InvTab inv_preload(PG8_LAS float* tab, const Sched& S, const unsigned long long* ss) {
    InvTab T; T.tab = tab; T.t0 = -1; T.t1 = -1; T.t2 = -1; T.t3 = -1; T.ss = ss; int n = 0; Unit u;
    for (int i = 0; S.next(i, u); ++i) {
        if (T.slot(u.pm) < 0 && n < 4) {
            if (threadIdx.x < BM) tab[n * BM + threadIdx.x] = inv_rms_from_val(ss[u.pm * BM + threadIdx.x]);
            if (n == 0) T.t0 = u.pm; else if (n == 1) T.t1 = u.pm; else if (n == 2) T.t2 = u.pm; else T.t3 = u.pm;
            ++n; } }
    __syncthreads();
    return T;
}
struct EpiSwiglu {
    static constexpr bool PERM = true, AFTER_DRAIN = false;
    bf16_t* O; int ldc; InvTab it;
    __device__ __forceinline__ void operator()(const f32x4 (&acc)[2][2][4][2], const Unit& u, int wr, int wc, int fr, int fq) const {
        const int row0 = u.pm * BM + wr * 64 + fr, col0 = u.pn * HALF + wc * 32 + 8 * fq;
        float invs[2][4]; it.get(invs, u.pm, wr * 64 + fr);
#pragma unroll
        for (int ai = 0; ai < 2; ++ai)
#pragma unroll
            for (int m = 0; m < 4; ++m) { const int row = row0 + ai * HALF + m * 16; const float inv = invs[ai][m], invn = inv * -1.44269504f;
                f32x4 o[2];
#pragma unroll
                for (int n = 0; n < 2; ++n) { const f32x4 g = acc[ai][0][m][n] * inv, up = acc[ai][1][m][n] * inv, t = acc[ai][0][m][n] * invn; f32x4 e, r;
#pragma unroll
                    for (int j = 0; j < 4; ++j) e[j] = __builtin_amdgcn_exp2f(t[j]);
                    const f32x4 d = e + 1.0f;
#pragma unroll
                    for (int j = 0; j < 4; ++j) r[j] = __builtin_amdgcn_rcpf(d[j]);
                    o[n] = (g * r) * up; }
                *(u32x4*)(O + (size_t)row * ldc + col0) = pack8(o[0], o[1]); }
    }
};
struct EpiResid {
    static constexpr bool PERM = true, AFTER_DRAIN = false;
    const float* rf; const bf16_t* rb; const float* rbg; float* out; bf16_t* ob; const float* gain; bf16_t* ob2; unsigned long long* ss; float alpha; int prb, pob, pob2;
    __device__ __forceinline__ void operator()(const f32x4 (&acc)[2][2][4][2], const Unit& u, int wr, int wc, int fr, int fq) const {
        const int row0 = u.pm * BM + wr * 64 + fr, col0 = u.pn * BM + wc * 32 + 8 * fq;
        f32x4 gi[2][2], go[2][2];
#pragma unroll
        for (int bj = 0; bj < 2; ++bj)
#pragma unroll
            for (int n = 0; n < 2; ++n) { gi[bj][n] = (f32x4){1.f, 1.f, 1.f, 1.f}; go[bj][n] = gi[bj][n];
                if (rbg) { const f32x4 t = *(const f32x4*)(rbg + col0 + bj * HALF + 4 * n); gi[bj][n] = (f32x4){1.0f / t[0], 1.0f / t[1], 1.0f / t[2], 1.0f / t[3]}; }
                if (ob) go[bj][n] = *(const f32x4*)(gain + col0 + bj * HALF + 4 * n); }
#pragma unroll
        for (int ai = 0; ai < 2; ++ai)
#pragma unroll
            for (int m = 0; m < 4; ++m) { const int row = row0 + ai * HALF + m * 16; const size_t off = (size_t)row * 2048 + col0, offr = (size_t)row * prb + col0, offo = (size_t)row * pob + col0, offo2 = (size_t)row * pob2 + col0; float s = 0.f;
#pragma unroll
                for (int bj = 0; bj < 2; ++bj) {
                    f32x4 r0, r1;
                    if (rf) { r0 = *(const f32x4*)(rf + off + bj * HALF); r1 = *(const f32x4*)(rf + off + bj * HALF + 4); }
                    else { const u32x4 w = *(const u32x4*)(rb + offr + bj * HALF);
                        r0 = (f32x4){__builtin_bit_cast(float, w.x << 16), __builtin_bit_cast(float, w.x & 0xffff0000u), __builtin_bit_cast(float, w.y << 16), __builtin_bit_cast(float, w.y & 0xffff0000u)} * gi[bj][0];
                        r1 = (f32x4){__builtin_bit_cast(float, w.z << 16), __builtin_bit_cast(float, w.z & 0xffff0000u), __builtin_bit_cast(float, w.w << 16), __builtin_bit_cast(float, w.w & 0xffff0000u)} * gi[bj][1]; }
                    const f32x4 o0 = r0 + acc[ai][bj][m][0] * alpha, o1 = r1 + acc[ai][bj][m][1] * alpha;
                    if (out) { *(f32x4*)(out + off + bj * HALF) = o0; *(f32x4*)(out + off + bj * HALF + 4) = o1; }
                    if (ob) *(u32x4*)(ob + offo + bj * HALF) = pack8(o0 * go[bj][0], o1 * go[bj][1]);
                    if (ob2) *(u32x4*)(ob2 + offo2 + bj * HALF) = pack8(o0, o1);
                    s += (o0[0] * o0[0] + o0[1] * o0[1]) + (o0[2] * o0[2] + o0[3] * o0[3]) + (o1[0] * o1[0] + o1[1] * o1[1]) + (o1[2] * o1[2] + o1[3] * o1[3]); }
                if (ss) { s += __shfl_xor(s, 16); s += __shfl_xor(s, 32);
                    if (fq == 0) atomicAdd(ss + row, (unsigned long long)(s * SS_SCALE + 0.5f)); } }
    }
};
struct EpiFinal {
    static constexpr bool PERM = true, AFTER_DRAIN = false;
    const bf16_t* rb; int prb; const float* rbg; const float* fgain; float* out; unsigned long long* ss; unsigned* cnt; unsigned* tmo; float alpha; unsigned npn;
    __device__ __forceinline__ void operator()(f32x4 (&acc)[2][2][4][2], const Unit& u, int wr, int wc, int fr, int fq) const {
        const int row0 = u.pm * BM + wr * 64 + fr, col0 = u.pn * BM + wc * 32 + 8 * fq;
        { f32x4 gi[2][2];
#pragma unroll
          for (int bj = 0; bj < 2; ++bj)
#pragma unroll
            for (int n = 0; n < 2; ++n) { const f32x4 t = *(const f32x4*)(rbg + col0 + bj * HALF + 4 * n); gi[bj][n] = (f32x4){1.0f / t[0], 1.0f / t[1], 1.0f / t[2], 1.0f / t[3]}; }
#pragma unroll
          for (int ai = 0; ai < 2; ++ai)
#pragma unroll
            for (int m = 0; m < 4; ++m) { const int row = row0 + ai * HALF + m * 16; const size_t offr = (size_t)row * prb + col0; float s = 0.f;
#pragma unroll
                for (int bj = 0; bj < 2; ++bj) { const u32x4 w = *(const u32x4*)(rb + offr + bj * HALF);
                    const f32x4 r0 = (f32x4){__builtin_bit_cast(float, w.x << 16), __builtin_bit_cast(float, w.x & 0xffff0000u), __builtin_bit_cast(float, w.y << 16), __builtin_bit_cast(float, w.y & 0xffff0000u)} * gi[bj][0];
                    const f32x4 r1 = (f32x4){__builtin_bit_cast(float, w.z << 16), __builtin_bit_cast(float, w.z & 0xffff0000u), __builtin_bit_cast(float, w.w << 16), __builtin_bit_cast(float, w.w & 0xffff0000u)} * gi[bj][1];
                    const f32x4 o0 = r0 + acc[ai][bj][m][0] * alpha, o1 = r1 + acc[ai][bj][m][1] * alpha; acc[ai][bj][m][0] = o0; acc[ai][bj][m][1] = o1;
                    s += (o0[0] * o0[0] + o0[1] * o0[1]) + (o0[2] * o0[2] + o0[3] * o0[3]) + (o1[0] * o1[0] + o1[1] * o1[1]) + (o1[2] * o1[2] + o1[3] * o1[3]); }
                s += __shfl_xor(s, 16); s += __shfl_xor(s, 32);
                if (fq == 0) atomicAdd(ss + row, (unsigned long long)(s * SS_SCALE + 0.5f)); } }
        asm volatile("s_waitcnt vmcnt(0)" ::: "memory"); __syncthreads();
        if (threadIdx.x == 0) { unsigned* c = cnt + u.pm;
            (void)__hip_atomic_fetch_add(c, 1u, __ATOMIC_RELAXED, __HIP_MEMORY_SCOPE_AGENT);
            unsigned sp = 0;
            while (__hip_atomic_load(c, __ATOMIC_RELAXED, __HIP_MEMORY_SCOPE_AGENT) < npn) { __builtin_amdgcn_s_sleep(1);
                if ((++sp & 255u) == 0u) { if (__hip_atomic_load(tmo, __ATOMIC_RELAXED, __HIP_MEMORY_SCOPE_AGENT)) break; if (sp > (1u << 18)) { atomicAdd(tmo, 1u); break; } } }
        }
        __syncthreads();
        f32x4 fg[2][2];
#pragma unroll
        for (int bj = 0; bj < 2; ++bj)
#pragma unroll
            for (int n = 0; n < 2; ++n) fg[bj][n] = *(const f32x4*)(fgain + col0 + bj * HALF + 4 * n);
#pragma unroll
        for (int ai = 0; ai < 2; ++ai)
#pragma unroll
            for (int m = 0; m < 4; ++m) { const int row = row0 + ai * HALF + m * 16; const size_t off = (size_t)row * 2048 + col0;
                const float inv = inv_rms_from_val(__hip_atomic_load(ss + row, __ATOMIC_RELAXED, __HIP_MEMORY_SCOPE_AGENT));
#pragma unroll
                for (int bj = 0; bj < 2; ++bj) { *(f32x4*)(out + off + bj * HALF) = acc[ai][bj][m][0] * inv * fg[bj][0]; *(f32x4*)(out + off + bj * HALF + 4) = acc[ai][bj][m][1] * inv * fg[bj][1]; } }
    }
};
struct EpiInProj {
    static constexpr bool PERM = true, AFTER_DRAIN = false;
    bf16_t* rkv; float* lin; bf16_t* hg; InvTab it; const PG8_LAS float* oml; int pn0;
    __device__ __forceinline__ void operator()(const f32x4 (&acc)[2][2][4][2], const Unit& u, int wr, int wc, int fr, int fq) const {
        const int row0 = u.pm * BM + wr * 64 + fr, cin = wc * 32 + 8 * fq;
        const int pn = u.pn + pn0;
        float invs[2][4]; it.get(invs, u.pm, wr * 64 + fr);
        int mode;
        if (pn < 12) mode = 0; else if (pn < 14) mode = 1; else { const int sg = (pn - 14) >> 2; mode = (sg == 0 || sg == 3) ? 2 : (sg == 1 ? 3 : 4); }
#pragma unroll
        for (int bj = 0; bj < 2; ++bj) {
            f32x4 om0 = (f32x4){0.f, 0.f, 0.f, 0.f}, om1 = om0;
            if (mode == 3) { const PG8_LAS float* lp = oml + (pn - 18) * BM + bj * HALF + cin; om0 = *(const PG8_LAS f32x4*)lp; om1 = *(const PG8_LAS f32x4*)(lp + 4); }
#pragma unroll
            for (int ai = 0; ai < 2; ++ai)
#pragma unroll
                for (int m = 0; m < 4; ++m) { const int row = row0 + ai * HALF + m * 16; const float inv = invs[ai][m];
                    f32x4 v0 = acc[ai][bj][m][0] * inv, v1 = acc[ai][bj][m][1] * inv;
                    if (mode == 0) { *(u32x4*)(rkv + (size_t)row * 3072 + pn * BM + bj * HALF + cin) = pack8(v0, v1); }
                    else if (mode == 1) { const int cl = (pn - 12) * BM + bj * HALF + cin;
                        if (cl < 288) { *(f32x4*)(lin + (size_t)row * 288 + cl) = v0; *(f32x4*)(lin + (size_t)row * 288 + cl + 4) = v1; } }
                    else {
                        if (mode == 2) {
#pragma unroll
                            for (int j = 0; j < 4; ++j) { v0[j] = fast_silu(v0[j]); v1[j] = fast_silu(v1[j]); } }
                        else if (mode == 3) {
#pragma unroll
                            for (int j = 0; j < 4; ++j) { v0[j] = __logf(1.0f - om0[j] * fast_sigmoid(-v0[j])); v1[j] = __logf(1.0f - om1[j] * fast_sigmoid(-v1[j])); } }
                        *(u32x4*)(hg + (size_t)row * 4096 + (pn - 14) * BM + bj * HALF + cin) = pack8(v0, v1); } } }
    }
};
struct EpiLora {
    static constexpr bool PERM = true, AFTER_DRAIN = false;
    bf16_t* lout; const PG8_LAS float* bias; int pn0;
    __device__ __forceinline__ void operator()(const f32x4 (&acc)[2][2][4][2], const Unit& u, int wr, int wc, int fr, int fq) const {
        const int row0 = u.pm * BM + wr * 64 + fr, cin = wc * 32 + 8 * fq;
        const int pn = u.pn + pn0, mode = pn >> 2;
#pragma unroll
        for (int bj = 0; bj < 2; ++bj) {
            f32x4 b0 = (f32x4){0.f, 0.f, 0.f, 0.f}, b1 = b0;
            if (mode < 2) { const PG8_LAS float* bp = bias + pn * BM + bj * HALF + cin; b0 = *(const PG8_LAS f32x4*)bp; b1 = *(const PG8_LAS f32x4*)(bp + 4); }
#pragma unroll
            for (int ai = 0; ai < 2; ++ai)
#pragma unroll
                for (int m = 0; m < 4; ++m) { const int row = row0 + ai * HALF + m * 16;
                    f32x4 v0 = acc[ai][bj][m][0] + b0, v1 = acc[ai][bj][m][1] + b1;
#pragma unroll
                    for (int j = 0; j < 4; ++j) { const float s0 = fast_sigmoid(v0[j]), s1 = fast_sigmoid(v1[j]);
                        const float d0 = -0.60653066f * s0, d1 = -0.60653066f * s1;
                        v0[j] = mode == 0 ? d0 : (mode == 1 ? s0 : v0[j]); v1[j] = mode == 0 ? d1 : (mode == 1 ? s1 : v1[j]); }
                    *(u32x4*)(lout + (size_t)row * 3072 + pn * BM + bj * HALF + cin) = pack8(v0, v1); asm volatile("" ::: "memory"); } }
    }
};
template <class Epi, class Sched, bool ALIGN_EPI = false, bool SP2 = false>
__device__ __forceinline__ void gemm_phase(PG8_LAS unsigned char* lds, const Gemm g, const Sched& S, const Epi& E) {
    const int tid = threadIdx.x, wid = __builtin_amdgcn_readfirstlane(tid >> 6), lane = tid & 63, wr = wid >> 2, wc = wid & 3, fr = lane & 15, fq = lane >> 4;
    const int K = g.K, nt = K / BK, lda = g.lda ? g.lda : g.K;
    unsigned voffA[2], voffB[2];
#pragma unroll
    for (int i = 0; i < 2; ++i) { int R, C; stage_rc(tid * 16 + i * 8192, R, C); const int Rb = Epi::PERM ? ((R & ~31) + perm32(R & 31)) : R;
        voffA[i] = (unsigned)(R * lda + C) * 2u; voffB[i] = (unsigned)(Rb * K + C) * 2u; }
    const size_t kstep = (size_t)(BK * 2);
    const size_t hstep = (size_t)HALF * K * 2, hstepA = (size_t)HALF * lda * 2;
    const size_t tstep = 2 * hstep, tstepA = 2 * hstepA;
    const unsigned ldsw = (unsigned)wid * 1024u;
    const int aoff = lds_byte(wr * 64 + fr, fq * 8), boff = lds_byte(wc * 32 + fr, fq * 8);
#define PG8_SA(b, h) (((b) * 2 + (h)) * HTB)
#define PG8_SB(b, h) ((4 + (b) * 2 + (h)) * HTB)
#define PG8_STAGE(bufoff, gbase, voff) do { _Pragma("unroll") for (int _i = 0; _i < 2; ++_i) \
        __builtin_amdgcn_global_load_lds((const unsigned*)((const char*)(gbase) + (voff)[_i]), (PG8_LAS unsigned*)(lds + (bufoff) + ldsw + _i * 8192), 16, 0, 0); } while (0)
#define PG8_LDA(dst, b, h) do { _Pragma("unroll") for (int m = 0; m < 4; ++m) _Pragma("unroll") for (int k = 0; k < 2; ++k) dst[m][k] = *(const PG8_LAS bf16x8*)(lds + PG8_SA(b, h) + aoff + m * 2048 + k * 1024); } while (0)
#define PG8_LDB(dst, b, h) do { _Pragma("unroll") for (int n = 0; n < 2; ++n) _Pragma("unroll") for (int k = 0; k < 2; ++k) dst[n][k] = *(const PG8_LAS bf16x8*)(lds + PG8_SB(b, h) + boff + n * 2048 + k * 1024); } while (0)
#define PG8_MMA(ai, bj, At, Bt) do { __builtin_amdgcn_s_setprio(1); _Pragma("unroll") for (int m = 0; m < 4; ++m) _Pragma("unroll") for (int n = 0; n < 2; ++n) _Pragma("unroll") for (int k = 0; k < 2; ++k) \
        acc[ai][bj][m][n] = __builtin_amdgcn_mfma_f32_16x16x32_bf16(Bt[n][k], At[m][k], acc[ai][bj][m][n], 0, 0, 0); __builtin_amdgcn_s_setprio(0); } while (0)
#define PG8_WAIT_V(n) asm volatile("s_waitcnt vmcnt(" #n ")" ::: "memory")
#define PG8_WAIT_L(n) asm volatile("s_waitcnt lgkmcnt(" #n ")" ::: "memory")
#define PG8_BAR __builtin_amdgcn_s_barrier()
#define PG8_SCHED __builtin_amdgcn_sched_barrier(0)
    Unit cur, nxt; int ui = 0;
    if (!S.next(0, cur)) return;
    f32x4 acc[2][2][4][2];
#pragma unroll
    for (int a = 0; a < 2; ++a)
#pragma unroll
        for (int b = 0; b < 2; ++b)
#pragma unroll
            for (int m = 0; m < 4; ++m)
#pragma unroll
                for (int n = 0; n < 2; ++n) acc[a][b][m][n] = (f32x4){0.f, 0.f, 0.f, 0.f};
    bf16x8 At[4][2], B0[2][2], B1[2][2];
    const char* cA = (const char*)g.A + (size_t)cur.pm * tstepA; const char* cB = (const char*)g.Bt + (size_t)cur.pn * tstep;
    S.a_ready(cur);
    if constexpr (SP2) {
        PG8_STAGE(PG8_SB(0, 0), cB, voffB); PG8_STAGE(PG8_SB(0, 1), cB + hstep, voffB); PG8_STAGE(PG8_SA(0, 0), cA, voffA); PG8_STAGE(PG8_SA(0, 1), cA + hstepA, voffA);
        if (wr == 1) PG8_BAR;
        PG8_WAIT_V(2); PG8_BAR;
        PG8_STAGE(PG8_SB(1, 0), cB + kstep, voffB); PG8_STAGE(PG8_SA(1, 0), cA + kstep, voffA); PG8_STAGE(PG8_SB(1, 1), cB + hstep + kstep, voffB);
        PG8_WAIT_V(6); PG8_BAR;
    } else {
        PG8_STAGE(PG8_SB(0, 0), cB, voffB); PG8_STAGE(PG8_SA(0, 0), cA, voffA); PG8_STAGE(PG8_SB(0, 1), cB + hstep, voffB); PG8_STAGE(PG8_SA(0, 1), cA + hstepA, voffA);
        if (wr == 1) PG8_BAR;
        PG8_WAIT_V(4); PG8_BAR;
        PG8_STAGE(PG8_SB(1, 0), cB + kstep, voffB); PG8_STAGE(PG8_SA(1, 0), cA + kstep, voffA); PG8_STAGE(PG8_SB(1, 1), cB + hstep + kstep, voffB);
        PG8_WAIT_V(6); PG8_BAR;
    }
    for (;;) {
        const bool has_next = S.next(ui + 1, nxt);
        const char* nA = has_next ? (const char*)g.A + (size_t)nxt.pm * tstepA : cA; const char* nB = has_next ? (const char*)g.Bt + (size_t)nxt.pn * tstep : cB;
        for (int t = 0; t < nt; t += 2) {
            const bool last = (t == nt - 2);
            const char* a1 = cA + (size_t)(t + 1) * kstep;
            const char* a2 = last ? nA : cA + (size_t)(t + 2) * kstep; const char* b2 = last ? nB : cB + (size_t)(t + 2) * kstep;
            const char* a3 = a2 + kstep; const char* b3 = b2 + kstep;
            if (last && has_next) S.a_ready(nxt);
            if constexpr (SP2) {
            PG8_LDB(B0, 0, 0); PG8_LDB(B1, 0, 1); PG8_SCHED; PG8_LDA(At, 0, 0); PG8_STAGE(PG8_SA(1, 1), a1 + hstepA, voffA);
            PG8_WAIT_V(8); PG8_WAIT_L(0); PG8_BAR; PG8_MMA(0, 0, At, B0); PG8_MMA(0, 1, At, B1); PG8_BAR; PG8_SCHED;
            PG8_LDA(At, 0, 1); PG8_STAGE(PG8_SB(0, 0), b2, voffB); PG8_STAGE(PG8_SB(0, 1), b2 + hstep, voffB); PG8_STAGE(PG8_SA(0, 0), a2, voffA);
            PG8_WAIT_V(8); PG8_WAIT_L(0); PG8_BAR; PG8_MMA(1, 0, At, B0); PG8_MMA(1, 1, At, B1); PG8_BAR; PG8_SCHED;
            PG8_LDB(B0, 1, 0); PG8_LDB(B1, 1, 1); PG8_SCHED; PG8_LDA(At, 1, 0); PG8_STAGE(PG8_SA(0, 1), a2 + hstepA, voffA);
            PG8_WAIT_V(8); PG8_WAIT_L(0); PG8_BAR; PG8_MMA(0, 0, At, B0); PG8_MMA(0, 1, At, B1); PG8_BAR; PG8_SCHED;
            PG8_LDA(At, 1, 1); PG8_STAGE(PG8_SB(1, 0), b3, voffB); PG8_STAGE(PG8_SB(1, 1), b3 + hstep, voffB); PG8_STAGE(PG8_SA(1, 0), a3, voffA);
            PG8_WAIT_V(8); PG8_WAIT_L(0); PG8_BAR; PG8_MMA(1, 0, At, B0); PG8_MMA(1, 1, At, B1); PG8_BAR; PG8_SCHED;
            } else {
            PG8_LDB(B0, 0, 0); PG8_SCHED; PG8_LDA(At, 0, 0); PG8_STAGE(PG8_SA(1, 1), a1 + hstepA, voffA);
            PG8_WAIT_L(8); PG8_BAR; PG8_WAIT_L(0); PG8_MMA(0, 0, At, B0); PG8_BAR; PG8_SCHED;
            PG8_LDB(B1, 0, 1); PG8_STAGE(PG8_SB(0, 0), b2, voffB);
            PG8_BAR; PG8_WAIT_L(0); PG8_MMA(0, 1, At, B1); PG8_BAR;
            PG8_LDA(At, 0, 1); PG8_STAGE(PG8_SA(0, 0), a2, voffA);
            PG8_BAR; PG8_WAIT_L(0); PG8_MMA(1, 0, At, B0); PG8_BAR; PG8_SCHED;
            PG8_STAGE(PG8_SB(0, 1), b2 + hstep, voffB);
            PG8_WAIT_V(6); PG8_BAR; PG8_MMA(1, 1, At, B1); PG8_BAR;
            PG8_LDB(B0, 1, 0); PG8_SCHED; PG8_LDA(At, 1, 0); PG8_STAGE(PG8_SA(0, 1), a2 + hstepA, voffA);
            PG8_WAIT_L(8); PG8_BAR; PG8_WAIT_L(0); PG8_MMA(0, 0, At, B0); PG8_BAR; PG8_SCHED;
            PG8_LDB(B1, 1, 1); PG8_STAGE(PG8_SB(1, 0), b3, voffB);
            PG8_BAR; PG8_WAIT_L(0); PG8_MMA(0, 1, At, B1); PG8_BAR;
            PG8_LDA(At, 1, 1); PG8_STAGE(PG8_SA(1, 0), a3, voffA);
            PG8_BAR; PG8_WAIT_L(0); PG8_MMA(1, 0, At, B0); PG8_BAR; PG8_SCHED;
            PG8_STAGE(PG8_SB(1, 1), b3 + hstep, voffB);
            PG8_WAIT_V(6); PG8_BAR; PG8_MMA(1, 1, At, B1); PG8_BAR;
            }
        }
        if constexpr (ALIGN_EPI) { if (wr == 0) PG8_BAR; }
        if constexpr (!Epi::AFTER_DRAIN) { E(acc, cur, wr, wc, fr, fq); S.done(cur); }
        if (!has_next) break;
#pragma unroll
        for (int a = 0; a < 2; ++a)
#pragma unroll
            for (int b = 0; b < 2; ++b)
#pragma unroll
                for (int m = 0; m < 4; ++m)
#pragma unroll
                    for (int n = 0; n < 2; ++n) acc[a][b][m][n] = (f32x4){0.f, 0.f, 0.f, 0.f};
        cur = nxt; cA = nA; cB = nB; ++ui;
        if constexpr (ALIGN_EPI) { if (wr == 1) PG8_BAR; }
    }
    PG8_WAIT_V(0);
    if constexpr (!ALIGN_EPI) { if (wr == 0) PG8_BAR; }
    PG8_BAR;
    if constexpr (Epi::AFTER_DRAIN) { E.fused(acc, cur, wr, wc, fr, fq, lds, wid, lane); S.done(cur); }
#undef PG8_SA
#undef PG8_SB
#undef PG8_STAGE
#undef PG8_LDA
#undef PG8_LDB
#undef PG8_MMA
#undef PG8_WAIT_V
#undef PG8_WAIT_L
#undef PG8_BAR
#undef PG8_SCHED
}
}

constexpr int NWAVES = 8;
constexpr int BATCH = 4, SEQ = 8192, D = 2048, M = BATCH * SEQ, FF = 5632;
constexpr int RC = 1024, RH = 16, RN = 64;
constexpr int HC = 1024, HH = 8, HD = 128;
constexpr int RWKV_COLS = 3360, IN_COLS = 7456, NIN = 7680;
constexpr int KL = 384, NL = 3072;
#ifndef MK_N_LAUNCHES
#define MK_N_LAUNCHES 1
#endif
constexpr int N_PHASES = 12;

constexpr size_t WS_CTL = 0, CTL_BYTES = 1u << 20;
constexpr size_t WS_W1GU = CTL_BYTES;
constexpr size_t WS_W1D = WS_W1GU + (size_t)2 * FF * D * 2;
constexpr size_t WS_WIN = WS_W1D + (size_t)D * FF * 2;
constexpr size_t WS_WLORA = WS_WIN + (size_t)NIN * D * 2;
constexpr size_t WS_WOUT = WS_WLORA + (size_t)NL * KL * 2;
constexpr size_t WS_W2GU = WS_WOUT + (size_t)D * D * 2;
constexpr size_t WS_W2D = WS_W2GU + (size_t)2 * FF * D * 2;
constexpr size_t WS_SS = WS_W2D + (size_t)D * FF * 2;
constexpr size_t WS_XB = WS_SS + (1u << 20);
constexpr size_t WS_R = WS_XB + (size_t)M * D * 2;
constexpr size_t R_ACT = 0;
constexpr size_t R_RKV = 0;
constexpr size_t R_HG = R_RKV + (size_t)M * 3072 * 2;
constexpr size_t R_LIN = R_HG + (size_t)M * 4096 * 2;
constexpr size_t R_BYTES = R_LIN + (size_t)M * 288 * 4;
constexpr size_t WS_ALORA = WS_R + R_BYTES;
constexpr size_t WS_LOUT = WS_ALORA + (size_t)M * KL * 2;
constexpr size_t WS_INVN = WS_LOUT + (size_t)M * NL * 2;
constexpr size_t WS_END = WS_INVN + (size_t)M * RH * 4;
static_assert(WS_END <= ((size_t)1 << 30), "d_ws map");
constexpr int CW_PCNT = 8704;
constexpr int CW_SIG_HALF = 8192, CW_SIG_SHA = 8256, CW_SIG_SHB = 8320, CW_SIG_P4 = 8384, CW_SIG_H2 = 8448;
constexpr int CW_BAR = 4096;

constexpr int RING_BYTES = 162816;
constexpr int LDSCTL_OFF = RING_BYTES, MISC_OFF = LDSCTL_OFF + 320;
constexpr int LDS_BYTES = 163840;
static_assert(MISC_OFF + 128 <= LDS_BYTES, "LDS map");

#define GAS __attribute__((address_space(1)))
#define LAS __attribute__((address_space(3)))
typedef unsigned short bf16;
typedef unsigned v4u __attribute__((ext_vector_type(4)));
typedef unsigned v2u __attribute__((ext_vector_type(2)));
typedef float f32x4 __attribute__((ext_vector_type(4)));
#define LDS_WAIT() asm volatile("s_waitcnt lgkmcnt(0)" ::: "memory")
#define VM_WAIT() asm volatile("s_waitcnt vmcnt(0)" ::: "memory")
__device__ __forceinline__ float bflo(unsigned u) { return __builtin_bit_cast(float, u << 16); }
__device__ __forceinline__ float bfhi(unsigned u) { return __builtin_bit_cast(float, u & 0xffff0000u); }
__device__ __forceinline__ f32x4 unpack4(v2u w) { return (f32x4){bflo(w.x), bfhi(w.x), bflo(w.y), bfhi(w.y)}; }
__device__ __forceinline__ unsigned pk2(float lo, float hi) { return pg8::cvt_pk_bf16(lo, hi); }
__device__ __forceinline__ v2u pack4(f32x4 v) { v2u w; w.x = pk2(v[0], v[1]); w.y = pk2(v[2], v[3]); return w; }
using pg8::fast_sigmoid;
using pg8::fast_silu;
template <int CTRL> __device__ __forceinline__ float dpp_mov(float x) { return __builtin_bit_cast(float, __builtin_amdgcn_update_dpp(0, __builtin_bit_cast(int, x), CTRL, 0xF, 0xF, true)); }
__device__ __forceinline__ float row16_sum(float x) { x += dpp_mov<0x128>(x); x += dpp_mov<0x124>(x); x += dpp_mov<0x122>(x); x += dpp_mov<0x121>(x); return x; }
template <int CTRL, int BANK> __device__ __forceinline__ float dpp_upd(float old, float x) { return __builtin_bit_cast(float, __builtin_amdgcn_update_dpp(__builtin_bit_cast(int, old), __builtin_bit_cast(int, x), CTRL, 0xF, BANK, false)); }
__device__ __forceinline__ float tr_reduce16(const float (&v)[16], int lane) {
    float u[8], w[4], x[2];
#pragma unroll
    for (int s = 0; s < 8; ++s) { const float t = v[s + 8] + dpp_mov<0x128>(v[s + 8]), a = v[s] + dpp_mov<0x128>(v[s]); u[s] = dpp_upd<0xE4, 0x3>(t, a); }
#pragma unroll
    for (int s = 0; s < 4; ++s) { const float t = u[s + 4] + dpp_mov<0x141>(u[s + 4]), a = u[s] + dpp_mov<0x141>(u[s]); w[s] = dpp_upd<0xE4, 0x5>(t, a); }
    const bool b1 = (lane & 2) != 0, b0 = (lane & 1) != 0;
#pragma unroll
    for (int s = 0; s < 2; ++s) { const float K = b1 ? w[s + 2] : w[s], T = b1 ? w[s] : w[s + 2]; x[s] = K + dpp_mov<0x1B>(T); }
    const float K = b0 ? x[1] : x[0], T = b0 ? x[0] : x[1];
    return K + dpp_mov<0xB1>(T);
}
typedef float f32x2 __attribute__((ext_vector_type(2)));
#define LO2(v) __builtin_shufflevector(v, v, 0, 1)
#define HI2(v) __builtin_shufflevector(v, v, 2, 3)
__device__ __forceinline__ float wave_sum(float v) {
#pragma unroll
    for (int o = 1; o < 64; o <<= 1) v += __shfl_xor(v, o);
    return v;
}
#define XB_TMO      128
#define XB_XCNT(j)  (256  + 64 * (j))
#define XB_XSUB(j)  (1280 + 64 * (j))
#define XB_XGEN(j)  (2304 + 64 * (j))
#define XB_TOP      3328
#define XB_TOPGEN   3392
#define XCD_BAR_WORDS 3456
#define XB_SPIN_CAP (1u << 18)

__device__ __forceinline__ unsigned xb_ld(unsigned* p)              { return __hip_atomic_load(p, __ATOMIC_RELAXED, __HIP_MEMORY_SCOPE_AGENT); }
__device__ __forceinline__ unsigned xb_add(unsigned* p, unsigned v) { return __hip_atomic_fetch_add(p, v, __ATOMIC_RELAXED, __HIP_MEMORY_SCOPE_AGENT); }
__device__ __forceinline__ unsigned xb_xcc_id() { return (unsigned)__builtin_amdgcn_s_getreg((3 << 11) | 20) & 0xFu; }
#define XB_SPIN(cond, bar) do { unsigned _sp = 0; while (cond) { __builtin_amdgcn_s_sleep(1); \
    if ((++_sp & 255u) == 0u) { if (xb_ld(&(bar)[XB_TMO])) break; if (_sp > XB_SPIN_CAP) { atomicAdd(&(bar)[XB_TMO], 1u); break; } } } } while (0)

struct XcdBarrier {
    unsigned* bar; unsigned x;
    volatile LAS unsigned* st;
};

__device__ __forceinline__ XcdBarrier xcd_barrier_post(unsigned* bar, volatile LAS unsigned* st) {
    XcdBarrier b; b.bar = bar; b.x = xb_xcc_id(); b.st = st;
    if (threadIdx.x == 0) (void)xb_add(&bar[XB_XCNT(b.x)], 1u);
    return b;
}
__device__ __forceinline__ void xcd_barrier_complete(unsigned* bar, unsigned x, unsigned& nloc, unsigned& nx) {
    const unsigned G = gridDim.x * gridDim.y * gridDim.z;
    unsigned sum, cnt, mine, sp = 0u;
    for (;;) {
        sum = 0u; cnt = 0u; mine = 0u;
#pragma unroll
        for (unsigned j = 0; j < 16; ++j) { const unsigned c = xb_ld(&bar[XB_XCNT(j)]); sum += c; cnt += (c > 0u) ? 1u : 0u; mine = (j == x) ? c : mine; }
        if (sum == G) break;
        __builtin_amdgcn_s_sleep(1);
        if ((++sp & 255u) == 0u) { if (xb_ld(&bar[XB_TMO])) break; if (sp > XB_SPIN_CAP) { atomicAdd(&bar[XB_TMO], 1u); break; } }
    }
    nloc = mine > 0u ? mine : 1u; nx = cnt > 0u ? cnt : 1u;
}

__device__ __forceinline__ void xcd_barrier(const XcdBarrier& b) {
    asm volatile("s_waitcnt vmcnt(0)" ::: "memory");
    __syncthreads();
    if (threadIdx.x == 0) {
        unsigned* bar = b.bar;
        __builtin_amdgcn_s_waitcnt(0);
        unsigned nloc = b.st[0], nx = b.st[1];
        if (nloc == 0u) { xcd_barrier_complete(bar, b.x, nloc, nx); b.st[0] = nloc; b.st[1] = nx; }
        const unsigned old = xb_add(&bar[XB_XSUB(b.x)], 1u);
        const unsigned gen = old / nloc;
        if (old + 1u == (gen + 1u) * nloc) {
            __builtin_amdgcn_fence(__ATOMIC_RELEASE, "agent");
            asm volatile("s_waitcnt vmcnt(0)" ::: "memory");
            const unsigned og = xb_add(&bar[XB_TOP], 1u);
            const unsigned tg = og / nx;
            if (og + 1u == (tg + 1u) * nx) xb_add(&bar[XB_TOPGEN], 1u);
            else XB_SPIN(xb_ld(&bar[XB_TOPGEN]) == tg, bar);
            __builtin_amdgcn_fence(__ATOMIC_ACQUIRE, "agent");
            xb_add(&bar[XB_XGEN(b.x)], 1u);
            asm volatile("s_waitcnt vmcnt(0)" ::: "memory");
        } else {
            XB_SPIN(xb_ld(&bar[XB_XGEN(b.x)]) == gen, bar);
            __builtin_amdgcn_fence(__ATOMIC_ACQUIRE, "agent");
            asm volatile("s_waitcnt vmcnt(0)" ::: "memory");
        }
    }
    __syncthreads();
}

__device__ __forceinline__ void sig_post(unsigned* ctr) {
    __builtin_amdgcn_fence(__ATOMIC_RELEASE, "agent"); asm volatile("s_waitcnt vmcnt(0)" ::: "memory"); (void)xb_add(ctr, 1u);
}
__device__ __forceinline__ void wg_signal(unsigned* ctr) {
    asm volatile("s_waitcnt vmcnt(0)" ::: "memory"); __syncthreads();
    if (threadIdx.x == 0) sig_post(ctr);
}
__device__ __forceinline__ void wg_wait(unsigned* ctr, unsigned target, unsigned* bar) {
    if (threadIdx.x == 0) { XB_SPIN(xb_ld(ctr) < target, bar); __builtin_amdgcn_fence(__ATOMIC_ACQUIRE, "agent"); asm volatile("s_waitcnt vmcnt(0)" ::: "memory"); }
    __syncthreads();
}

struct Frame {
    LAS unsigned char* lds;
    int tid, lane, wave, vcu, G;
    const float* in[26];
    float* out; unsigned char* ws;
};
#define WSP(T, off) ((T*)(F.ws + (off)))
struct Args { const float* in[26]; float* out; unsigned char* ws; int ph_lo, ph_hi; };

struct P0Item { const float* W; bf16* WT; int K, N, kb, n0, drow0; };
__device__ __forceinline__ int map_gu(int n0, int which) { return (n0 >> 7) * 256 + which * 128 + (n0 & 127); }
constexpr int P0_I_GU = (D / 64) * (FF / 32), P0_I_DN = (FF / 64) * (D / 32), P0_I_IN = (D / 64) * (IN_COLS / 32), P0_I_OUT = (D / 64) * (D / 32);
constexpr int P0_N0 = 2 * P0_I_GU + P0_I_DN + P0_I_IN, P0_N1 = 2 * P0_I_GU + P0_I_DN + P0_I_OUT;
template <int SET> __device__ __forceinline__ P0Item p0_decode(Frame& F, const Args& A, int it) {
    constexpr int I_GU = P0_I_GU, I_DN = P0_I_DN, I_IN = P0_I_IN;
    P0Item p; int r = it;
    if (SET == 0) { if (r >= 2 * I_GU) r += 2 * I_GU; if (r >= 4 * I_GU + I_DN) r += I_DN; }
    else { r += 2 * I_GU; if (r >= 4 * I_GU) r += I_DN; if (r >= 4 * I_GU + 2 * I_DN) r += I_IN; }
    if (r < 4 * I_GU) { const int mat = r / I_GU; r -= mat * I_GU; const int nblk = FF / 32, ffn = mat >> 1, which = mat & 1;
        p.W = A.in[2 + 20 * ffn + which]; p.WT = WSP(bf16, ffn ? WS_W2GU : WS_W1GU); p.K = D; p.N = FF; p.kb = r / nblk; p.n0 = 32 * (r % nblk); p.drow0 = map_gu(p.n0, which); return p; }
    r -= 4 * I_GU;
    if (r < 2 * I_DN) { const int ffn = r / I_DN; r -= ffn * I_DN; const int nblk = D / 32;
        p.W = A.in[4 + 20 * ffn]; p.WT = WSP(bf16, ffn ? WS_W2D : WS_W1D); p.K = FF; p.N = D; p.kb = r / nblk; p.n0 = 32 * (r % nblk); p.drow0 = p.n0; return p; }
    r -= 2 * I_DN;
    if (r < I_IN) { const int nblk = IN_COLS / 32;
        p.W = A.in[6]; p.WT = WSP(bf16, WS_WIN); p.K = D; p.N = IN_COLS; p.kb = r / nblk; p.n0 = 32 * (r % nblk); p.drow0 = p.n0 < RWKV_COLS ? p.n0 : p.n0 + 224; return p; }
    r -= I_IN;
    { const int nblk = D / 32; p.W = A.in[20]; p.WT = WSP(bf16, WS_WOUT); p.K = D; p.N = D; p.kb = r / nblk; p.n0 = 32 * (r % nblk); p.drow0 = p.n0; return p; }
}
__device__ __forceinline__ void p0_dma(const P0Item& p, LAS unsigned char* tile, int lane) {
    const int half = lane >> 5, sl = lane & 31;
#pragma unroll 8
    for (int i = 0; i < 32; ++i) { const int kk = 2 * i + half;
        __builtin_amdgcn_global_load_lds((const GAS unsigned*)(p.W + (size_t)(64 * p.kb + kk) * p.N + p.n0 + (sl ^ (4 * (kk >> 3)))), (LAS unsigned*)(tile + i * 256), 4, 0, 0); }
}
__device__ __forceinline__ void p0_emit(const P0Item& p, const LAS float* t, int lane) {
    const int c = lane & 7;
#pragma unroll
    for (int j = 0; j < 4; ++j) { const int n = (lane >> 3) + 8 * j; const LAS float* s = t + (8 * c) * 32 + (n ^ (4 * c));
        v4u o; o.x = pk2(s[0 * 32], s[1 * 32]); o.y = pk2(s[2 * 32], s[3 * 32]); o.z = pk2(s[4 * 32], s[5 * 32]); o.w = pk2(s[6 * 32], s[7 * 32]);
        *(GAS v4u*)(p.WT + (size_t)(p.drow0 + n) * p.K + 64 * p.kb + 8 * c) = o; }
}
template <int SET> __device__ __forceinline__ void p0_transposes(Frame& F, const Args& A, int gw, int NGW) {
    LAS unsigned char* tiles = F.lds + F.wave * 16384;
    constexpr int NITEMS = SET == 0 ? P0_N0 : P0_N1;
    if (gw < NITEMS) {
        P0Item cur = p0_decode<SET>(F, A, gw); int buf = 0;
        p0_dma(cur, tiles, F.lane);
        for (int it = gw; it < NITEMS; it += NGW) {
            const bool more = it + NGW < NITEMS; P0Item nxt = cur;
            if (more) { nxt = p0_decode<SET>(F, A, it + NGW); p0_dma(nxt, tiles + (buf ^ 1) * 8192, F.lane); asm volatile("s_waitcnt vmcnt(32)" ::: "memory"); }
            else asm volatile("s_waitcnt vmcnt(0)" ::: "memory");
            p0_emit(cur, (const LAS float*)(tiles + buf * 8192), F.lane);
            LDS_WAIT(); asm volatile("" ::: "memory");
            cur = nxt; buf ^= 1;
        }
        asm volatile("s_waitcnt vmcnt(0)" ::: "memory");
    }
}
__device__ __forceinline__ void p0_prologue(Frame& F, const Args& A) {
    const int gw = F.vcu * NWAVES + F.wave, NGW = F.G * NWAVES;
    p0_transposes<0>(F, A, gw, NGW);
    const size_t gt = (size_t)F.vcu * (NWAVES * 64) + F.tid, NT = (size_t)F.G * NWAVES * 64;
    { GAS v4u* z = (GAS v4u*)(WSP(bf16, WS_WIN) + (size_t)RWKV_COLS * D);
      for (size_t i = gt; i < (size_t)224 * D * 2 / 16; i += NT) z[i] = (v4u){0u, 0u, 0u, 0u}; }
    { bf16* wl = WSP(bf16, WS_WLORA); const float* w2 = F.in[9]; const float* a2 = F.in[11]; const float* g2 = F.in[12];
      for (size_t i = gt; i < (size_t)NL * KL / 2; i += NT) { const int n = (int)(i / (KL / 2)), k = 2 * (int)(i % (KL / 2)); const int seg = n >> 10, c = n & 1023;
          float v0 = 0.f, v1 = 0.f;
          if (seg == 0) { if (k < 64) { v0 = w2[(size_t)k * RC + c]; v1 = w2[(size_t)(k + 1) * RC + c]; } }
          else if (seg == 1) { if (k >= 64 && k < 128) { v0 = a2[(size_t)(k - 64) * RC + c]; v1 = a2[(size_t)(k - 63) * RC + c]; } }
          else { if (k >= 128 && k < 288) { v0 = g2[(size_t)(k - 128) * RC + c]; v1 = g2[(size_t)(k - 127) * RC + c]; } }
          ((GAS unsigned*)wl)[i] = pk2(v0, v1); } }
    { GAS unsigned long long* s = (GAS unsigned long long*)(F.ws + WS_SS) + M;
      for (size_t i = gt; i < (size_t)3 * M; i += NT) s[i] = 0ull; }
    { const float* x = F.in[0]; bf16* xb = WSP(bf16, WS_XB); unsigned long long* ss0 = WSP(unsigned long long, WS_SS);
      for (int m = gw; m < M; m += NGW) { const GAS f32x4* xr = (const GAS f32x4*)(x + (size_t)m * D) + 2 * F.lane; GAS v4u* o = (GAS v4u*)(xb + (size_t)m * D) + F.lane; float s = 0.f;
#pragma unroll
          for (int j = 0; j < 4; ++j) { const f32x4 a = xr[128 * j], b = xr[128 * j + 1];
              s += (a[0] * a[0] + a[1] * a[1]) + (a[2] * a[2] + a[3] * a[3]) + (b[0] * b[0] + b[1] * b[1]) + (b[2] * b[2] + b[3] * b[3]);
              const f32x4 ga = *(const f32x4*)(F.in[1] + 8 * F.lane + 512 * j), gb = *(const f32x4*)(F.in[1] + 8 * F.lane + 512 * j + 4);
              o[64 * j] = pg8::pack8(a * ga, b * gb); }
          s = wave_sum(s);
          if (F.lane == 0) ss0[m] = (unsigned long long)(s * pg8::SS_SCALE + 0.5f); } }
}

__device__ __forceinline__ void p4_lora_in(Frame& F, int hsel, int c, int G) {
    const int NR = hsel < 0 ? M : M / 2;
#define P4_ROW(i_) (hsel < 0 ? (i_) : ((i_) / (SEQ / 2)) * SEQ + ((i_) % (SEQ / 2)) + hsel * (SEQ / 2))
    const float* lin = WSP(float, WS_R + R_LIN); bf16* al = WSP(bf16, WS_ALORA); const float* mu = F.in[7] + 3 * RC;
    const size_t gt = (size_t)c * (NWAVES * 64) + F.tid, NT = (size_t)G * NWAVES * 64;
#pragma unroll 4
    for (size_t i = gt; i < (size_t)NR * 96; i += NT) { const int mi = (int)(i / 96), m = P4_ROW(mi), q = (int)(i % 96), qc = q < 72 ? q : 0; const bool first = (m & (SEQ - 1)) == 0;
        const f32x4 p = *(const GAS f32x4*)(lin + (size_t)m * 288 + 4 * qc), pr = *(const GAS f32x4*)(lin + (size_t)(first ? m : m - 1) * 288 + 4 * qc), mv = *(const GAS f32x4*)(mu + 4 * qc);
        const f32x4 pp = first ? (f32x4){0.f, 0.f, 0.f, 0.f} : pr; f32x4 s = p + (pp - p) * mv;
#pragma unroll
        for (int j = 0; j < 4; ++j) { const float sg = fast_sigmoid(q < 16 ? 2.0f * s[j] : s[j]); s[j] = q < 16 ? 2.0f * sg - 1.0f : (q >= 32 ? sg : s[j]); }
        v2u o = pack4(s); if (q >= 72) o = (v2u){0u, 0u};
        *(GAS v2u*)(al + (size_t)m * KL + 4 * q) = o; }
    { const bf16* rkv = WSP(bf16, WS_R + R_RKV); float* invn = WSP(float, WS_INVN); const int j4 = (F.tid & 15) * 4;
      const size_t it0 = gt >> 4, step = NT >> 4; const int h = (int)(it0 & 15), ch = h * RN + j4;
      const f32x4 muk = *(const f32x4*)(F.in[7] + RC + ch), kkc = *(const f32x4*)(F.in[13] + ch);
      if ((step & 15) == 0) {
#pragma unroll 4
          for (size_t it = it0; it < (size_t)NR * RH; it += step) { const int mi = (int)(it >> 4), m = P4_ROW(mi); const bool first = (m & (SEQ - 1)) == 0;
              const f32x4 k = unpack4(*(const GAS v2u*)(rkv + (size_t)m * 3072 + RC + ch)), kr = unpack4(*(const GAS v2u*)(rkv + (size_t)(first ? m : m - 1) * 3072 + RC + ch));
              const f32x4 kp = first ? (f32x4){0.f, 0.f, 0.f, 0.f} : kr;
              const f32x4 kk = (k + (kp - k) * muk) * kkc; float s2 = (kk[0] * kk[0] + kk[1] * kk[1]) + (kk[2] * kk[2] + kk[3] * kk[3]); s2 = row16_sum(s2);
              if ((F.tid & 15) == 0) invn[(size_t)m * RH + h] = 1.0f / fmaxf(sqrtf(s2), 1e-12f); }
      } else {
          for (size_t it = it0; it < (size_t)NR * RH; it += step) { const int mi = (int)(it >> 4), m = P4_ROW(mi), h2 = (int)(it & 15), c2 = h2 * RN + j4; const bool first = (m & (SEQ - 1)) == 0;
              const f32x4 k = unpack4(*(const GAS v2u*)(rkv + (size_t)m * 3072 + RC + c2)), kr = unpack4(*(const GAS v2u*)(rkv + (size_t)(first ? m : m - 1) * 3072 + RC + c2));
              const f32x4 kp = first ? (f32x4){0.f, 0.f, 0.f, 0.f} : kr; const f32x4 mk2 = *(const f32x4*)(F.in[7] + RC + c2), kc2 = *(const f32x4*)(F.in[13] + c2);
              const f32x4 kk = (k + (kp - k) * mk2) * kc2; float s2 = (kk[0] * kk[0] + kk[1] * kk[1]) + (kk[2] * kk[2] + kk[3] * kk[3]); s2 = row16_sum(s2);
              if ((F.tid & 15) == 0) invn[(size_t)m * RH + h2] = 1.0f / fmaxf(sqrtf(s2), 1e-12f); } } }
#undef P4_ROW
}

typedef short bf16x4 __attribute__((ext_vector_type(4)));
typedef short bf16x8 __attribute__((ext_vector_type(8)));
#define MFMA32(a, b, c) __builtin_amdgcn_mfma_f32_16x16x32_bf16(a, b, c, 0, 0, 0)
#define MFMA16(a, b, c) __builtin_amdgcn_mfma_f32_16x16x16bf16_1k(a, b, c, 0, 0, 0)
__device__ __forceinline__ bf16x4 cv4(f32x4 v) { v2u w; w.x = pk2(v[0], v[1]); w.y = pk2(v[2], v[3]); return __builtin_bit_cast(bf16x4, w); }
__device__ __forceinline__ bf16x8 cv8(f32x4 a, f32x4 b) { v4u w; w.x = pk2(a[0], a[1]); w.y = pk2(a[2], a[3]); w.z = pk2(b[0], b[1]); w.w = pk2(b[2], b[3]); return __builtin_bit_cast(bf16x8, w); }
__device__ __forceinline__ bf16x8 cat8(bf16x4 a, bf16x4 b) { return __builtin_shufflevector(a, b, 0, 1, 2, 3, 4, 5, 6, 7); }
__device__ __forceinline__ bf16x8 join8(v2u a, v2u b) { v4u w; w.x = a.x; w.y = a.y; w.z = b.x; w.w = b.y; return __builtin_bit_cast(bf16x8, w); }
__device__ __forceinline__ float row16_scan(float x) { x += dpp_mov<0x111>(x); x += dpp_mov<0x112>(x); x += dpp_mov<0x114>(x); x += dpp_mov<0x118>(x); return x; }
__device__ __forceinline__ unsigned short bf1(float x) { return (unsigned short)(pk2(x, 0.f) & 0xffffu); }
constexpr int CH = 16;
constexpr int RWS = 144;
constexpr int HGS = 272;
constexpr int RWB_KG = 0, RWB_RG = 16 * RWS, RWB_KTI = 32 * RWS, RWB_BTI = 48 * RWS, RWB_KTIT = 64 * RWS, RWB_BTIT = RWB_KTIT + 2048, RWB_VT = RWB_BTIT + 2048, RWB_GL = RWB_VT + 2048, RWB_BYTES = RWB_GL + 256;
constexpr int HGB_QG = 0, HGB_KI = 16 * HGS, HGB_KIT = 32 * HGS, HGB_VT = HGB_KIT + 4096, HGB_GL = HGB_VT + 4096, HGB_BYTES = HGB_GL + 512;

__device__ __forceinline__ f32x4 padc(f32x4 r) { asm("s_nop 15" : "+v"(r)); return r; }
constexpr int NCHK = SEQ / CH;
constexpr int NRAW = 8;
constexpr int RWR_R = 0, RWR_K = 2048, RWR_V = 4096, RWR_LW = 6144, RWR_A = 8192, RWR_INV = 10240, RWR_BYTES = 10304;
constexpr int RW_OPND = 0, RW_RAW = 3 * RWB_BYTES, RW_AOP = RW_RAW + NRAW * RWR_BYTES, RW_LDS = RW_AOP + 2 * 2048;
constexpr int HGR_Q = 0, HGR_LF = 4096, HGR_V = 8192, HGR_BYTES = 12288;
constexpr int HG_OPND = 0, HG_RAW = 3 * HGB_BYTES, HG_AOP = HG_RAW + NRAW * HGR_BYTES, HG_LDS = HG_AOP + 2 * 512;
static_assert(RW_LDS <= RING_BYTES && HG_LDS <= RING_BYTES && RW_AOP % 16 == 0 && HG_AOP % 16 == 0, "scan LDS map");
#define GLDS4(gptr, lptr) __builtin_amdgcn_global_load_lds((const GAS unsigned*)(gptr), (LAS unsigned*)(lptr), 4, 0, 0)
#define WG_BAR() do { LDS_WAIT(); __builtin_amdgcn_s_barrier(); asm volatile("" ::: "memory"); } while (0)

__device__ __forceinline__ void p6_rwkv_head(Frame& F, int bh, int nsh) {
    const bf16* rkv = WSP(bf16, WS_R + R_RKV); const bf16* lout = WSP(bf16, WS_LOUT); const float* invn = WSP(float, WS_INVN); bf16* ydst = WSP(bf16, WS_LOUT);
    const int lane = F.lane, c = lane & 15, g = lane >> 4, w = F.wave;
    const int b = bh >> 4, h = bh & 15;
    const size_t rowbase = (size_t)b * SEQ;
    const int st = lane & 15, k0 = 2 * (w * 4 + (lane >> 4)), chn = h * RN + k0;
    const float mur0 = F.in[7][chn], mur1 = F.in[7][chn + 1], muk0 = F.in[7][RC + chn], muk1 = F.in[7][RC + chn + 1], muv0 = F.in[7][2 * RC + chn], muv1 = F.in[7][2 * RC + chn + 1];
    const float kk0 = F.in[13][chn], kk1 = F.in[13][chn + 1], ka0 = F.in[14][chn], ka1 = F.in[14][chn + 1];
    LAS unsigned char* const opnd = F.lds + RW_OPND; LAS unsigned char* const raw = F.lds + RW_RAW; LAS unsigned char* const aop = F.lds + RW_AOP;
#define RW3_DMA(j) do { const int r_ = 2 * w + (lane >> 5); const size_t ro_ = (rowbase + (size_t)(j) * CH + r_) * 3072 + h * RN + 2 * ((lane & 31) ^ r_); \
        LAS unsigned char* d_ = raw + ((j) % NRAW) * RWR_BYTES + w * 256; \
        GLDS4(rkv + ro_, d_ + RWR_R); GLDS4(rkv + ro_ + RC, d_ + RWR_K); GLDS4(rkv + ro_ + 2 * RC, d_ + RWR_V); GLDS4(lout + ro_, d_ + RWR_LW); GLDS4(lout + ro_ + RC, d_ + RWR_A); \
        if (lane < 2) GLDS4(invn + (rowbase + (size_t)(j) * CH + 2 * w + lane) * RH + h, raw + ((j) % NRAW) * RWR_BYTES + RWR_INV + w * 8); } while (0)
#define RW3_PROC(j) do { const LAS unsigned char* s_ = raw + ((j) % NRAW) * RWR_BYTES; const int pq_ = (k0 >> 1) ^ st, pp_ = (k0 >> 1) ^ ((st + 15) & 15); \
        const LAS unsigned char* sc_ = s_ + st * 128 + pq_ * 4; const LAS unsigned char* sp_ = ((st > 0) ? s_ + (st - 1) * 128 : raw + (((j) + NRAW - 1) % NRAW) * RWR_BYTES + 15 * 128) + pp_ * 4; \
        const bool first_ = ((j) == 0) && (st == 0); \
        const unsigned Lr = *(const LAS unsigned*)(sc_ + RWR_R), Lk = *(const LAS unsigned*)(sc_ + RWR_K), Lv = *(const LAS unsigned*)(sc_ + RWR_V); \
        const unsigned Lw = *(const LAS unsigned*)(sc_ + RWR_LW), La = *(const LAS unsigned*)(sc_ + RWR_A); \
        const unsigned Lrp = *(const LAS unsigned*)(sp_ + RWR_R), Lkp = *(const LAS unsigned*)(sp_ + RWR_K), Lvp = *(const LAS unsigned*)(sp_ + RWR_V); \
        const float Linv = *(const LAS float*)(s_ + RWR_INV + st * 4); \
        const float r0_ = bflo(Lr), r1_ = bfhi(Lr), q0_ = bflo(Lk), q1_ = bfhi(Lk), v0_ = bflo(Lv), v1_ = bfhi(Lv); \
        const float rp0_ = first_ ? 0.f : bflo(Lrp), rp1_ = first_ ? 0.f : bfhi(Lrp), qp0_ = first_ ? 0.f : bflo(Lkp), qp1_ = first_ ? 0.f : bfhi(Lkp), vp0_ = first_ ? 0.f : bflo(Lvp), vp1_ = first_ ? 0.f : bfhi(Lvp); \
        const float rs0_ = r0_ + (rp0_ - r0_) * mur0, rs1_ = r1_ + (rp1_ - r1_) * mur1, ks0_ = q0_ + (qp0_ - q0_) * muk0, ks1_ = q1_ + (qp1_ - q1_) * muk1, vs0_ = v0_ + (vp0_ - v0_) * muv0, vs1_ = v1_ + (vp1_ - v1_) * muv1; \
        const float a0_ = bflo(La), a1_ = bfhi(La), lw0_ = bflo(Lw) * 1.44269504f, lw1_ = bfhi(Lw) * 1.44269504f; \
        const float kap0_ = ks0_ * kk0 * Linv, kap1_ = ks1_ * kk1 * Linv, bet0_ = kap0_ * a0_, bet1_ = kap1_ * a1_; \
        const float kt0_ = ks0_ * (1.0f + (a0_ - 1.0f) * ka0), kt1_ = ks1_ * (1.0f + (a1_ - 1.0f) * ka1); \
        const float G0_ = row16_scan(lw0_), G1_ = row16_scan(lw1_); \
        const float eg0_ = __builtin_amdgcn_exp2f(G0_), eg1_ = __builtin_amdgcn_exp2f(G1_), ep0_ = __builtin_amdgcn_exp2f(G0_ - lw0_), ep1_ = __builtin_amdgcn_exp2f(G1_ - lw1_), ei0_ = __builtin_amdgcn_exp2f(-G0_), ei1_ = __builtin_amdgcn_exp2f(-G1_); \
        LAS unsigned char* d_ = opnd + ((j) % 3) * RWB_BYTES; \
        *(LAS unsigned*)(d_ + RWB_KG + st * RWS + k0 * 2) = pk2(kap0_ * ep0_, kap1_ * ep1_); *(LAS unsigned*)(d_ + RWB_RG + st * RWS + k0 * 2) = pk2(rs0_ * eg0_, rs1_ * eg1_); \
        const unsigned kti_ = pk2(kt0_ * ei0_, kt1_ * ei1_), bti_ = pk2(bet0_ * ei0_, bet1_ * ei1_), vv_ = pk2(vs0_, vs1_); \
        *(LAS unsigned*)(d_ + RWB_KTI + st * RWS + k0 * 2) = kti_; *(LAS unsigned*)(d_ + RWB_BTI + st * RWS + k0 * 2) = bti_; \
        *(LAS unsigned short*)(d_ + RWB_KTIT + k0 * 32 + st * 2) = (unsigned short)(kti_ & 0xffffu); *(LAS unsigned short*)(d_ + RWB_KTIT + (k0 + 1) * 32 + st * 2) = (unsigned short)(kti_ >> 16); \
        *(LAS unsigned short*)(d_ + RWB_BTIT + k0 * 32 + st * 2) = (unsigned short)(bti_ & 0xffffu); *(LAS unsigned short*)(d_ + RWB_BTIT + (k0 + 1) * 32 + st * 2) = (unsigned short)(bti_ >> 16); \
        *(LAS unsigned short*)(d_ + RWB_VT + k0 * 32 + st * 2) = (unsigned short)(vv_ & 0xffffu); *(LAS unsigned short*)(d_ + RWB_VT + (k0 + 1) * 32 + st * 2) = (unsigned short)(vv_ >> 16); \
        if (st == 15) { *(LAS float*)(d_ + RWB_GL + k0 * 4) = eg0_; *(LAS float*)(d_ + RWB_GL + k0 * 4 + 4) = eg1_; } } while (0)
    const f32x4 zero4 = (f32x4){0.f, 0.f, 0.f, 0.f};
    auto a_stage = [&](int j) {
        const LAS unsigned char* rowp = opnd + (j % 3) * RWB_BYTES + c * RWS;
        const int offA = (w == 4 || w == 7) ? RWB_BTI : RWB_KTI;
        const int offB = (w == 4 || w == 5) ? RWB_KG : RWB_RG;
        const bf16x8 a0 = *(const LAS bf16x8*)(rowp + offA + 16 * g), a1 = *(const LAS bf16x8*)(rowp + offA + 64 + 16 * g);
        const bf16x8 b0 = *(const LAS bf16x8*)(rowp + offB + 16 * g), b1 = *(const LAS bf16x8*)(rowp + offB + 64 + 16 * g);
        f32x4 N = MFMA32(a0, b0, zero4); N = MFMA32(a1, b1, N);
        const bool strict = (w == 4 || w == 5);
#pragma unroll
        for (int r = 0; r < 4; ++r) { const int rj = 4 * g + r; N[r] = (strict ? (c > rj) : (c >= rj)) ? N[r] : 0.f; }
        f32x4 res = N;
        if (w == 4) {
            f32x4 N1t = MFMA32(b0, a0, zero4); N1t = MFMA32(b1, a1, N1t);
            f32x4 X;
#pragma unroll
            for (int r = 0; r < 4; ++r) { const int rj = 4 * g + r; N1t[r] = (rj > c) ? N1t[r] : 0.f; X[r] = ((rj == c) ? 1.0f : 0.f) - N[r]; }
            bf16x4 an = cv4(N), at = cv4(N1t);
            f32x4 P = MFMA16(at, an, zero4), Pt = MFMA16(an, at, zero4);
            X = MFMA16(cv4(Pt), cv4(X), padc(X));
            an = cv4(P); at = cv4(Pt);
            P = MFMA16(at, an, zero4); Pt = MFMA16(an, at, zero4);
            X = MFMA16(cv4(Pt), cv4(X), padc(X));
            an = cv4(P); at = cv4(Pt);
            Pt = MFMA16(an, at, zero4);
            X = MFMA16(cv4(Pt), cv4(X), padc(X));
            res = X;
        }
        *(LAS bf16x4*)(aop + (j & 1) * 2048 + (w - 4) * 512 + lane * 8) = cv4(res);
    };
    f32x4 Z[4];
#pragma unroll
    for (int i = 0; i < 4; ++i) Z[i] = (f32x4){0.f, 0.f, 0.f, 0.f};
    { RW3_DMA(0); RW3_DMA(1); RW3_DMA(2); RW3_DMA(3); RW3_DMA(4); RW3_DMA(5); RW3_DMA(6); RW3_DMA(7); asm volatile("s_waitcnt vmcnt(0)" ::: "memory"); WG_BAR(); RW3_PROC(0); RW3_PROC(1); WG_BAR(); if (w >= 4) a_stage(0); WG_BAR(); }
    if (w < 4) {
        for (int ci = 0; ci < NCHK; ++ci) {
            const int t0 = ci * CH; const int jp = (ci + 2 < NCHK) ? ci + 2 : NCHK - 1;
            if (nsh > 0 && ci == NCHK / 2 - NRAW) { if (w == 0 && lane == 0) { unsigned* ctl_ = WSP(unsigned, WS_CTL); XB_SPIN(xb_ld(ctl_ + CW_SIG_H2) < (unsigned)nsh, ctl_ + CW_BAR); __builtin_amdgcn_fence(__ATOMIC_ACQUIRE, "agent"); asm volatile("s_waitcnt vmcnt(0)" ::: "memory"); } WG_BAR(); }
            RW3_PROC(jp);
            const LAS unsigned char* cur = opnd + (ci % 3) * RWB_BYTES; const LAS unsigned char* rowp = cur + c * RWS; const LAS unsigned char* ap = aop + (ci & 1) * 2048 + lane * 8;
            bf16x8 pKg[2], pRg[2];
#pragma unroll
            for (int s = 0; s < 2; ++s) {
                pKg[s] = join8(*(const LAS v2u*)(rowp + RWB_KG + 64 * s + 8 * g), *(const LAS v2u*)(rowp + RWB_KG + 64 * s + 32 + 8 * g));
                pRg[s] = join8(*(const LAS v2u*)(rowp + RWB_RG + 64 * s + 8 * g), *(const LAS v2u*)(rowp + RWB_RG + 64 * s + 32 + 8 * g)); }
            const bf16x4 bV = *(const LAS bf16x4*)(cur + RWB_VT + (16 * w + c) * 32 + 8 * g);
            const bf16x4 xT = *(const LAS bf16x4*)(ap), n2 = *(const LAS bf16x4*)(ap + 512), n3 = *(const LAS bf16x4*)(ap + 1024), n4 = *(const LAS bf16x4*)(ap + 1536);
            const bf16x8 bZ0 = cv8(Z[0], Z[1]), bZ1 = cv8(Z[2], Z[3]);
            const bf16x4 z4 = (bf16x4){0, 0, 0, 0};
            f32x4 W = MFMA32(pKg[0], bZ0, zero4); W = MFMA32(pKg[1], bZ1, W); W = MFMA32(cat8(n2, z4), cat8(bV, z4), W);
            const f32x4 U = MFMA16(xT, cv4(W), zero4);
            const bf16x4 nU = cv4(-U);
            const bf16x8 bVU = cat8(bV, nU);
            f32x4 Y = MFMA32(pRg[0], bZ0, zero4); Y = MFMA32(pRg[1], bZ1, Y); Y = MFMA32(cat8(n3, n4), bVU, Y);
#pragma unroll
            for (int r = 0; r < 4; ++r) ydst[(rowbase + t0 + 4 * g + r) * 3072 + h * RN + 16 * w + c] = bf1(Y[r]);
#pragma unroll
            for (int zt = 0; zt < 4; ++zt) {
                const bf16x4 aK = *(const LAS bf16x4*)(cur + RWB_KTIT + (16 * zt + c) * 32 + 8 * g), aB = *(const LAS bf16x4*)(cur + RWB_BTIT + (16 * zt + c) * 32 + 8 * g);
                const f32x4 gl = *(const LAS f32x4*)(cur + RWB_GL + (16 * zt + 4 * g) * 4);
                Z[zt] = MFMA32(cat8(aK, aB), bVU, Z[zt]) * gl; }
            { const int jn = (ci + NRAW < NCHK) ? ci + NRAW : NCHK - 1; RW3_DMA(jn); }
            if (ci == NCHK / 2 - 1) asm volatile("s_waitcnt vmcnt(0)" ::: "memory");
            asm volatile("s_waitcnt vmcnt(50)" ::: "memory");
            WG_BAR();
            if (ci == NCHK / 2 - 1 && w == 0 && lane == 0) sig_post(WSP(unsigned, WS_CTL) + CW_SIG_HALF);
        }
    } else {
        for (int ci = 0; ci < NCHK; ++ci) {
            const int jp = (ci + 2 < NCHK) ? ci + 2 : NCHK - 1, ja = (ci + 1 < NCHK) ? ci + 1 : NCHK - 1;
            if (nsh > 0 && ci == NCHK / 2 - NRAW) WG_BAR();
            RW3_PROC(jp);
            a_stage(ja);
            { const int jn = (ci + NRAW < NCHK) ? ci + NRAW : NCHK - 1; RW3_DMA(jn); }
            asm volatile("s_waitcnt vmcnt(30)" ::: "memory");
            WG_BAR();
        }
    }
#undef RW3_DMA
#undef RW3_PROC
}

__device__ __forceinline__ void p6_hgrn_head(Frame& F, int hb) {
    const bf16* hg = WSP(bf16, WS_R + R_HG); bf16* odst = WSP(bf16, WS_R + R_HG);
    const int lane = F.lane, c = lane & 15, g = lane >> 4, w = F.wave;
    const int bh = hb >> 1, half = hb & 1, b = bh >> 3, h = bh & 7, vb = half * 4 + (w & 3);
    const size_t rowbase = (size_t)b * SEQ;
    const int st = lane & 15, k0 = 4 * (w * 4 + (lane >> 4));
    LAS unsigned char* const opnd = F.lds + HG_OPND; LAS unsigned char* const raw = F.lds + HG_RAW; LAS unsigned char* const aop = F.lds + HG_AOP;
#define HG3_DMA(j) do { _Pragma("unroll") for (int rr_ = 0; rr_ < 2; ++rr_) { const int r_ = 2 * w + rr_; const bf16* p_ = hg + (rowbase + (size_t)(j) * CH + r_) * 4096 + h * HD + 2 * (2 * ((lane >> 1) ^ r_) + (lane & 1)); \
        LAS unsigned char* d_ = raw + ((j) % NRAW) * HGR_BYTES + r_ * 256; GLDS4(p_, d_ + HGR_Q); GLDS4(p_ + HC, d_ + HGR_LF); GLDS4(p_ + 2 * HC, d_ + HGR_V); } } while (0)
#define HG3_PROC(j) do { const LAS unsigned char* s_ = raw + ((j) % NRAW) * HGR_BYTES + st * 256 + (((k0 >> 2) ^ st) * 8); LAS unsigned char* d_ = opnd + ((j) % 3) * HGB_BYTES; \
        const v2u Lq = *(const LAS v2u*)(s_ + HGR_Q), Lf = *(const LAS v2u*)(s_ + HGR_LF), Lv = *(const LAS v2u*)(s_ + HGR_V); \
        const f32x4 q_ = unpack4(Lq); f32x4 lf_ = unpack4(Lf) * 1.44269504f; f32x4 qg_, ki_, eg_; \
        _Pragma("unroll") for (int e = 0; e < 4; ++e) { const float G_ = row16_scan(lf_[e]); eg_[e] = __builtin_amdgcn_exp2f(G_); qg_[e] = q_[e] * eg_[e]; ki_[e] = (1.0f - __builtin_amdgcn_exp2f(lf_[e])) * __builtin_amdgcn_exp2f(-G_); } \
        const v2u kw_ = pack4(ki_); *(LAS v2u*)(d_ + HGB_QG + st * HGS + k0 * 2) = pack4(qg_); *(LAS v2u*)(d_ + HGB_KI + st * HGS + k0 * 2) = kw_; \
        *(LAS unsigned short*)(d_ + HGB_KIT + (k0 + 0) * 32 + st * 2) = (unsigned short)(kw_.x & 0xffffu); *(LAS unsigned short*)(d_ + HGB_KIT + (k0 + 1) * 32 + st * 2) = (unsigned short)(kw_.x >> 16); \
        *(LAS unsigned short*)(d_ + HGB_KIT + (k0 + 2) * 32 + st * 2) = (unsigned short)(kw_.y & 0xffffu); *(LAS unsigned short*)(d_ + HGB_KIT + (k0 + 3) * 32 + st * 2) = (unsigned short)(kw_.y >> 16); \
        *(LAS unsigned short*)(d_ + HGB_VT + (k0 + 0) * 32 + st * 2) = (unsigned short)(Lv.x & 0xffffu); *(LAS unsigned short*)(d_ + HGB_VT + (k0 + 1) * 32 + st * 2) = (unsigned short)(Lv.x >> 16); \
        *(LAS unsigned short*)(d_ + HGB_VT + (k0 + 2) * 32 + st * 2) = (unsigned short)(Lv.y & 0xffffu); *(LAS unsigned short*)(d_ + HGB_VT + (k0 + 3) * 32 + st * 2) = (unsigned short)(Lv.y >> 16); \
        if (st == 15) *(LAS f32x4*)(d_ + HGB_GL + k0 * 4) = eg_; } while (0)
    const f32x4 zero4 = (f32x4){0.f, 0.f, 0.f, 0.f};
    auto a_stage = [&](int j) {
        const LAS unsigned char* rowp = opnd + (j % 3) * HGB_BYTES + c * HGS;
        f32x4 N = zero4;
#pragma unroll
        for (int s = 0; s < 4; ++s) { const bf16x8 nQ = *(const LAS bf16x8*)(rowp + HGB_QG + 64 * s + 16 * g), nK = *(const LAS bf16x8*)(rowp + HGB_KI + 64 * s + 16 * g); N = MFMA32(nK, nQ, N); }
#pragma unroll
        for (int r = 0; r < 4; ++r) N[r] = (c >= 4 * g + r) ? N[r] : 0.f;
        *(LAS bf16x4*)(aop + (j & 1) * 512 + lane * 8) = cv4(N);
    };
    f32x4 Z[8];
#pragma unroll
    for (int i = 0; i < 8; ++i) Z[i] = (f32x4){0.f, 0.f, 0.f, 0.f};
    { HG3_DMA(0); HG3_DMA(1); HG3_DMA(2); HG3_DMA(3); HG3_DMA(4); HG3_DMA(5); HG3_DMA(6); HG3_DMA(7); asm volatile("s_waitcnt vmcnt(0)" ::: "memory"); WG_BAR(); HG3_PROC(0); HG3_PROC(1); WG_BAR(); if (w == 4) a_stage(0); WG_BAR(); }
    if (w < 4) {
        for (int ci = 0; ci < NCHK; ++ci) {
            const int t0 = ci * CH; const int jp = (ci + 2 < NCHK) ? ci + 2 : NCHK - 1;
            HG3_PROC(jp);
            const LAS unsigned char* cur = opnd + (ci % 3) * HGB_BYTES; const LAS unsigned char* rowp = cur + c * HGS;
            f32x4 Y = zero4;
#pragma unroll
            for (int s = 0; s < 4; ++s) {
                const bf16x8 pQ = join8(*(const LAS v2u*)(rowp + HGB_QG + 64 * s + 8 * g), *(const LAS v2u*)(rowp + HGB_QG + 64 * s + 32 + 8 * g));
                Y = MFMA32(pQ, cv8(Z[2 * s], Z[2 * s + 1]), Y); }
            const bf16x4 bV = *(const LAS bf16x4*)(cur + HGB_VT + (16 * vb + c) * 32 + 8 * g);
            const bf16x4 n = *(const LAS bf16x4*)(aop + (ci & 1) * 512 + lane * 8);
            const bf16x4 z4 = (bf16x4){0, 0, 0, 0};
            Y = MFMA32(cat8(n, z4), cat8(bV, z4), Y);
#pragma unroll
            for (int r = 0; r < 4; ++r) odst[(rowbase + t0 + 4 * g + r) * 4096 + 2 * HC + h * HD + 16 * vb + c] = bf1(Y[r]);
#pragma unroll
            for (int zt = 0; zt < 8; ++zt) {
                const bf16x4 aK = *(const LAS bf16x4*)(cur + HGB_KIT + (16 * zt + c) * 32 + 8 * g);
                const f32x4 gl = *(const LAS f32x4*)(cur + HGB_GL + (16 * zt + 4 * g) * 4);
                Z[zt] = MFMA16(aK, bV, Z[zt]) * gl; }
            { const int jn = (ci + NRAW < NCHK) ? ci + NRAW : NCHK - 1; HG3_DMA(jn); }
            if (ci == NCHK / 2 - 1) asm volatile("s_waitcnt vmcnt(0)" ::: "memory");
            asm volatile("s_waitcnt vmcnt(50)" ::: "memory");
            WG_BAR();
            if (ci == NCHK / 2 - 1 && w == 0 && lane == 0) sig_post(WSP(unsigned, WS_CTL) + CW_SIG_HALF);
        }
    } else {
        for (int ci = 0; ci < NCHK; ++ci) {
            const int jp = (ci + 2 < NCHK) ? ci + 2 : NCHK - 1, ja = (ci + 1 < NCHK) ? ci + 1 : NCHK - 1;
            HG3_PROC(jp);
            if (w == 4) a_stage(ja);
            { const int jn = (ci + NRAW < NCHK) ? ci + NRAW : NCHK - 1; HG3_DMA(jn); }
            asm volatile("s_waitcnt vmcnt(30)" ::: "memory");
            WG_BAR();
        }
    }
#undef HG3_DMA
#undef HG3_PROC
}
#undef WG_BAR
__device__ __forceinline__ void p7_post(Frame& F, int hsel, int c, int G);
constexpr int NSCAN = BATCH * RH + 2 * BATCH * HH;
__device__ __forceinline__ void p6_shadow(Frame& F, const Args& A, int c, int G) {
    const unsigned long long* ss = WSP(unsigned long long, WS_SS);
    {   pg8::Gemm g{WSP(bf16, WS_XB), WSP(bf16, WS_WIN) + (size_t)26 * 256 * D, M, 4 * 256, D, 0}; pg8::StaticOrder S; S.init(M, 4 * 256, G, c);
        pg8::EpiInProj E{WSP(bf16, WS_R + R_RKV), WSP(float, WS_R + R_LIN), WSP(bf16, WS_R + R_HG), pg8::inv_preload((PG8_LAS float*)(F.lds + pg8::STAGE_BYTES), S, ss + M), (PG8_LAS float*)(F.lds + pg8::STAGE_BYTES + 4096), 26};
        pg8::gemm_phase<pg8::EpiInProj, pg8::StaticOrder, true, true>(F.lds, g, S, E); }
    {   int kl = KL; asm volatile("" : "+s"(kl));
        pg8::Gemm g{WSP(bf16, WS_ALORA), WSP(bf16, WS_WLORA) + (size_t)8 * 256 * KL, M, 4 * 256, kl, 0}; pg8::StaticOrder S; S.init(M, 4 * 256, G, c);
        pg8::EpiLora E{WSP(bf16, WS_LOUT), (PG8_LAS float*)(F.lds + pg8::STAGE_BYTES), 8};
        pg8::gemm_phase<pg8::EpiLora, pg8::StaticOrder, true, true>(F.lds, g, S, E); }
    p0_transposes<1>(F, A, c * NWAVES + F.wave, G * NWAVES);
}
__device__ __forceinline__ void p6_shadow_pre(Frame& F, int c, int G) {
    unsigned* ctl = WSP(unsigned, WS_CTL);
    p4_lora_in(F, 1, c, G);
    wg_signal(ctl + CW_SIG_P4); wg_wait(ctl + CW_SIG_P4, (unsigned)G, ctl + CW_BAR);
    {   int kl = KL; asm volatile("" : "+s"(kl));
        pg8::Gemm g{WSP(bf16, WS_ALORA), WSP(bf16, WS_WLORA), M, 8 * 256, kl, 0}; pg8::StaticOrder S; S.init(M / 2, 8 * 256, G, c); S.hsel = 1;
        PG8_LAS float* bt = (PG8_LAS float*)(F.lds + pg8::STAGE_BYTES);
        for (int cix = F.tid; cix < 2 * RC; cix += NWAVES * 64) bt[cix] = cix < RC ? F.in[8][cix] : F.in[10][cix - RC];
        __syncthreads();
        pg8::EpiLora E{WSP(bf16, WS_LOUT), bt, 0};
        pg8::gemm_phase<pg8::EpiLora, pg8::StaticOrder, true, true>(F.lds, g, S, E); }
    wg_signal(ctl + CW_SIG_H2);
}
__device__ __forceinline__ void p6_shadow_b(Frame& F, int c, int G) {
    unsigned* ctl = WSP(unsigned, WS_CTL);
    wg_signal(ctl + CW_SIG_SHA); wg_wait(ctl + CW_SIG_SHA, (unsigned)G, ctl + CW_BAR);
    wg_wait(ctl + CW_SIG_HALF, (unsigned)NSCAN, ctl + CW_BAR);
    p7_post(F, 0, c, G);
    wg_signal(ctl + CW_SIG_SHB); wg_wait(ctl + CW_SIG_SHB, (unsigned)G, ctl + CW_BAR);
    {   pg8::Gemm g{WSP(bf16, WS_XB), WSP(bf16, WS_WOUT), M, D, D, 0}; pg8::StaticOrder S; S.init(M / 2, D, G, c, 4); S.hsel = 0;
        pg8::EpiResid E{nullptr, (const bf16*)F.out, nullptr, nullptr, (bf16*)F.out + D, F.in[21], nullptr, WSP(unsigned long long, WS_SS) + 2 * M, 1.0f, 2 * D, 2 * D, 2048};
        pg8::gemm_phase<pg8::EpiResid, pg8::StaticOrder, true, true>(F.lds, g, S, E); }
}
__device__ __forceinline__ void p6_scans(Frame& F, const Args& A) {
    const int bx = (int)blockIdx.x;
    if (F.G == 2 * NSCAN) {
        const int x = bx & 7, idx = (bx >> 3) * 4 + (x & 3);
        if (x < 4) { if (idx < BATCH * RH) p6_rwkv_head(F, idx, NSCAN); else p6_hgrn_head(F, idx - BATCH * RH); } else { p6_shadow_pre(F, idx, NSCAN); p6_shadow(F, A, idx, NSCAN); p6_shadow_b(F, idx, NSCAN); } }
    else if (F.G > NSCAN) { if (bx < NSCAN) { if (bx < BATCH * RH) p6_rwkv_head(F, bx, F.G - NSCAN); else p6_hgrn_head(F, bx - BATCH * RH); } else { p6_shadow_pre(F, bx - NSCAN, F.G - NSCAN); p6_shadow(F, A, bx - NSCAN, F.G - NSCAN); p6_shadow_b(F, bx - NSCAN, F.G - NSCAN); } }
    else {
        for (int u = bx; u < NSCAN; u += F.G) { if (u < BATCH * RH) p6_rwkv_head(F, u, 0); else p6_hgrn_head(F, u - BATCH * RH); }
        __syncthreads(); p6_shadow(F, A, bx, F.G);
    }
}

__device__ __forceinline__ void p7_post(Frame& F, int hsel, int c, int G) {
    const int NR = hsel < 0 ? M : M / 2;
    const bf16* rkv = WSP(bf16, WS_R + R_RKV); const bf16* hg = WSP(bf16, WS_R + R_HG); const bf16* lout = WSP(bf16, WS_LOUT); bf16* yc = WSP(bf16, WS_XB);
    { const int half = F.tid >> 8, ch = (F.tid & 255) * 4;
      const f32x4 mu_r = *(const f32x4*)(F.in[7] + ch), mu_k = *(const f32x4*)(F.in[7] + RC + ch), mu_v = *(const f32x4*)(F.in[7] + 2 * RC + ch);
      const f32x4 kac = *(const f32x4*)(F.in[14] + ch), rkc = *(const f32x4*)(F.in[15] + ch), lnw = *(const f32x4*)(F.in[16] + ch), lnb = *(const f32x4*)(F.in[17] + ch);
#pragma unroll 2
      for (int i = c * 2 + half; i < NR; i += 2 * G) { const int m = hsel < 0 ? i : (i / (SEQ / 2)) * SEQ + (i % (SEQ / 2)) + hsel * (SEQ / 2);
          const bool first = (m & (SEQ - 1)) == 0; const size_t mp = first ? m : m - 1;
          const bf16* p = rkv + (size_t)m * 3072 + ch; const bf16* q = rkv + mp * 3072 + ch; const bf16* l = lout + (size_t)m * 3072 + ch;
          const f32x4 y = unpack4(*(const GAS v2u*)(l));
          const f32x4 r = unpack4(*(const GAS v2u*)(p)), k = unpack4(*(const GAS v2u*)(p + RC)), v = unpack4(*(const GAS v2u*)(p + 2 * RC));
          f32x4 rp = unpack4(*(const GAS v2u*)(q)), kp = unpack4(*(const GAS v2u*)(q + RC)), vp = unpack4(*(const GAS v2u*)(q + 2 * RC));
          if (first) { rp = (f32x4){0.f, 0.f, 0.f, 0.f}; kp = rp; vp = rp; }
          const f32x4 a = unpack4(*(const GAS v2u*)(l + RC)), gg = unpack4(*(const GAS v2u*)(l + 2 * RC));
          const f32x4 rs = r + (rp - r) * mu_r, ks = k + (kp - k) * mu_k, vs = v + (vp - v) * mu_v;
          const f32x4 km = ks * (1.0f + (a - 1.0f) * kac);
          const f32x4 bt = rs * km * rkc; float bon = (bt[0] + bt[1]) + (bt[2] + bt[3]); bon = row16_sum(bon);
          float s1 = (y[0] + y[1]) + (y[2] + y[3]); s1 = row16_sum(s1); const float mean = s1 * (1.0f / 64.0f);
          const f32x4 d = y - mean; float s2 = (d[0] * d[0] + d[1] * d[1]) + (d[2] * d[2] + d[3] * d[3]); s2 = row16_sum(s2);
          const float rstd = 1.0f / sqrtf(s2 * (1.0f / 64.0f) + 64e-5f);
          const f32x4 o = ((d * rstd) * lnw + lnb + vs * bon) * gg;
          *(GAS v2u*)(yc + (size_t)m * 2048 + ch) = pack4(o); } }
    { const int quarter = F.tid >> 7, ch = (F.tid & 127) * 8;
      const f32x4 nw0 = *(const f32x4*)(F.in[19] + ch), nw1 = *(const f32x4*)(F.in[19] + ch + 4);
#pragma unroll 4
      for (int i = c * 4 + quarter; i < NR; i += 4 * G) { const int m = hsel < 0 ? i : (i / (SEQ / 2)) * SEQ + (i % (SEQ / 2)) + hsel * (SEQ / 2);
          const v4u ow = *(const GAS v4u*)(hg + (size_t)m * 4096 + 2 * HC + ch), gw4 = *(const GAS v4u*)(hg + (size_t)m * 4096 + 3 * HC + ch);
          const f32x4 o0 = (f32x4){bflo(ow.x), bfhi(ow.x), bflo(ow.y), bfhi(ow.y)}, o1 = (f32x4){bflo(ow.z), bfhi(ow.z), bflo(ow.w), bfhi(ow.w)};
          const f32x4 g0 = (f32x4){bflo(gw4.x), bfhi(gw4.x), bflo(gw4.y), bfhi(gw4.y)}, g1 = (f32x4){bflo(gw4.z), bfhi(gw4.z), bflo(gw4.w), bfhi(gw4.w)};
          float s2 = ((o0[0] * o0[0] + o0[1] * o0[1]) + (o0[2] * o0[2] + o0[3] * o0[3])) + ((o1[0] * o1[0] + o1[1] * o1[1]) + (o1[2] * o1[2] + o1[3] * o1[3])); s2 = row16_sum(s2);
          const float rstd = 1.0f / sqrtf(s2 * (1.0f / 128.0f) + 1e-6f);
          *(GAS v4u*)(yc + (size_t)m * 2048 + RC + ch) = pg8::pack8(o0 * rstd * nw0 * g0, o1 * rstd * nw1 * g1); } }
}

__device__ __forceinline__ void p11_final(Frame& F) {
    const int gw = F.vcu * NWAVES + F.wave, NGW = F.G * NWAVES; const float* fg = F.in[25];
    const bf16* x3 = WSP(bf16, WS_XB); const unsigned long long* ss3 = WSP(unsigned long long, WS_SS) + 3 * M;
    f32x4 gn[8];
#pragma unroll
    for (int j = 0; j < 4; ++j) { gn[2 * j] = *(const f32x4*)(fg + 8 * F.lane + 512 * j); gn[2 * j + 1] = *(const f32x4*)(fg + 8 * F.lane + 512 * j + 4); }
#pragma unroll 2
    for (int m = gw; m < M; m += NGW) { const GAS v4u* xr = (const GAS v4u*)(x3 + (size_t)m * D) + F.lane; GAS f32x4* o = (GAS f32x4*)(F.out + (size_t)m * D) + 2 * F.lane;
        const float inv = pg8::inv_rms_from_val(ss3[m]);
#pragma unroll
        for (int j = 0; j < 4; ++j) { const v4u w = xr[64 * j];
            o[128 * j] = (f32x4){bflo(w.x), bfhi(w.x), bflo(w.y), bfhi(w.y)} * inv * gn[2 * j]; o[128 * j + 1] = (f32x4){bflo(w.z), bfhi(w.z), bflo(w.w), bfhi(w.w)} * inv * gn[2 * j + 1]; } }
}

__global__ void __launch_bounds__(NWAVES * 64, 2) mk_fwd(Args args) {
    extern __shared__ __attribute__((aligned(16))) unsigned char lds[];
    Frame F;
    F.lds = (LAS unsigned char*)lds;
    F.tid = threadIdx.x; F.lane = F.tid & 63; F.wave = __builtin_amdgcn_readfirstlane(F.tid >> 6);
    F.G = gridDim.x; { const int bx = blockIdx.x; F.vcu = (F.G % 8 == 0) ? (bx % 8) * (F.G / 8) + bx / 8 : bx; }
#pragma unroll
    for (int i = 0; i < 26; ++i) F.in[i] = args.in[i];
    F.out = args.out; F.ws = args.ws;
    for (int u = F.tid; u < (LDS_BYTES - LDSCTL_OFF) / 4; u += NWAVES * 64) ((LAS unsigned*)(F.lds + LDSCTL_OFF))[u] = 0u;
    __syncthreads();
    const int lo = args.ph_lo, hi = args.ph_hi;
    XcdBarrier bar; bar.bar = (unsigned*)(args.ws + WS_CTL) + CW_BAR; bar.x = 0; bar.st = nullptr;
    if (hi - lo > 1) bar = xcd_barrier_post((unsigned*)(args.ws + WS_CTL) + CW_BAR, (volatile LAS unsigned*)(F.lds + MISC_OFF) + 8);
#ifndef PH_MASK
#define PH_MASK 0xFFF
#endif
#define IN(k) (((PH_MASK >> (k)) & 1) && lo <= (k) && (k) < hi)
#define SEAM(k) do { if (IN(k) && IN((k) + 1)) xcd_barrier(bar); } while (0)
    const bf16* xb = WSP(bf16, WS_XB); unsigned long long* ss = WSP(unsigned long long, WS_SS);
    const int cid = (int)blockIdx.x;
    bf16* const x2b = (bf16*)F.out + D;
    const bool fuse = (F.G % 256) == 0;

    if (IN(0)) { p0_prologue(F, args); } SEAM(0);
    if (IN(1)) {
        pg8::Gemm g{xb, WSP(bf16, WS_W1GU), M, 2 * FF, D, 0}; pg8::StaticOrder S; S.init(M, 2 * FF, F.G, cid);
        pg8::EpiSwiglu E{WSP(bf16, WS_R + R_ACT), FF, pg8::inv_preload((PG8_LAS float*)(F.lds + pg8::STAGE_BYTES), S, ss)};
        pg8::gemm_phase<pg8::EpiSwiglu, pg8::StaticOrder, true, true>(F.lds, g, S, E);
    } SEAM(1);
    if (IN(2)) {
        pg8::Gemm g{WSP(bf16, WS_R + R_ACT), WSP(bf16, WS_W1D), M, D, FF, 0}; pg8::StaticOrder S; S.init(M, D, F.G, cid, 4);
        pg8::EpiResid E{F.in[0], nullptr, nullptr, nullptr, WSP(bf16, WS_XB), F.in[5], (bf16*)F.out, ss + M, 0.5f, 2048, 2048, 2 * D};
        pg8::gemm_phase<pg8::EpiResid, pg8::StaticOrder, true, true>(F.lds, g, S, E);
    } SEAM(2);
    if (IN(3)) {
        pg8::Gemm g{xb, WSP(bf16, WS_WIN), M, 26 * 256, D, 0}; pg8::StaticOrder S; S.init(M, 26 * 256, F.G, cid);
        PG8_LAS float* omt = (PG8_LAS float*)(F.lds + pg8::STAGE_BYTES + 4096);
        for (int cix = F.tid; cix < HC; cix += NWAVES * 64) omt[cix] = 1.0f - fast_sigmoid(F.in[18][cix] - F.in[18][HC + cix]);
        pg8::EpiInProj E{WSP(bf16, WS_R + R_RKV), WSP(float, WS_R + R_LIN), WSP(bf16, WS_R + R_HG), pg8::inv_preload((PG8_LAS float*)(F.lds + pg8::STAGE_BYTES), S, ss + M), omt, 0};
        pg8::gemm_phase<pg8::EpiInProj, pg8::StaticOrder, true, true>(F.lds, g, S, E);
    } SEAM(3);
    const bool split = F.G > NSCAN;
    if (IN(4)) { p4_lora_in(F, split ? 0 : -1, F.vcu, F.G); } SEAM(4);
    if (IN(5)) {
        int kl = KL; asm volatile("" : "+s"(kl));
        pg8::Gemm g{WSP(bf16, WS_ALORA), WSP(bf16, WS_WLORA), M, 8 * 256, kl, 0}; pg8::StaticOrder S; S.init(split ? M / 2 : M, 8 * 256, F.G, cid); S.hsel = split ? 0 : -1;
        PG8_LAS float* bt = (PG8_LAS float*)(F.lds + pg8::STAGE_BYTES);
        for (int cix = F.tid; cix < 2 * RC; cix += NWAVES * 64) bt[cix] = cix < RC ? F.in[8][cix] : F.in[10][cix - RC];
        __syncthreads();
        pg8::EpiLora E{WSP(bf16, WS_LOUT), bt, 0};
        pg8::gemm_phase<pg8::EpiLora, pg8::StaticOrder, true, true>(F.lds, g, S, E);
    } SEAM(5);
    if (IN(6)) { p6_scans(F, args); } SEAM(6);
    if (IN(7)) { p7_post(F, split ? 1 : -1, F.vcu, F.G); } SEAM(7);
    if (IN(8)) {
        pg8::Gemm g{xb, WSP(bf16, WS_WOUT), M, D, D, 0}; pg8::StaticOrder S; S.init(split ? M / 2 : M, D, F.G, cid, 4); S.hsel = split ? 1 : -1;
        pg8::EpiResid E{nullptr, (const bf16*)F.out, nullptr, nullptr, x2b, F.in[21], nullptr, ss + 2 * M, 1.0f, 2 * D, 2 * D, 2048};
        pg8::gemm_phase<pg8::EpiResid, pg8::StaticOrder, true, true>(F.lds, g, S, E);
    } SEAM(8);
    if (IN(9)) {
        pg8::Gemm g{x2b, WSP(bf16, WS_W2GU), M, 2 * FF, D, 2 * D}; pg8::StaticOrder S; S.init(M, 2 * FF, F.G, cid);
        pg8::EpiSwiglu E{WSP(bf16, WS_R + R_ACT), FF, pg8::inv_preload((PG8_LAS float*)(F.lds + pg8::STAGE_BYTES), S, ss + 2 * M)};
        pg8::gemm_phase<pg8::EpiSwiglu, pg8::StaticOrder, true, true>(F.lds, g, S, E);
    } SEAM(9);
    if (IN(10)) {
        pg8::Gemm g{WSP(bf16, WS_R + R_ACT), WSP(bf16, WS_W2D), M, D, FF, 0}; pg8::StaticOrder S; S.init(M, D, F.G, cid, 4);
        if (fuse) { pg8::EpiFinal E{x2b, 2 * D, F.in[21], F.in[25], F.out, ss + 3 * M, WSP(unsigned, WS_CTL) + CW_PCNT, WSP(unsigned, WS_CTL) + CW_BAR + XB_TMO, 0.5f, (unsigned)(D / 256)};
            pg8::gemm_phase<pg8::EpiFinal, pg8::StaticOrder, true, true>(F.lds, g, S, E); }
        else { pg8::EpiResid E{nullptr, x2b, F.in[21], nullptr, nullptr, nullptr, WSP(bf16, WS_XB), ss + 3 * M, 0.5f, 2 * D, 2048, 2048};
            pg8::gemm_phase<pg8::EpiResid, pg8::StaticOrder, true, true>(F.lds, g, S, E); }
    }
    if (!fuse) { SEAM(10); if (IN(11)) { p11_final(F); } }
#undef IN
#undef SEAM
}

extern "C" void kernel_launch(void* const* d_in, const int* in_sizes, int n_in, void* d_out, int out_size, void* d_ws, size_t ws_size, hipStream_t stream) {
    static int grid = 0;
    if (grid == 0) {
        if (n_in != 26 || in_sizes[0] != M * D || out_size != M * D || ws_size < WS_END) { fprintf(stderr, "kernel_launch: unexpected problem (n_in %d, ws %zu < %zu)\n", n_in, ws_size, (size_t)WS_END); grid = -1; return; }
        int dev = 0, cus = 0, per_cu = 0;
        if (hipGetDevice(&dev) != hipSuccess || hipDeviceGetAttribute(&cus, hipDeviceAttributeMultiprocessorCount, dev) != hipSuccess) { grid = -1; return; }
        if (hipFuncSetAttribute((const void*)mk_fwd, hipFuncAttributeMaxDynamicSharedMemorySize, LDS_BYTES) != hipSuccess) { grid = -1; return; }
        if (hipOccupancyMaxActiveBlocksPerMultiprocessor(&per_cu, (const void*)mk_fwd, NWAVES * 64, LDS_BYTES) != hipSuccess || per_cu < 1) fprintf(stderr, "kernel_launch: occupancy query reports %d\n", per_cu);
        (void)hipGetLastError();
        grid = cus;
    }
    if (grid < 0) return;
    (void)hipMemsetAsync((char*)d_ws + WS_CTL, 0, CTL_BYTES, stream);
    Args a{};
    for (int i = 0; i < 26; ++i) a.in[i] = (const float*)d_in[i];
    a.out = (float*)d_out; a.ws = (unsigned char*)d_ws;
    constexpr int NL_ = MK_N_LAUNCHES;
    for (int li = 0; li < NL_; ++li) {
        a.ph_lo = (NL_ == 1) ? 0 : li; a.ph_hi = (NL_ == 1) ? N_PHASES : li + 1;
        hipLaunchKernelGGL(mk_fwd, dim3(grid), dim3(NWAVES * 64), LDS_BYTES, stream, a);
    }
}
```

```cpp
#include <hip/hip_runtime.h>
#include <cstdio>
#include <cstdint>
namespace pg8 {
#define PG8_LAS __attribute__((address_space(3)))
typedef unsigned short bf16_t;
typedef short bf16x8 __attribute__((ext_vector_type(8)));
typedef float f32x4 __attribute__((ext_vector_type(4)));
typedef unsigned u32x4 __attribute__((ext_vector_type(4)));
constexpr int BM = 256, BK = 64, HALF = 128, HTB = HALF * BK * 2  , STAGE_BYTES = 8 * HTB, NXCD = 8, WGM = 8;

__host__ __device__ __forceinline__ int lds_byte(int r, int c) { const int st = (r >> 4) * 2 + (c >> 5), rr = r & 15, cc = c & 31, ob = rr * 64 + cc * 2; return st * 1024 + (ob ^ (((ob >> 9) & 1) << 5)); }
__host__ __device__ __forceinline__ void stage_rc(int b, int& R, int& C) { const int st = b / 1024, sb = b % 1024, swz = sb ^ (((sb >> 9) & 1) << 5); R = (st >> 1) * 16 + swz / 64; C = (st & 1) * 32 + (swz % 64) / 2; }
__host__ __device__ __forceinline__ int perm32(int rho) { const int n = rho >> 4, i = rho & 15; return 8 * (i >> 2) + 4 * n + (i & 3); }

struct Unit { int pm, pn; };
struct Gemm { const bf16_t* A; const bf16_t* Bt; int M, N, K, lda; };

struct StaticOrder {
    int nM, nN, nwg, G, c, wgm, hsel;
    __host__ __device__ void init(int M, int N, int G_, int c_, int wgm_ = WGM) { nM = M / BM; nN = N / BM; nwg = nM * nN; G = G_; c = c_; wgm = wgm_; hsel = -1; }
    __host__ __device__ bool next(int i, Unit& u) const {
        const long L = (long)i * G + c; if (L >= nwg) return false;
        int wgid = (int)L; { const int q = nwg / NXCD, r = nwg % NXCD, xcd = wgid % NXCD, off = wgid / NXCD; wgid = (xcd < r ? xcd * (q + 1) : r * (q + 1) + (xcd - r) * q) + off; }
        const int nig = wgm * nN, gid = wgid / nig, fm = gid * wgm, gsz = (nM - fm) < wgm ? (nM - fm) : wgm;
        u.pm = fm + ((wgid % nig) % gsz); u.pn = (wgid % nig) / gsz; if (hsel >= 0) u.pm = (u.pm >> 4) * 32 + (u.pm & 15) + 16 * hsel; return true;
    }
    __device__ __forceinline__ void a_ready(const Unit&) const {}
    __device__ __forceinline__ void done(const Unit&) const {}
};


typedef __bf16 bf16n2 __attribute__((ext_vector_type(2)));
__device__ __forceinline__ unsigned cvt_pk_bf16(float lo, float hi) { bf16n2 v; v.x = (__bf16)lo; v.y = (__bf16)hi; return __builtin_bit_cast(unsigned, v); }
__device__ __forceinline__ float fast_sigmoid(float z) { return __builtin_amdgcn_rcpf(1.0f + __builtin_amdgcn_exp2f(-1.44269504f * z)); }
__device__ __forceinline__ float fast_silu(float z) { return z * fast_sigmoid(z); }
constexpr float SS_SCALE = 16777216.0f;
__device__ __forceinline__ float inv_rms_from_val(unsigned long long v) {
    const float tot = (float)v * (1.0f / SS_SCALE);
    return 1.0f / sqrtf(tot * (1.0f / 2048.0f) + 1e-6f);
}
__device__ __forceinline__ u32x4 pack8(const f32x4 v0, const f32x4 v1) { u32x4 w; w.x = cvt_pk_bf16(v0[0], v0[1]); w.y = cvt_pk_bf16(v0[2], v0[3]); w.z = cvt_pk_bf16(v1[0], v1[1]); w.w = cvt_pk_bf16(v1[2], v1[3]); return w; }

struct InvTab {
    const PG8_LAS float* tab; int t0, t1, t2, t3; const unsigned long long* ss;
    __device__ __forceinline__ int slot(int pm) const { return pm == t0 ? 0 : (pm == t1 ? 1 : (pm == t2 ? 2 : (pm == t3 ? 3 : -1))); }
    __device__ __forceinline__ void get(float (&inv)[2][4], int pm, int r0) const {
        const int sl = slot(pm);
        if (sl >= 0) {
#pragma unroll
            for (int ai = 0; ai < 2; ++ai)
#pragma unroll
                for (int m = 0; m < 4; ++m) inv[ai][m] = tab[sl * BM + r0 + ai * HALF + m * 16];
        } else { unsigned long long sv[2][4];
#pragma unroll
            for (int ai = 0; ai < 2; ++ai)
#pragma unroll
                for (int m = 0; m < 4; ++m) sv[ai][m] = ss[pm * BM + r0 + ai * HALF + m * 16];
#pragma unroll
            for (int ai = 0; ai < 2; ++ai)
#pragma unroll
                for (int m = 0; m < 4; ++m) inv[ai][m] = inv_rms_from_val(sv[ai][m]); }
    }
};
template <class Sched> __device__ __forceinline__ InvTab inv_preload(PG8_LAS float* tab, const Sched& S, const unsigned long long* ss) {
    InvTab T; T.tab = tab; T.t0 = -1; T.t1 = -1; T.t2 = -1; T.t3 = -1; T.ss = ss; int n = 0; Unit u;
    for (int i = 0; S.next(i, u); ++i) {
        if (T.slot(u.pm) < 0 && n < 4) {
            if (threadIdx.x < BM) tab[n * BM + threadIdx.x] = inv_rms_from_val(ss[u.pm * BM + threadIdx.x]);
            if (n == 0) T.t0 = u.pm; else if (n == 1) T.t1 = u.pm; else if (n == 2) T.t2 = u.pm; else T.t3 = u.pm;
            ++n; } }
    __syncthreads();
    return T;
}
struct EpiSwiglu {
    static constexpr bool PERM = true, AFTER_DRAIN = false;
    bf16_t* O; int ldc; InvTab it;
    __device__ __forceinline__ void operator()(const f32x4 (&acc)[2][2][4][2], const Unit& u, int wr, int wc, int fr, int fq) const {
        const int row0 = u.pm * BM + wr * 64 + fr, col0 = u.pn * HALF + wc * 32 + 8 * fq;
        float invs[2][4]; it.get(invs, u.pm, wr * 64 + fr);
#pragma unroll
        for (int ai = 0; ai < 2; ++ai)
#pragma unroll
            for (int m = 0; m < 4; ++m) { const int row = row0 + ai * HALF + m * 16; const float inv = invs[ai][m], invn = inv * -1.44269504f;
                f32x4 o[2];
#pragma unroll
                for (int n = 0; n < 2; ++n) { const f32x4 g = acc[ai][0][m][n] * inv, up = acc[ai][1][m][n] * inv, t = acc[ai][0][m][n] * invn; f32x4 e, r;
#pragma unroll
                    for (int j = 0; j < 4; ++j) e[j] = __builtin_amdgcn_exp2f(t[j]);
                    const f32x4 d = e + 1.0f;
#pragma unroll
                    for (int j = 0; j < 4; ++j) r[j] = __builtin_amdgcn_rcpf(d[j]);
                    o[n] = (g * r) * up; }
                *(u32x4*)(O + (size_t)row * ldc + col0) = pack8(o[0], o[1]); }
    }
};
struct EpiResid {
    static constexpr bool PERM = true, AFTER_DRAIN = false;
    const float* rf; const bf16_t* rb; const float* rbg; float* out; bf16_t* ob; const float* gain; bf16_t* ob2; unsigned long long* ss; float alpha; int prb, pob, pob2;
    __device__ __forceinline__ void operator()(const f32x4 (&acc)[2][2][4][2], const Unit& u, int wr, int wc, int fr, int fq) const {
        const int row0 = u.pm * BM + wr * 64 + fr, col0 = u.pn * BM + wc * 32 + 8 * fq;
        f32x4 gi[2][2], go[2][2];
#pragma unroll
        for (int bj = 0; bj < 2; ++bj)
#pragma unroll
            for (int n = 0; n < 2; ++n) { gi[bj][n] = (f32x4){1.f, 1.f, 1.f, 1.f}; go[bj][n] = gi[bj][n];
                if (rbg) { const f32x4 t = *(const f32x4*)(rbg + col0 + bj * HALF + 4 * n); gi[bj][n] = (f32x4){1.0f / t[0], 1.0f / t[1], 1.0f / t[2], 1.0f / t[3]}; }
                if (ob) go[bj][n] = *(const f32x4*)(gain + col0 + bj * HALF + 4 * n); }
#pragma unroll
        for (int ai = 0; ai < 2; ++ai)
#pragma unroll
            for (int m = 0; m < 4; ++m) { const int row = row0 + ai * HALF + m * 16; const size_t off = (size_t)row * 2048 + col0, offr = (size_t)row * prb + col0, offo = (size_t)row * pob + col0, offo2 = (size_t)row * pob2 + col0; float s = 0.f;
#pragma unroll
                for (int bj = 0; bj < 2; ++bj) {
                    f32x4 r0, r1;
                    if (rf) { r0 = *(const f32x4*)(rf + off + bj * HALF); r1 = *(const f32x4*)(rf + off + bj * HALF + 4); }
                    else { const u32x4 w = *(const u32x4*)(rb + offr + bj * HALF);
                        r0 = (f32x4){__builtin_bit_cast(float, w.x << 16), __builtin_bit_cast(float, w.x & 0xffff0000u), __builtin_bit_cast(float, w.y << 16), __builtin_bit_cast(float, w.y & 0xffff0000u)} * gi[bj][0];
                        r1 = (f32x4){__builtin_bit_cast(float, w.z << 16), __builtin_bit_cast(float, w.z & 0xffff0000u), __builtin_bit_cast(float, w.w << 16), __builtin_bit_cast(float, w.w & 0xffff0000u)} * gi[bj][1]; }
                    const f32x4 o0 = r0 + acc[ai][bj][m][0] * alpha, o1 = r1 + acc[ai][bj][m][1] * alpha;
                    if (out) { *(f32x4*)(out + off + bj * HALF) = o0; *(f32x4*)(out + off + bj * HALF + 4) = o1; }
                    if (ob) *(u32x4*)(ob + offo + bj * HALF) = pack8(o0 * go[bj][0], o1 * go[bj][1]);
                    if (ob2) *(u32x4*)(ob2 + offo2 + bj * HALF) = pack8(o0, o1);
                    s += (o0[0] * o0[0] + o0[1] * o0[1]) + (o0[2] * o0[2] + o0[3] * o0[3]) + (o1[0] * o1[0] + o1[1] * o1[1]) + (o1[2] * o1[2] + o1[3] * o1[3]); }
                if (ss) { s += __shfl_xor(s, 16); s += __shfl_xor(s, 32);
                    if (fq == 0) atomicAdd(ss + row, (unsigned long long)(s * SS_SCALE + 0.5f)); } }
    }
};
struct EpiFinal {
    static constexpr bool PERM = true, AFTER_DRAIN = false;
    const bf16_t* rb; int prb; const float* rbg; const float* fgain; float* out; unsigned long long* ss; unsigned* cnt; unsigned* tmo; float alpha; unsigned npn;
    __device__ __forceinline__ void operator()(f32x4 (&acc)[2][2][4][2], const Unit& u, int wr, int wc, int fr, int fq) const {
        const int row0 = u.pm * BM + wr * 64 + fr, col0 = u.pn * BM + wc * 32 + 8 * fq;
        { f32x4 gi[2][2];
#pragma unroll
          for (int bj = 0; bj < 2; ++bj)
#pragma unroll
            for (int n = 0; n < 2; ++n) { const f32x4 t = *(const f32x4*)(rbg + col0 + bj * HALF + 4 * n); gi[bj][n] = (f32x4){1.0f / t[0], 1.0f / t[1], 1.0f / t[2], 1.0f / t[3]}; }
#pragma unroll
          for (int ai = 0; ai < 2; ++ai)
#pragma unroll
            for (int m = 0; m < 4; ++m) { const int row = row0 + ai * HALF + m * 16; const size_t offr = (size_t)row * prb + col0; float s = 0.f;
#pragma unroll
                for (int bj = 0; bj < 2; ++bj) { const u32x4 w = *(const u32x4*)(rb + offr + bj * HALF);
                    const f32x4 r0 = (f32x4){__builtin_bit_cast(float, w.x << 16), __builtin_bit_cast(float, w.x & 0xffff0000u), __builtin_bit_cast(float, w.y << 16), __builtin_bit_cast(float, w.y & 0xffff0000u)} * gi[bj][0];
                    const f32x4 r1 = (f32x4){__builtin_bit_cast(float, w.z << 16), __builtin_bit_cast(float, w.z & 0xffff0000u), __builtin_bit_cast(float, w.w << 16), __builtin_bit_cast(float, w.w & 0xffff0000u)} * gi[bj][1];
                    const f32x4 o0 = r0 + acc[ai][bj][m][0] * alpha, o1 = r1 + acc[ai][bj][m][1] * alpha; acc[ai][bj][m][0] = o0; acc[ai][bj][m][1] = o1;
                    s += (o0[0] * o0[0] + o0[1] * o0[1]) + (o0[2] * o0[2] + o0[3] * o0[3]) + (o1[0] * o1[0] + o1[1] * o1[1]) + (o1[2] * o1[2] + o1[3] * o1[3]); }
                s += __shfl_xor(s, 16); s += __shfl_xor(s, 32);
                if (fq == 0) atomicAdd(ss + row, (unsigned long long)(s * SS_SCALE + 0.5f)); } }
        asm volatile("s_waitcnt vmcnt(0)" ::: "memory"); __syncthreads();
        if (threadIdx.x == 0) { unsigned* c = cnt + u.pm;
            (void)__hip_atomic_fetch_add(c, 1u, __ATOMIC_RELAXED, __HIP_MEMORY_SCOPE_AGENT);
            unsigned sp = 0;
            while (__hip_atomic_load(c, __ATOMIC_RELAXED, __HIP_MEMORY_SCOPE_AGENT) < npn) { __builtin_amdgcn_s_sleep(1);
                if ((++sp & 255u) == 0u) { if (__hip_atomic_load(tmo, __ATOMIC_RELAXED, __HIP_MEMORY_SCOPE_AGENT)) break; if (sp > (1u << 18)) { atomicAdd(tmo, 1u); break; } } }
        }
        __syncthreads();
        f32x4 fg[2][2];
#pragma unroll
        for (int bj = 0; bj < 2; ++bj)
#pragma unroll
            for (int n = 0; n < 2; ++n) fg[bj][n] = *(const f32x4*)(fgain + col0 + bj * HALF + 4 * n);
#pragma unroll
        for (int ai = 0; ai < 2; ++ai)
#pragma unroll
            for (int m = 0; m < 4; ++m) { const int row = row0 + ai * HALF + m * 16; const size_t off = (size_t)row * 2048 + col0;
                const float inv = inv_rms_from_val(__hip_atomic_load(ss + row, __ATOMIC_RELAXED, __HIP_MEMORY_SCOPE_AGENT));
#pragma unroll
                for (int bj = 0; bj < 2; ++bj) { *(f32x4*)(out + off + bj * HALF) = acc[ai][bj][m][0] * inv * fg[bj][0]; *(f32x4*)(out + off + bj * HALF + 4) = acc[ai][bj][m][1] * inv * fg[bj][1]; } }
    }
};
struct EpiInProj {
    static constexpr bool PERM = true, AFTER_DRAIN = false;
    bf16_t* rkv; float* lin; bf16_t* hg; InvTab it; const PG8_LAS float* oml; int pn0;
    __device__ __forceinline__ void operator()(const f32x4 (&acc)[2][2][4][2], const Unit& u, int wr, int wc, int fr, int fq) const {
        const int row0 = u.pm * BM + wr * 64 + fr, cin = wc * 32 + 8 * fq;
        const int pn = u.pn + pn0;
        float invs[2][4]; it.get(invs, u.pm, wr * 64 + fr);
        int mode;
        if (pn < 12) mode = 0; else if (pn < 14) mode = 1; else { const int sg = (pn - 14) >> 2; mode = (sg == 0 || sg == 3) ? 2 : (sg == 1 ? 3 : 4); }
#pragma unroll
        for (int bj = 0; bj < 2; ++bj) {
            f32x4 om0 = (f32x4){0.f, 0.f, 0.f, 0.f}, om1 = om0;
            if (mode == 3) { const PG8_LAS float* lp = oml + (pn - 18) * BM + bj * HALF + cin; om0 = *(const PG8_LAS f32x4*)lp; om1 = *(const PG8_LAS f32x4*)(lp + 4); }
#pragma unroll
            for (int ai = 0; ai < 2; ++ai)
#pragma unroll
                for (int m = 0; m < 4; ++m) { const int row = row0 + ai * HALF + m * 16; const float inv = invs[ai][m];
                    f32x4 v0 = acc[ai][bj][m][0] * inv, v1 = acc[ai][bj][m][1] * inv;
                    if (mode == 0) { *(u32x4*)(rkv + (size_t)row * 3072 + pn * BM + bj * HALF + cin) = pack8(v0, v1); }
                    else if (mode == 1) { const int cl = (pn - 12) * BM + bj * HALF + cin;
                        if (cl < 288) { *(f32x4*)(lin + (size_t)row * 288 + cl) = v0; *(f32x4*)(lin + (size_t)row * 288 + cl + 4) = v1; } }
                    else {
                        if (mode == 2) {
#pragma unroll
                            for (int j = 0; j < 4; ++j) { v0[j] = fast_silu(v0[j]); v1[j] = fast_silu(v1[j]); } }
                        else if (mode == 3) {
#pragma unroll
                            for (int j = 0; j < 4; ++j) { v0[j] = __logf(1.0f - om0[j] * fast_sigmoid(-v0[j])); v1[j] = __logf(1.0f - om1[j] * fast_sigmoid(-v1[j])); } }
                        *(u32x4*)(hg + (size_t)row * 4096 + (pn - 14) * BM + bj * HALF + cin) = pack8(v0, v1); } } }
    }
};
struct EpiLora {
    static constexpr bool PERM = true, AFTER_DRAIN = false;
    bf16_t* lout; const PG8_LAS float* bias; int pn0;
    __device__ __forceinline__ void operator()(const f32x4 (&acc)[2][2][4][2], const Unit& u, int wr, int wc, int fr, int fq) const {
        const int row0 = u.pm * BM + wr * 64 + fr, cin = wc * 32 + 8 * fq;
        const int pn = u.pn + pn0, mode = pn >> 2;
#pragma unroll
        for (int bj = 0; bj < 2; ++bj) {
            f32x4 b0 = (f32x4){0.f, 0.f, 0.f, 0.f}, b1 = b0;
            if (mode < 2) { const PG8_LAS float* bp = bias + pn * BM + bj * HALF + cin; b0 = *(const PG8_LAS f32x4*)bp; b1 = *(const PG8_LAS f32x4*)(bp + 4); }
#pragma unroll
            for (int ai = 0; ai < 2; ++ai)
#pragma unroll
                for (int m = 0; m < 4; ++m) { const int row = row0 + ai * HALF + m * 16;
                    f32x4 v0 = acc[ai][bj][m][0] + b0, v1 = acc[ai][bj][m][1] + b1;
#pragma unroll
                    for (int j = 0; j < 4; ++j) { const float s0 = fast_sigmoid(v0[j]), s1 = fast_sigmoid(v1[j]);
                        const float d0 = -0.60653066f * s0, d1 = -0.60653066f * s1;
                        v0[j] = mode == 0 ? d0 : (mode == 1 ? s0 : v0[j]); v1[j] = mode == 0 ? d1 : (mode == 1 ? s1 : v1[j]); }
                    *(u32x4*)(lout + (size_t)row * 3072 + pn * BM + bj * HALF + cin) = pack8(v0, v1); asm volatile("" ::: "memory"); } }
    }
};
template <class Epi, class Sched, bool ALIGN_EPI = false, bool SP2 = false>
__device__ __forceinline__ void gemm_phase(PG8_LAS unsigned char* lds, const Gemm g, const Sched& S, const Epi& E) {
    const int tid = threadIdx.x, wid = __builtin_amdgcn_readfirstlane(tid >> 6), lane = tid & 63, wr = wid >> 2, wc = wid & 3, fr = lane & 15, fq = lane >> 4;
    const int K = g.K, nt = K / BK, lda = g.lda ? g.lda : g.K;
    unsigned voffA[2], voffB[2];
#pragma unroll
    for (int i = 0; i < 2; ++i) { int R, C; stage_rc(tid * 16 + i * 8192, R, C); const int Rb = Epi::PERM ? ((R & ~31) + perm32(R & 31)) : R;
        voffA[i] = (unsigned)(R * lda + C) * 2u; voffB[i] = (unsigned)(Rb * K + C) * 2u; }
    const size_t kstep = (size_t)(BK * 2);
    const size_t hstep = (size_t)HALF * K * 2, hstepA = (size_t)HALF * lda * 2;
    const size_t tstep = 2 * hstep, tstepA = 2 * hstepA;
    const unsigned ldsw = (unsigned)wid * 1024u;
    const int aoff = lds_byte(wr * 64 + fr, fq * 8), boff = lds_byte(wc * 32 + fr, fq * 8);
#define PG8_SA(b, h) (((b) * 2 + (h)) * HTB)
#define PG8_SB(b, h) ((4 + (b) * 2 + (h)) * HTB)
#define PG8_STAGE(bufoff, gbase, voff) do { _Pragma("unroll") for (int _i = 0; _i < 2; ++_i) \
        __builtin_amdgcn_global_load_lds((const unsigned*)((const char*)(gbase) + (voff)[_i]), (PG8_LAS unsigned*)(lds + (bufoff) + ldsw + _i * 8192), 16, 0, 0); } while (0)
#define PG8_LDA(dst, b, h) do { _Pragma("unroll") for (int m = 0; m < 4; ++m) _Pragma("unroll") for (int k = 0; k < 2; ++k) dst[m][k] = *(const PG8_LAS bf16x8*)(lds + PG8_SA(b, h) + aoff + m * 2048 + k * 1024); } while (0)
#define PG8_LDB(dst, b, h) do { _Pragma("unroll") for (int n = 0; n < 2; ++n) _Pragma("unroll") for (int k = 0; k < 2; ++k) dst[n][k] = *(const PG8_LAS bf16x8*)(lds + PG8_SB(b, h) + boff + n * 2048 + k * 1024); } while (0)
#define PG8_MMA(ai, bj, At, Bt) do { __builtin_amdgcn_s_setprio(1); _Pragma("unroll") for (int k = 0; k < 2; ++k) _Pragma("unroll") for (int m = 0; m < 4; ++m) _Pragma("unroll") for (int n_ = 0; n_ < 2; ++n_) { const int n = (m & 1) ? 1 - n_ : n_; \
        acc[ai][bj][m][n] = __builtin_amdgcn_mfma_f32_16x16x32_bf16(Bt[n][k], At[m][k], acc[ai][bj][m][n], 0, 0, 0); PG8_SCHED; } __builtin_amdgcn_s_setprio(0); } while (0)
#define PG8_MMA2(ai, At, B0, B1) do { __builtin_amdgcn_s_setprio(1); _Pragma("unroll") for (int k = 0; k < 2; ++k) _Pragma("unroll") for (int s_ = 0; s_ < 16; ++s_) { \
        constexpr int HM[16] = {0, 0, 1, 1, 1, 1, 0, 0, 2, 2, 3, 3, 3, 3, 2, 2}, HQ[16] = {0, 1, 1, 0, 2, 3, 3, 2, 2, 3, 3, 2, 1, 0, 0, 1}; \
        const int m = HM[s_], q = HQ[s_], bj = q >> 1, n = q & 1; \
        acc[ai][bj][m][n] = __builtin_amdgcn_mfma_f32_16x16x32_bf16(bj ? B1[n][k] : B0[n][k], At[m][k], acc[ai][bj][m][n], 0, 0, 0); PG8_SCHED; } __builtin_amdgcn_s_setprio(0); } while (0)
#define PG8_WAIT_V(n) asm volatile("s_waitcnt vmcnt(" #n ")" ::: "memory")
#define PG8_WAIT_L(n) asm volatile("s_waitcnt lgkmcnt(" #n ")" ::: "memory")
#define PG8_BAR __builtin_amdgcn_s_barrier()
#define PG8_SCHED __builtin_amdgcn_sched_barrier(0)
    Unit cur, nxt; int ui = 0;
    if (!S.next(0, cur)) return;
    f32x4 acc[2][2][4][2];
#pragma unroll
    for (int a = 0; a < 2; ++a)
#pragma unroll
        for (int b = 0; b < 2; ++b)
#pragma unroll
            for (int m = 0; m < 4; ++m)
#pragma unroll
                for (int n = 0; n < 2; ++n) acc[a][b][m][n] = (f32x4){0.f, 0.f, 0.f, 0.f};
    bf16x8 At[4][2], B0[2][2], B1[2][2];
    const long kspan = (long)(nt - 1) * (long)kstep; long ks_c = (long)kstep, ks_n = (long)kstep;
    const char* cA = (const char*)g.A + (size_t)cur.pm * tstepA; const char* cB = (const char*)g.Bt + (size_t)cur.pn * tstep;
    S.a_ready(cur);
    if constexpr (SP2) {
        PG8_STAGE(PG8_SB(0, 0), cB, voffB); PG8_STAGE(PG8_SB(0, 1), cB + hstep, voffB); PG8_STAGE(PG8_SA(0, 0), cA, voffA); PG8_STAGE(PG8_SA(0, 1), cA + hstepA, voffA);
        if (wr == 1) PG8_BAR;
        PG8_WAIT_V(2); PG8_BAR;
        PG8_STAGE(PG8_SB(1, 0), cB + ks_c, voffB); PG8_STAGE(PG8_SA(1, 0), cA + ks_c, voffA); PG8_STAGE(PG8_SB(1, 1), cB + hstep + ks_c, voffB);
        PG8_WAIT_V(6); PG8_BAR;
    } else {
        PG8_STAGE(PG8_SB(0, 0), cB, voffB); PG8_STAGE(PG8_SA(0, 0), cA, voffA); PG8_STAGE(PG8_SB(0, 1), cB + hstep, voffB); PG8_STAGE(PG8_SA(0, 1), cA + hstepA, voffA);
        if (wr == 1) PG8_BAR;
        PG8_WAIT_V(4); PG8_BAR;
        PG8_STAGE(PG8_SB(1, 0), cB + ks_c, voffB); PG8_STAGE(PG8_SA(1, 0), cA + ks_c, voffA); PG8_STAGE(PG8_SB(1, 1), cB + hstep + ks_c, voffB);
        PG8_WAIT_V(6); PG8_BAR;
    }
    for (;;) {
        const bool has_next = S.next(ui + 1, nxt);
        const bool rev_n = has_next && (((ui + 1) & 1) != 0); ks_n = has_next ? (rev_n ? -(long)kstep : (long)kstep) : ks_c;
        const char* nA = has_next ? (const char*)g.A + (size_t)nxt.pm * tstepA + (rev_n ? kspan : 0) : cA; const char* nB = has_next ? (const char*)g.Bt + (size_t)nxt.pn * tstep + (rev_n ? kspan : 0) : cB;
        for (int t = 0; t < nt; t += 2) {
            const bool last = (t == nt - 2);
            const char* a1 = cA + (long)(t + 1) * ks_c;
            const char* a2 = last ? nA : cA + (long)(t + 2) * ks_c; const char* b2 = last ? nB : cB + (long)(t + 2) * ks_c;
            const long ks23 = last ? ks_n : ks_c; const char* a3 = a2 + ks23; const char* b3 = b2 + ks23;
            if (last && has_next) S.a_ready(nxt);
            if constexpr (SP2) {
            PG8_LDB(B0, 0, 0); PG8_LDB(B1, 0, 1); PG8_SCHED; PG8_LDA(At, 0, 0); PG8_STAGE(PG8_SA(1, 1), a1 + hstepA, voffA);
            PG8_WAIT_V(8); PG8_WAIT_L(0); PG8_BAR; PG8_MMA2(0, At, B0, B1); PG8_BAR; PG8_SCHED;
            PG8_LDA(At, 0, 1); PG8_STAGE(PG8_SB(0, 0), b2, voffB); PG8_STAGE(PG8_SB(0, 1), b2 + hstep, voffB); PG8_STAGE(PG8_SA(0, 0), a2, voffA);
            PG8_WAIT_V(8); PG8_WAIT_L(0); PG8_BAR; PG8_MMA2(1, At, B0, B1); PG8_BAR; PG8_SCHED;
            PG8_LDB(B0, 1, 0); PG8_LDB(B1, 1, 1); PG8_SCHED; PG8_LDA(At, 1, 0); PG8_STAGE(PG8_SA(0, 1), a2 + hstepA, voffA);
            PG8_WAIT_V(8); PG8_WAIT_L(0); PG8_BAR; PG8_MMA2(0, At, B0, B1); PG8_BAR; PG8_SCHED;
            PG8_LDA(At, 1, 1); PG8_STAGE(PG8_SB(1, 0), b3, voffB); PG8_STAGE(PG8_SB(1, 1), b3 + hstep, voffB); PG8_STAGE(PG8_SA(1, 0), a3, voffA);
            PG8_WAIT_V(8); PG8_WAIT_L(0); PG8_BAR; PG8_MMA2(1, At, B0, B1); PG8_BAR; PG8_SCHED;
            } else {
            PG8_LDB(B0, 0, 0); PG8_SCHED; PG8_LDA(At, 0, 0); PG8_STAGE(PG8_SA(1, 1), a1 + hstepA, voffA);
            PG8_WAIT_L(8); PG8_BAR; PG8_WAIT_L(0); PG8_MMA(0, 0, At, B0); PG8_BAR; PG8_SCHED;
            PG8_LDB(B1, 0, 1); PG8_STAGE(PG8_SB(0, 0), b2, voffB);
            PG8_BAR; PG8_WAIT_L(0); PG8_MMA(0, 1, At, B1); PG8_BAR;
            PG8_LDA(At, 0, 1); PG8_STAGE(PG8_SA(0, 0), a2, voffA);
            PG8_BAR; PG8_WAIT_L(0); PG8_MMA(1, 0, At, B0); PG8_BAR; PG8_SCHED;
            PG8_STAGE(PG8_SB(0, 1), b2 + hstep, voffB);
            PG8_WAIT_V(6); PG8_BAR; PG8_MMA(1, 1, At, B1); PG8_BAR;
            PG8_LDB(B0, 1, 0); PG8_SCHED; PG8_LDA(At, 1, 0); PG8_STAGE(PG8_SA(0, 1), a2 + hstepA, voffA);
            PG8_WAIT_L(8); PG8_BAR; PG8_WAIT_L(0); PG8_MMA(0, 0, At, B0); PG8_BAR; PG8_SCHED;
            PG8_LDB(B1, 1, 1); PG8_STAGE(PG8_SB(1, 0), b3, voffB);
            PG8_BAR; PG8_WAIT_L(0); PG8_MMA(0, 1, At, B1); PG8_BAR;
            PG8_LDA(At, 1, 1); PG8_STAGE(PG8_SA(1, 0), a3, voffA);
            PG8_BAR; PG8_WAIT_L(0); PG8_MMA(1, 0, At, B0); PG8_BAR; PG8_SCHED;
            PG8_STAGE(PG8_SB(1, 1), b3 + hstep, voffB);
            PG8_WAIT_V(6); PG8_BAR; PG8_MMA(1, 1, At, B1); PG8_BAR;
            }
        }
        if constexpr (ALIGN_EPI) { if (wr == 0) PG8_BAR; }
        if constexpr (!Epi::AFTER_DRAIN) { E(acc, cur, wr, wc, fr, fq); S.done(cur); }
        if (!has_next) break;
#pragma unroll
        for (int a = 0; a < 2; ++a)
#pragma unroll
            for (int b = 0; b < 2; ++b)
#pragma unroll
                for (int m = 0; m < 4; ++m)
#pragma unroll
                    for (int n = 0; n < 2; ++n) acc[a][b][m][n] = (f32x4){0.f, 0.f, 0.f, 0.f};
        cur = nxt; cA = nA; cB = nB; ks_c = ks_n; ++ui;
        if constexpr (ALIGN_EPI) { if (wr == 1) PG8_BAR; }
    }
    PG8_WAIT_V(0);
    if constexpr (!ALIGN_EPI) { if (wr == 0) PG8_BAR; }
    PG8_BAR;
    if constexpr (Epi::AFTER_DRAIN) { E.fused(acc, cur, wr, wc, fr, fq, lds, wid, lane); S.done(cur); }
#undef PG8_SA
#undef PG8_SB
#undef PG8_STAGE
#undef PG8_LDA
#undef PG8_LDB
#undef PG8_MMA
#undef PG8_WAIT_V
#undef PG8_WAIT_L
#undef PG8_BAR
#undef PG8_SCHED
}
}

constexpr int NWAVES = 8;
constexpr int BATCH = 4, SEQ = 8192, D = 2048, M = BATCH * SEQ, FF = 5632;
constexpr int RC = 1024, RH = 16, RN = 64;
constexpr int HC = 1024, HH = 8, HD = 128;
constexpr int RWKV_COLS = 3360, IN_COLS = 7456, NIN = 7680;
constexpr int KL = 384, NL = 3072;
#ifndef MK_N_LAUNCHES
#define MK_N_LAUNCHES 1
#endif
constexpr int N_PHASES = 12;

constexpr size_t WS_CTL = 0, CTL_BYTES = 1u << 20;
constexpr size_t WS_W1GU = CTL_BYTES;
constexpr size_t WS_W1D = WS_W1GU + (size_t)2 * FF * D * 2;
constexpr size_t WS_WIN = WS_W1D + (size_t)D * FF * 2;
constexpr size_t WS_WLORA = WS_WIN + (size_t)NIN * D * 2;
constexpr size_t WS_WOUT = WS_WLORA + (size_t)NL * KL * 2;
constexpr size_t WS_W2GU = WS_WOUT + (size_t)D * D * 2;
constexpr size_t WS_W2D = WS_W2GU + (size_t)2 * FF * D * 2;
constexpr size_t WS_SS = WS_W2D + (size_t)D * FF * 2;
constexpr size_t WS_XB = WS_SS + (1u << 20);
constexpr size_t WS_R = WS_XB + (size_t)M * D * 2;
constexpr size_t R_ACT = 0;
constexpr size_t R_RKV = 0;
constexpr size_t R_HG = R_RKV + (size_t)M * 3072 * 2;
constexpr size_t R_LIN = R_HG + (size_t)M * 4096 * 2;
constexpr size_t R_BYTES = R_LIN + (size_t)M * 288 * 4;
constexpr size_t WS_ALORA = WS_R + R_BYTES;
constexpr size_t WS_LOUT = WS_ALORA + (size_t)M * KL * 2;
constexpr size_t WS_INVN = WS_LOUT + (size_t)M * NL * 2;
constexpr size_t WS_END = WS_INVN + (size_t)M * RH * 4;
static_assert(WS_END <= ((size_t)1 << 30), "d_ws map");
constexpr int CW_PCNT = 8704;
constexpr int CW_SIG_HALF = 8192, CW_SIG_SHA = 8256, CW_SIG_SHB = 8320, CW_SIG_P4 = 8384, CW_SIG_H2 = 8448;
constexpr int CW_BAR = 4096;

constexpr int RING_BYTES = 162816;
constexpr int LDSCTL_OFF = RING_BYTES, MISC_OFF = LDSCTL_OFF + 320;
constexpr int LDS_BYTES = 163840;
static_assert(MISC_OFF + 128 <= LDS_BYTES, "LDS map");

#define GAS __attribute__((address_space(1)))
#define LAS __attribute__((address_space(3)))
typedef unsigned short bf16;
typedef unsigned v4u __attribute__((ext_vector_type(4)));
typedef unsigned v2u __attribute__((ext_vector_type(2)));
typedef float f32x4 __attribute__((ext_vector_type(4)));
#define LDS_WAIT() asm volatile("s_waitcnt lgkmcnt(0)" ::: "memory")
#define VM_WAIT() asm volatile("s_waitcnt vmcnt(0)" ::: "memory")
__device__ __forceinline__ float bflo(unsigned u) { return __builtin_bit_cast(float, u << 16); }
__device__ __forceinline__ float bfhi(unsigned u) { return __builtin_bit_cast(float, u & 0xffff0000u); }
__device__ __forceinline__ f32x4 unpack4(v2u w) { return (f32x4){bflo(w.x), bfhi(w.x), bflo(w.y), bfhi(w.y)}; }
__device__ __forceinline__ unsigned pk2(float lo, float hi) { return pg8::cvt_pk_bf16(lo, hi); }
__device__ __forceinline__ v2u pack4(f32x4 v) { v2u w; w.x = pk2(v[0], v[1]); w.y = pk2(v[2], v[3]); return w; }
using pg8::fast_sigmoid;
using pg8::fast_silu;
template <int CTRL> __device__ __forceinline__ float dpp_mov(float x) { return __builtin_bit_cast(float, __builtin_amdgcn_update_dpp(0, __builtin_bit_cast(int, x), CTRL, 0xF, 0xF, true)); }
__device__ __forceinline__ float row16_sum(float x) { x += dpp_mov<0x128>(x); x += dpp_mov<0x124>(x); x += dpp_mov<0x122>(x); x += dpp_mov<0x121>(x); return x; }
template <int CTRL, int BANK> __device__ __forceinline__ float dpp_upd(float old, float x) { return __builtin_bit_cast(float, __builtin_amdgcn_update_dpp(__builtin_bit_cast(int, old), __builtin_bit_cast(int, x), CTRL, 0xF, BANK, false)); }
__device__ __forceinline__ float tr_reduce16(const float (&v)[16], int lane) {
    float u[8], w[4], x[2];
#pragma unroll
    for (int s = 0; s < 8; ++s) { const float t = v[s + 8] + dpp_mov<0x128>(v[s + 8]), a = v[s] + dpp_mov<0x128>(v[s]); u[s] = dpp_upd<0xE4, 0x3>(t, a); }
#pragma unroll
    for (int s = 0; s < 4; ++s) { const float t = u[s + 4] + dpp_mov<0x141>(u[s + 4]), a = u[s] + dpp_mov<0x141>(u[s]); w[s] = dpp_upd<0xE4, 0x5>(t, a); }
    const bool b1 = (lane & 2) != 0, b0 = (lane & 1) != 0;
#pragma unroll
    for (int s = 0; s < 2; ++s) { const float K = b1 ? w[s + 2] : w[s], T = b1 ? w[s] : w[s + 2]; x[s] = K + dpp_mov<0x1B>(T); }
    const float K = b0 ? x[1] : x[0], T = b0 ? x[0] : x[1];
    return K + dpp_mov<0xB1>(T);
}
typedef float f32x2 __attribute__((ext_vector_type(2)));
#define LO2(v) __builtin_shufflevector(v, v, 0, 1)
#define HI2(v) __builtin_shufflevector(v, v, 2, 3)
__device__ __forceinline__ float wave_sum(float v) {
#pragma unroll
    for (int o = 1; o < 64; o <<= 1) v += __shfl_xor(v, o);
    return v;
}
#define XB_TMO      128
#define XB_XCNT(j)  (256  + 64 * (j))
#define XB_XSUB(j)  (1280 + 64 * (j))
#define XB_XGEN(j)  (2304 + 64 * (j))
#define XB_TOP      3328
#define XB_TOPGEN   3392
#define XCD_BAR_WORDS 3456
#define XB_SPIN_CAP (1u << 18)

__device__ __forceinline__ unsigned xb_ld(unsigned* p)              { return __hip_atomic_load(p, __ATOMIC_RELAXED, __HIP_MEMORY_SCOPE_AGENT); }
__device__ __forceinline__ unsigned xb_add(unsigned* p, unsigned v) { return __hip_atomic_fetch_add(p, v, __ATOMIC_RELAXED, __HIP_MEMORY_SCOPE_AGENT); }
__device__ __forceinline__ unsigned xb_xcc_id() { return (unsigned)__builtin_amdgcn_s_getreg((3 << 11) | 20) & 0xFu; }
#define XB_SPIN(cond, bar) do { unsigned _sp = 0; while (cond) { __builtin_amdgcn_s_sleep(1); \
    if ((++_sp & 255u) == 0u) { if (xb_ld(&(bar)[XB_TMO])) break; if (_sp > XB_SPIN_CAP) { atomicAdd(&(bar)[XB_TMO], 1u); break; } } } } while (0)

struct XcdBarrier {
    unsigned* bar; unsigned x;
    volatile LAS unsigned* st;
};

__device__ __forceinline__ XcdBarrier xcd_barrier_post(unsigned* bar, volatile LAS unsigned* st) {
    XcdBarrier b; b.bar = bar; b.x = xb_xcc_id(); b.st = st;
    if (threadIdx.x == 0) (void)xb_add(&bar[XB_XCNT(b.x)], 1u);
    return b;
}
__device__ __forceinline__ void xcd_barrier_complete(unsigned* bar, unsigned x, unsigned& nloc, unsigned& nx) {
    const unsigned G = gridDim.x * gridDim.y * gridDim.z;
    unsigned sum, cnt, mine, sp = 0u;
    for (;;) {
        sum = 0u; cnt = 0u; mine = 0u;
#pragma unroll
        for (unsigned j = 0; j < 16; ++j) { const unsigned c = xb_ld(&bar[XB_XCNT(j)]); sum += c; cnt += (c > 0u) ? 1u : 0u; mine = (j == x) ? c : mine; }
        if (sum == G) break;
        __builtin_amdgcn_s_sleep(1);
        if ((++sp & 255u) == 0u) { if (xb_ld(&bar[XB_TMO])) break; if (sp > XB_SPIN_CAP) { atomicAdd(&bar[XB_TMO], 1u); break; } }
    }
    nloc = mine > 0u ? mine : 1u; nx = cnt > 0u ? cnt : 1u;
}

__device__ __forceinline__ void xcd_barrier(const XcdBarrier& b) {
    asm volatile("s_waitcnt vmcnt(0)" ::: "memory");
    __syncthreads();
    if (threadIdx.x == 0) {
        unsigned* bar = b.bar;
        __builtin_amdgcn_s_waitcnt(0);
        unsigned nloc = b.st[0], nx = b.st[1];
        if (nloc == 0u) { xcd_barrier_complete(bar, b.x, nloc, nx); b.st[0] = nloc; b.st[1] = nx; }
        const unsigned old = xb_add(&bar[XB_XSUB(b.x)], 1u);
        const unsigned gen = old / nloc;
        if (old + 1u == (gen + 1u) * nloc) {
            __builtin_amdgcn_fence(__ATOMIC_RELEASE, "agent");
            asm volatile("s_waitcnt vmcnt(0)" ::: "memory");
            const unsigned og = xb_add(&bar[XB_TOP], 1u);
            const unsigned tg = og / nx;
            if (og + 1u == (tg + 1u) * nx) xb_add(&bar[XB_TOPGEN], 1u);
            else XB_SPIN(xb_ld(&bar[XB_TOPGEN]) == tg, bar);
            __builtin_amdgcn_fence(__ATOMIC_ACQUIRE, "agent");
            xb_add(&bar[XB_XGEN(b.x)], 1u);
            asm volatile("s_waitcnt vmcnt(0)" ::: "memory");
        } else {
            XB_SPIN(xb_ld(&bar[XB_XGEN(b.x)]) == gen, bar);
            __builtin_amdgcn_fence(__ATOMIC_ACQUIRE, "agent");
            asm volatile("s_waitcnt vmcnt(0)" ::: "memory");
        }
    }
    __syncthreads();
}

__device__ __forceinline__ void sig_post(unsigned* ctr) {
    __builtin_amdgcn_fence(__ATOMIC_RELEASE, "agent"); asm volatile("s_waitcnt vmcnt(0)" ::: "memory"); (void)xb_add(ctr, 1u);
}
__device__ __forceinline__ void wg_signal(unsigned* ctr) {
    asm volatile("s_waitcnt vmcnt(0)" ::: "memory"); __syncthreads();
    if (threadIdx.x == 0) sig_post(ctr);
}
__device__ __forceinline__ void wg_wait(unsigned* ctr, unsigned target, unsigned* bar) {
    if (threadIdx.x == 0) { XB_SPIN(xb_ld(ctr) < target, bar); __builtin_amdgcn_fence(__ATOMIC_ACQUIRE, "agent"); asm volatile("s_waitcnt vmcnt(0)" ::: "memory"); }
    __syncthreads();
}

struct Frame {
    LAS unsigned char* lds;
    int tid, lane, wave, vcu, G;
    const float* in[26];
    float* out; unsigned char* ws;
};
#define WSP(T, off) ((T*)(F.ws + (off)))
struct Args { const float* in[26]; float* out; unsigned char* ws; int ph_lo, ph_hi; };

struct P0Item { const float* W; bf16* WT; int K, N, kb, n0, drow0; };
__device__ __forceinline__ int map_gu(int n0, int which) { return (n0 >> 7) * 256 + which * 128 + (n0 & 127); }
constexpr int P0_I_GU = (D / 64) * (FF / 32), P0_I_DN = (FF / 64) * (D / 32), P0_I_IN = (D / 64) * (IN_COLS / 32), P0_I_OUT = (D / 64) * (D / 32);
constexpr int P0_N0 = 2 * P0_I_GU + P0_I_DN + P0_I_IN, P0_N1 = 2 * P0_I_GU + P0_I_DN + P0_I_OUT;
template <int SET> __device__ __forceinline__ P0Item p0_decode(Frame& F, const Args& A, int it) {
    constexpr int I_GU = P0_I_GU, I_DN = P0_I_DN, I_IN = P0_I_IN;
    P0Item p; int r = it;
    if (SET == 0) { if (r >= 2 * I_GU) r += 2 * I_GU; if (r >= 4 * I_GU + I_DN) r += I_DN; }
    else { r += 2 * I_GU; if (r >= 4 * I_GU) r += I_DN; if (r >= 4 * I_GU + 2 * I_DN) r += I_IN; }
    if (r < 4 * I_GU) { const int mat = r / I_GU; r -= mat * I_GU; const int nblk = FF / 32, ffn = mat >> 1, which = mat & 1;
        p.W = A.in[2 + 20 * ffn + which]; p.WT = WSP(bf16, ffn ? WS_W2GU : WS_W1GU); p.K = D; p.N = FF; p.kb = r / nblk; p.n0 = 32 * (r % nblk); p.drow0 = map_gu(p.n0, which); return p; }
    r -= 4 * I_GU;
    if (r < 2 * I_DN) { const int ffn = r / I_DN; r -= ffn * I_DN; const int nblk = D / 32;
        p.W = A.in[4 + 20 * ffn]; p.WT = WSP(bf16, ffn ? WS_W2D : WS_W1D); p.K = FF; p.N = D; p.kb = r / nblk; p.n0 = 32 * (r % nblk); p.drow0 = p.n0; return p; }
    r -= 2 * I_DN;
    if (r < I_IN) { const int nblk = IN_COLS / 32;
        p.W = A.in[6]; p.WT = WSP(bf16, WS_WIN); p.K = D; p.N = IN_COLS; p.kb = r / nblk; p.n0 = 32 * (r % nblk); p.drow0 = p.n0 < RWKV_COLS ? p.n0 : p.n0 + 224; return p; }
    r -= I_IN;
    { const int nblk = D / 32; p.W = A.in[20]; p.WT = WSP(bf16, WS_WOUT); p.K = D; p.N = D; p.kb = r / nblk; p.n0 = 32 * (r % nblk); p.drow0 = p.n0; return p; }
}
__device__ __forceinline__ void p0_dma(const P0Item& p, LAS unsigned char* tile, int lane) {
    const int half = lane >> 5, sl = lane & 31;
#pragma unroll 8
    for (int i = 0; i < 32; ++i) { const int kk = 2 * i + half;
        __builtin_amdgcn_global_load_lds((const GAS unsigned*)(p.W + (size_t)(64 * p.kb + kk) * p.N + p.n0 + (sl ^ (4 * (kk >> 3)))), (LAS unsigned*)(tile + i * 256), 4, 0, 0); }
}
__device__ __forceinline__ void p0_emit(const P0Item& p, const LAS float* t, int lane) {
    const int c = lane & 7;
#pragma unroll
    for (int j = 0; j < 4; ++j) { const int n = (lane >> 3) + 8 * j; const LAS float* s = t + (8 * c) * 32 + (n ^ (4 * c));
        v4u o; o.x = pk2(s[0 * 32], s[1 * 32]); o.y = pk2(s[2 * 32], s[3 * 32]); o.z = pk2(s[4 * 32], s[5 * 32]); o.w = pk2(s[6 * 32], s[7 * 32]);
        *(GAS v4u*)(p.WT + (size_t)(p.drow0 + n) * p.K + 64 * p.kb + 8 * c) = o; }
}
template <int SET> __device__ __forceinline__ void p0_transposes(Frame& F, const Args& A, int gw, int NGW) {
    LAS unsigned char* tiles = F.lds + F.wave * 16384;
    constexpr int NITEMS = SET == 0 ? P0_N0 : P0_N1;
    if (gw < NITEMS) {
        P0Item cur = p0_decode<SET>(F, A, gw); int buf = 0;
        p0_dma(cur, tiles, F.lane);
        for (int it = gw; it < NITEMS; it += NGW) {
            const bool more = it + NGW < NITEMS; P0Item nxt = cur;
            if (more) { nxt = p0_decode<SET>(F, A, it + NGW); p0_dma(nxt, tiles + (buf ^ 1) * 8192, F.lane); asm volatile("s_waitcnt vmcnt(32)" ::: "memory"); }
            else asm volatile("s_waitcnt vmcnt(0)" ::: "memory");
            p0_emit(cur, (const LAS float*)(tiles + buf * 8192), F.lane);
            LDS_WAIT(); asm volatile("" ::: "memory");
            cur = nxt; buf ^= 1;
        }
        asm volatile("s_waitcnt vmcnt(0)" ::: "memory");
    }
}
__device__ __forceinline__ void p0_prologue(Frame& F, const Args& A) {
    const int gw = F.vcu * NWAVES + F.wave, NGW = F.G * NWAVES;
    p0_transposes<0>(F, A, gw, NGW);
    const size_t gt = (size_t)F.vcu * (NWAVES * 64) + F.tid, NT = (size_t)F.G * NWAVES * 64;
    { GAS v4u* z = (GAS v4u*)(WSP(bf16, WS_WIN) + (size_t)RWKV_COLS * D);
      for (size_t i = gt; i < (size_t)224 * D * 2 / 16; i += NT) z[i] = (v4u){0u, 0u, 0u, 0u}; }
    { bf16* wl = WSP(bf16, WS_WLORA); const float* w2 = F.in[9]; const float* a2 = F.in[11]; const float* g2 = F.in[12];
      for (size_t i = gt; i < (size_t)NL * KL / 2; i += NT) { const int n = (int)(i / (KL / 2)), k = 2 * (int)(i % (KL / 2)); const int seg = n >> 10, c = n & 1023;
          float v0 = 0.f, v1 = 0.f;
          if (seg == 0) { if (k < 64) { v0 = w2[(size_t)k * RC + c]; v1 = w2[(size_t)(k + 1) * RC + c]; } }
          else if (seg == 1) { if (k >= 64 && k < 128) { v0 = a2[(size_t)(k - 64) * RC + c]; v1 = a2[(size_t)(k - 63) * RC + c]; } }
          else { if (k >= 128 && k < 288) { v0 = g2[(size_t)(k - 128) * RC + c]; v1 = g2[(size_t)(k - 127) * RC + c]; } }
          ((GAS unsigned*)wl)[i] = pk2(v0, v1); } }
    { GAS unsigned long long* s = (GAS unsigned long long*)(F.ws + WS_SS) + M;
      for (size_t i = gt; i < (size_t)3 * M; i += NT) s[i] = 0ull; }
    { const float* x = F.in[0]; bf16* xb = WSP(bf16, WS_XB); unsigned long long* ss0 = WSP(unsigned long long, WS_SS);
      for (int m = gw; m < M; m += NGW) { const GAS f32x4* xr = (const GAS f32x4*)(x + (size_t)m * D) + 2 * F.lane; GAS v4u* o = (GAS v4u*)(xb + (size_t)m * D) + F.lane; float s = 0.f;
#pragma unroll
          for (int j = 0; j < 4; ++j) { const f32x4 a = xr[128 * j], b = xr[128 * j + 1];
              s += (a[0] * a[0] + a[1] * a[1]) + (a[2] * a[2] + a[3] * a[3]) + (b[0] * b[0] + b[1] * b[1]) + (b[2] * b[2] + b[3] * b[3]);
              const f32x4 ga = *(const f32x4*)(F.in[1] + 8 * F.lane + 512 * j), gb = *(const f32x4*)(F.in[1] + 8 * F.lane + 512 * j + 4);
              o[64 * j] = pg8::pack8(a * ga, b * gb); }
          s = wave_sum(s);
          if (F.lane == 0) ss0[m] = (unsigned long long)(s * pg8::SS_SCALE + 0.5f); } }
}

__device__ __forceinline__ void p4_lora_in(Frame& F, int hsel, int c, int G) {
    const int NR = hsel < 0 ? M : M / 2;
#define P4_ROW(i_) (hsel < 0 ? (i_) : ((i_) / (SEQ / 2)) * SEQ + ((i_) % (SEQ / 2)) + hsel * (SEQ / 2))
    const float* lin = WSP(float, WS_R + R_LIN); bf16* al = WSP(bf16, WS_ALORA); const float* mu = F.in[7] + 3 * RC;
    const size_t gt = (size_t)c * (NWAVES * 64) + F.tid, NT = (size_t)G * NWAVES * 64;
#pragma unroll 4
    for (size_t i = gt; i < (size_t)NR * 96; i += NT) { const int mi = (int)(i / 96), m = P4_ROW(mi), q = (int)(i % 96), qc = q < 72 ? q : 0; const bool first = (m & (SEQ - 1)) == 0;
        const f32x4 p = *(const GAS f32x4*)(lin + (size_t)m * 288 + 4 * qc), pr = *(const GAS f32x4*)(lin + (size_t)(first ? m : m - 1) * 288 + 4 * qc), mv = *(const GAS f32x4*)(mu + 4 * qc);
        const f32x4 pp = first ? (f32x4){0.f, 0.f, 0.f, 0.f} : pr; f32x4 s = p + (pp - p) * mv;
#pragma unroll
        for (int j = 0; j < 4; ++j) { const float sg = fast_sigmoid(q < 16 ? 2.0f * s[j] : s[j]); s[j] = q < 16 ? 2.0f * sg - 1.0f : (q >= 32 ? sg : s[j]); }
        v2u o = pack4(s); if (q >= 72) o = (v2u){0u, 0u};
        *(GAS v2u*)(al + (size_t)m * KL + 4 * q) = o; }
    { const bf16* rkv = WSP(bf16, WS_R + R_RKV); float* invn = WSP(float, WS_INVN); const int j4 = (F.tid & 15) * 4;
      const size_t it0 = gt >> 4, step = NT >> 4; const int h = (int)(it0 & 15), ch = h * RN + j4;
      const f32x4 muk = *(const f32x4*)(F.in[7] + RC + ch), kkc = *(const f32x4*)(F.in[13] + ch);
      if ((step & 15) == 0) {
#pragma unroll 4
          for (size_t it = it0; it < (size_t)NR * RH; it += step) { const int mi = (int)(it >> 4), m = P4_ROW(mi); const bool first = (m & (SEQ - 1)) == 0;
              const f32x4 k = unpack4(*(const GAS v2u*)(rkv + (size_t)m * 3072 + RC + ch)), kr = unpack4(*(const GAS v2u*)(rkv + (size_t)(first ? m : m - 1) * 3072 + RC + ch));
              const f32x4 kp = first ? (f32x4){0.f, 0.f, 0.f, 0.f} : kr;
              const f32x4 kk = (k + (kp - k) * muk) * kkc; float s2 = (kk[0] * kk[0] + kk[1] * kk[1]) + (kk[2] * kk[2] + kk[3] * kk[3]); s2 = row16_sum(s2);
              if ((F.tid & 15) == 0) invn[(size_t)m * RH + h] = 1.0f / fmaxf(sqrtf(s2), 1e-12f); }
      } else {
          for (size_t it = it0; it < (size_t)NR * RH; it += step) { const int mi = (int)(it >> 4), m = P4_ROW(mi), h2 = (int)(it & 15), c2 = h2 * RN + j4; const bool first = (m & (SEQ - 1)) == 0;
              const f32x4 k = unpack4(*(const GAS v2u*)(rkv + (size_t)m * 3072 + RC + c2)), kr = unpack4(*(const GAS v2u*)(rkv + (size_t)(first ? m : m - 1) * 3072 + RC + c2));
              const f32x4 kp = first ? (f32x4){0.f, 0.f, 0.f, 0.f} : kr; const f32x4 mk2 = *(const f32x4*)(F.in[7] + RC + c2), kc2 = *(const f32x4*)(F.in[13] + c2);
              const f32x4 kk = (k + (kp - k) * mk2) * kc2; float s2 = (kk[0] * kk[0] + kk[1] * kk[1]) + (kk[2] * kk[2] + kk[3] * kk[3]); s2 = row16_sum(s2);
              if ((F.tid & 15) == 0) invn[(size_t)m * RH + h2] = 1.0f / fmaxf(sqrtf(s2), 1e-12f); } } }
#undef P4_ROW
}

typedef short bf16x4 __attribute__((ext_vector_type(4)));
typedef short bf16x8 __attribute__((ext_vector_type(8)));
#define MFMA32(a, b, c) __builtin_amdgcn_mfma_f32_16x16x32_bf16(a, b, c, 0, 0, 0)
#define MFMA16(a, b, c) __builtin_amdgcn_mfma_f32_16x16x16bf16_1k(a, b, c, 0, 0, 0)
__device__ __forceinline__ bf16x4 cv4(f32x4 v) { v2u w; w.x = pk2(v[0], v[1]); w.y = pk2(v[2], v[3]); return __builtin_bit_cast(bf16x4, w); }
__device__ __forceinline__ bf16x8 cv8(f32x4 a, f32x4 b) { v4u w; w.x = pk2(a[0], a[1]); w.y = pk2(a[2], a[3]); w.z = pk2(b[0], b[1]); w.w = pk2(b[2], b[3]); return __builtin_bit_cast(bf16x8, w); }
__device__ __forceinline__ bf16x8 cat8(bf16x4 a, bf16x4 b) { return __builtin_shufflevector(a, b, 0, 1, 2, 3, 4, 5, 6, 7); }
__device__ __forceinline__ bf16x8 join8(v2u a, v2u b) { v4u w; w.x = a.x; w.y = a.y; w.z = b.x; w.w = b.y; return __builtin_bit_cast(bf16x8, w); }
__device__ __forceinline__ float row16_scan(float x) { x += dpp_mov<0x111>(x); x += dpp_mov<0x112>(x); x += dpp_mov<0x114>(x); x += dpp_mov<0x118>(x); return x; }
__device__ __forceinline__ unsigned short bf1(float x) { return (unsigned short)(pk2(x, 0.f) & 0xffffu); }
constexpr int CH = 16;
constexpr int RWS = 144;
constexpr int HGS = 272;
constexpr int RWB_KG = 0, RWB_RG = 16 * RWS, RWB_KTI = 32 * RWS, RWB_BTI = 48 * RWS, RWB_KTIT = 64 * RWS, RWB_BTIT = RWB_KTIT + 2048, RWB_VT = RWB_BTIT + 2048, RWB_GL = RWB_VT + 2048, RWB_BYTES = RWB_GL + 256;
constexpr int HGB_QG = 0, HGB_KI = 16 * HGS, HGB_KIT = 32 * HGS, HGB_VT = HGB_KIT + 4096, HGB_GL = HGB_VT + 4096, HGB_BYTES = HGB_GL + 512;

__device__ __forceinline__ f32x4 padc(f32x4 r) { asm("s_nop 15" : "+v"(r)); return r; }
constexpr int NCHK = SEQ / CH;
constexpr int NRAW = 8;
constexpr int RWR_R = 0, RWR_K = 2048, RWR_V = 4096, RWR_LW = 6144, RWR_A = 8192, RWR_INV = 10240, RWR_BYTES = 10304;
constexpr int RW_OPND = 0, RW_RAW = 3 * RWB_BYTES, RW_AOP = RW_RAW + NRAW * RWR_BYTES, RW_LDS = RW_AOP + 2 * 2048;
constexpr int HGR_Q = 0, HGR_LF = 4096, HGR_V = 8192, HGR_BYTES = 12288;
constexpr int HG_OPND = 0, HG_RAW = 3 * HGB_BYTES, HG_AOP = HG_RAW + NRAW * HGR_BYTES, HG_LDS = HG_AOP + 2 * 512;
static_assert(RW_LDS <= RING_BYTES && HG_LDS <= RING_BYTES && RW_AOP % 16 == 0 && HG_AOP % 16 == 0, "scan LDS map");
#define GLDS4(gptr, lptr) __builtin_amdgcn_global_load_lds((const GAS unsigned*)(gptr), (LAS unsigned*)(lptr), 4, 0, 0)
#define WG_BAR() do { LDS_WAIT(); __builtin_amdgcn_s_barrier(); asm volatile("" ::: "memory"); } while (0)

__device__ __forceinline__ void p6_rwkv_head(Frame& F, int bh, int nsh) {
    const bf16* rkv = WSP(bf16, WS_R + R_RKV); const bf16* lout = WSP(bf16, WS_LOUT); const float* invn = WSP(float, WS_INVN); bf16* ydst = WSP(bf16, WS_LOUT);
    const int lane = F.lane, c = lane & 15, g = lane >> 4, w = F.wave;
    const int b = bh >> 4, h = bh & 15;
    const size_t rowbase = (size_t)b * SEQ;
    const int st = lane & 15, k0 = 2 * (w * 4 + (lane >> 4)), chn = h * RN + k0;
    const float mur0 = F.in[7][chn], mur1 = F.in[7][chn + 1], muk0 = F.in[7][RC + chn], muk1 = F.in[7][RC + chn + 1], muv0 = F.in[7][2 * RC + chn], muv1 = F.in[7][2 * RC + chn + 1];
    const float kk0 = F.in[13][chn], kk1 = F.in[13][chn + 1], ka0 = F.in[14][chn], ka1 = F.in[14][chn + 1];
    LAS unsigned char* const opnd = F.lds + RW_OPND; LAS unsigned char* const raw = F.lds + RW_RAW; LAS unsigned char* const aop = F.lds + RW_AOP;
#define RW3_DMA(j) do { const int r_ = 2 * w + (lane >> 5); const size_t ro_ = (rowbase + (size_t)(j) * CH + r_) * 3072 + h * RN + 2 * ((lane & 31) ^ r_); \
        LAS unsigned char* d_ = raw + ((j) % NRAW) * RWR_BYTES + w * 256; \
        GLDS4(rkv + ro_, d_ + RWR_R); GLDS4(rkv + ro_ + RC, d_ + RWR_K); GLDS4(rkv + ro_ + 2 * RC, d_ + RWR_V); GLDS4(lout + ro_, d_ + RWR_LW); GLDS4(lout + ro_ + RC, d_ + RWR_A); \
        if (lane < 2) GLDS4(invn + (rowbase + (size_t)(j) * CH + 2 * w + lane) * RH + h, raw + ((j) % NRAW) * RWR_BYTES + RWR_INV + w * 8); } while (0)
#define RW3_PROC(j) do { const LAS unsigned char* s_ = raw + ((j) % NRAW) * RWR_BYTES; const int pq_ = (k0 >> 1) ^ st, pp_ = (k0 >> 1) ^ ((st + 15) & 15); \
        const LAS unsigned char* sc_ = s_ + st * 128 + pq_ * 4; const LAS unsigned char* sp_ = ((st > 0) ? s_ + (st - 1) * 128 : raw + (((j) + NRAW - 1) % NRAW) * RWR_BYTES + 15 * 128) + pp_ * 4; \
        const bool first_ = ((j) == 0) && (st == 0); \
        const unsigned Lr = *(const LAS unsigned*)(sc_ + RWR_R), Lk = *(const LAS unsigned*)(sc_ + RWR_K), Lv = *(const LAS unsigned*)(sc_ + RWR_V); \
        const unsigned Lw = *(const LAS unsigned*)(sc_ + RWR_LW), La = *(const LAS unsigned*)(sc_ + RWR_A); \
        const unsigned Lrp = *(const LAS unsigned*)(sp_ + RWR_R), Lkp = *(const LAS unsigned*)(sp_ + RWR_K), Lvp = *(const LAS unsigned*)(sp_ + RWR_V); \
        const float Linv = *(const LAS float*)(s_ + RWR_INV + st * 4); \
        const float r0_ = bflo(Lr), r1_ = bfhi(Lr), q0_ = bflo(Lk), q1_ = bfhi(Lk), v0_ = bflo(Lv), v1_ = bfhi(Lv); \
        const float rp0_ = first_ ? 0.f : bflo(Lrp), rp1_ = first_ ? 0.f : bfhi(Lrp), qp0_ = first_ ? 0.f : bflo(Lkp), qp1_ = first_ ? 0.f : bfhi(Lkp), vp0_ = first_ ? 0.f : bflo(Lvp), vp1_ = first_ ? 0.f : bfhi(Lvp); \
        const float rs0_ = r0_ + (rp0_ - r0_) * mur0, rs1_ = r1_ + (rp1_ - r1_) * mur1, ks0_ = q0_ + (qp0_ - q0_) * muk0, ks1_ = q1_ + (qp1_ - q1_) * muk1, vs0_ = v0_ + (vp0_ - v0_) * muv0, vs1_ = v1_ + (vp1_ - v1_) * muv1; \
        const float a0_ = bflo(La), a1_ = bfhi(La), lw0_ = bflo(Lw) * 1.44269504f, lw1_ = bfhi(Lw) * 1.44269504f; \
        const float kap0_ = ks0_ * kk0 * Linv, kap1_ = ks1_ * kk1 * Linv, bet0_ = kap0_ * a0_, bet1_ = kap1_ * a1_; \
        const float kt0_ = ks0_ * (1.0f + (a0_ - 1.0f) * ka0), kt1_ = ks1_ * (1.0f + (a1_ - 1.0f) * ka1); \
        const float G0_ = row16_scan(lw0_), G1_ = row16_scan(lw1_); \
        const float eg0_ = __builtin_amdgcn_exp2f(G0_), eg1_ = __builtin_amdgcn_exp2f(G1_), ep0_ = __builtin_amdgcn_exp2f(G0_ - lw0_), ep1_ = __builtin_amdgcn_exp2f(G1_ - lw1_), ei0_ = __builtin_amdgcn_exp2f(-G0_), ei1_ = __builtin_amdgcn_exp2f(-G1_); \
        LAS unsigned char* d_ = opnd + ((j) % 3) * RWB_BYTES; \
        *(LAS unsigned*)(d_ + RWB_KG + st * RWS + k0 * 2) = pk2(kap0_ * ep0_, kap1_ * ep1_); *(LAS unsigned*)(d_ + RWB_RG + st * RWS + k0 * 2) = pk2(rs0_ * eg0_, rs1_ * eg1_); \
        const unsigned kti_ = pk2(kt0_ * ei0_, kt1_ * ei1_), bti_ = pk2(bet0_ * ei0_, bet1_ * ei1_), vv_ = pk2(vs0_, vs1_); \
        *(LAS unsigned*)(d_ + RWB_KTI + st * RWS + k0 * 2) = kti_; *(LAS unsigned*)(d_ + RWB_BTI + st * RWS + k0 * 2) = bti_; \
        *(LAS unsigned short*)(d_ + RWB_KTIT + k0 * 32 + st * 2) = (unsigned short)(kti_ & 0xffffu); *(LAS unsigned short*)(d_ + RWB_KTIT + (k0 + 1) * 32 + st * 2) = (unsigned short)(kti_ >> 16); \
        *(LAS unsigned short*)(d_ + RWB_BTIT + k0 * 32 + st * 2) = (unsigned short)(bti_ & 0xffffu); *(LAS unsigned short*)(d_ + RWB_BTIT + (k0 + 1) * 32 + st * 2) = (unsigned short)(bti_ >> 16); \
        *(LAS unsigned short*)(d_ + RWB_VT + k0 * 32 + st * 2) = (unsigned short)(vv_ & 0xffffu); *(LAS unsigned short*)(d_ + RWB_VT + (k0 + 1) * 32 + st * 2) = (unsigned short)(vv_ >> 16); \
        if (st == 15) { *(LAS float*)(d_ + RWB_GL + k0 * 4) = eg0_; *(LAS float*)(d_ + RWB_GL + k0 * 4 + 4) = eg1_; } } while (0)
    const f32x4 zero4 = (f32x4){0.f, 0.f, 0.f, 0.f};
    auto a_stage = [&](int j) {
        const LAS unsigned char* rowp = opnd + (j % 3) * RWB_BYTES + c * RWS;
        const int offA = (w == 4 || w == 7) ? RWB_BTI : RWB_KTI;
        const int offB = (w == 4 || w == 5) ? RWB_KG : RWB_RG;
        const bf16x8 a0 = *(const LAS bf16x8*)(rowp + offA + 16 * g), a1 = *(const LAS bf16x8*)(rowp + offA + 64 + 16 * g);
        const bf16x8 b0 = *(const LAS bf16x8*)(rowp + offB + 16 * g), b1 = *(const LAS bf16x8*)(rowp + offB + 64 + 16 * g);
        f32x4 N = MFMA32(a0, b0, zero4); N = MFMA32(a1, b1, N);
        const bool strict = (w == 4 || w == 5);
#pragma unroll
        for (int r = 0; r < 4; ++r) { const int rj = 4 * g + r; N[r] = (strict ? (c > rj) : (c >= rj)) ? N[r] : 0.f; }
        f32x4 res = N;
        if (w == 4) {
            f32x4 N1t = MFMA32(b0, a0, zero4); N1t = MFMA32(b1, a1, N1t);
            f32x4 X;
#pragma unroll
            for (int r = 0; r < 4; ++r) { const int rj = 4 * g + r; N1t[r] = (rj > c) ? N1t[r] : 0.f; X[r] = ((rj == c) ? 1.0f : 0.f) - N[r]; }
            bf16x4 an = cv4(N), at = cv4(N1t);
            f32x4 P = MFMA16(at, an, zero4), Pt = MFMA16(an, at, zero4);
            X = MFMA16(cv4(Pt), cv4(X), padc(X));
            an = cv4(P); at = cv4(Pt);
            P = MFMA16(at, an, zero4); Pt = MFMA16(an, at, zero4);
            X = MFMA16(cv4(Pt), cv4(X), padc(X));
            an = cv4(P); at = cv4(Pt);
            Pt = MFMA16(an, at, zero4);
            X = MFMA16(cv4(Pt), cv4(X), padc(X));
            res = X;
        }
        *(LAS bf16x4*)(aop + (j & 1) * 2048 + (w - 4) * 512 + lane * 8) = cv4(res);
    };
    f32x4 Z[4];
#pragma unroll
    for (int i = 0; i < 4; ++i) Z[i] = (f32x4){0.f, 0.f, 0.f, 0.f};
    { RW3_DMA(0); RW3_DMA(1); RW3_DMA(2); RW3_DMA(3); RW3_DMA(4); RW3_DMA(5); RW3_DMA(6); RW3_DMA(7); asm volatile("s_waitcnt vmcnt(0)" ::: "memory"); WG_BAR(); RW3_PROC(0); RW3_PROC(1); WG_BAR(); if (w >= 4) a_stage(0); WG_BAR(); }
    if (w < 4) {
        for (int ci = 0; ci < NCHK; ++ci) {
            const int t0 = ci * CH; const int jp = (ci + 2 < NCHK) ? ci + 2 : NCHK - 1;
            if (nsh > 0 && ci == NCHK / 2 - NRAW) { if (w == 0 && lane == 0) { unsigned* ctl_ = WSP(unsigned, WS_CTL); XB_SPIN(xb_ld(ctl_ + CW_SIG_H2) < (unsigned)nsh, ctl_ + CW_BAR); __builtin_amdgcn_fence(__ATOMIC_ACQUIRE, "agent"); asm volatile("s_waitcnt vmcnt(0)" ::: "memory"); } WG_BAR(); }
            RW3_PROC(jp);
            const LAS unsigned char* cur = opnd + (ci % 3) * RWB_BYTES; const LAS unsigned char* rowp = cur + c * RWS; const LAS unsigned char* ap = aop + (ci & 1) * 2048 + lane * 8;
            bf16x8 pKg[2], pRg[2];
#pragma unroll
            for (int s = 0; s < 2; ++s) {
                pKg[s] = join8(*(const LAS v2u*)(rowp + RWB_KG + 64 * s + 8 * g), *(const LAS v2u*)(rowp + RWB_KG + 64 * s + 32 + 8 * g));
                pRg[s] = join8(*(const LAS v2u*)(rowp + RWB_RG + 64 * s + 8 * g), *(const LAS v2u*)(rowp + RWB_RG + 64 * s + 32 + 8 * g)); }
            const bf16x4 bV = *(const LAS bf16x4*)(cur + RWB_VT + (16 * w + c) * 32 + 8 * g);
            const bf16x4 xT = *(const LAS bf16x4*)(ap), n2 = *(const LAS bf16x4*)(ap + 512), n3 = *(const LAS bf16x4*)(ap + 1024), n4 = *(const LAS bf16x4*)(ap + 1536);
            const bf16x8 bZ0 = cv8(Z[0], Z[1]), bZ1 = cv8(Z[2], Z[3]);
            const bf16x4 z4 = (bf16x4){0, 0, 0, 0};
            f32x4 W = MFMA32(pKg[0], bZ0, zero4); W = MFMA32(pKg[1], bZ1, W); W = MFMA32(cat8(n2, z4), cat8(bV, z4), W);
            const f32x4 U = MFMA16(xT, cv4(W), zero4);
            const bf16x4 nU = cv4(-U);
            const bf16x8 bVU = cat8(bV, nU);
            f32x4 Y = MFMA32(pRg[0], bZ0, zero4); Y = MFMA32(pRg[1], bZ1, Y); Y = MFMA32(cat8(n3, n4), bVU, Y);
#pragma unroll
            for (int r = 0; r < 4; ++r) ydst[(rowbase + t0 + 4 * g + r) * 3072 + h * RN + 16 * w + c] = bf1(Y[r]);
#pragma unroll
            for (int zt = 0; zt < 4; ++zt) {
                const bf16x4 aK = *(const LAS bf16x4*)(cur + RWB_KTIT + (16 * zt + c) * 32 + 8 * g), aB = *(const LAS bf16x4*)(cur + RWB_BTIT + (16 * zt + c) * 32 + 8 * g);
                const f32x4 gl = *(const LAS f32x4*)(cur + RWB_GL + (16 * zt + 4 * g) * 4);
                Z[zt] = MFMA32(cat8(aK, aB), bVU, Z[zt]) * gl; }
            { const int jn = (ci + NRAW < NCHK) ? ci + NRAW : NCHK - 1; RW3_DMA(jn); }
            if (ci == NCHK / 2 - 1) asm volatile("s_waitcnt vmcnt(0)" ::: "memory");
            asm volatile("s_waitcnt vmcnt(50)" ::: "memory");
            WG_BAR();
            if (ci == NCHK / 2 - 1 && w == 0 && lane == 0) sig_post(WSP(unsigned, WS_CTL) + CW_SIG_HALF);
        }
    } else {
        for (int ci = 0; ci < NCHK; ++ci) {
            const int jp = (ci + 2 < NCHK) ? ci + 2 : NCHK - 1, ja = (ci + 1 < NCHK) ? ci + 1 : NCHK - 1;
            if (nsh > 0 && ci == NCHK / 2 - NRAW) WG_BAR();
            RW3_PROC(jp);
            a_stage(ja);
            { const int jn = (ci + NRAW < NCHK) ? ci + NRAW : NCHK - 1; RW3_DMA(jn); }
            asm volatile("s_waitcnt vmcnt(30)" ::: "memory");
            WG_BAR();
        }
    }
#undef RW3_DMA
#undef RW3_PROC
}

__device__ __forceinline__ void p6_hgrn_head(Frame& F, int hb) {
    const bf16* hg = WSP(bf16, WS_R + R_HG); bf16* odst = WSP(bf16, WS_R + R_HG);
    const int lane = F.lane, c = lane & 15, g = lane >> 4, w = F.wave;
    const int bh = hb >> 1, half = hb & 1, b = bh >> 3, h = bh & 7, vb = half * 4 + (w & 3);
    const size_t rowbase = (size_t)b * SEQ;
    const int st = lane & 15, k0 = 4 * (w * 4 + (lane >> 4));
    LAS unsigned char* const opnd = F.lds + HG_OPND; LAS unsigned char* const raw = F.lds + HG_RAW; LAS unsigned char* const aop = F.lds + HG_AOP;
#define HG3_DMA(j) do { _Pragma("unroll") for (int rr_ = 0; rr_ < 2; ++rr_) { const int r_ = 2 * w + rr_; const bf16* p_ = hg + (rowbase + (size_t)(j) * CH + r_) * 4096 + h * HD + 2 * (2 * ((lane >> 1) ^ r_) + (lane & 1)); \
        LAS unsigned char* d_ = raw + ((j) % NRAW) * HGR_BYTES + r_ * 256; GLDS4(p_, d_ + HGR_Q); GLDS4(p_ + HC, d_ + HGR_LF); GLDS4(p_ + 2 * HC, d_ + HGR_V); } } while (0)
#define HG3_PROC(j) do { const LAS unsigned char* s_ = raw + ((j) % NRAW) * HGR_BYTES + st * 256 + (((k0 >> 2) ^ st) * 8); LAS unsigned char* d_ = opnd + ((j) % 3) * HGB_BYTES; \
        const v2u Lq = *(const LAS v2u*)(s_ + HGR_Q), Lf = *(const LAS v2u*)(s_ + HGR_LF), Lv = *(const LAS v2u*)(s_ + HGR_V); \
        const f32x4 q_ = unpack4(Lq); f32x4 lf_ = unpack4(Lf) * 1.44269504f; f32x4 qg_, ki_, eg_; \
        _Pragma("unroll") for (int e = 0; e < 4; ++e) { const float G_ = row16_scan(lf_[e]); eg_[e] = __builtin_amdgcn_exp2f(G_); qg_[e] = q_[e] * eg_[e]; ki_[e] = (1.0f - __builtin_amdgcn_exp2f(lf_[e])) * __builtin_amdgcn_exp2f(-G_); } \
        const v2u kw_ = pack4(ki_); *(LAS v2u*)(d_ + HGB_QG + st * HGS + k0 * 2) = pack4(qg_); *(LAS v2u*)(d_ + HGB_KI + st * HGS + k0 * 2) = kw_; \
        *(LAS unsigned short*)(d_ + HGB_KIT + (k0 + 0) * 32 + st * 2) = (unsigned short)(kw_.x & 0xffffu); *(LAS unsigned short*)(d_ + HGB_KIT + (k0 + 1) * 32 + st * 2) = (unsigned short)(kw_.x >> 16); \
        *(LAS unsigned short*)(d_ + HGB_KIT + (k0 + 2) * 32 + st * 2) = (unsigned short)(kw_.y & 0xffffu); *(LAS unsigned short*)(d_ + HGB_KIT + (k0 + 3) * 32 + st * 2) = (unsigned short)(kw_.y >> 16); \
        *(LAS unsigned short*)(d_ + HGB_VT + (k0 + 0) * 32 + st * 2) = (unsigned short)(Lv.x & 0xffffu); *(LAS unsigned short*)(d_ + HGB_VT + (k0 + 1) * 32 + st * 2) = (unsigned short)(Lv.x >> 16); \
        *(LAS unsigned short*)(d_ + HGB_VT + (k0 + 2) * 32 + st * 2) = (unsigned short)(Lv.y & 0xffffu); *(LAS unsigned short*)(d_ + HGB_VT + (k0 + 3) * 32 + st * 2) = (unsigned short)(Lv.y >> 16); \
        if (st == 15) *(LAS f32x4*)(d_ + HGB_GL + k0 * 4) = eg_; } while (0)
    const f32x4 zero4 = (f32x4){0.f, 0.f, 0.f, 0.f};
    auto a_stage = [&](int j) {
        const LAS unsigned char* rowp = opnd + (j % 3) * HGB_BYTES + c * HGS;
        f32x4 N = zero4;
#pragma unroll
        for (int s = 0; s < 4; ++s) { const bf16x8 nQ = *(const LAS bf16x8*)(rowp + HGB_QG + 64 * s + 16 * g), nK = *(const LAS bf16x8*)(rowp + HGB_KI + 64 * s + 16 * g); N = MFMA32(nK, nQ, N); }
#pragma unroll
        for (int r = 0; r < 4; ++r) N[r] = (c >= 4 * g + r) ? N[r] : 0.f;
        *(LAS bf16x4*)(aop + (j & 1) * 512 + lane * 8) = cv4(N);
    };
    f32x4 Z[8];
#pragma unroll
    for (int i = 0; i < 8; ++i) Z[i] = (f32x4){0.f, 0.f, 0.f, 0.f};
    { HG3_DMA(0); HG3_DMA(1); HG3_DMA(2); HG3_DMA(3); HG3_DMA(4); HG3_DMA(5); HG3_DMA(6); HG3_DMA(7); asm volatile("s_waitcnt vmcnt(0)" ::: "memory"); WG_BAR(); HG3_PROC(0); HG3_PROC(1); WG_BAR(); if (w == 4) a_stage(0); WG_BAR(); }
    if (w < 4) {
        for (int ci = 0; ci < NCHK; ++ci) {
            const int t0 = ci * CH; const int jp = (ci + 2 < NCHK) ? ci + 2 : NCHK - 1;
            HG3_PROC(jp);
            const LAS unsigned char* cur = opnd + (ci % 3) * HGB_BYTES; const LAS unsigned char* rowp = cur + c * HGS;
            f32x4 Y = zero4;
#pragma unroll
            for (int s = 0; s < 4; ++s) {
                const bf16x8 pQ = join8(*(const LAS v2u*)(rowp + HGB_QG + 64 * s + 8 * g), *(const LAS v2u*)(rowp + HGB_QG + 64 * s + 32 + 8 * g));
                Y = MFMA32(pQ, cv8(Z[2 * s], Z[2 * s + 1]), Y); }
            const bf16x4 bV = *(const LAS bf16x4*)(cur + HGB_VT + (16 * vb + c) * 32 + 8 * g);
            const bf16x4 n = *(const LAS bf16x4*)(aop + (ci & 1) * 512 + lane * 8);
            const bf16x4 z4 = (bf16x4){0, 0, 0, 0};
            Y = MFMA32(cat8(n, z4), cat8(bV, z4), Y);
#pragma unroll
            for (int r = 0; r < 4; ++r) odst[(rowbase + t0 + 4 * g + r) * 4096 + 2 * HC + h * HD + 16 * vb + c] = bf1(Y[r]);
#pragma unroll
            for (int zt = 0; zt < 8; ++zt) {
                const bf16x4 aK = *(const LAS bf16x4*)(cur + HGB_KIT + (16 * zt + c) * 32 + 8 * g);
                const f32x4 gl = *(const LAS f32x4*)(cur + HGB_GL + (16 * zt + 4 * g) * 4);
                Z[zt] = MFMA16(aK, bV, Z[zt]) * gl; }
            { const int jn = (ci + NRAW < NCHK) ? ci + NRAW : NCHK - 1; HG3_DMA(jn); }
            if (ci == NCHK / 2 - 1) asm volatile("s_waitcnt vmcnt(0)" ::: "memory");
            asm volatile("s_waitcnt vmcnt(50)" ::: "memory");
            WG_BAR();
            if (ci == NCHK / 2 - 1 && w == 0 && lane == 0) sig_post(WSP(unsigned, WS_CTL) + CW_SIG_HALF);
        }
    } else {
        for (int ci = 0; ci < NCHK; ++ci) {
            const int jp = (ci + 2 < NCHK) ? ci + 2 : NCHK - 1, ja = (ci + 1 < NCHK) ? ci + 1 : NCHK - 1;
            HG3_PROC(jp);
            if (w == 4) a_stage(ja);
            { const int jn = (ci + NRAW < NCHK) ? ci + NRAW : NCHK - 1; HG3_DMA(jn); }
            asm volatile("s_waitcnt vmcnt(30)" ::: "memory");
            WG_BAR();
        }
    }
#undef HG3_DMA
#undef HG3_PROC
}
#undef WG_BAR
__device__ __forceinline__ void p7_post(Frame& F, int hsel, int c, int G);
constexpr int NSCAN = BATCH * RH + 2 * BATCH * HH;
__device__ __forceinline__ void p6_shadow(Frame& F, const Args& A, int c, int G) {
    const unsigned long long* ss = WSP(unsigned long long, WS_SS);
    {   pg8::Gemm g{WSP(bf16, WS_XB), WSP(bf16, WS_WIN) + (size_t)26 * 256 * D, M, 4 * 256, D, 0}; pg8::StaticOrder S; S.init(M, 4 * 256, G, c);
        pg8::EpiInProj E{WSP(bf16, WS_R + R_RKV), WSP(float, WS_R + R_LIN), WSP(bf16, WS_R + R_HG), pg8::inv_preload((PG8_LAS float*)(F.lds + pg8::STAGE_BYTES), S, ss + M), (PG8_LAS float*)(F.lds + pg8::STAGE_BYTES + 4096), 26};
        pg8::gemm_phase<pg8::EpiInProj, pg8::StaticOrder, true, true>(F.lds, g, S, E); }
    {   int kl = KL; asm volatile("" : "+s"(kl));
        pg8::Gemm g{WSP(bf16, WS_ALORA), WSP(bf16, WS_WLORA) + (size_t)8 * 256 * KL, M, 4 * 256, kl, 0}; pg8::StaticOrder S; S.init(M, 4 * 256, G, c);
        pg8::EpiLora E{WSP(bf16, WS_LOUT), (PG8_LAS float*)(F.lds + pg8::STAGE_BYTES), 8};
        pg8::gemm_phase<pg8::EpiLora, pg8::StaticOrder, true, true>(F.lds, g, S, E); }
    p0_transposes<1>(F, A, c * NWAVES + F.wave, G * NWAVES);
}
__device__ __forceinline__ void p6_shadow_pre(Frame& F, int c, int G) {
    unsigned* ctl = WSP(unsigned, WS_CTL);
    p4_lora_in(F, 1, c, G);
    wg_signal(ctl + CW_SIG_P4); wg_wait(ctl + CW_SIG_P4, (unsigned)G, ctl + CW_BAR);
    {   int kl = KL; asm volatile("" : "+s"(kl));
        pg8::Gemm g{WSP(bf16, WS_ALORA), WSP(bf16, WS_WLORA), M, 8 * 256, kl, 0}; pg8::StaticOrder S; S.init(M / 2, 8 * 256, G, c); S.hsel = 1;
        PG8_LAS float* bt = (PG8_LAS float*)(F.lds + pg8::STAGE_BYTES);
        for (int cix = F.tid; cix < 2 * RC; cix += NWAVES * 64) bt[cix] = cix < RC ? F.in[8][cix] : F.in[10][cix - RC];
        __syncthreads();
        pg8::EpiLora E{WSP(bf16, WS_LOUT), bt, 0};
        pg8::gemm_phase<pg8::EpiLora, pg8::StaticOrder, true, true>(F.lds, g, S, E); }
    wg_signal(ctl + CW_SIG_H2);
}
__device__ __forceinline__ void p6_shadow_b(Frame& F, int c, int G) {
    unsigned* ctl = WSP(unsigned, WS_CTL);
    wg_signal(ctl + CW_SIG_SHA); wg_wait(ctl + CW_SIG_SHA, (unsigned)G, ctl + CW_BAR);
    wg_wait(ctl + CW_SIG_HALF, (unsigned)NSCAN, ctl + CW_BAR);
    p7_post(F, 0, c, G);
    wg_signal(ctl + CW_SIG_SHB); wg_wait(ctl + CW_SIG_SHB, (unsigned)G, ctl + CW_BAR);
    {   pg8::Gemm g{WSP(bf16, WS_XB), WSP(bf16, WS_WOUT), M, D, D, 0}; pg8::StaticOrder S; S.init(M / 2, D, G, c, 4); S.hsel = 0;
        pg8::EpiResid E{nullptr, (const bf16*)F.out, nullptr, nullptr, (bf16*)F.out + D, F.in[21], nullptr, WSP(unsigned long long, WS_SS) + 2 * M, 1.0f, 2 * D, 2 * D, 2048};
        pg8::gemm_phase<pg8::EpiResid, pg8::StaticOrder, true, true>(F.lds, g, S, E); }
}
__device__ __forceinline__ void p6_scans(Frame& F, const Args& A) {
    const int bx = (int)blockIdx.x;
    if (F.G == 2 * NSCAN) {
        const int x = bx & 7, idx = (bx >> 3) * 4 + (x & 3);
        if (x < 4) { if (idx < BATCH * RH) p6_rwkv_head(F, idx, NSCAN); else p6_hgrn_head(F, idx - BATCH * RH); } else { p6_shadow_pre(F, idx, NSCAN); p6_shadow(F, A, idx, NSCAN); p6_shadow_b(F, idx, NSCAN); } }
    else if (F.G > NSCAN) { if (bx < NSCAN) { if (bx < BATCH * RH) p6_rwkv_head(F, bx, F.G - NSCAN); else p6_hgrn_head(F, bx - BATCH * RH); } else { p6_shadow_pre(F, bx - NSCAN, F.G - NSCAN); p6_shadow(F, A, bx - NSCAN, F.G - NSCAN); p6_shadow_b(F, bx - NSCAN, F.G - NSCAN); } }
    else {
        for (int u = bx; u < NSCAN; u += F.G) { if (u < BATCH * RH) p6_rwkv_head(F, u, 0); else p6_hgrn_head(F, u - BATCH * RH); }
        __syncthreads(); p6_shadow(F, A, bx, F.G);
    }
}

__device__ __forceinline__ void p7_post(Frame& F, int hsel, int c, int G) {
    const int NR = hsel < 0 ? M : M / 2;
    const bf16* rkv = WSP(bf16, WS_R + R_RKV); const bf16* hg = WSP(bf16, WS_R + R_HG); const bf16* lout = WSP(bf16, WS_LOUT); bf16* yc = WSP(bf16, WS_XB);
    { const int half = F.tid >> 8, ch = (F.tid & 255) * 4;
      const f32x4 mu_r = *(const f32x4*)(F.in[7] + ch), mu_k = *(const f32x4*)(F.in[7] + RC + ch), mu_v = *(const f32x4*)(F.in[7] + 2 * RC + ch);
      const f32x4 kac = *(const f32x4*)(F.in[14] + ch), rkc = *(const f32x4*)(F.in[15] + ch), lnw = *(const f32x4*)(F.in[16] + ch), lnb = *(const f32x4*)(F.in[17] + ch);
#pragma unroll 2
      for (int i = c * 2 + half; i < NR; i += 2 * G) { const int m = hsel < 0 ? i : (i / (SEQ / 2)) * SEQ + (i % (SEQ / 2)) + hsel * (SEQ / 2);
          const bool first = (m & (SEQ - 1)) == 0; const size_t mp = first ? m : m - 1;
          const bf16* p = rkv + (size_t)m * 3072 + ch; const bf16* q = rkv + mp * 3072 + ch; const bf16* l = lout + (size_t)m * 3072 + ch;
          const f32x4 y = unpack4(*(const GAS v2u*)(l));
          const f32x4 r = unpack4(*(const GAS v2u*)(p)), k = unpack4(*(const GAS v2u*)(p + RC)), v = unpack4(*(const GAS v2u*)(p + 2 * RC));
          f32x4 rp = unpack4(*(const GAS v2u*)(q)), kp = unpack4(*(const GAS v2u*)(q + RC)), vp = unpack4(*(const GAS v2u*)(q + 2 * RC));
          if (first) { rp = (f32x4){0.f, 0.f, 0.f, 0.f}; kp = rp; vp = rp; }
          const f32x4 a = unpack4(*(const GAS v2u*)(l + RC)), gg = unpack4(*(const GAS v2u*)(l + 2 * RC));
          const f32x4 rs = r + (rp - r) * mu_r, ks = k + (kp - k) * mu_k, vs = v + (vp - v) * mu_v;
          const f32x4 km = ks * (1.0f + (a - 1.0f) * kac);
          const f32x4 bt = rs * km * rkc; float bon = (bt[0] + bt[1]) + (bt[2] + bt[3]); bon = row16_sum(bon);
          float s1 = (y[0] + y[1]) + (y[2] + y[3]); s1 = row16_sum(s1); const float mean = s1 * (1.0f / 64.0f);
          const f32x4 d = y - mean; float s2 = (d[0] * d[0] + d[1] * d[1]) + (d[2] * d[2] + d[3] * d[3]); s2 = row16_sum(s2);
          const float rstd = 1.0f / sqrtf(s2 * (1.0f / 64.0f) + 64e-5f);
          const f32x4 o = ((d * rstd) * lnw + lnb + vs * bon) * gg;
          *(GAS v2u*)(yc + (size_t)m * 2048 + ch) = pack4(o); } }
    { const int quarter = F.tid >> 7, ch = (F.tid & 127) * 8;
      const f32x4 nw0 = *(const f32x4*)(F.in[19] + ch), nw1 = *(const f32x4*)(F.in[19] + ch + 4);
#pragma unroll 4
      for (int i = c * 4 + quarter; i < NR; i += 4 * G) { const int m = hsel < 0 ? i : (i / (SEQ / 2)) * SEQ + (i % (SEQ / 2)) + hsel * (SEQ / 2);
          const v4u ow = *(const GAS v4u*)(hg + (size_t)m * 4096 + 2 * HC + ch), gw4 = *(const GAS v4u*)(hg + (size_t)m * 4096 + 3 * HC + ch);
          const f32x4 o0 = (f32x4){bflo(ow.x), bfhi(ow.x), bflo(ow.y), bfhi(ow.y)}, o1 = (f32x4){bflo(ow.z), bfhi(ow.z), bflo(ow.w), bfhi(ow.w)};
          const f32x4 g0 = (f32x4){bflo(gw4.x), bfhi(gw4.x), bflo(gw4.y), bfhi(gw4.y)}, g1 = (f32x4){bflo(gw4.z), bfhi(gw4.z), bflo(gw4.w), bfhi(gw4.w)};
          float s2 = ((o0[0] * o0[0] + o0[1] * o0[1]) + (o0[2] * o0[2] + o0[3] * o0[3])) + ((o1[0] * o1[0] + o1[1] * o1[1]) + (o1[2] * o1[2] + o1[3] * o1[3])); s2 = row16_sum(s2);
          const float rstd = 1.0f / sqrtf(s2 * (1.0f / 128.0f) + 1e-6f);
          *(GAS v4u*)(yc + (size_t)m * 2048 + RC + ch) = pg8::pack8(o0 * rstd * nw0 * g0, o1 * rstd * nw1 * g1); } }
}

__device__ __forceinline__ void p11_final(Frame& F) {
    const int gw = F.vcu * NWAVES + F.wave, NGW = F.G * NWAVES; const float* fg = F.in[25];
    const bf16* x3 = WSP(bf16, WS_XB); const unsigned long long* ss3 = WSP(unsigned long long, WS_SS) + 3 * M;
    f32x4 gn[8];
#pragma unroll
    for (int j = 0; j < 4; ++j) { gn[2 * j] = *(const f32x4*)(fg + 8 * F.lane + 512 * j); gn[2 * j + 1] = *(const f32x4*)(fg + 8 * F.lane + 512 * j + 4); }
#pragma unroll 2
    for (int m = gw; m < M; m += NGW) { const GAS v4u* xr = (const GAS v4u*)(x3 + (size_t)m * D) + F.lane; GAS f32x4* o = (GAS f32x4*)(F.out + (size_t)m * D) + 2 * F.lane;
        const float inv = pg8::inv_rms_from_val(ss3[m]);
#pragma unroll
        for (int j = 0; j < 4; ++j) { const v4u w = xr[64 * j];
            o[128 * j] = (f32x4){bflo(w.x), bfhi(w.x), bflo(w.y), bfhi(w.y)} * inv * gn[2 * j]; o[128 * j + 1] = (f32x4){bflo(w.z), bfhi(w.z), bflo(w.w), bfhi(w.w)} * inv * gn[2 * j + 1]; } }
}

__global__ void __launch_bounds__(NWAVES * 64, 2) mk_fwd(Args args) {
    extern __shared__ __attribute__((aligned(16))) unsigned char lds[];
    Frame F;
    F.lds = (LAS unsigned char*)lds;
    F.tid = threadIdx.x; F.lane = F.tid & 63; F.wave = __builtin_amdgcn_readfirstlane(F.tid >> 6);
    F.G = gridDim.x; { const int bx = blockIdx.x; F.vcu = (F.G % 8 == 0) ? (bx % 8) * (F.G / 8) + bx / 8 : bx; }
#pragma unroll
    for (int i = 0; i < 26; ++i) F.in[i] = args.in[i];
    F.out = args.out; F.ws = args.ws;
    for (int u = F.tid; u < (LDS_BYTES - LDSCTL_OFF) / 4; u += NWAVES * 64) ((LAS unsigned*)(F.lds + LDSCTL_OFF))[u] = 0u;
    __syncthreads();
    const int lo = args.ph_lo, hi = args.ph_hi;
    XcdBarrier bar; bar.bar = (unsigned*)(args.ws + WS_CTL) + CW_BAR; bar.x = 0; bar.st = nullptr;
    if (hi - lo > 1) bar = xcd_barrier_post((unsigned*)(args.ws + WS_CTL) + CW_BAR, (volatile LAS unsigned*)(F.lds + MISC_OFF) + 8);
#ifndef PH_MASK
#define PH_MASK 0xFFF
#endif
#define IN(k) (((PH_MASK >> (k)) & 1) && lo <= (k) && (k) < hi)
#define SEAM(k) do { if (IN(k) && IN((k) + 1)) xcd_barrier(bar); } while (0)
    const bf16* xb = WSP(bf16, WS_XB); unsigned long long* ss = WSP(unsigned long long, WS_SS);
    const int cid = (int)blockIdx.x;
    bf16* const x2b = (bf16*)F.out + D;
    const bool fuse = (F.G % 256) == 0;

    if (IN(0)) { p0_prologue(F, args); } SEAM(0);
    if (IN(1)) {
        pg8::Gemm g{xb, WSP(bf16, WS_W1GU), M, 2 * FF, D, 0}; pg8::StaticOrder S; S.init(M, 2 * FF, F.G, cid);
        pg8::EpiSwiglu E{WSP(bf16, WS_R + R_ACT), FF, pg8::inv_preload((PG8_LAS float*)(F.lds + pg8::STAGE_BYTES), S, ss)};
        pg8::gemm_phase<pg8::EpiSwiglu, pg8::StaticOrder, true, true>(F.lds, g, S, E);
    } SEAM(1);
    if (IN(2)) {
        pg8::Gemm g{WSP(bf16, WS_R + R_ACT), WSP(bf16, WS_W1D), M, D, FF, 0}; pg8::StaticOrder S; S.init(M, D, F.G, cid, 4);
        pg8::EpiResid E{F.in[0], nullptr, nullptr, nullptr, WSP(bf16, WS_XB), F.in[5], (bf16*)F.out, ss + M, 0.5f, 2048, 2048, 2 * D};
        pg8::gemm_phase<pg8::EpiResid, pg8::StaticOrder, true, true>(F.lds, g, S, E);
    } SEAM(2);
    if (IN(3)) {
        pg8::Gemm g{xb, WSP(bf16, WS_WIN), M, 26 * 256, D, 0}; pg8::StaticOrder S; S.init(M, 26 * 256, F.G, cid);
        PG8_LAS float* omt = (PG8_LAS float*)(F.lds + pg8::STAGE_BYTES + 4096);
        for (int cix = F.tid; cix < HC; cix += NWAVES * 64) omt[cix] = 1.0f - fast_sigmoid(F.in[18][cix] - F.in[18][HC + cix]);
        pg8::EpiInProj E{WSP(bf16, WS_R + R_RKV), WSP(float, WS_R + R_LIN), WSP(bf16, WS_R + R_HG), pg8::inv_preload((PG8_LAS float*)(F.lds + pg8::STAGE_BYTES), S, ss + M), omt, 0};
        pg8::gemm_phase<pg8::EpiInProj, pg8::StaticOrder, true, true>(F.lds, g, S, E);
    } SEAM(3);
    const bool split = F.G > NSCAN;
    if (IN(4)) { p4_lora_in(F, split ? 0 : -1, F.vcu, F.G); } SEAM(4);
    if (IN(5)) {
        int kl = KL; asm volatile("" : "+s"(kl));
        pg8::Gemm g{WSP(bf16, WS_ALORA), WSP(bf16, WS_WLORA), M, 8 * 256, kl, 0}; pg8::StaticOrder S; S.init(split ? M / 2 : M, 8 * 256, F.G, cid); S.hsel = split ? 0 : -1;
        PG8_LAS float* bt = (PG8_LAS float*)(F.lds + pg8::STAGE_BYTES);
        for (int cix = F.tid; cix < 2 * RC; cix += NWAVES * 64) bt[cix] = cix < RC ? F.in[8][cix] : F.in[10][cix - RC];
        __syncthreads();
        pg8::EpiLora E{WSP(bf16, WS_LOUT), bt, 0};
        pg8::gemm_phase<pg8::EpiLora, pg8::StaticOrder, true, true>(F.lds, g, S, E);
    } SEAM(5);
    if (IN(6)) { p6_scans(F, args); } SEAM(6);
    if (IN(7)) { p7_post(F, split ? 1 : -1, F.vcu, F.G); } SEAM(7);
    if (IN(8)) {
        pg8::Gemm g{xb, WSP(bf16, WS_WOUT), M, D, D, 0}; pg8::StaticOrder S; S.init(split ? M / 2 : M, D, F.G, cid, 4); S.hsel = split ? 1 : -1;
        pg8::EpiResid E{nullptr, (const bf16*)F.out, nullptr, nullptr, x2b, F.in[21], nullptr, ss + 2 * M, 1.0f, 2 * D, 2 * D, 2048};
        pg8::gemm_phase<pg8::EpiResid, pg8::StaticOrder, true, true>(F.lds, g, S, E);
    } SEAM(8);
    if (IN(9)) {
        pg8::Gemm g{x2b, WSP(bf16, WS_W2GU), M, 2 * FF, D, 2 * D}; pg8::StaticOrder S; S.init(M, 2 * FF, F.G, cid);
        pg8::EpiSwiglu E{WSP(bf16, WS_R + R_ACT), FF, pg8::inv_preload((PG8_LAS float*)(F.lds + pg8::STAGE_BYTES), S, ss + 2 * M)};
        pg8::gemm_phase<pg8::EpiSwiglu, pg8::StaticOrder, true, true>(F.lds, g, S, E);
    } SEAM(9);
    if (IN(10)) {
        pg8::Gemm g{WSP(bf16, WS_R + R_ACT), WSP(bf16, WS_W2D), M, D, FF, 0}; pg8::StaticOrder S; S.init(M, D, F.G, cid, 4);
        if (fuse) { pg8::EpiFinal E{x2b, 2 * D, F.in[21], F.in[25], F.out, ss + 3 * M, WSP(unsigned, WS_CTL) + CW_PCNT, WSP(unsigned, WS_CTL) + CW_BAR + XB_TMO, 0.5f, (unsigned)(D / 256)};
            pg8::gemm_phase<pg8::EpiFinal, pg8::StaticOrder, true, true>(F.lds, g, S, E); }
        else { pg8::EpiResid E{nullptr, x2b, F.in[21], nullptr, nullptr, nullptr, WSP(bf16, WS_XB), ss + 3 * M, 0.5f, 2 * D, 2048, 2048};
            pg8::gemm_phase<pg8::EpiResid, pg8::StaticOrder, true, true>(F.lds, g, S, E); }
    }
    if (!fuse) { SEAM(10); if (IN(11)) { p11_final(F); } }
#undef IN
#undef SEAM
}

extern "C" void kernel_launch(void* const* d_in, const int* in_sizes, int n_in, void* d_out, int out_size, void* d_ws, size_t ws_size, hipStream_t stream) {
    static int grid = 0;
    if (grid == 0) {
        if (n_in != 26 || in_sizes[0] != M * D || out_size != M * D || ws_size < WS_END) { fprintf(stderr, "kernel_launch: unexpected problem (n_in %d, ws %zu < %zu)\n", n_in, ws_size, (size_t)WS_END); grid = -1; return; }
        int dev = 0, cus = 0, per_cu = 0;
        if (hipGetDevice(&dev) != hipSuccess || hipDeviceGetAttribute(&cus, hipDeviceAttributeMultiprocessorCount, dev) != hipSuccess) { grid = -1; return; }
        if (hipFuncSetAttribute((const void*)mk_fwd, hipFuncAttributeMaxDynamicSharedMemorySize, LDS_BYTES) != hipSuccess) { grid = -1; return; }
        if (hipOccupancyMaxActiveBlocksPerMultiprocessor(&per_cu, (const void*)mk_fwd, NWAVES * 64, LDS_BYTES) != hipSuccess || per_cu < 1) fprintf(stderr, "kernel_launch: occupancy query reports %d\n", per_cu);
        (void)hipGetLastError();
        grid = cus;
    }
    if (grid < 0) return;
    (void)hipMemsetAsync((char*)d_ws + WS_CTL, 0, CTL_BYTES, stream);
    Args a{};
    for (int i = 0; i < 26; ++i) a.in[i] = (const float*)d_in[i];
    a.out = (float*)d_out; a.ws = (unsigned char*)d_ws;
    constexpr int NL_ = MK_N_LAUNCHES;
    for (int li = 0; li < NL_; ++li) {
        a.ph_lo = (NL_ == 1) ? 0 : li; a.ph_hi = (NL_ == 1) ? N_PHASES : li + 1;
        hipLaunchKernelGGL(mk_fwd, dim3(grid), dim3(NWAVES * 64), LDS_BYTES, stream, a);
    }
}
```

```cpp
#include <hip/hip_runtime.h>
#include <cstdio>
#include <cstdint>
namespace pg8 {
#define PG8_LAS __attribute__((address_space(3)))
typedef unsigned short bf16_t;
typedef short bf16x8 __attribute__((ext_vector_type(8)));
typedef float f32x4 __attribute__((ext_vector_type(4)));
typedef unsigned u32x4 __attribute__((ext_vector_type(4)));
constexpr int BM = 256, BK = 64, HALF = 128, HTB = HALF * BK * 2  , STAGE_BYTES = 8 * HTB, NXCD = 8, WGM = 8;

__host__ __device__ __forceinline__ int lds_byte(int r, int c) { const int st = (r >> 4) * 2 + (c >> 5), rr = r & 15, cc = c & 31, ob = rr * 64 + cc * 2; return st * 1024 + (ob ^ (((ob >> 9) & 1) << 5)); }
__host__ __device__ __forceinline__ void stage_rc(int b, int& R, int& C) { const int st = b / 1024, sb = b % 1024, swz = sb ^ (((sb >> 9) & 1) << 5); R = (st >> 1) * 16 + swz / 64; C = (st & 1) * 32 + (swz % 64) / 2; }
__host__ __device__ __forceinline__ int perm32(int rho) { const int n = rho >> 4, i = rho & 15; return 8 * (i >> 2) + 4 * n + (i & 3); }

struct Unit { int pm, pn; };
struct Gemm { const bf16_t* A; const bf16_t* Bt; int M, N, K, lda; };

struct StaticOrder {
    int nM, nN, nwg, G, c, wgm, hsel;
    __host__ __device__ void init(int M, int N, int G_, int c_, int wgm_ = WGM) { nM = M / BM; nN = N / BM; nwg = nM * nN; G = G_; c = c_; wgm = wgm_; hsel = -1; }
    __host__ __device__ bool next(int i, Unit& u) const {
        const long L = (long)i * G + c; if (L >= nwg) return false;
        int wgid = (int)L; { const int q = nwg / NXCD, r = nwg % NXCD, xcd = wgid % NXCD, off = wgid / NXCD; wgid = (xcd < r ? xcd * (q + 1) : r * (q + 1) + (xcd - r) * q) + off; }
        const int nig = wgm * nN, gid = wgid / nig, fm = gid * wgm, gsz = (nM - fm) < wgm ? (nM - fm) : wgm;
        u.pm = fm + ((wgid % nig) % gsz); u.pn = (wgid % nig) / gsz; if (hsel >= 0) u.pm = (u.pm >> 4) * 32 + (u.pm & 15) + 16 * hsel; return true;
    }
    __device__ __forceinline__ void a_ready(const Unit&) const {}
    __device__ __forceinline__ void done(const Unit&) const {}
};


typedef __bf16 bf16n2 __attribute__((ext_vector_type(2)));
__device__ __forceinline__ unsigned cvt_pk_bf16(float lo, float hi) { bf16n2 v; v.x = (__bf16)lo; v.y = (__bf16)hi; return __builtin_bit_cast(unsigned, v); }
__device__ __forceinline__ float fast_sigmoid(float z) { return __builtin_amdgcn_rcpf(1.0f + __builtin_amdgcn_exp2f(-1.44269504f * z)); }
__device__ __forceinline__ float fast_silu(float z) { return z * fast_sigmoid(z); }
constexpr float SS_SCALE = 16777216.0f;
__device__ __forceinline__ float inv_rms_from_val(unsigned long long v) {
    const float tot = (float)v * (1.0f / SS_SCALE);
    return 1.0f / sqrtf(tot * (1.0f / 2048.0f) + 1e-6f);
}
__device__ __forceinline__ u32x4 pack8(const f32x4 v0, const f32x4 v1) { u32x4 w; w.x = cvt_pk_bf16(v0[0], v0[1]); w.y = cvt_pk_bf16(v0[2], v0[3]); w.z = cvt_pk_bf16(v1[0], v1[1]); w.w = cvt_pk_bf16(v1[2], v1[3]); return w; }

struct InvTab {
    const PG8_LAS float* tab; int t0, t1, t2, t3; const unsigned long long* ss;
    __device__ __forceinline__ int slot(int pm) const { return pm == t0 ? 0 : (pm == t1 ? 1 : (pm == t2 ? 2 : (pm == t3 ? 3 : -1))); }
    __device__ __forceinline__ void get(float (&inv)[2][4], int pm, int r0) const {
        const int sl = slot(pm);
        if (sl >= 0) {
#pragma unroll
            for (int ai = 0; ai < 2; ++ai)
#pragma unroll
                for (int m = 0; m < 4; ++m) inv[ai][m] = tab[sl * BM + r0 + ai * HALF + m * 16];
        } else { unsigned long long sv[2][4];
#pragma unroll
            for (int ai = 0; ai < 2; ++ai)
#pragma unroll
                for (int m = 0; m < 4; ++m) sv[ai][m] = ss[pm * BM + r0 + ai * HALF + m * 16];
#pragma unroll
            for (int ai = 0; ai < 2; ++ai)
#pragma unroll
                for (int m = 0; m < 4; ++m) inv[ai][m] = inv_rms_from_val(sv[ai][m]); }
    }
};
template <class Sched> __device__ __forceinline__ InvTab inv_preload(PG8_LAS float* tab, const Sched& S, const unsigned long long* ss) {
    InvTab T; T.tab = tab; T.t0 = -1; T.t1 = -1; T.t2 = -1; T.t3 = -1; T.ss = ss; int n = 0; Unit u;
    for (int i = 0; S.next(i, u); ++i) {
        if (T.slot(u.pm) < 0 && n < 4) {
            if (threadIdx.x < BM) tab[n * BM + threadIdx.x] = inv_rms_from_val(ss[u.pm * BM + threadIdx.x]);
            if (n == 0) T.t0 = u.pm; else if (n == 1) T.t1 = u.pm; else if (n == 2) T.t2 = u.pm; else T.t3 = u.pm;
            ++n; } }
    __syncthreads();
    return T;
}
struct EpiSwiglu {
    static constexpr bool PERM = true, AFTER_DRAIN = false;
    bf16_t* O; int ldc; InvTab it;
    __device__ __forceinline__ void operator()(const f32x4 (&acc)[2][2][4][2], const Unit& u, int wr, int wc, int fr, int fq) const {
        const int row0 = u.pm * BM + wr * 64 + fr, col0 = u.pn * HALF + wc * 32 + 8 * fq;
        float invs[2][4]; it.get(invs, u.pm, wr * 64 + fr);
#pragma unroll
        for (int ai = 0; ai < 2; ++ai)
#pragma unroll
            for (int m = 0; m < 4; ++m) { const int row = row0 + ai * HALF + m * 16; const float inv = invs[ai][m], invn = inv * -1.44269504f;
                f32x4 o[2];
#pragma unroll
                for (int n = 0; n < 2; ++n) { const f32x4 g = acc[ai][0][m][n] * inv, up = acc[ai][1][m][n] * inv, t = acc[ai][0][m][n] * invn; f32x4 e, r;
#pragma unroll
                    for (int j = 0; j < 4; ++j) e[j] = __builtin_amdgcn_exp2f(t[j]);
                    const f32x4 d = e + 1.0f;
#pragma unroll
                    for (int j = 0; j < 4; ++j) r[j] = __builtin_amdgcn_rcpf(d[j]);
                    o[n] = (g * r) * up; }
                *(u32x4*)(O + (size_t)row * ldc + col0) = pack8(o[0], o[1]); }
    }
};
struct EpiResid {
    static constexpr bool PERM = true, AFTER_DRAIN = false;
    const float* rf; const bf16_t* rb; const float* rbg; float* out; bf16_t* ob; const float* gain; bf16_t* ob2; unsigned long long* ss; float alpha; int prb, pob, pob2;
    __device__ __forceinline__ void operator()(const f32x4 (&acc)[2][2][4][2], const Unit& u, int wr, int wc, int fr, int fq) const {
        const int row0 = u.pm * BM + wr * 64 + fr, col0 = u.pn * BM + wc * 32 + 8 * fq;
        f32x4 gi[2][2], go[2][2];
#pragma unroll
        for (int bj = 0; bj < 2; ++bj)
#pragma unroll
            for (int n = 0; n < 2; ++n) { gi[bj][n] = (f32x4){1.f, 1.f, 1.f, 1.f}; go[bj][n] = gi[bj][n];
                if (rbg) { const f32x4 t = *(const f32x4*)(rbg + col0 + bj * HALF + 4 * n); gi[bj][n] = (f32x4){1.0f / t[0], 1.0f / t[1], 1.0f / t[2], 1.0f / t[3]}; }
                if (ob) go[bj][n] = *(const f32x4*)(gain + col0 + bj * HALF + 4 * n); }
#pragma unroll
        for (int ai = 0; ai < 2; ++ai)
#pragma unroll
            for (int m = 0; m < 4; ++m) { const int row = row0 + ai * HALF + m * 16; const size_t off = (size_t)row * 2048 + col0, offr = (size_t)row * prb + col0, offo = (size_t)row * pob + col0, offo2 = (size_t)row * pob2 + col0; float s = 0.f;
#pragma unroll
                for (int bj = 0; bj < 2; ++bj) {
                    f32x4 r0, r1;
                    if (rf) { r0 = *(const f32x4*)(rf + off + bj * HALF); r1 = *(const f32x4*)(rf + off + bj * HALF + 4); }
                    else { const u32x4 w = *(const u32x4*)(rb + offr + bj * HALF);
                        r0 = (f32x4){__builtin_bit_cast(float, w.x << 16), __builtin_bit_cast(float, w.x & 0xffff0000u), __builtin_bit_cast(float, w.y << 16), __builtin_bit_cast(float, w.y & 0xffff0000u)} * gi[bj][0];
                        r1 = (f32x4){__builtin_bit_cast(float, w.z << 16), __builtin_bit_cast(float, w.z & 0xffff0000u), __builtin_bit_cast(float, w.w << 16), __builtin_bit_cast(float, w.w & 0xffff0000u)} * gi[bj][1]; }
                    const f32x4 o0 = r0 + acc[ai][bj][m][0] * alpha, o1 = r1 + acc[ai][bj][m][1] * alpha;
                    if (out) { *(f32x4*)(out + off + bj * HALF) = o0; *(f32x4*)(out + off + bj * HALF + 4) = o1; }
                    if (ob) *(u32x4*)(ob + offo + bj * HALF) = pack8(o0 * go[bj][0], o1 * go[bj][1]);
                    if (ob2) *(u32x4*)(ob2 + offo2 + bj * HALF) = pack8(o0, o1);
                    s += (o0[0] * o0[0] + o0[1] * o0[1]) + (o0[2] * o0[2] + o0[3] * o0[3]) + (o1[0] * o1[0] + o1[1] * o1[1]) + (o1[2] * o1[2] + o1[3] * o1[3]); }
                if (ss) { s += __shfl_xor(s, 16); s += __shfl_xor(s, 32);
                    if (fq == 0) atomicAdd(ss + row, (unsigned long long)(s * SS_SCALE + 0.5f)); } }
    }
};
struct EpiFinal {
    static constexpr bool PERM = true, AFTER_DRAIN = false;
    const bf16_t* rb; int prb; const float* rbg; const float* fgain; float* out; unsigned long long* ss; unsigned* cnt; unsigned* tmo; float alpha; unsigned npn;
    __device__ __forceinline__ void operator()(f32x4 (&acc)[2][2][4][2], const Unit& u, int wr, int wc, int fr, int fq) const {
        const int row0 = u.pm * BM + wr * 64 + fr, col0 = u.pn * BM + wc * 32 + 8 * fq;
        { f32x4 gi[2][2];
#pragma unroll
          for (int bj = 0; bj < 2; ++bj)
#pragma unroll
            for (int n = 0; n < 2; ++n) { const f32x4 t = *(const f32x4*)(rbg + col0 + bj * HALF + 4 * n); gi[bj][n] = (f32x4){1.0f / t[0], 1.0f / t[1], 1.0f / t[2], 1.0f / t[3]}; }
#pragma unroll
          for (int ai = 0; ai < 2; ++ai)
#pragma unroll
            for (int m = 0; m < 4; ++m) { const int row = row0 + ai * HALF + m * 16; const size_t offr = (size_t)row * prb + col0; float s = 0.f;
#pragma unroll
                for (int bj = 0; bj < 2; ++bj) { const u32x4 w = *(const u32x4*)(rb + offr + bj * HALF);
                    const f32x4 r0 = (f32x4){__builtin_bit_cast(float, w.x << 16), __builtin_bit_cast(float, w.x & 0xffff0000u), __builtin_bit_cast(float, w.y << 16), __builtin_bit_cast(float, w.y & 0xffff0000u)} * gi[bj][0];
                    const f32x4 r1 = (f32x4){__builtin_bit_cast(float, w.z << 16), __builtin_bit_cast(float, w.z & 0xffff0000u), __builtin_bit_cast(float, w.w << 16), __builtin_bit_cast(float, w.w & 0xffff0000u)} * gi[bj][1];
                    const f32x4 o0 = r0 + acc[ai][bj][m][0] * alpha, o1 = r1 + acc[ai][bj][m][1] * alpha; acc[ai][bj][m][0] = o0; acc[ai][bj][m][1] = o1;
                    s += (o0[0] * o0[0] + o0[1] * o0[1]) + (o0[2] * o0[2] + o0[3] * o0[3]) + (o1[0] * o1[0] + o1[1] * o1[1]) + (o1[2] * o1[2] + o1[3] * o1[3]); }
                s += __shfl_xor(s, 16); s += __shfl_xor(s, 32);
                if (fq == 0) atomicAdd(ss + row, (unsigned long long)(s * SS_SCALE + 0.5f)); } }
        asm volatile("s_waitcnt vmcnt(0)" ::: "memory"); __syncthreads();
        if (threadIdx.x == 0) { unsigned* c = cnt + u.pm;
            (void)__hip_atomic_fetch_add(c, 1u, __ATOMIC_RELAXED, __HIP_MEMORY_SCOPE_AGENT);
            unsigned sp = 0;
            while (__hip_atomic_load(c, __ATOMIC_RELAXED, __HIP_MEMORY_SCOPE_AGENT) < npn) { __builtin_amdgcn_s_sleep(1);
                if ((++sp & 255u) == 0u) { if (__hip_atomic_load(tmo, __ATOMIC_RELAXED, __HIP_MEMORY_SCOPE_AGENT)) break; if (sp > (1u << 18)) { atomicAdd(tmo, 1u); break; } } }
        }
        __syncthreads();
        f32x4 fg[2][2];
#pragma unroll
        for (int bj = 0; bj < 2; ++bj)
#pragma unroll
            for (int n = 0; n < 2; ++n) fg[bj][n] = *(const f32x4*)(fgain + col0 + bj * HALF + 4 * n);
#pragma unroll
        for (int ai = 0; ai < 2; ++ai)
#pragma unroll
            for (int m = 0; m < 4; ++m) { const int row = row0 + ai * HALF + m * 16; const size_t off = (size_t)row * 2048 + col0;
                const float inv = inv_rms_from_val(__hip_atomic_load(ss + row, __ATOMIC_RELAXED, __HIP_MEMORY_SCOPE_AGENT));
#pragma unroll
                for (int bj = 0; bj < 2; ++bj) { *(f32x4*)(out + off + bj * HALF) = acc[ai][bj][m][0] * inv * fg[bj][0]; *(f32x4*)(out + off + bj * HALF + 4) = acc[ai][bj][m][1] * inv * fg[bj][1]; } }
    }
};
struct EpiInProj {
    static constexpr bool PERM = true, AFTER_DRAIN = false;
    bf16_t* rkv; float* lin; bf16_t* hg; InvTab it; const PG8_LAS float* oml; int pn0;
    __device__ __forceinline__ void operator()(const f32x4 (&acc)[2][2][4][2], const Unit& u, int wr, int wc, int fr, int fq) const {
        const int row0 = u.pm * BM + wr * 64 + fr, cin = wc * 32 + 8 * fq;
        const int pn = u.pn + pn0;
        float invs[2][4]; it.get(invs, u.pm, wr * 64 + fr);
        int mode;
        if (pn < 12) mode = 0; else if (pn < 14) mode = 1; else { const int sg = (pn - 14) >> 2; mode = (sg == 0 || sg == 3) ? 2 : (sg == 1 ? 3 : 4); }
#pragma unroll
        for (int bj = 0; bj < 2; ++bj) {
            f32x4 om0 = (f32x4){0.f, 0.f, 0.f, 0.f}, om1 = om0;
            if (mode == 3) { const PG8_LAS float* lp = oml + (pn - 18) * BM + bj * HALF + cin; om0 = *(const PG8_LAS f32x4*)lp; om1 = *(const PG8_LAS f32x4*)(lp + 4); }
#pragma unroll
            for (int ai = 0; ai < 2; ++ai)
#pragma unroll
                for (int m = 0; m < 4; ++m) { const int row = row0 + ai * HALF + m * 16; const float inv = invs[ai][m];
                    f32x4 v0 = acc[ai][bj][m][0] * inv, v1 = acc[ai][bj][m][1] * inv;
                    if (mode == 0) { *(u32x4*)(rkv + (size_t)row * 3072 + pn * BM + bj * HALF + cin) = pack8(v0, v1); }
                    else if (mode == 1) { const int cl = (pn - 12) * BM + bj * HALF + cin;
                        if (cl < 288) { *(f32x4*)(lin + (size_t)row * 288 + cl) = v0; *(f32x4*)(lin + (size_t)row * 288 + cl + 4) = v1; } }
                    else {
                        if (mode == 2) {
#pragma unroll
                            for (int j = 0; j < 4; ++j) { v0[j] = fast_silu(v0[j]); v1[j] = fast_silu(v1[j]); } }
                        else if (mode == 3) {
#pragma unroll
                            for (int j = 0; j < 4; ++j) { v0[j] = __logf(1.0f - om0[j] * fast_sigmoid(-v0[j])); v1[j] = __logf(1.0f - om1[j] * fast_sigmoid(-v1[j])); } }
                        *(u32x4*)(hg + (size_t)row * 4096 + (pn - 14) * BM + bj * HALF + cin) = pack8(v0, v1); } } }
    }
};
struct EpiLora {
    static constexpr bool PERM = true, AFTER_DRAIN = false;
    bf16_t* lout; const PG8_LAS float* bias; int pn0;
    __device__ __forceinline__ void operator()(const f32x4 (&acc)[2][2][4][2], const Unit& u, int wr, int wc, int fr, int fq) const {
        const int row0 = u.pm * BM + wr * 64 + fr, cin = wc * 32 + 8 * fq;
        const int pn = u.pn + pn0, mode = pn >> 2;
#pragma unroll
        for (int bj = 0; bj < 2; ++bj) {
            f32x4 b0 = (f32x4){0.f, 0.f, 0.f, 0.f}, b1 = b0;
            if (mode < 2) { const PG8_LAS float* bp = bias + pn * BM + bj * HALF + cin; b0 = *(const PG8_LAS f32x4*)bp; b1 = *(const PG8_LAS f32x4*)(bp + 4); }
#pragma unroll
            for (int ai = 0; ai < 2; ++ai)
#pragma unroll
                for (int m = 0; m < 4; ++m) { const int row = row0 + ai * HALF + m * 16;
                    f32x4 v0 = acc[ai][bj][m][0] + b0, v1 = acc[ai][bj][m][1] + b1;
#pragma unroll
                    for (int j = 0; j < 4; ++j) { const float s0 = fast_sigmoid(v0[j]), s1 = fast_sigmoid(v1[j]);
                        const float d0 = -0.60653066f * s0, d1 = -0.60653066f * s1;
                        v0[j] = mode == 0 ? d0 : (mode == 1 ? s0 : v0[j]); v1[j] = mode == 0 ? d1 : (mode == 1 ? s1 : v1[j]); }
                    *(u32x4*)(lout + (size_t)row * 3072 + pn * BM + bj * HALF + cin) = pack8(v0, v1); asm volatile("" ::: "memory"); } }
    }
};
template <class Epi, class Sched, bool ALIGN_EPI = false, bool SP2 = false>
__device__ __forceinline__ void gemm_phase(PG8_LAS unsigned char* lds, const Gemm g, const Sched& S, const Epi& E) {
    const int tid = threadIdx.x, wid = __builtin_amdgcn_readfirstlane(tid >> 6), lane = tid & 63, wr = wid >> 2, wc = wid & 3, fr = lane & 15, fq = lane >> 4;
    const int K = g.K, nt = K / BK, lda = g.lda ? g.lda : g.K;
    unsigned voffA[2], voffB[2];
#pragma unroll
    for (int i = 0; i < 2; ++i) { int R, C; stage_rc(tid * 16 + i * 8192, R, C); const int Rb = Epi::PERM ? ((R & ~31) + perm32(R & 31)) : R;
        voffA[i] = (unsigned)(R * lda + C) * 2u; voffB[i] = (unsigned)(Rb * K + C) * 2u; }
    const size_t kstep = (size_t)(BK * 2);
    const size_t hstep = (size_t)HALF * K * 2, hstepA = (size_t)HALF * lda * 2;
    const size_t tstep = 2 * hstep, tstepA = 2 * hstepA;
    const unsigned ldsw = (unsigned)wid * 1024u;
    const int aoff = lds_byte(wr * 64 + fr, fq * 8), boff = lds_byte(wc * 32 + fr, fq * 8);
#define PG8_SA(b, h) (((b) * 2 + (h)) * HTB)
#define PG8_SB(b, h) ((4 + (b) * 2 + (h)) * HTB)
#define PG8_STAGE(bufoff, gbase, voff) do { _Pragma("unroll") for (int _i = 0; _i < 2; ++_i) \
        __builtin_amdgcn_global_load_lds((const unsigned*)((const char*)(gbase) + (voff)[_i]), (PG8_LAS unsigned*)(lds + (bufoff) + ldsw + _i * 8192), 16, 0, 0); } while (0)
#define PG8_LDA(dst, b, h) do { _Pragma("unroll") for (int m = 0; m < 4; ++m) _Pragma("unroll") for (int k = 0; k < 2; ++k) dst[m][k] = *(const PG8_LAS bf16x8*)(lds + PG8_SA(b, h) + aoff + m * 2048 + k * 1024); } while (0)
#define PG8_LDB(dst, b, h) do { _Pragma("unroll") for (int n = 0; n < 2; ++n) _Pragma("unroll") for (int k = 0; k < 2; ++k) dst[n][k] = *(const PG8_LAS bf16x8*)(lds + PG8_SB(b, h) + boff + n * 2048 + k * 1024); } while (0)
#define PG8_MMA(ai, bj, At, Bt) do { __builtin_amdgcn_s_setprio(1); _Pragma("unroll") for (int k = 0; k < 2; ++k) _Pragma("unroll") for (int m = 0; m < 4; ++m) _Pragma("unroll") for (int n_ = 0; n_ < 2; ++n_) { const int n = (m & 1) ? 1 - n_ : n_; \
        acc[ai][bj][m][n] = __builtin_amdgcn_mfma_f32_16x16x32_bf16(Bt[n][k], At[m][k], acc[ai][bj][m][n], 0, 0, 0); PG8_SCHED; } __builtin_amdgcn_s_setprio(0); } while (0)
#define PG8_MMA2(ai, At, B0, B1) do { __builtin_amdgcn_s_setprio(1); _Pragma("unroll") for (int k = 0; k < 2; ++k) _Pragma("unroll") for (int s_ = 0; s_ < 16; ++s_) { \
        constexpr int HM[16] = {0, 0, 1, 1, 1, 1, 0, 0, 2, 2, 3, 3, 3, 3, 2, 2}, HQ[16] = {0, 1, 1, 0, 2, 3, 3, 2, 2, 3, 3, 2, 1, 0, 0, 1}; \
        const int m = HM[s_], q = HQ[s_], bj = q >> 1, n = q & 1; \
        acc[ai][bj][m][n] = __builtin_amdgcn_mfma_f32_16x16x32_bf16(bj ? B1[n][k] : B0[n][k], At[m][k], acc[ai][bj][m][n], 0, 0, 0); PG8_SCHED; } __builtin_amdgcn_s_setprio(0); } while (0)
#define PG8_WAIT_V(n) asm volatile("s_waitcnt vmcnt(" #n ")" ::: "memory")
#define PG8_WAIT_L(n) asm volatile("s_waitcnt lgkmcnt(" #n ")" ::: "memory")
#define PG8_BAR __builtin_amdgcn_s_barrier()
#define PG8_SCHED __builtin_amdgcn_sched_barrier(0)
    Unit cur, nxt; int ui = 0;
    if (!S.next(0, cur)) return;
    f32x4 acc[2][2][4][2];
#pragma unroll
    for (int a = 0; a < 2; ++a)
#pragma unroll
        for (int b = 0; b < 2; ++b)
#pragma unroll
            for (int m = 0; m < 4; ++m)
#pragma unroll
                for (int n = 0; n < 2; ++n) acc[a][b][m][n] = (f32x4){0.f, 0.f, 0.f, 0.f};
    bf16x8 At[4][2], B0[2][2], B1[2][2];
    const char* cA = (const char*)g.A + (size_t)cur.pm * tstepA; const char* cB = (const char*)g.Bt + (size_t)cur.pn * tstep;
    S.a_ready(cur);
    if constexpr (SP2) {
        PG8_STAGE(PG8_SB(0, 0), cB, voffB); PG8_STAGE(PG8_SB(0, 1), cB + hstep, voffB); PG8_STAGE(PG8_SA(0, 0), cA, voffA); PG8_STAGE(PG8_SA(0, 1), cA + hstepA, voffA);
        if (wr == 1) PG8_BAR;
        PG8_WAIT_V(2); PG8_BAR;
        PG8_STAGE(PG8_SB(1, 0), cB + kstep, voffB); PG8_STAGE(PG8_SA(1, 0), cA + kstep, voffA); PG8_STAGE(PG8_SB(1, 1), cB + hstep + kstep, voffB);
        PG8_WAIT_V(6); PG8_BAR;
    } else {
        PG8_STAGE(PG8_SB(0, 0), cB, voffB); PG8_STAGE(PG8_SA(0, 0), cA, voffA); PG8_STAGE(PG8_SB(0, 1), cB + hstep, voffB); PG8_STAGE(PG8_SA(0, 1), cA + hstepA, voffA);
        if (wr == 1) PG8_BAR;
        PG8_WAIT_V(4); PG8_BAR;
        PG8_STAGE(PG8_SB(1, 0), cB + kstep, voffB); PG8_STAGE(PG8_SA(1, 0), cA + kstep, voffA); PG8_STAGE(PG8_SB(1, 1), cB + hstep + kstep, voffB);
        PG8_WAIT_V(6); PG8_BAR;
    }
    for (;;) {
        const bool has_next = S.next(ui + 1, nxt);
        const char* nA = has_next ? (const char*)g.A + (size_t)nxt.pm * tstepA : cA; const char* nB = has_next ? (const char*)g.Bt + (size_t)nxt.pn * tstep : cB;
        for (int t = 0; t < nt; t += 2) {
            const bool last = (t == nt - 2);
            const char* a1 = cA + (size_t)(t + 1) * kstep;
            const char* a2 = last ? nA : cA + (size_t)(t + 2) * kstep; const char* b2 = last ? nB : cB + (size_t)(t + 2) * kstep;
            const char* a3 = a2 + kstep; const char* b3 = b2 + kstep;
            if (last && has_next) S.a_ready(nxt);
            if constexpr (SP2) {
            PG8_LDB(B0, 0, 0); PG8_LDB(B1, 0, 1); PG8_SCHED; PG8_LDA(At, 0, 0); PG8_STAGE(PG8_SA(1, 1), a1 + hstepA, voffA);
            PG8_WAIT_V(8); PG8_WAIT_L(0); PG8_BAR; PG8_MMA2(0, At, B0, B1); PG8_BAR; PG8_SCHED;
            PG8_LDA(At, 0, 1); PG8_STAGE(PG8_SB(0, 0), b2, voffB); PG8_STAGE(PG8_SB(0, 1), b2 + hstep, voffB); PG8_STAGE(PG8_SA(0, 0), a2, voffA);
            PG8_WAIT_V(8); PG8_WAIT_L(0); PG8_BAR; PG8_MMA2(1, At, B0, B1); PG8_BAR; PG8_SCHED;
            PG8_LDB(B0, 1, 0); PG8_LDB(B1, 1, 1); PG8_SCHED; PG8_LDA(At, 1, 0); PG8_STAGE(PG8_SA(0, 1), a2 + hstepA, voffA);
            PG8_WAIT_V(8); PG8_WAIT_L(0); PG8_BAR; PG8_MMA2(0, At, B0, B1); PG8_BAR; PG8_SCHED;
            PG8_LDA(At, 1, 1); PG8_STAGE(PG8_SB(1, 0), b3, voffB); PG8_STAGE(PG8_SB(1, 1), b3 + hstep, voffB); PG8_STAGE(PG8_SA(1, 0), a3, voffA);
            PG8_WAIT_V(8); PG8_WAIT_L(0); PG8_BAR; PG8_MMA2(1, At, B0, B1); PG8_BAR; PG8_SCHED;
            } else {
            PG8_LDB(B0, 0, 0); PG8_SCHED; PG8_LDA(At, 0, 0); PG8_STAGE(PG8_SA(1, 1), a1 + hstepA, voffA);
            PG8_WAIT_L(8); PG8_BAR; PG8_WAIT_L(0); PG8_MMA(0, 0, At, B0); PG8_BAR; PG8_SCHED;
            PG8_LDB(B1, 0, 1); PG8_STAGE(PG8_SB(0, 0), b2, voffB);
            PG8_BAR; PG8_WAIT_L(0); PG8_MMA(0, 1, At, B1); PG8_BAR;
            PG8_LDA(At, 0, 1); PG8_STAGE(PG8_SA(0, 0), a2, voffA);
            PG8_BAR; PG8_WAIT_L(0); PG8_MMA(1, 0, At, B0); PG8_BAR; PG8_SCHED;
            PG8_STAGE(PG8_SB(0, 1), b2 + hstep, voffB);
            PG8_WAIT_V(6); PG8_BAR; PG8_MMA(1, 1, At, B1); PG8_BAR;
            PG8_LDB(B0, 1, 0); PG8_SCHED; PG8_LDA(At, 1, 0); PG8_STAGE(PG8_SA(0, 1), a2 + hstepA, voffA);
            PG8_WAIT_L(8); PG8_BAR; PG8_WAIT_L(0); PG8_MMA(0, 0, At, B0); PG8_BAR; PG8_SCHED;
            PG8_LDB(B1, 1, 1); PG8_STAGE(PG8_SB(1, 0), b3, voffB);
            PG8_BAR; PG8_WAIT_L(0); PG8_MMA(0, 1, At, B1); PG8_BAR;
            PG8_LDA(At, 1, 1); PG8_STAGE(PG8_SA(1, 0), a3, voffA);
            PG8_BAR; PG8_WAIT_L(0); PG8_MMA(1, 0, At, B0); PG8_BAR; PG8_SCHED;
            PG8_STAGE(PG8_SB(1, 1), b3 + hstep, voffB);
            PG8_WAIT_V(6); PG8_BAR; PG8_MMA(1, 1, At, B1); PG8_BAR;
            }
        }
        if constexpr (ALIGN_EPI) { if (wr == 0) PG8_BAR; }
        if constexpr (!Epi::AFTER_DRAIN) { E(acc, cur, wr, wc, fr, fq); S.done(cur); }
        if (!has_next) break;
#pragma unroll
        for (int a = 0; a < 2; ++a)
#pragma unroll
            for (int b = 0; b < 2; ++b)
#pragma unroll
                for (int m = 0; m < 4; ++m)
#pragma unroll
                    for (int n = 0; n < 2; ++n) acc[a][b][m][n] = (f32x4){0.f, 0.f, 0.f, 0.f};
        cur = nxt; cA = nA; cB = nB; ++ui;
        if constexpr (ALIGN_EPI) { if (wr == 1) PG8_BAR; }
    }
    PG8_WAIT_V(0);
    if constexpr (!ALIGN_EPI) { if (wr == 0) PG8_BAR; }
    PG8_BAR;
    if constexpr (Epi::AFTER_DRAIN) { E.fused(acc, cur, wr, wc, fr, fq, lds, wid, lane); S.done(cur); }
#undef PG8_SA
#undef PG8_SB
#undef PG8_STAGE
#undef PG8_LDA
#undef PG8_LDB
#undef PG8_MMA
#undef PG8_WAIT_V
#undef PG8_WAIT_L
#undef PG8_BAR
#undef PG8_SCHED
}
}

constexpr int NWAVES = 8;
constexpr int BATCH = 4, SEQ = 8192, D = 2048, M = BATCH * SEQ, FF = 5632;
constexpr int RC = 1024, RH = 16, RN = 64;
constexpr int HC = 1024, HH = 8, HD = 128;
constexpr int RWKV_COLS = 3360, IN_COLS = 7456, NIN = 7680;
constexpr int KL = 384, NL = 3072;
#ifndef MK_N_LAUNCHES
#define MK_N_LAUNCHES 1
#endif
constexpr int N_PHASES = 12;

constexpr size_t WS_CTL = 0, CTL_BYTES = 1u << 20;
constexpr size_t WS_W1GU = CTL_BYTES;
constexpr size_t WS_W1D = WS_W1GU + (size_t)2 * FF * D * 2;
constexpr size_t WS_WIN = WS_W1D + (size_t)D * FF * 2;
constexpr size_t WS_WLORA = WS_WIN + (size_t)NIN * D * 2;
constexpr size_t WS_WOUT = WS_WLORA + (size_t)NL * KL * 2;
constexpr size_t WS_W2GU = WS_WOUT + (size_t)D * D * 2;
constexpr size_t WS_W2D = WS_W2GU + (size_t)2 * FF * D * 2;
constexpr size_t WS_SS = WS_W2D + (size_t)D * FF * 2;
constexpr size_t WS_XB = WS_SS + (1u << 20);
constexpr size_t WS_R = WS_XB + (size_t)M * D * 2;
constexpr size_t R_ACT = 0;
constexpr size_t R_RKV = 0;
constexpr size_t R_HG = R_RKV + (size_t)M * 3072 * 2;
constexpr size_t R_LIN = R_HG + (size_t)M * 4096 * 2;
constexpr size_t R_BYTES = R_LIN + (size_t)M * 288 * 4;
constexpr size_t WS_ALORA = WS_R + R_BYTES;
constexpr size_t WS_LOUT = WS_ALORA + (size_t)M * KL * 2;
constexpr size_t WS_INVN = WS_LOUT + (size_t)M * NL * 2;
constexpr size_t WS_END = WS_INVN + (size_t)M * RH * 4;
static_assert(WS_END <= ((size_t)1 << 30), "d_ws map");
constexpr int CW_PCNT = 8704;
constexpr int CW_SIG_HALF = 8192, CW_SIG_SHA = 8256, CW_SIG_SHB = 8320, CW_SIG_P4 = 8384, CW_SIG_H2 = 8448;
constexpr int CW_BAR = 4096;

constexpr int RING_BYTES = 162816;
constexpr int LDSCTL_OFF = RING_BYTES, MISC_OFF = LDSCTL_OFF + 320;
constexpr int LDS_BYTES = 163840;
static_assert(MISC_OFF + 128 <= LDS_BYTES, "LDS map");

#define GAS __attribute__((address_space(1)))
#define LAS __attribute__((address_space(3)))
typedef unsigned short bf16;
typedef unsigned v4u __attribute__((ext_vector_type(4)));
typedef unsigned v2u __attribute__((ext_vector_type(2)));
typedef float f32x4 __attribute__((ext_vector_type(4)));
#define LDS_WAIT() asm volatile("s_waitcnt lgkmcnt(0)" ::: "memory")
#define VM_WAIT() asm volatile("s_waitcnt vmcnt(0)" ::: "memory")
__device__ __forceinline__ float bflo(unsigned u) { return __builtin_bit_cast(float, u << 16); }
__device__ __forceinline__ float bfhi(unsigned u) { return __builtin_bit_cast(float, u & 0xffff0000u); }
__device__ __forceinline__ f32x4 unpack4(v2u w) { return (f32x4){bflo(w.x), bfhi(w.x), bflo(w.y), bfhi(w.y)}; }
__device__ __forceinline__ unsigned pk2(float lo, float hi) { return pg8::cvt_pk_bf16(lo, hi); }
__device__ __forceinline__ v2u pack4(f32x4 v) { v2u w; w.x = pk2(v[0], v[1]); w.y = pk2(v[2], v[3]); return w; }
using pg8::fast_sigmoid;
using pg8::fast_silu;
template <int CTRL> __device__ __forceinline__ float dpp_mov(float x) { return __builtin_bit_cast(float, __builtin_amdgcn_update_dpp(0, __builtin_bit_cast(int, x), CTRL, 0xF, 0xF, true)); }
__device__ __forceinline__ float row16_sum(float x) { x += dpp_mov<0x128>(x); x += dpp_mov<0x124>(x); x += dpp_mov<0x122>(x); x += dpp_mov<0x121>(x); return x; }
template <int CTRL, int BANK> __device__ __forceinline__ float dpp_upd(float old, float x) { return __builtin_bit_cast(float, __builtin_amdgcn_update_dpp(__builtin_bit_cast(int, old), __builtin_bit_cast(int, x), CTRL, 0xF, BANK, false)); }
__device__ __forceinline__ float tr_reduce16(const float (&v)[16], int lane) {
    float u[8], w[4], x[2];
#pragma unroll
    for (int s = 0; s < 8; ++s) { const float t = v[s + 8] + dpp_mov<0x128>(v[s + 8]), a = v[s] + dpp_mov<0x128>(v[s]); u[s] = dpp_upd<0xE4, 0x3>(t, a); }
#pragma unroll
    for (int s = 0; s < 4; ++s) { const float t = u[s + 4] + dpp_mov<0x141>(u[s + 4]), a = u[s] + dpp_mov<0x141>(u[s]); w[s] = dpp_upd<0xE4, 0x5>(t, a); }
    const bool b1 = (lane & 2) != 0, b0 = (lane & 1) != 0;
#pragma unroll
    for (int s = 0; s < 2; ++s) { const float K = b1 ? w[s + 2] : w[s], T = b1 ? w[s] : w[s + 2]; x[s] = K + dpp_mov<0x1B>(T); }
    const float K = b0 ? x[1] : x[0], T = b0 ? x[0] : x[1];
    return K + dpp_mov<0xB1>(T);
}
typedef float f32x2 __attribute__((ext_vector_type(2)));
#define LO2(v) __builtin_shufflevector(v, v, 0, 1)
#define HI2(v) __builtin_shufflevector(v, v, 2, 3)
__device__ __forceinline__ float wave_sum(float v) {
#pragma unroll
    for (int o = 1; o < 64; o <<= 1) v += __shfl_xor(v, o);
    return v;
}
#define XB_TMO      128
#define XB_XCNT(j)  (256  + 64 * (j))
#define XB_XSUB(j)  (1280 + 64 * (j))
#define XB_XGEN(j)  (2304 + 64 * (j))
#define XB_TOP      3328
#define XB_TOPGEN   3392
#define XCD_BAR_WORDS 3456
#define XB_SPIN_CAP (1u << 18)

__device__ __forceinline__ unsigned xb_ld(unsigned* p)              { return __hip_atomic_load(p, __ATOMIC_RELAXED, __HIP_MEMORY_SCOPE_AGENT); }
__device__ __forceinline__ unsigned xb_add(unsigned* p, unsigned v) { return __hip_atomic_fetch_add(p, v, __ATOMIC_RELAXED, __HIP_MEMORY_SCOPE_AGENT); }
__device__ __forceinline__ unsigned xb_xcc_id() { return (unsigned)__builtin_amdgcn_s_getreg((3 << 11) | 20) & 0xFu; }
#define XB_SPIN(cond, bar) do { unsigned _sp = 0; while (cond) { __builtin_amdgcn_s_sleep(1); \
    if ((++_sp & 255u) == 0u) { if (xb_ld(&(bar)[XB_TMO])) break; if (_sp > XB_SPIN_CAP) { atomicAdd(&(bar)[XB_TMO], 1u); break; } } } } while (0)

struct XcdBarrier {
    unsigned* bar; unsigned x;
    volatile LAS unsigned* st;
};

__device__ __forceinline__ XcdBarrier xcd_barrier_post(unsigned* bar, volatile LAS unsigned* st) {
    XcdBarrier b; b.bar = bar; b.x = xb_xcc_id(); b.st = st;
    if (threadIdx.x == 0) (void)xb_add(&bar[XB_XCNT(b.x)], 1u);
    return b;
}
__device__ __forceinline__ void xcd_barrier_complete(unsigned* bar, unsigned x, unsigned& nloc, unsigned& nx) {
    const unsigned G = gridDim.x * gridDim.y * gridDim.z;
    unsigned sum, cnt, mine, sp = 0u;
    for (;;) {
        sum = 0u; cnt = 0u; mine = 0u;
#pragma unroll
        for (unsigned j = 0; j < 16; ++j) { const unsigned c = xb_ld(&bar[XB_XCNT(j)]); sum += c; cnt += (c > 0u) ? 1u : 0u; mine = (j == x) ? c : mine; }
        if (sum == G) break;
        __builtin_amdgcn_s_sleep(1);
        if ((++sp & 255u) == 0u) { if (xb_ld(&bar[XB_TMO])) break; if (sp > XB_SPIN_CAP) { atomicAdd(&bar[XB_TMO], 1u); break; } }
    }
    nloc = mine > 0u ? mine : 1u; nx = cnt > 0u ? cnt : 1u;
}

__device__ __forceinline__ void xcd_barrier(const XcdBarrier& b) {
    asm volatile("s_waitcnt vmcnt(0)" ::: "memory");
    __syncthreads();
    if (threadIdx.x == 0) {
        unsigned* bar = b.bar;
        __builtin_amdgcn_s_waitcnt(0);
        unsigned nloc = b.st[0], nx = b.st[1];
        if (nloc == 0u) { xcd_barrier_complete(bar, b.x, nloc, nx); b.st[0] = nloc; b.st[1] = nx; }
        const unsigned old = xb_add(&bar[XB_XSUB(b.x)], 1u);
        const unsigned gen = old / nloc;
        if (old + 1u == (gen + 1u) * nloc) {
            __builtin_amdgcn_fence(__ATOMIC_RELEASE, "agent");
            asm volatile("s_waitcnt vmcnt(0)" ::: "memory");
            const unsigned og = xb_add(&bar[XB_TOP], 1u);
            const unsigned tg = og / nx;
            if (og + 1u == (tg + 1u) * nx) xb_add(&bar[XB_TOPGEN], 1u);
            else XB_SPIN(xb_ld(&bar[XB_TOPGEN]) == tg, bar);
            __builtin_amdgcn_fence(__ATOMIC_ACQUIRE, "agent");
            xb_add(&bar[XB_XGEN(b.x)], 1u);
            asm volatile("s_waitcnt vmcnt(0)" ::: "memory");
        } else {
            XB_SPIN(xb_ld(&bar[XB_XGEN(b.x)]) == gen, bar);
            __builtin_amdgcn_fence(__ATOMIC_ACQUIRE, "agent");
            asm volatile("s_waitcnt vmcnt(0)" ::: "memory");
        }
    }
    __syncthreads();
}

__device__ __forceinline__ void sig_post(unsigned* ctr) {
    __builtin_amdgcn_fence(__ATOMIC_RELEASE, "agent"); asm volatile("s_waitcnt vmcnt(0)" ::: "memory"); (void)xb_add(ctr, 1u);
}
__device__ __forceinline__ void wg_signal(unsigned* ctr) {
    asm volatile("s_waitcnt vmcnt(0)" ::: "memory"); __syncthreads();
    if (threadIdx.x == 0) sig_post(ctr);
}
__device__ __forceinline__ void wg_wait(unsigned* ctr, unsigned target, unsigned* bar) {
    if (threadIdx.x == 0) { XB_SPIN(xb_ld(ctr) < target, bar); __builtin_amdgcn_fence(__ATOMIC_ACQUIRE, "agent"); asm volatile("s_waitcnt vmcnt(0)" ::: "memory"); }
    __syncthreads();
}

struct Frame {
    LAS unsigned char* lds;
    int tid, lane, wave, vcu, G;
    const float* in[26];
    float* out; unsigned char* ws;
};
#define WSP(T, off) ((T*)(F.ws + (off)))
struct Args { const float* in[26]; float* out; unsigned char* ws; int ph_lo, ph_hi; };

struct P0Item { const float* W; bf16* WT; int K, N, kb, n0, drow0; };
__device__ __forceinline__ int map_gu(int n0, int which) { return (n0 >> 7) * 256 + which * 128 + (n0 & 127); }
constexpr int P0_I_GU = (D / 64) * (FF / 32), P0_I_DN = (FF / 64) * (D / 32), P0_I_IN = (D / 64) * (IN_COLS / 32), P0_I_OUT = (D / 64) * (D / 32);
constexpr int P0_N0 = 2 * P0_I_GU + P0_I_DN + P0_I_IN, P0_N1 = 2 * P0_I_GU + P0_I_DN + P0_I_OUT;
template <int SET> __device__ __forceinline__ P0Item p0_decode(Frame& F, const Args& A, int it) {
    constexpr int I_GU = P0_I_GU, I_DN = P0_I_DN, I_IN = P0_I_IN;
    P0Item p; int r = it;
    if (SET == 0) { if (r >= 2 * I_GU) r += 2 * I_GU; if (r >= 4 * I_GU + I_DN) r += I_DN; }
    else { r += 2 * I_GU; if (r >= 4 * I_GU) r += I_DN; if (r >= 4 * I_GU + 2 * I_DN) r += I_IN; }
    if (r < 4 * I_GU) { const int mat = r / I_GU; r -= mat * I_GU; const int nblk = FF / 32, ffn = mat >> 1, which = mat & 1;
        p.W = A.in[2 + 20 * ffn + which]; p.WT = WSP(bf16, ffn ? WS_W2GU : WS_W1GU); p.K = D; p.N = FF; p.kb = r / nblk; p.n0 = 32 * (r % nblk); p.drow0 = map_gu(p.n0, which); return p; }
    r -= 4 * I_GU;
    if (r < 2 * I_DN) { const int ffn = r / I_DN; r -= ffn * I_DN; const int nblk = D / 32;
        p.W = A.in[4 + 20 * ffn]; p.WT = WSP(bf16, ffn ? WS_W2D : WS_W1D); p.K = FF; p.N = D; p.kb = r / nblk; p.n0 = 32 * (r % nblk); p.drow0 = p.n0; return p; }
    r -= 2 * I_DN;
    if (r < I_IN) { const int nblk = IN_COLS / 32;
        p.W = A.in[6]; p.WT = WSP(bf16, WS_WIN); p.K = D; p.N = IN_COLS; p.kb = r / nblk; p.n0 = 32 * (r % nblk); p.drow0 = p.n0 < RWKV_COLS ? p.n0 : p.n0 + 224; return p; }
    r -= I_IN;
    { const int nblk = D / 32; p.W = A.in[20]; p.WT = WSP(bf16, WS_WOUT); p.K = D; p.N = D; p.kb = r / nblk; p.n0 = 32 * (r % nblk); p.drow0 = p.n0; return p; }
}
__device__ __forceinline__ void p0_dma(const P0Item& p, LAS unsigned char* tile, int lane) {
    const int half = lane >> 5, sl = lane & 31;
#pragma unroll 8
    for (int i = 0; i < 32; ++i) { const int kk = 2 * i + half;
        __builtin_amdgcn_global_load_lds((const GAS unsigned*)(p.W + (size_t)(64 * p.kb + kk) * p.N + p.n0 + (sl ^ (4 * (kk >> 3)))), (LAS unsigned*)(tile + i * 256), 4, 0, 0); }
}
__device__ __forceinline__ void p0_emit(const P0Item& p, const LAS float* t, int lane) {
    const int c = lane & 7;
#pragma unroll
    for (int j = 0; j < 4; ++j) { const int n = (lane >> 3) + 8 * j; const LAS float* s = t + (8 * c) * 32 + (n ^ (4 * c));
        v4u o; o.x = pk2(s[0 * 32], s[1 * 32]); o.y = pk2(s[2 * 32], s[3 * 32]); o.z = pk2(s[4 * 32], s[5 * 32]); o.w = pk2(s[6 * 32], s[7 * 32]);
        *(GAS v4u*)(p.WT + (size_t)(p.drow0 + n) * p.K + 64 * p.kb + 8 * c) = o; }
}
template <int SET> __device__ __forceinline__ void p0_transposes(Frame& F, const Args& A, int gw, int NGW) {
    LAS unsigned char* tiles = F.lds + F.wave * 16384;
    constexpr int NITEMS = SET == 0 ? P0_N0 : P0_N1;
    if (gw < NITEMS) {
        P0Item cur = p0_decode<SET>(F, A, gw); int buf = 0;
        p0_dma(cur, tiles, F.lane);
        for (int it = gw; it < NITEMS; it += NGW) {
            const bool more = it + NGW < NITEMS; P0Item nxt = cur;
            if (more) { nxt = p0_decode<SET>(F, A, it + NGW); p0_dma(nxt, tiles + (buf ^ 1) * 8192, F.lane); asm volatile("s_waitcnt vmcnt(32)" ::: "memory"); }
            else asm volatile("s_waitcnt vmcnt(0)" ::: "memory");
            p0_emit(cur, (const LAS float*)(tiles + buf * 8192), F.lane);
            LDS_WAIT(); asm volatile("" ::: "memory");
            cur = nxt; buf ^= 1;
        }
        asm volatile("s_waitcnt vmcnt(0)" ::: "memory");
    }
}
__device__ __forceinline__ void p0_prologue(Frame& F, const Args& A) {
    const int gw = F.vcu * NWAVES + F.wave, NGW = F.G * NWAVES;
    p0_transposes<0>(F, A, gw, NGW);
    const size_t gt = (size_t)F.vcu * (NWAVES * 64) + F.tid, NT = (size_t)F.G * NWAVES * 64;
    { GAS v4u* z = (GAS v4u*)(WSP(bf16, WS_WIN) + (size_t)RWKV_COLS * D);
      for (size_t i = gt; i < (size_t)224 * D * 2 / 16; i += NT) z[i] = (v4u){0u, 0u, 0u, 0u}; }
    { bf16* wl = WSP(bf16, WS_WLORA); const float* w2 = F.in[9]; const float* a2 = F.in[11]; const float* g2 = F.in[12];
      for (size_t i = gt; i < (size_t)NL * KL / 2; i += NT) { const int n = (int)(i / (KL / 2)), k = 2 * (int)(i % (KL / 2)); const int seg = n >> 10, c = n & 1023;
          float v0 = 0.f, v1 = 0.f;
          if (seg == 0) { if (k < 64) { v0 = w2[(size_t)k * RC + c]; v1 = w2[(size_t)(k + 1) * RC + c]; } }
          else if (seg == 1) { if (k >= 64 && k < 128) { v0 = a2[(size_t)(k - 64) * RC + c]; v1 = a2[(size_t)(k - 63) * RC + c]; } }
          else { if (k >= 128 && k < 288) { v0 = g2[(size_t)(k - 128) * RC + c]; v1 = g2[(size_t)(k - 127) * RC + c]; } }
          ((GAS unsigned*)wl)[i] = pk2(v0, v1); } }
    { GAS unsigned long long* s = (GAS unsigned long long*)(F.ws + WS_SS) + M;
      for (size_t i = gt; i < (size_t)3 * M; i += NT) s[i] = 0ull; }
    { const float* x = F.in[0]; bf16* xb = WSP(bf16, WS_XB); unsigned long long* ss0 = WSP(unsigned long long, WS_SS);
      for (int m = gw; m < M; m += NGW) { const GAS f32x4* xr = (const GAS f32x4*)(x + (size_t)m * D) + 2 * F.lane; GAS v4u* o = (GAS v4u*)(xb + (size_t)m * D) + F.lane; float s = 0.f;
#pragma unroll
          for (int j = 0; j < 4; ++j) { const f32x4 a = xr[128 * j], b = xr[128 * j + 1];
              s += (a[0] * a[0] + a[1] * a[1]) + (a[2] * a[2] + a[3] * a[3]) + (b[0] * b[0] + b[1] * b[1]) + (b[2] * b[2] + b[3] * b[3]);
              const f32x4 ga = *(const f32x4*)(F.in[1] + 8 * F.lane + 512 * j), gb = *(const f32x4*)(F.in[1] + 8 * F.lane + 512 * j + 4);
              o[64 * j] = pg8::pack8(a * ga, b * gb); }
          s = wave_sum(s);
          if (F.lane == 0) ss0[m] = (unsigned long long)(s * pg8::SS_SCALE + 0.5f); } }
}

__device__ __forceinline__ void p4_lora_in(Frame& F, int hsel, int c, int G) {
    const int NR = hsel < 0 ? M : M / 2;
#define P4_ROW(i_) (hsel < 0 ? (i_) : ((i_) / (SEQ / 2)) * SEQ + ((i_) % (SEQ / 2)) + hsel * (SEQ / 2))
    const float* lin = WSP(float, WS_R + R_LIN); bf16* al = WSP(bf16, WS_ALORA); const float* mu = F.in[7] + 3 * RC;
    const size_t gt = (size_t)c * (NWAVES * 64) + F.tid, NT = (size_t)G * NWAVES * 64;
#pragma unroll 4
    for (size_t i = gt; i < (size_t)NR * 96; i += NT) { const int mi = (int)(i / 96), m = P4_ROW(mi), q = (int)(i % 96), qc = q < 72 ? q : 0; const bool first = (m & (SEQ - 1)) == 0;
        const f32x4 p = *(const GAS f32x4*)(lin + (size_t)m * 288 + 4 * qc), pr = *(const GAS f32x4*)(lin + (size_t)(first ? m : m - 1) * 288 + 4 * qc), mv = *(const GAS f32x4*)(mu + 4 * qc);
        const f32x4 pp = first ? (f32x4){0.f, 0.f, 0.f, 0.f} : pr; f32x4 s = p + (pp - p) * mv;
#pragma unroll
        for (int j = 0; j < 4; ++j) { const float sg = fast_sigmoid(q < 16 ? 2.0f * s[j] : s[j]); s[j] = q < 16 ? 2.0f * sg - 1.0f : (q >= 32 ? sg : s[j]); }
        v2u o = pack4(s); if (q >= 72) o = (v2u){0u, 0u};
        *(GAS v2u*)(al + (size_t)m * KL + 4 * q) = o; }
    { const bf16* rkv = WSP(bf16, WS_R + R_RKV); float* invn = WSP(float, WS_INVN); const int j4 = (F.tid & 15) * 4;
      const size_t it0 = gt >> 4, step = NT >> 4; const int h = (int)(it0 & 15), ch = h * RN + j4;
      const f32x4 muk = *(const f32x4*)(F.in[7] + RC + ch), kkc = *(const f32x4*)(F.in[13] + ch);
      if ((step & 15) == 0) {
#pragma unroll 4
          for (size_t it = it0; it < (size_t)NR * RH; it += step) { const int mi = (int)(it >> 4), m = P4_ROW(mi); const bool first = (m & (SEQ - 1)) == 0;
              const f32x4 k = unpack4(*(const GAS v2u*)(rkv + (size_t)m * 3072 + RC + ch)), kr = unpack4(*(const GAS v2u*)(rkv + (size_t)(first ? m : m - 1) * 3072 + RC + ch));
              const f32x4 kp = first ? (f32x4){0.f, 0.f, 0.f, 0.f} : kr;
              const f32x4 kk = (k + (kp - k) * muk) * kkc; float s2 = (kk[0] * kk[0] + kk[1] * kk[1]) + (kk[2] * kk[2] + kk[3] * kk[3]); s2 = row16_sum(s2);
              if ((F.tid & 15) == 0) invn[(size_t)m * RH + h] = 1.0f / fmaxf(sqrtf(s2), 1e-12f); }
      } else {
          for (size_t it = it0; it < (size_t)NR * RH; it += step) { const int mi = (int)(it >> 4), m = P4_ROW(mi), h2 = (int)(it & 15), c2 = h2 * RN + j4; const bool first = (m & (SEQ - 1)) == 0;
              const f32x4 k = unpack4(*(const GAS v2u*)(rkv + (size_t)m * 3072 + RC + c2)), kr = unpack4(*(const GAS v2u*)(rkv + (size_t)(first ? m : m - 1) * 3072 + RC + c2));
              const f32x4 kp = first ? (f32x4){0.f, 0.f, 0.f, 0.f} : kr; const f32x4 mk2 = *(const f32x4*)(F.in[7] + RC + c2), kc2 = *(const f32x4*)(F.in[13] + c2);
              const f32x4 kk = (k + (kp - k) * mk2) * kc2; float s2 = (kk[0] * kk[0] + kk[1] * kk[1]) + (kk[2] * kk[2] + kk[3] * kk[3]); s2 = row16_sum(s2);
              if ((F.tid & 15) == 0) invn[(size_t)m * RH + h2] = 1.0f / fmaxf(sqrtf(s2), 1e-12f); } } }
#undef P4_ROW
}

typedef short bf16x4 __attribute__((ext_vector_type(4)));
typedef short bf16x8 __attribute__((ext_vector_type(8)));
#define MFMA32(a, b, c) __builtin_amdgcn_mfma_f32_16x16x32_bf16(a, b, c, 0, 0, 0)
#define MFMA16(a, b, c) __builtin_amdgcn_mfma_f32_16x16x16bf16_1k(a, b, c, 0, 0, 0)
__device__ __forceinline__ bf16x4 cv4(f32x4 v) { v2u w; w.x = pk2(v[0], v[1]); w.y = pk2(v[2], v[3]); return __builtin_bit_cast(bf16x4, w); }
__device__ __forceinline__ bf16x8 cv8(f32x4 a, f32x4 b) { v4u w; w.x = pk2(a[0], a[1]); w.y = pk2(a[2], a[3]); w.z = pk2(b[0], b[1]); w.w = pk2(b[2], b[3]); return __builtin_bit_cast(bf16x8, w); }
__device__ __forceinline__ bf16x8 cat8(bf16x4 a, bf16x4 b) { return __builtin_shufflevector(a, b, 0, 1, 2, 3, 4, 5, 6, 7); }
__device__ __forceinline__ bf16x8 join8(v2u a, v2u b) { v4u w; w.x = a.x; w.y = a.y; w.z = b.x; w.w = b.y; return __builtin_bit_cast(bf16x8, w); }
__device__ __forceinline__ float row16_scan(float x) { x += dpp_mov<0x111>(x); x += dpp_mov<0x112>(x); x += dpp_mov<0x114>(x); x += dpp_mov<0x118>(x); return x; }
__device__ __forceinline__ unsigned short bf1(float x) { return (unsigned short)(pk2(x, 0.f) & 0xffffu); }
constexpr int CH = 16;
constexpr int RWS = 144;
constexpr int HGS = 272;
constexpr int RWB_KG = 0, RWB_RG = 16 * RWS, RWB_KTI = 32 * RWS, RWB_BTI = 48 * RWS, RWB_V = 64 * RWS, RWB_GL = 80 * RWS, RWB_BYTES = RWB_GL + 256;
__device__ __forceinline__ bf16x4 lds_tr4(const LAS unsigned char* p) { return __builtin_amdgcn_ds_read_tr16_b64_v4i16((LAS bf16x4*)p); }
constexpr int HGB_QG = 0, HGB_KI = 16 * HGS, HGB_KIT = 32 * HGS, HGB_VT = HGB_KIT + 4096, HGB_GL = HGB_VT + 4096, HGB_BYTES = HGB_GL + 512;

__device__ __forceinline__ f32x4 padc(f32x4 r) { asm("s_nop 15" : "+v"(r)); return r; }
constexpr int NCHK = SEQ / CH;
constexpr int NRAW = 8;
constexpr int RWR_R = 0, RWR_K = 2048, RWR_V = 4096, RWR_LW = 6144, RWR_A = 8192, RWR_INV = 10240, RWR_BYTES = 10304;
constexpr int RW_OPND = 0, RW_RAW = 3 * RWB_BYTES, RW_AOP = RW_RAW + NRAW * RWR_BYTES, RW_LDS = RW_AOP + 2 * 2048;
constexpr int HGR_Q = 0, HGR_LF = 4096, HGR_V = 8192, HGR_BYTES = 12288;
constexpr int HG_OPND = 0, HG_RAW = 3 * HGB_BYTES, HG_AOP = HG_RAW + NRAW * HGR_BYTES, HG_LDS = HG_AOP + 2 * 512;
static_assert(RW_LDS <= RING_BYTES && HG_LDS <= RING_BYTES && RW_AOP % 16 == 0 && HG_AOP % 16 == 0, "scan LDS map");
#define GLDS4(gptr, lptr) __builtin_amdgcn_global_load_lds((const GAS unsigned*)(gptr), (LAS unsigned*)(lptr), 4, 0, 0)
#define WG_BAR() do { LDS_WAIT(); __builtin_amdgcn_s_barrier(); asm volatile("" ::: "memory"); } while (0)

__device__ __forceinline__ void p6_rwkv_head(Frame& F, int bh, int nsh) {
    const bf16* rkv = WSP(bf16, WS_R + R_RKV); const bf16* lout = WSP(bf16, WS_LOUT); const float* invn = WSP(float, WS_INVN); bf16* ydst = WSP(bf16, WS_LOUT);
    const int lane = F.lane, c = lane & 15, g = lane >> 4, w = F.wave;
    const int b = bh >> 4, h = bh & 15;
    const size_t rowbase = (size_t)b * SEQ;
    const int st = lane & 15, k0 = 2 * (w * 4 + (lane >> 4)), chn = h * RN + k0;
    const float mur0 = F.in[7][chn], mur1 = F.in[7][chn + 1], muk0 = F.in[7][RC + chn], muk1 = F.in[7][RC + chn + 1], muv0 = F.in[7][2 * RC + chn], muv1 = F.in[7][2 * RC + chn + 1];
    const float kk0 = F.in[13][chn], kk1 = F.in[13][chn + 1], ka0 = F.in[14][chn], ka1 = F.in[14][chn + 1];
    LAS unsigned char* const opnd = F.lds + RW_OPND; LAS unsigned char* const raw = F.lds + RW_RAW; LAS unsigned char* const aop = F.lds + RW_AOP;
#define RW3_DMA(j) do { const int r_ = 2 * w + (lane >> 5); const size_t ro_ = (rowbase + (size_t)(j) * CH + r_) * 3072 + h * RN + 2 * ((lane & 31) ^ r_); \
        LAS unsigned char* d_ = raw + ((j) % NRAW) * RWR_BYTES + w * 256; \
        GLDS4(rkv + ro_, d_ + RWR_R); GLDS4(rkv + ro_ + RC, d_ + RWR_K); GLDS4(rkv + ro_ + 2 * RC, d_ + RWR_V); GLDS4(lout + ro_, d_ + RWR_LW); GLDS4(lout + ro_ + RC, d_ + RWR_A); \
        if (lane < 2) GLDS4(invn + (rowbase + (size_t)(j) * CH + 2 * w + lane) * RH + h, raw + ((j) % NRAW) * RWR_BYTES + RWR_INV + w * 8); } while (0)
#define RW3_PROC(j) do { const LAS unsigned char* s_ = raw + ((j) % NRAW) * RWR_BYTES; const int pq_ = (k0 >> 1) ^ st, pp_ = (k0 >> 1) ^ ((st + 15) & 15); \
        const LAS unsigned char* sc_ = s_ + st * 128 + pq_ * 4; const LAS unsigned char* sp_ = ((st > 0) ? s_ + (st - 1) * 128 : raw + (((j) + NRAW - 1) % NRAW) * RWR_BYTES + 15 * 128) + pp_ * 4; \
        const bool first_ = ((j) == 0) && (st == 0); \
        const unsigned Lr = *(const LAS unsigned*)(sc_ + RWR_R), Lk = *(const LAS unsigned*)(sc_ + RWR_K), Lv = *(const LAS unsigned*)(sc_ + RWR_V); \
        const unsigned Lw = *(const LAS unsigned*)(sc_ + RWR_LW), La = *(const LAS unsigned*)(sc_ + RWR_A); \
        const unsigned Lrp = *(const LAS unsigned*)(sp_ + RWR_R), Lkp = *(const LAS unsigned*)(sp_ + RWR_K), Lvp = *(const LAS unsigned*)(sp_ + RWR_V); \
        const float Linv = *(const LAS float*)(s_ + RWR_INV + st * 4); \
        const float r0_ = bflo(Lr), r1_ = bfhi(Lr), q0_ = bflo(Lk), q1_ = bfhi(Lk), v0_ = bflo(Lv), v1_ = bfhi(Lv); \
        const float rp0_ = first_ ? 0.f : bflo(Lrp), rp1_ = first_ ? 0.f : bfhi(Lrp), qp0_ = first_ ? 0.f : bflo(Lkp), qp1_ = first_ ? 0.f : bfhi(Lkp), vp0_ = first_ ? 0.f : bflo(Lvp), vp1_ = first_ ? 0.f : bfhi(Lvp); \
        const float rs0_ = r0_ + (rp0_ - r0_) * mur0, rs1_ = r1_ + (rp1_ - r1_) * mur1, ks0_ = q0_ + (qp0_ - q0_) * muk0, ks1_ = q1_ + (qp1_ - q1_) * muk1, vs0_ = v0_ + (vp0_ - v0_) * muv0, vs1_ = v1_ + (vp1_ - v1_) * muv1; \
        const float a0_ = bflo(La), a1_ = bfhi(La), lw0_ = bflo(Lw) * 1.44269504f, lw1_ = bfhi(Lw) * 1.44269504f; \
        const float kap0_ = ks0_ * kk0 * Linv, kap1_ = ks1_ * kk1 * Linv, bet0_ = kap0_ * a0_, bet1_ = kap1_ * a1_; \
        const float kt0_ = ks0_ * (1.0f + (a0_ - 1.0f) * ka0), kt1_ = ks1_ * (1.0f + (a1_ - 1.0f) * ka1); \
        const float G0_ = row16_scan(lw0_), G1_ = row16_scan(lw1_); \
        const float eg0_ = __builtin_amdgcn_exp2f(G0_), eg1_ = __builtin_amdgcn_exp2f(G1_), ep0_ = __builtin_amdgcn_exp2f(G0_ - lw0_), ep1_ = __builtin_amdgcn_exp2f(G1_ - lw1_), ei0_ = __builtin_amdgcn_exp2f(-G0_), ei1_ = __builtin_amdgcn_exp2f(-G1_); \
        LAS unsigned char* d_ = opnd + ((j) % 3) * RWB_BYTES; \
        *(LAS unsigned*)(d_ + RWB_KG + st * RWS + k0 * 2) = pk2(kap0_ * ep0_, kap1_ * ep1_); *(LAS unsigned*)(d_ + RWB_RG + st * RWS + k0 * 2) = pk2(rs0_ * eg0_, rs1_ * eg1_); \
        const unsigned kti_ = pk2(kt0_ * ei0_, kt1_ * ei1_), bti_ = pk2(bet0_ * ei0_, bet1_ * ei1_), vv_ = pk2(vs0_, vs1_); \
        *(LAS unsigned*)(d_ + RWB_KTI + st * RWS + k0 * 2) = kti_; *(LAS unsigned*)(d_ + RWB_BTI + st * RWS + k0 * 2) = bti_; \
        *(LAS unsigned*)(d_ + RWB_V + st * RWS + k0 * 2) = vv_; \
        if (st == 15) { *(LAS float*)(d_ + RWB_GL + k0 * 4) = eg0_; *(LAS float*)(d_ + RWB_GL + k0 * 4 + 4) = eg1_; } } while (0)
    const f32x4 zero4 = (f32x4){0.f, 0.f, 0.f, 0.f};
    auto a_stage = [&](int j) {
        const LAS unsigned char* rowp = opnd + (j % 3) * RWB_BYTES + c * RWS;
        const int offA = (w == 4 || w == 7) ? RWB_BTI : RWB_KTI;
        const int offB = (w == 4 || w == 5) ? RWB_KG : RWB_RG;
        const bf16x8 a0 = *(const LAS bf16x8*)(rowp + offA + 16 * g), a1 = *(const LAS bf16x8*)(rowp + offA + 64 + 16 * g);
        const bf16x8 b0 = *(const LAS bf16x8*)(rowp + offB + 16 * g), b1 = *(const LAS bf16x8*)(rowp + offB + 64 + 16 * g);
        f32x4 N = MFMA32(a0, b0, zero4); N = MFMA32(a1, b1, N);
        const bool strict = (w == 4 || w == 5);
#pragma unroll
        for (int r = 0; r < 4; ++r) { const int rj = 4 * g + r; N[r] = (strict ? (c > rj) : (c >= rj)) ? N[r] : 0.f; }
        f32x4 res = N;
        if (w == 4) {
            f32x4 N1t = MFMA32(b0, a0, zero4); N1t = MFMA32(b1, a1, N1t);
            f32x4 X;
#pragma unroll
            for (int r = 0; r < 4; ++r) { const int rj = 4 * g + r; N1t[r] = (rj > c) ? N1t[r] : 0.f; X[r] = ((rj == c) ? 1.0f : 0.f) - N[r]; }
            bf16x4 an = cv4(N), at = cv4(N1t);
            f32x4 P = MFMA16(at, an, zero4), Pt = MFMA16(an, at, zero4);
            X = MFMA16(cv4(Pt), cv4(X), padc(X));
            an = cv4(P); at = cv4(Pt);
            P = MFMA16(at, an, zero4); Pt = MFMA16(an, at, zero4);
            X = MFMA16(cv4(Pt), cv4(X), padc(X));
            an = cv4(P); at = cv4(Pt);
            Pt = MFMA16(an, at, zero4);
            X = MFMA16(cv4(Pt), cv4(X), padc(X));
            res = X;
        }
        *(LAS bf16x4*)(aop + (j & 1) * 2048 + (w - 4) * 512 + lane * 8) = cv4(res);
    };
    f32x4 Z[4];
#pragma unroll
    for (int i = 0; i < 4; ++i) Z[i] = (f32x4){0.f, 0.f, 0.f, 0.f};
    const int tra = (4 * (lane >> 4) + ((lane >> 2) & 3)) * RWS + 8 * (lane & 3);
    { RW3_DMA(0); RW3_DMA(1); RW3_DMA(2); RW3_DMA(3); RW3_DMA(4); RW3_DMA(5); RW3_DMA(6); RW3_DMA(7); asm volatile("s_waitcnt vmcnt(0)" ::: "memory"); WG_BAR(); RW3_PROC(0); RW3_PROC(1); WG_BAR(); if (w >= 4) a_stage(0); WG_BAR(); }
    if (w < 4) {
        for (int ci = 0; ci < NCHK; ++ci) {
            const int t0 = ci * CH; const int jp = (ci + 2 < NCHK) ? ci + 2 : NCHK - 1;
            if (nsh > 0 && ci == NCHK / 2 - NRAW) { if (w == 0 && lane == 0) { unsigned* ctl_ = WSP(unsigned, WS_CTL); XB_SPIN(xb_ld(ctl_ + CW_SIG_H2) < (unsigned)nsh, ctl_ + CW_BAR); __builtin_amdgcn_fence(__ATOMIC_ACQUIRE, "agent"); asm volatile("s_waitcnt vmcnt(0)" ::: "memory"); } WG_BAR(); }
            RW3_PROC(jp);
            const LAS unsigned char* cur = opnd + (ci % 3) * RWB_BYTES; const LAS unsigned char* rowp = cur + c * RWS; const LAS unsigned char* ap = aop + (ci & 1) * 2048 + lane * 8;
            bf16x8 pKg[2], pRg[2];
#pragma unroll
            for (int s = 0; s < 2; ++s) {
                pKg[s] = join8(*(const LAS v2u*)(rowp + RWB_KG + 64 * s + 8 * g), *(const LAS v2u*)(rowp + RWB_KG + 64 * s + 32 + 8 * g));
                pRg[s] = join8(*(const LAS v2u*)(rowp + RWB_RG + 64 * s + 8 * g), *(const LAS v2u*)(rowp + RWB_RG + 64 * s + 32 + 8 * g)); }
            const bf16x4 bV = lds_tr4(cur + RWB_V + tra + 32 * w);
            const bf16x4 xT = *(const LAS bf16x4*)(ap), n2 = *(const LAS bf16x4*)(ap + 512), n3 = *(const LAS bf16x4*)(ap + 1024), n4 = *(const LAS bf16x4*)(ap + 1536);
            const bf16x8 bZ0 = cv8(Z[0], Z[1]), bZ1 = cv8(Z[2], Z[3]);
            const bf16x4 z4 = (bf16x4){0, 0, 0, 0};
            f32x4 W = MFMA32(pKg[0], bZ0, zero4); W = MFMA32(pKg[1], bZ1, W); W = MFMA32(cat8(n2, z4), cat8(bV, z4), W);
            const f32x4 U = MFMA16(xT, cv4(W), zero4);
            const bf16x4 nU = cv4(-U);
            const bf16x8 bVU = cat8(bV, nU);
            f32x4 Y = MFMA32(pRg[0], bZ0, zero4); Y = MFMA32(pRg[1], bZ1, Y); Y = MFMA32(cat8(n3, n4), bVU, Y);
#pragma unroll
            for (int r = 0; r < 4; ++r) ydst[(rowbase + t0 + 4 * g + r) * 3072 + h * RN + 16 * w + c] = bf1(Y[r]);
#pragma unroll
            for (int zt = 0; zt < 4; ++zt) {
                const bf16x4 aK = lds_tr4(cur + RWB_KTI + tra + 32 * zt), aB = lds_tr4(cur + RWB_BTI + tra + 32 * zt);
                const f32x4 gl = *(const LAS f32x4*)(cur + RWB_GL + (16 * zt + 4 * g) * 4);
                Z[zt] = MFMA32(cat8(aK, aB), bVU, Z[zt]) * gl; }
            { const int jn = (ci + NRAW < NCHK) ? ci + NRAW : NCHK - 1; RW3_DMA(jn); }
            if (ci == NCHK / 2 - 1) asm volatile("s_waitcnt vmcnt(0)" ::: "memory");
            asm volatile("s_waitcnt vmcnt(50)" ::: "memory");
            WG_BAR();
            if (ci == NCHK / 2 - 1 && w == 0 && lane == 0) sig_post(WSP(unsigned, WS_CTL) + CW_SIG_HALF);
        }
    } else {
        for (int ci = 0; ci < NCHK; ++ci) {
            const int jp = (ci + 2 < NCHK) ? ci + 2 : NCHK - 1, ja = (ci + 1 < NCHK) ? ci + 1 : NCHK - 1;
            if (nsh > 0 && ci == NCHK / 2 - NRAW) WG_BAR();
            RW3_PROC(jp);
            a_stage(ja);
            { const int jn = (ci + NRAW < NCHK) ? ci + NRAW : NCHK - 1; RW3_DMA(jn); }
            asm volatile("s_waitcnt vmcnt(30)" ::: "memory");
            WG_BAR();
        }
    }
#undef RW3_DMA
#undef RW3_PROC
}

__device__ __forceinline__ void p6_hgrn_head(Frame& F, int hb) {
    const bf16* hg = WSP(bf16, WS_R + R_HG); bf16* odst = WSP(bf16, WS_R + R_HG);
    const int lane = F.lane, c = lane & 15, g = lane >> 4, w = F.wave;
    const int bh = hb >> 1, half = hb & 1, b = bh >> 3, h = bh & 7, vb = half * 4 + (w & 3);
    const size_t rowbase = (size_t)b * SEQ;
    const int st = lane & 15, k0 = 4 * (w * 4 + (lane >> 4));
    LAS unsigned char* const opnd = F.lds + HG_OPND; LAS unsigned char* const raw = F.lds + HG_RAW; LAS unsigned char* const aop = F.lds + HG_AOP;
#define HG3_DMA(j) do { _Pragma("unroll") for (int rr_ = 0; rr_ < 2; ++rr_) { const int r_ = 2 * w + rr_; const bf16* p_ = hg + (rowbase + (size_t)(j) * CH + r_) * 4096 + h * HD + 2 * (2 * ((lane >> 1) ^ r_) + (lane & 1)); \
        LAS unsigned char* d_ = raw + ((j) % NRAW) * HGR_BYTES + r_ * 256; GLDS4(p_, d_ + HGR_Q); GLDS4(p_ + HC, d_ + HGR_LF); GLDS4(p_ + 2 * HC, d_ + HGR_V); } } while (0)
#define HG3_PROC(j) do { const LAS unsigned char* s_ = raw + ((j) % NRAW) * HGR_BYTES + st * 256 + (((k0 >> 2) ^ st) * 8); LAS unsigned char* d_ = opnd + ((j) % 3) * HGB_BYTES; \
        const v2u Lq = *(const LAS v2u*)(s_ + HGR_Q), Lf = *(const LAS v2u*)(s_ + HGR_LF), Lv = *(const LAS v2u*)(s_ + HGR_V); \
        const f32x4 q_ = unpack4(Lq); f32x4 lf_ = unpack4(Lf) * 1.44269504f; f32x4 qg_, ki_, eg_; \
        _Pragma("unroll") for (int e = 0; e < 4; ++e) { const float G_ = row16_scan(lf_[e]); eg_[e] = __builtin_amdgcn_exp2f(G_); qg_[e] = q_[e] * eg_[e]; ki_[e] = (1.0f - __builtin_amdgcn_exp2f(lf_[e])) * __builtin_amdgcn_exp2f(-G_); } \
        const v2u kw_ = pack4(ki_); *(LAS v2u*)(d_ + HGB_QG + st * HGS + k0 * 2) = pack4(qg_); *(LAS v2u*)(d_ + HGB_KI + st * HGS + k0 * 2) = kw_; \
        *(LAS unsigned short*)(d_ + HGB_KIT + (k0 + 0) * 32 + st * 2) = (unsigned short)(kw_.x & 0xffffu); *(LAS unsigned short*)(d_ + HGB_KIT + (k0 + 1) * 32 + st * 2) = (unsigned short)(kw_.x >> 16); \
        *(LAS unsigned short*)(d_ + HGB_KIT + (k0 + 2) * 32 + st * 2) = (unsigned short)(kw_.y & 0xffffu); *(LAS unsigned short*)(d_ + HGB_KIT + (k0 + 3) * 32 + st * 2) = (unsigned short)(kw_.y >> 16); \
        *(LAS unsigned short*)(d_ + HGB_VT + (k0 + 0) * 32 + st * 2) = (unsigned short)(Lv.x & 0xffffu); *(LAS unsigned short*)(d_ + HGB_VT + (k0 + 1) * 32 + st * 2) = (unsigned short)(Lv.x >> 16); \
        *(LAS unsigned short*)(d_ + HGB_VT + (k0 + 2) * 32 + st * 2) = (unsigned short)(Lv.y & 0xffffu); *(LAS unsigned short*)(d_ + HGB_VT + (k0 + 3) * 32 + st * 2) = (unsigned short)(Lv.y >> 16); \
        if (st == 15) *(LAS f32x4*)(d_ + HGB_GL + k0 * 4) = eg_; } while (0)
    const f32x4 zero4 = (f32x4){0.f, 0.f, 0.f, 0.f};
    auto a_stage = [&](int j) {
        const LAS unsigned char* rowp = opnd + (j % 3) * HGB_BYTES + c * HGS;
        f32x4 N = zero4;
#pragma unroll
        for (int s = 0; s < 4; ++s) { const bf16x8 nQ = *(const LAS bf16x8*)(rowp + HGB_QG + 64 * s + 16 * g), nK = *(const LAS bf16x8*)(rowp + HGB_KI + 64 * s + 16 * g); N = MFMA32(nK, nQ, N); }
#pragma unroll
        for (int r = 0; r < 4; ++r) N[r] = (c >= 4 * g + r) ? N[r] : 0.f;
        *(LAS bf16x4*)(aop + (j & 1) * 512 + lane * 8) = cv4(N);
    };
    f32x4 Z[8];
#pragma unroll
    for (int i = 0; i < 8; ++i) Z[i] = (f32x4){0.f, 0.f, 0.f, 0.f};
    { HG3_DMA(0); HG3_DMA(1); HG3_DMA(2); HG3_DMA(3); HG3_DMA(4); HG3_DMA(5); HG3_DMA(6); HG3_DMA(7); asm volatile("s_waitcnt vmcnt(0)" ::: "memory"); WG_BAR(); HG3_PROC(0); HG3_PROC(1); WG_BAR(); if (w == 4) a_stage(0); WG_BAR(); }
    if (w < 4) {
        for (int ci = 0; ci < NCHK; ++ci) {
            const int t0 = ci * CH; const int jp = (ci + 2 < NCHK) ? ci + 2 : NCHK - 1;
            HG3_PROC(jp);
            const LAS unsigned char* cur = opnd + (ci % 3) * HGB_BYTES; const LAS unsigned char* rowp = cur + c * HGS;
            f32x4 Y = zero4;
#pragma unroll
            for (int s = 0; s < 4; ++s) {
                const bf16x8 pQ = join8(*(const LAS v2u*)(rowp + HGB_QG + 64 * s + 8 * g), *(const LAS v2u*)(rowp + HGB_QG + 64 * s + 32 + 8 * g));
                Y = MFMA32(pQ, cv8(Z[2 * s], Z[2 * s + 1]), Y); }
            const bf16x4 bV = *(const LAS bf16x4*)(cur + HGB_VT + (16 * vb + c) * 32 + 8 * g);
            const bf16x4 n = *(const LAS bf16x4*)(aop + (ci & 1) * 512 + lane * 8);
            const bf16x4 z4 = (bf16x4){0, 0, 0, 0};
            Y = MFMA32(cat8(n, z4), cat8(bV, z4), Y);
#pragma unroll
            for (int r = 0; r < 4; ++r) odst[(rowbase + t0 + 4 * g + r) * 4096 + 2 * HC + h * HD + 16 * vb + c] = bf1(Y[r]);
#pragma unroll
            for (int zt = 0; zt < 8; ++zt) {
                const bf16x4 aK = *(const LAS bf16x4*)(cur + HGB_KIT + (16 * zt + c) * 32 + 8 * g);
                const f32x4 gl = *(const LAS f32x4*)(cur + HGB_GL + (16 * zt + 4 * g) * 4);
                Z[zt] = MFMA16(aK, bV, Z[zt]) * gl; }
            { const int jn = (ci + NRAW < NCHK) ? ci + NRAW : NCHK - 1; HG3_DMA(jn); }
            if (ci == NCHK / 2 - 1) asm volatile("s_waitcnt vmcnt(0)" ::: "memory");
            asm volatile("s_waitcnt vmcnt(50)" ::: "memory");
            WG_BAR();
            if (ci == NCHK / 2 - 1 && w == 0 && lane == 0) sig_post(WSP(unsigned, WS_CTL) + CW_SIG_HALF);
        }
    } else {
        for (int ci = 0; ci < NCHK; ++ci) {
            const int jp = (ci + 2 < NCHK) ? ci + 2 : NCHK - 1, ja = (ci + 1 < NCHK) ? ci + 1 : NCHK - 1;
            HG3_PROC(jp);
            if (w == 4) a_stage(ja);
            { const int jn = (ci + NRAW < NCHK) ? ci + NRAW : NCHK - 1; HG3_DMA(jn); }
            asm volatile("s_waitcnt vmcnt(30)" ::: "memory");
            WG_BAR();
        }
    }
#undef HG3_DMA
#undef HG3_PROC
}
#undef WG_BAR
__device__ __forceinline__ void p7_post(Frame& F, int hsel, int c, int G);
constexpr int NSCAN = BATCH * RH + 2 * BATCH * HH;
__device__ __forceinline__ void p6_shadow(Frame& F, const Args& A, int c, int G) {
    const unsigned long long* ss = WSP(unsigned long long, WS_SS);
    {   pg8::Gemm g{WSP(bf16, WS_XB), WSP(bf16, WS_WIN) + (size_t)26 * 256 * D, M, 4 * 256, D, 0}; pg8::StaticOrder S; S.init(M, 4 * 256, G, c);
        pg8::EpiInProj E{WSP(bf16, WS_R + R_RKV), WSP(float, WS_R + R_LIN), WSP(bf16, WS_R + R_HG), pg8::inv_preload((PG8_LAS float*)(F.lds + pg8::STAGE_BYTES), S, ss + M), (PG8_LAS float*)(F.lds + pg8::STAGE_BYTES + 4096), 26};
        pg8::gemm_phase<pg8::EpiInProj, pg8::StaticOrder, true, true>(F.lds, g, S, E); }
    {   int kl = KL; asm volatile("" : "+s"(kl));
        pg8::Gemm g{WSP(bf16, WS_ALORA), WSP(bf16, WS_WLORA) + (size_t)8 * 256 * KL, M, 4 * 256, kl, 0}; pg8::StaticOrder S; S.init(M, 4 * 256, G, c);
        pg8::EpiLora E{WSP(bf16, WS_LOUT), (PG8_LAS float*)(F.lds + pg8::STAGE_BYTES), 8};
        pg8::gemm_phase<pg8::EpiLora, pg8::StaticOrder, true, true>(F.lds, g, S, E); }
    p0_transposes<1>(F, A, c * NWAVES + F.wave, G * NWAVES);
}
__device__ __forceinline__ void p6_shadow_pre(Frame& F, int c, int G) {
    unsigned* ctl = WSP(unsigned, WS_CTL);
    p4_lora_in(F, 1, c, G);
    wg_signal(ctl + CW_SIG_P4); wg_wait(ctl + CW_SIG_P4, (unsigned)G, ctl + CW_BAR);
    {   int kl = KL; asm volatile("" : "+s"(kl));
        pg8::Gemm g{WSP(bf16, WS_ALORA), WSP(bf16, WS_WLORA), M, 8 * 256, kl, 0}; pg8::StaticOrder S; S.init(M / 2, 8 * 256, G, c); S.hsel = 1;
        PG8_LAS float* bt = (PG8_LAS float*)(F.lds + pg8::STAGE_BYTES);
        for (int cix = F.tid; cix < 2 * RC; cix += NWAVES * 64) bt[cix] = cix < RC ? F.in[8][cix] : F.in[10][cix - RC];
        __syncthreads();
        pg8::EpiLora E{WSP(bf16, WS_LOUT), bt, 0};
        pg8::gemm_phase<pg8::EpiLora, pg8::StaticOrder, true, true>(F.lds, g, S, E); }
    wg_signal(ctl + CW_SIG_H2);
}
__device__ __forceinline__ void p6_shadow_b(Frame& F, int c, int G) {
    unsigned* ctl = WSP(unsigned, WS_CTL);
    wg_signal(ctl + CW_SIG_SHA); wg_wait(ctl + CW_SIG_SHA, (unsigned)G, ctl + CW_BAR);
    wg_wait(ctl + CW_SIG_HALF, (unsigned)NSCAN, ctl + CW_BAR);
    p7_post(F, 0, c, G);
    wg_signal(ctl + CW_SIG_SHB); wg_wait(ctl + CW_SIG_SHB, (unsigned)G, ctl + CW_BAR);
    {   pg8::Gemm g{WSP(bf16, WS_XB), WSP(bf16, WS_WOUT), M, D, D, 0}; pg8::StaticOrder S; S.init(M / 2, D, G, c, 4); S.hsel = 0;
        pg8::EpiResid E{nullptr, (const bf16*)F.out, nullptr, nullptr, (bf16*)F.out + D, F.in[21], nullptr, WSP(unsigned long long, WS_SS) + 2 * M, 1.0f, 2 * D, 2 * D, 2048};
        pg8::gemm_phase<pg8::EpiResid, pg8::StaticOrder, true, true>(F.lds, g, S, E); }
}
__device__ __forceinline__ void p6_scans(Frame& F, const Args& A) {
    const int bx = (int)blockIdx.x;
    if (F.G == 2 * NSCAN) {
        const int x = bx & 7, idx = (bx >> 3) * 4 + (x & 3);
        if (x < 4) { if (idx < BATCH * RH) p6_rwkv_head(F, idx, NSCAN); else p6_hgrn_head(F, idx - BATCH * RH); } else { p6_shadow_pre(F, idx, NSCAN); p6_shadow(F, A, idx, NSCAN); p6_shadow_b(F, idx, NSCAN); } }
    else if (F.G > NSCAN) { if (bx < NSCAN) { if (bx < BATCH * RH) p6_rwkv_head(F, bx, F.G - NSCAN); else p6_hgrn_head(F, bx - BATCH * RH); } else { p6_shadow_pre(F, bx - NSCAN, F.G - NSCAN); p6_shadow(F, A, bx - NSCAN, F.G - NSCAN); p6_shadow_b(F, bx - NSCAN, F.G - NSCAN); } }
    else {
        for (int u = bx; u < NSCAN; u += F.G) { if (u < BATCH * RH) p6_rwkv_head(F, u, 0); else p6_hgrn_head(F, u - BATCH * RH); }
        __syncthreads(); p6_shadow(F, A, bx, F.G);
    }
}

__device__ __forceinline__ void p7_post(Frame& F, int hsel, int c, int G) {
    const int NR = hsel < 0 ? M : M / 2;
    const bf16* rkv = WSP(bf16, WS_R + R_RKV); const bf16* hg = WSP(bf16, WS_R + R_HG); const bf16* lout = WSP(bf16, WS_LOUT); bf16* yc = WSP(bf16, WS_XB);
    { const int half = F.tid >> 8, ch = (F.tid & 255) * 4;
      const f32x4 mu_r = *(const f32x4*)(F.in[7] + ch), mu_k = *(const f32x4*)(F.in[7] + RC + ch), mu_v = *(const f32x4*)(F.in[7] + 2 * RC + ch);
      const f32x4 kac = *(const f32x4*)(F.in[14] + ch), rkc = *(const f32x4*)(F.in[15] + ch), lnw = *(const f32x4*)(F.in[16] + ch), lnb = *(const f32x4*)(F.in[17] + ch);
#pragma unroll 2
      for (int i = c * 2 + half; i < NR; i += 2 * G) { const int m = hsel < 0 ? i : (i / (SEQ / 2)) * SEQ + (i % (SEQ / 2)) + hsel * (SEQ / 2);
          const bool first = (m & (SEQ - 1)) == 0; const size_t mp = first ? m : m - 1;
          const bf16* p = rkv + (size_t)m * 3072 + ch; const bf16* q = rkv + mp * 3072 + ch; const bf16* l = lout + (size_t)m * 3072 + ch;
          const f32x4 y = unpack4(*(const GAS v2u*)(l));
          const f32x4 r = unpack4(*(const GAS v2u*)(p)), k = unpack4(*(const GAS v2u*)(p + RC)), v = unpack4(*(const GAS v2u*)(p + 2 * RC));
          f32x4 rp = unpack4(*(const GAS v2u*)(q)), kp = unpack4(*(const GAS v2u*)(q + RC)), vp = unpack4(*(const GAS v2u*)(q + 2 * RC));
          if (first) { rp = (f32x4){0.f, 0.f, 0.f, 0.f}; kp = rp; vp = rp; }
          const f32x4 a = unpack4(*(const GAS v2u*)(l + RC)), gg = unpack4(*(const GAS v2u*)(l + 2 * RC));
          const f32x4 rs = r + (rp - r) * mu_r, ks = k + (kp - k) * mu_k, vs = v + (vp - v) * mu_v;
          const f32x4 km = ks * (1.0f + (a - 1.0f) * kac);
          const f32x4 bt = rs * km * rkc; float bon = (bt[0] + bt[1]) + (bt[2] + bt[3]); bon = row16_sum(bon);
          float s1 = (y[0] + y[1]) + (y[2] + y[3]); s1 = row16_sum(s1); const float mean = s1 * (1.0f / 64.0f);
          const f32x4 d = y - mean; float s2 = (d[0] * d[0] + d[1] * d[1]) + (d[2] * d[2] + d[3] * d[3]); s2 = row16_sum(s2);
          const float rstd = 1.0f / sqrtf(s2 * (1.0f / 64.0f) + 64e-5f);
          const f32x4 o = ((d * rstd) * lnw + lnb + vs * bon) * gg;
          *(GAS v2u*)(yc + (size_t)m * 2048 + ch) = pack4(o); } }
    { const int quarter = F.tid >> 7, ch = (F.tid & 127) * 8;
      const f32x4 nw0 = *(const f32x4*)(F.in[19] + ch), nw1 = *(const f32x4*)(F.in[19] + ch + 4);
#pragma unroll 4
      for (int i = c * 4 + quarter; i < NR; i += 4 * G) { const int m = hsel < 0 ? i : (i / (SEQ / 2)) * SEQ + (i % (SEQ / 2)) + hsel * (SEQ / 2);
          const v4u ow = *(const GAS v4u*)(hg + (size_t)m * 4096 + 2 * HC + ch), gw4 = *(const GAS v4u*)(hg + (size_t)m * 4096 + 3 * HC + ch);
          const f32x4 o0 = (f32x4){bflo(ow.x), bfhi(ow.x), bflo(ow.y), bfhi(ow.y)}, o1 = (f32x4){bflo(ow.z), bfhi(ow.z), bflo(ow.w), bfhi(ow.w)};
          const f32x4 g0 = (f32x4){bflo(gw4.x), bfhi(gw4.x), bflo(gw4.y), bfhi(gw4.y)}, g1 = (f32x4){bflo(gw4.z), bfhi(gw4.z), bflo(gw4.w), bfhi(gw4.w)};
          float s2 = ((o0[0] * o0[0] + o0[1] * o0[1]) + (o0[2] * o0[2] + o0[3] * o0[3])) + ((o1[0] * o1[0] + o1[1] * o1[1]) + (o1[2] * o1[2] + o1[3] * o1[3])); s2 = row16_sum(s2);
          const float rstd = 1.0f / sqrtf(s2 * (1.0f / 128.0f) + 1e-6f);
          *(GAS v4u*)(yc + (size_t)m * 2048 + RC + ch) = pg8::pack8(o0 * rstd * nw0 * g0, o1 * rstd * nw1 * g1); } }
}

__device__ __forceinline__ void p11_final(Frame& F) {
    const int gw = F.vcu * NWAVES + F.wave, NGW = F.G * NWAVES; const float* fg = F.in[25];
    const bf16* x3 = WSP(bf16, WS_XB); const unsigned long long* ss3 = WSP(unsigned long long, WS_SS) + 3 * M;
    f32x4 gn[8];
#pragma unroll
    for (int j = 0; j < 4; ++j) { gn[2 * j] = *(const f32x4*)(fg + 8 * F.lane + 512 * j); gn[2 * j + 1] = *(const f32x4*)(fg + 8 * F.lane + 512 * j + 4); }
#pragma unroll 2
    for (int m = gw; m < M; m += NGW) { const GAS v4u* xr = (const GAS v4u*)(x3 + (size_t)m * D) + F.lane; GAS f32x4* o = (GAS f32x4*)(F.out + (size_t)m * D) + 2 * F.lane;
        const float inv = pg8::inv_rms_from_val(ss3[m]);
#pragma unroll
        for (int j = 0; j < 4; ++j) { const v4u w = xr[64 * j];
            o[128 * j] = (f32x4){bflo(w.x), bfhi(w.x), bflo(w.y), bfhi(w.y)} * inv * gn[2 * j]; o[128 * j + 1] = (f32x4){bflo(w.z), bfhi(w.z), bflo(w.w), bfhi(w.w)} * inv * gn[2 * j + 1]; } }
}

__global__ void __launch_bounds__(NWAVES * 64, 2) mk_fwd(Args args) {
    extern __shared__ __attribute__((aligned(16))) unsigned char lds[];
    Frame F;
    F.lds = (LAS unsigned char*)lds;
    F.tid = threadIdx.x; F.lane = F.tid & 63; F.wave = __builtin_amdgcn_readfirstlane(F.tid >> 6);
    F.G = gridDim.x; { const int bx = blockIdx.x; F.vcu = (F.G % 8 == 0) ? (bx % 8) * (F.G / 8) + bx / 8 : bx; }
#pragma unroll
    for (int i = 0; i < 26; ++i) F.in[i] = args.in[i];
    F.out = args.out; F.ws = args.ws;
    for (int u = F.tid; u < (LDS_BYTES - LDSCTL_OFF) / 4; u += NWAVES * 64) ((LAS unsigned*)(F.lds + LDSCTL_OFF))[u] = 0u;
    __syncthreads();
    const int lo = args.ph_lo, hi = args.ph_hi;
    XcdBarrier bar; bar.bar = (unsigned*)(args.ws + WS_CTL) + CW_BAR; bar.x = 0; bar.st = nullptr;
    if (hi - lo > 1) bar = xcd_barrier_post((unsigned*)(args.ws + WS_CTL) + CW_BAR, (volatile LAS unsigned*)(F.lds + MISC_OFF) + 8);
#ifndef PH_MASK
#define PH_MASK 0xFFF
#endif
#define IN(k) (((PH_MASK >> (k)) & 1) && lo <= (k) && (k) < hi)
#define SEAM(k) do { if (IN(k) && IN((k) + 1)) xcd_barrier(bar); } while (0)
    const bf16* xb = WSP(bf16, WS_XB); unsigned long long* ss = WSP(unsigned long long, WS_SS);
    const int cid = (int)blockIdx.x;
    bf16* const x2b = (bf16*)F.out + D;
    const bool fuse = (F.G % 256) == 0;

    if (IN(0)) { p0_prologue(F, args); } SEAM(0);
    if (IN(1)) {
        pg8::Gemm g{xb, WSP(bf16, WS_W1GU), M, 2 * FF, D, 0}; pg8::StaticOrder S; S.init(M, 2 * FF, F.G, cid);
        pg8::EpiSwiglu E{WSP(bf16, WS_R + R_ACT), FF, pg8::inv_preload((PG8_LAS float*)(F.lds + pg8::STAGE_BYTES), S, ss)};
        pg8::gemm_phase<pg8::EpiSwiglu, pg8::StaticOrder, true, true>(F.lds, g, S, E);
    } SEAM(1);
    if (IN(2)) {
        pg8::Gemm g{WSP(bf16, WS_R + R_ACT), WSP(bf16, WS_W1D), M, D, FF, 0}; pg8::StaticOrder S; S.init(M, D, F.G, cid, 4);
        pg8::EpiResid E{F.in[0], nullptr, nullptr, nullptr, WSP(bf16, WS_XB), F.in[5], (bf16*)F.out, ss + M, 0.5f, 2048, 2048, 2 * D};
        pg8::gemm_phase<pg8::EpiResid, pg8::StaticOrder, true, true>(F.lds, g, S, E);
    } SEAM(2);
    if (IN(3)) {
        pg8::Gemm g{xb, WSP(bf16, WS_WIN), M, 26 * 256, D, 0}; pg8::StaticOrder S; S.init(M, 26 * 256, F.G, cid);
        PG8_LAS float* omt = (PG8_LAS float*)(F.lds + pg8::STAGE_BYTES + 4096);
        for (int cix = F.tid; cix < HC; cix += NWAVES * 64) omt[cix] = 1.0f - fast_sigmoid(F.in[18][cix] - F.in[18][HC + cix]);
        pg8::EpiInProj E{WSP(bf16, WS_R + R_RKV), WSP(float, WS_R + R_LIN), WSP(bf16, WS_R + R_HG), pg8::inv_preload((PG8_LAS float*)(F.lds + pg8::STAGE_BYTES), S, ss + M), omt, 0};
        pg8::gemm_phase<pg8::EpiInProj, pg8::StaticOrder, true, true>(F.lds, g, S, E);
    } SEAM(3);
    const bool split = F.G > NSCAN;
    if (IN(4)) { p4_lora_in(F, split ? 0 : -1, F.vcu, F.G); } SEAM(4);
    if (IN(5)) {
        int kl = KL; asm volatile("" : "+s"(kl));
        pg8::Gemm g{WSP(bf16, WS_ALORA), WSP(bf16, WS_WLORA), M, 8 * 256, kl, 0}; pg8::StaticOrder S; S.init(split ? M / 2 : M, 8 * 256, F.G, cid); S.hsel = split ? 0 : -1;
        PG8_LAS float* bt = (PG8_LAS float*)(F.lds + pg8::STAGE_BYTES);
        for (int cix = F.tid; cix < 2 * RC; cix += NWAVES * 64) bt[cix] = cix < RC ? F.in[8][cix] : F.in[10][cix - RC];
        __syncthreads();
        pg8::EpiLora E{WSP(bf16, WS_LOUT), bt, 0};
        pg8::gemm_phase<pg8::EpiLora, pg8::StaticOrder, true, true>(F.lds, g, S, E);
    } SEAM(5);
    if (IN(6)) { p6_scans(F, args); } SEAM(6);
    if (IN(7)) { p7_post(F, split ? 1 : -1, F.vcu, F.G); } SEAM(7);
    if (IN(8)) {
        pg8::Gemm g{xb, WSP(bf16, WS_WOUT), M, D, D, 0}; pg8::StaticOrder S; S.init(split ? M / 2 : M, D, F.G, cid, 4); S.hsel = split ? 1 : -1;
        pg8::EpiResid E{nullptr, (const bf16*)F.out, nullptr, nullptr, x2b, F.in[21], nullptr, ss + 2 * M, 1.0f, 2 * D, 2 * D, 2048};
        pg8::gemm_phase<pg8::EpiResid, pg8::StaticOrder, true, true>(F.lds, g, S, E);
    } SEAM(8);
    if (IN(9)) {
        pg8::Gemm g{x2b, WSP(bf16, WS_W2GU), M, 2 * FF, D, 2 * D}; pg8::StaticOrder S; S.init(M, 2 * FF, F.G, cid);
        pg8::EpiSwiglu E{WSP(bf16, WS_R + R_ACT), FF, pg8::inv_preload((PG8_LAS float*)(F.lds + pg8::STAGE_BYTES), S, ss + 2 * M)};
        pg8::gemm_phase<pg8::EpiSwiglu, pg8::StaticOrder, true, true>(F.lds, g, S, E);
    } SEAM(9);
    if (IN(10)) {
        pg8::Gemm g{WSP(bf16, WS_R + R_ACT), WSP(bf16, WS_W2D), M, D, FF, 0}; pg8::StaticOrder S; S.init(M, D, F.G, cid, 4);
        if (fuse) { pg8::EpiFinal E{x2b, 2 * D, F.in[21], F.in[25], F.out, ss + 3 * M, WSP(unsigned, WS_CTL) + CW_PCNT, WSP(unsigned, WS_CTL) + CW_BAR + XB_TMO, 0.5f, (unsigned)(D / 256)};
            pg8::gemm_phase<pg8::EpiFinal, pg8::StaticOrder, true, true>(F.lds, g, S, E); }
        else { pg8::EpiResid E{nullptr, x2b, F.in[21], nullptr, nullptr, nullptr, WSP(bf16, WS_XB), ss + 3 * M, 0.5f, 2 * D, 2048, 2048};
            pg8::gemm_phase<pg8::EpiResid, pg8::StaticOrder, true, true>(F.lds, g, S, E); }
    }
    if (!fuse) { SEAM(10); if (IN(11)) { p11_final(F); } }
#undef IN
#undef SEAM
}

extern "C" void kernel_launch(void* const* d_in, const int* in_sizes, int n_in, void* d_out, int out_size, void* d_ws, size_t ws_size, hipStream_t stream) {
    static int grid = 0;
    if (grid == 0) {
        if (n_in != 26 || in_sizes[0] != M * D || out_size != M * D || ws_size < WS_END) { fprintf(stderr, "kernel_launch: unexpected problem (n_in %d, ws %zu < %zu)\n", n_in, ws_size, (size_t)WS_END); grid = -1; return; }
        int dev = 0, cus = 0, per_cu = 0;
        if (hipGetDevice(&dev) != hipSuccess || hipDeviceGetAttribute(&cus, hipDeviceAttributeMultiprocessorCount, dev) != hipSuccess) { grid = -1; return; }
        if (hipFuncSetAttribute((const void*)mk_fwd, hipFuncAttributeMaxDynamicSharedMemorySize, LDS_BYTES) != hipSuccess) { grid = -1; return; }
        if (hipOccupancyMaxActiveBlocksPerMultiprocessor(&per_cu, (const void*)mk_fwd, NWAVES * 64, LDS_BYTES) != hipSuccess || per_cu < 1) fprintf(stderr, "kernel_launch: occupancy query reports %d\n", per_cu);
        (void)hipGetLastError();
        grid = cus;
    }
    if (grid < 0) return;
    (void)hipMemsetAsync((char*)d_ws + WS_CTL, 0, CTL_BYTES, stream);
    Args a{};
    for (int i = 0; i < 26; ++i) a.in[i] = (const float*)d_in[i];
    a.out = (float*)d_out; a.ws = (unsigned char*)d_ws;
    constexpr int NL_ = MK_N_LAUNCHES;
    for (int li = 0; li < NL_; ++li) {
        a.ph_lo = (NL_ == 1) ? 0 : li; a.ph_hi = (NL_ == 1) ? N_PHASES : li + 1;
        hipLaunchKernelGGL(mk_fwd, dim3(grid), dim3(NWAVES * 64), LDS_BYTES, stream, a);
    }
}
```

```cpp
#include <hip/hip_runtime.h>
#include <cstdio>
#include <cstdint>
namespace pg8 {
#define PG8_LAS __attribute__((address_space(3)))
typedef unsigned short bf16_t;
typedef short bf16x8 __attribute__((ext_vector_type(8)));
typedef float f32x4 __attribute__((ext_vector_type(4)));
typedef unsigned u32x4 __attribute__((ext_vector_type(4)));
constexpr int BM = 256, BK = 64, HALF = 128, HTB = HALF * BK * 2  , STAGE_BYTES = 8 * HTB, NXCD = 8, WGM = 8;

__host__ __device__ __forceinline__ int lds_byte(int r, int c) { const int st = (r >> 4) * 2 + (c >> 5), rr = r & 15, cc = c & 31, ob = rr * 64 + cc * 2; return st * 1024 + (ob ^ (((ob >> 9) & 1) << 5)); }
__host__ __device__ __forceinline__ void stage_rc(int b, int& R, int& C) { const int st = b / 1024, sb = b % 1024, swz = sb ^ (((sb >> 9) & 1) << 5); R = (st >> 1) * 16 + swz / 64; C = (st & 1) * 32 + (swz % 64) / 2; }
__host__ __device__ __forceinline__ int perm32(int rho) { const int n = rho >> 4, i = rho & 15; return 8 * (i >> 2) + 4 * n + (i & 3); }

struct Unit { int pm, pn; };
struct Gemm { const bf16_t* A; const bf16_t* Bt; int M, N, K, lda; };

struct StaticOrder {
    int nM, nN, nwg, G, c, wgm, hsel;
    __host__ __device__ void init(int M, int N, int G_, int c_, int wgm_ = WGM) { nM = M / BM; nN = N / BM; nwg = nM * nN; G = G_; c = c_; wgm = wgm_; hsel = -1; }
    __host__ __device__ bool next(int i, Unit& u) const {
        const long L = (long)i * G + c; if (L >= nwg) return false;
        int wgid = (int)L; { const int q = nwg / NXCD, r = nwg % NXCD, xcd = wgid % NXCD, off = wgid / NXCD; wgid = (xcd < r ? xcd * (q + 1) : r * (q + 1) + (xcd - r) * q) + off; }
        const int nig = wgm * nN, gid = wgid / nig, fm = gid * wgm, gsz = (nM - fm) < wgm ? (nM - fm) : wgm;
        u.pm = fm + ((wgid % nig) % gsz); u.pn = (wgid % nig) / gsz; if (hsel >= 0) u.pm = (u.pm >> 4) * 32 + (u.pm & 15) + 16 * hsel; return true;
    }
    __device__ __forceinline__ void a_ready(const Unit&) const {}
    __device__ __forceinline__ void done(const Unit&) const {}
};


typedef __bf16 bf16n2 __attribute__((ext_vector_type(2)));
__device__ __forceinline__ unsigned cvt_pk_bf16(float lo, float hi) { bf16n2 v; v.x = (__bf16)lo; v.y = (__bf16)hi; return __builtin_bit_cast(unsigned, v); }
__device__ __forceinline__ float fast_sigmoid(float z) { return __builtin_amdgcn_rcpf(1.0f + __builtin_amdgcn_exp2f(-1.44269504f * z)); }
__device__ __forceinline__ float fast_silu(float z) { return z * fast_sigmoid(z); }
constexpr float SS_SCALE = 16777216.0f;
__device__ __forceinline__ float inv_rms_from_val(unsigned long long v) {
    const float tot = (float)v * (1.0f / SS_SCALE);
    return 1.0f / sqrtf(tot * (1.0f / 2048.0f) + 1e-6f);
}
__device__ __forceinline__ u32x4 pack8(const f32x4 v0, const f32x4 v1) { u32x4 w; w.x = cvt_pk_bf16(v0[0], v0[1]); w.y = cvt_pk_bf16(v0[2], v0[3]); w.z = cvt_pk_bf16(v1[0], v1[1]); w.w = cvt_pk_bf16(v1[2], v1[3]); return w; }

struct InvTab {
    const PG8_LAS float* tab; int t0, t1, t2, t3; const unsigned long long* ss;
    __device__ __forceinline__ int slot(int pm) const { return pm == t0 ? 0 : (pm == t1 ? 1 : (pm == t2 ? 2 : (pm == t3 ? 3 : -1))); }
    __device__ __forceinline__ void get(float (&inv)[2][4], int pm, int r0) const {
        const int sl = slot(pm);
        if (sl >= 0) {
#pragma unroll
            for (int ai = 0; ai < 2; ++ai)
#pragma unroll
                for (int m = 0; m < 4; ++m) inv[ai][m] = tab[sl * BM + r0 + ai * HALF + m * 16];
        } else { unsigned long long sv[2][4];
#pragma unroll
            for (int ai = 0; ai < 2; ++ai)
#pragma unroll
                for (int m = 0; m < 4; ++m) sv[ai][m] = ss[pm * BM + r0 + ai * HALF + m * 16];
#pragma unroll
            for (int ai = 0; ai < 2; ++ai)
#pragma unroll
                for (int m = 0; m < 4; ++m) inv[ai][m] = inv_rms_from_val(sv[ai][m]); }
    }
};
template <class Sched> __device__ __forceinline__ InvTab inv_preload(PG8_LAS float* tab, const Sched& S, const unsigned long long* ss) {
    InvTab T; T.tab = tab; T.t0 = -1; T.t1 = -1; T.t2 = -1; T.t3 = -1; T.ss = ss; int n = 0; Unit u;
    for (int i = 0; S.next(i, u); ++i) {
        if (T.slot(u.pm) < 0 && n < 4) {
            if (threadIdx.x < BM) tab[n * BM + threadIdx.x] = inv_rms_from_val(ss[u.pm * BM + threadIdx.x]);
            if (n == 0) T.t0 = u.pm; else if (n == 1) T.t1 = u.pm; else if (n == 2) T.t2 = u.pm; else T.t3 = u.pm;
            ++n; } }
    __syncthreads();
    return T;
}
struct EpiSwiglu {
    static constexpr bool PERM = true, AFTER_DRAIN = false;
    bf16_t* O; int ldc; InvTab it;
    __device__ __forceinline__ void operator()(const f32x4 (&acc)[2][2][4][2], const Unit& u, int wr, int wc, int fr, int fq) const {
        const int row0 = u.pm * BM + wr * 64 + fr, col0 = u.pn * HALF + wc * 32 + 8 * fq;
        float invs[2][4]; it.get(invs, u.pm, wr * 64 + fr);
#pragma unroll
        for (int ai = 0; ai < 2; ++ai)
#pragma unroll
            for (int m = 0; m < 4; ++m) { const int row = row0 + ai * HALF + m * 16; const float inv = invs[ai][m], invn = inv * -1.44269504f;
                f32x4 o[2];
#pragma unroll
                for (int n = 0; n < 2; ++n) { const f32x4 g = acc[ai][0][m][n] * inv, up = acc[ai][1][m][n] * inv, t = acc[ai][0][m][n] * invn; f32x4 e, r;
#pragma unroll
                    for (int j = 0; j < 4; ++j) e[j] = __builtin_amdgcn_exp2f(t[j]);
                    const f32x4 d = e + 1.0f;
#pragma unroll
                    for (int j = 0; j < 4; ++j) r[j] = __builtin_amdgcn_rcpf(d[j]);
                    o[n] = (g * r) * up; }
                *(u32x4*)(O + (size_t)row * ldc + col0) = pack8(o[0], o[1]); }
    }
};
struct EpiResid {
    static constexpr bool PERM = true, AFTER_DRAIN = false;
    const float* rf; const bf16_t* rb; const float* rbg; float* out; bf16_t* ob; const float* gain; bf16_t* ob2; unsigned long long* ss; float alpha; int prb, pob, pob2;
    __device__ __forceinline__ void operator()(const f32x4 (&acc)[2][2][4][2], const Unit& u, int wr, int wc, int fr, int fq) const {
        const int row0 = u.pm * BM + wr * 64 + fr, col0 = u.pn * BM + wc * 32 + 8 * fq;
        f32x4 gi[2][2], go[2][2];
#pragma unroll
        for (int bj = 0; bj < 2; ++bj)
#pragma unroll
            for (int n = 0; n < 2; ++n) { gi[bj][n] = (f32x4){1.f, 1.f, 1.f, 1.f}; go[bj][n] = gi[bj][n];
                if (rbg) { const f32x4 t = *(const f32x4*)(rbg + col0 + bj * HALF + 4 * n); gi[bj][n] = (f32x4){1.0f / t[0], 1.0f / t[1], 1.0f / t[2], 1.0f / t[3]}; }
                if (ob) go[bj][n] = *(const f32x4*)(gain + col0 + bj * HALF + 4 * n); }
#pragma unroll
        for (int ai = 0; ai < 2; ++ai)
#pragma unroll
            for (int m = 0; m < 4; ++m) { const int row = row0 + ai * HALF + m * 16; const size_t off = (size_t)row * 2048 + col0, offr = (size_t)row * prb + col0, offo = (size_t)row * pob + col0, offo2 = (size_t)row * pob2 + col0; float s = 0.f;
#pragma unroll
                for (int bj = 0; bj < 2; ++bj) {
                    f32x4 r0, r1;
                    if (rf) { r0 = *(const f32x4*)(rf + off + bj * HALF); r1 = *(const f32x4*)(rf + off + bj * HALF + 4); }
                    else { const u32x4 w = *(const u32x4*)(rb + offr + bj * HALF);
                        r0 = (f32x4){__builtin_bit_cast(float, w.x << 16), __builtin_bit_cast(float, w.x & 0xffff0000u), __builtin_bit_cast(float, w.y << 16), __builtin_bit_cast(float, w.y & 0xffff0000u)} * gi[bj][0];
                        r1 = (f32x4){__builtin_bit_cast(float, w.z << 16), __builtin_bit_cast(float, w.z & 0xffff0000u), __builtin_bit_cast(float, w.w << 16), __builtin_bit_cast(float, w.w & 0xffff0000u)} * gi[bj][1]; }
                    const f32x4 o0 = r0 + acc[ai][bj][m][0] * alpha, o1 = r1 + acc[ai][bj][m][1] * alpha;
                    if (out) { *(f32x4*)(out + off + bj * HALF) = o0; *(f32x4*)(out + off + bj * HALF + 4) = o1; }
                    if (ob) *(u32x4*)(ob + offo + bj * HALF) = pack8(o0 * go[bj][0], o1 * go[bj][1]);
                    if (ob2) *(u32x4*)(ob2 + offo2 + bj * HALF) = pack8(o0, o1);
                    s += (o0[0] * o0[0] + o0[1] * o0[1]) + (o0[2] * o0[2] + o0[3] * o0[3]) + (o1[0] * o1[0] + o1[1] * o1[1]) + (o1[2] * o1[2] + o1[3] * o1[3]); }
                if (ss) { s += __shfl_xor(s, 16); s += __shfl_xor(s, 32);
                    if (fq == 0) atomicAdd(ss + row, (unsigned long long)(s * SS_SCALE + 0.5f)); } }
    }
};
struct EpiFinal {
    static constexpr bool PERM = true, AFTER_DRAIN = false;
    const bf16_t* rb; int prb; const float* rbg; const float* fgain; float* out; unsigned long long* ss; unsigned* cnt; unsigned* tmo; float alpha; unsigned npn;
    __device__ __forceinline__ void operator()(f32x4 (&acc)[2][2][4][2], const Unit& u, int wr, int wc, int fr, int fq) const {
        const int row0 = u.pm * BM + wr * 64 + fr, col0 = u.pn * BM + wc * 32 + 8 * fq;
        { f32x4 gi[2][2];
#pragma unroll
          for (int bj = 0; bj < 2; ++bj)
#pragma unroll
            for (int n = 0; n < 2; ++n) { const f32x4 t = *(const f32x4*)(rbg + col0 + bj * HALF + 4 * n); gi[bj][n] = (f32x4){1.0f / t[0], 1.0f / t[1], 1.0f / t[2], 1.0f / t[3]}; }
#pragma unroll
          for (int ai = 0; ai < 2; ++ai)
#pragma unroll
            for (int m = 0; m < 4; ++m) { const int row = row0 + ai * HALF + m * 16; const size_t offr = (size_t)row * prb + col0; float s = 0.f;
#pragma unroll
                for (int bj = 0; bj < 2; ++bj) { const u32x4 w = *(const u32x4*)(rb + offr + bj * HALF);
                    const f32x4 r0 = (f32x4){__builtin_bit_cast(float, w.x << 16), __builtin_bit_cast(float, w.x & 0xffff0000u), __builtin_bit_cast(float, w.y << 16), __builtin_bit_cast(float, w.y & 0xffff0000u)} * gi[bj][0];
                    const f32x4 r1 = (f32x4){__builtin_bit_cast(float, w.z << 16), __builtin_bit_cast(float, w.z & 0xffff0000u), __builtin_bit_cast(float, w.w << 16), __builtin_bit_cast(float, w.w & 0xffff0000u)} * gi[bj][1];
                    const f32x4 o0 = r0 + acc[ai][bj][m][0] * alpha, o1 = r1 + acc[ai][bj][m][1] * alpha; acc[ai][bj][m][0] = o0; acc[ai][bj][m][1] = o1;
                    s += (o0[0] * o0[0] + o0[1] * o0[1]) + (o0[2] * o0[2] + o0[3] * o0[3]) + (o1[0] * o1[0] + o1[1] * o1[1]) + (o1[2] * o1[2] + o1[3] * o1[3]); }
                s += __shfl_xor(s, 16); s += __shfl_xor(s, 32);
                if (fq == 0) atomicAdd(ss + row, (unsigned long long)(s * SS_SCALE + 0.5f)); } }
        asm volatile("s_waitcnt vmcnt(0)" ::: "memory"); __syncthreads();
        if (threadIdx.x == 0) { unsigned* c = cnt + u.pm;
            (void)__hip_atomic_fetch_add(c, 1u, __ATOMIC_RELAXED, __HIP_MEMORY_SCOPE_AGENT);
            unsigned sp = 0;
            while (__hip_atomic_load(c, __ATOMIC_RELAXED, __HIP_MEMORY_SCOPE_AGENT) < npn) { __builtin_amdgcn_s_sleep(1);
                if ((++sp & 255u) == 0u) { if (__hip_atomic_load(tmo, __ATOMIC_RELAXED, __HIP_MEMORY_SCOPE_AGENT)) break; if (sp > (1u << 18)) { atomicAdd(tmo, 1u); break; } } }
        }
        __syncthreads();
        f32x4 fg[2][2];
#pragma unroll
        for (int bj = 0; bj < 2; ++bj)
#pragma unroll
            for (int n = 0; n < 2; ++n) fg[bj][n] = *(const f32x4*)(fgain + col0 + bj * HALF + 4 * n);
#pragma unroll
        for (int ai = 0; ai < 2; ++ai)
#pragma unroll
            for (int m = 0; m < 4; ++m) { const int row = row0 + ai * HALF + m * 16; const size_t off = (size_t)row * 2048 + col0;
                const float inv = inv_rms_from_val(__hip_atomic_load(ss + row, __ATOMIC_RELAXED, __HIP_MEMORY_SCOPE_AGENT));
#pragma unroll
                for (int bj = 0; bj < 2; ++bj) { *(f32x4*)(out + off + bj * HALF) = acc[ai][bj][m][0] * inv * fg[bj][0]; *(f32x4*)(out + off + bj * HALF + 4) = acc[ai][bj][m][1] * inv * fg[bj][1]; } }
    }
};
struct EpiInProj {
    static constexpr bool PERM = true, AFTER_DRAIN = false;
    bf16_t* rkv; float* lin; bf16_t* hg; InvTab it; const PG8_LAS float* oml; int pn0;
    __device__ __forceinline__ void operator()(const f32x4 (&acc)[2][2][4][2], const Unit& u, int wr, int wc, int fr, int fq) const {
        const int row0 = u.pm * BM + wr * 64 + fr, cin = wc * 32 + 8 * fq;
        const int pn = u.pn + pn0;
        float invs[2][4]; it.get(invs, u.pm, wr * 64 + fr);
        int mode;
        if (pn < 12) mode = 0; else if (pn < 14) mode = 1; else { const int sg = (pn - 14) >> 2; mode = (sg == 0 || sg == 3) ? 2 : (sg == 1 ? 3 : 4); }
#pragma unroll
        for (int bj = 0; bj < 2; ++bj) {
            f32x4 om0 = (f32x4){0.f, 0.f, 0.f, 0.f}, om1 = om0;
            if (mode == 3) { const PG8_LAS float* lp = oml + (pn - 18) * BM + bj * HALF + cin; om0 = *(const PG8_LAS f32x4*)lp; om1 = *(const PG8_LAS f32x4*)(lp + 4); }
#pragma unroll
            for (int ai = 0; ai < 2; ++ai)
#pragma unroll
                for (int m = 0; m < 4; ++m) { const int row = row0 + ai * HALF + m * 16; const float inv = invs[ai][m];
                    f32x4 v0 = acc[ai][bj][m][0] * inv, v1 = acc[ai][bj][m][1] * inv;
                    if (mode == 0) { *(u32x4*)(rkv + (size_t)row * 3072 + pn * BM + bj * HALF + cin) = pack8(v0, v1); }
                    else if (mode == 1) { const int cl = (pn - 12) * BM + bj * HALF + cin;
                        if (cl < 288) { *(f32x4*)(lin + (size_t)row * 288 + cl) = v0; *(f32x4*)(lin + (size_t)row * 288 + cl + 4) = v1; } }
                    else {
                        if (mode == 2) {
#pragma unroll
                            for (int j = 0; j < 4; ++j) { v0[j] = fast_silu(v0[j]); v1[j] = fast_silu(v1[j]); } }
                        else if (mode == 3) {
#pragma unroll
                            for (int j = 0; j < 4; ++j) { v0[j] = __logf(1.0f - om0[j] * fast_sigmoid(-v0[j])); v1[j] = __logf(1.0f - om1[j] * fast_sigmoid(-v1[j])); } }
                        *(u32x4*)(hg + (size_t)row * 4096 + (pn - 14) * BM + bj * HALF + cin) = pack8(v0, v1); } } }
    }
};
struct EpiLora {
    static constexpr bool PERM = true, AFTER_DRAIN = false;
    bf16_t* lout; const PG8_LAS float* bias; int pn0;
    __device__ __forceinline__ void operator()(const f32x4 (&acc)[2][2][4][2], const Unit& u, int wr, int wc, int fr, int fq) const {
        const int row0 = u.pm * BM + wr * 64 + fr, cin = wc * 32 + 8 * fq;
        const int pn = u.pn + pn0, mode = pn >> 2;
#pragma unroll
        for (int bj = 0; bj < 2; ++bj) {
            f32x4 b0 = (f32x4){0.f, 0.f, 0.f, 0.f}, b1 = b0;
            if (mode < 2) { const PG8_LAS float* bp = bias + pn * BM + bj * HALF + cin; b0 = *(const PG8_LAS f32x4*)bp; b1 = *(const PG8_LAS f32x4*)(bp + 4); }
#pragma unroll
            for (int ai = 0; ai < 2; ++ai)
#pragma unroll
                for (int m = 0; m < 4; ++m) { const int row = row0 + ai * HALF + m * 16;
                    f32x4 v0 = acc[ai][bj][m][0] + b0, v1 = acc[ai][bj][m][1] + b1;
#pragma unroll
                    for (int j = 0; j < 4; ++j) { const float s0 = fast_sigmoid(v0[j]), s1 = fast_sigmoid(v1[j]);
                        const float d0 = -0.60653066f * s0, d1 = -0.60653066f * s1;
                        v0[j] = mode == 0 ? d0 : (mode == 1 ? s0 : v0[j]); v1[j] = mode == 0 ? d1 : (mode == 1 ? s1 : v1[j]); }
                    *(u32x4*)(lout + (size_t)row * 3072 + pn * BM + bj * HALF + cin) = pack8(v0, v1); asm volatile("" ::: "memory"); } }
    }
};
template <class Epi, class Sched, bool ALIGN_EPI = false, bool SP2 = false>
__device__ __forceinline__ void gemm_phase(PG8_LAS unsigned char* lds, const Gemm g, const Sched& S, const Epi& E) {
    const int tid = threadIdx.x, wid = __builtin_amdgcn_readfirstlane(tid >> 6), lane = tid & 63, wr = wid >> 2, wc = wid & 3, fr = lane & 15, fq = lane >> 4;
    const int K = g.K, nt = K / BK, lda = g.lda ? g.lda : g.K;
    unsigned voffA[2], voffB[2];
#pragma unroll
    for (int i = 0; i < 2; ++i) { int R, C; stage_rc(tid * 16 + i * 8192, R, C); const int Rb = Epi::PERM ? ((R & ~31) + perm32(R & 31)) : R;
        voffA[i] = (unsigned)(R * lda + C) * 2u; voffB[i] = (unsigned)(Rb * K + C) * 2u; }
    const size_t kstep = (size_t)(BK * 2);
    const size_t hstep = (size_t)HALF * K * 2, hstepA = (size_t)HALF * lda * 2;
    const size_t tstep = 2 * hstep, tstepA = 2 * hstepA;
    const unsigned ldsw = (unsigned)wid * 1024u;
    const int aoff = lds_byte(wr * 64 + fr, fq * 8), boff = lds_byte(wc * 32 + fr, fq * 8);
#define PG8_SA(b, h) (((b) * 2 + (h)) * HTB)
#define PG8_SB(b, h) ((4 + (b) * 2 + (h)) * HTB)
#define PG8_STAGE(bufoff, gbase, voff) do { _Pragma("unroll") for (int _i = 0; _i < 2; ++_i) \
        __builtin_amdgcn_global_load_lds((const unsigned*)((const char*)(gbase) + (voff)[_i]), (PG8_LAS unsigned*)(lds + (bufoff) + ldsw + _i * 8192), 16, 0, 0); } while (0)
#define PG8_LDA(dst, b, h) do { _Pragma("unroll") for (int m = 0; m < 4; ++m) _Pragma("unroll") for (int k = 0; k < 2; ++k) dst[m][k] = *(const PG8_LAS bf16x8*)(lds + PG8_SA(b, h) + aoff + m * 2048 + k * 1024); } while (0)
#define PG8_LDB(dst, b, h) do { _Pragma("unroll") for (int n = 0; n < 2; ++n) _Pragma("unroll") for (int k = 0; k < 2; ++k) dst[n][k] = *(const PG8_LAS bf16x8*)(lds + PG8_SB(b, h) + boff + n * 2048 + k * 1024); } while (0)
#define PG8_MMA(ai, bj, At, Bt) do { __builtin_amdgcn_s_setprio(1); _Pragma("unroll") for (int k = 0; k < 2; ++k) _Pragma("unroll") for (int m = 0; m < 4; ++m) _Pragma("unroll") for (int n_ = 0; n_ < 2; ++n_) { const int n = (m & 1) ? 1 - n_ : n_; \
        acc[ai][bj][m][n] = __builtin_amdgcn_mfma_f32_16x16x32_bf16(Bt[n][k], At[m][k], acc[ai][bj][m][n], 0, 0, 0); PG8_SCHED; } __builtin_amdgcn_s_setprio(0); } while (0)
#define PG8_MMA2(ai, At, B0, B1) do { __builtin_amdgcn_s_setprio(1); _Pragma("unroll") for (int k = 0; k < 2; ++k) _Pragma("unroll") for (int s_ = 0; s_ < 16; ++s_) { \
        constexpr int HM[16] = {0, 0, 1, 1, 1, 1, 0, 0, 2, 2, 3, 3, 3, 3, 2, 2}, HQ[16] = {0, 1, 1, 0, 2, 3, 3, 2, 2, 3, 3, 2, 1, 0, 0, 1}; \
        const int m = HM[s_], q = HQ[s_], bj = q >> 1, n = q & 1; \
        acc[ai][bj][m][n] = __builtin_amdgcn_mfma_f32_16x16x32_bf16(bj ? B1[n][k] : B0[n][k], At[m][k], acc[ai][bj][m][n], 0, 0, 0); PG8_SCHED; } __builtin_amdgcn_s_setprio(0); } while (0)
#define PG8_WAIT_V(n) asm volatile("s_waitcnt vmcnt(" #n ")" ::: "memory")
#define PG8_WAIT_L(n) asm volatile("s_waitcnt lgkmcnt(" #n ")" ::: "memory")
#define PG8_BAR __builtin_amdgcn_s_barrier()
#define PG8_SCHED __builtin_amdgcn_sched_barrier(0)
    Unit cur, nxt; int ui = 0;
    if (!S.next(0, cur)) return;
    f32x4 acc[2][2][4][2];
#pragma unroll
    for (int a = 0; a < 2; ++a)
#pragma unroll
        for (int b = 0; b < 2; ++b)
#pragma unroll
            for (int m = 0; m < 4; ++m)
#pragma unroll
                for (int n = 0; n < 2; ++n) acc[a][b][m][n] = (f32x4){0.f, 0.f, 0.f, 0.f};
    bf16x8 At[4][2], B0[2][2], B1[2][2];
    const char* cA = (const char*)g.A + (size_t)cur.pm * tstepA; const char* cB = (const char*)g.Bt + (size_t)cur.pn * tstep;
    S.a_ready(cur);
    if constexpr (SP2) {
        PG8_STAGE(PG8_SB(0, 0), cB, voffB); PG8_STAGE(PG8_SB(0, 1), cB + hstep, voffB); PG8_STAGE(PG8_SA(0, 0), cA, voffA); PG8_STAGE(PG8_SA(0, 1), cA + hstepA, voffA);
        if (wr == 1) PG8_BAR;
        PG8_WAIT_V(2); PG8_BAR;
        PG8_STAGE(PG8_SB(1, 0), cB + kstep, voffB); PG8_STAGE(PG8_SA(1, 0), cA + kstep, voffA); PG8_STAGE(PG8_SB(1, 1), cB + hstep + kstep, voffB);
        PG8_WAIT_V(6); PG8_BAR;
    } else {
        PG8_STAGE(PG8_SB(0, 0), cB, voffB); PG8_STAGE(PG8_SA(0, 0), cA, voffA); PG8_STAGE(PG8_SB(0, 1), cB + hstep, voffB); PG8_STAGE(PG8_SA(0, 1), cA + hstepA, voffA);
        if (wr == 1) PG8_BAR;
        PG8_WAIT_V(4); PG8_BAR;
        PG8_STAGE(PG8_SB(1, 0), cB + kstep, voffB); PG8_STAGE(PG8_SA(1, 0), cA + kstep, voffA); PG8_STAGE(PG8_SB(1, 1), cB + hstep + kstep, voffB);
        PG8_WAIT_V(6); PG8_BAR;
    }
    for (;;) {
        const bool has_next = S.next(ui + 1, nxt);
        const char* nA = has_next ? (const char*)g.A + (size_t)nxt.pm * tstepA : cA; const char* nB = has_next ? (const char*)g.Bt + (size_t)nxt.pn * tstep : cB;
        for (int t = 0; t < nt; t += 2) {
            const bool last = (t == nt - 2);
            const char* a1 = cA + (size_t)(t + 1) * kstep;
            const char* a2 = last ? nA : cA + (size_t)(t + 2) * kstep; const char* b2 = last ? nB : cB + (size_t)(t + 2) * kstep;
            const char* a3 = a2 + kstep; const char* b3 = b2 + kstep;
            if (last && has_next) S.a_ready(nxt);
            if constexpr (SP2) {
            PG8_LDB(B0, 0, 0); PG8_LDB(B1, 0, 1); PG8_SCHED; PG8_LDA(At, 0, 0); PG8_STAGE(PG8_SA(1, 1), a1 + hstepA, voffA);
            PG8_WAIT_V(8); PG8_WAIT_L(0); PG8_BAR; PG8_MMA2(0, At, B0, B1); PG8_BAR; PG8_SCHED;
            PG8_LDA(At, 0, 1); PG8_STAGE(PG8_SB(0, 0), b2, voffB); PG8_STAGE(PG8_SB(0, 1), b2 + hstep, voffB); PG8_STAGE(PG8_SA(0, 0), a2, voffA);
            PG8_WAIT_V(8); PG8_WAIT_L(0); PG8_BAR; PG8_MMA2(1, At, B0, B1); PG8_BAR; PG8_SCHED;
            PG8_LDB(B0, 1, 0); PG8_LDB(B1, 1, 1); PG8_SCHED; PG8_LDA(At, 1, 0); PG8_STAGE(PG8_SA(0, 1), a2 + hstepA, voffA);
            PG8_WAIT_V(8); PG8_WAIT_L(0); PG8_BAR; PG8_MMA2(0, At, B0, B1); PG8_BAR; PG8_SCHED;
            PG8_LDA(At, 1, 1); PG8_STAGE(PG8_SB(1, 0), b3, voffB); PG8_STAGE(PG8_SB(1, 1), b3 + hstep, voffB); PG8_STAGE(PG8_SA(1, 0), a3, voffA);
            PG8_WAIT_V(8); PG8_WAIT_L(0); PG8_BAR; PG8_MMA2(1, At, B0, B1); PG8_BAR; PG8_SCHED;
            } else {
            PG8_LDB(B0, 0, 0); PG8_SCHED; PG8_LDA(At, 0, 0); PG8_STAGE(PG8_SA(1, 1), a1 + hstepA, voffA);
            PG8_WAIT_L(8); PG8_BAR; PG8_WAIT_L(0); PG8_MMA(0, 0, At, B0); PG8_BAR; PG8_SCHED;
            PG8_LDB(B1, 0, 1); PG8_STAGE(PG8_SB(0, 0), b2, voffB);
            PG8_BAR; PG8_WAIT_L(0); PG8_MMA(0, 1, At, B1); PG8_BAR;
            PG8_LDA(At, 0, 1); PG8_STAGE(PG8_SA(0, 0), a2, voffA);
            PG8_BAR; PG8_WAIT_L(0); PG8_MMA(1, 0, At, B0); PG8_BAR; PG8_SCHED;
            PG8_STAGE(PG8_SB(0, 1), b2 + hstep, voffB);
            PG8_WAIT_V(6); PG8_BAR; PG8_MMA(1, 1, At, B1); PG8_BAR;
            PG8_LDB(B0, 1, 0); PG8_SCHED; PG8_LDA(At, 1, 0); PG8_STAGE(PG8_SA(0, 1), a2 + hstepA, voffA);
            PG8_WAIT_L(8); PG8_BAR; PG8_WAIT_L(0); PG8_MMA(0, 0, At, B0); PG8_BAR; PG8_SCHED;
            PG8_LDB(B1, 1, 1); PG8_STAGE(PG8_SB(1, 0), b3, voffB);
            PG8_BAR; PG8_WAIT_L(0); PG8_MMA(0, 1, At, B1); PG8_BAR;
            PG8_LDA(At, 1, 1); PG8_STAGE(PG8_SA(1, 0), a3, voffA);
            PG8_BAR; PG8_WAIT_L(0); PG8_MMA(1, 0, At, B0); PG8_BAR; PG8_SCHED;
            PG8_STAGE(PG8_SB(1, 1), b3 + hstep, voffB);
            PG8_WAIT_V(6); PG8_BAR; PG8_MMA(1, 1, At, B1); PG8_BAR;
            }
        }
        if constexpr (ALIGN_EPI) { if (wr == 0) PG8_BAR; }
        if constexpr (!Epi::AFTER_DRAIN) { E(acc, cur, wr, wc, fr, fq); S.done(cur); }
        if (!has_next) break;
#pragma unroll
        for (int a = 0; a < 2; ++a)
#pragma unroll
            for (int b = 0; b < 2; ++b)
#pragma unroll
                for (int m = 0; m < 4; ++m)
#pragma unroll
                    for (int n = 0; n < 2; ++n) acc[a][b][m][n] = (f32x4){0.f, 0.f, 0.f, 0.f};
        cur = nxt; cA = nA; cB = nB; ++ui;
        if constexpr (ALIGN_EPI) { if (wr == 1) PG8_BAR; }
    }
    PG8_WAIT_V(0);
    if constexpr (!ALIGN_EPI) { if (wr == 0) PG8_BAR; }
    PG8_BAR;
    if constexpr (Epi::AFTER_DRAIN) { E.fused(acc, cur, wr, wc, fr, fq, lds, wid, lane); S.done(cur); }
#undef PG8_SA
#undef PG8_SB
#undef PG8_STAGE
#undef PG8_LDA
#undef PG8_LDB
#undef PG8_MMA
#undef PG8_WAIT_V
#undef PG8_WAIT_L
#undef PG8_BAR
#undef PG8_SCHED
}
}

constexpr int NWAVES = 8;
constexpr int BATCH = 4, SEQ = 8192, D = 2048, M = BATCH * SEQ, FF = 5632;
constexpr int RC = 1024, RH = 16, RN = 64;
constexpr int HC = 1024, HH = 8, HD = 128;
constexpr int RWKV_COLS = 3360, IN_COLS = 7456, NIN = 7680;
constexpr int KL = 384, NL = 3072;
#ifndef MK_N_LAUNCHES
#define MK_N_LAUNCHES 1
#endif
constexpr int N_PHASES = 12;

constexpr size_t WS_CTL = 0, CTL_BYTES = 1u << 20;
constexpr size_t WS_W1GU = CTL_BYTES;
constexpr size_t WS_W1D = WS_W1GU + (size_t)2 * FF * D * 2;
constexpr size_t WS_WIN = WS_W1D + (size_t)D * FF * 2;
constexpr size_t WS_WLORA = WS_WIN + (size_t)NIN * D * 2;
constexpr size_t WS_WOUT = WS_WLORA + (size_t)NL * KL * 2;
constexpr size_t WS_W2GU = WS_WOUT + (size_t)D * D * 2;
constexpr size_t WS_W2D = WS_W2GU + (size_t)2 * FF * D * 2;
constexpr size_t WS_SS = WS_W2D + (size_t)D * FF * 2;
constexpr size_t WS_XB = WS_SS + (1u << 20);
constexpr size_t WS_R = WS_XB + (size_t)M * D * 2;
constexpr size_t R_ACT = 0;
constexpr size_t R_RKV = 0;
constexpr size_t R_HG = R_RKV + (size_t)M * 3072 * 2;
constexpr size_t R_LIN = R_HG + (size_t)M * 4096 * 2;
constexpr size_t R_BYTES = R_LIN + (size_t)M * 288 * 4;
constexpr size_t WS_ALORA = WS_R + R_BYTES;
constexpr size_t WS_LOUT = WS_ALORA + (size_t)M * KL * 2;
constexpr size_t WS_INVN = WS_LOUT + (size_t)M * NL * 2;
constexpr size_t WS_END = WS_INVN + (size_t)M * RH * 4;
static_assert(WS_END <= ((size_t)1 << 30), "d_ws map");
constexpr int CW_PCNT = 8704;
constexpr int CW_SIG_HALF = 8192, CW_SIG_SHA = 8256, CW_SIG_SHB = 8320, CW_SIG_P4 = 8384, CW_SIG_H2 = 8448;
constexpr int CW_BAR = 4096;

constexpr int RING_BYTES = 162816;
constexpr int LDSCTL_OFF = RING_BYTES, MISC_OFF = LDSCTL_OFF + 320;
constexpr int LDS_BYTES = 163840;
static_assert(MISC_OFF + 128 <= LDS_BYTES, "LDS map");

#define GAS __attribute__((address_space(1)))
#define LAS __attribute__((address_space(3)))
typedef unsigned short bf16;
typedef unsigned v4u __attribute__((ext_vector_type(4)));
typedef unsigned v2u __attribute__((ext_vector_type(2)));
typedef float f32x4 __attribute__((ext_vector_type(4)));
#define LDS_WAIT() asm volatile("s_waitcnt lgkmcnt(0)" ::: "memory")
#define VM_WAIT() asm volatile("s_waitcnt vmcnt(0)" ::: "memory")
__device__ __forceinline__ float bflo(unsigned u) { return __builtin_bit_cast(float, u << 16); }
__device__ __forceinline__ float bfhi(unsigned u) { return __builtin_bit_cast(float, u & 0xffff0000u); }
__device__ __forceinline__ f32x4 unpack4(v2u w) { return (f32x4){bflo(w.x), bfhi(w.x), bflo(w.y), bfhi(w.y)}; }
__device__ __forceinline__ unsigned pk2(float lo, float hi) { return pg8::cvt_pk_bf16(lo, hi); }
__device__ __forceinline__ v2u pack4(f32x4 v) { v2u w; w.x = pk2(v[0], v[1]); w.y = pk2(v[2], v[3]); return w; }
using pg8::fast_sigmoid;
using pg8::fast_silu;
template <int CTRL> __device__ __forceinline__ float dpp_mov(float x) { return __builtin_bit_cast(float, __builtin_amdgcn_update_dpp(0, __builtin_bit_cast(int, x), CTRL, 0xF, 0xF, true)); }
__device__ __forceinline__ float row16_sum(float x) { x += dpp_mov<0x128>(x); x += dpp_mov<0x124>(x); x += dpp_mov<0x122>(x); x += dpp_mov<0x121>(x); return x; }
template <int CTRL, int BANK> __device__ __forceinline__ float dpp_upd(float old, float x) { return __builtin_bit_cast(float, __builtin_amdgcn_update_dpp(__builtin_bit_cast(int, old), __builtin_bit_cast(int, x), CTRL, 0xF, BANK, false)); }
__device__ __forceinline__ float tr_reduce16(const float (&v)[16], int lane) {
    float u[8], w[4], x[2];
#pragma unroll
    for (int s = 0; s < 8; ++s) { const float t = v[s + 8] + dpp_mov<0x128>(v[s + 8]), a = v[s] + dpp_mov<0x128>(v[s]); u[s] = dpp_upd<0xE4, 0x3>(t, a); }
#pragma unroll
    for (int s = 0; s < 4; ++s) { const float t = u[s + 4] + dpp_mov<0x141>(u[s + 4]), a = u[s] + dpp_mov<0x141>(u[s]); w[s] = dpp_upd<0xE4, 0x5>(t, a); }
    const bool b1 = (lane & 2) != 0, b0 = (lane & 1) != 0;
#pragma unroll
    for (int s = 0; s < 2; ++s) { const float K = b1 ? w[s + 2] : w[s], T = b1 ? w[s] : w[s + 2]; x[s] = K + dpp_mov<0x1B>(T); }
    const float K = b0 ? x[1] : x[0], T = b0 ? x[0] : x[1];
    return K + dpp_mov<0xB1>(T);
}
typedef float f32x2 __attribute__((ext_vector_type(2)));
#define LO2(v) __builtin_shufflevector(v, v, 0, 1)
#define HI2(v) __builtin_shufflevector(v, v, 2, 3)
__device__ __forceinline__ float wave_sum(float v) {
#pragma unroll
    for (int o = 1; o < 64; o <<= 1) v += __shfl_xor(v, o);
    return v;
}
#define XB_TMO      128
#define XB_XCNT(j)  (256  + 64 * (j))
#define XB_XSUB(j)  (1280 + 64 * (j))
#define XB_XGEN(j)  (2304 + 64 * (j))
#define XB_TOP      3328
#define XB_TOPGEN   3392
#define XCD_BAR_WORDS 3456
#define XB_SPIN_CAP (1u << 18)

__device__ __forceinline__ unsigned xb_ld(unsigned* p)              { return __hip_atomic_load(p, __ATOMIC_RELAXED, __HIP_MEMORY_SCOPE_AGENT); }
__device__ __forceinline__ unsigned xb_add(unsigned* p, unsigned v) { return __hip_atomic_fetch_add(p, v, __ATOMIC_RELAXED, __HIP_MEMORY_SCOPE_AGENT); }
__device__ __forceinline__ unsigned xb_xcc_id() { return (unsigned)__builtin_amdgcn_s_getreg((3 << 11) | 20) & 0xFu; }
#define XB_SPIN(cond, bar) do { unsigned _sp = 0; while (cond) { __builtin_amdgcn_s_sleep(1); \
    if ((++_sp & 255u) == 0u) { if (xb_ld(&(bar)[XB_TMO])) break; if (_sp > XB_SPIN_CAP) { atomicAdd(&(bar)[XB_TMO], 1u); break; } } } } while (0)

struct XcdBarrier {
    unsigned* bar; unsigned x;
    volatile LAS unsigned* st;
};

__device__ __forceinline__ XcdBarrier xcd_barrier_post(unsigned* bar, volatile LAS unsigned* st) {
    XcdBarrier b; b.bar = bar; b.x = xb_xcc_id(); b.st = st;
    if (threadIdx.x == 0) (void)xb_add(&bar[XB_XCNT(b.x)], 1u);
    return b;
}
__device__ __forceinline__ void xcd_barrier_complete(unsigned* bar, unsigned x, unsigned& nloc, unsigned& nx) {
    const unsigned G = gridDim.x * gridDim.y * gridDim.z;
    unsigned sum, cnt, mine, sp = 0u;
    for (;;) {
        sum = 0u; cnt = 0u; mine = 0u;
#pragma unroll
        for (unsigned j = 0; j < 16; ++j) { const unsigned c = xb_ld(&bar[XB_XCNT(j)]); sum += c; cnt += (c > 0u) ? 1u : 0u; mine = (j == x) ? c : mine; }
        if (sum == G) break;
        __builtin_amdgcn_s_sleep(1);
        if ((++sp & 255u) == 0u) { if (xb_ld(&bar[XB_TMO])) break; if (sp > XB_SPIN_CAP) { atomicAdd(&bar[XB_TMO], 1u); break; } }
    }
    nloc = mine > 0u ? mine : 1u; nx = cnt > 0u ? cnt : 1u;
}

__device__ __forceinline__ void xcd_barrier(const XcdBarrier& b) {
    asm volatile("s_waitcnt vmcnt(0)" ::: "memory");
    __syncthreads();
    if (threadIdx.x == 0) {
        unsigned* bar = b.bar;
        __builtin_amdgcn_s_waitcnt(0);
        unsigned nloc = b.st[0], nx = b.st[1];
        if (nloc == 0u) { xcd_barrier_complete(bar, b.x, nloc, nx); b.st[0] = nloc; b.st[1] = nx; }
        const unsigned old = xb_add(&bar[XB_XSUB(b.x)], 1u);
        const unsigned gen = old / nloc;
        if (old + 1u == (gen + 1u) * nloc) {
            __builtin_amdgcn_fence(__ATOMIC_RELEASE, "agent");
            asm volatile("s_waitcnt vmcnt(0)" ::: "memory");
            const unsigned og = xb_add(&bar[XB_TOP], 1u);
            const unsigned tg = og / nx;
            if (og + 1u == (tg + 1u) * nx) xb_add(&bar[XB_TOPGEN], 1u);
            else XB_SPIN(xb_ld(&bar[XB_TOPGEN]) == tg, bar);
            __builtin_amdgcn_fence(__ATOMIC_ACQUIRE, "agent");
            xb_add(&bar[XB_XGEN(b.x)], 1u);
            asm volatile("s_waitcnt vmcnt(0)" ::: "memory");
        } else {
            XB_SPIN(xb_ld(&bar[XB_XGEN(b.x)]) == gen, bar);
            __builtin_amdgcn_fence(__ATOMIC_ACQUIRE, "agent");
            asm volatile("s_waitcnt vmcnt(0)" ::: "memory");
        }
    }
    __syncthreads();
}

__device__ __forceinline__ void sig_post(unsigned* ctr) {
    __builtin_amdgcn_fence(__ATOMIC_RELEASE, "agent"); asm volatile("s_waitcnt vmcnt(0)" ::: "memory"); (void)xb_add(ctr, 1u);
}
__device__ __forceinline__ void wg_signal(unsigned* ctr) {
    asm volatile("s_waitcnt vmcnt(0)" ::: "memory"); __syncthreads();
    if (threadIdx.x == 0) sig_post(ctr);
}
__device__ __forceinline__ void wg_wait(unsigned* ctr, unsigned target, unsigned* bar) {
    if (threadIdx.x == 0) { XB_SPIN(xb_ld(ctr) < target, bar); __builtin_amdgcn_fence(__ATOMIC_ACQUIRE, "agent"); asm volatile("s_waitcnt vmcnt(0)" ::: "memory"); }
    __syncthreads();
}

struct Frame {
    LAS unsigned char* lds;
    int tid, lane, wave, vcu, G;
    const float* in[26];
    float* out; unsigned char* ws;
};
#define WSP(T, off) ((T*)(F.ws + (off)))
struct Args { const float* in[26]; float* out; unsigned char* ws; int ph_lo, ph_hi; };

struct P0Item { const float* W; bf16* WT; int K, N, kb, n0, drow0; };
__device__ __forceinline__ int map_gu(int n0, int which) { return (n0 >> 7) * 256 + which * 128 + (n0 & 127); }
constexpr int P0_I_GU = (D / 64) * (FF / 32), P0_I_DN = (FF / 64) * (D / 32), P0_I_IN = (D / 64) * (IN_COLS / 32), P0_I_OUT = (D / 64) * (D / 32);
constexpr int P0_N0 = 2 * P0_I_GU + P0_I_DN + P0_I_IN, P0_N1 = 2 * P0_I_GU + P0_I_DN + P0_I_OUT;
template <int SET> __device__ __forceinline__ P0Item p0_decode(Frame& F, const Args& A, int it) {
    constexpr int I_GU = P0_I_GU, I_DN = P0_I_DN, I_IN = P0_I_IN;
    P0Item p; int r = it;
    if (SET == 0) { if (r >= 2 * I_GU) r += 2 * I_GU; if (r >= 4 * I_GU + I_DN) r += I_DN; }
    else { r += 2 * I_GU; if (r >= 4 * I_GU) r += I_DN; if (r >= 4 * I_GU + 2 * I_DN) r += I_IN; }
    if (r < 4 * I_GU) { const int mat = r / I_GU; r -= mat * I_GU; const int nblk = FF / 32, ffn = mat >> 1, which = mat & 1;
        p.W = A.in[2 + 20 * ffn + which]; p.WT = WSP(bf16, ffn ? WS_W2GU : WS_W1GU); p.K = D; p.N = FF; p.kb = r / nblk; p.n0 = 32 * (r % nblk); p.drow0 = map_gu(p.n0, which); return p; }
    r -= 4 * I_GU;
    if (r < 2 * I_DN) { const int ffn = r / I_DN; r -= ffn * I_DN; const int nblk = D / 32;
        p.W = A.in[4 + 20 * ffn]; p.WT = WSP(bf16, ffn ? WS_W2D : WS_W1D); p.K = FF; p.N = D; p.kb = r / nblk; p.n0 = 32 * (r % nblk); p.drow0 = p.n0; return p; }
    r -= 2 * I_DN;
    if (r < I_IN) { const int nblk = IN_COLS / 32;
        p.W = A.in[6]; p.WT = WSP(bf16, WS_WIN); p.K = D; p.N = IN_COLS; p.kb = r / nblk; p.n0 = 32 * (r % nblk); p.drow0 = p.n0 < RWKV_COLS ? p.n0 : p.n0 + 224; return p; }
    r -= I_IN;
    { const int nblk = D / 32; p.W = A.in[20]; p.WT = WSP(bf16, WS_WOUT); p.K = D; p.N = D; p.kb = r / nblk; p.n0 = 32 * (r % nblk); p.drow0 = p.n0; return p; }
}
__device__ __forceinline__ void p0_dma(const P0Item& p, LAS unsigned char* tile, int lane) {
    const int half = lane >> 5, sl = lane & 31;
#pragma unroll 8
    for (int i = 0; i < 32; ++i) { const int kk = 2 * i + half;
        __builtin_amdgcn_global_load_lds((const GAS unsigned*)(p.W + (size_t)(64 * p.kb + kk) * p.N + p.n0 + (sl ^ (4 * (kk >> 3)))), (LAS unsigned*)(tile + i * 256), 4, 0, 0); }
}
__device__ __forceinline__ void p0_emit(const P0Item& p, const LAS float* t, int lane) {
    const int c = lane & 7;
#pragma unroll
    for (int j = 0; j < 4; ++j) { const int n = (lane >> 3) + 8 * j; const LAS float* s = t + (8 * c) * 32 + (n ^ (4 * c));
        v4u o; o.x = pk2(s[0 * 32], s[1 * 32]); o.y = pk2(s[2 * 32], s[3 * 32]); o.z = pk2(s[4 * 32], s[5 * 32]); o.w = pk2(s[6 * 32], s[7 * 32]);
        *(GAS v4u*)(p.WT + (size_t)(p.drow0 + n) * p.K + 64 * p.kb + 8 * c) = o; }
}
template <int SET> __device__ __forceinline__ void p0_transposes(Frame& F, const Args& A, int gw, int NGW) {
    LAS unsigned char* tiles = F.lds + F.wave * 16384;
    constexpr int NITEMS = SET == 0 ? P0_N0 : P0_N1;
    if (gw < NITEMS) {
        P0Item cur = p0_decode<SET>(F, A, gw); int buf = 0;
        p0_dma(cur, tiles, F.lane);
        for (int it = gw; it < NITEMS; it += NGW) {
            const bool more = it + NGW < NITEMS; P0Item nxt = cur;
            if (more) { nxt = p0_decode<SET>(F, A, it + NGW); p0_dma(nxt, tiles + (buf ^ 1) * 8192, F.lane); asm volatile("s_waitcnt vmcnt(32)" ::: "memory"); }
            else asm volatile("s_waitcnt vmcnt(0)" ::: "memory");
            p0_emit(cur, (const LAS float*)(tiles + buf * 8192), F.lane);
            LDS_WAIT(); asm volatile("" ::: "memory");
            cur = nxt; buf ^= 1;
        }
        asm volatile("s_waitcnt vmcnt(0)" ::: "memory");
    }
}
__device__ __forceinline__ void p0_prologue(Frame& F, const Args& A) {
    const int gw = F.vcu * NWAVES + F.wave, NGW = F.G * NWAVES;
    p0_transposes<0>(F, A, gw, NGW);
    const size_t gt = (size_t)F.vcu * (NWAVES * 64) + F.tid, NT = (size_t)F.G * NWAVES * 64;
    { GAS v4u* z = (GAS v4u*)(WSP(bf16, WS_WIN) + (size_t)RWKV_COLS * D);
      for (size_t i = gt; i < (size_t)224 * D * 2 / 16; i += NT) z[i] = (v4u){0u, 0u, 0u, 0u}; }
    { bf16* wl = WSP(bf16, WS_WLORA); const float* w2 = F.in[9]; const float* a2 = F.in[11]; const float* g2 = F.in[12];
      for (size_t i = gt; i < (size_t)2048 * 64; i += NT) { const int n = (int)(i >> 6), k = 2 * (int)(i & 63); const int seg = n >> 10, c = n & 1023;
          float v0 = 0.f, v1 = 0.f;
          if (seg == 0) { if (k < 64) { v0 = w2[(size_t)k * RC + c]; v1 = w2[(size_t)(k + 1) * RC + c]; } }
          else { if (k >= 64) { v0 = a2[(size_t)(k - 64) * RC + c]; v1 = a2[(size_t)(k - 63) * RC + c]; } }
          ((GAS unsigned*)wl)[i] = pk2(v0, v1); }
      GAS unsigned* wg = (GAS unsigned*)(wl + (size_t)2048 * 128);
      for (size_t i = gt; i < (size_t)1024 * 128; i += NT) { const int c = (int)(i >> 7), k = 2 * (int)(i & 127);
          float v0 = 0.f, v1 = 0.f;
          if (k < 160) { v0 = g2[(size_t)k * RC + c]; v1 = g2[(size_t)(k + 1) * RC + c]; }
          wg[i] = pk2(v0, v1); } }
    { GAS unsigned long long* s = (GAS unsigned long long*)(F.ws + WS_SS) + M;
      for (size_t i = gt; i < (size_t)3 * M; i += NT) s[i] = 0ull; }
    { const float* x = F.in[0]; bf16* xb = WSP(bf16, WS_XB); unsigned long long* ss0 = WSP(unsigned long long, WS_SS);
      for (int m = gw; m < M; m += NGW) { const GAS f32x4* xr = (const GAS f32x4*)(x + (size_t)m * D) + 2 * F.lane; GAS v4u* o = (GAS v4u*)(xb + (size_t)m * D) + F.lane; float s = 0.f;
#pragma unroll
          for (int j = 0; j < 4; ++j) { const f32x4 a = xr[128 * j], b = xr[128 * j + 1];
              s += (a[0] * a[0] + a[1] * a[1]) + (a[2] * a[2] + a[3] * a[3]) + (b[0] * b[0] + b[1] * b[1]) + (b[2] * b[2] + b[3] * b[3]);
              const f32x4 ga = *(const f32x4*)(F.in[1] + 8 * F.lane + 512 * j), gb = *(const f32x4*)(F.in[1] + 8 * F.lane + 512 * j + 4);
              o[64 * j] = pg8::pack8(a * ga, b * gb); }
          s = wave_sum(s);
          if (F.lane == 0) ss0[m] = (unsigned long long)(s * pg8::SS_SCALE + 0.5f); } }
}

__device__ __forceinline__ void p4_lora_in(Frame& F, int hsel, int c, int G) {
    const int NR = hsel < 0 ? M : M / 2;
#define P4_ROW(i_) (hsel < 0 ? (i_) : ((i_) / (SEQ / 2)) * SEQ + ((i_) % (SEQ / 2)) + hsel * (SEQ / 2))
    const float* lin = WSP(float, WS_R + R_LIN); bf16* al = WSP(bf16, WS_ALORA); const float* mu = F.in[7] + 3 * RC;
    const size_t gt = (size_t)c * (NWAVES * 64) + F.tid, NT = (size_t)G * NWAVES * 64;
#pragma unroll 4
    for (size_t i = gt; i < (size_t)NR * 96; i += NT) { const int mi = (int)(i / 96), m = P4_ROW(mi), q = (int)(i % 96), qc = q < 72 ? q : 0; const bool first = (m & (SEQ - 1)) == 0;
        const f32x4 p = *(const GAS f32x4*)(lin + (size_t)m * 288 + 4 * qc), pr = *(const GAS f32x4*)(lin + (size_t)(first ? m : m - 1) * 288 + 4 * qc), mv = *(const GAS f32x4*)(mu + 4 * qc);
        const f32x4 pp = first ? (f32x4){0.f, 0.f, 0.f, 0.f} : pr; f32x4 s = p + (pp - p) * mv;
#pragma unroll
        for (int j = 0; j < 4; ++j) { const float sg = fast_sigmoid(q < 16 ? 2.0f * s[j] : s[j]); s[j] = q < 16 ? 2.0f * sg - 1.0f : (q >= 32 ? sg : s[j]); }
        v2u o = pack4(s); if (q >= 72) o = (v2u){0u, 0u};
        *(GAS v2u*)(al + (size_t)m * KL + 4 * q) = o; }
    { const bf16* rkv = WSP(bf16, WS_R + R_RKV); float* invn = WSP(float, WS_INVN); const int j4 = (F.tid & 15) * 4;
      const size_t it0 = gt >> 4, step = NT >> 4; const int h = (int)(it0 & 15), ch = h * RN + j4;
      const f32x4 muk = *(const f32x4*)(F.in[7] + RC + ch), kkc = *(const f32x4*)(F.in[13] + ch);
      if ((step & 15) == 0) {
#pragma unroll 4
          for (size_t it = it0; it < (size_t)NR * RH; it += step) { const int mi = (int)(it >> 4), m = P4_ROW(mi); const bool first = (m & (SEQ - 1)) == 0;
              const f32x4 k = unpack4(*(const GAS v2u*)(rkv + (size_t)m * 3072 + RC + ch)), kr = unpack4(*(const GAS v2u*)(rkv + (size_t)(first ? m : m - 1) * 3072 + RC + ch));
              const f32x4 kp = first ? (f32x4){0.f, 0.f, 0.f, 0.f} : kr;
              const f32x4 kk = (k + (kp - k) * muk) * kkc; float s2 = (kk[0] * kk[0] + kk[1] * kk[1]) + (kk[2] * kk[2] + kk[3] * kk[3]); s2 = row16_sum(s2);
              if ((F.tid & 15) == 0) invn[(size_t)m * RH + h] = 1.0f / fmaxf(sqrtf(s2), 1e-12f); }
      } else {
          for (size_t it = it0; it < (size_t)NR * RH; it += step) { const int mi = (int)(it >> 4), m = P4_ROW(mi), h2 = (int)(it & 15), c2 = h2 * RN + j4; const bool first = (m & (SEQ - 1)) == 0;
              const f32x4 k = unpack4(*(const GAS v2u*)(rkv + (size_t)m * 3072 + RC + c2)), kr = unpack4(*(const GAS v2u*)(rkv + (size_t)(first ? m : m - 1) * 3072 + RC + c2));
              const f32x4 kp = first ? (f32x4){0.f, 0.f, 0.f, 0.f} : kr; const f32x4 mk2 = *(const f32x4*)(F.in[7] + RC + c2), kc2 = *(const f32x4*)(F.in[13] + c2);
              const f32x4 kk = (k + (kp - k) * mk2) * kc2; float s2 = (kk[0] * kk[0] + kk[1] * kk[1]) + (kk[2] * kk[2] + kk[3] * kk[3]); s2 = row16_sum(s2);
              if ((F.tid & 15) == 0) invn[(size_t)m * RH + h2] = 1.0f / fmaxf(sqrtf(s2), 1e-12f); } } }
#undef P4_ROW
}

typedef short bf16x4 __attribute__((ext_vector_type(4)));
typedef short bf16x8 __attribute__((ext_vector_type(8)));
#define MFMA32(a, b, c) __builtin_amdgcn_mfma_f32_16x16x32_bf16(a, b, c, 0, 0, 0)
#define MFMA16(a, b, c) __builtin_amdgcn_mfma_f32_16x16x16bf16_1k(a, b, c, 0, 0, 0)
__device__ __forceinline__ bf16x4 cv4(f32x4 v) { v2u w; w.x = pk2(v[0], v[1]); w.y = pk2(v[2], v[3]); return __builtin_bit_cast(bf16x4, w); }
__device__ __forceinline__ bf16x8 cv8(f32x4 a, f32x4 b) { v4u w; w.x = pk2(a[0], a[1]); w.y = pk2(a[2], a[3]); w.z = pk2(b[0], b[1]); w.w = pk2(b[2], b[3]); return __builtin_bit_cast(bf16x8, w); }
__device__ __forceinline__ bf16x8 cat8(bf16x4 a, bf16x4 b) { return __builtin_shufflevector(a, b, 0, 1, 2, 3, 4, 5, 6, 7); }
__device__ __forceinline__ bf16x8 join8(v2u a, v2u b) { v4u w; w.x = a.x; w.y = a.y; w.z = b.x; w.w = b.y; return __builtin_bit_cast(bf16x8, w); }
__device__ __forceinline__ float row16_scan(float x) { x += dpp_mov<0x111>(x); x += dpp_mov<0x112>(x); x += dpp_mov<0x114>(x); x += dpp_mov<0x118>(x); return x; }
__device__ __forceinline__ unsigned short bf1(float x) { return (unsigned short)(pk2(x, 0.f) & 0xffffu); }
constexpr int CH = 16;
constexpr int RWS = 144;
constexpr int HGS = 272;
constexpr int RWB_KG = 0, RWB_RG = 16 * RWS, RWB_KTI = 32 * RWS, RWB_BTI = 48 * RWS, RWB_V = 64 * RWS, RWB_GL = 80 * RWS, RWB_BYTES = RWB_GL + 256;
__device__ __forceinline__ bf16x4 lds_tr4(const LAS unsigned char* p) { return __builtin_amdgcn_ds_read_tr16_b64_v4i16((LAS bf16x4*)p); }
constexpr int HGB_QG = 0, HGB_KI = 16 * HGS, HGB_KIT = 32 * HGS, HGB_VT = HGB_KIT + 4096, HGB_GL = HGB_VT + 4096, HGB_BYTES = HGB_GL + 512;

__device__ __forceinline__ f32x4 padc(f32x4 r) { asm("s_nop 15" : "+v"(r)); return r; }
constexpr int NCHK = SEQ / CH;
constexpr int NRAW = 8;
constexpr int RWR_R = 0, RWR_K = 2048, RWR_V = 4096, RWR_LW = 6144, RWR_A = 8192, RWR_INV = 10240, RWR_BYTES = 10304;
constexpr int RW_OPND = 0, RW_RAW = 3 * RWB_BYTES, RW_AOP = RW_RAW + NRAW * RWR_BYTES, RW_LDS = RW_AOP + 2 * 2048;
constexpr int HGR_Q = 0, HGR_LF = 4096, HGR_V = 8192, HGR_BYTES = 12288;
constexpr int HG_OPND = 0, HG_RAW = 3 * HGB_BYTES, HG_AOP = HG_RAW + NRAW * HGR_BYTES, HG_LDS = HG_AOP + 2 * 512;
static_assert(RW_LDS <= RING_BYTES && HG_LDS <= RING_BYTES && RW_AOP % 16 == 0 && HG_AOP % 16 == 0, "scan LDS map");
#define GLDS4(gptr, lptr) __builtin_amdgcn_global_load_lds((const GAS unsigned*)(gptr), (LAS unsigned*)(lptr), 4, 0, 0)
#define WG_BAR() do { LDS_WAIT(); __builtin_amdgcn_s_barrier(); asm volatile("" ::: "memory"); } while (0)

__device__ __forceinline__ void p6_rwkv_head(Frame& F, int bh, int nsh) {
    const bf16* rkv = WSP(bf16, WS_R + R_RKV); const bf16* lout = WSP(bf16, WS_LOUT); const float* invn = WSP(float, WS_INVN); bf16* ydst = WSP(bf16, WS_LOUT);
    const int lane = F.lane, c = lane & 15, g = lane >> 4, w = F.wave;
    const int b = bh >> 4, h = bh & 15;
    const size_t rowbase = (size_t)b * SEQ;
    const int st = lane & 15, k0 = 2 * (w * 4 + (lane >> 4)), chn = h * RN + k0;
    const float mur0 = F.in[7][chn], mur1 = F.in[7][chn + 1], muk0 = F.in[7][RC + chn], muk1 = F.in[7][RC + chn + 1], muv0 = F.in[7][2 * RC + chn], muv1 = F.in[7][2 * RC + chn + 1];
    const float kk0 = F.in[13][chn], kk1 = F.in[13][chn + 1], ka0 = F.in[14][chn], ka1 = F.in[14][chn + 1];
    LAS unsigned char* const opnd = F.lds + RW_OPND; LAS unsigned char* const raw = F.lds + RW_RAW; LAS unsigned char* const aop = F.lds + RW_AOP;
#define RW3_DMA(j) do { const int r_ = 2 * w + (lane >> 5); const size_t ro_ = (rowbase + (size_t)(j) * CH + r_) * 3072 + h * RN + 2 * ((lane & 31) ^ r_); \
        LAS unsigned char* d_ = raw + ((j) % NRAW) * RWR_BYTES + w * 256; \
        GLDS4(rkv + ro_, d_ + RWR_R); GLDS4(rkv + ro_ + RC, d_ + RWR_K); GLDS4(rkv + ro_ + 2 * RC, d_ + RWR_V); GLDS4(lout + ro_, d_ + RWR_LW); GLDS4(lout + ro_ + RC, d_ + RWR_A); \
        if (lane < 2) GLDS4(invn + (rowbase + (size_t)(j) * CH + 2 * w + lane) * RH + h, raw + ((j) % NRAW) * RWR_BYTES + RWR_INV + w * 8); } while (0)
#define RW3_PROC(j) do { const LAS unsigned char* s_ = raw + ((j) % NRAW) * RWR_BYTES; const int pq_ = (k0 >> 1) ^ st, pp_ = (k0 >> 1) ^ ((st + 15) & 15); \
        const LAS unsigned char* sc_ = s_ + st * 128 + pq_ * 4; const LAS unsigned char* sp_ = ((st > 0) ? s_ + (st - 1) * 128 : raw + (((j) + NRAW - 1) % NRAW) * RWR_BYTES + 15 * 128) + pp_ * 4; \
        const bool first_ = ((j) == 0) && (st == 0); \
        const unsigned Lr = *(const LAS unsigned*)(sc_ + RWR_R), Lk = *(const LAS unsigned*)(sc_ + RWR_K), Lv = *(const LAS unsigned*)(sc_ + RWR_V); \
        const unsigned Lw = *(const LAS unsigned*)(sc_ + RWR_LW), La = *(const LAS unsigned*)(sc_ + RWR_A); \
        const unsigned Lrp = *(const LAS unsigned*)(sp_ + RWR_R), Lkp = *(const LAS unsigned*)(sp_ + RWR_K), Lvp = *(const LAS unsigned*)(sp_ + RWR_V); \
        const float Linv = *(const LAS float*)(s_ + RWR_INV + st * 4); \
        const float r0_ = bflo(Lr), r1_ = bfhi(Lr), q0_ = bflo(Lk), q1_ = bfhi(Lk), v0_ = bflo(Lv), v1_ = bfhi(Lv); \
        const float rp0_ = first_ ? 0.f : bflo(Lrp), rp1_ = first_ ? 0.f : bfhi(Lrp), qp0_ = first_ ? 0.f : bflo(Lkp), qp1_ = first_ ? 0.f : bfhi(Lkp), vp0_ = first_ ? 0.f : bflo(Lvp), vp1_ = first_ ? 0.f : bfhi(Lvp); \
        const float rs0_ = r0_ + (rp0_ - r0_) * mur0, rs1_ = r1_ + (rp1_ - r1_) * mur1, ks0_ = q0_ + (qp0_ - q0_) * muk0, ks1_ = q1_ + (qp1_ - q1_) * muk1, vs0_ = v0_ + (vp0_ - v0_) * muv0, vs1_ = v1_ + (vp1_ - v1_) * muv1; \
        const float a0_ = bflo(La), a1_ = bfhi(La), lw0_ = bflo(Lw) * 1.44269504f, lw1_ = bfhi(Lw) * 1.44269504f; \
        const float kap0_ = ks0_ * kk0 * Linv, kap1_ = ks1_ * kk1 * Linv, bet0_ = kap0_ * a0_, bet1_ = kap1_ * a1_; \
        const float kt0_ = ks0_ * (1.0f + (a0_ - 1.0f) * ka0), kt1_ = ks1_ * (1.0f + (a1_ - 1.0f) * ka1); \
        const float G0_ = row16_scan(lw0_), G1_ = row16_scan(lw1_); \
        const float eg0_ = __builtin_amdgcn_exp2f(G0_), eg1_ = __builtin_amdgcn_exp2f(G1_), ep0_ = __builtin_amdgcn_exp2f(G0_ - lw0_), ep1_ = __builtin_amdgcn_exp2f(G1_ - lw1_), ei0_ = __builtin_amdgcn_exp2f(-G0_), ei1_ = __builtin_amdgcn_exp2f(-G1_); \
        LAS unsigned char* d_ = opnd + ((j) % 3) * RWB_BYTES; \
        *(LAS unsigned*)(d_ + RWB_KG + st * RWS + k0 * 2) = pk2(kap0_ * ep0_, kap1_ * ep1_); *(LAS unsigned*)(d_ + RWB_RG + st * RWS + k0 * 2) = pk2(rs0_ * eg0_, rs1_ * eg1_); \
        const unsigned kti_ = pk2(kt0_ * ei0_, kt1_ * ei1_), bti_ = pk2(bet0_ * ei0_, bet1_ * ei1_), vv_ = pk2(vs0_, vs1_); \
        *(LAS unsigned*)(d_ + RWB_KTI + st * RWS + k0 * 2) = kti_; *(LAS unsigned*)(d_ + RWB_BTI + st * RWS + k0 * 2) = bti_; \
        *(LAS unsigned*)(d_ + RWB_V + st * RWS + k0 * 2) = vv_; \
        if (st == 15) { *(LAS float*)(d_ + RWB_GL + k0 * 4) = eg0_; *(LAS float*)(d_ + RWB_GL + k0 * 4 + 4) = eg1_; } } while (0)
    const f32x4 zero4 = (f32x4){0.f, 0.f, 0.f, 0.f};
    auto a_stage = [&](int j) {
        const LAS unsigned char* rowp = opnd + (j % 3) * RWB_BYTES + c * RWS;
        const int offA = (w == 4 || w == 7) ? RWB_BTI : RWB_KTI;
        const int offB = (w == 4 || w == 5) ? RWB_KG : RWB_RG;
        const bf16x8 a0 = *(const LAS bf16x8*)(rowp + offA + 16 * g), a1 = *(const LAS bf16x8*)(rowp + offA + 64 + 16 * g);
        const bf16x8 b0 = *(const LAS bf16x8*)(rowp + offB + 16 * g), b1 = *(const LAS bf16x8*)(rowp + offB + 64 + 16 * g);
        f32x4 N = MFMA32(a0, b0, zero4); N = MFMA32(a1, b1, N);
        const bool strict = (w == 4 || w == 5);
#pragma unroll
        for (int r = 0; r < 4; ++r) { const int rj = 4 * g + r; N[r] = (strict ? (c > rj) : (c >= rj)) ? N[r] : 0.f; }
        f32x4 res = N;
        if (w == 4) {
            f32x4 N1t = MFMA32(b0, a0, zero4); N1t = MFMA32(b1, a1, N1t);
            f32x4 X;
#pragma unroll
            for (int r = 0; r < 4; ++r) { const int rj = 4 * g + r; N1t[r] = (rj > c) ? N1t[r] : 0.f; X[r] = ((rj == c) ? 1.0f : 0.f) - N[r]; }
            bf16x4 an = cv4(N), at = cv4(N1t);
            f32x4 P = MFMA16(at, an, zero4), Pt = MFMA16(an, at, zero4);
            X = MFMA16(cv4(Pt), cv4(X), padc(X));
            an = cv4(P); at = cv4(Pt);
            P = MFMA16(at, an, zero4); Pt = MFMA16(an, at, zero4);
            X = MFMA16(cv4(Pt), cv4(X), padc(X));
            an = cv4(P); at = cv4(Pt);
            Pt = MFMA16(an, at, zero4);
            X = MFMA16(cv4(Pt), cv4(X), padc(X));
            res = X;
        }
        *(LAS bf16x4*)(aop + (j & 1) * 2048 + (w - 4) * 512 + lane * 8) = cv4(res);
    };
    f32x4 Z[4];
#pragma unroll
    for (int i = 0; i < 4; ++i) Z[i] = (f32x4){0.f, 0.f, 0.f, 0.f};
    const int tra = (4 * (lane >> 4) + ((lane >> 2) & 3)) * RWS + 8 * (lane & 3);
    { RW3_DMA(0); RW3_DMA(1); RW3_DMA(2); RW3_DMA(3); RW3_DMA(4); RW3_DMA(5); RW3_DMA(6); RW3_DMA(7); asm volatile("s_waitcnt vmcnt(0)" ::: "memory"); WG_BAR(); RW3_PROC(0); RW3_PROC(1); WG_BAR(); if (w >= 4) a_stage(0); WG_BAR(); }
    if (w < 4) {
        for (int ci = 0; ci < NCHK; ++ci) {
            const int t0 = ci * CH; const int jp = (ci + 2 < NCHK) ? ci + 2 : NCHK - 1;
            if (nsh > 0 && ci == NCHK / 2 - NRAW) { if (w == 0 && lane == 0) { unsigned* ctl_ = WSP(unsigned, WS_CTL); XB_SPIN(xb_ld(ctl_ + CW_SIG_H2) < (unsigned)nsh, ctl_ + CW_BAR); __builtin_amdgcn_fence(__ATOMIC_ACQUIRE, "agent"); asm volatile("s_waitcnt vmcnt(0)" ::: "memory"); } WG_BAR(); }
            RW3_PROC(jp);
            const LAS unsigned char* cur = opnd + (ci % 3) * RWB_BYTES; const LAS unsigned char* rowp = cur + c * RWS; const LAS unsigned char* ap = aop + (ci & 1) * 2048 + lane * 8;
            bf16x8 pKg[2], pRg[2];
#pragma unroll
            for (int s = 0; s < 2; ++s) {
                pKg[s] = join8(*(const LAS v2u*)(rowp + RWB_KG + 64 * s + 8 * g), *(const LAS v2u*)(rowp + RWB_KG + 64 * s + 32 + 8 * g));
                pRg[s] = join8(*(const LAS v2u*)(rowp + RWB_RG + 64 * s + 8 * g), *(const LAS v2u*)(rowp + RWB_RG + 64 * s + 32 + 8 * g)); }
            const bf16x4 bV = lds_tr4(cur + RWB_V + tra + 32 * w);
            const bf16x4 xT = *(const LAS bf16x4*)(ap), n2 = *(const LAS bf16x4*)(ap + 512), n3 = *(const LAS bf16x4*)(ap + 1024), n4 = *(const LAS bf16x4*)(ap + 1536);
            const bf16x8 bZ0 = cv8(Z[0], Z[1]), bZ1 = cv8(Z[2], Z[3]);
            const bf16x4 z4 = (bf16x4){0, 0, 0, 0};
            f32x4 W = MFMA32(pKg[0], bZ0, zero4); W = MFMA32(pKg[1], bZ1, W); W = MFMA32(cat8(n2, z4), cat8(bV, z4), W);
            const f32x4 U = MFMA16(xT, cv4(W), zero4);
            const bf16x4 nU = cv4(-U);
            const bf16x8 bVU = cat8(bV, nU);
            f32x4 Y = MFMA32(pRg[0], bZ0, zero4); Y = MFMA32(pRg[1], bZ1, Y); Y = MFMA32(cat8(n3, n4), bVU, Y);
#pragma unroll
            for (int r = 0; r < 4; ++r) ydst[(rowbase + t0 + 4 * g + r) * 3072 + h * RN + 16 * w + c] = bf1(Y[r]);
#pragma unroll
            for (int zt = 0; zt < 4; ++zt) {
                const bf16x4 aK = lds_tr4(cur + RWB_KTI + tra + 32 * zt), aB = lds_tr4(cur + RWB_BTI + tra + 32 * zt);
                const f32x4 gl = *(const LAS f32x4*)(cur + RWB_GL + (16 * zt + 4 * g) * 4);
                Z[zt] = MFMA32(cat8(aK, aB), bVU, Z[zt]) * gl; }
            { const int jn = (ci + NRAW < NCHK) ? ci + NRAW : NCHK - 1; RW3_DMA(jn); }
            if (ci == NCHK / 2 - 1) asm volatile("s_waitcnt vmcnt(0)" ::: "memory");
            asm volatile("s_waitcnt vmcnt(50)" ::: "memory");
            WG_BAR();
            if (ci == NCHK / 2 - 1 && w == 0 && lane == 0) sig_post(WSP(unsigned, WS_CTL) + CW_SIG_HALF);
        }
    } else {
        for (int ci = 0; ci < NCHK; ++ci) {
            const int jp = (ci + 2 < NCHK) ? ci + 2 : NCHK - 1, ja = (ci + 1 < NCHK) ? ci + 1 : NCHK - 1;
            if (nsh > 0 && ci == NCHK / 2 - NRAW) WG_BAR();
            RW3_PROC(jp);
            a_stage(ja);
            { const int jn = (ci + NRAW < NCHK) ? ci + NRAW : NCHK - 1; RW3_DMA(jn); }
            asm volatile("s_waitcnt vmcnt(30)" ::: "memory");
            WG_BAR();
        }
    }
#undef RW3_DMA
#undef RW3_PROC
}

__device__ __forceinline__ void p6_hgrn_head(Frame& F, int hb) {
    const bf16* hg = WSP(bf16, WS_R + R_HG); bf16* odst = WSP(bf16, WS_R + R_HG);
    const int lane = F.lane, c = lane & 15, g = lane >> 4, w = F.wave;
    const int bh = hb >> 1, half = hb & 1, b = bh >> 3, h = bh & 7, vb = half * 4 + (w & 3);
    const size_t rowbase = (size_t)b * SEQ;
    const int st = lane & 15, k0 = 4 * (w * 4 + (lane >> 4));
    LAS unsigned char* const opnd = F.lds + HG_OPND; LAS unsigned char* const raw = F.lds + HG_RAW; LAS unsigned char* const aop = F.lds + HG_AOP;
#define HG3_DMA(j) do { _Pragma("unroll") for (int rr_ = 0; rr_ < 2; ++rr_) { const int r_ = 2 * w + rr_; const bf16* p_ = hg + (rowbase + (size_t)(j) * CH + r_) * 4096 + h * HD + 2 * (2 * ((lane >> 1) ^ r_) + (lane & 1)); \
        LAS unsigned char* d_ = raw + ((j) % NRAW) * HGR_BYTES + r_ * 256; GLDS4(p_, d_ + HGR_Q); GLDS4(p_ + HC, d_ + HGR_LF); GLDS4(p_ + 2 * HC, d_ + HGR_V); } } while (0)
#define HG3_PROC(j) do { const LAS unsigned char* s_ = raw + ((j) % NRAW) * HGR_BYTES + st * 256 + (((k0 >> 2) ^ st) * 8); LAS unsigned char* d_ = opnd + ((j) % 3) * HGB_BYTES; \
        const v2u Lq = *(const LAS v2u*)(s_ + HGR_Q), Lf = *(const LAS v2u*)(s_ + HGR_LF), Lv = *(const LAS v2u*)(s_ + HGR_V); \
        const f32x4 q_ = unpack4(Lq); f32x4 lf_ = unpack4(Lf) * 1.44269504f; f32x4 qg_, ki_, eg_; \
        _Pragma("unroll") for (int e = 0; e < 4; ++e) { const float G_ = row16_scan(lf_[e]); eg_[e] = __builtin_amdgcn_exp2f(G_); qg_[e] = q_[e] * eg_[e]; ki_[e] = (1.0f - __builtin_amdgcn_exp2f(lf_[e])) * __builtin_amdgcn_exp2f(-G_); } \
        const v2u kw_ = pack4(ki_); *(LAS v2u*)(d_ + HGB_QG + st * HGS + k0 * 2) = pack4(qg_); *(LAS v2u*)(d_ + HGB_KI + st * HGS + k0 * 2) = kw_; \
        *(LAS unsigned short*)(d_ + HGB_KIT + (k0 + 0) * 32 + st * 2) = (unsigned short)(kw_.x & 0xffffu); *(LAS unsigned short*)(d_ + HGB_KIT + (k0 + 1) * 32 + st * 2) = (unsigned short)(kw_.x >> 16); \
        *(LAS unsigned short*)(d_ + HGB_KIT + (k0 + 2) * 32 + st * 2) = (unsigned short)(kw_.y & 0xffffu); *(LAS unsigned short*)(d_ + HGB_KIT + (k0 + 3) * 32 + st * 2) = (unsigned short)(kw_.y >> 16); \
        *(LAS unsigned short*)(d_ + HGB_VT + (k0 + 0) * 32 + st * 2) = (unsigned short)(Lv.x & 0xffffu); *(LAS unsigned short*)(d_ + HGB_VT + (k0 + 1) * 32 + st * 2) = (unsigned short)(Lv.x >> 16); \
        *(LAS unsigned short*)(d_ + HGB_VT + (k0 + 2) * 32 + st * 2) = (unsigned short)(Lv.y & 0xffffu); *(LAS unsigned short*)(d_ + HGB_VT + (k0 + 3) * 32 + st * 2) = (unsigned short)(Lv.y >> 16); \
        if (st == 15) *(LAS f32x4*)(d_ + HGB_GL + k0 * 4) = eg_; } while (0)
    const f32x4 zero4 = (f32x4){0.f, 0.f, 0.f, 0.f};
    auto a_stage = [&](int j) {
        const LAS unsigned char* rowp = opnd + (j % 3) * HGB_BYTES + c * HGS;
        f32x4 N = zero4;
#pragma unroll
        for (int s = 0; s < 4; ++s) { const bf16x8 nQ = *(const LAS bf16x8*)(rowp + HGB_QG + 64 * s + 16 * g), nK = *(const LAS bf16x8*)(rowp + HGB_KI + 64 * s + 16 * g); N = MFMA32(nK, nQ, N); }
#pragma unroll
        for (int r = 0; r < 4; ++r) N[r] = (c >= 4 * g + r) ? N[r] : 0.f;
        *(LAS bf16x4*)(aop + (j & 1) * 512 + lane * 8) = cv4(N);
    };
    f32x4 Z[8];
#pragma unroll
    for (int i = 0; i < 8; ++i) Z[i] = (f32x4){0.f, 0.f, 0.f, 0.f};
    { HG3_DMA(0); HG3_DMA(1); HG3_DMA(2); HG3_DMA(3); HG3_DMA(4); HG3_DMA(5); HG3_DMA(6); HG3_DMA(7); asm volatile("s_waitcnt vmcnt(0)" ::: "memory"); WG_BAR(); HG3_PROC(0); HG3_PROC(1); WG_BAR(); if (w == 4) a_stage(0); WG_BAR(); }
    if (w < 4) {
        for (int ci = 0; ci < NCHK; ++ci) {
            const int t0 = ci * CH; const int jp = (ci + 2 < NCHK) ? ci + 2 : NCHK - 1;
            HG3_PROC(jp);
            const LAS unsigned char* cur = opnd + (ci % 3) * HGB_BYTES; const LAS unsigned char* rowp = cur + c * HGS;
            f32x4 Y = zero4;
#pragma unroll
            for (int s = 0; s < 4; ++s) {
                const bf16x8 pQ = join8(*(const LAS v2u*)(rowp + HGB_QG + 64 * s + 8 * g), *(const LAS v2u*)(rowp + HGB_QG + 64 * s + 32 + 8 * g));
                Y = MFMA32(pQ, cv8(Z[2 * s], Z[2 * s + 1]), Y); }
            const bf16x4 bV = *(const LAS bf16x4*)(cur + HGB_VT + (16 * vb + c) * 32 + 8 * g);
            const bf16x4 n = *(const LAS bf16x4*)(aop + (ci & 1) * 512 + lane * 8);
            const bf16x4 z4 = (bf16x4){0, 0, 0, 0};
            Y = MFMA32(cat8(n, z4), cat8(bV, z4), Y);
#pragma unroll
            for (int r = 0; r < 4; ++r) odst[(rowbase + t0 + 4 * g + r) * 4096 + 2 * HC + h * HD + 16 * vb + c] = bf1(Y[r]);
#pragma unroll
            for (int zt = 0; zt < 8; ++zt) {
                const bf16x4 aK = *(const LAS bf16x4*)(cur + HGB_KIT + (16 * zt + c) * 32 + 8 * g);
                const f32x4 gl = *(const LAS f32x4*)(cur + HGB_GL + (16 * zt + 4 * g) * 4);
                Z[zt] = MFMA16(aK, bV, Z[zt]) * gl; }
            { const int jn = (ci + NRAW < NCHK) ? ci + NRAW : NCHK - 1; HG3_DMA(jn); }
            if (ci == NCHK / 2 - 1) asm volatile("s_waitcnt vmcnt(0)" ::: "memory");
            asm volatile("s_waitcnt vmcnt(50)" ::: "memory");
            WG_BAR();
            if (ci == NCHK / 2 - 1 && w == 0 && lane == 0) sig_post(WSP(unsigned, WS_CTL) + CW_SIG_HALF);
        }
    } else {
        for (int ci = 0; ci < NCHK; ++ci) {
            const int jp = (ci + 2 < NCHK) ? ci + 2 : NCHK - 1, ja = (ci + 1 < NCHK) ? ci + 1 : NCHK - 1;
            HG3_PROC(jp);
            if (w == 4) a_stage(ja);
            { const int jn = (ci + NRAW < NCHK) ? ci + NRAW : NCHK - 1; HG3_DMA(jn); }
            asm volatile("s_waitcnt vmcnt(30)" ::: "memory");
            WG_BAR();
        }
    }
#undef HG3_DMA
#undef HG3_PROC
}
#undef WG_BAR
__device__ __forceinline__ void p7_post(Frame& F, int hsel, int c, int G);
constexpr int NSCAN = BATCH * RH + 2 * BATCH * HH;
__device__ __forceinline__ void p6_shadow(Frame& F, const Args& A, int c, int G) {
    const unsigned long long* ss = WSP(unsigned long long, WS_SS);
    {   pg8::Gemm g{WSP(bf16, WS_XB), WSP(bf16, WS_WIN) + (size_t)26 * 256 * D, M, 4 * 256, D, 0}; pg8::StaticOrder S; S.init(M, 4 * 256, G, c);
        pg8::EpiInProj E{WSP(bf16, WS_R + R_RKV), WSP(float, WS_R + R_LIN), WSP(bf16, WS_R + R_HG), pg8::inv_preload((PG8_LAS float*)(F.lds + pg8::STAGE_BYTES), S, ss + M), (PG8_LAS float*)(F.lds + pg8::STAGE_BYTES + 4096), 26};
        pg8::gemm_phase<pg8::EpiInProj, pg8::StaticOrder, true, true>(F.lds, g, S, E); }
    {   int kl = 256; asm volatile("" : "+s"(kl));
        pg8::Gemm g{WSP(bf16, WS_ALORA) + 128, WSP(bf16, WS_WLORA) + (size_t)2048 * 128, M, 4 * 256, kl, KL}; pg8::StaticOrder S; S.init(M, 4 * 256, G, c);
        pg8::EpiLora E{WSP(bf16, WS_LOUT), (PG8_LAS float*)(F.lds + pg8::STAGE_BYTES), 8};
        pg8::gemm_phase<pg8::EpiLora, pg8::StaticOrder, true, true>(F.lds, g, S, E); }
    p0_transposes<1>(F, A, c * NWAVES + F.wave, G * NWAVES);
}
__device__ __forceinline__ void p6_shadow_pre(Frame& F, int c, int G) {
    unsigned* ctl = WSP(unsigned, WS_CTL);
    p4_lora_in(F, 1, c, G);
    wg_signal(ctl + CW_SIG_P4); wg_wait(ctl + CW_SIG_P4, (unsigned)G, ctl + CW_BAR);
    {   int kl = 128; asm volatile("" : "+s"(kl));
        pg8::Gemm g{WSP(bf16, WS_ALORA), WSP(bf16, WS_WLORA), M, 8 * 256, kl, KL}; pg8::StaticOrder S; S.init(M / 2, 8 * 256, G, c); S.hsel = 1;
        PG8_LAS float* bt = (PG8_LAS float*)(F.lds + pg8::STAGE_BYTES);
        for (int cix = F.tid; cix < 2 * RC; cix += NWAVES * 64) bt[cix] = cix < RC ? F.in[8][cix] : F.in[10][cix - RC];
        __syncthreads();
        pg8::EpiLora E{WSP(bf16, WS_LOUT), bt, 0};
        pg8::gemm_phase<pg8::EpiLora, pg8::StaticOrder, true, true>(F.lds, g, S, E); }
    wg_signal(ctl + CW_SIG_H2);
}
__device__ __forceinline__ void p6_shadow_b(Frame& F, int c, int G) {
    unsigned* ctl = WSP(unsigned, WS_CTL);
    wg_signal(ctl + CW_SIG_SHA); wg_wait(ctl + CW_SIG_SHA, (unsigned)G, ctl + CW_BAR);
    wg_wait(ctl + CW_SIG_HALF, (unsigned)NSCAN, ctl + CW_BAR);
    p7_post(F, 0, c, G);
    wg_signal(ctl + CW_SIG_SHB); wg_wait(ctl + CW_SIG_SHB, (unsigned)G, ctl + CW_BAR);
    {   pg8::Gemm g{WSP(bf16, WS_XB), WSP(bf16, WS_WOUT), M, D, D, 0}; pg8::StaticOrder S; S.init(M / 2, D, G, c, 4); S.hsel = 0;
        pg8::EpiResid E{nullptr, (const bf16*)F.out, nullptr, nullptr, (bf16*)F.out + D, F.in[21], nullptr, WSP(unsigned long long, WS_SS) + 2 * M, 1.0f, 2 * D, 2 * D, 2048};
        pg8::gemm_phase<pg8::EpiResid, pg8::StaticOrder, true, true>(F.lds, g, S, E); }
}
__device__ __forceinline__ void p6_scans(Frame& F, const Args& A) {
    const int bx = (int)blockIdx.x;
    if (F.G == 2 * NSCAN) {
        const int x = bx & 7, idx = (bx >> 3) * 4 + (x & 3);
        if (x < 4) { if (idx < BATCH * RH) p6_rwkv_head(F, idx, NSCAN); else p6_hgrn_head(F, idx - BATCH * RH); } else { p6_shadow_pre(F, idx, NSCAN); p6_shadow(F, A, idx, NSCAN); p6_shadow_b(F, idx, NSCAN); } }
    else if (F.G > NSCAN) { if (bx < NSCAN) { if (bx < BATCH * RH) p6_rwkv_head(F, bx, F.G - NSCAN); else p6_hgrn_head(F, bx - BATCH * RH); } else { p6_shadow_pre(F, bx - NSCAN, F.G - NSCAN); p6_shadow(F, A, bx - NSCAN, F.G - NSCAN); p6_shadow_b(F, bx - NSCAN, F.G - NSCAN); } }
    else {
        for (int u = bx; u < NSCAN; u += F.G) { if (u < BATCH * RH) p6_rwkv_head(F, u, 0); else p6_hgrn_head(F, u - BATCH * RH); }
        __syncthreads(); p6_shadow(F, A, bx, F.G);
    }
}

__device__ __forceinline__ void p7_post(Frame& F, int hsel, int c, int G) {
    const int NR = hsel < 0 ? M : M / 2;
    const bf16* rkv = WSP(bf16, WS_R + R_RKV); const bf16* hg = WSP(bf16, WS_R + R_HG); const bf16* lout = WSP(bf16, WS_LOUT); bf16* yc = WSP(bf16, WS_XB);
    { const int half = F.tid >> 8, ch = (F.tid & 255) * 4;
      const f32x4 mu_r = *(const f32x4*)(F.in[7] + ch), mu_k = *(const f32x4*)(F.in[7] + RC + ch), mu_v = *(const f32x4*)(F.in[7] + 2 * RC + ch);
      const f32x4 kac = *(const f32x4*)(F.in[14] + ch), rkc = *(const f32x4*)(F.in[15] + ch), lnw = *(const f32x4*)(F.in[16] + ch), lnb = *(const f32x4*)(F.in[17] + ch);
#pragma unroll 2
      for (int i = c * 2 + half; i < NR; i += 2 * G) { const int m = hsel < 0 ? i : (i / (SEQ / 2)) * SEQ + (i % (SEQ / 2)) + hsel * (SEQ / 2);
          const bool first = (m & (SEQ - 1)) == 0; const size_t mp = first ? m : m - 1;
          const bf16* p = rkv + (size_t)m * 3072 + ch; const bf16* q = rkv + mp * 3072 + ch; const bf16* l = lout + (size_t)m * 3072 + ch;
          const f32x4 y = unpack4(*(const GAS v2u*)(l));
          const f32x4 r = unpack4(*(const GAS v2u*)(p)), k = unpack4(*(const GAS v2u*)(p + RC)), v = unpack4(*(const GAS v2u*)(p + 2 * RC));
          f32x4 rp = unpack4(*(const GAS v2u*)(q)), kp = unpack4(*(const GAS v2u*)(q + RC)), vp = unpack4(*(const GAS v2u*)(q + 2 * RC));
          if (first) { rp = (f32x4){0.f, 0.f, 0.f, 0.f}; kp = rp; vp = rp; }
          const f32x4 a = unpack4(*(const GAS v2u*)(l + RC)), gg = unpack4(*(const GAS v2u*)(l + 2 * RC));
          const f32x4 rs = r + (rp - r) * mu_r, ks = k + (kp - k) * mu_k, vs = v + (vp - v) * mu_v;
          const f32x4 km = ks * (1.0f + (a - 1.0f) * kac);
          const f32x4 bt = rs * km * rkc; float bon = (bt[0] + bt[1]) + (bt[2] + bt[3]); bon = row16_sum(bon);
          float s1 = (y[0] + y[1]) + (y[2] + y[3]); s1 = row16_sum(s1); const float mean = s1 * (1.0f / 64.0f);
          const f32x4 d = y - mean; float s2 = (d[0] * d[0] + d[1] * d[1]) + (d[2] * d[2] + d[3] * d[3]); s2 = row16_sum(s2);
          const float rstd = 1.0f / sqrtf(s2 * (1.0f / 64.0f) + 64e-5f);
          const f32x4 o = ((d * rstd) * lnw + lnb + vs * bon) * gg;
          *(GAS v2u*)(yc + (size_t)m * 2048 + ch) = pack4(o); } }
    { const int quarter = F.tid >> 7, ch = (F.tid & 127) * 8;
      const f32x4 nw0 = *(const f32x4*)(F.in[19] + ch), nw1 = *(const f32x4*)(F.in[19] + ch + 4);
#pragma unroll 4
      for (int i = c * 4 + quarter; i < NR; i += 4 * G) { const int m = hsel < 0 ? i : (i / (SEQ / 2)) * SEQ + (i % (SEQ / 2)) + hsel * (SEQ / 2);
          const v4u ow = *(const GAS v4u*)(hg + (size_t)m * 4096 + 2 * HC + ch), gw4 = *(const GAS v4u*)(hg + (size_t)m * 4096 + 3 * HC + ch);
          const f32x4 o0 = (f32x4){bflo(ow.x), bfhi(ow.x), bflo(ow.y), bfhi(ow.y)}, o1 = (f32x4){bflo(ow.z), bfhi(ow.z), bflo(ow.w), bfhi(ow.w)};
          const f32x4 g0 = (f32x4){bflo(gw4.x), bfhi(gw4.x), bflo(gw4.y), bfhi(gw4.y)}, g1 = (f32x4){bflo(gw4.z), bfhi(gw4.z), bflo(gw4.w), bfhi(gw4.w)};
          float s2 = ((o0[0] * o0[0] + o0[1] * o0[1]) + (o0[2] * o0[2] + o0[3] * o0[3])) + ((o1[0] * o1[0] + o1[1] * o1[1]) + (o1[2] * o1[2] + o1[3] * o1[3])); s2 = row16_sum(s2);
          const float rstd = 1.0f / sqrtf(s2 * (1.0f / 128.0f) + 1e-6f);
          *(GAS v4u*)(yc + (size_t)m * 2048 + RC + ch) = pg8::pack8(o0 * rstd * nw0 * g0, o1 * rstd * nw1 * g1); } }
}

__device__ __forceinline__ void p11_final(Frame& F) {
    const int gw = F.vcu * NWAVES + F.wave, NGW = F.G * NWAVES; const float* fg = F.in[25];
    const bf16* x3 = WSP(bf16, WS_XB); const unsigned long long* ss3 = WSP(unsigned long long, WS_SS) + 3 * M;
    f32x4 gn[8];
#pragma unroll
    for (int j = 0; j < 4; ++j) { gn[2 * j] = *(const f32x4*)(fg + 8 * F.lane + 512 * j); gn[2 * j + 1] = *(const f32x4*)(fg + 8 * F.lane + 512 * j + 4); }
#pragma unroll 2
    for (int m = gw; m < M; m += NGW) { const GAS v4u* xr = (const GAS v4u*)(x3 + (size_t)m * D) + F.lane; GAS f32x4* o = (GAS f32x4*)(F.out + (size_t)m * D) + 2 * F.lane;
        const float inv = pg8::inv_rms_from_val(ss3[m]);
#pragma unroll
        for (int j = 0; j < 4; ++j) { const v4u w = xr[64 * j];
            o[128 * j] = (f32x4){bflo(w.x), bfhi(w.x), bflo(w.y), bfhi(w.y)} * inv * gn[2 * j]; o[128 * j + 1] = (f32x4){bflo(w.z), bfhi(w.z), bflo(w.w), bfhi(w.w)} * inv * gn[2 * j + 1]; } }
}

__global__ void __launch_bounds__(NWAVES * 64, 2) mk_fwd(Args args) {
    extern __shared__ __attribute__((aligned(16))) unsigned char lds[];
    Frame F;
    F.lds = (LAS unsigned char*)lds;
    F.tid = threadIdx.x; F.lane = F.tid & 63; F.wave = __builtin_amdgcn_readfirstlane(F.tid >> 6);
    F.G = gridDim.x; { const int bx = blockIdx.x; F.vcu = (F.G % 8 == 0) ? (bx % 8) * (F.G / 8) + bx / 8 : bx; }
#pragma unroll
    for (int i = 0; i < 26; ++i) F.in[i] = args.in[i];
    F.out = args.out; F.ws = args.ws;
    for (int u = F.tid; u < (LDS_BYTES - LDSCTL_OFF) / 4; u += NWAVES * 64) ((LAS unsigned*)(F.lds + LDSCTL_OFF))[u] = 0u;
    __syncthreads();
    const int lo = args.ph_lo, hi = args.ph_hi;
    XcdBarrier bar; bar.bar = (unsigned*)(args.ws + WS_CTL) + CW_BAR; bar.x = 0; bar.st = nullptr;
    if (hi - lo > 1) bar = xcd_barrier_post((unsigned*)(args.ws + WS_CTL) + CW_BAR, (volatile LAS unsigned*)(F.lds + MISC_OFF) + 8);
#ifndef PH_MASK
#define PH_MASK 0xFFF
#endif
#define IN(k) (((PH_MASK >> (k)) & 1) && lo <= (k) && (k) < hi)
#define SEAM(k) do { if (IN(k) && IN((k) + 1)) xcd_barrier(bar); } while (0)
    const bf16* xb = WSP(bf16, WS_XB); unsigned long long* ss = WSP(unsigned long long, WS_SS);
    const int cid = (int)blockIdx.x;
    bf16* const x2b = (bf16*)F.out + D;
    const bool fuse = (F.G % 256) == 0;

    if (IN(0)) { p0_prologue(F, args); } SEAM(0);
    if (IN(1)) {
        pg8::Gemm g{xb, WSP(bf16, WS_W1GU), M, 2 * FF, D, 0}; pg8::StaticOrder S; S.init(M, 2 * FF, F.G, cid);
        pg8::EpiSwiglu E{WSP(bf16, WS_R + R_ACT), FF, pg8::inv_preload((PG8_LAS float*)(F.lds + pg8::STAGE_BYTES), S, ss)};
        pg8::gemm_phase<pg8::EpiSwiglu, pg8::StaticOrder, true, true>(F.lds, g, S, E);
    } SEAM(1);
    if (IN(2)) {
        pg8::Gemm g{WSP(bf16, WS_R + R_ACT), WSP(bf16, WS_W1D), M, D, FF, 0}; pg8::StaticOrder S; S.init(M, D, F.G, cid, 4);
        pg8::EpiResid E{F.in[0], nullptr, nullptr, nullptr, WSP(bf16, WS_XB), F.in[5], (bf16*)F.out, ss + M, 0.5f, 2048, 2048, 2 * D};
        pg8::gemm_phase<pg8::EpiResid, pg8::StaticOrder, true, true>(F.lds, g, S, E);
    } SEAM(2);
    if (IN(3)) {
        pg8::Gemm g{xb, WSP(bf16, WS_WIN), M, 26 * 256, D, 0}; pg8::StaticOrder S; S.init(M, 26 * 256, F.G, cid);
        PG8_LAS float* omt = (PG8_LAS float*)(F.lds + pg8::STAGE_BYTES + 4096);
        for (int cix = F.tid; cix < HC; cix += NWAVES * 64) omt[cix] = 1.0f - fast_sigmoid(F.in[18][cix] - F.in[18][HC + cix]);
        pg8::EpiInProj E{WSP(bf16, WS_R + R_RKV), WSP(float, WS_R + R_LIN), WSP(bf16, WS_R + R_HG), pg8::inv_preload((PG8_LAS float*)(F.lds + pg8::STAGE_BYTES), S, ss + M), omt, 0};
        pg8::gemm_phase<pg8::EpiInProj, pg8::StaticOrder, true, true>(F.lds, g, S, E);
    } SEAM(3);
    const bool split = F.G > NSCAN;
    if (IN(4)) { p4_lora_in(F, split ? 0 : -1, F.vcu, F.G); } SEAM(4);
    if (IN(5)) {
        int kl = 128; asm volatile("" : "+s"(kl));
        pg8::Gemm g{WSP(bf16, WS_ALORA), WSP(bf16, WS_WLORA), M, 8 * 256, kl, KL}; pg8::StaticOrder S; S.init(split ? M / 2 : M, 8 * 256, F.G, cid); S.hsel = split ? 0 : -1;
        PG8_LAS float* bt = (PG8_LAS float*)(F.lds + pg8::STAGE_BYTES);
        for (int cix = F.tid; cix < 2 * RC; cix += NWAVES * 64) bt[cix] = cix < RC ? F.in[8][cix] : F.in[10][cix - RC];
        __syncthreads();
        pg8::EpiLora E{WSP(bf16, WS_LOUT), bt, 0};
        pg8::gemm_phase<pg8::EpiLora, pg8::StaticOrder, true, true>(F.lds, g, S, E);
    } SEAM(5);
    if (IN(6)) { p6_scans(F, args); } SEAM(6);
    if (IN(7)) { p7_post(F, split ? 1 : -1, F.vcu, F.G); } SEAM(7);
    if (IN(8)) {
        pg8::Gemm g{xb, WSP(bf16, WS_WOUT), M, D, D, 0}; pg8::StaticOrder S; S.init(split ? M / 2 : M, D, F.G, cid, 4); S.hsel = split ? 1 : -1;
        pg8::EpiResid E{nullptr, (const bf16*)F.out, nullptr, nullptr, x2b, F.in[21], nullptr, ss + 2 * M, 1.0f, 2 * D, 2 * D, 2048};
        pg8::gemm_phase<pg8::EpiResid, pg8::StaticOrder, true, true>(F.lds, g, S, E);
    } SEAM(8);
    if (IN(9)) {
        pg8::Gemm g{x2b, WSP(bf16, WS_W2GU), M, 2 * FF, D, 2 * D}; pg8::StaticOrder S; S.init(M, 2 * FF, F.G, cid);
        pg8::EpiSwiglu E{WSP(bf16, WS_R + R_ACT), FF, pg8::inv_preload((PG8_LAS float*)(F.lds + pg8::STAGE_BYTES), S, ss + 2 * M)};
        pg8::gemm_phase<pg8::EpiSwiglu, pg8::StaticOrder, true, true>(F.lds, g, S, E);
    } SEAM(9);
    if (IN(10)) {
        pg8::Gemm g{WSP(bf16, WS_R + R_ACT), WSP(bf16, WS_W2D), M, D, FF, 0}; pg8::StaticOrder S; S.init(M, D, F.G, cid, 4);
        if (fuse) { pg8::EpiFinal E{x2b, 2 * D, F.in[21], F.in[25], F.out, ss + 3 * M, WSP(unsigned, WS_CTL) + CW_PCNT, WSP(unsigned, WS_CTL) + CW_BAR + XB_TMO, 0.5f, (unsigned)(D / 256)};
            pg8::gemm_phase<pg8::EpiFinal, pg8::StaticOrder, true, true>(F.lds, g, S, E); }
        else { pg8::EpiResid E{nullptr, x2b, F.in[21], nullptr, nullptr, nullptr, WSP(bf16, WS_XB), ss + 3 * M, 0.5f, 2 * D, 2048, 2048};
            pg8::gemm_phase<pg8::EpiResid, pg8::StaticOrder, true, true>(F.lds, g, S, E); }
    }
    if (!fuse) { SEAM(10); if (IN(11)) { p11_final(F); } }
#undef IN
#undef SEAM
}

extern "C" void kernel_launch(void* const* d_in, const int* in_sizes, int n_in, void* d_out, int out_size, void* d_ws, size_t ws_size, hipStream_t stream) {
    static int grid = 0;
    if (grid == 0) {
        if (n_in != 26 || in_sizes[0] != M * D || out_size != M * D || ws_size < WS_END) { fprintf(stderr, "kernel_launch: unexpected problem (n_in %d, ws %zu < %zu)\n", n_in, ws_size, (size_t)WS_END); grid = -1; return; }
        int dev = 0, cus = 0, per_cu = 0;
        if (hipGetDevice(&dev) != hipSuccess || hipDeviceGetAttribute(&cus, hipDeviceAttributeMultiprocessorCount, dev) != hipSuccess) { grid = -1; return; }
        if (hipFuncSetAttribute((const void*)mk_fwd, hipFuncAttributeMaxDynamicSharedMemorySize, LDS_BYTES) != hipSuccess) { grid = -1; return; }
        if (hipOccupancyMaxActiveBlocksPerMultiprocessor(&per_cu, (const void*)mk_fwd, NWAVES * 64, LDS_BYTES) != hipSuccess || per_cu < 1) fprintf(stderr, "kernel_launch: occupancy query reports %d\n", per_cu);
        (void)hipGetLastError();
        grid = cus;
    }
    if (grid < 0) return;
    (void)hipMemsetAsync((char*)d_ws + WS_CTL, 0, CTL_BYTES, stream);
    Args a{};
    for (int i = 0; i < 26; ++i) a.in[i] = (const float*)d_in[i];
    a.out = (float*)d_out; a.ws = (unsigned char*)d_ws;
    constexpr int NL_ = MK_N_LAUNCHES;
    for (int li = 0; li < NL_; ++li) {
        a.ph_lo = (NL_ == 1) ? 0 : li; a.ph_hi = (NL_ == 1) ? N_PHASES : li + 1;
        hipLaunchKernelGGL(mk_fwd, dim3(grid), dim3(NWAVES * 64), LDS_BYTES, stream, a);
    }
}
```

```cpp
#include <hip/hip_runtime.h>
#include <cstdio>
#include <cstdint>
namespace pg8 {
#define PG8_LAS __attribute__((address_space(3)))
typedef unsigned short bf16_t;
typedef short bf16x8 __attribute__((ext_vector_type(8)));
typedef float f32x4 __attribute__((ext_vector_type(4)));
typedef unsigned u32x4 __attribute__((ext_vector_type(4)));
constexpr int BM = 256, BK = 64, HALF = 128, HTB = HALF * BK * 2  , STAGE_BYTES = 8 * HTB, NXCD = 8, WGM = 8;

__host__ __device__ __forceinline__ int lds_byte(int r, int c) { const int st = (r >> 4) * 2 + (c >> 5), rr = r & 15, cc = c & 31, ob = rr * 64 + cc * 2; return st * 1024 + (ob ^ (((ob >> 9) & 1) << 5)); }
__host__ __device__ __forceinline__ void stage_rc(int b, int& R, int& C) { const int st = b / 1024, sb = b % 1024, swz = sb ^ (((sb >> 9) & 1) << 5); R = (st >> 1) * 16 + swz / 64; C = (st & 1) * 32 + (swz % 64) / 2; }
__host__ __device__ __forceinline__ int perm32(int rho) { const int n = rho >> 4, i = rho & 15; return 8 * (i >> 2) + 4 * n + (i & 3); }

struct Unit { int pm, pn; };
struct Gemm { const bf16_t* A; const bf16_t* Bt; int M, N, K, lda; };

struct StaticOrder {
    int ubase, ulim;
    int nM, nN, nwg, G, c, wgm, hsel;
    __host__ __device__ void init(int M, int N, int G_, int c_, int wgm_ = WGM) { nM = M / BM; nN = N / BM; nwg = nM * nN; G = G_; c = c_; wgm = wgm_; hsel = -1; ubase = 0; ulim = nwg; }
    __host__ __device__ bool next(int i, Unit& u) const {
        const long L = (long)ubase + (long)i * G + c; if (L >= ulim) return false;
        int wgid = (int)L; { const int q = nwg / NXCD, r = nwg % NXCD, xcd = wgid % NXCD, off = wgid / NXCD; wgid = (xcd < r ? xcd * (q + 1) : r * (q + 1) + (xcd - r) * q) + off; }
        const int nig = wgm * nN, gid = wgid / nig, fm = gid * wgm, gsz = (nM - fm) < wgm ? (nM - fm) : wgm;
        u.pm = fm + ((wgid % nig) % gsz); u.pn = (wgid % nig) / gsz; if (hsel >= 0) u.pm = (u.pm >> 4) * 32 + (u.pm & 15) + 16 * hsel; return true;
    }
    __device__ __forceinline__ void a_ready(const Unit&) const {}
    __device__ __forceinline__ void done(const Unit&) const {}
};


typedef __bf16 bf16n2 __attribute__((ext_vector_type(2)));
__device__ __forceinline__ unsigned cvt_pk_bf16(float lo, float hi) { bf16n2 v; v.x = (__bf16)lo; v.y = (__bf16)hi; return __builtin_bit_cast(unsigned, v); }
__device__ __forceinline__ float fast_sigmoid(float z) { return __builtin_amdgcn_rcpf(1.0f + __builtin_amdgcn_exp2f(-1.44269504f * z)); }
__device__ __forceinline__ float fast_silu(float z) { return z * fast_sigmoid(z); }
constexpr float SS_SCALE = 16777216.0f;
__device__ __forceinline__ float inv_rms_from_val(unsigned long long v) {
    const float tot = (float)v * (1.0f / SS_SCALE);
    return 1.0f / sqrtf(tot * (1.0f / 2048.0f) + 1e-6f);
}
__device__ __forceinline__ u32x4 pack8(const f32x4 v0, const f32x4 v1) { u32x4 w; w.x = cvt_pk_bf16(v0[0], v0[1]); w.y = cvt_pk_bf16(v0[2], v0[3]); w.z = cvt_pk_bf16(v1[0], v1[1]); w.w = cvt_pk_bf16(v1[2], v1[3]); return w; }

struct InvTab {
    const PG8_LAS float* tab; int t0, t1, t2, t3; const unsigned long long* ss;
    __device__ __forceinline__ int slot(int pm) const { return pm == t0 ? 0 : (pm == t1 ? 1 : (pm == t2 ? 2 : (pm == t3 ? 3 : -1))); }
    __device__ __forceinline__ void get(float (&inv)[2][4], int pm, int r0) const {
        const int sl = slot(pm);
        if (sl >= 0) {
#pragma unroll
            for (int ai = 0; ai < 2; ++ai)
#pragma unroll
                for (int m = 0; m < 4; ++m) inv[ai][m] = tab[sl * BM + r0 + ai * HALF + m * 16];
        } else { unsigned long long sv[2][4];
#pragma unroll
            for (int ai = 0; ai < 2; ++ai)
#pragma unroll
                for (int m = 0; m < 4; ++m) sv[ai][m] = ss[pm * BM + r0 + ai * HALF + m * 16];
#pragma unroll
            for (int ai = 0; ai < 2; ++ai)
#pragma unroll
                for (int m = 0; m < 4; ++m) inv[ai][m] = inv_rms_from_val(sv[ai][m]); }
    }
};
template <class Sched> __device__ __forceinline__ InvTab inv_preload(PG8_LAS float* tab, const Sched& S, const unsigned long long* ss) {
    InvTab T; T.tab = tab; T.t0 = -1; T.t1 = -1; T.t2 = -1; T.t3 = -1; T.ss = ss; int n = 0; Unit u;
    for (int i = 0; S.next(i, u); ++i) {
        if (T.slot(u.pm) < 0 && n < 4) {
            if (threadIdx.x < BM) tab[n * BM + threadIdx.x] = inv_rms_from_val(ss[u.pm * BM + threadIdx.x]);
            if (n == 0) T.t0 = u.pm; else if (n == 1) T.t1 = u.pm; else if (n == 2) T.t2 = u.pm; else T.t3 = u.pm;
            ++n; } }
    __syncthreads();
    return T;
}
struct EpiSwiglu {
    static constexpr bool PERM = true, AFTER_DRAIN = false;
    bf16_t* O; int ldc; InvTab it;
    __device__ __forceinline__ void operator()(const f32x4 (&acc)[2][2][4][2], const Unit& u, int wr, int wc, int fr, int fq) const {
        const int row0 = u.pm * BM + wr * 64 + fr, col0 = u.pn * HALF + wc * 32 + 8 * fq;
        float invs[2][4]; it.get(invs, u.pm, wr * 64 + fr);
#pragma unroll
        for (int ai = 0; ai < 2; ++ai)
#pragma unroll
            for (int m = 0; m < 4; ++m) { const int row = row0 + ai * HALF + m * 16; const float inv = invs[ai][m], invn = inv * -1.44269504f;
                f32x4 o[2];
#pragma unroll
                for (int n = 0; n < 2; ++n) { const f32x4 g = acc[ai][0][m][n] * inv, up = acc[ai][1][m][n] * inv, t = acc[ai][0][m][n] * invn; f32x4 e, r;
#pragma unroll
                    for (int j = 0; j < 4; ++j) e[j] = __builtin_amdgcn_exp2f(t[j]);
                    const f32x4 d = e + 1.0f;
#pragma unroll
                    for (int j = 0; j < 4; ++j) r[j] = __builtin_amdgcn_rcpf(d[j]);
                    o[n] = (g * r) * up; }
                *(u32x4*)(O + (size_t)row * ldc + col0) = pack8(o[0], o[1]); }
    }
};
struct EpiResid {
    static constexpr bool PERM = true, AFTER_DRAIN = false;
    const float* rf; const bf16_t* rb; const float* rbg; float* out; bf16_t* ob; const float* gain; bf16_t* ob2; unsigned long long* ss; float alpha; int prb, pob, pob2;
    __device__ __forceinline__ void operator()(const f32x4 (&acc)[2][2][4][2], const Unit& u, int wr, int wc, int fr, int fq) const {
        const int row0 = u.pm * BM + wr * 64 + fr, col0 = u.pn * BM + wc * 32 + 8 * fq;
        f32x4 gi[2][2], go[2][2];
#pragma unroll
        for (int bj = 0; bj < 2; ++bj)
#pragma unroll
            for (int n = 0; n < 2; ++n) { gi[bj][n] = (f32x4){1.f, 1.f, 1.f, 1.f}; go[bj][n] = gi[bj][n];
                if (rbg) { const f32x4 t = *(const f32x4*)(rbg + col0 + bj * HALF + 4 * n); gi[bj][n] = (f32x4){1.0f / t[0], 1.0f / t[1], 1.0f / t[2], 1.0f / t[3]}; }
                if (ob) go[bj][n] = *(const f32x4*)(gain + col0 + bj * HALF + 4 * n); }
#pragma unroll
        for (int ai = 0; ai < 2; ++ai)
#pragma unroll
            for (int m = 0; m < 4; ++m) { const int row = row0 + ai * HALF + m * 16; const size_t off = (size_t)row * 2048 + col0, offr = (size_t)row * prb + col0, offo = (size_t)row * pob + col0, offo2 = (size_t)row * pob2 + col0; float s = 0.f;
#pragma unroll
                for (int bj = 0; bj < 2; ++bj) {
                    f32x4 r0, r1;
                    if (rf) { r0 = *(const f32x4*)(rf + off + bj * HALF); r1 = *(const f32x4*)(rf + off + bj * HALF + 4); }
                    else { const u32x4 w = *(const u32x4*)(rb + offr + bj * HALF);
                        r0 = (f32x4){__builtin_bit_cast(float, w.x << 16), __builtin_bit_cast(float, w.x & 0xffff0000u), __builtin_bit_cast(float, w.y << 16), __builtin_bit_cast(float, w.y & 0xffff0000u)} * gi[bj][0];
                        r1 = (f32x4){__builtin_bit_cast(float, w.z << 16), __builtin_bit_cast(float, w.z & 0xffff0000u), __builtin_bit_cast(float, w.w << 16), __builtin_bit_cast(float, w.w & 0xffff0000u)} * gi[bj][1]; }
                    const f32x4 o0 = r0 + acc[ai][bj][m][0] * alpha, o1 = r1 + acc[ai][bj][m][1] * alpha;
                    if (out) { *(f32x4*)(out + off + bj * HALF) = o0; *(f32x4*)(out + off + bj * HALF + 4) = o1; }
                    if (ob) *(u32x4*)(ob + offo + bj * HALF) = pack8(o0 * go[bj][0], o1 * go[bj][1]);
                    if (ob2) *(u32x4*)(ob2 + offo2 + bj * HALF) = pack8(o0, o1);
                    s += (o0[0] * o0[0] + o0[1] * o0[1]) + (o0[2] * o0[2] + o0[3] * o0[3]) + (o1[0] * o1[0] + o1[1] * o1[1]) + (o1[2] * o1[2] + o1[3] * o1[3]); }
                if (ss) { s += __shfl_xor(s, 16); s += __shfl_xor(s, 32);
                    if (fq == 0) atomicAdd(ss + row, (unsigned long long)(s * SS_SCALE + 0.5f)); } }
    }
};
struct EpiFinal {
    static constexpr bool PERM = true, AFTER_DRAIN = false;
    const bf16_t* rb; int prb; const float* rbg; const float* fgain; float* out; unsigned long long* ss; unsigned* cnt; unsigned* tmo; float alpha; unsigned npn;
    __device__ __forceinline__ void operator()(f32x4 (&acc)[2][2][4][2], const Unit& u, int wr, int wc, int fr, int fq) const {
        const int row0 = u.pm * BM + wr * 64 + fr, col0 = u.pn * BM + wc * 32 + 8 * fq;
        { f32x4 gi[2][2];
#pragma unroll
          for (int bj = 0; bj < 2; ++bj)
#pragma unroll
            for (int n = 0; n < 2; ++n) { const f32x4 t = *(const f32x4*)(rbg + col0 + bj * HALF + 4 * n); gi[bj][n] = (f32x4){1.0f / t[0], 1.0f / t[1], 1.0f / t[2], 1.0f / t[3]}; }
#pragma unroll
          for (int ai = 0; ai < 2; ++ai)
#pragma unroll
            for (int m = 0; m < 4; ++m) { const int row = row0 + ai * HALF + m * 16; const size_t offr = (size_t)row * prb + col0; float s = 0.f;
#pragma unroll
                for (int bj = 0; bj < 2; ++bj) { const u32x4 w = *(const u32x4*)(rb + offr + bj * HALF);
                    const f32x4 r0 = (f32x4){__builtin_bit_cast(float, w.x << 16), __builtin_bit_cast(float, w.x & 0xffff0000u), __builtin_bit_cast(float, w.y << 16), __builtin_bit_cast(float, w.y & 0xffff0000u)} * gi[bj][0];
                    const f32x4 r1 = (f32x4){__builtin_bit_cast(float, w.z << 16), __builtin_bit_cast(float, w.z & 0xffff0000u), __builtin_bit_cast(float, w.w << 16), __builtin_bit_cast(float, w.w & 0xffff0000u)} * gi[bj][1];
                    const f32x4 o0 = r0 + acc[ai][bj][m][0] * alpha, o1 = r1 + acc[ai][bj][m][1] * alpha; acc[ai][bj][m][0] = o0; acc[ai][bj][m][1] = o1;
                    s += (o0[0] * o0[0] + o0[1] * o0[1]) + (o0[2] * o0[2] + o0[3] * o0[3]) + (o1[0] * o1[0] + o1[1] * o1[1]) + (o1[2] * o1[2] + o1[3] * o1[3]); }
                s += __shfl_xor(s, 16); s += __shfl_xor(s, 32);
                if (fq == 0) atomicAdd(ss + row, (unsigned long long)(s * SS_SCALE + 0.5f)); } }
        asm volatile("s_waitcnt vmcnt(0)" ::: "memory"); __syncthreads();
        if (threadIdx.x == 0) { unsigned* c = cnt + u.pm;
            (void)__hip_atomic_fetch_add(c, 1u, __ATOMIC_RELAXED, __HIP_MEMORY_SCOPE_AGENT);
            unsigned sp = 0;
            while (__hip_atomic_load(c, __ATOMIC_RELAXED, __HIP_MEMORY_SCOPE_AGENT) < npn) { __builtin_amdgcn_s_sleep(1);
                if ((++sp & 255u) == 0u) { if (__hip_atomic_load(tmo, __ATOMIC_RELAXED, __HIP_MEMORY_SCOPE_AGENT)) break; if (sp > (1u << 18)) { atomicAdd(tmo, 1u); break; } } }
        }
        __syncthreads();
        f32x4 fg[2][2];
#pragma unroll
        for (int bj = 0; bj < 2; ++bj)
#pragma unroll
            for (int n = 0; n < 2; ++n) fg[bj][n] = *(const f32x4*)(fgain + col0 + bj * HALF + 4 * n);
#pragma unroll
        for (int ai = 0; ai < 2; ++ai)
#pragma unroll
            for (int m = 0; m < 4; ++m) { const int row = row0 + ai * HALF + m * 16; const size_t off = (size_t)row * 2048 + col0;
                const float inv = inv_rms_from_val(__hip_atomic_load(ss + row, __ATOMIC_RELAXED, __HIP_MEMORY_SCOPE_AGENT));
#pragma unroll
                for (int bj = 0; bj < 2; ++bj) { *(f32x4*)(out + off + bj * HALF) = acc[ai][bj][m][0] * inv * fg[bj][0]; *(f32x4*)(out + off + bj * HALF + 4) = acc[ai][bj][m][1] * inv * fg[bj][1]; } }
    }
};
struct EpiInProj {
    static constexpr bool PERM = true, AFTER_DRAIN = false;
    bf16_t* rkv; float* lin; bf16_t* hg; InvTab it; const PG8_LAS float* oml; int pn0;
    __device__ __forceinline__ void operator()(const f32x4 (&acc)[2][2][4][2], const Unit& u, int wr, int wc, int fr, int fq) const {
        const int row0 = u.pm * BM + wr * 64 + fr, cin = wc * 32 + 8 * fq;
        const int pn = u.pn + pn0;
        float invs[2][4]; it.get(invs, u.pm, wr * 64 + fr);
        int mode;
        if (pn < 12) mode = 0; else if (pn < 14) mode = 1; else { const int sg = (pn - 14) >> 2; mode = (sg == 0 || sg == 3) ? 2 : (sg == 1 ? 3 : 4); }
#pragma unroll
        for (int bj = 0; bj < 2; ++bj) {
            f32x4 om0 = (f32x4){0.f, 0.f, 0.f, 0.f}, om1 = om0;
            if (mode == 3) { const PG8_LAS float* lp = oml + (pn - 18) * BM + bj * HALF + cin; om0 = *(const PG8_LAS f32x4*)lp; om1 = *(const PG8_LAS f32x4*)(lp + 4); }
#pragma unroll
            for (int ai = 0; ai < 2; ++ai)
#pragma unroll
                for (int m = 0; m < 4; ++m) { const int row = row0 + ai * HALF + m * 16; const float inv = invs[ai][m];
                    f32x4 v0 = acc[ai][bj][m][0] * inv, v1 = acc[ai][bj][m][1] * inv;
                    if (mode == 0) { *(u32x4*)(rkv + (size_t)row * 3072 + pn * BM + bj * HALF + cin) = pack8(v0, v1); }
                    else if (mode == 1) { const int cl = (pn - 12) * BM + bj * HALF + cin;
                        if (cl < 288) { *(f32x4*)(lin + (size_t)row * 288 + cl) = v0; *(f32x4*)(lin + (size_t)row * 288 + cl + 4) = v1; } }
                    else {
                        if (mode == 2) {
#pragma unroll
                            for (int j = 0; j < 4; ++j) { v0[j] = fast_silu(v0[j]); v1[j] = fast_silu(v1[j]); } }
                        else if (mode == 3) {
#pragma unroll
                            for (int j = 0; j < 4; ++j) { v0[j] = __logf(1.0f - om0[j] * fast_sigmoid(-v0[j])); v1[j] = __logf(1.0f - om1[j] * fast_sigmoid(-v1[j])); } }
                        *(u32x4*)(hg + (size_t)row * 4096 + (pn - 14) * BM + bj * HALF + cin) = pack8(v0, v1); } } }
    }
};
struct EpiLora {
    static constexpr bool PERM = true, AFTER_DRAIN = false;
    bf16_t* lout; const PG8_LAS float* bias; int pn0;
    __device__ __forceinline__ void operator()(const f32x4 (&acc)[2][2][4][2], const Unit& u, int wr, int wc, int fr, int fq) const {
        const int row0 = u.pm * BM + wr * 64 + fr, cin = wc * 32 + 8 * fq;
        const int pn = u.pn + pn0, mode = pn >> 2;
#pragma unroll
        for (int bj = 0; bj < 2; ++bj) {
            f32x4 b0 = (f32x4){0.f, 0.f, 0.f, 0.f}, b1 = b0;
            if (mode < 2) { const PG8_LAS float* bp = bias + pn * BM + bj * HALF + cin; b0 = *(const PG8_LAS f32x4*)bp; b1 = *(const PG8_LAS f32x4*)(bp + 4); }
#pragma unroll
            for (int ai = 0; ai < 2; ++ai)
#pragma unroll
                for (int m = 0; m < 4; ++m) { const int row = row0 + ai * HALF + m * 16;
                    f32x4 v0 = acc[ai][bj][m][0] + b0, v1 = acc[ai][bj][m][1] + b1;
#pragma unroll
                    for (int j = 0; j < 4; ++j) { const float s0 = fast_sigmoid(v0[j]), s1 = fast_sigmoid(v1[j]);
                        const float d0 = -0.60653066f * s0, d1 = -0.60653066f * s1;
                        v0[j] = mode == 0 ? d0 : (mode == 1 ? s0 : v0[j]); v1[j] = mode == 0 ? d1 : (mode == 1 ? s1 : v1[j]); }
                    *(u32x4*)(lout + (size_t)row * 3072 + pn * BM + bj * HALF + cin) = pack8(v0, v1); asm volatile("" ::: "memory"); } }
    }
};
template <class Epi, class Sched, bool ALIGN_EPI = false, bool SP2 = false>
__device__ __forceinline__ void gemm_phase(PG8_LAS unsigned char* lds, const Gemm g, const Sched& S, const Epi& E) {
    const int tid = threadIdx.x, wid = __builtin_amdgcn_readfirstlane(tid >> 6), lane = tid & 63, wr = wid >> 2, wc = wid & 3, fr = lane & 15, fq = lane >> 4;
    const int K = g.K, nt = K / BK, lda = g.lda ? g.lda : g.K;
    unsigned voffA[2], voffB[2];
#pragma unroll
    for (int i = 0; i < 2; ++i) { int R, C; stage_rc(tid * 16 + i * 8192, R, C); const int Rb = Epi::PERM ? ((R & ~31) + perm32(R & 31)) : R;
        voffA[i] = (unsigned)(R * lda + C) * 2u; voffB[i] = (unsigned)(Rb * K + C) * 2u; }
    const size_t kstep = (size_t)(BK * 2);
    const size_t hstep = (size_t)HALF * K * 2, hstepA = (size_t)HALF * lda * 2;
    const size_t tstep = 2 * hstep, tstepA = 2 * hstepA;
    const unsigned ldsw = (unsigned)wid * 1024u;
    const int aoff = lds_byte(wr * 64 + fr, fq * 8), boff = lds_byte(wc * 32 + fr, fq * 8);
#define PG8_SA(b, h) (((b) * 2 + (h)) * HTB)
#define PG8_SB(b, h) ((4 + (b) * 2 + (h)) * HTB)
#define PG8_STAGE(bufoff, gbase, voff) do { _Pragma("unroll") for (int _i = 0; _i < 2; ++_i) \
        __builtin_amdgcn_global_load_lds((const unsigned*)((const char*)(gbase) + (voff)[_i]), (PG8_LAS unsigned*)(lds + (bufoff) + ldsw + _i * 8192), 16, 0, 0); } while (0)
#define PG8_LDA(dst, b, h) do { _Pragma("unroll") for (int m = 0; m < 4; ++m) _Pragma("unroll") for (int k = 0; k < 2; ++k) dst[m][k] = *(const PG8_LAS bf16x8*)(lds + PG8_SA(b, h) + aoff + m * 2048 + k * 1024); } while (0)
#define PG8_LDB(dst, b, h) do { _Pragma("unroll") for (int n = 0; n < 2; ++n) _Pragma("unroll") for (int k = 0; k < 2; ++k) dst[n][k] = *(const PG8_LAS bf16x8*)(lds + PG8_SB(b, h) + boff + n * 2048 + k * 1024); } while (0)
#define PG8_MMA(ai, bj, At, Bt) do { __builtin_amdgcn_s_setprio(1); _Pragma("unroll") for (int k = 0; k < 2; ++k) _Pragma("unroll") for (int m = 0; m < 4; ++m) _Pragma("unroll") for (int n_ = 0; n_ < 2; ++n_) { const int n = (m & 1) ? 1 - n_ : n_; \
        acc[ai][bj][m][n] = __builtin_amdgcn_mfma_f32_16x16x32_bf16(Bt[n][k], At[m][k], acc[ai][bj][m][n], 0, 0, 0); PG8_SCHED; } __builtin_amdgcn_s_setprio(0); } while (0)
#define PG8_MMA2(ai, At, B0, B1) do { __builtin_amdgcn_s_setprio(1); _Pragma("unroll") for (int k = 0; k < 2; ++k) _Pragma("unroll") for (int s_ = 0; s_ < 16; ++s_) { \
        constexpr int HM[16] = {0, 0, 1, 1, 1, 1, 0, 0, 2, 2, 3, 3, 3, 3, 2, 2}, HQ[16] = {0, 1, 1, 0, 2, 3, 3, 2, 2, 3, 3, 2, 1, 0, 0, 1}; \
        const int m = HM[s_], q = HQ[s_], bj = q >> 1, n = q & 1; \
        acc[ai][bj][m][n] = __builtin_amdgcn_mfma_f32_16x16x32_bf16(bj ? B1[n][k] : B0[n][k], At[m][k], acc[ai][bj][m][n], 0, 0, 0); PG8_SCHED; } __builtin_amdgcn_s_setprio(0); } while (0)
#define PG8_WAIT_V(n) asm volatile("s_waitcnt vmcnt(" #n ")" ::: "memory")
#define PG8_WAIT_L(n) asm volatile("s_waitcnt lgkmcnt(" #n ")" ::: "memory")
#define PG8_BAR __builtin_amdgcn_s_barrier()
#define PG8_SCHED __builtin_amdgcn_sched_barrier(0)
    Unit cur, nxt; int ui = 0;
    if (!S.next(0, cur)) return;
    f32x4 acc[2][2][4][2];
#pragma unroll
    for (int a = 0; a < 2; ++a)
#pragma unroll
        for (int b = 0; b < 2; ++b)
#pragma unroll
            for (int m = 0; m < 4; ++m)
#pragma unroll
                for (int n = 0; n < 2; ++n) acc[a][b][m][n] = (f32x4){0.f, 0.f, 0.f, 0.f};
    bf16x8 At[4][2], B0[2][2], B1[2][2];
    const char* cA = (const char*)g.A + (size_t)cur.pm * tstepA; const char* cB = (const char*)g.Bt + (size_t)cur.pn * tstep;
    S.a_ready(cur);
    if constexpr (SP2) {
        PG8_STAGE(PG8_SB(0, 0), cB, voffB); PG8_STAGE(PG8_SB(0, 1), cB + hstep, voffB); PG8_STAGE(PG8_SA(0, 0), cA, voffA); PG8_STAGE(PG8_SA(0, 1), cA + hstepA, voffA);
        if (wr == 1) PG8_BAR;
        PG8_WAIT_V(2); PG8_BAR;
        PG8_STAGE(PG8_SB(1, 0), cB + kstep, voffB); PG8_STAGE(PG8_SA(1, 0), cA + kstep, voffA); PG8_STAGE(PG8_SB(1, 1), cB + hstep + kstep, voffB);
        PG8_WAIT_V(6); PG8_BAR;
    } else {
        PG8_STAGE(PG8_SB(0, 0), cB, voffB); PG8_STAGE(PG8_SA(0, 0), cA, voffA); PG8_STAGE(PG8_SB(0, 1), cB + hstep, voffB); PG8_STAGE(PG8_SA(0, 1), cA + hstepA, voffA);
        if (wr == 1) PG8_BAR;
        PG8_WAIT_V(4); PG8_BAR;
        PG8_STAGE(PG8_SB(1, 0), cB + kstep, voffB); PG8_STAGE(PG8_SA(1, 0), cA + kstep, voffA); PG8_STAGE(PG8_SB(1, 1), cB + hstep + kstep, voffB);
        PG8_WAIT_V(6); PG8_BAR;
    }
    for (;;) {
        const bool has_next = S.next(ui + 1, nxt);
        const char* nA = has_next ? (const char*)g.A + (size_t)nxt.pm * tstepA : cA; const char* nB = has_next ? (const char*)g.Bt + (size_t)nxt.pn * tstep : cB;
        for (int t = 0; t < nt; t += 2) {
            const bool last = (t == nt - 2);
            const char* a1 = cA + (size_t)(t + 1) * kstep;
            const char* a2 = last ? nA : cA + (size_t)(t + 2) * kstep; const char* b2 = last ? nB : cB + (size_t)(t + 2) * kstep;
            const char* a3 = a2 + kstep; const char* b3 = b2 + kstep;
            if (last && has_next) S.a_ready(nxt);
            if constexpr (SP2) {
            PG8_LDB(B0, 0, 0); PG8_LDB(B1, 0, 1); PG8_SCHED; PG8_LDA(At, 0, 0); PG8_STAGE(PG8_SA(1, 1), a1 + hstepA, voffA);
            PG8_WAIT_V(8); PG8_WAIT_L(0); PG8_BAR; PG8_MMA2(0, At, B0, B1); PG8_BAR; PG8_SCHED;
            PG8_LDA(At, 0, 1); PG8_STAGE(PG8_SB(0, 0), b2, voffB); PG8_STAGE(PG8_SB(0, 1), b2 + hstep, voffB); PG8_STAGE(PG8_SA(0, 0), a2, voffA);
            PG8_WAIT_V(8); PG8_WAIT_L(0); PG8_BAR; PG8_MMA2(1, At, B0, B1); PG8_BAR; PG8_SCHED;
            PG8_LDB(B0, 1, 0); PG8_LDB(B1, 1, 1); PG8_SCHED; PG8_LDA(At, 1, 0); PG8_STAGE(PG8_SA(0, 1), a2 + hstepA, voffA);
            PG8_WAIT_V(8); PG8_WAIT_L(0); PG8_BAR; PG8_MMA2(0, At, B0, B1); PG8_BAR; PG8_SCHED;
            PG8_LDA(At, 1, 1); PG8_STAGE(PG8_SB(1, 0), b3, voffB); PG8_STAGE(PG8_SB(1, 1), b3 + hstep, voffB); PG8_STAGE(PG8_SA(1, 0), a3, voffA);
            PG8_WAIT_V(8); PG8_WAIT_L(0); PG8_BAR; PG8_MMA2(1, At, B0, B1); PG8_BAR; PG8_SCHED;
            } else {
            PG8_LDB(B0, 0, 0); PG8_SCHED; PG8_LDA(At, 0, 0); PG8_STAGE(PG8_SA(1, 1), a1 + hstepA, voffA);
            PG8_WAIT_L(8); PG8_BAR; PG8_WAIT_L(0); PG8_MMA(0, 0, At, B0); PG8_BAR; PG8_SCHED;
            PG8_LDB(B1, 0, 1); PG8_STAGE(PG8_SB(0, 0), b2, voffB);
            PG8_BAR; PG8_WAIT_L(0); PG8_MMA(0, 1, At, B1); PG8_BAR;
            PG8_LDA(At, 0, 1); PG8_STAGE(PG8_SA(0, 0), a2, voffA);
            PG8_BAR; PG8_WAIT_L(0); PG8_MMA(1, 0, At, B0); PG8_BAR; PG8_SCHED;
            PG8_STAGE(PG8_SB(0, 1), b2 + hstep, voffB);
            PG8_WAIT_V(6); PG8_BAR; PG8_MMA(1, 1, At, B1); PG8_BAR;
            PG8_LDB(B0, 1, 0); PG8_SCHED; PG8_LDA(At, 1, 0); PG8_STAGE(PG8_SA(0, 1), a2 + hstepA, voffA);
            PG8_WAIT_L(8); PG8_BAR; PG8_WAIT_L(0); PG8_MMA(0, 0, At, B0); PG8_BAR; PG8_SCHED;
            PG8_LDB(B1, 1, 1); PG8_STAGE(PG8_SB(1, 0), b3, voffB);
            PG8_BAR; PG8_WAIT_L(0); PG8_MMA(0, 1, At, B1); PG8_BAR;
            PG8_LDA(At, 1, 1); PG8_STAGE(PG8_SA(1, 0), a3, voffA);
            PG8_BAR; PG8_WAIT_L(0); PG8_MMA(1, 0, At, B0); PG8_BAR; PG8_SCHED;
            PG8_STAGE(PG8_SB(1, 1), b3 + hstep, voffB);
            PG8_WAIT_V(6); PG8_BAR; PG8_MMA(1, 1, At, B1); PG8_BAR;
            }
        }
        if constexpr (ALIGN_EPI) { if (wr == 0) PG8_BAR; }
        if constexpr (!Epi::AFTER_DRAIN) { E(acc, cur, wr, wc, fr, fq); S.done(cur); }
        if (!has_next) break;
#pragma unroll
        for (int a = 0; a < 2; ++a)
#pragma unroll
            for (int b = 0; b < 2; ++b)
#pragma unroll
                for (int m = 0; m < 4; ++m)
#pragma unroll
                    for (int n = 0; n < 2; ++n) acc[a][b][m][n] = (f32x4){0.f, 0.f, 0.f, 0.f};
        cur = nxt; cA = nA; cB = nB; ++ui;
        if constexpr (ALIGN_EPI) { if (wr == 1) PG8_BAR; }
    }
    PG8_WAIT_V(0);
    if constexpr (!ALIGN_EPI) { if (wr == 0) PG8_BAR; }
    PG8_BAR;
    if constexpr (Epi::AFTER_DRAIN) { E.fused(acc, cur, wr, wc, fr, fq, lds, wid, lane); S.done(cur); }
#undef PG8_SA
#undef PG8_SB
#undef PG8_STAGE
#undef PG8_LDA
#undef PG8_LDB
#undef PG8_MMA
#undef PG8_WAIT_V
#undef PG8_WAIT_L
#undef PG8_BAR
#undef PG8_SCHED
}
}

constexpr int NWAVES = 8;
constexpr int BATCH = 4, SEQ = 8192, D = 2048, M = BATCH * SEQ, FF = 5632;
constexpr int RC = 1024, RH = 16, RN = 64;
constexpr int HC = 1024, HH = 8, HD = 128;
constexpr int RWKV_COLS = 3360, IN_COLS = 7456, NIN = 7680;
constexpr int KL = 384, NL = 3072;
#ifndef MK_N_LAUNCHES
#define MK_N_LAUNCHES 1
#endif
constexpr int N_PHASES = 12;

constexpr size_t WS_CTL = 0, CTL_BYTES = 1u << 20;
constexpr size_t WS_W1GU = CTL_BYTES;
constexpr size_t WS_W1D = WS_W1GU + (size_t)2 * FF * D * 2;
constexpr size_t WS_WIN = WS_W1D + (size_t)D * FF * 2;
constexpr size_t WS_WLORA = WS_WIN + (size_t)NIN * D * 2;
constexpr size_t WS_WOUT = WS_WLORA + (size_t)NL * KL * 2;
constexpr size_t WS_W2GU = WS_WOUT + (size_t)D * D * 2;
constexpr size_t WS_W2D = WS_W2GU + (size_t)2 * FF * D * 2;
constexpr size_t WS_SS = WS_W2D + (size_t)D * FF * 2;
constexpr size_t WS_XB = WS_SS + (1u << 20);
constexpr size_t WS_R = WS_XB + (size_t)M * D * 2;
constexpr size_t R_ACT = 0;
constexpr size_t R_RKV = 0;
constexpr size_t R_HG = R_RKV + (size_t)M * 3072 * 2;
constexpr size_t R_LIN = R_HG + (size_t)M * 4096 * 2;
constexpr size_t R_BYTES = R_LIN + (size_t)M * 288 * 4;
constexpr size_t WS_ALORA = WS_R + R_BYTES;
constexpr size_t WS_LOUT = WS_ALORA + (size_t)M * KL * 2;
constexpr size_t WS_INVN = WS_LOUT + (size_t)M * NL * 2;
constexpr size_t WS_END = WS_INVN + (size_t)M * RH * 4;
static_assert(WS_END <= ((size_t)1 << 30), "d_ws map");
constexpr int CW_PCNT = 8704;
constexpr int CW_SIG_HALF = 8192, CW_SIG_SHA = 8256, CW_SIG_SHB = 8320, CW_SIG_P4 = 8384, CW_SIG_H2 = 8448, CW_SIG_HG = 8512, CW_SIG_RW = 8576;
constexpr int CW_BAR = 4096;

constexpr int RING_BYTES = 162816;
constexpr int LDSCTL_OFF = RING_BYTES, MISC_OFF = LDSCTL_OFF + 320;
constexpr int LDS_BYTES = 163840;
static_assert(MISC_OFF + 128 <= LDS_BYTES, "LDS map");

#define GAS __attribute__((address_space(1)))
#define LAS __attribute__((address_space(3)))
typedef unsigned short bf16;
typedef unsigned v4u __attribute__((ext_vector_type(4)));
typedef unsigned v2u __attribute__((ext_vector_type(2)));
typedef float f32x4 __attribute__((ext_vector_type(4)));
#define LDS_WAIT() asm volatile("s_waitcnt lgkmcnt(0)" ::: "memory")
#define VM_WAIT() asm volatile("s_waitcnt vmcnt(0)" ::: "memory")
__device__ __forceinline__ float bflo(unsigned u) { return __builtin_bit_cast(float, u << 16); }
__device__ __forceinline__ float bfhi(unsigned u) { return __builtin_bit_cast(float, u & 0xffff0000u); }
__device__ __forceinline__ f32x4 unpack4(v2u w) { return (f32x4){bflo(w.x), bfhi(w.x), bflo(w.y), bfhi(w.y)}; }
__device__ __forceinline__ unsigned pk2(float lo, float hi) { return pg8::cvt_pk_bf16(lo, hi); }
__device__ __forceinline__ v2u pack4(f32x4 v) { v2u w; w.x = pk2(v[0], v[1]); w.y = pk2(v[2], v[3]); return w; }
using pg8::fast_sigmoid;
using pg8::fast_silu;
template <int CTRL> __device__ __forceinline__ float dpp_mov(float x) { return __builtin_bit_cast(float, __builtin_amdgcn_update_dpp(0, __builtin_bit_cast(int, x), CTRL, 0xF, 0xF, true)); }
__device__ __forceinline__ float row16_sum(float x) { x += dpp_mov<0x128>(x); x += dpp_mov<0x124>(x); x += dpp_mov<0x122>(x); x += dpp_mov<0x121>(x); return x; }
template <int CTRL, int BANK> __device__ __forceinline__ float dpp_upd(float old, float x) { return __builtin_bit_cast(float, __builtin_amdgcn_update_dpp(__builtin_bit_cast(int, old), __builtin_bit_cast(int, x), CTRL, 0xF, BANK, false)); }
__device__ __forceinline__ float tr_reduce16(const float (&v)[16], int lane) {
    float u[8], w[4], x[2];
#pragma unroll
    for (int s = 0; s < 8; ++s) { const float t = v[s + 8] + dpp_mov<0x128>(v[s + 8]), a = v[s] + dpp_mov<0x128>(v[s]); u[s] = dpp_upd<0xE4, 0x3>(t, a); }
#pragma unroll
    for (int s = 0; s < 4; ++s) { const float t = u[s + 4] + dpp_mov<0x141>(u[s + 4]), a = u[s] + dpp_mov<0x141>(u[s]); w[s] = dpp_upd<0xE4, 0x5>(t, a); }
    const bool b1 = (lane & 2) != 0, b0 = (lane & 1) != 0;
#pragma unroll
    for (int s = 0; s < 2; ++s) { const float K = b1 ? w[s + 2] : w[s], T = b1 ? w[s] : w[s + 2]; x[s] = K + dpp_mov<0x1B>(T); }
    const float K = b0 ? x[1] : x[0], T = b0 ? x[0] : x[1];
    return K + dpp_mov<0xB1>(T);
}
typedef float f32x2 __attribute__((ext_vector_type(2)));
#define LO2(v) __builtin_shufflevector(v, v, 0, 1)
#define HI2(v) __builtin_shufflevector(v, v, 2, 3)
__device__ __forceinline__ float wave_sum(float v) {
#pragma unroll
    for (int o = 1; o < 64; o <<= 1) v += __shfl_xor(v, o);
    return v;
}
#define XB_TMO      128
#define XB_XCNT(j)  (256  + 64 * (j))
#define XB_XSUB(j)  (1280 + 64 * (j))
#define XB_XGEN(j)  (2304 + 64 * (j))
#define XB_TOP      3328
#define XB_TOPGEN   3392
#define XCD_BAR_WORDS 3456
#define XB_SPIN_CAP (1u << 18)

__device__ __forceinline__ unsigned xb_ld(unsigned* p)              { return __hip_atomic_load(p, __ATOMIC_RELAXED, __HIP_MEMORY_SCOPE_AGENT); }
__device__ __forceinline__ unsigned xb_add(unsigned* p, unsigned v) { return __hip_atomic_fetch_add(p, v, __ATOMIC_RELAXED, __HIP_MEMORY_SCOPE_AGENT); }
__device__ __forceinline__ unsigned xb_xcc_id() { return (unsigned)__builtin_amdgcn_s_getreg((3 << 11) | 20) & 0xFu; }
#define XB_SPIN(cond, bar) do { unsigned _sp = 0; while (cond) { __builtin_amdgcn_s_sleep(1); \
    if ((++_sp & 255u) == 0u) { if (xb_ld(&(bar)[XB_TMO])) break; if (_sp > XB_SPIN_CAP) { atomicAdd(&(bar)[XB_TMO], 1u); break; } } } } while (0)

struct XcdBarrier {
    unsigned* bar; unsigned x;
    volatile LAS unsigned* st;
};

__device__ __forceinline__ XcdBarrier xcd_barrier_post(unsigned* bar, volatile LAS unsigned* st) {
    XcdBarrier b; b.bar = bar; b.x = xb_xcc_id(); b.st = st;
    if (threadIdx.x == 0) (void)xb_add(&bar[XB_XCNT(b.x)], 1u);
    return b;
}
__device__ __forceinline__ void xcd_barrier_complete(unsigned* bar, unsigned x, unsigned& nloc, unsigned& nx) {
    const unsigned G = gridDim.x * gridDim.y * gridDim.z;
    unsigned sum, cnt, mine, sp = 0u;
    for (;;) {
        sum = 0u; cnt = 0u; mine = 0u;
#pragma unroll
        for (unsigned j = 0; j < 16; ++j) { const unsigned c = xb_ld(&bar[XB_XCNT(j)]); sum += c; cnt += (c > 0u) ? 1u : 0u; mine = (j == x) ? c : mine; }
        if (sum == G) break;
        __builtin_amdgcn_s_sleep(1);
        if ((++sp & 255u) == 0u) { if (xb_ld(&bar[XB_TMO])) break; if (sp > XB_SPIN_CAP) { atomicAdd(&bar[XB_TMO], 1u); break; } }
    }
    nloc = mine > 0u ? mine : 1u; nx = cnt > 0u ? cnt : 1u;
}

__device__ __forceinline__ void xcd_barrier(const XcdBarrier& b) {
    asm volatile("s_waitcnt vmcnt(0)" ::: "memory");
    __syncthreads();
    if (threadIdx.x == 0) {
        unsigned* bar = b.bar;
        __builtin_amdgcn_s_waitcnt(0);
        unsigned nloc = b.st[0], nx = b.st[1];
        if (nloc == 0u) { xcd_barrier_complete(bar, b.x, nloc, nx); b.st[0] = nloc; b.st[1] = nx; }
        const unsigned old = xb_add(&bar[XB_XSUB(b.x)], 1u);
        const unsigned gen = old / nloc;
        if (old + 1u == (gen + 1u) * nloc) {
            __builtin_amdgcn_fence(__ATOMIC_RELEASE, "agent");
            asm volatile("s_waitcnt vmcnt(0)" ::: "memory");
            const unsigned og = xb_add(&bar[XB_TOP], 1u);
            const unsigned tg = og / nx;
            if (og + 1u == (tg + 1u) * nx) xb_add(&bar[XB_TOPGEN], 1u);
            else XB_SPIN(xb_ld(&bar[XB_TOPGEN]) == tg, bar);
            __builtin_amdgcn_fence(__ATOMIC_ACQUIRE, "agent");
            xb_add(&bar[XB_XGEN(b.x)], 1u);
            asm volatile("s_waitcnt vmcnt(0)" ::: "memory");
        } else {
            XB_SPIN(xb_ld(&bar[XB_XGEN(b.x)]) == gen, bar);
            __builtin_amdgcn_fence(__ATOMIC_ACQUIRE, "agent");
            asm volatile("s_waitcnt vmcnt(0)" ::: "memory");
        }
    }
    __syncthreads();
}

__device__ __forceinline__ void sig_post(unsigned* ctr) {
    __builtin_amdgcn_fence(__ATOMIC_RELEASE, "agent"); asm volatile("s_waitcnt vmcnt(0)" ::: "memory"); (void)xb_add(ctr, 1u);
}
__device__ __forceinline__ void wg_signal(unsigned* ctr) {
    asm volatile("s_waitcnt vmcnt(0)" ::: "memory"); __syncthreads();
    if (threadIdx.x == 0) sig_post(ctr);
}
__device__ __forceinline__ void wg_wait(unsigned* ctr, unsigned target, unsigned* bar) {
    if (threadIdx.x == 0) { XB_SPIN(xb_ld(ctr) < target, bar); __builtin_amdgcn_fence(__ATOMIC_ACQUIRE, "agent"); asm volatile("s_waitcnt vmcnt(0)" ::: "memory"); }
    __syncthreads();
}

struct Frame {
    LAS unsigned char* lds;
    int tid, lane, wave, vcu, G;
    const float* in[26];
    float* out; unsigned char* ws;
};
#define WSP(T, off) ((T*)(F.ws + (off)))
struct Args { const float* in[26]; float* out; unsigned char* ws; int ph_lo, ph_hi; };

struct P0Item { const float* W; bf16* WT; int K, N, kb, n0, drow0; };
__device__ __forceinline__ int map_gu(int n0, int which) { return (n0 >> 7) * 256 + which * 128 + (n0 & 127); }
constexpr int P0_I_GU = (D / 64) * (FF / 32), P0_I_DN = (FF / 64) * (D / 32), P0_I_IN = (D / 64) * (IN_COLS / 32), P0_I_OUT = (D / 64) * (D / 32);
constexpr int P0_N0 = 2 * P0_I_GU + P0_I_DN + P0_I_IN, P0_N1 = 2 * P0_I_GU + P0_I_DN + P0_I_OUT;
template <int SET> __device__ __forceinline__ P0Item p0_decode(Frame& F, const Args& A, int it) {
    constexpr int I_GU = P0_I_GU, I_DN = P0_I_DN, I_IN = P0_I_IN;
    P0Item p; int r = it;
    if (SET == 0) { if (r >= 2 * I_GU) r += 2 * I_GU; if (r >= 4 * I_GU + I_DN) r += I_DN; }
    else { r += 2 * I_GU; if (r >= 4 * I_GU) r += I_DN; if (r >= 4 * I_GU + 2 * I_DN) r += I_IN; }
    if (r < 4 * I_GU) { const int mat = r / I_GU; r -= mat * I_GU; const int nblk = FF / 32, ffn = mat >> 1, which = mat & 1;
        p.W = A.in[2 + 20 * ffn + which]; p.WT = WSP(bf16, ffn ? WS_W2GU : WS_W1GU); p.K = D; p.N = FF; p.kb = r / nblk; p.n0 = 32 * (r % nblk); p.drow0 = map_gu(p.n0, which); return p; }
    r -= 4 * I_GU;
    if (r < 2 * I_DN) { const int ffn = r / I_DN; r -= ffn * I_DN; const int nblk = D / 32;
        p.W = A.in[4 + 20 * ffn]; p.WT = WSP(bf16, ffn ? WS_W2D : WS_W1D); p.K = FF; p.N = D; p.kb = r / nblk; p.n0 = 32 * (r % nblk); p.drow0 = p.n0; return p; }
    r -= 2 * I_DN;
    if (r < I_IN) { const int nblk = IN_COLS / 32;
        p.W = A.in[6]; p.WT = WSP(bf16, WS_WIN); p.K = D; p.N = IN_COLS; p.kb = r / nblk; p.n0 = 32 * (r % nblk); p.drow0 = p.n0 < RWKV_COLS ? p.n0 : p.n0 + 224; return p; }
    r -= I_IN;
    { const int nblk = D / 32; p.W = A.in[20]; p.WT = WSP(bf16, WS_WOUT); p.K = D; p.N = D; p.kb = r / nblk; p.n0 = 32 * (r % nblk); p.drow0 = p.n0; return p; }
}
__device__ __forceinline__ void p0_dma(const P0Item& p, LAS unsigned char* tile, int lane) {
    const int half = lane >> 5, sl = lane & 31;
#pragma unroll 8
    for (int i = 0; i < 32; ++i) { const int kk = 2 * i + half;
        __builtin_amdgcn_global_load_lds((const GAS unsigned*)(p.W + (size_t)(64 * p.kb + kk) * p.N + p.n0 + (sl ^ (4 * (kk >> 3)))), (LAS unsigned*)(tile + i * 256), 4, 0, 0); }
}
__device__ __forceinline__ void p0_emit(const P0Item& p, const LAS float* t, int lane) {
    const int c = lane & 7;
#pragma unroll
    for (int j = 0; j < 4; ++j) { const int n = (lane >> 3) + 8 * j; const LAS float* s = t + (8 * c) * 32 + (n ^ (4 * c));
        v4u o; o.x = pk2(s[0 * 32], s[1 * 32]); o.y = pk2(s[2 * 32], s[3 * 32]); o.z = pk2(s[4 * 32], s[5 * 32]); o.w = pk2(s[6 * 32], s[7 * 32]);
        *(GAS v4u*)(p.WT + (size_t)(p.drow0 + n) * p.K + 64 * p.kb + 8 * c) = o; }
}
template <int SET> __device__ __forceinline__ void p0_transposes(Frame& F, const Args& A, int gw, int NGW) {
    LAS unsigned char* tiles = F.lds + F.wave * 16384;
    constexpr int NITEMS = SET == 0 ? P0_N0 : P0_N1;
    if (gw < NITEMS) {
        P0Item cur = p0_decode<SET>(F, A, gw); int buf = 0;
        p0_dma(cur, tiles, F.lane);
        for (int it = gw; it < NITEMS; it += NGW) {
            const bool more = it + NGW < NITEMS; P0Item nxt = cur;
            if (more) { nxt = p0_decode<SET>(F, A, it + NGW); p0_dma(nxt, tiles + (buf ^ 1) * 8192, F.lane); asm volatile("s_waitcnt vmcnt(32)" ::: "memory"); }
            else asm volatile("s_waitcnt vmcnt(0)" ::: "memory");
            p0_emit(cur, (const LAS float*)(tiles + buf * 8192), F.lane);
            LDS_WAIT(); asm volatile("" ::: "memory");
            cur = nxt; buf ^= 1;
        }
        asm volatile("s_waitcnt vmcnt(0)" ::: "memory");
    }
}
__device__ __forceinline__ void p0_prologue(Frame& F, const Args& A) {
    const int gw = F.vcu * NWAVES + F.wave, NGW = F.G * NWAVES;
    p0_transposes<0>(F, A, gw, NGW);
    const size_t gt = (size_t)F.vcu * (NWAVES * 64) + F.tid, NT = (size_t)F.G * NWAVES * 64;
    { GAS v4u* z = (GAS v4u*)(WSP(bf16, WS_WIN) + (size_t)RWKV_COLS * D);
      for (size_t i = gt; i < (size_t)224 * D * 2 / 16; i += NT) z[i] = (v4u){0u, 0u, 0u, 0u}; }
    { bf16* wl = WSP(bf16, WS_WLORA); const float* w2 = F.in[9]; const float* a2 = F.in[11]; const float* g2 = F.in[12];
      for (size_t i = gt; i < (size_t)2048 * 64; i += NT) { const int n = (int)(i >> 6), k = 2 * (int)(i & 63); const int seg = n >> 10, c = n & 1023;
          float v0 = 0.f, v1 = 0.f;
          if (seg == 0) { if (k < 64) { v0 = w2[(size_t)k * RC + c]; v1 = w2[(size_t)(k + 1) * RC + c]; } }
          else { if (k >= 64) { v0 = a2[(size_t)(k - 64) * RC + c]; v1 = a2[(size_t)(k - 63) * RC + c]; } }
          ((GAS unsigned*)wl)[i] = pk2(v0, v1); }
      GAS unsigned* wg = (GAS unsigned*)(wl + (size_t)2048 * 128);
      for (size_t i = gt; i < (size_t)1024 * 128; i += NT) { const int c = (int)(i >> 7), k = 2 * (int)(i & 127);
          float v0 = 0.f, v1 = 0.f;
          if (k < 160) { v0 = g2[(size_t)k * RC + c]; v1 = g2[(size_t)(k + 1) * RC + c]; }
          wg[i] = pk2(v0, v1); } }
    { GAS unsigned long long* s = (GAS unsigned long long*)(F.ws + WS_SS) + M;
      for (size_t i = gt; i < (size_t)3 * M; i += NT) s[i] = 0ull; }
    { const float* x = F.in[0]; bf16* xb = WSP(bf16, WS_XB); unsigned long long* ss0 = WSP(unsigned long long, WS_SS);
      for (int m = gw; m < M; m += NGW) { const GAS f32x4* xr = (const GAS f32x4*)(x + (size_t)m * D) + 2 * F.lane; GAS v4u* o = (GAS v4u*)(xb + (size_t)m * D) + F.lane; float s = 0.f;
#pragma unroll
          for (int j = 0; j < 4; ++j) { const f32x4 a = xr[128 * j], b = xr[128 * j + 1];
              s += (a[0] * a[0] + a[1] * a[1]) + (a[2] * a[2] + a[3] * a[3]) + (b[0] * b[0] + b[1] * b[1]) + (b[2] * b[2] + b[3] * b[3]);
              const f32x4 ga = *(const f32x4*)(F.in[1] + 8 * F.lane + 512 * j), gb = *(const f32x4*)(F.in[1] + 8 * F.lane + 512 * j + 4);
              o[64 * j] = pg8::pack8(a * ga, b * gb); }
          s = wave_sum(s);
          if (F.lane == 0) ss0[m] = (unsigned long long)(s * pg8::SS_SCALE + 0.5f); } }
}

__device__ __forceinline__ void p4_lora_in(Frame& F, int hsel, int c, int G) {
    const int NR = hsel < 0 ? M : M / 2;
#define P4_ROW(i_) (hsel < 0 ? (i_) : ((i_) / (SEQ / 2)) * SEQ + ((i_) % (SEQ / 2)) + hsel * (SEQ / 2))
    const float* lin = WSP(float, WS_R + R_LIN); bf16* al = WSP(bf16, WS_ALORA); const float* mu = F.in[7] + 3 * RC;
    const size_t gt = (size_t)c * (NWAVES * 64) + F.tid, NT = (size_t)G * NWAVES * 64;
#pragma unroll 4
    for (size_t i = gt; i < (size_t)NR * 96; i += NT) { const int mi = (int)(i / 96), m = P4_ROW(mi), q = (int)(i % 96), qc = q < 72 ? q : 0; const bool first = (m & (SEQ - 1)) == 0;
        const f32x4 p = *(const GAS f32x4*)(lin + (size_t)m * 288 + 4 * qc), pr = *(const GAS f32x4*)(lin + (size_t)(first ? m : m - 1) * 288 + 4 * qc), mv = *(const GAS f32x4*)(mu + 4 * qc);
        const f32x4 pp = first ? (f32x4){0.f, 0.f, 0.f, 0.f} : pr; f32x4 s = p + (pp - p) * mv;
#pragma unroll
        for (int j = 0; j < 4; ++j) { const float sg = fast_sigmoid(q < 16 ? 2.0f * s[j] : s[j]); s[j] = q < 16 ? 2.0f * sg - 1.0f : (q >= 32 ? sg : s[j]); }
        v2u o = pack4(s); if (q >= 72) o = (v2u){0u, 0u};
        *(GAS v2u*)(al + (size_t)m * KL + 4 * q) = o; }
    { const bf16* rkv = WSP(bf16, WS_R + R_RKV); float* invn = WSP(float, WS_INVN); const int j4 = (F.tid & 15) * 4;
      const size_t it0 = gt >> 4, step = NT >> 4; const int h = (int)(it0 & 15), ch = h * RN + j4;
      const f32x4 muk = *(const f32x4*)(F.in[7] + RC + ch), kkc = *(const f32x4*)(F.in[13] + ch);
      if ((step & 15) == 0) {
          const size_t NI = (size_t)NR * RH;
          for (size_t it = it0; it < NI; it += 8 * step) { v2u Lk[8], Lp[8];
#pragma unroll
              for (int u = 0; u < 8; ++u) { const size_t iu = (it + u * step < NI) ? it + u * step : it; const int mi = (int)(iu >> 4), m = P4_ROW(mi); const bool first = (m & (SEQ - 1)) == 0;
                  Lk[u] = *(const GAS v2u*)(rkv + (size_t)m * 3072 + RC + ch); Lp[u] = *(const GAS v2u*)(rkv + (size_t)(first ? m : m - 1) * 3072 + RC + ch); }
#pragma unroll
              for (int u = 0; u < 8; ++u) { const size_t iu = it + u * step; if (iu < NI) { const int mi = (int)(iu >> 4), m = P4_ROW(mi); const bool first = (m & (SEQ - 1)) == 0;
                  const f32x4 k = unpack4(Lk[u]), kr = unpack4(Lp[u]);
                  const f32x4 kp = first ? (f32x4){0.f, 0.f, 0.f, 0.f} : kr;
                  const f32x4 kk = (k + (kp - k) * muk) * kkc; float s2 = (kk[0] * kk[0] + kk[1] * kk[1]) + (kk[2] * kk[2] + kk[3] * kk[3]); s2 = row16_sum(s2);
                  if ((F.tid & 15) == 0) invn[(size_t)m * RH + h] = 1.0f / fmaxf(sqrtf(s2), 1e-12f); } } }
      } else {
          for (size_t it = it0; it < (size_t)NR * RH; it += step) { const int mi = (int)(it >> 4), m = P4_ROW(mi), h2 = (int)(it & 15), c2 = h2 * RN + j4; const bool first = (m & (SEQ - 1)) == 0;
              const f32x4 k = unpack4(*(const GAS v2u*)(rkv + (size_t)m * 3072 + RC + c2)), kr = unpack4(*(const GAS v2u*)(rkv + (size_t)(first ? m : m - 1) * 3072 + RC + c2));
              const f32x4 kp = first ? (f32x4){0.f, 0.f, 0.f, 0.f} : kr; const f32x4 mk2 = *(const f32x4*)(F.in[7] + RC + c2), kc2 = *(const f32x4*)(F.in[13] + c2);
              const f32x4 kk = (k + (kp - k) * mk2) * kc2; float s2 = (kk[0] * kk[0] + kk[1] * kk[1]) + (kk[2] * kk[2] + kk[3] * kk[3]); s2 = row16_sum(s2);
              if ((F.tid & 15) == 0) invn[(size_t)m * RH + h2] = 1.0f / fmaxf(sqrtf(s2), 1e-12f); } } }
#undef P4_ROW
}

typedef short bf16x4 __attribute__((ext_vector_type(4)));
typedef short bf16x8 __attribute__((ext_vector_type(8)));
#define MFMA32(a, b, c) __builtin_amdgcn_mfma_f32_16x16x32_bf16(a, b, c, 0, 0, 0)
#define MFMA16(a, b, c) __builtin_amdgcn_mfma_f32_16x16x16bf16_1k(a, b, c, 0, 0, 0)
__device__ __forceinline__ bf16x4 cv4(f32x4 v) { v2u w; w.x = pk2(v[0], v[1]); w.y = pk2(v[2], v[3]); return __builtin_bit_cast(bf16x4, w); }
__device__ __forceinline__ bf16x8 cv8(f32x4 a, f32x4 b) { v4u w; w.x = pk2(a[0], a[1]); w.y = pk2(a[2], a[3]); w.z = pk2(b[0], b[1]); w.w = pk2(b[2], b[3]); return __builtin_bit_cast(bf16x8, w); }
__device__ __forceinline__ bf16x8 cat8(bf16x4 a, bf16x4 b) { return __builtin_shufflevector(a, b, 0, 1, 2, 3, 4, 5, 6, 7); }
__device__ __forceinline__ bf16x8 join8(v2u a, v2u b) { v4u w; w.x = a.x; w.y = a.y; w.z = b.x; w.w = b.y; return __builtin_bit_cast(bf16x8, w); }
__device__ __forceinline__ float row16_scan(float x) { x += dpp_mov<0x111>(x); x += dpp_mov<0x112>(x); x += dpp_mov<0x114>(x); x += dpp_mov<0x118>(x); return x; }
__device__ __forceinline__ unsigned short bf1(float x) { return (unsigned short)(pk2(x, 0.f) & 0xffffu); }
constexpr int CH = 16;
constexpr int RWS = 144;
constexpr int HGS = 400;
constexpr int RWB_KG = 0, RWB_RG = 16 * RWS, RWB_KTI = 32 * RWS, RWB_BTI = 48 * RWS, RWB_V = 64 * RWS, RWB_GL = 80 * RWS, RWB_BYTES = RWB_GL + 256;
__device__ __forceinline__ bf16x4 lds_tr4(const LAS unsigned char* p) { return __builtin_amdgcn_ds_read_tr16_b64_v4i16((LAS bf16x4*)p); }
constexpr int HGB_QG = 0, HGB_KI = 16 * HGS, HGB_V = 32 * HGS, HGB_GL = 48 * HGS, HGB_BYTES = HGB_GL + 512;

__device__ __forceinline__ f32x4 padc(f32x4 r) { asm("s_nop 15" : "+v"(r)); return r; }
constexpr int NCHK = SEQ / CH;
constexpr int NRAW = 8;
constexpr int RWR_R = 0, RWR_K = 2048, RWR_V = 4096, RWR_LW = 6144, RWR_A = 8192, RWR_INV = 10240, RWR_BYTES = 10304;
constexpr int RW_OPND = 0, RW_RAW = 3 * RWB_BYTES, RW_AOP = RW_RAW + NRAW * RWR_BYTES, RW_ZROW = RW_AOP + 2 * 2048  , RW_LDS = RW_ZROW + RWR_V + 128;
constexpr int HGR_Q = 0, HGR_LF = 4096, HGR_V = 8192, HGR_BYTES = 12288;
constexpr int HG_OPND = 0, HG_RAW = 3 * HGB_BYTES, HG_AOP = HG_RAW + NRAW * HGR_BYTES, HG_LDS = HG_AOP + 2 * 512;
static_assert(RW_LDS <= RING_BYTES && HG_LDS <= RING_BYTES && RW_AOP % 16 == 0 && HG_AOP % 16 == 0, "scan LDS map");
#define GLDS4(gptr, lptr) __builtin_amdgcn_global_load_lds((const GAS unsigned*)(gptr), (LAS unsigned*)(lptr), 4, 0, 0)
#define WG_BAR() do { LDS_WAIT(); __builtin_amdgcn_s_barrier(); asm volatile("" ::: "memory"); } while (0)

__device__ __forceinline__ void p6_rwkv_head(Frame& F, int bh, int nsh) {
    const bf16* rkv = WSP(bf16, WS_R + R_RKV); const bf16* lout = WSP(bf16, WS_LOUT); const float* invn = WSP(float, WS_INVN); bf16* ydst = WSP(bf16, WS_LOUT);
    const int lane = F.lane, c = lane & 15, g = lane >> 4, w = F.wave;
    const int b = bh >> 4, h = bh & 15;
    const size_t rowbase = (size_t)b * SEQ;
    const int st = lane & 15;
    LAS unsigned char* const opnd = F.lds + RW_OPND; LAS unsigned char* const raw = F.lds + RW_RAW; LAS unsigned char* const aop = F.lds + RW_AOP;
#define RW3_DMA(j) do { const int r_ = 2 * w + (lane >> 5); const size_t ro_ = (rowbase + (size_t)(j) * CH + r_) * 3072 + h * RN + 2 * ((lane & 31) ^ r_); \
        LAS unsigned char* d_ = raw + ((j) % NRAW) * RWR_BYTES + w * 256; \
        GLDS4(rkv + ro_, d_ + RWR_R); GLDS4(rkv + ro_ + RC, d_ + RWR_K); GLDS4(rkv + ro_ + 2 * RC, d_ + RWR_V); GLDS4(lout + ro_, d_ + RWR_LW); GLDS4(lout + ro_ + RC, d_ + RWR_A); \
        if (lane < 2) GLDS4(invn + (rowbase + (size_t)(j) * CH + 2 * w + lane) * RH + h, raw + ((j) % NRAW) * RWR_BYTES + RWR_INV + w * 8); } while (0)
    struct PC { float mur0, mur1, muk0, muk1, muv0, muv1, kk0, kk1, ka0, ka1; };
    auto load_pc = [&](int k0) { const int chn = h * RN + k0; PC p; p.mur0 = F.in[7][chn]; p.mur1 = F.in[7][chn + 1]; p.muk0 = F.in[7][RC + chn]; p.muk1 = F.in[7][RC + chn + 1]; p.muv0 = F.in[7][2 * RC + chn]; p.muv1 = F.in[7][2 * RC + chn + 1];
        p.kk0 = F.in[13][chn]; p.kk1 = F.in[13][chn + 1]; p.ka0 = F.in[14][chn]; p.ka1 = F.in[14][chn + 1]; return p; };
    auto proc = [&](int j, int k0, const PC& pc) { const float mur0 = pc.mur0, mur1 = pc.mur1, muk0 = pc.muk0, muk1 = pc.muk1, muv0 = pc.muv0, muv1 = pc.muv1, kk0 = pc.kk0, kk1 = pc.kk1, ka0 = pc.ka0, ka1 = pc.ka1;
 const LAS unsigned char* s_ = raw + (j % NRAW) * RWR_BYTES; const int pq_ = (k0 >> 1) ^ st, pp_ = (k0 >> 1) ^ ((st + 15) & 15);
        const LAS unsigned char* sc_ = s_ + st * 128 + pq_ * 4; const LAS unsigned char* sp_ = ((st > 0) ? s_ + (st - 1) * 128 : ((j == 0) ? F.lds + RW_ZROW : raw + ((j + NRAW - 1) % NRAW) * RWR_BYTES + 15 * 128)) + pp_ * 4;
        const unsigned Lr = *(const LAS unsigned*)(sc_ + RWR_R), Lk = *(const LAS unsigned*)(sc_ + RWR_K), Lv = *(const LAS unsigned*)(sc_ + RWR_V);
        const unsigned Lw = *(const LAS unsigned*)(sc_ + RWR_LW), La = *(const LAS unsigned*)(sc_ + RWR_A);
        const unsigned Lrp = *(const LAS unsigned*)(sp_ + RWR_R), Lkp = *(const LAS unsigned*)(sp_ + RWR_K), Lvp = *(const LAS unsigned*)(sp_ + RWR_V);
        const float Linv = *(const LAS float*)(s_ + RWR_INV + st * 4);
        const float r0_ = bflo(Lr), r1_ = bfhi(Lr), q0_ = bflo(Lk), q1_ = bfhi(Lk), v0_ = bflo(Lv), v1_ = bfhi(Lv);
        const float rp0_ = bflo(Lrp), rp1_ = bfhi(Lrp), qp0_ = bflo(Lkp), qp1_ = bfhi(Lkp), vp0_ = bflo(Lvp), vp1_ = bfhi(Lvp);
        const float rs0_ = r0_ + (rp0_ - r0_) * mur0, rs1_ = r1_ + (rp1_ - r1_) * mur1, ks0_ = q0_ + (qp0_ - q0_) * muk0, ks1_ = q1_ + (qp1_ - q1_) * muk1, vs0_ = v0_ + (vp0_ - v0_) * muv0, vs1_ = v1_ + (vp1_ - v1_) * muv1;
        const float a0_ = bflo(La), a1_ = bfhi(La), lw0_ = bflo(Lw) * 1.44269504f, lw1_ = bfhi(Lw) * 1.44269504f;
        const float kap0_ = ks0_ * kk0 * Linv, kap1_ = ks1_ * kk1 * Linv, bet0_ = kap0_ * a0_, bet1_ = kap1_ * a1_;
        const float kt0_ = ks0_ * (1.0f + (a0_ - 1.0f) * ka0), kt1_ = ks1_ * (1.0f + (a1_ - 1.0f) * ka1);
        const float G0_ = row16_scan(lw0_), G1_ = row16_scan(lw1_);
        const float eg0_ = __builtin_amdgcn_exp2f(G0_), eg1_ = __builtin_amdgcn_exp2f(G1_), ep0_ = __builtin_amdgcn_exp2f(G0_ - lw0_), ep1_ = __builtin_amdgcn_exp2f(G1_ - lw1_), ei0_ = __builtin_amdgcn_exp2f(-G0_), ei1_ = __builtin_amdgcn_exp2f(-G1_);
        LAS unsigned char* d_ = opnd + (j % 3) * RWB_BYTES;
        *(LAS unsigned*)(d_ + RWB_KG + st * RWS + k0 * 2) = pk2(kap0_ * ep0_, kap1_ * ep1_); *(LAS unsigned*)(d_ + RWB_RG + st * RWS + k0 * 2) = pk2(rs0_ * eg0_, rs1_ * eg1_);
        const unsigned kti_ = pk2(kt0_ * ei0_, kt1_ * ei1_), bti_ = pk2(bet0_ * ei0_, bet1_ * ei1_), vv_ = pk2(vs0_, vs1_);
        *(LAS unsigned*)(d_ + RWB_KTI + st * RWS + k0 * 2) = kti_; *(LAS unsigned*)(d_ + RWB_BTI + st * RWS + k0 * 2) = bti_;
        *(LAS unsigned*)(d_ + RWB_V + st * RWS + k0 * 2) = vv_;
        if (st == 15) { *(LAS float*)(d_ + RWB_GL + k0 * 4) = eg0_; *(LAS float*)(d_ + RWB_GL + k0 * 4 + 4) = eg1_; }     };
    const int k0a = 2 * (w * 4 + (lane >> 4)), k0b = 2 * (4 * 4 + (lane >> 4));
    const PC pca = load_pc(k0a), pcb = load_pc(k0b);
#define RW3_PROC(j) do { if (w != 4) proc((j), k0a, pca); if (w == 5) proc((j), k0b, pcb); } while (0)
    const f32x4 zero4 = (f32x4){0.f, 0.f, 0.f, 0.f};
    auto a_job = [&](int j, int job) {
        const LAS unsigned char* rowp = opnd + (j % 3) * RWB_BYTES + c * RWS;
        const int offA = (job == 0 || job == 3) ? RWB_BTI : RWB_KTI;
        const int offB = (job == 0 || job == 1) ? RWB_KG : RWB_RG;
        const bf16x8 a0 = *(const LAS bf16x8*)(rowp + offA + 16 * g), a1 = *(const LAS bf16x8*)(rowp + offA + 64 + 16 * g);
        const bf16x8 b0 = *(const LAS bf16x8*)(rowp + offB + 16 * g), b1 = *(const LAS bf16x8*)(rowp + offB + 64 + 16 * g);
        f32x4 N = MFMA32(a0, b0, zero4); N = MFMA32(a1, b1, N);
        const bool strict = (job == 0 || job == 1);
#pragma unroll
        for (int r = 0; r < 4; ++r) { const int rj = 4 * g + r; N[r] = (strict ? (c > rj) : (c >= rj)) ? N[r] : 0.f; }
        f32x4 res = N;
        if (job == 0) {
            f32x4 N1t = MFMA32(b0, a0, zero4); N1t = MFMA32(b1, a1, N1t);
            f32x4 X;
#pragma unroll
            for (int r = 0; r < 4; ++r) { const int rj = 4 * g + r; N1t[r] = (rj > c) ? N1t[r] : 0.f; X[r] = ((rj == c) ? 1.0f : 0.f) - N[r]; }
            bf16x4 an = cv4(N), at = cv4(N1t);
            f32x4 P = MFMA16(at, an, zero4), Pt = MFMA16(an, at, zero4);
            X = MFMA16(cv4(Pt), cv4(X), padc(X));
            an = cv4(P); at = cv4(Pt);
            P = MFMA16(at, an, zero4); Pt = MFMA16(an, at, zero4);
            X = MFMA16(cv4(Pt), cv4(X), padc(X));
            an = cv4(P); at = cv4(Pt);
            Pt = MFMA16(an, at, zero4);
            X = MFMA16(cv4(Pt), cv4(X), padc(X));
            res = X;
        }
        *(LAS bf16x4*)(aop + (j & 1) * 2048 + job * 512 + lane * 8) = cv4(res);
    };
    auto a_stage = [&](int j) { if (w == 4) { a_job(j, 0); a_job(j, 1); } else if (w >= 6) a_job(j, w - 4); };
    f32x4 Z[4];
#pragma unroll
    for (int i = 0; i < 4; ++i) Z[i] = (f32x4){0.f, 0.f, 0.f, 0.f};
    const int tra = (4 * (lane >> 4) + ((lane >> 2) & 3)) * RWS + 8 * (lane & 3);
    for (int i_ = F.tid * 4; i_ < RWR_V + 128; i_ += NWAVES * 64 * 4) *(LAS unsigned*)(F.lds + RW_ZROW + i_) = 0u;
    { RW3_DMA(0); RW3_DMA(1); RW3_DMA(2); RW3_DMA(3); RW3_DMA(4); RW3_DMA(5); RW3_DMA(6); RW3_DMA(7); asm volatile("s_waitcnt vmcnt(0)" ::: "memory"); WG_BAR(); RW3_PROC(0); RW3_PROC(1); WG_BAR(); if (w >= 4) a_stage(0); WG_BAR(); }
    if (w >= 4) __builtin_amdgcn_s_setprio(1);
    if (w < 4) {
        for (int ci = 0; ci < NCHK; ++ci) {
            const int t0 = ci * CH; const int jp = (ci + 2 < NCHK) ? ci + 2 : NCHK - 1;
            if (nsh > 0 && ci == NCHK / 2 - NRAW) { if (w == 0 && lane == 0) { unsigned* ctl_ = WSP(unsigned, WS_CTL); XB_SPIN(xb_ld(ctl_ + CW_SIG_H2) < (unsigned)nsh, ctl_ + CW_BAR); __builtin_amdgcn_fence(__ATOMIC_ACQUIRE, "agent"); asm volatile("s_waitcnt vmcnt(0)" ::: "memory"); } WG_BAR(); }
            RW3_PROC(jp);
            const LAS unsigned char* cur = opnd + (ci % 3) * RWB_BYTES; const LAS unsigned char* rowp = cur + c * RWS; const LAS unsigned char* ap = aop + (ci & 1) * 2048 + lane * 8;
            bf16x8 pKg[2], pRg[2];
#pragma unroll
            for (int s = 0; s < 2; ++s) {
                pKg[s] = join8(*(const LAS v2u*)(rowp + RWB_KG + 64 * s + 8 * g), *(const LAS v2u*)(rowp + RWB_KG + 64 * s + 32 + 8 * g));
                pRg[s] = join8(*(const LAS v2u*)(rowp + RWB_RG + 64 * s + 8 * g), *(const LAS v2u*)(rowp + RWB_RG + 64 * s + 32 + 8 * g)); }
            const bf16x4 bV = lds_tr4(cur + RWB_V + tra + 32 * w);
            const bf16x4 xT = *(const LAS bf16x4*)(ap), n2 = *(const LAS bf16x4*)(ap + 512), n3 = *(const LAS bf16x4*)(ap + 1024), n4 = *(const LAS bf16x4*)(ap + 1536);
            const bf16x8 bZ0 = cv8(Z[0], Z[1]), bZ1 = cv8(Z[2], Z[3]);
            const bf16x4 z4 = (bf16x4){0, 0, 0, 0};
            f32x4 W = MFMA32(pKg[0], bZ0, zero4); W = MFMA32(pKg[1], bZ1, W); W = MFMA32(cat8(n2, z4), cat8(bV, z4), W);
            const f32x4 U = MFMA16(xT, cv4(W), zero4);
            const bf16x4 nU = cv4(-U);
            const bf16x8 bVU = cat8(bV, nU);
            f32x4 Y = MFMA32(pRg[0], bZ0, zero4); Y = MFMA32(pRg[1], bZ1, Y); Y = MFMA32(cat8(n3, n4), bVU, Y);
#pragma unroll
            for (int r = 0; r < 4; ++r) ydst[(rowbase + t0 + 4 * g + r) * 3072 + h * RN + 16 * w + c] = bf1(Y[r]);
#pragma unroll
            for (int zt = 0; zt < 4; ++zt) {
                const bf16x4 aK = lds_tr4(cur + RWB_KTI + tra + 32 * zt), aB = lds_tr4(cur + RWB_BTI + tra + 32 * zt);
                const f32x4 gl = *(const LAS f32x4*)(cur + RWB_GL + (16 * zt + 4 * g) * 4);
                Z[zt] = MFMA32(cat8(aK, aB), bVU, Z[zt]) * gl; }
            { const int jn = (ci + NRAW < NCHK) ? ci + NRAW : NCHK - 1; RW3_DMA(jn); }
            if (ci == NCHK / 2 - 1) asm volatile("s_waitcnt vmcnt(0)" ::: "memory");
            asm volatile("s_waitcnt vmcnt(50)" ::: "memory");
            WG_BAR();
            if (ci == NCHK / 2 - 1 && w == 0 && lane == 0) sig_post(WSP(unsigned, WS_CTL) + CW_SIG_HALF);
        }
    } else {
        for (int ci = 0; ci < NCHK; ++ci) {
            const int jp = (ci + 2 < NCHK) ? ci + 2 : NCHK - 1, ja = (ci + 1 < NCHK) ? ci + 1 : NCHK - 1;
            if (nsh > 0 && ci == NCHK / 2 - NRAW) WG_BAR();
            RW3_PROC(jp);
            a_stage(ja);
            { const int jn = (ci + NRAW < NCHK) ? ci + NRAW : NCHK - 1; RW3_DMA(jn); }
            asm volatile("s_waitcnt vmcnt(30)" ::: "memory");
            WG_BAR();
        }
    }
    __builtin_amdgcn_s_setprio(0);
#undef RW3_DMA
#undef RW3_PROC
}

__device__ __forceinline__ void p6_hgrn_head(Frame& F, int hb) {
    const bf16* hg = WSP(bf16, WS_R + R_HG); bf16* odst = WSP(bf16, WS_R + R_HG);
    const int lane = F.lane, c = lane & 15, g = lane >> 4, w = F.wave;
    const int bh = hb >> 1, half = hb & 1, b = bh >> 3, h = bh & 7, vb = half * 4 + (w & 3);
    const size_t rowbase = (size_t)b * SEQ;
    const int st = lane & 15, k0 = 4 * (w * 4 + (lane >> 4));
    LAS unsigned char* const opnd = F.lds + HG_OPND; LAS unsigned char* const raw = F.lds + HG_RAW; LAS unsigned char* const aop = F.lds + HG_AOP;
#define HG3_DMA(j) do { _Pragma("unroll") for (int rr_ = 0; rr_ < 2; ++rr_) { const int r_ = 2 * w + rr_; const bf16* p_ = hg + (rowbase + (size_t)(j) * CH + r_) * 4096 + h * HD + 2 * (2 * ((lane >> 1) ^ r_) + (lane & 1)); \
        LAS unsigned char* d_ = raw + ((j) % NRAW) * HGR_BYTES + r_ * 256; GLDS4(p_, d_ + HGR_Q); GLDS4(p_ + HC, d_ + HGR_LF); GLDS4(p_ + 2 * HC, d_ + HGR_V); } } while (0)
#define HG3_PROC(j) do { const LAS unsigned char* s_ = raw + ((j) % NRAW) * HGR_BYTES + st * 256 + (((k0 >> 2) ^ st) * 8); LAS unsigned char* d_ = opnd + ((j) % 3) * HGB_BYTES; \
        const v2u Lq = *(const LAS v2u*)(s_ + HGR_Q), Lf = *(const LAS v2u*)(s_ + HGR_LF), Lv = *(const LAS v2u*)(s_ + HGR_V); \
        const f32x4 q_ = unpack4(Lq); f32x4 lf_ = unpack4(Lf) * 1.44269504f; f32x4 qg_, ki_, eg_; \
        _Pragma("unroll") for (int e = 0; e < 4; ++e) { const float G_ = row16_scan(lf_[e]); eg_[e] = __builtin_amdgcn_exp2f(G_); qg_[e] = q_[e] * eg_[e]; ki_[e] = (1.0f - __builtin_amdgcn_exp2f(lf_[e])) * __builtin_amdgcn_exp2f(-G_); } \
        const v2u kw_ = pack4(ki_); *(LAS v2u*)(d_ + HGB_QG + st * HGS + k0 * 2) = pack4(qg_); *(LAS v2u*)(d_ + HGB_KI + st * HGS + k0 * 2) = kw_; \
        *(LAS v2u*)(d_ + HGB_V + st * HGS + k0 * 2) = Lv; \
        if (st == 15) *(LAS f32x4*)(d_ + HGB_GL + k0 * 4) = eg_; } while (0)
    const f32x4 zero4 = (f32x4){0.f, 0.f, 0.f, 0.f};
    auto a_stage = [&](int j) {
        const LAS unsigned char* rowp = opnd + (j % 3) * HGB_BYTES + c * HGS;
        f32x4 N = zero4;
#pragma unroll
        for (int s = 0; s < 4; ++s) { const bf16x8 nQ = *(const LAS bf16x8*)(rowp + HGB_QG + 64 * s + 16 * g), nK = *(const LAS bf16x8*)(rowp + HGB_KI + 64 * s + 16 * g); N = MFMA32(nK, nQ, N); }
#pragma unroll
        for (int r = 0; r < 4; ++r) N[r] = (c >= 4 * g + r) ? N[r] : 0.f;
        *(LAS bf16x4*)(aop + (j & 1) * 512 + lane * 8) = cv4(N);
    };
    f32x4 Z[8];
    const int trh = (4 * (lane >> 4) + ((lane >> 2) & 3)) * HGS + 8 * (lane & 3);
#pragma unroll
    for (int i = 0; i < 8; ++i) Z[i] = (f32x4){0.f, 0.f, 0.f, 0.f};
    { HG3_DMA(0); HG3_DMA(1); HG3_DMA(2); HG3_DMA(3); HG3_DMA(4); HG3_DMA(5); HG3_DMA(6); HG3_DMA(7); asm volatile("s_waitcnt vmcnt(0)" ::: "memory"); WG_BAR(); HG3_PROC(0); HG3_PROC(1); WG_BAR(); if (w == 4) a_stage(0); WG_BAR(); }
    if (w < 4) __builtin_amdgcn_s_setprio(1);
    if (w < 4) {
        for (int ci = 0; ci < NCHK; ++ci) {
            const int t0 = ci * CH; const int jp = (ci + 2 < NCHK) ? ci + 2 : NCHK - 1;
            HG3_PROC(jp);
            const LAS unsigned char* cur = opnd + (ci % 3) * HGB_BYTES; const LAS unsigned char* rowp = cur + c * HGS;
            f32x4 Y = zero4;
#pragma unroll
            for (int s = 0; s < 4; ++s) {
                const bf16x8 pQ = join8(*(const LAS v2u*)(rowp + HGB_QG + 64 * s + 8 * g), *(const LAS v2u*)(rowp + HGB_QG + 64 * s + 32 + 8 * g));
                Y = MFMA32(pQ, cv8(Z[2 * s], Z[2 * s + 1]), Y); }
            const bf16x4 bV = lds_tr4(cur + HGB_V + trh + 32 * vb);
            const bf16x4 n = *(const LAS bf16x4*)(aop + (ci & 1) * 512 + lane * 8);
            const bf16x4 z4 = (bf16x4){0, 0, 0, 0};
            Y = MFMA32(cat8(n, z4), cat8(bV, z4), Y);
#pragma unroll
            for (int r = 0; r < 4; ++r) odst[(rowbase + t0 + 4 * g + r) * 4096 + 2 * HC + h * HD + 16 * vb + c] = bf1(Y[r]);
#pragma unroll
            for (int zt = 0; zt < 8; ++zt) {
                const bf16x4 aK = lds_tr4(cur + HGB_KI + trh + 32 * zt);
                const f32x4 gl = *(const LAS f32x4*)(cur + HGB_GL + (16 * zt + 4 * g) * 4);
                Z[zt] = MFMA16(aK, bV, Z[zt]) * gl; }
            { const int jn = (ci + NRAW < NCHK) ? ci + NRAW : NCHK - 1; HG3_DMA(jn); }
            if (ci == NCHK / 2 - 1) asm volatile("s_waitcnt vmcnt(0)" ::: "memory");
            asm volatile("s_waitcnt vmcnt(50)" ::: "memory");
            WG_BAR();
            if (ci == NCHK / 2 - 1 && w == 0 && lane == 0) sig_post(WSP(unsigned, WS_CTL) + CW_SIG_HALF);
        }
    } else {
        for (int ci = 0; ci < NCHK; ++ci) {
            const int jp = (ci + 2 < NCHK) ? ci + 2 : NCHK - 1, ja = (ci + 1 < NCHK) ? ci + 1 : NCHK - 1;
            HG3_PROC(jp);
            if (w == 4) a_stage(ja);
            { const int jn = (ci + NRAW < NCHK) ? ci + NRAW : NCHK - 1; HG3_DMA(jn); }
            asm volatile("s_waitcnt vmcnt(30)" ::: "memory");
            WG_BAR();
        }
    }
    __builtin_amdgcn_s_setprio(0);
#undef HG3_DMA
#undef HG3_PROC
}
#undef WG_BAR
__device__ __forceinline__ void p7_post(Frame& F, int roff, int rlen, int c, int G, int parts);
constexpr int NSCAN = BATCH * RH + 2 * BATCH * HH;
__device__ __forceinline__ void p6_shadow(Frame& F, const Args& A, int c, int G) {
    const unsigned long long* ss = WSP(unsigned long long, WS_SS);
    {   pg8::Gemm g{WSP(bf16, WS_XB), WSP(bf16, WS_WIN) + (size_t)26 * 256 * D, M, 4 * 256, D, 0}; pg8::StaticOrder S; S.init(M, 4 * 256, G, c);
        pg8::EpiInProj E{WSP(bf16, WS_R + R_RKV), WSP(float, WS_R + R_LIN), WSP(bf16, WS_R + R_HG), pg8::inv_preload((PG8_LAS float*)(F.lds + pg8::STAGE_BYTES), S, ss + M), (PG8_LAS float*)(F.lds + pg8::STAGE_BYTES + 4096), 26};
        pg8::gemm_phase<pg8::EpiInProj, pg8::StaticOrder, true, true>(F.lds, g, S, E); }
    {   int kl = 256; asm volatile("" : "+s"(kl));
        pg8::Gemm g{WSP(bf16, WS_ALORA) + 128, WSP(bf16, WS_WLORA) + (size_t)2048 * 128, M, 4 * 256, kl, KL}; pg8::StaticOrder S; S.init(M, 4 * 256, G, c);
        pg8::EpiLora E{WSP(bf16, WS_LOUT), (PG8_LAS float*)(F.lds + pg8::STAGE_BYTES), 8};
        pg8::gemm_phase<pg8::EpiLora, pg8::StaticOrder, true, true>(F.lds, g, S, E); }
    p0_transposes<1>(F, A, c * NWAVES + F.wave, G * NWAVES);
}
__device__ __forceinline__ void p6_shadow_pre(Frame& F, int c, int G) {
    unsigned* ctl = WSP(unsigned, WS_CTL);
    p4_lora_in(F, 1, c, G);
    wg_signal(ctl + CW_SIG_P4); wg_wait(ctl + CW_SIG_P4, (unsigned)G, ctl + CW_BAR);
    {   int kl = 128; asm volatile("" : "+s"(kl));
        pg8::Gemm g{WSP(bf16, WS_ALORA), WSP(bf16, WS_WLORA), M, 8 * 256, kl, KL}; pg8::StaticOrder S; S.init(M / 2, 8 * 256, G, c); S.hsel = 1;
        PG8_LAS float* bt = (PG8_LAS float*)(F.lds + pg8::STAGE_BYTES);
        for (int cix = F.tid; cix < 2 * RC; cix += NWAVES * 64) bt[cix] = cix < RC ? F.in[8][cix] : F.in[10][cix - RC];
        __syncthreads();
        pg8::EpiLora E{WSP(bf16, WS_LOUT), bt, 0};
        pg8::gemm_phase<pg8::EpiLora, pg8::StaticOrder, true, true>(F.lds, g, S, E); }
    wg_signal(ctl + CW_SIG_H2);
}
constexpr int P8H1_SHADOW_UNITS = 384;
__device__ __forceinline__ void p6_shadow_b(Frame& F, int c, int G, bool helped) {
    unsigned* ctl = WSP(unsigned, WS_CTL);
    wg_signal(ctl + CW_SIG_SHA); wg_wait(ctl + CW_SIG_SHA, (unsigned)G, ctl + CW_BAR);
    wg_wait(ctl + CW_SIG_HALF, (unsigned)NSCAN, ctl + CW_BAR);
    p7_post(F, 0, SEQ / 2, c, G, 3);
    wg_signal(ctl + CW_SIG_SHB); wg_wait(ctl + CW_SIG_SHB, (unsigned)G, ctl + CW_BAR);
    {   pg8::Gemm g{WSP(bf16, WS_XB), WSP(bf16, WS_WOUT), M, D, D, 0}; pg8::StaticOrder S; S.init(M / 2, D, G, c, 4); S.hsel = 0; if (helped) S.ulim = P8H1_SHADOW_UNITS;
        pg8::EpiResid E{nullptr, (const bf16*)F.out, nullptr, nullptr, (bf16*)F.out + D, F.in[21], nullptr, WSP(unsigned long long, WS_SS) + 2 * M, 1.0f, 2 * D, 2 * D, 2048};
        pg8::gemm_phase<pg8::EpiResid, pg8::StaticOrder, true, true>(F.lds, g, S, E); }
    if (helped) {
        __syncthreads();
        wg_wait(ctl + CW_SIG_RW, (unsigned)(BATCH * RH), ctl + CW_BAR);
        p7_post(F, 5 * SEQ / 8, SEQ / 8, c, G, 1);
        wg_wait(ctl + CW_SIG_HG, (unsigned)(2 * BATCH * HH), ctl + CW_BAR);
        p7_post(F, 7 * SEQ / 8, SEQ / 8, c, G, 2);
    }
}
__device__ __forceinline__ void p6_hgrn_tail(Frame& F, int c, int G, int nshadow) {
    unsigned* ctl = WSP(unsigned, WS_CTL);
    __syncthreads();
    wg_signal(ctl + CW_SIG_HG); wg_wait(ctl + CW_SIG_HG, (unsigned)G, ctl + CW_BAR);
    wg_wait(ctl + CW_SIG_SHA, (unsigned)nshadow, ctl + CW_BAR);
    p7_post(F, SEQ / 2, 3 * SEQ / 8, c, G, 2);
    wg_wait(ctl + CW_SIG_SHB, (unsigned)nshadow, ctl + CW_BAR);
    {   pg8::Gemm g{WSP(bf16, WS_XB), WSP(bf16, WS_WOUT), M, D, D, 0}; pg8::StaticOrder S; S.init(M / 2, D, G, c, 4); S.hsel = 0; S.ubase = P8H1_SHADOW_UNITS;
        pg8::EpiResid E{nullptr, (const bf16*)F.out, nullptr, nullptr, (bf16*)F.out + D, F.in[21], nullptr, WSP(unsigned long long, WS_SS) + 2 * M, 1.0f, 2 * D, 2 * D, 2048};
        pg8::gemm_phase<pg8::EpiResid, pg8::StaticOrder, true, true>(F.lds, g, S, E); }
}
__device__ __forceinline__ void p6_rwkv_tail(Frame& F, int c, int G, int nshadow) {
    unsigned* ctl = WSP(unsigned, WS_CTL);
    __syncthreads();
    wg_signal(ctl + CW_SIG_RW); wg_wait(ctl + CW_SIG_RW, (unsigned)G, ctl + CW_BAR);
    wg_wait(ctl + CW_SIG_SHA, (unsigned)nshadow, ctl + CW_BAR);
    p7_post(F, SEQ / 2, SEQ / 8, c, G, 1);
}
__device__ __forceinline__ void p6_scans(Frame& F, const Args& A) {
    const int bx = (int)blockIdx.x;
    if (F.G == 2 * NSCAN) {
        const int x = bx & 7, idx = (bx >> 3) * 4 + (x & 3);
        if (x < 4) { if (idx < BATCH * RH) { p6_rwkv_head(F, idx, NSCAN); p6_rwkv_tail(F, idx, BATCH * RH, NSCAN); } else { p6_hgrn_head(F, idx - BATCH * RH); p6_hgrn_tail(F, idx - BATCH * RH, 2 * BATCH * HH, NSCAN); } } else { p6_shadow_pre(F, idx, NSCAN); p6_shadow(F, A, idx, NSCAN); p6_shadow_b(F, idx, NSCAN, true); } }
    else if (F.G > NSCAN) { if (bx < NSCAN) { if (bx < BATCH * RH) p6_rwkv_head(F, bx, F.G - NSCAN); else p6_hgrn_head(F, bx - BATCH * RH); } else { p6_shadow_pre(F, bx - NSCAN, F.G - NSCAN); p6_shadow(F, A, bx - NSCAN, F.G - NSCAN); p6_shadow_b(F, bx - NSCAN, F.G - NSCAN, false); } }
    else {
        for (int u = bx; u < NSCAN; u += F.G) { if (u < BATCH * RH) p6_rwkv_head(F, u, 0); else p6_hgrn_head(F, u - BATCH * RH); }
        __syncthreads(); p6_shadow(F, A, bx, F.G);
    }
}

__device__ __forceinline__ void p7_post(Frame& F, int roff, int rlen, int c, int G, int parts) {
    const int NR = BATCH * rlen;
    const bf16* rkv = WSP(bf16, WS_R + R_RKV); const bf16* hg = WSP(bf16, WS_R + R_HG); const bf16* lout = WSP(bf16, WS_LOUT); bf16* yc = WSP(bf16, WS_XB);
    if (parts & 1) { const int half = F.tid >> 8, ch = (F.tid & 255) * 4;
      const f32x4 mu_r = *(const f32x4*)(F.in[7] + ch), mu_k = *(const f32x4*)(F.in[7] + RC + ch), mu_v = *(const f32x4*)(F.in[7] + 2 * RC + ch);
      const f32x4 kac = *(const f32x4*)(F.in[14] + ch), rkc = *(const f32x4*)(F.in[15] + ch), lnw = *(const f32x4*)(F.in[16] + ch), lnb = *(const f32x4*)(F.in[17] + ch);
      for (int b0 = c * 2 + half; b0 < NR / 4; b0 += 2 * G) { const int i = 4 * b0, m0 = (i / rlen) * SEQ + roff + (i % rlen);
          const bool first0 = (m0 & (SEQ - 1)) == 0; const size_t mp = first0 ? m0 : m0 - 1;
          v2u Ly[4], Lr[4], Lk[4], Lv[4], La[4], Lg[4];
          const bf16* q = rkv + mp * 3072 + ch; const v2u Lrp = *(const GAS v2u*)(q), Lkp = *(const GAS v2u*)(q + RC), Lvp = *(const GAS v2u*)(q + 2 * RC);
#pragma unroll
          for (int u = 0; u < 4; ++u) { const bf16* p = rkv + (size_t)(m0 + u) * 3072 + ch; const bf16* l = lout + (size_t)(m0 + u) * 3072 + ch;
              Ly[u] = *(const GAS v2u*)(l); Lr[u] = *(const GAS v2u*)(p); Lk[u] = *(const GAS v2u*)(p + RC); Lv[u] = *(const GAS v2u*)(p + 2 * RC); La[u] = *(const GAS v2u*)(l + RC); Lg[u] = *(const GAS v2u*)(l + 2 * RC); }
          f32x4 rp = unpack4(Lrp), kp = unpack4(Lkp), vp = unpack4(Lvp);
          if (first0) { rp = (f32x4){0.f, 0.f, 0.f, 0.f}; kp = rp; vp = rp; }
#pragma unroll
          for (int u = 0; u < 4; ++u) {
              const f32x4 y = unpack4(Ly[u]);
              const f32x4 r = unpack4(Lr[u]), k = unpack4(Lk[u]), v = unpack4(Lv[u]);
              const f32x4 a = unpack4(La[u]), gg = unpack4(Lg[u]);
              const f32x4 rs = r + (rp - r) * mu_r, ks = k + (kp - k) * mu_k, vs = v + (vp - v) * mu_v;
              const f32x4 km = ks * (1.0f + (a - 1.0f) * kac);
              const f32x4 bt = rs * km * rkc; float bon = (bt[0] + bt[1]) + (bt[2] + bt[3]); bon = row16_sum(bon);
              float s1 = (y[0] + y[1]) + (y[2] + y[3]); s1 = row16_sum(s1); const float mean = s1 * (1.0f / 64.0f);
              const f32x4 d = y - mean; float s2 = (d[0] * d[0] + d[1] * d[1]) + (d[2] * d[2] + d[3] * d[3]); s2 = row16_sum(s2);
              const float rstd = 1.0f / sqrtf(s2 * (1.0f / 64.0f) + 64e-5f);
              const f32x4 o = ((d * rstd) * lnw + lnb + vs * bon) * gg;
              *(GAS v2u*)(yc + (size_t)(m0 + u) * 2048 + ch) = pack4(o);
              rp = r; kp = k; vp = v; } } }
    if (parts & 2) { const int quarter = F.tid >> 7, ch = (F.tid & 127) * 8;
      const f32x4 nw0 = *(const f32x4*)(F.in[19] + ch), nw1 = *(const f32x4*)(F.in[19] + ch + 4);
#pragma unroll 4
      for (int i = c * 4 + quarter; i < NR; i += 4 * G) { const int m = (i / rlen) * SEQ + roff + (i % rlen);
          const v4u ow = *(const GAS v4u*)(hg + (size_t)m * 4096 + 2 * HC + ch), gw4 = *(const GAS v4u*)(hg + (size_t)m * 4096 + 3 * HC + ch);
          const f32x4 o0 = (f32x4){bflo(ow.x), bfhi(ow.x), bflo(ow.y), bfhi(ow.y)}, o1 = (f32x4){bflo(ow.z), bfhi(ow.z), bflo(ow.w), bfhi(ow.w)};
          const f32x4 g0 = (f32x4){bflo(gw4.x), bfhi(gw4.x), bflo(gw4.y), bfhi(gw4.y)}, g1 = (f32x4){bflo(gw4.z), bfhi(gw4.z), bflo(gw4.w), bfhi(gw4.w)};
          float s2 = ((o0[0] * o0[0] + o0[1] * o0[1]) + (o0[2] * o0[2] + o0[3] * o0[3])) + ((o1[0] * o1[0] + o1[1] * o1[1]) + (o1[2] * o1[2] + o1[3] * o1[3])); s2 = row16_sum(s2);
          const float rstd = 1.0f / sqrtf(s2 * (1.0f / 128.0f) + 1e-6f);
          *(GAS v4u*)(yc + (size_t)m * 2048 + RC + ch) = pg8::pack8(o0 * rstd * nw0 * g0, o1 * rstd * nw1 * g1); } }
}

__device__ __forceinline__ void p11_final(Frame& F) {
    const int gw = F.vcu * NWAVES + F.wave, NGW = F.G * NWAVES; const float* fg = F.in[25];
    const bf16* x3 = WSP(bf16, WS_XB); const unsigned long long* ss3 = WSP(unsigned long long, WS_SS) + 3 * M;
    f32x4 gn[8];
#pragma unroll
    for (int j = 0; j < 4; ++j) { gn[2 * j] = *(const f32x4*)(fg + 8 * F.lane + 512 * j); gn[2 * j + 1] = *(const f32x4*)(fg + 8 * F.lane + 512 * j + 4); }
#pragma unroll 2
    for (int m = gw; m < M; m += NGW) { const GAS v4u* xr = (const GAS v4u*)(x3 + (size_t)m * D) + F.lane; GAS f32x4* o = (GAS f32x4*)(F.out + (size_t)m * D) + 2 * F.lane;
        const float inv = pg8::inv_rms_from_val(ss3[m]);
#pragma unroll
        for (int j = 0; j < 4; ++j) { const v4u w = xr[64 * j];
            o[128 * j] = (f32x4){bflo(w.x), bfhi(w.x), bflo(w.y), bfhi(w.y)} * inv * gn[2 * j]; o[128 * j + 1] = (f32x4){bflo(w.z), bfhi(w.z), bflo(w.w), bfhi(w.w)} * inv * gn[2 * j + 1]; } }
}

__global__ void __launch_bounds__(NWAVES * 64, 2) mk_fwd(Args args) {
    extern __shared__ __attribute__((aligned(16))) unsigned char lds[];
    Frame F;
    F.lds = (LAS unsigned char*)lds;
    F.tid = threadIdx.x; F.lane = F.tid & 63; F.wave = __builtin_amdgcn_readfirstlane(F.tid >> 6);
    F.G = gridDim.x; { const int bx = blockIdx.x; F.vcu = (F.G % 8 == 0) ? (bx % 8) * (F.G / 8) + bx / 8 : bx; }
#pragma unroll
    for (int i = 0; i < 26; ++i) F.in[i] = args.in[i];
    F.out = args.out; F.ws = args.ws;
    for (int u = F.tid; u < (LDS_BYTES - LDSCTL_OFF) / 4; u += NWAVES * 64) ((LAS unsigned*)(F.lds + LDSCTL_OFF))[u] = 0u;
    __syncthreads();
    const int lo = args.ph_lo, hi = args.ph_hi;
    XcdBarrier bar; bar.bar = (unsigned*)(args.ws + WS_CTL) + CW_BAR; bar.x = 0; bar.st = nullptr;
    if (hi - lo > 1) bar = xcd_barrier_post((unsigned*)(args.ws + WS_CTL) + CW_BAR, (volatile LAS unsigned*)(F.lds + MISC_OFF) + 8);
#ifndef PH_MASK
#define PH_MASK 0xFFF
#endif
#define IN(k) (((PH_MASK >> (k)) & 1) && lo <= (k) && (k) < hi)
#define SEAM(k) do { if (IN(k) && IN((k) + 1)) xcd_barrier(bar); } while (0)
    const bf16* xb = WSP(bf16, WS_XB); unsigned long long* ss = WSP(unsigned long long, WS_SS);
    const int cid = (int)blockIdx.x;
    bf16* const x2b = (bf16*)F.out + D;
    const bool fuse = (F.G % 256) == 0;

    if (IN(0)) { p0_prologue(F, args); } SEAM(0);
    if (IN(1)) {
        pg8::Gemm g{xb, WSP(bf16, WS_W1GU), M, 2 * FF, D, 0}; pg8::StaticOrder S; S.init(M, 2 * FF, F.G, cid);
        pg8::EpiSwiglu E{WSP(bf16, WS_R + R_ACT), FF, pg8::inv_preload((PG8_LAS float*)(F.lds + pg8::STAGE_BYTES), S, ss)};
        pg8::gemm_phase<pg8::EpiSwiglu, pg8::StaticOrder, true, true>(F.lds, g, S, E);
    } SEAM(1);
    if (IN(2)) {
        pg8::Gemm g{WSP(bf16, WS_R + R_ACT), WSP(bf16, WS_W1D), M, D, FF, 0}; pg8::StaticOrder S; S.init(M, D, F.G, cid, 4);
        pg8::EpiResid E{F.in[0], nullptr, nullptr, nullptr, WSP(bf16, WS_XB), F.in[5], (bf16*)F.out, ss + M, 0.5f, 2048, 2048, 2 * D};
        pg8::gemm_phase<pg8::EpiResid, pg8::StaticOrder, true, true>(F.lds, g, S, E);
    } SEAM(2);
    if (IN(3)) {
        pg8::Gemm g{xb, WSP(bf16, WS_WIN), M, 26 * 256, D, 0}; pg8::StaticOrder S; S.init(M, 26 * 256, F.G, cid);
        PG8_LAS float* omt = (PG8_LAS float*)(F.lds + pg8::STAGE_BYTES + 4096);
        for (int cix = F.tid; cix < HC; cix += NWAVES * 64) omt[cix] = 1.0f - fast_sigmoid(F.in[18][cix] - F.in[18][HC + cix]);
        pg8::EpiInProj E{WSP(bf16, WS_R + R_RKV), WSP(float, WS_R + R_LIN), WSP(bf16, WS_R + R_HG), pg8::inv_preload((PG8_LAS float*)(F.lds + pg8::STAGE_BYTES), S, ss + M), omt, 0};
        pg8::gemm_phase<pg8::EpiInProj, pg8::StaticOrder, true, true>(F.lds, g, S, E);
    } SEAM(3);
    const bool split = F.G > NSCAN;
    if (IN(4)) { p4_lora_in(F, split ? 0 : -1, F.vcu, F.G); } SEAM(4);
    if (IN(5)) {
        int kl = 128; asm volatile("" : "+s"(kl));
        pg8::Gemm g{WSP(bf16, WS_ALORA), WSP(bf16, WS_WLORA), M, 8 * 256, kl, KL}; pg8::StaticOrder S; S.init(split ? M / 2 : M, 8 * 256, F.G, cid); S.hsel = split ? 0 : -1;
        PG8_LAS float* bt = (PG8_LAS float*)(F.lds + pg8::STAGE_BYTES);
        for (int cix = F.tid; cix < 2 * RC; cix += NWAVES * 64) bt[cix] = cix < RC ? F.in[8][cix] : F.in[10][cix - RC];
        __syncthreads();
        pg8::EpiLora E{WSP(bf16, WS_LOUT), bt, 0};
        pg8::gemm_phase<pg8::EpiLora, pg8::StaticOrder, true, true>(F.lds, g, S, E);
    } SEAM(5);
    if (IN(6)) { p6_scans(F, args); } SEAM(6);
    if (IN(7)) { if (F.G == 2 * NSCAN) p7_post(F, 3 * SEQ / 4, SEQ / 4, F.vcu, F.G, 1); else p7_post(F, split ? SEQ / 2 : 0, split ? SEQ / 2 : SEQ, F.vcu, F.G, 3); } SEAM(7);
    if (IN(8)) {
        pg8::Gemm g{xb, WSP(bf16, WS_WOUT), M, D, D, 0}; pg8::StaticOrder S; S.init(split ? M / 2 : M, D, F.G, cid, 4); S.hsel = split ? 1 : -1;
        pg8::EpiResid E{nullptr, (const bf16*)F.out, nullptr, nullptr, x2b, F.in[21], nullptr, ss + 2 * M, 1.0f, 2 * D, 2 * D, 2048};
        pg8::gemm_phase<pg8::EpiResid, pg8::StaticOrder, true, true>(F.lds, g, S, E);
    } SEAM(8);
    if (IN(9)) {
        pg8::Gemm g{x2b, WSP(bf16, WS_W2GU), M, 2 * FF, D, 2 * D}; pg8::StaticOrder S; S.init(M, 2 * FF, F.G, cid);
        pg8::EpiSwiglu E{WSP(bf16, WS_R + R_ACT), FF, pg8::inv_preload((PG8_LAS float*)(F.lds + pg8::STAGE_BYTES), S, ss + 2 * M)};
        pg8::gemm_phase<pg8::EpiSwiglu, pg8::StaticOrder, true, true>(F.lds, g, S, E);
    } SEAM(9);
    if (IN(10)) {
        pg8::Gemm g{WSP(bf16, WS_R + R_ACT), WSP(bf16, WS_W2D), M, D, FF, 0}; pg8::StaticOrder S; S.init(M, D, F.G, cid, 4);
        if (fuse) { pg8::EpiFinal E{x2b, 2 * D, F.in[21], F.in[25], F.out, ss + 3 * M, WSP(unsigned, WS_CTL) + CW_PCNT, WSP(unsigned, WS_CTL) + CW_BAR + XB_TMO, 0.5f, (unsigned)(D / 256)};
            pg8::gemm_phase<pg8::EpiFinal, pg8::StaticOrder, true, true>(F.lds, g, S, E); }
        else { pg8::EpiResid E{nullptr, x2b, F.in[21], nullptr, nullptr, nullptr, WSP(bf16, WS_XB), ss + 3 * M, 0.5f, 2 * D, 2048, 2048};
            pg8::gemm_phase<pg8::EpiResid, pg8::StaticOrder, true, true>(F.lds, g, S, E); }
    }
    if (!fuse) { SEAM(10); if (IN(11)) { p11_final(F); } }
#undef IN
#undef SEAM
}

extern "C" void kernel_launch(void* const* d_in, const int* in_sizes, int n_in, void* d_out, int out_size, void* d_ws, size_t ws_size, hipStream_t stream) {
    static int grid = 0;
    if (grid == 0) {
        if (n_in != 26 || in_sizes[0] != M * D || out_size != M * D || ws_size < WS_END) { fprintf(stderr, "kernel_launch: unexpected problem (n_in %d, ws %zu < %zu)\n", n_in, ws_size, (size_t)WS_END); grid = -1; return; }
        int dev = 0, cus = 0, per_cu = 0;
        if (hipGetDevice(&dev) != hipSuccess || hipDeviceGetAttribute(&cus, hipDeviceAttributeMultiprocessorCount, dev) != hipSuccess) { grid = -1; return; }
        if (hipFuncSetAttribute((const void*)mk_fwd, hipFuncAttributeMaxDynamicSharedMemorySize, LDS_BYTES) != hipSuccess) { grid = -1; return; }
        if (hipOccupancyMaxActiveBlocksPerMultiprocessor(&per_cu, (const void*)mk_fwd, NWAVES * 64, LDS_BYTES) != hipSuccess || per_cu < 1) fprintf(stderr, "kernel_launch: occupancy query reports %d\n", per_cu);
        (void)hipGetLastError();
        grid = cus;
    }
    if (grid < 0) return;
    (void)hipMemsetAsync((char*)d_ws + WS_CTL, 0, CTL_BYTES, stream);
    Args a{};
    for (int i = 0; i < 26; ++i) a.in[i] = (const float*)d_in[i];
    a.out = (float*)d_out; a.ws = (unsigned char*)d_ws;
    constexpr int NL_ = MK_N_LAUNCHES;
    for (int li = 0; li < NL_; ++li) {
        a.ph_lo = (NL_ == 1) ? 0 : li; a.ph_hi = (NL_ == 1) ? N_PHASES : li + 1;
        hipLaunchKernelGGL(mk_fwd, dim3(grid), dim3(NWAVES * 64), LDS_BYTES, stream, a);
    }
}
```
